# Optimizing an MI355X kernel written in HIP

```python
import math
import jax, jax.numpy as jnp
from jax import lax
import numpy as np

D_MODEL = 1024
BATCH = 8
SEQ = 4096
DEPTH = 2

CTX_LEN = 256
GRID_W = 64
HEAD_DIM = 64
D_MIX = D_MODEL
N_GROUPS = 4
GROUP_W = D_MIX // N_GROUPS
EPS = 1e-6
ROPE_BASE = 10000.0

SWA_HEADS = GROUP_W // HEAD_DIM
SWA_KV_HEADS = SWA_HEADS // 2
SWA_WINDOW = 128
SWA_BLOCK = 128
SWA_Q = SWA_HEADS * HEAD_DIM
SWA_KV = SWA_KV_HEADS * HEAD_DIM
SWA_COLS = SWA_Q + 2 * SWA_KV

RET_HEADS = GROUP_W // HEAD_DIM
RET_W = RET_HEADS * HEAD_DIM
RET_CHUNK = 128
RET_EPS = 1e-5
RET_COLS = 4 * RET_W

RWKV_HEADS = GROUP_W // HEAD_DIM
RWKV_W = RWKV_HEADS * HEAD_DIM
RWKV_DECAY_LORA = 64
RWKV_A_LORA = 64
RWKV_GATE_LORA = 128
RWKV_EPS = 64e-5
RWKV_COLS = 3 * RWKV_W + RWKV_DECAY_LORA + RWKV_A_LORA + RWKV_GATE_LORA

MLA_HEADS = GROUP_W // HEAD_DIM
MLA_Q_LORA = 256
MLA_KV_LORA = 128
MLA_NOPE = 64
MLA_ROPE = 32
MLA_V = HEAD_DIM
MLA_QK = MLA_NOPE + MLA_ROPE
MLA_BLOCK = 128
MLA_COLS = MLA_Q_LORA + MLA_KV_LORA + MLA_ROPE

GROUP_COLS = (SWA_COLS, RET_COLS, RWKV_COLS, MLA_COLS)
N_IN = SWA_COLS + RET_COLS + RWKV_COLS + MLA_COLS
D_FF = 4 * D_MODEL

kernel_name = 'hybrid_parallel_group_flow_block'


def split_sizes(t, sizes):
    idx = [int(i) for i in np.cumsum(sizes)[:-1]]
    return jnp.split(t, idx, axis=-1)


def rmsnorm(x, g, eps=EPS):
    xf = x.astype(jnp.float32)
    y = xf * lax.rsqrt(jnp.mean(xf * xf, axis=-1, keepdims=True) + eps)
    return y.astype(x.dtype) * g


def head_norm(o, gain, eps):
    mu = jnp.mean(o, axis=-1, keepdims=True)
    var = jnp.mean(jnp.square(o - mu), axis=-1, keepdims=True)
    y = (o - mu) * lax.rsqrt(var + eps)
    return y.reshape(o.shape[:-2] + (-1,)) * gain.astype(jnp.float32)


def modulate(h, shift, scale):
    return h * (1.0 + scale) + shift


def axial_rope_tables(n_tokens, d_rot):
    n_rows = n_tokens // GRID_W
    row, col = jnp.meshgrid(jnp.arange(n_rows, dtype=jnp.float32), jnp.arange(GRID_W, dtype=jnp.float32), indexing='ij')
    d_ax = d_rot // 2
    inv = ROPE_BASE ** (-jnp.arange(0, d_ax, 2, dtype=jnp.float32) / d_ax)
    ang = jnp.stack([row.reshape(-1)[:, None] * inv, col.reshape(-1)[:, None] * inv], axis=1)
    return jnp.cos(ang), jnp.sin(ang)


def rope(x, tables):
    cos, sin = tables
    nf = cos.shape[-1]
    shape = (1, cos.shape[0]) + (1,) * (x.ndim - 3) + (2, nf)
    c = cos.reshape(shape).astype(x.dtype)
    s = sin.reshape(shape).astype(x.dtype)
    xr = x.reshape(x.shape[:-1] + (2, 2, nf))
    x1, x2 = xr[..., 0, :], xr[..., 1, :]
    return jnp.stack([x1 * c - x2 * s, x2 * c + x1 * s], axis=-2).reshape(x.shape)


def sink_softmax(s, sink):
    m = jnp.maximum(jnp.max(s, axis=-1, keepdims=True), sink)
    p = jnp.exp(s - m)
    return p / (jnp.sum(p, axis=-1, keepdims=True) + jnp.exp(sink - m))


def swa_mixer(p, pc, sink, rope_t, emit_ctx):
    B, L, _ = p.shape
    G = SWA_HEADS // SWA_KV_HEADS
    dh = HEAD_DIM
    Bk = SWA_BLOCK
    NB = L // Bk
    scale = dh ** -0.5

    def heads(t):
        q, k, v = split_sizes(t, (SWA_Q, SWA_KV, SWA_KV))
        b, n = t.shape[:2]
        return (q.reshape(b, n, SWA_KV_HEADS, G, dh), k.reshape(b, n, SWA_KV_HEADS, dh),
                v.reshape(b, n, SWA_KV_HEADS, dh))

    q, k, v = heads(p)
    qc, kc, vc = heads(pc)
    q = rope(q, rope_t) * scale
    k = rope(k, rope_t)
    sink_hg = sink.astype(jnp.float32).reshape(SWA_KV_HEADS, G)

    pad = ((0, 0), (Bk, Bk), (0, 0), (0, 0))
    kp = jnp.pad(k, pad).reshape(B, NB + 2, Bk, SWA_KV_HEADS, dh)
    vp = jnp.pad(v, pad).reshape(B, NB + 2, Bk, SWA_KV_HEADS, dh)
    kb = jnp.concatenate([kp[:, :-2], kp[:, 1:-1], kp[:, 2:]], axis=2)
    vb = jnp.concatenate([vp[:, :-2], vp[:, 1:-1], vp[:, 2:]], axis=2)
    qb = q.reshape(B, NB, Bk, SWA_KV_HEADS, G, dh)
    s_loc = jnp.einsum('bnqhgd,bnkhd->bhgnqk', qb, kb).astype(jnp.float32)
    qpos = jnp.arange(NB)[:, None] * Bk + jnp.arange(Bk)[None, :]
    kpos = (jnp.arange(NB)[:, None] - 1) * Bk + jnp.arange(3 * Bk)[None, :]
    valid = ((jnp.abs(qpos[:, :, None] - kpos[:, None, :]) <= SWA_WINDOW)
             & (kpos[:, None, :] >= 0) & (kpos[:, None, :] < L))
    s_loc = jnp.where(valid, s_loc, -jnp.inf)
    s_ctx = jnp.einsum('bnqhgd,bchd->bhgnqc', qb, kc).astype(jnp.float32)
    probs = sink_softmax(jnp.concatenate([s_loc, s_ctx], axis=-1),
                         sink_hg[None, :, :, None, None, None]).astype(v.dtype)
    o = (jnp.einsum('bhgnqk,bnkhd->bnqhgd', probs[..., :3 * Bk], vb)
         + jnp.einsum('bhgnqc,bchd->bnqhgd', probs[..., 3 * Bk:], vc))
    y = o.reshape(B, L, SWA_Q)

    y_ctx = None
    if emit_ctx:
        qcs = qc * scale
        sc = jnp.einsum('bqhgd,bkhd->bhgqk', qcs, kc).astype(jnp.float32)
        pc_ = sink_softmax(sc, sink_hg[None, :, :, None, None]).astype(vc.dtype)
        y_ctx = jnp.einsum('bhgqk,bkhd->bqhgd', pc_, vc).reshape(B, pc.shape[1], SWA_Q)
    return y, y_ctx


def retention_scan(q, k, v, log_g, S0):
    B, H, L, d = q.shape
    C = RET_CHUNK
    N = L // C
    i = jnp.arange(C, dtype=jnp.float32)
    diff = i[:, None] - i[None, :]
    D = jnp.where(diff >= 0, jnp.exp(jnp.maximum(diff, 0.0)[None] * log_g[:, None, None]), 0.0)
    q_dec = jnp.exp((i + 1.0)[None, :] * log_g[:, None])
    k_dec = jnp.exp((C - 1.0 - i)[None, :] * log_g[:, None])
    c_dec = jnp.exp(C * log_g)
    xs = tuple(t.reshape(B, H, N, C, d).transpose(2, 0, 1, 3, 4) for t in (q, k, v))

    def step(S, qkv):
        qc, kc, vc = qkv
        s = jnp.einsum('bhid,bhjd->bhij', qc, kc) * D
        o = jnp.einsum('bhij,bhjd->bhid', s, vc) + jnp.einsum('bhid,bhde->bhie', qc * q_dec[:, :, None], S)
        S = S * c_dec[:, None, None] + jnp.einsum('bhjd,bhje->bhde', kc * k_dec[:, :, None], vc)
        return S, o

    S, o = lax.scan(step, S0, xs)
    return o.transpose(1, 2, 0, 3, 4).reshape(B, H, L, d), S


def retention_state(k, v, log_g):
    L = k.shape[2]
    dec = jnp.exp((L - 1.0 - jnp.arange(L, dtype=jnp.float32))[None, :] * log_g[:, None])
    return jnp.einsum('bhjd,bhje->bhde', k * dec[None, :, :, None], v)


def retention_mixer(p, pc, gn_g, emit_ctx):
    log_g = jnp.log1p(-jnp.exp2(-5.0 - jnp.arange(RET_HEADS, dtype=jnp.float32)))

    def heads(t):
        return t.reshape(t.shape[0], t.shape[1], RET_HEADS, HEAD_DIM).transpose(0, 2, 1, 3).astype(jnp.float32)

    def prep(t):
        q, k, v, g = split_sizes(t, (RET_W, RET_W, RET_W, RET_W))
        return heads(q), heads(k) * (HEAD_DIM ** -0.5), heads(v), g

    flip = lambda t: t[:, :, ::-1]
    q, k, v, g = prep(p)
    qc, kc, vc, gc = prep(pc)
    zeros = jnp.zeros((p.shape[0], RET_HEADS, HEAD_DIM, HEAD_DIM), jnp.float32)
    if emit_ctx:
        oc_f, s_f = retention_scan(qc, kc, vc, log_g, zeros)
        oc_b, s_b = retention_scan(flip(qc), flip(kc), flip(vc), log_g, zeros)
    else:
        s_f = retention_state(kc, vc, log_g)
        s_b = retention_state(flip(kc), flip(vc), log_g)
    o_f, _ = retention_scan(q, k, v, log_g, s_f)
    o_b, _ = retention_scan(flip(q), flip(k), flip(v), log_g, s_b)

    def finish(o, gate):
        y = head_norm(o.transpose(0, 2, 1, 3), gn_g, RET_EPS)
        return (y * jax.nn.silu(gate.astype(jnp.float32))).astype(gate.dtype)

    y = finish(o_f + flip(o_b), g)
    y_ctx = finish(oc_f + flip(oc_b), gc) if emit_ctx else None
    return y, y_ctx


def token_shift(z, mu):
    zp = jnp.pad(z, ((0, 0), (1, 1), (0, 0)))
    return z + mu * (0.5 * (zp[:, :-2] + zp[:, 2:]) - z)


def rwkv_scan(w, kh, a, v, kt, r, S0, emit):
    tm = lambda t: jnp.swapaxes(t, 0, 1)
    xs = (tm(w), tm(kh), tm(a), tm(v), tm(kt)) + ((tm(r),) if emit else ())

    def step(S, inp):
        w_t, kh_t, a_t, v_t, kt_t = inp[:5]
        S = (S * w_t[:, :, None, :]
             - jnp.einsum('bhvk,bhk->bhv', S, kh_t)[..., None] * (kh_t * a_t)[:, :, None, :]
             + v_t[..., None] * kt_t[:, :, None, :])
        o = jnp.einsum('bhvk,bhk->bhv', S, inp[5]) if emit else None
        return S, o

    S, o = lax.scan(step, S0, xs)
    return S, (tm(o) if emit else None)


def rwkv_mixer(p, pc, mu, w0, w_up, a0, a_up, g_up, kk_p, ka_p, rk, gn_g, emit_ctx):
    def heads(t):
        return t.reshape(t.shape[0], t.shape[1], RWKV_HEADS, HEAD_DIM).astype(jnp.float32)

    def prep(t):
        r, k, v, wd, ad, gd = split_sizes(token_shift(t, mu), (RWKV_W, RWKV_W, RWKV_W, RWKV_DECAY_LORA, RWKV_A_LORA, RWKV_GATE_LORA))
        kk = heads(k * kk_p)
        kh = kk * lax.rsqrt(jnp.maximum(jnp.sum(kk * kk, axis=-1, keepdims=True), 1e-12))
        dirs = []
        for d in range(2):
            w = jnp.exp(-math.exp(-0.5) * jax.nn.sigmoid((w0[d] + jnp.tanh(wd) @ w_up[d]).astype(jnp.float32)))
            a = jax.nn.sigmoid((a0[d] + ad @ a_up[d]).astype(jnp.float32))
            kt = heads(k) * (1.0 + (heads(a) - 1.0) * heads(ka_p[None, None, :]))
            dirs.append((heads(w), heads(a), kt))
        g = jax.nn.sigmoid(gd) @ g_up
        return heads(r), kh, heads(v), dirs, g

    flip = lambda t: t[:, ::-1]

    def run(r, kh, v, dirs, S0s, emit):
        outs, states = [], []
        for d in range(2):
            w, a, kt = dirs[d]
            seqs = (w, kh, a, v, kt, r)
            if d == 1:
                seqs = tuple(flip(t) for t in seqs)
            S, o = rwkv_scan(*seqs, S0s[d], emit)
            states.append(S)
            outs.append(flip(o) if (emit and d == 1) else o)
        return outs, states

    def finish(outs, r, v, dirs, g):
        y = head_norm(outs[0] + outs[1], gn_g, RWKV_EPS)
        bonus = sum(jnp.sum(r * dirs[d][2] * rk, axis=-1, keepdims=True) * v for d in range(2))
        y = y + bonus.reshape(y.shape)
        return (y * g.astype(jnp.float32)).astype(g.dtype)

    r_c, kh_c, v_c, dirs_c, g_c = prep(pc)
    zeros = jnp.zeros((p.shape[0], RWKV_HEADS, HEAD_DIM, HEAD_DIM), jnp.float32)
    outs_c, states_c = run(r_c, kh_c, v_c, dirs_c, (zeros, zeros), emit_ctx)
    r, kh, v, dirs, g = prep(p)
    outs, _ = run(r, kh, v, dirs, states_c, True)
    y = finish(outs, r, v, dirs, g)
    y_ctx = finish(outs_c, r_c, v_c, dirs_c, g_c) if emit_ctx else None
    return y, y_ctx


def mla_mixer(p, pc, q_norm_g, w_uq, kv_norm_g, w_ukv, rope_t, emit_ctx):
    H = MLA_HEADS
    scale = MLA_QK ** -0.5

    def project_q(t, rotate):
        qd = t[..., :MLA_Q_LORA]
        b, n = t.shape[:2]
        q = (rmsnorm(qd, q_norm_g) @ w_uq).reshape(b, n, H, MLA_QK)
        q_nope, q_pe = q[..., :MLA_NOPE], q[..., MLA_NOPE:]
        if rotate:
            q_pe = rope(q_pe, rope_t)
        return jnp.concatenate([q_nope, q_pe], axis=-1) * scale

    def project_kv(t, rotate):
        _, kvd, kpe = split_sizes(t, (MLA_Q_LORA, MLA_KV_LORA, MLA_ROPE))
        b, n = t.shape[:2]
        kv = (rmsnorm(kvd, kv_norm_g) @ w_ukv).reshape(b, n, H, MLA_NOPE + MLA_V)
        k_nope, v = kv[..., :MLA_NOPE], kv[..., MLA_NOPE:]
        kpe = kpe[:, :, None, :]
        if rotate:
            kpe = rope(kpe, rope_t)
        k = jnp.concatenate([k_nope, jnp.broadcast_to(kpe, (b, n, H, MLA_ROPE))], axis=-1)
        return k, v

    B, L, _ = p.shape
    q = project_q(p, True)
    k, v = project_kv(p, True)
    kc, vc = project_kv(pc, False)
    k_all = jnp.concatenate([kc, k], axis=1)
    v_all = jnp.concatenate([vc, v], axis=1)
    qb = q.reshape(B, L // MLA_BLOCK, MLA_BLOCK, H, MLA_QK).swapaxes(0, 1)

    def attend(qblk):
        s = jnp.einsum('bqhd,bkhd->bhqk', qblk, k_all).astype(jnp.float32)
        pr = jax.nn.softmax(s, axis=-1).astype(v_all.dtype)
        return jnp.einsum('bhqk,bkhd->bqhd', pr, v_all)

    y = lax.map(attend, qb).swapaxes(0, 1).reshape(B, L, H * MLA_V)
    y_ctx = None
    if emit_ctx:
        qc = project_q(pc, False)
        sc = jnp.einsum('bqhd,bkhd->bhqk', qc, kc).astype(jnp.float32)
        prc = jax.nn.softmax(sc, axis=-1).astype(vc.dtype)
        y_ctx = jnp.einsum('bhqk,bkhd->bqhd', prc, vc).reshape(B, pc.shape[1], H * MLA_V)
    return y, y_ctx


def sq_relu_mlp(h, w1, w2):
    return jnp.square(jax.nn.relu(h @ w1)) @ w2


def layer(x, xc, c, c_ctx, lp, rope_a, rope_d, emit_ctx):
    mod = jax.nn.silu(c) @ lp['ada_w'] + lp['ada_b']
    sh_m, sc_m, gt_m, sh_f, sc_f, gt_f = jnp.split(mod[:, None, :], 6, axis=-1)
    mod_c = jax.nn.silu(c_ctx) @ lp['ada_w'] + lp['ada_b']
    csh_m, csc_m, cgt_m, csh_f, csc_f, cgt_f = jnp.split(mod_c, 6, axis=-1)

    h = modulate(rmsnorm(x, lp['pre_mix_g']), sh_m, sc_m)
    hc = modulate(rmsnorm(xc, lp['pre_mix_g']), csh_m, csc_m)
    p_a, p_b, p_c, p_d = split_sizes(h @ lp['w_in'], GROUP_COLS)
    pc_a, pc_b, pc_c, pc_d = split_sizes(hc @ lp['w_in'], GROUP_COLS)

    y_a, yc_a = swa_mixer(p_a, pc_a, lp['swa_sink'], rope_a, emit_ctx)
    y_b, yc_b = retention_mixer(p_b, pc_b, lp['ret_gn_g'], emit_ctx)
    y_c, yc_c = rwkv_mixer(p_c, pc_c, lp['rwkv_mu'], lp['rwkv_w0'], lp['rwkv_w_up'], lp['rwkv_a0'], lp['rwkv_a_up'],
                           lp['rwkv_g_up'], lp['rwkv_kk'], lp['rwkv_ka'], lp['rwkv_rk'], lp['rwkv_gn_g'], emit_ctx)
    y_d, yc_d = mla_mixer(p_d, pc_d, lp['mla_q_norm_g'], lp['mla_w_uq'], lp['mla_kv_norm_g'], lp['mla_w_ukv'], rope_d, emit_ctx)

    y = jnp.concatenate([y_a, y_b, y_c, y_d], axis=-1) @ lp['w_out']
    x = x + gt_m * rmsnorm(y, lp['post_mix_g'])
    f = sq_relu_mlp(modulate(rmsnorm(x, lp['pre_mlp_g']), sh_f, sc_f), lp['mlp_w1'], lp['mlp_w2'])
    x = x + gt_f * rmsnorm(f, lp['post_mlp_g'])

    if emit_ctx:
        yc = jnp.concatenate([yc_a, yc_b, yc_c, yc_d], axis=-1) @ lp['w_out']
        xc = xc + cgt_m * rmsnorm(yc, lp['post_mix_g'])
        fc = sq_relu_mlp(modulate(rmsnorm(xc, lp['pre_mlp_g']), csh_f, csc_f), lp['mlp_w1'], lp['mlp_w2'])
        xc = xc + cgt_f * rmsnorm(fc, lp['post_mlp_g'])
    return x, xc


def setup_inputs(seed: int = 0) -> dict:
    key = jax.random.key(seed)
    ks = iter(jax.random.split(key, 40))
    nrm = lambda shape, s: jax.random.normal(next(ks), shape, jnp.float32) * s
    gain = lambda shape: 1.0 + nrm(shape, 0.05)
    return {
        'x': nrm((BATCH, SEQ, D_MODEL), 1.0),
        'c': nrm((BATCH, D_MODEL), 1.0),
        'ctx': nrm((BATCH, CTX_LEN, D_MODEL), 1.0),
        'c_ctx': nrm((D_MODEL,), 1.0),
        'ada_w': nrm((DEPTH, D_MODEL, 6 * D_MODEL), 0.5 * D_MODEL ** -0.5),
        'ada_b': nrm((DEPTH, 6 * D_MODEL), 0.01),
        'pre_mix_g': gain((DEPTH, D_MODEL)),
        'post_mix_g': gain((DEPTH, D_MODEL)),
        'pre_mlp_g': gain((DEPTH, D_MODEL)),
        'post_mlp_g': gain((DEPTH, D_MODEL)),
        'w_in': nrm((DEPTH, D_MODEL, N_IN), D_MODEL ** -0.5),
        'w_out': nrm((DEPTH, D_MIX, D_MODEL), D_MIX ** -0.5),
        'swa_sink': nrm((DEPTH, SWA_HEADS), 0.5),
        'ret_gn_g': gain((DEPTH, RET_W)),
        'rwkv_mu': jax.random.uniform(next(ks), (DEPTH, RWKV_COLS), jnp.float32),
        'rwkv_w0': nrm((DEPTH, 2, RWKV_W), 0.5),
        'rwkv_w_up': nrm((DEPTH, 2, RWKV_DECAY_LORA, RWKV_W), 0.1),
        'rwkv_a0': nrm((DEPTH, 2, RWKV_W), 0.5),
        'rwkv_a_up': nrm((DEPTH, 2, RWKV_A_LORA, RWKV_W), 0.1),
        'rwkv_g_up': nrm((DEPTH, RWKV_GATE_LORA, RWKV_W), RWKV_GATE_LORA ** -0.5),
        'rwkv_kk': gain((DEPTH, RWKV_W)),
        'rwkv_ka': gain((DEPTH, RWKV_W)),
        'rwkv_rk': nrm((DEPTH, RWKV_HEADS, HEAD_DIM), 0.1),
        'rwkv_gn_g': gain((DEPTH, RWKV_W)),
        'mla_q_norm_g': gain((DEPTH, MLA_Q_LORA)),
        'mla_w_uq': nrm((DEPTH, MLA_Q_LORA, MLA_HEADS * MLA_QK), MLA_Q_LORA ** -0.5),
        'mla_kv_norm_g': gain((DEPTH, MLA_KV_LORA)),
        'mla_w_ukv': nrm((DEPTH, MLA_KV_LORA, MLA_HEADS * (MLA_NOPE + MLA_V)), MLA_KV_LORA ** -0.5),
        'mlp_w1': nrm((DEPTH, D_MODEL, D_FF), D_MODEL ** -0.5),
        'mlp_w2': nrm((DEPTH, D_FF, D_MODEL), D_FF ** -0.5),
    }


def reference(x, c, ctx, c_ctx, ada_w, ada_b, pre_mix_g, post_mix_g, pre_mlp_g, post_mlp_g, w_in, w_out,
              swa_sink, ret_gn_g, rwkv_mu, rwkv_w0, rwkv_w_up, rwkv_a0, rwkv_a_up, rwkv_g_up, rwkv_kk, rwkv_ka,
              rwkv_rk, rwkv_gn_g, mla_q_norm_g, mla_w_uq, mla_kv_norm_g, mla_w_ukv, mlp_w1, mlp_w2):
    L = x.shape[1]
    rope_a = axial_rope_tables(L, HEAD_DIM)
    rope_d = axial_rope_tables(L, MLA_ROPE)
    xc = ctx
    for l in range(DEPTH):
        lp = dict(ada_w=ada_w[l], ada_b=ada_b[l], pre_mix_g=pre_mix_g[l], post_mix_g=post_mix_g[l],
                  pre_mlp_g=pre_mlp_g[l], post_mlp_g=post_mlp_g[l], w_in=w_in[l], w_out=w_out[l],
                  swa_sink=swa_sink[l], ret_gn_g=ret_gn_g[l], rwkv_mu=rwkv_mu[l], rwkv_w0=rwkv_w0[l],
                  rwkv_w_up=rwkv_w_up[l], rwkv_a0=rwkv_a0[l], rwkv_a_up=rwkv_a_up[l], rwkv_g_up=rwkv_g_up[l],
                  rwkv_kk=rwkv_kk[l], rwkv_ka=rwkv_ka[l], rwkv_rk=rwkv_rk[l], rwkv_gn_g=rwkv_gn_g[l],
                  mla_q_norm_g=mla_q_norm_g[l], mla_w_uq=mla_w_uq[l], mla_kv_norm_g=mla_kv_norm_g[l],
                  mla_w_ukv=mla_w_ukv[l], mlp_w1=mlp_w1[l], mlp_w2=mlp_w2[l])
        x, xc = layer(x, xc, c, c_ctx, lp, rope_a, rope_d, l < DEPTH - 1)
    return x
```

```cpp
#include <hip/hip_runtime.h>
#include <hip/hip_cooperative_groups.h>
#include <cstdio>
#include <cstdint>
#include <cmath>
namespace cg = cooperative_groups;
__device__ __forceinline__ int get_tid() { int t = threadIdx.x; asm volatile("" : "+v"(t)); return t; }
namespace pg8 {
#define PG8_LAS __attribute__((address_space(3)))
typedef unsigned short bf16_t;
typedef short bf16x8 __attribute__((ext_vector_type(8)));
typedef float f32x4 __attribute__((ext_vector_type(4)));
typedef unsigned u32x4 __attribute__((ext_vector_type(4)));
typedef unsigned u32x2 __attribute__((ext_vector_type(2)));
constexpr int BM = 256, BK = 64, HALF = 128, HTB = HALF * BK * 2, STAGE_BYTES = 8 * HTB, NXCD = 8, WGM = 8;

__host__ __device__ __forceinline__ int lds_byte(int r, int c) { const int st = (r >> 4) * 2 + (c >> 5), rr = r & 15, cc = c & 31, ob = rr * 64 + cc * 2; return st * 1024 + (ob ^ (((ob >> 9) & 1) << 5)); }
__host__ __device__ __forceinline__ void stage_rc(int b, int& R, int& C) { const int st = b / 1024, sb = b % 1024, swz = sb ^ (((sb >> 9) & 1) << 5); R = (st >> 1) * 16 + swz / 64; C = (st & 1) * 32 + (swz % 64) / 2; }

struct Unit { int pm, pn; };
struct Gemm { const bf16_t* A; const bf16_t* Bt; int M, N, K, lda; };

struct StaticOrder {
    int nM, nN, nwg, G, c;
    __host__ __device__ void init(int M, int N, int G_, int c_) { nM = M / BM; nN = N / BM; nwg = nM * nN; G = G_; c = c_; }
    __host__ __device__ bool next(int i, Unit& u) const {
        const long L = (long)i * G + c; if (L >= nwg) return false;
        int wgid = (int)L; { const int q = nwg / NXCD, r = nwg % NXCD, xcd = wgid % NXCD, off = wgid / NXCD; wgid = (xcd < r ? xcd * (q + 1) : r * (q + 1) + (xcd - r) * q) + off; }
        const int nig = WGM * nN, gid = wgid / nig, fm = gid * WGM, gsz = (nM - fm) < WGM ? (nM - fm) : WGM;
        u.pm = fm + ((wgid % nig) % gsz); u.pn = (wgid % nig) / gsz; return true;
    }
};

template <class Epi>
__device__ __forceinline__ void gemm_phase(PG8_LAS unsigned char* lds, const Gemm g, const StaticOrder& S, const Epi& E) {
    const int tid = get_tid(), wid = __builtin_amdgcn_readfirstlane(tid >> 6), lane = tid & 63, wr = wid >> 2, wc = wid & 3, fr = lane & 15, fq = lane >> 4;
    const int K = g.K, nt = K / BK, lda = g.lda;
    unsigned voffA[2], voffB[2];
#pragma unroll
    for (int i = 0; i < 2; ++i) { int R, C; stage_rc(tid * 16 + i * 8192, R, C);
        voffA[i] = (unsigned)(R * lda + C) * 2u; voffB[i] = (unsigned)(R * K + C) * 2u; }
    const size_t kstep = (size_t)(BK * 2);
    const size_t hstepA = (size_t)HALF * lda * 2, hstepB = (size_t)HALF * K * 2;
    const size_t tstepA = 2 * hstepA, tstepB = 2 * hstepB;
    const unsigned ldsw = (unsigned)wid * 1024u;
    const int aoff = lds_byte(wr * 64 + fr, fq * 8), boff = lds_byte(wc * 32 + fr, fq * 8);
#define PG8_SA(b, h) (((b) * 2 + (h)) * HTB)
#define PG8_SB(b, h) ((4 + (b) * 2 + (h)) * HTB)
#define PG8_STAGE(bufoff, gbase, voff) do { _Pragma("unroll") for (int _i = 0; _i < 2; ++_i) \
        __builtin_amdgcn_global_load_lds((const unsigned*)((const char*)(gbase) + (voff)[_i]), (PG8_LAS unsigned*)(lds + (bufoff) + ldsw + _i * 8192), 16, 0, 0); } while (0)
#define PG8_LDA(dst, b, h) do { _Pragma("unroll") for (int m = 0; m < 4; ++m) _Pragma("unroll") for (int k = 0; k < 2; ++k) dst[m][k] = *(const PG8_LAS bf16x8*)(lds + PG8_SA(b, h) + aoff + m * 2048 + k * 1024); } while (0)
#define PG8_LDB(dst, b, h) do { _Pragma("unroll") for (int n = 0; n < 2; ++n) _Pragma("unroll") for (int k = 0; k < 2; ++k) dst[n][k] = *(const PG8_LAS bf16x8*)(lds + PG8_SB(b, h) + boff + n * 2048 + k * 1024); } while (0)
#define PG8_MMA(ai, bj, At, Bt) do { __builtin_amdgcn_s_setprio(1); _Pragma("unroll") for (int m = 0; m < 4; ++m) _Pragma("unroll") for (int n = 0; n < 2; ++n) _Pragma("unroll") for (int k = 0; k < 2; ++k) \
        acc[ai][bj][m][n] = __builtin_amdgcn_mfma_f32_16x16x32_bf16(Bt[n][k], At[m][k], acc[ai][bj][m][n], 0, 0, 0); __builtin_amdgcn_s_setprio(0); } while (0)
#define PG8_WAIT_V(n) asm volatile("s_waitcnt vmcnt(" #n ")" ::: "memory")
#define PG8_WAIT_L(n) asm volatile("s_waitcnt lgkmcnt(" #n ")" ::: "memory")
#define PG8_BAR __builtin_amdgcn_s_barrier()
#define PG8_SCHED __builtin_amdgcn_sched_barrier(0)
    Unit cur, nxt; int ui = 0;
    if (!S.next(0, cur)) return;
    f32x4 acc[2][2][4][2];
#pragma unroll
    for (int a = 0; a < 2; ++a)
#pragma unroll
        for (int b = 0; b < 2; ++b)
#pragma unroll
            for (int m = 0; m < 4; ++m)
#pragma unroll
                for (int n = 0; n < 2; ++n) acc[a][b][m][n] = (f32x4){0.f, 0.f, 0.f, 0.f};
    bf16x8 At[4][2], B0[2][2], B1[2][2];
    const char* cA = (const char*)g.A + (size_t)cur.pm * tstepA; const char* cB = (const char*)g.Bt + (size_t)cur.pn * tstepB;
    PG8_STAGE(PG8_SB(0, 0), cB, voffB); PG8_STAGE(PG8_SA(0, 0), cA, voffA); PG8_STAGE(PG8_SB(0, 1), cB + hstepB, voffB); PG8_STAGE(PG8_SA(0, 1), cA + hstepA, voffA);
    if (wr == 1) PG8_BAR;
    PG8_WAIT_V(4); PG8_BAR;
    PG8_STAGE(PG8_SB(1, 0), cB + kstep, voffB); PG8_STAGE(PG8_SA(1, 0), cA + kstep, voffA); PG8_STAGE(PG8_SB(1, 1), cB + hstepB + kstep, voffB);
    PG8_WAIT_V(6); PG8_BAR;
    for (;;) {
        const bool has_next = S.next(ui + 1, nxt);
        const char* nA = has_next ? (const char*)g.A + (size_t)nxt.pm * tstepA : cA; const char* nB = has_next ? (const char*)g.Bt + (size_t)nxt.pn * tstepB : cB;
        for (int t = 0; t < nt; t += 2) {
            const bool last = (t == nt - 2);
            const char* a1 = cA + (size_t)(t + 1) * kstep;
            const char* a2 = last ? nA : cA + (size_t)(t + 2) * kstep; const char* b2 = last ? nB : cB + (size_t)(t + 2) * kstep;
            const char* a3 = a2 + kstep; const char* b3 = b2 + kstep;
            PG8_LDB(B0, 0, 0); PG8_SCHED; PG8_LDA(At, 0, 0); PG8_STAGE(PG8_SA(1, 1), a1 + hstepA, voffA);
            PG8_WAIT_L(8); PG8_BAR; PG8_WAIT_L(0); PG8_MMA(0, 0, At, B0); PG8_BAR; PG8_SCHED;
            PG8_LDB(B1, 0, 1); PG8_STAGE(PG8_SB(0, 0), b2, voffB);
            PG8_BAR; PG8_WAIT_L(0); PG8_MMA(0, 1, At, B1); PG8_BAR;
            PG8_LDA(At, 0, 1); PG8_STAGE(PG8_SA(0, 0), a2, voffA);
            PG8_BAR; PG8_WAIT_L(0); PG8_MMA(1, 0, At, B0); PG8_BAR; PG8_SCHED;
            PG8_STAGE(PG8_SB(0, 1), b2 + hstepB, voffB);
            PG8_WAIT_V(6); PG8_BAR; PG8_MMA(1, 1, At, B1); PG8_BAR;
            PG8_LDB(B0, 1, 0); PG8_SCHED; PG8_LDA(At, 1, 0); PG8_STAGE(PG8_SA(0, 1), a2 + hstepA, voffA);
            PG8_WAIT_L(8); PG8_BAR; PG8_WAIT_L(0); PG8_MMA(0, 0, At, B0); PG8_BAR; PG8_SCHED;
            PG8_LDB(B1, 1, 1); PG8_STAGE(PG8_SB(1, 0), b3, voffB);
            PG8_BAR; PG8_WAIT_L(0); PG8_MMA(0, 1, At, B1); PG8_BAR;
            PG8_LDA(At, 1, 1); PG8_STAGE(PG8_SA(1, 0), a3, voffA);
            PG8_BAR; PG8_WAIT_L(0); PG8_MMA(1, 0, At, B0); PG8_BAR; PG8_SCHED;
            PG8_STAGE(PG8_SB(1, 1), b3 + hstepB, voffB);
            PG8_WAIT_V(6); PG8_BAR; PG8_MMA(1, 1, At, B1); PG8_BAR;
        }
        E(acc, cur, wr, wc, fr, fq);
        if (!has_next) break;
#pragma unroll
        for (int a = 0; a < 2; ++a)
#pragma unroll
            for (int b = 0; b < 2; ++b)
#pragma unroll
                for (int m = 0; m < 4; ++m)
#pragma unroll
                    for (int n = 0; n < 2; ++n) acc[a][b][m][n] = (f32x4){0.f, 0.f, 0.f, 0.f};
        cur = nxt; cA = nA; cB = nB; ++ui;
    }
    PG8_WAIT_V(0);
    if (wr == 0) PG8_BAR;
    PG8_BAR;
#undef PG8_SA
#undef PG8_SB
#undef PG8_STAGE
#undef PG8_LDA
#undef PG8_LDB
#undef PG8_MMA
#undef PG8_WAIT_V
#undef PG8_WAIT_L
#undef PG8_BAR
#undef PG8_SCHED
}

__device__ __forceinline__ unsigned f2bf_u(float f) { unsigned u = __builtin_bit_cast(unsigned, f); return (u + 0x7fffu + ((u >> 16) & 1u)) >> 16; }
template <int ACT> struct EpiBf16 {
    bf16_t* O; int ldc;
    __device__ __forceinline__ void operator()(const f32x4 (&acc)[2][2][4][2], const Unit& u, int wr, int wc, int fr, int fq) const {
        const int row0 = u.pm * BM + wr * 64 + fr, col0 = u.pn * BM + wc * 32 + 4 * fq;
#pragma unroll
        for (int ai = 0; ai < 2; ++ai)
#pragma unroll
            for (int m = 0; m < 4; ++m) { bf16_t* rowp = O + (size_t)(row0 + ai * HALF + m * 16) * ldc + col0;
#pragma unroll
                for (int bj = 0; bj < 2; ++bj)
#pragma unroll
                    for (int n = 0; n < 2; ++n) { f32x4 v = acc[ai][bj][m][n];
                        if (ACT == 1) { v.x = v.x > 0.f ? v.x * v.x : 0.f; v.y = v.y > 0.f ? v.y * v.y : 0.f; v.z = v.z > 0.f ? v.z * v.z : 0.f; v.w = v.w > 0.f ? v.w * v.w : 0.f; }
                        u32x2 o; o.x = f2bf_u(v.x) | (f2bf_u(v.y) << 16); o.y = f2bf_u(v.z) | (f2bf_u(v.w) << 16);
                        *(u32x2*)(rowp + bj * HALF + n * 16) = o; } }
    }
};
}
typedef unsigned short bf16_t;
typedef short bf16x8 __attribute__((ext_vector_type(8)));
typedef float f32x4 __attribute__((ext_vector_type(4)));
typedef unsigned u32x4 __attribute__((ext_vector_type(4)));
typedef unsigned u32x2 __attribute__((ext_vector_type(2)));
#define LAS __attribute__((address_space(3)))

constexpr int NBATCH = 8, SEQL = 4096, DM = 1024, CTXL = 256, TMAIN = 32768, TCTX = 2048, TT = 34816, NP = 3072, FF = 4096;
constexpr int PC_SWAQ = 0, PC_RETQ = 256, PC_RWR = 512, PC_MLAQD = 768, PC_SWAK = 1024, PC_SWAV = 1152, PC_RETK = 1280, PC_RETV = 1536, PC_RETG = 1792,
              PC_RWK = 2048, PC_RWV = 2304, PC_RWWD = 2560, PC_RWAD = 2624, PC_RWGD = 2688, PC_MLAKVD = 2816, PC_MLAKPE = 2944;
constexpr int PC_RWO0 = PC_RWV, PC_RWO1 = PC_RWR;
constexpr int NKEYS = CTXL + SEQL;

constexpr size_t MiB = 1u << 20;
constexpr size_t WS_MOD = 0;
constexpr size_t WS_TAB = 512 * 1024;
constexpr size_t WS_BON = 1 * MiB;
constexpr size_t WS_WB = 2 * MiB;
constexpr size_t WB_LAYER = 24 * MiB, WB_IN = 0, WB_OUT = 6 * MiB, WB_W1 = 8 * MiB, WB_W2 = 16 * MiB;
constexpr size_t WS_XC = 50 * MiB;
constexpr size_t WS_P = 58 * MiB;
constexpr size_t WS_HID = 58 * MiB;
constexpr size_t WS_A = 262 * MiB;
constexpr size_t ARR17 = 17 * MiB;
constexpr size_t WS_RWK = WS_A, WS_RWV = WS_A + ARR17, WS_RWRR = WS_A + 2 * ARR17, WS_RWA0 = WS_A + 3 * ARR17, WS_RWA1 = WS_A + 4 * ARR17,
                 WS_RWM0 = WS_A + 5 * ARR17, WS_RWM1 = WS_A + 6 * ARR17;
constexpr size_t WS_RET = WS_A + 119 * MiB;
constexpr size_t WS_MQ = WS_RET + 34 * MiB;
constexpr size_t WS_KM = WS_MQ + 26738688;
constexpr size_t WS_VTM = WS_KM + 26738688;
constexpr size_t WS_KS = WS_VTM + ARR17;
constexpr size_t WS_VTS = WS_KS + 8912896;
constexpr size_t WS_A_END = WS_VTS + 8912896;
constexpr size_t WS_Z = 330 * MiB;
constexpr size_t WS_HB = 398 * MiB;
constexpr size_t WS_NEED = 500 * MiB;
static_assert(WS_A_END <= WS_NEED && WS_HB + 68 * MiB <= WS_NEED && WS_HID + 272 * MiB <= WS_Z, "ws map");

constexpr int LDS_BYTES = 150 * 1024;

struct Params { const float* in[30]; float* out; unsigned char* ws; };

__device__ __forceinline__ float bf2f(bf16_t v) { return __builtin_bit_cast(float, (unsigned)v << 16); }
__device__ __forceinline__ bf16_t f2bf(float f) { unsigned u = __builtin_bit_cast(unsigned, f); return (bf16_t)((u + 0x7fffu + ((u >> 16) & 1u)) >> 16); }
__device__ __forceinline__ unsigned pk2(float lo, float hi) { return (unsigned)f2bf(lo) | ((unsigned)f2bf(hi) << 16); }
__device__ __forceinline__ float wave_sum(float v) {
#pragma unroll
    for (int o = 1; o < 64; o <<= 1) v += __shfl_xor(v, o);
    return v;
}
__device__ __forceinline__ float sigmoidf_(float x) { return 1.f / (1.f + __expf(-x)); }

struct SeqInfo { int b, pos, len, start, isctx; };
__device__ __forceinline__ SeqInfo seq_of_row(int row) {
    SeqInfo s;
    if (row < TMAIN) { s.b = row >> 12; s.pos = row & 4095; s.len = SEQL; s.start = s.b << 12; s.isctx = 0; }
    else { const int r = row - TMAIN; s.b = r >> 8; s.pos = r & 255; s.len = CTXL; s.start = TMAIN + (s.b << 8); s.isctx = 1; }
    return s;
}

__device__ __forceinline__ void transpose_item(const float* W, int N, int nsrc0, bf16_t* WT, int K, int ndst0, int k0, LAS float* scr, int lane) {
    if (nsrc0 >= 0) {
#pragma unroll 8
        for (int i = 0; i < 32; ++i) { const int kk = 2 * i + (lane >> 5); scr[kk * 33 + (lane & 31)] = W[(size_t)(k0 + kk) * N + nsrc0 + (lane & 31)]; }
    } else {
#pragma unroll 8
        for (int i = 0; i < 32; ++i) { const int kk = 2 * i + (lane >> 5); scr[kk * 33 + (lane & 31)] = 0.f; }
    }
    __builtin_amdgcn_wave_barrier(); asm volatile("s_waitcnt lgkmcnt(0)" ::: "memory");
    const int c = lane & 7;
#pragma unroll
    for (int j = 0; j < 4; ++j) { const int n = (lane >> 3) + 8 * j; const LAS float* s = scr + (8 * c) * 33 + n;
        u32x4 o; o.x = pk2(s[0 * 33], s[1 * 33]); o.y = pk2(s[2 * 33], s[3 * 33]); o.z = pk2(s[4 * 33], s[5 * 33]); o.w = pk2(s[6 * 33], s[7 * 33]);
        *(u32x4*)(WT + (size_t)(ndst0 + n) * K + k0 + 8 * c) = o; }
    __builtin_amdgcn_wave_barrier(); asm volatile("s_waitcnt lgkmcnt(0)" ::: "memory");
}
__device__ __forceinline__ int win_src_col(int n) {
    if (n < 256) return n;
    if (n < 512) return 512 + (n - 256);
    if (n < 768) return 1536 + (n - 512);
    if (n < 1024) return 2560 + (n - 768);
    if (n < 1280) return 256 + (n - 1024);
    if (n < 2048) return 768 + (n - 1280);
    if (n < 2816) return 1792 + (n - 2048);
    if (n < 2976) return n;
    return -1;
}
__device__ __forceinline__ void phase_prologue(const Params& p, LAS unsigned char* lds, int bid, int nb) {
    const int tid = get_tid(), lane = tid & 63, wave = tid >> 6;
    LAS float* scr = (LAS float*)(lds + wave * 16384);
    const int gw = bid * 8 + wave, NGW = nb * 8;
    constexpr int I_IN = 16 * 96, I_OUT = 16 * 32, I_1 = 16 * 128, I_2 = 64 * 32, I_L = I_IN + I_OUT + I_1 + I_2;
    for (int it = gw; it < 2 * I_L; it += NGW) {
        const int l = it / I_L; int r = it % I_L;
        unsigned char* wb = p.ws + WS_WB + (size_t)l * WB_LAYER;
        if (r < I_IN) { const int kb = r / 96, nbk = r % 96; transpose_item(p.in[10] + (size_t)l * DM * 2976, 2976, win_src_col(nbk * 32), (bf16_t*)(wb + WB_IN), DM, nbk * 32, kb * 64, scr, lane); continue; } r -= I_IN;
        if (r < I_OUT) { const int kb = r / 32, nbk = r % 32; transpose_item(p.in[11] + (size_t)l * DM * DM, DM, nbk * 32, (bf16_t*)(wb + WB_OUT), DM, nbk * 32, kb * 64, scr, lane); continue; } r -= I_OUT;
        if (r < I_1) { const int kb = r / 128, nbk = r % 128; transpose_item(p.in[28] + (size_t)l * DM * FF, FF, nbk * 32, (bf16_t*)(wb + WB_W1), DM, nbk * 32, kb * 64, scr, lane); continue; } r -= I_1;
        { const int kb = r / 32, nbk = r % 32; transpose_item(p.in[29] + (size_t)l * FF * DM, DM, nbk * 32, (bf16_t*)(wb + WB_W2), FF, nbk * 32, kb * 64, scr, lane); }
    }
    __syncthreads();
    for (int it = bid; it < 192; it += nb) {
        const int l = it / 96, cb = it % 96;
        LAS float* sc = (LAS float*)lds;
        LAS float* red = sc + 9 * 1024;
        for (int e = tid; e < 9 * 1024; e += 512) { const int r = e >> 10, k = e & 1023; const float v = (r < 8) ? p.in[1][r * 1024 + k] : p.in[3][k]; sc[e] = v / (1.f + __expf(-v)); }
        __syncthreads();
        const int ks = tid >> 6, cl = tid & 63, n = cb * 64 + cl;
        float acc[9];
#pragma unroll
        for (int r = 0; r < 9; ++r) acc[r] = 0.f;
        const float* aw = p.in[4] + (size_t)l * DM * 6144;
        for (int k = ks * 128; k < ks * 128 + 128; ++k) { const float w = aw[(size_t)k * 6144 + n];
#pragma unroll
            for (int r = 0; r < 9; ++r) acc[r] += sc[r * 1024 + k] * w; }
#pragma unroll
        for (int r = 0; r < 9; ++r) red[(ks * 9 + r) * 64 + cl] = acc[r];
        __syncthreads();
        for (int e = tid; e < 9 * 64; e += 512) { const int r = e >> 6, c2 = e & 63; float s = 0.f;
            for (int q = 0; q < 8; ++q) s += red[(q * 9 + r) * 64 + c2];
            ((float*)(p.ws + WS_MOD))[((size_t)l * 9 + r) * 6144 + cb * 64 + c2] = s + p.in[5][(size_t)l * 6144 + cb * 64 + c2]; }
        __syncthreads();
    }
    if (bid == nb - 1) {
        float* tab = (float*)(p.ws + WS_TAB);
        for (int e = tid; e < 64 * 16; e += 512) { const int pos = e >> 4, f = e & 15; const float inv = powf(10000.f, -(float)(2 * f) / 32.f); const float a = (float)pos * inv; tab[e] = cosf(a); tab[1024 + e] = sinf(a); }
        for (int e = tid; e < 64 * 8; e += 512) { const int pos = e >> 3, f = e & 7; const float inv = powf(10000.f, -(float)(2 * f) / 16.f); const float a = (float)pos * inv; tab[2048 + e] = cosf(a); tab[2560 + e] = sinf(a); }
    }
}

__device__ __forceinline__ void rowop(const float* xsrc, const bf16_t* z, const float* gpost, const float* gate, float* xdst,
                                      const float* gpre, const float* shift, const float* scale, bf16_t* hdst, int lane) {
    f32x4 v[4];
#pragma unroll
    for (int j = 0; j < 4; ++j) v[j] = *(const f32x4*)(xsrc + (j * 64 + lane) * 4);
    if (z) {
        f32x4 zz[4]; float ss = 0.f;
#pragma unroll
        for (int j = 0; j < 4; ++j) { const u32x2 u = *(const u32x2*)(z + (j * 64 + lane) * 4);
            zz[j].x = bf2f((bf16_t)(u.x & 0xffff)); zz[j].y = bf2f((bf16_t)(u.x >> 16)); zz[j].z = bf2f((bf16_t)(u.y & 0xffff)); zz[j].w = bf2f((bf16_t)(u.y >> 16));
            ss += zz[j].x * zz[j].x + zz[j].y * zz[j].y + zz[j].z * zz[j].z + zz[j].w * zz[j].w; }
        const float rinv = 1.f / sqrtf(wave_sum(ss) * (1.f / 1024.f) + 1e-6f);
#pragma unroll
        for (int j = 0; j < 4; ++j) { const int c = (j * 64 + lane) * 4; const f32x4 gp = *(const f32x4*)(gpost + c), gt = *(const f32x4*)(gate + c);
            v[j].x += gt.x * (zz[j].x * rinv * gp.x); v[j].y += gt.y * (zz[j].y * rinv * gp.y); v[j].z += gt.z * (zz[j].z * rinv * gp.z); v[j].w += gt.w * (zz[j].w * rinv * gp.w);
            *(f32x4*)(xdst + c) = v[j]; }
    }
    if (hdst) {
        float ss = 0.f;
#pragma unroll
        for (int j = 0; j < 4; ++j) ss += v[j].x * v[j].x + v[j].y * v[j].y + v[j].z * v[j].z + v[j].w * v[j].w;
        const float rinv = 1.f / sqrtf(wave_sum(ss) * (1.f / 1024.f) + 1e-6f);
#pragma unroll
        for (int j = 0; j < 4; ++j) { const int c = (j * 64 + lane) * 4; const f32x4 g = *(const f32x4*)(gpre + c), sh = *(const f32x4*)(shift + c), sc = *(const f32x4*)(scale + c);
            u32x2 o; o.x = pk2(v[j].x * rinv * g.x * (1.f + sc.x) + sh.x, v[j].y * rinv * g.y * (1.f + sc.y) + sh.y);
            o.y = pk2(v[j].z * rinv * g.z * (1.f + sc.z) + sh.z, v[j].w * rinv * g.w * (1.f + sc.w) + sh.w);
            *(u32x2*)(hdst + c) = o; }
    }
}
__device__ __forceinline__ void phase_rowops(const Params& p, int mode, int l, int nrows, int bid, int nb) {
    const int tid = get_tid(), lane = tid & 63, wave = tid >> 6;
    const float* mod = (const float*)(p.ws + WS_MOD);
    bf16_t* HB = (bf16_t*)(p.ws + WS_HB); const bf16_t* Z = (const bf16_t*)(p.ws + WS_Z);
    float* XC = (float*)(p.ws + WS_XC);
    for (int row = bid * 8 + wave; row < nrows; row += nb * 8) {
        const SeqInfo s = seq_of_row(row);
        const int mr = s.isctx ? 8 : s.b;
        const float* m_l = mod + ((size_t)l * 9 + mr) * 6144;
        float* xs = s.isctx ? XC + (size_t)(row - TMAIN) * DM : p.out + (size_t)row * DM;
        const float* xin = s.isctx ? p.in[2] + (size_t)(row - TMAIN) * DM : p.in[0] + (size_t)row * DM;
        if (mode == 0) {
            rowop(xin, nullptr, nullptr, nullptr, nullptr, p.in[6] + l * DM, m_l + 0, m_l + 1024, HB + (size_t)row * DM, lane);
        } else if (mode == 1) {
            rowop(l == 0 ? xin : xs, Z + (size_t)row * DM, p.in[7] + l * DM, m_l + 2048, xs, p.in[8] + l * DM, m_l + 3072, m_l + 4096, HB + (size_t)row * DM, lane);
        } else {
            const bool has_next = (l + 1 < 2);
            const float* m_n = mod + ((size_t)(l + 1) * 9 + mr) * 6144;
            rowop(xs, Z + (size_t)row * DM, p.in[9] + l * DM, m_l + 5120, xs, p.in[6] + (l + 1) * DM, m_n + 0, m_n + 1024, has_next ? HB + (size_t)row * DM : nullptr, lane);
        }
    }
}

__device__ __forceinline__ void rwkv_prep_item(const Params& p, int l, LAS unsigned char* lds, int tile) {
    const int tid = get_tid();
    const bf16_t* P = (const bf16_t*)(p.ws + WS_P);
    const int t0 = tile * 32; const SeqInfo s0 = seq_of_row(t0);
    const float* mu = p.in[14] + l * 1024;
    LAS float* r_s = (LAS float*)lds;
    LAS float* k_s = r_s + 32 * 256;
    LAS float* v_s = k_s + 32 * 256;
    LAS float* twd = v_s + 32 * 256;
    LAS float* ad_s = twd + 32 * 64;
    for (int e = tid; e < 32 * 896; e += 512) {
        const int tok = e / 896, cc = e % 896;
        const int pcol = cc < 256 ? PC_RWR + cc : PC_RWK + (cc - 256);
        const int row = t0 + tok, pos = s0.pos + tok;
        const float z0 = bf2f(P[(size_t)row * NP + pcol]);
        const float zm = pos > 0 ? bf2f(P[(size_t)(row - 1) * NP + pcol]) : 0.f;
        const float zp = pos < s0.len - 1 ? bf2f(P[(size_t)(row + 1) * NP + pcol]) : 0.f;
        const float zs = z0 + mu[cc] * (0.5f * (zm + zp) - z0);
        if (cc < 256) r_s[tok * 256 + cc] = zs;
        else if (cc < 512) k_s[tok * 256 + cc - 256] = zs;
        else if (cc < 768) v_s[tok * 256 + cc - 512] = zs;
        else if (cc < 832) twd[tok * 64 + cc - 768] = tanhf(zs);
        else ad_s[tok * 64 + cc - 832] = zs;
    }
    __syncthreads();
    const int hh = tid >> 8, c = tid & 255, h = c >> 6;
    float aw0[16], aw1[16], aa0[16], aa1[16];
#pragma unroll
    for (int i = 0; i < 16; ++i) { aw0[i] = 0.f; aw1[i] = 0.f; aa0[i] = 0.f; aa1[i] = 0.f; }
    const float* wup = p.in[16] + (size_t)l * 2 * 64 * 256; const float* aup = p.in[18] + (size_t)l * 2 * 64 * 256;
    for (int j = 0; j < 64; ++j) {
        const float w0 = wup[j * 256 + c], w1 = wup[64 * 256 + j * 256 + c], a0 = aup[j * 256 + c], a1 = aup[64 * 256 + j * 256 + c];
#pragma unroll
        for (int i = 0; i < 16; ++i) { const float tw = twd[(hh * 16 + i) * 64 + j], ta = ad_s[(hh * 16 + i) * 64 + j];
            aw0[i] += tw * w0; aw1[i] += tw * w1; aa0[i] += ta * a0; aa1[i] += ta * a1; }
    }
    const float w0b0 = p.in[15][(l * 2 + 0) * 256 + c], w0b1 = p.in[15][(l * 2 + 1) * 256 + c];
    const float a0b0 = p.in[17][(l * 2 + 0) * 256 + c], a0b1 = p.in[17][(l * 2 + 1) * 256 + c];
    const float ka = p.in[21][l * 256 + c], rk = p.in[22][l * 256 + c];
    bf16_t* RK = (bf16_t*)(p.ws + WS_RWK); bf16_t* RV = (bf16_t*)(p.ws + WS_RWV); bf16_t* RR = (bf16_t*)(p.ws + WS_RWRR);
    bf16_t* RA0 = (bf16_t*)(p.ws + WS_RWA0); bf16_t* RA1 = (bf16_t*)(p.ws + WS_RWA1); bf16_t* RM0 = (bf16_t*)(p.ws + WS_RWM0); bf16_t* RM1 = (bf16_t*)(p.ws + WS_RWM1);
    float* BON = (float*)(p.ws + WS_BON);
#pragma unroll
    for (int i = 0; i < 16; ++i) {
        const int tok = hh * 16 + i, row = t0 + tok;
        const float k = k_s[tok * 256 + c], v = v_s[tok * 256 + c], r = r_s[tok * 256 + c];
        const float sg0 = sigmoidf_(w0b0 + aw0[i]), sg1 = sigmoidf_(w0b1 + aw1[i]);
        const float om0 = -expm1f(-0.60653066f * sg0), om1 = -expm1f(-0.60653066f * sg1);
        const float a0 = sigmoidf_(a0b0 + aa0[i]), a1 = sigmoidf_(a0b1 + aa1[i]);
        const float kt0 = k * (1.f + (a0 - 1.f) * ka), kt1 = k * (1.f + (a1 - 1.f) * ka);
        const float bs = wave_sum(r * (kt0 + kt1) * rk);
        const size_t o = (size_t)row * 256 + c;
        RK[o] = f2bf(k); RV[o] = f2bf(v); RR[o] = f2bf(r); RA0[o] = f2bf(a0); RA1[o] = f2bf(a1); RM0[o] = f2bf(om0); RM1[o] = f2bf(om1);
        if ((tid & 63) == 0) BON[(size_t)row * 4 + h] = bs;
    }
    __syncthreads();
}
__device__ __forceinline__ int ret_chunk_index(int cr, int& b) { if (cr < 256) { b = cr >> 5; return 2 + (cr & 31); } b = (cr - 256) >> 1; return (cr - 256) & 1; }
__device__ __forceinline__ void ret_kv_item(const Params& p, LAS unsigned char* lds, int item) {
    const int tid = get_tid();
    const bf16_t* P = (const bf16_t*)(p.ws + WS_P);
    const int cr = item >> 2, h = item & 3; int b; const int ci = ret_chunk_index(cr, b);
    const int r0 = cr * 128;
    LAS float* Ks = (LAS float*)lds;
    LAS float* Vs = Ks + 128 * 64;
    LAS float* dec = Vs + 128 * 64;
    const float lg = log1pf(-exp2f(-5.f - (float)h));
    for (int e = tid; e < 128 * 64; e += 512) { const int j = e >> 6, d = e & 63;
        Ks[e] = bf2f(P[(size_t)(r0 + j) * NP + PC_RETK + h * 64 + d]) * 0.125f; Vs[e] = bf2f(P[(size_t)(r0 + j) * NP + PC_RETV + h * 64 + d]); }
    if (tid < 128) dec[tid] = expf((float)tid * lg);
    __syncthreads();
    const int d = tid >> 3, e0 = (tid & 7) * 8;
    float af[8], ab[8];
#pragma unroll
    for (int i = 0; i < 8; ++i) { af[i] = 0.f; ab[i] = 0.f; }
    for (int j = 0; j < 128; ++j) { const float kd = Ks[j * 64 + d]; const float kf = kd * dec[127 - j], kb = kd * dec[j];
        const f32x4 v0 = *(const LAS f32x4*)(Vs + j * 64 + e0), v1 = *(const LAS f32x4*)(Vs + j * 64 + e0 + 4);
        af[0] += kf * v0.x; af[1] += kf * v0.y; af[2] += kf * v0.z; af[3] += kf * v0.w; af[4] += kf * v1.x; af[5] += kf * v1.y; af[6] += kf * v1.z; af[7] += kf * v1.w;
        ab[0] += kb * v0.x; ab[1] += kb * v0.y; ab[2] += kb * v0.z; ab[3] += kb * v0.w; ab[4] += kb * v1.x; ab[5] += kb * v1.y; ab[6] += kb * v1.z; ab[7] += kb * v1.w; }
    float* RS = (float*)(p.ws + WS_RET) + ((size_t)((b * 4 + h) * 34 + ci) * 2) * 4096;
#pragma unroll
    for (int i = 0; i < 8; ++i) { RS[d * 64 + e0 + i] = af[i]; RS[4096 + d * 64 + e0 + i] = ab[i]; }
    __syncthreads();
}
__device__ __forceinline__ void swa_prep_item(const Params& p, int tile) {
    const int tid = get_tid();
    bf16_t* P = (bf16_t*)(p.ws + WS_P);
    const float* tabc = (const float*)(p.ws + WS_TAB); const float* tabs = tabc + 1024;
    bf16_t* KS = (bf16_t*)(p.ws + WS_KS); bf16_t* VT = (bf16_t*)(p.ws + WS_VTS);
    const int t0 = tile * 64; const SeqInfo s0 = seq_of_row(t0);
    const int key0 = s0.isctx ? s0.pos : CTXL + s0.pos;
    for (int e = tid; e < 64 * 192; e += 512) {
        const int tok = e / 192, rem = e % 192, hd = rem >> 5, pr = rem & 31, axis = pr >> 4, f = pr & 15;
        const int row = t0 + tok, pos = s0.pos + tok;
        const int colbase = (hd < 4 ? PC_SWAQ + hd * 64 : PC_SWAK + (hd - 4) * 64) + axis * 32 + f;
        float x1 = bf2f(P[(size_t)row * NP + colbase]), x2 = bf2f(P[(size_t)row * NP + colbase + 16]);
        if (!s0.isctx) { const int pp = axis == 0 ? (pos >> 6) : (pos & 63); const float cs = tabc[pp * 16 + f], sn = tabs[pp * 16 + f];
            const float y1 = x1 * cs - x2 * sn, y2 = x2 * cs + x1 * sn; x1 = y1; x2 = y2; }
        if (hd < 4) { if (!s0.isctx) { P[(size_t)row * NP + colbase] = f2bf(x1); P[(size_t)row * NP + colbase + 16] = f2bf(x2); } }
        else { bf16_t* kd = KS + ((size_t)(s0.b * 2 + (hd - 4)) * NKEYS + key0 + tok) * 64 + axis * 32 + f; kd[0] = f2bf(x1); kd[16] = f2bf(x2); }
    }
    for (int e = tid; e < 64 * 128; e += 512) { const int tok = e & 63, hd = e >> 6, hk = hd >> 6, d = hd & 63;
        VT[((size_t)(s0.b * 2 + hk) * 64 + d) * NKEYS + key0 + tok] = P[(size_t)(t0 + tok) * NP + PC_SWAV + hk * 64 + d]; }
}
__device__ __forceinline__ void phase_prepA(const Params& p, int l, LAS unsigned char* lds, int bid, int nb) {
    constexpr int N1 = TT / 32, N2 = 272 * 4, N3 = TT / 64;
    for (int it = bid; it < N1 + N2 + N3; it += nb) {
        if (it < N1) rwkv_prep_item(p, l, lds, it);
        else if (it < N1 + N2) ret_kv_item(p, lds, it - N1);
        else swa_prep_item(p, it - N1 - N2);
    }
}

__device__ __forceinline__ void mla_proj_item(const Params& p, int l, LAS unsigned char* lds, int tile) {
    const int tid = get_tid(), lane = tid & 63, wave = tid >> 6;
    const bf16_t* P = (const bf16_t*)(p.ws + WS_P);
    const float* tabc = (const float*)(p.ws + WS_TAB) + 2048; const float* tabs = tabc + 512;
    const int t0 = tile * 32; const SeqInfo s0 = seq_of_row(t0);
    const int key0 = s0.isctx ? s0.pos : CTXL + s0.pos;
    LAS float* qn = (LAS float*)lds;
    LAS float* kvn = qn + 32 * 256;
    LAS float* qo = kvn + 32 * 128;
    const float* qg = p.in[24] + l * 256; const float* kvg = p.in[26] + l * 128;
    for (int i = 0; i < 4; ++i) { const int tok = wave * 4 + i, row = t0 + tok;
        float x[4]; float ss = 0.f;
#pragma unroll
        for (int j = 0; j < 4; ++j) { x[j] = bf2f(P[(size_t)row * NP + PC_MLAQD + j * 64 + lane]); ss += x[j] * x[j]; }
        const float rq = 1.f / sqrtf(wave_sum(ss) * (1.f / 256.f) + 1e-6f);
#pragma unroll
        for (int j = 0; j < 4; ++j) qn[tok * 256 + j * 64 + lane] = x[j] * rq * qg[j * 64 + lane];
        float y[2]; float s2 = 0.f;
#pragma unroll
        for (int j = 0; j < 2; ++j) { y[j] = bf2f(P[(size_t)row * NP + PC_MLAKVD + j * 64 + lane]); s2 += y[j] * y[j]; }
        const float rk = 1.f / sqrtf(wave_sum(s2) * (1.f / 128.f) + 1e-6f);
#pragma unroll
        for (int j = 0; j < 2; ++j) kvn[tok * 128 + j * 64 + lane] = y[j] * rk * kvg[j * 64 + lane];
    }
    __syncthreads();
    if (tid < 384) {
        const float* wq = p.in[25] + (size_t)l * 256 * 384;
        float acc[32];
#pragma unroll
        for (int i = 0; i < 32; ++i) acc[i] = 0.f;
        for (int k = 0; k < 256; k += 4) {
            const float w0 = wq[(size_t)k * 384 + tid], w1 = wq[(size_t)(k + 1) * 384 + tid], w2 = wq[(size_t)(k + 2) * 384 + tid], w3 = wq[(size_t)(k + 3) * 384 + tid];
#pragma unroll
            for (int i = 0; i < 32; ++i) { const f32x4 a = *(const LAS f32x4*)(qn + i * 256 + k); acc[i] += a.x * w0 + a.y * w1 + a.z * w2 + a.w * w3; }
        }
#pragma unroll
        for (int i = 0; i < 32; ++i) qo[i * 384 + tid] = acc[i];
    }
    {
        const float* wkv = p.in[27] + (size_t)l * 128 * 512;
        float acc[32];
#pragma unroll
        for (int i = 0; i < 32; ++i) acc[i] = 0.f;
        for (int k = 0; k < 128; k += 4) {
            const float w0 = wkv[(size_t)k * 512 + tid], w1 = wkv[(size_t)(k + 1) * 512 + tid], w2 = wkv[(size_t)(k + 2) * 512 + tid], w3 = wkv[(size_t)(k + 3) * 512 + tid];
#pragma unroll
            for (int i = 0; i < 32; ++i) { const f32x4 a = *(const LAS f32x4*)(kvn + i * 128 + k); acc[i] += a.x * w0 + a.y * w1 + a.z * w2 + a.w * w3; }
        }
        const int h = tid >> 7, dd = tid & 127;
        if (dd < 64) { bf16_t* KM = (bf16_t*)(p.ws + WS_KM) + ((size_t)(s0.b * 4 + h) * NKEYS + key0) * 96 + dd;
#pragma unroll
            for (int i = 0; i < 32; ++i) KM[(size_t)i * 96] = f2bf(acc[i]); }
        else { bf16_t* VT = (bf16_t*)(p.ws + WS_VTM) + ((size_t)(s0.b * 4 + h) * 64 + (dd - 64)) * NKEYS + key0;
#pragma unroll
            for (int i = 0; i < 32; ++i) VT[i] = f2bf(acc[i]); }
    }
    __syncthreads();
    bf16_t* MQ = (bf16_t*)(p.ws + WS_MQ);
    for (int e = tid; e < 32 * 384; e += 512) { const int tok = e / 384, c = e % 384, dd = c % 96; const int pos = s0.pos + tok;
        float v = qo[e];
        if (dd >= 64 && !s0.isctx) { const int pe = dd - 64, axis = pe >> 4, half = (pe >> 3) & 1, f = pe & 7; const int pp = axis == 0 ? (pos >> 6) : (pos & 63);
            const float cs = tabc[pp * 8 + f], sn = tabs[pp * 8 + f];
            const float x1 = half ? qo[e - 8] : v, x2 = half ? v : qo[e + 8];
            v = half ? (x2 * cs + x1 * sn) : (x1 * cs - x2 * sn); }
        MQ[(size_t)(t0 + tok) * 384 + c] = f2bf(v); }
    for (int e = tid; e < 32 * 32; e += 512) { const int tok = e >> 5, pe = e & 31, axis = pe >> 4, half = (pe >> 3) & 1, f = pe & 7; const int row = t0 + tok, pos = s0.pos + tok;
        float v = bf2f(P[(size_t)row * NP + PC_MLAKPE + pe]);
        if (!s0.isctx) { const int pp = axis == 0 ? (pos >> 6) : (pos & 63); const float cs = tabc[pp * 8 + f], sn = tabs[pp * 8 + f];
            const float other = bf2f(P[(size_t)row * NP + PC_MLAKPE + (half ? pe - 8 : pe + 8)]);
            const float x1 = half ? other : v, x2 = half ? v : other;
            v = half ? (x2 * cs + x1 * sn) : (x1 * cs - x2 * sn); }
        const bf16_t o = f2bf(v);
#pragma unroll
        for (int h = 0; h < 4; ++h) ((bf16_t*)(p.ws + WS_KM))[((size_t)(s0.b * 4 + h) * NKEYS + key0 + tok) * 96 + 64 + pe] = o; }
    __syncthreads();
}
__device__ __forceinline__ void ret_scan_item(const Params& p, int item) {
    const int tid = get_tid(); const int seq = item >> 1, dir = item & 1, h = seq & 3;
    const float lg = log1pf(-exp2f(-5.f - (float)h)); const float cdec = expf(128.f * lg);
    float* base = (float*)(p.ws + WS_RET) + (size_t)seq * 34 * 2 * 4096 + dir * 4096;
    float S[8];
#pragma unroll
    for (int i = 0; i < 8; ++i) S[i] = 0.f;
    for (int st = 0; st < 34; ++st) {
        const int ci = dir == 0 ? st : (st == 0 ? 1 : (st == 1 ? 0 : 35 - st));
        float* q = base + (size_t)ci * 2 * 4096 + tid * 8;
        const f32x4 t0 = *(const f32x4*)q, t1 = *(const f32x4*)(q + 4);
        *(f32x4*)q = (f32x4){S[0], S[1], S[2], S[3]}; *(f32x4*)(q + 4) = (f32x4){S[4], S[5], S[6], S[7]};
        S[0] = S[0] * cdec + t0.x; S[1] = S[1] * cdec + t0.y; S[2] = S[2] * cdec + t0.z; S[3] = S[3] * cdec + t0.w;
        S[4] = S[4] * cdec + t1.x; S[5] = S[5] * cdec + t1.y; S[6] = S[6] * cdec + t1.z; S[7] = S[7] * cdec + t1.w;
    }
}
__device__ __forceinline__ void phase_prepB(const Params& p, int l, LAS unsigned char* lds, int bid, int nb) {
    constexpr int N1 = TT / 32, N2 = 64;
    for (int it = bid; it < N1 + N2; it += nb) {
        if (it < N1) mla_proj_item(p, l, lds, it); else ret_scan_item(p, it - N1);
    }
}

template <int DK>
__device__ __forceinline__ void attn_unit(const bf16_t* Q, int qstride, const bf16_t* K, const bf16_t* Vt, int nctx, int mt0, int mt1, bool masked, int qpos0,
                                          bool has_sink, float sink, float scale, bf16_t* O, int ostride, LAS unsigned char* lds) {
    constexpr int KC = DK / 32, KP = DK + 8, KROW = KP * 2;
    constexpr int PIECES_K = 64 * DK / 8;
    const int tid = get_tid(), lane = tid & 63, wave = tid >> 6, fr = lane & 15, fq = lane >> 4;
    LAS unsigned char* Kt = lds;
    LAS unsigned char* Vl = lds + 64 * KROW;
    LAS unsigned char* Pw = Vl + 64 * 144 + wave * (16 * 144);
    bf16x8 qf[KC];
#pragma unroll
    for (int kc = 0; kc < KC; ++kc) qf[kc] = *(const bf16x8*)(Q + (size_t)(wave * 16 + fr) * qstride + kc * 32 + fq * 8);
    const float sl2 = scale * 1.44269504f;
    float m[4], lsum[4]; f32x4 o[4];
#pragma unroll
    for (int r = 0; r < 4; ++r) { m[r] = has_sink ? sink * 1.44269504f : -INFINITY; lsum[r] = 0.f; }
#pragma unroll
    for (int n = 0; n < 4; ++n) o[n] = (f32x4){0.f, 0.f, 0.f, 0.f};
    const int ntiles = nctx + (mt1 - mt0);
    u32x4 kr[2], vr;
    auto issue = [&](int ti) {
        const int tile = ti < nctx ? ti : mt0 + (ti - nctx);
        const bf16_t* kb = K + (size_t)tile * 64 * DK;
#pragma unroll
        for (int i = 0; i < 2; ++i) { const int pc = tid + i * 512; if (pc < PIECES_K) kr[i] = *(const u32x4*)(kb + (size_t)pc * 8); }
        { const int d = tid >> 3, c8 = tid & 7; vr = *(const u32x4*)(Vt + (size_t)d * NKEYS + tile * 64 + c8 * 8); }
    };
    issue(0);
    for (int ti = 0; ti < ntiles; ++ti) {
        const int tile = ti < nctx ? ti : mt0 + (ti - nctx);
        __syncthreads();
#pragma unroll
        for (int i = 0; i < 2; ++i) { const int pc = tid + i * 512; if (pc < PIECES_K) { const int row = pc / (DK / 8), c8 = pc % (DK / 8); *(LAS u32x4*)(Kt + row * KROW + c8 * 16) = kr[i]; } }
        { const int d = tid >> 3, c8 = tid & 7; *(LAS u32x4*)(Vl + d * 144 + c8 * 16) = vr; }
        __syncthreads();
        if (ti + 1 < ntiles) issue(ti + 1);
        f32x4 s[4];
#pragma unroll
        for (int n = 0; n < 4; ++n) { s[n] = (f32x4){0.f, 0.f, 0.f, 0.f};
#pragma unroll
            for (int kc = 0; kc < KC; ++kc) { const bf16x8 kf = *(const LAS bf16x8*)(Kt + (n * 16 + fr) * KROW + kc * 64 + fq * 16);
                s[n] = __builtin_amdgcn_mfma_f32_16x16x32_bf16(qf[kc], kf, s[n], 0, 0, 0); } }
        const bool domask = masked && ti >= nctx;
        float tmax[4];
#pragma unroll
        for (int r = 0; r < 4; ++r) tmax[r] = -INFINITY;
#pragma unroll
        for (int n = 0; n < 4; ++n)
#pragma unroll
            for (int r = 0; r < 4; ++r) { float v = s[n][r] * sl2;
                if (domask) { const int kp = tile * 64 + n * 16 + fr - CTXL, qp = qpos0 + wave * 16 + fq * 4 + r; const int df = qp - kp; if (df > 128 || df < -128) v = -INFINITY; }
                s[n][r] = v; tmax[r] = fmaxf(tmax[r], v); }
#pragma unroll
        for (int r = 0; r < 4; ++r) {
            float t = tmax[r];
            t = fmaxf(t, __shfl_xor(t, 1)); t = fmaxf(t, __shfl_xor(t, 2)); t = fmaxf(t, __shfl_xor(t, 4)); t = fmaxf(t, __shfl_xor(t, 8));
            const float mn = fmaxf(m[r], t);
            const float corr = exp2f(m[r] - mn);
            m[r] = mn; lsum[r] *= corr;
#pragma unroll
            for (int n = 0; n < 4; ++n) o[n][r] *= corr;
        }
#pragma unroll
        for (int n = 0; n < 4; ++n)
#pragma unroll
            for (int r = 0; r < 4; ++r) { const float pv = exp2f(s[n][r] - m[r]); lsum[r] += pv;
                *(LAS bf16_t*)(Pw + (fq * 4 + r) * 144 + (n * 16 + fr) * 2) = f2bf(pv); }
        __builtin_amdgcn_wave_barrier(); asm volatile("s_waitcnt lgkmcnt(0)" ::: "memory"); __builtin_amdgcn_wave_barrier();
        bf16x8 pf[2];
#pragma unroll
        for (int kc = 0; kc < 2; ++kc) pf[kc] = *(const LAS bf16x8*)(Pw + fr * 144 + kc * 64 + fq * 16);
#pragma unroll
        for (int n = 0; n < 4; ++n)
#pragma unroll
            for (int kc = 0; kc < 2; ++kc) { const bf16x8 vf = *(const LAS bf16x8*)(Vl + (n * 16 + fr) * 144 + kc * 64 + fq * 16);
                o[n] = __builtin_amdgcn_mfma_f32_16x16x32_bf16(pf[kc], vf, o[n], 0, 0, 0); }
        __builtin_amdgcn_wave_barrier(); asm volatile("s_waitcnt lgkmcnt(0)" ::: "memory");
    }
#pragma unroll
    for (int r = 0; r < 4; ++r) {
        float t = lsum[r];
        t += __shfl_xor(t, 1); t += __shfl_xor(t, 2); t += __shfl_xor(t, 4); t += __shfl_xor(t, 8);
        if (has_sink) t += exp2f(sink * 1.44269504f - m[r]);
        const float inv = 1.f / t;
#pragma unroll
        for (int n = 0; n < 4; ++n) O[(size_t)(wave * 16 + fq * 4 + r) * ostride + n * 16 + fr] = f2bf(o[n][r] * inv);
    }
    __syncthreads();
}

__device__ __forceinline__ void unpack8(const u32x4 u, float* f) {
    f[0] = bf2f((bf16_t)(u.x & 0xffff)); f[1] = bf2f((bf16_t)(u.x >> 16)); f[2] = bf2f((bf16_t)(u.y & 0xffff)); f[3] = bf2f((bf16_t)(u.y >> 16));
    f[4] = bf2f((bf16_t)(u.z & 0xffff)); f[5] = bf2f((bf16_t)(u.z >> 16)); f[6] = bf2f((bf16_t)(u.w & 0xffff)); f[7] = bf2f((bf16_t)(u.w >> 16));
}
__device__ __forceinline__ void ret_out_item(const Params& p, int l, LAS unsigned char* lds, int item) {
    const int tid = get_tid();
    bf16_t* P = (bf16_t*)(p.ws + WS_P);
    const int cr = item >> 2, h = item & 3; int b; const int ci = ret_chunk_index(cr, b);
    const int r0 = cr * 128;
    const float lg = log1pf(-exp2f(-5.f - (float)h));
    LAS bf16_t* Kb = (LAS bf16_t*)lds;
    LAS float* Sf = (LAS float*)lds;
    LAS bf16_t* Qb = (LAS bf16_t*)(lds + 16384);
    LAS bf16_t* Vb = (LAS bf16_t*)(lds + 32768);
    LAS float* Am = (LAS float*)(lds + 49152);
    LAS float* dec = (LAS float*)(lds + 116736);
    LAS float* Sb = (LAS float*)(lds + 117760);
    for (int e = tid; e < 128 * 8; e += 512) { const int j = e >> 3, c8 = e & 7;
        const u32x4 kk = *(const u32x4*)(P + (size_t)(r0 + j) * NP + PC_RETK + h * 64 + c8 * 8);
        float kf[8]; unpack8(kk, kf);
        u32x4 ko; ko.x = pk2(kf[0] * 0.125f, kf[1] * 0.125f); ko.y = pk2(kf[2] * 0.125f, kf[3] * 0.125f); ko.z = pk2(kf[4] * 0.125f, kf[5] * 0.125f); ko.w = pk2(kf[6] * 0.125f, kf[7] * 0.125f);
        *(LAS u32x4*)(Kb + j * 64 + c8 * 8) = ko;
        *(LAS u32x4*)(Vb + j * 64 + c8 * 8) = *(const u32x4*)(P + (size_t)(r0 + j) * NP + PC_RETV + h * 64 + c8 * 8);
        *(LAS u32x4*)(Qb + j * 64 + c8 * 8) = *(const u32x4*)(P + (size_t)(r0 + j) * NP + PC_RETQ + h * 64 + c8 * 8); }
    if (tid < 129) dec[tid] = expf((float)tid * lg);
    const int i = tid >> 2, jq = tid & 3;
    __syncthreads();
#pragma unroll 1
    for (int hf = 0; hf < 4; ++hf) {
        float a[8];
#pragma unroll
        for (int jj = 0; jj < 8; ++jj) a[jj] = 0.f;
        const int jb = jq * 32 + hf * 8;
#pragma unroll 1
        for (int c8 = 0; c8 < 8; ++c8) {
            float q8[8]; unpack8(*(const LAS u32x4*)(Qb + i * 64 + c8 * 8), q8);
#pragma unroll
            for (int jj = 0; jj < 8; ++jj) { float k8[8]; unpack8(*(const LAS u32x4*)(Kb + (jb + jj) * 64 + c8 * 8), k8);
#pragma unroll
                for (int x = 0; x < 8; ++x) a[jj] += q8[x] * k8[x]; }
        }
#pragma unroll
        for (int jj = 0; jj < 8; ++jj) { const int j = jb + jj; const int df = i > j ? i - j : j - i;
            Am[i * 132 + j] = a[jj] * dec[df] * (i == j ? 2.f : 1.f); }
    }
    __syncthreads();
    { const float* RS = (const float*)(p.ws + WS_RET) + ((size_t)((b * 4 + h) * 34 + ci) * 2) * 4096;
      for (int e = tid; e < 4096; e += 512) { Sf[e] = RS[e]; Sb[e] = RS[4096 + e]; } }
    __syncthreads();
    const int e0 = jq * 16;
    float oacc[16];
#pragma unroll
    for (int e = 0; e < 16; ++e) oacc[e] = 0.f;
#pragma unroll 2
    for (int j = 0; j < 128; ++j) { const float a = Am[i * 132 + j];
        float v8[8];
        unpack8(*(const LAS u32x4*)(Vb + j * 64 + e0), v8);
#pragma unroll
        for (int x = 0; x < 8; ++x) oacc[x] += a * v8[x];
        unpack8(*(const LAS u32x4*)(Vb + j * 64 + e0 + 8), v8);
#pragma unroll
        for (int x = 0; x < 8; ++x) oacc[8 + x] += a * v8[x]; }
    const float gf = dec[i + 1], gb = dec[128 - i];
#pragma unroll 1
    for (int d8 = 0; d8 < 8; ++d8) {
        float q8[8]; unpack8(*(const LAS u32x4*)(Qb + i * 64 + d8 * 8), q8);
#pragma unroll
        for (int x = 0; x < 8; ++x) { const int d = d8 * 8 + x; const float qf = q8[x] * gf, qb = q8[x] * gb;
#pragma unroll
            for (int e4 = 0; e4 < 4; ++e4) { const f32x4 sf = *(const LAS f32x4*)(Sf + d * 64 + e0 + e4 * 4), sb = *(const LAS f32x4*)(Sb + d * 64 + e0 + e4 * 4);
                oacc[e4 * 4 + 0] += qf * sf.x + qb * sb.x; oacc[e4 * 4 + 1] += qf * sf.y + qb * sb.y; oacc[e4 * 4 + 2] += qf * sf.z + qb * sb.z; oacc[e4 * 4 + 3] += qf * sf.w + qb * sb.w; } }
    }
    float sm = 0.f;
#pragma unroll
    for (int e = 0; e < 16; ++e) sm += oacc[e];
    sm += __shfl_xor(sm, 1); sm += __shfl_xor(sm, 2);
    const float mu = sm * (1.f / 64.f);
    float vs = 0.f;
#pragma unroll
    for (int e = 0; e < 16; ++e) { const float dlt = oacc[e] - mu; vs += dlt * dlt; }
    vs += __shfl_xor(vs, 1); vs += __shfl_xor(vs, 2);
    const float rstd = 1.f / sqrtf(vs * (1.f / 64.f) + 1e-5f);
    const float* gn = p.in[13] + l * 256 + h * 64 + e0;
    const bf16_t* gp = P + (size_t)(r0 + i) * NP + PC_RETG + h * 64 + e0;
    bf16_t* yo = P + (size_t)(r0 + i) * NP + PC_RETQ + h * 64 + e0;
    float g16[16]; unpack8(*(const u32x4*)gp, g16); unpack8(*(const u32x4*)(gp + 8), g16 + 8);
    unsigned ow[8];
#pragma unroll
    for (int e = 0; e < 16; e += 2) { const float g0 = g16[e], g1 = g16[e + 1];
        const float y0 = (oacc[e] - mu) * rstd * gn[e] * (g0 / (1.f + __expf(-g0))), y1 = (oacc[e + 1] - mu) * rstd * gn[e + 1] * (g1 / (1.f + __expf(-g1)));
        ow[e >> 1] = pk2(y0, y1); }
    *(u32x4*)yo = (u32x4){ow[0], ow[1], ow[2], ow[3]}; *(u32x4*)(yo + 8) = (u32x4){ow[4], ow[5], ow[6], ow[7]};
    __syncthreads();
}

__device__ __forceinline__ float red8(float v) { v += __shfl_xor(v, 1); v += __shfl_xor(v, 2); v += __shfl_xor(v, 4); return v; }
__device__ __forceinline__ void rwkv_scan_item(const Params& p, int l, LAS unsigned char* lds, int item) {
    const int tid = get_tid();
    const int b = item >> 3, h = (item >> 1) & 3, dir = item & 1;
    const bf16_t* RK = (const bf16_t*)(p.ws + WS_RWK); const bf16_t* RV = (const bf16_t*)(p.ws + WS_RWV); const bf16_t* RR = (const bf16_t*)(p.ws + WS_RWRR);
    const bf16_t* RA = (const bf16_t*)(p.ws + (dir ? WS_RWA1 : WS_RWA0)); const bf16_t* RM = (const bf16_t*)(p.ws + (dir ? WS_RWM1 : WS_RWM0));
    bf16_t* P = (bf16_t*)(p.ws + WS_P);
    const int ocol = (dir ? PC_RWO1 : PC_RWO0) + h * 64;
    LAS float* KH = (LAS float*)lds;
    LAS float* WW = KH + 4096; LAS float* BB = WW + 4096; LAS float* KT = BB + 4096; LAS float* RRl = KT + 4096; LAS float* VV = RRl + 4096; LAS float* OUT = VV + 4096;
    const int st = tid >> 3, c0 = (tid & 7) * 8;
    float kkp[8], kap[8];
#pragma unroll
    for (int i = 0; i < 8; ++i) { kkp[i] = p.in[20][l * 256 + h * 64 + c0 + i]; kap[i] = p.in[21][l * 256 + h * 64 + c0 + i]; }
    const int row = tid >> 3, kq = tid & 7;
    float S[8];
#pragma unroll
    for (int i = 0; i < 8; ++i) S[i] = 0.f;
    auto row_of = [&](int s) -> int {
        if (s < CTXL) return TMAIN + b * CTXL + (dir ? CTXL - 1 - s : s);
        const int t = s - CTXL; return b * SEQL + (dir ? SEQL - 1 - t : t);
    };
    u32x4 gk, gv, gr, ga, gm;
    auto issue = [&](int ch) { const size_t o = (size_t)row_of(ch * 64 + st) * 256 + h * 64 + c0;
        gk = *(const u32x4*)(RK + o); gv = *(const u32x4*)(RV + o); gr = *(const u32x4*)(RR + o); ga = *(const u32x4*)(RA + o); gm = *(const u32x4*)(RM + o); };
    issue(0);
    for (int ch = 0; ch < 68; ++ch) {
        {
            const unsigned uk[4] = {gk.x, gk.y, gk.z, gk.w}, uv[4] = {gv.x, gv.y, gv.z, gv.w}, ur[4] = {gr.x, gr.y, gr.z, gr.w}, ua[4] = {ga.x, ga.y, ga.z, ga.w}, um[4] = {gm.x, gm.y, gm.z, gm.w};
            float k[8], kk[8]; float n2 = 0.f;
#pragma unroll
            for (int i = 0; i < 8; ++i) { const unsigned w = uk[i >> 1]; k[i] = bf2f((bf16_t)((i & 1) ? (w >> 16) : (w & 0xffff))); kk[i] = k[i] * kkp[i]; n2 += kk[i] * kk[i]; }
            n2 = red8(n2);
            const float rn = 1.f / sqrtf(fmaxf(n2, 1e-12f));
#pragma unroll
            for (int i = 0; i < 8; ++i) {
                const float a = bf2f((bf16_t)((i & 1) ? (ua[i >> 1] >> 16) : (ua[i >> 1] & 0xffff)));
                const float om = bf2f((bf16_t)((i & 1) ? (um[i >> 1] >> 16) : (um[i >> 1] & 0xffff)));
                const float kh = kk[i] * rn;
                KH[st * 64 + c0 + i] = kh; WW[st * 64 + c0 + i] = 1.f - om; BB[st * 64 + c0 + i] = kh * a; KT[st * 64 + c0 + i] = k[i] * (1.f + (a - 1.f) * kap[i]);
                RRl[st * 64 + c0 + i] = bf2f((bf16_t)((i & 1) ? (ur[i >> 1] >> 16) : (ur[i >> 1] & 0xffff)));
                VV[st * 64 + c0 + i] = bf2f((bf16_t)((i & 1) ? (uv[i >> 1] >> 16) : (uv[i >> 1] & 0xffff)));
            }
        }
        __syncthreads();
        if (ch + 1 < 68) issue(ch + 1);
#pragma unroll 2
        for (int s = 0; s < 64; ++s) {
            const f32x4 kh0 = *(const LAS f32x4*)(KH + s * 64 + kq * 8), kh1 = *(const LAS f32x4*)(KH + s * 64 + kq * 8 + 4);
            const f32x4 w0 = *(const LAS f32x4*)(WW + s * 64 + kq * 8), w1 = *(const LAS f32x4*)(WW + s * 64 + kq * 8 + 4);
            const f32x4 b0 = *(const LAS f32x4*)(BB + s * 64 + kq * 8), b1 = *(const LAS f32x4*)(BB + s * 64 + kq * 8 + 4);
            const f32x4 t0 = *(const LAS f32x4*)(KT + s * 64 + kq * 8), t1 = *(const LAS f32x4*)(KT + s * 64 + kq * 8 + 4);
            const f32x4 r0 = *(const LAS f32x4*)(RRl + s * 64 + kq * 8), r1 = *(const LAS f32x4*)(RRl + s * 64 + kq * 8 + 4);
            const float vv = VV[s * 64 + row];
            float sk = S[0] * kh0.x + S[1] * kh0.y + S[2] * kh0.z + S[3] * kh0.w + S[4] * kh1.x + S[5] * kh1.y + S[6] * kh1.z + S[7] * kh1.w;
            sk = red8(sk);
            S[0] = S[0] * w0.x - sk * b0.x + vv * t0.x; S[1] = S[1] * w0.y - sk * b0.y + vv * t0.y; S[2] = S[2] * w0.z - sk * b0.z + vv * t0.z; S[3] = S[3] * w0.w - sk * b0.w + vv * t0.w;
            S[4] = S[4] * w1.x - sk * b1.x + vv * t1.x; S[5] = S[5] * w1.y - sk * b1.y + vv * t1.y; S[6] = S[6] * w1.z - sk * b1.z + vv * t1.z; S[7] = S[7] * w1.w - sk * b1.w + vv * t1.w;
            float ov = S[0] * r0.x + S[1] * r0.y + S[2] * r0.z + S[3] * r0.w + S[4] * r1.x + S[5] * r1.y + S[6] * r1.z + S[7] * r1.w;
            ov = red8(ov);
            if (kq == 0) OUT[s * 64 + row] = ov;
        }
        __syncthreads();
        { u32x4 o4; o4.x = pk2(OUT[st * 64 + c0], OUT[st * 64 + c0 + 1]); o4.y = pk2(OUT[st * 64 + c0 + 2], OUT[st * 64 + c0 + 3]); o4.z = pk2(OUT[st * 64 + c0 + 4], OUT[st * 64 + c0 + 5]); o4.w = pk2(OUT[st * 64 + c0 + 6], OUT[st * 64 + c0 + 7]);
          *(u32x4*)(P + (size_t)row_of(ch * 64 + st) * NP + ocol + c0) = o4; }
    }
    __syncthreads();
}

__device__ __forceinline__ void phase_mixers(const Params& p, int l, LAS unsigned char* lds, int bid, int nb) {
    const bool ectx = (l == 0);
    bf16_t* P = (bf16_t*)(p.ws + WS_P);
    const int NSCAN = 64;
#ifndef DIS_SCAN
    if (bid < NSCAN) { rwkv_scan_item(p, l, lds, bid); return; }
#endif
    const int N_MLA = 1024 + (ectx ? 64 : 0), N_SWA = 1024 + (ectx ? 64 : 0), N_RET = 1024 + (ectx ? 64 : 0);
    for (int it = bid - NSCAN; it < N_MLA + N_SWA + N_RET; it += nb - NSCAN) {
        if (it < N_MLA) {
#ifndef DIS_MLA
            const bf16_t* MQ = (const bf16_t*)(p.ws + WS_MQ);
            if (it < 1024) { const int b = it >> 7, h = (it >> 5) & 3, qb = it & 31; const int row0 = b * SEQL + qb * 128;
                attn_unit<96>(MQ + (size_t)row0 * 384 + h * 96, 384, (const bf16_t*)(p.ws + WS_KM) + (size_t)(b * 4 + h) * NKEYS * 96, (const bf16_t*)(p.ws + WS_VTM) + (size_t)(b * 4 + h) * 64 * NKEYS,
                              4, 4, 68, false, 0, false, 0.f, 0.10206207f, P + (size_t)row0 * NP + PC_MLAQD + h * 64, NP, lds); }
            else { const int u = it - 1024, b = u >> 3, h = (u >> 1) & 3, qb = u & 1; const int row0 = TMAIN + b * CTXL + qb * 128;
                attn_unit<96>(MQ + (size_t)row0 * 384 + h * 96, 384, (const bf16_t*)(p.ws + WS_KM) + (size_t)(b * 4 + h) * NKEYS * 96, (const bf16_t*)(p.ws + WS_VTM) + (size_t)(b * 4 + h) * 64 * NKEYS,
                              4, 4, 4, false, 0, false, 0.f, 0.10206207f, P + (size_t)row0 * NP + PC_MLAQD + h * 64, NP, lds); }
#endif
        } else if (it < N_MLA + N_SWA) {
#ifndef DIS_SWA
            const int u0 = it - N_MLA;
            if (u0 < 1024) { const int b = u0 >> 7, h = (u0 >> 5) & 3, qb = u0 & 31, hk = h >> 1; const int row0 = b * SEQL + qb * 128;
                int mt0 = 4 + 2 * (qb - 1), mt1 = 4 + 2 * (qb + 2); if (mt0 < 4) mt0 = 4; if (mt1 > 68) mt1 = 68;
                bf16_t* qp = P + (size_t)row0 * NP + PC_SWAQ + h * 64;
                attn_unit<64>(qp, NP, (const bf16_t*)(p.ws + WS_KS) + (size_t)(b * 2 + hk) * NKEYS * 64, (const bf16_t*)(p.ws + WS_VTS) + (size_t)(b * 2 + hk) * 64 * NKEYS,
                              4, mt0, mt1, true, qb * 128, true, p.in[12][l * 4 + h], 0.125f, qp, NP, lds); }
            else { const int u = u0 - 1024, b = u >> 3, h = (u >> 1) & 3, qb = u & 1, hk = h >> 1; const int row0 = TMAIN + b * CTXL + qb * 128;
                bf16_t* qp = P + (size_t)row0 * NP + PC_SWAQ + h * 64;
                attn_unit<64>(qp, NP, (const bf16_t*)(p.ws + WS_KS) + (size_t)(b * 2 + hk) * NKEYS * 64, (const bf16_t*)(p.ws + WS_VTS) + (size_t)(b * 2 + hk) * 64 * NKEYS,
                              4, 4, 4, false, 0, true, p.in[12][l * 4 + h], 0.125f, qp, NP, lds); }
#endif
        } else {
#ifndef DIS_RET
            ret_out_item(p, l, lds, it - N_MLA - N_SWA);
#endif
        }
    }
}

__device__ __forceinline__ void phase_rwkv_finish(const Params& p, int l, LAS unsigned char* lds, int bid, int nb) {
    const int tid = get_tid();
    bf16_t* P = (bf16_t*)(p.ws + WS_P);
    const int ntiles = (l == 0 ? TT : TMAIN) / 32;
    const float* mu = p.in[14] + l * 1024 + 896;
    const float* gup = p.in[19] + (size_t)l * 128 * 256;
    const bf16_t* RV = (const bf16_t*)(p.ws + WS_RWV); const float* BON = (const float*)(p.ws + WS_BON);
    LAS float* sg = (LAS float*)lds;
    for (int tile = bid; tile < ntiles; tile += nb) {
        const int t0 = tile * 32; const SeqInfo s0 = seq_of_row(t0);
        for (int e = tid; e < 32 * 128; e += 512) { const int tok = e >> 7, j = e & 127; const int row = t0 + tok, pos = s0.pos + tok;
            const float z0 = bf2f(P[(size_t)row * NP + PC_RWGD + j]);
            const float zm = pos > 0 ? bf2f(P[(size_t)(row - 1) * NP + PC_RWGD + j]) : 0.f;
            const float zp = pos < s0.len - 1 ? bf2f(P[(size_t)(row + 1) * NP + PC_RWGD + j]) : 0.f;
            sg[e] = sigmoidf_(z0 + mu[j] * (0.5f * (zm + zp) - z0)); }
        __syncthreads();
        const int hh = tid >> 8, c = tid & 255, h = c >> 6;
        float g[16];
#pragma unroll
        for (int i = 0; i < 16; ++i) g[i] = 0.f;
        for (int j = 0; j < 128; ++j) { const float w = gup[j * 256 + c];
#pragma unroll
            for (int i = 0; i < 16; ++i) g[i] += sg[(hh * 16 + i) * 128 + j] * w; }
        const float gn = p.in[23][l * 256 + c];
#pragma unroll
        for (int i = 0; i < 16; ++i) { const int row = t0 + hh * 16 + i;
            const float o = bf2f(P[(size_t)row * NP + PC_RWO0 + c]) + bf2f(P[(size_t)row * NP + PC_RWO1 + c]);
            const float mean = wave_sum(o) * (1.f / 64.f); const float dl = o - mean; const float var = wave_sum(dl * dl) * (1.f / 64.f);
            float y = dl * (1.f / sqrtf(var + 64e-5f)) * gn + BON[(size_t)row * 4 + h] * bf2f(RV[(size_t)row * 256 + c]);
            P[(size_t)row * NP + PC_RWO1 + c] = f2bf(y * g[i]); }
        __syncthreads();
    }
}

#ifndef N_LAUNCH_MODE
#define N_LAUNCH_MODE 1
#endif
template <int Q>
__device__ __forceinline__ void layer_phase(const Params& p, int l, LAS unsigned char* lds, int bid, int nb) {
    unsigned char* wb = p.ws + WS_WB + (size_t)l * WB_LAYER;
    const int Mrows = (l == 0) ? TT : TMAIN;
    pg8::StaticOrder S;
    if constexpr (Q == 0) { pg8::Gemm g{(const bf16_t*)(p.ws + WS_HB), (const bf16_t*)(wb + WB_IN), TT, NP, DM, DM}; S.init(TT, NP, nb, bid);
              pg8::EpiBf16<0> E{(bf16_t*)(p.ws + WS_P), NP}; pg8::gemm_phase(lds, g, S, E); }
    if constexpr (Q == 1) phase_prepA(p, l, lds, bid, nb);
    if constexpr (Q == 2) phase_prepB(p, l, lds, bid, nb);
    if constexpr (Q == 3) phase_mixers(p, l, lds, bid, nb);
    if constexpr (Q == 4) phase_rwkv_finish(p, l, lds, bid, nb);
    if constexpr (Q == 5) { pg8::Gemm g{(const bf16_t*)(p.ws + WS_P), (const bf16_t*)(wb + WB_OUT), Mrows, DM, DM, NP}; S.init(Mrows, DM, nb, bid);
              pg8::EpiBf16<0> E{(bf16_t*)(p.ws + WS_Z), DM}; pg8::gemm_phase(lds, g, S, E); }
    if constexpr (Q == 6) phase_rowops(p, 1, l, Mrows, bid, nb);
    if constexpr (Q == 7) { pg8::Gemm g{(const bf16_t*)(p.ws + WS_HB), (const bf16_t*)(wb + WB_W1), Mrows, FF, DM, DM}; S.init(Mrows, FF, nb, bid);
              pg8::EpiBf16<1> E{(bf16_t*)(p.ws + WS_HID), FF}; pg8::gemm_phase(lds, g, S, E); }
    if constexpr (Q == 8) { pg8::Gemm g{(const bf16_t*)(p.ws + WS_HID), (const bf16_t*)(wb + WB_W2), Mrows, DM, FF, FF}; S.init(Mrows, DM, nb, bid);
              pg8::EpiBf16<0> E{(bf16_t*)(p.ws + WS_Z), DM}; pg8::gemm_phase(lds, g, S, E); }
    if constexpr (Q == 9) phase_rowops(p, 2, l, Mrows, bid, nb);
}

__global__ void __launch_bounds__(512, 2) mega_fwd(Params p) {
    extern __shared__ __attribute__((aligned(16))) unsigned char lds_raw[];
    LAS unsigned char* lds = (LAS unsigned char*)lds_raw;
    cg::grid_group grid = cg::this_grid();
    const int bid = blockIdx.x, nb = gridDim.x;
    phase_prologue(p, lds, bid, nb); grid.sync();
    phase_rowops(p, 0, 0, TT, bid, nb); grid.sync();
#define LAYER(L, LAST) \
    layer_phase<0>(p, L, lds, bid, nb); grid.sync(); layer_phase<1>(p, L, lds, bid, nb); grid.sync(); layer_phase<2>(p, L, lds, bid, nb); grid.sync(); \
    layer_phase<3>(p, L, lds, bid, nb); grid.sync(); layer_phase<4>(p, L, lds, bid, nb); grid.sync(); layer_phase<5>(p, L, lds, bid, nb); grid.sync(); \
    layer_phase<6>(p, L, lds, bid, nb); grid.sync(); layer_phase<7>(p, L, lds, bid, nb); grid.sync(); layer_phase<8>(p, L, lds, bid, nb); grid.sync(); \
    layer_phase<9>(p, L, lds, bid, nb); if (!(LAST)) grid.sync();
    LAYER(0, false)
    LAYER(1, true)
}
#if N_LAUNCH_MODE != 1
template <int PH> __global__ void __launch_bounds__(512, 2) one_phase(Params p, int l) {
    extern __shared__ __attribute__((aligned(16))) unsigned char lds_raw[];
    LAS unsigned char* lds = (LAS unsigned char*)lds_raw;
    if constexpr (PH == 100) phase_prologue(p, lds, blockIdx.x, gridDim.x);
    else if constexpr (PH == 101) phase_rowops(p, 0, 0, TT, blockIdx.x, gridDim.x);
    else layer_phase<PH>(p, l, lds, blockIdx.x, gridDim.x);
}
#endif

extern "C" void kernel_launch(void* const* d_in, const int* in_sizes, int n_in, void* d_out, int out_size, void* d_ws, size_t ws_size, hipStream_t stream) {
    if (n_in != 30 || ws_size < WS_NEED || out_size != TMAIN * DM) { fprintf(stderr, "kernel_launch: unexpected shapes (n_in %d, ws %zu, out %d)\n", n_in, ws_size, out_size); return; }
    Params p{};
    for (int i = 0; i < 30; ++i) p.in[i] = (const float*)d_in[i];
    p.out = (float*)d_out; p.ws = (unsigned char*)d_ws;
    static int grid_blocks = 0;
    if (!grid_blocks) {
        int dev = 0, cus = 0, per_cu = 0;
        (void)hipGetDevice(&dev);
        (void)hipDeviceGetAttribute(&cus, hipDeviceAttributeMultiprocessorCount, dev);
        (void)hipFuncSetAttribute((const void*)mega_fwd, hipFuncAttributeMaxDynamicSharedMemorySize, LDS_BYTES);
        (void)hipOccupancyMaxActiveBlocksPerMultiprocessor(&per_cu, mega_fwd, 512, LDS_BYTES);
        if (per_cu < 1) { fprintf(stderr, "kernel_launch: occupancy query says %d blocks/CU\n", per_cu); per_cu = 1; }
        grid_blocks = cus * 1;
        if (grid_blocks < 128) { fprintf(stderr, "kernel_launch: only %d CUs\n", grid_blocks); }
    }
#if N_LAUNCH_MODE == 1
    void* args[] = {&p};
    hipError_t e = hipLaunchCooperativeKernel((const void*)mega_fwd, dim3(grid_blocks), dim3(512), args, LDS_BYTES, stream);
    if (e != hipSuccess) fprintf(stderr, "cooperative launch failed: %s (grid %d)\n", hipGetErrorString(e), grid_blocks);
#else
#define LP(PH, L) do { (void)hipFuncSetAttribute((const void*)one_phase<PH>, hipFuncAttributeMaxDynamicSharedMemorySize, LDS_BYTES); one_phase<PH><<<grid_blocks, 512, LDS_BYTES, stream>>>(p, L); } while (0)
    LP(100, 0); LP(101, 0);
    for (int l = 0; l < 2; ++l) { LP(0, l); LP(1, l); LP(2, l); LP(3, l); LP(4, l); LP(5, l); LP(6, l); LP(7, l); LP(8, l); LP(9, l); }
#endif
}
```

```cpp
#include <hip/hip_runtime.h>
#include <hip/hip_cooperative_groups.h>
#include <cstdio>
#include <cstdint>
#include <cmath>
namespace cg = cooperative_groups;
__device__ __forceinline__ int get_tid() { int t = threadIdx.x; asm volatile("" : "+v"(t)); return t; }
namespace pg8 {
#define PG8_LAS __attribute__((address_space(3)))
typedef unsigned short bf16_t;
typedef short bf16x8 __attribute__((ext_vector_type(8)));
typedef float f32x4 __attribute__((ext_vector_type(4)));
typedef unsigned u32x4 __attribute__((ext_vector_type(4)));
typedef unsigned u32x2 __attribute__((ext_vector_type(2)));
constexpr int BM = 256, BK = 64, HALF = 128, HTB = HALF * BK * 2, STAGE_BYTES = 8 * HTB, NXCD = 8, WGM = 8;

__host__ __device__ __forceinline__ int lds_byte(int r, int c) { const int st = (r >> 4) * 2 + (c >> 5), rr = r & 15, cc = c & 31, ob = rr * 64 + cc * 2; return st * 1024 + (ob ^ (((ob >> 9) & 1) << 5)); }
__host__ __device__ __forceinline__ void stage_rc(int b, int& R, int& C) { const int st = b / 1024, sb = b % 1024, swz = sb ^ (((sb >> 9) & 1) << 5); R = (st >> 1) * 16 + swz / 64; C = (st & 1) * 32 + (swz % 64) / 2; }

struct Unit { int pm, pn; };
struct Gemm { const bf16_t* A; const bf16_t* Bt; int M, N, K, lda; };

struct StaticOrder {
    int nM, nN, nwg, G, c;
    __host__ __device__ void init(int M, int N, int G_, int c_) { nM = M / BM; nN = N / BM; nwg = nM * nN; G = G_; c = c_; }
    __host__ __device__ bool next(int i, Unit& u) const {
        const long L = (long)i * G + c; if (L >= nwg) return false;
        int wgid = (int)L; { const int q = nwg / NXCD, r = nwg % NXCD, xcd = wgid % NXCD, off = wgid / NXCD; wgid = (xcd < r ? xcd * (q + 1) : r * (q + 1) + (xcd - r) * q) + off; }
        const int nig = WGM * nN, gid = wgid / nig, fm = gid * WGM, gsz = (nM - fm) < WGM ? (nM - fm) : WGM;
        u.pm = fm + ((wgid % nig) % gsz); u.pn = (wgid % nig) / gsz; return true;
    }
};

template <class Epi>
__device__ __forceinline__ void gemm_phase(PG8_LAS unsigned char* lds, const Gemm g, const StaticOrder& S, const Epi& E) {
    const int tid = get_tid(), wid = __builtin_amdgcn_readfirstlane(tid >> 6), lane = tid & 63, wr = wid >> 2, wc = wid & 3, fr = lane & 15, fq = lane >> 4;
    const int K = g.K, nt = K / BK, lda = g.lda;
    unsigned voffA[2], voffB[2];
#pragma unroll
    for (int i = 0; i < 2; ++i) { int R, C; stage_rc(tid * 16 + i * 8192, R, C);
        voffA[i] = (unsigned)(R * lda + C) * 2u; voffB[i] = (unsigned)(R * K + C) * 2u; }
    const size_t kstep = (size_t)(BK * 2);
    const size_t hstepA = (size_t)HALF * lda * 2, hstepB = (size_t)HALF * K * 2;
    const size_t tstepA = 2 * hstepA, tstepB = 2 * hstepB;
    const unsigned ldsw = (unsigned)wid * 1024u;
    const int aoff = lds_byte(wr * 64 + fr, fq * 8), boff = lds_byte(wc * 32 + fr, fq * 8);
#define PG8_SA(b, h) (((b) * 2 + (h)) * HTB)
#define PG8_SB(b, h) ((4 + (b) * 2 + (h)) * HTB)
#define PG8_STAGE(bufoff, gbase, voff) do { _Pragma("unroll") for (int _i = 0; _i < 2; ++_i) \
        __builtin_amdgcn_global_load_lds((const unsigned*)((const char*)(gbase) + (voff)[_i]), (PG8_LAS unsigned*)(lds + (bufoff) + ldsw + _i * 8192), 16, 0, 0); } while (0)
#define PG8_LDA(dst, b, h) do { _Pragma("unroll") for (int m = 0; m < 4; ++m) _Pragma("unroll") for (int k = 0; k < 2; ++k) dst[m][k] = *(const PG8_LAS bf16x8*)(lds + PG8_SA(b, h) + aoff + m * 2048 + k * 1024); } while (0)
#define PG8_LDB(dst, b, h) do { _Pragma("unroll") for (int n = 0; n < 2; ++n) _Pragma("unroll") for (int k = 0; k < 2; ++k) dst[n][k] = *(const PG8_LAS bf16x8*)(lds + PG8_SB(b, h) + boff + n * 2048 + k * 1024); } while (0)
#define PG8_MMA(ai, bj, At, Bt) do { __builtin_amdgcn_s_setprio(1); _Pragma("unroll") for (int m = 0; m < 4; ++m) _Pragma("unroll") for (int n = 0; n < 2; ++n) _Pragma("unroll") for (int k = 0; k < 2; ++k) \
        acc[ai][bj][m][n] = __builtin_amdgcn_mfma_f32_16x16x32_bf16(Bt[n][k], At[m][k], acc[ai][bj][m][n], 0, 0, 0); __builtin_amdgcn_s_setprio(0); } while (0)
#define PG8_WAIT_V(n) asm volatile("s_waitcnt vmcnt(" #n ")" ::: "memory")
#define PG8_WAIT_L(n) asm volatile("s_waitcnt lgkmcnt(" #n ")" ::: "memory")
#define PG8_BAR __builtin_amdgcn_s_barrier()
#define PG8_SCHED __builtin_amdgcn_sched_barrier(0)
    Unit cur, nxt; int ui = 0;
    if (!S.next(0, cur)) return;
    f32x4 acc[2][2][4][2];
#pragma unroll
    for (int a = 0; a < 2; ++a)
#pragma unroll
        for (int b = 0; b < 2; ++b)
#pragma unroll
            for (int m = 0; m < 4; ++m)
#pragma unroll
                for (int n = 0; n < 2; ++n) acc[a][b][m][n] = (f32x4){0.f, 0.f, 0.f, 0.f};
    bf16x8 At[4][2], B0[2][2], B1[2][2];
    const char* cA = (const char*)g.A + (size_t)cur.pm * tstepA; const char* cB = (const char*)g.Bt + (size_t)cur.pn * tstepB;
    PG8_STAGE(PG8_SB(0, 0), cB, voffB); PG8_STAGE(PG8_SA(0, 0), cA, voffA); PG8_STAGE(PG8_SB(0, 1), cB + hstepB, voffB); PG8_STAGE(PG8_SA(0, 1), cA + hstepA, voffA);
    if (wr == 1) PG8_BAR;
    PG8_WAIT_V(4); PG8_BAR;
    PG8_STAGE(PG8_SB(1, 0), cB + kstep, voffB); PG8_STAGE(PG8_SA(1, 0), cA + kstep, voffA); PG8_STAGE(PG8_SB(1, 1), cB + hstepB + kstep, voffB);
    PG8_WAIT_V(6); PG8_BAR;
    for (;;) {
        const bool has_next = S.next(ui + 1, nxt);
        const char* nA = has_next ? (const char*)g.A + (size_t)nxt.pm * tstepA : cA; const char* nB = has_next ? (const char*)g.Bt + (size_t)nxt.pn * tstepB : cB;
        for (int t = 0; t < nt; t += 2) {
            const bool last = (t == nt - 2);
            const char* a1 = cA + (size_t)(t + 1) * kstep;
            const char* a2 = last ? nA : cA + (size_t)(t + 2) * kstep; const char* b2 = last ? nB : cB + (size_t)(t + 2) * kstep;
            const char* a3 = a2 + kstep; const char* b3 = b2 + kstep;
            PG8_LDB(B0, 0, 0); PG8_SCHED; PG8_LDA(At, 0, 0); PG8_STAGE(PG8_SA(1, 1), a1 + hstepA, voffA);
            PG8_WAIT_L(8); PG8_BAR; PG8_WAIT_L(0); PG8_MMA(0, 0, At, B0); PG8_BAR; PG8_SCHED;
            PG8_LDB(B1, 0, 1); PG8_STAGE(PG8_SB(0, 0), b2, voffB);
            PG8_BAR; PG8_WAIT_L(0); PG8_MMA(0, 1, At, B1); PG8_BAR;
            PG8_LDA(At, 0, 1); PG8_STAGE(PG8_SA(0, 0), a2, voffA);
            PG8_BAR; PG8_WAIT_L(0); PG8_MMA(1, 0, At, B0); PG8_BAR; PG8_SCHED;
            PG8_STAGE(PG8_SB(0, 1), b2 + hstepB, voffB);
            PG8_WAIT_V(6); PG8_BAR; PG8_MMA(1, 1, At, B1); PG8_BAR;
            PG8_LDB(B0, 1, 0); PG8_SCHED; PG8_LDA(At, 1, 0); PG8_STAGE(PG8_SA(0, 1), a2 + hstepA, voffA);
            PG8_WAIT_L(8); PG8_BAR; PG8_WAIT_L(0); PG8_MMA(0, 0, At, B0); PG8_BAR; PG8_SCHED;
            PG8_LDB(B1, 1, 1); PG8_STAGE(PG8_SB(1, 0), b3, voffB);
            PG8_BAR; PG8_WAIT_L(0); PG8_MMA(0, 1, At, B1); PG8_BAR;
            PG8_LDA(At, 1, 1); PG8_STAGE(PG8_SA(1, 0), a3, voffA);
            PG8_BAR; PG8_WAIT_L(0); PG8_MMA(1, 0, At, B0); PG8_BAR; PG8_SCHED;
            PG8_STAGE(PG8_SB(1, 1), b3 + hstepB, voffB);
            PG8_WAIT_V(6); PG8_BAR; PG8_MMA(1, 1, At, B1); PG8_BAR;
        }
        E(acc, cur, wr, wc, fr, fq);
        if (!has_next) break;
#pragma unroll
        for (int a = 0; a < 2; ++a)
#pragma unroll
            for (int b = 0; b < 2; ++b)
#pragma unroll
                for (int m = 0; m < 4; ++m)
#pragma unroll
                    for (int n = 0; n < 2; ++n) acc[a][b][m][n] = (f32x4){0.f, 0.f, 0.f, 0.f};
        cur = nxt; cA = nA; cB = nB; ++ui;
    }
    PG8_WAIT_V(0);
    if (wr == 0) PG8_BAR;
    PG8_BAR;
#undef PG8_SA
#undef PG8_SB
#undef PG8_STAGE
#undef PG8_LDA
#undef PG8_LDB
#undef PG8_MMA
#undef PG8_WAIT_V
#undef PG8_WAIT_L
#undef PG8_BAR
#undef PG8_SCHED
}

__device__ __forceinline__ unsigned f2bf_u(float f) { unsigned u = __builtin_bit_cast(unsigned, f); return (u + 0x7fffu + ((u >> 16) & 1u)) >> 16; }
template <int ACT> struct EpiBf16 {
    bf16_t* O; int ldc;
    __device__ __forceinline__ void operator()(const f32x4 (&acc)[2][2][4][2], const Unit& u, int wr, int wc, int fr, int fq) const {
        const int row0 = u.pm * BM + wr * 64 + fr, col0 = u.pn * BM + wc * 32 + 4 * fq;
#pragma unroll
        for (int ai = 0; ai < 2; ++ai)
#pragma unroll
            for (int m = 0; m < 4; ++m) { bf16_t* rowp = O + (size_t)(row0 + ai * HALF + m * 16) * ldc + col0;
#pragma unroll
                for (int bj = 0; bj < 2; ++bj)
#pragma unroll
                    for (int n = 0; n < 2; ++n) { f32x4 v = acc[ai][bj][m][n];
                        if (ACT == 1) { v.x = v.x > 0.f ? v.x * v.x : 0.f; v.y = v.y > 0.f ? v.y * v.y : 0.f; v.z = v.z > 0.f ? v.z * v.z : 0.f; v.w = v.w > 0.f ? v.w * v.w : 0.f; }
                        u32x2 o; o.x = f2bf_u(v.x) | (f2bf_u(v.y) << 16); o.y = f2bf_u(v.z) | (f2bf_u(v.w) << 16);
                        *(u32x2*)(rowp + bj * HALF + n * 16) = o; } }
    }
};
}
typedef unsigned short bf16_t;
typedef short bf16x8 __attribute__((ext_vector_type(8)));
typedef float f32x4 __attribute__((ext_vector_type(4)));
typedef unsigned u32x4 __attribute__((ext_vector_type(4)));
typedef unsigned u32x2 __attribute__((ext_vector_type(2)));
#define LAS __attribute__((address_space(3)))

constexpr int NBATCH = 8, SEQL = 4096, DM = 1024, CTXL = 256, TMAIN = 32768, TCTX = 2048, TT = 34816, NP = 3072, FF = 4096;
constexpr int PC_SWAQ = 0, PC_RETQ = 256, PC_RWR = 512, PC_MLAQD = 768, PC_SWAK = 1024, PC_SWAV = 1152, PC_RETK = 1280, PC_RETV = 1536, PC_RETG = 1792,
              PC_RWK = 2048, PC_RWV = 2304, PC_RWWD = 2560, PC_RWAD = 2624, PC_RWGD = 2688, PC_MLAKVD = 2816, PC_MLAKPE = 2944;
constexpr int PC_RWO0 = PC_RWV, PC_RWO1 = PC_RWR;
constexpr int NKEYS = CTXL + SEQL;

constexpr size_t MiB = 1u << 20;
constexpr size_t WS_MOD = 0;
constexpr size_t WS_TAB = 512 * 1024;
constexpr size_t WS_BON = 1 * MiB;
constexpr size_t WS_WB = 2 * MiB;
constexpr size_t WB_LAYER = 24 * MiB, WB_IN = 0, WB_OUT = 6 * MiB, WB_W1 = 8 * MiB, WB_W2 = 16 * MiB;
constexpr size_t WS_XC = 50 * MiB;
constexpr size_t WS_P = 58 * MiB;
constexpr size_t WS_HID = 58 * MiB;
constexpr size_t WS_A = 262 * MiB;
constexpr size_t ARR17 = 17 * MiB;
constexpr size_t WS_RWK = WS_A, WS_RWV = WS_A + ARR17, WS_RWRR = WS_A + 2 * ARR17, WS_RWA0 = WS_A + 3 * ARR17, WS_RWA1 = WS_A + 4 * ARR17,
                 WS_RWM0 = WS_A + 5 * ARR17, WS_RWM1 = WS_A + 6 * ARR17;
constexpr size_t WS_RET = WS_A + 119 * MiB;
constexpr size_t WS_MQ = WS_RET + 34 * MiB;
constexpr size_t WS_KM = WS_MQ + 26738688;
constexpr size_t WS_VTM = WS_KM + 26738688;
constexpr size_t WS_KS = WS_VTM + ARR17;
constexpr size_t WS_VTS = WS_KS + 8912896;
constexpr size_t WS_A_END = WS_VTS + 8912896;
constexpr size_t WS_Z = 330 * MiB;
constexpr size_t WS_HB = 398 * MiB;
constexpr size_t WS_NEED = 500 * MiB;
static_assert(WS_A_END <= WS_NEED && WS_HB + 68 * MiB <= WS_NEED && WS_HID + 272 * MiB <= WS_Z, "ws map");

constexpr int LDS_BYTES = 150 * 1024;

struct Params { const float* in[30]; float* out; unsigned char* ws; };

__device__ __forceinline__ float bf2f(bf16_t v) { return __builtin_bit_cast(float, (unsigned)v << 16); }
__device__ __forceinline__ bf16_t f2bf(float f) { unsigned u = __builtin_bit_cast(unsigned, f); return (bf16_t)((u + 0x7fffu + ((u >> 16) & 1u)) >> 16); }
__device__ __forceinline__ unsigned pk2(float lo, float hi) { return (unsigned)f2bf(lo) | ((unsigned)f2bf(hi) << 16); }
typedef float f32x2 __attribute__((ext_vector_type(2)));
template <int CTRL> __device__ __forceinline__ float dppf(float v) { return __builtin_bit_cast(float, __builtin_amdgcn_update_dpp(0, __builtin_bit_cast(int, v), CTRL, 0xF, 0xF, true)); }
__device__ __forceinline__ float red4(float v) { v += dppf<0xB1>(v); v += dppf<0x4E>(v); return v; }
__device__ __forceinline__ float red8(float v) { v = red4(v); v += dppf<0x141>(v); return v; }
__device__ __forceinline__ float red16(float v) { v = red8(v); v += dppf<0x140>(v); return v; }
__device__ __forceinline__ float max16(float v) { v = fmaxf(v, dppf<0xB1>(v)); v = fmaxf(v, dppf<0x4E>(v)); v = fmaxf(v, dppf<0x141>(v)); v = fmaxf(v, dppf<0x140>(v)); return v; }
__device__ __forceinline__ float wave_sum(float v) {
    v = red16(v);
    const int u = __builtin_bit_cast(int, v);
    return __builtin_bit_cast(float, __builtin_amdgcn_readlane(u, 0)) + __builtin_bit_cast(float, __builtin_amdgcn_readlane(u, 16)) +
           __builtin_bit_cast(float, __builtin_amdgcn_readlane(u, 32)) + __builtin_bit_cast(float, __builtin_amdgcn_readlane(u, 48));
}
__device__ __forceinline__ void unpack8(const u32x4 u, float* f) {
    f[0] = bf2f((bf16_t)(u.x & 0xffff)); f[1] = bf2f((bf16_t)(u.x >> 16)); f[2] = bf2f((bf16_t)(u.y & 0xffff)); f[3] = bf2f((bf16_t)(u.y >> 16));
    f[4] = bf2f((bf16_t)(u.z & 0xffff)); f[5] = bf2f((bf16_t)(u.z >> 16)); f[6] = bf2f((bf16_t)(u.w & 0xffff)); f[7] = bf2f((bf16_t)(u.w >> 16));
}
__device__ __forceinline__ float sigmoidf_(float x) { return 1.f / (1.f + __expf(-x)); }

struct SeqInfo { int b, pos, len, start, isctx; };
__device__ __forceinline__ SeqInfo seq_of_row(int row) {
    SeqInfo s;
    if (row < TMAIN) { s.b = row >> 12; s.pos = row & 4095; s.len = SEQL; s.start = s.b << 12; s.isctx = 0; }
    else { const int r = row - TMAIN; s.b = r >> 8; s.pos = r & 255; s.len = CTXL; s.start = TMAIN + (s.b << 8); s.isctx = 1; }
    return s;
}

__device__ __forceinline__ void transpose_item(const float* W, int N, int nsrc0, bf16_t* WT, int K, int ndst0, int k0, LAS float* scr, int lane) {
    if (nsrc0 >= 0) {
#pragma unroll 32
        for (int i = 0; i < 32; ++i) { const int kk = 2 * i + (lane >> 5); scr[kk * 33 + (lane & 31)] = W[(size_t)(k0 + kk) * N + nsrc0 + (lane & 31)]; }
    } else {
#pragma unroll 8
        for (int i = 0; i < 32; ++i) { const int kk = 2 * i + (lane >> 5); scr[kk * 33 + (lane & 31)] = 0.f; }
    }
    __builtin_amdgcn_wave_barrier(); asm volatile("s_waitcnt lgkmcnt(0)" ::: "memory");
    const int c = lane & 7;
#pragma unroll
    for (int j = 0; j < 4; ++j) { const int n = (lane >> 3) + 8 * j; const LAS float* s = scr + (8 * c) * 33 + n;
        u32x4 o; o.x = pk2(s[0 * 33], s[1 * 33]); o.y = pk2(s[2 * 33], s[3 * 33]); o.z = pk2(s[4 * 33], s[5 * 33]); o.w = pk2(s[6 * 33], s[7 * 33]);
        *(u32x4*)(WT + (size_t)(ndst0 + n) * K + k0 + 8 * c) = o; }
    __builtin_amdgcn_wave_barrier(); asm volatile("s_waitcnt lgkmcnt(0)" ::: "memory");
}
__device__ __forceinline__ int win_src_col(int n) {
    if (n < 256) return n;
    if (n < 512) return 512 + (n - 256);
    if (n < 768) return 1536 + (n - 512);
    if (n < 1024) return 2560 + (n - 768);
    if (n < 1280) return 256 + (n - 1024);
    if (n < 2048) return 768 + (n - 1280);
    if (n < 2816) return 1792 + (n - 2048);
    if (n < 2976) return n;
    return -1;
}
__device__ __forceinline__ void phase_prologue(const Params& p, LAS unsigned char* lds, int bid, int nb) {
    const int tid = get_tid(), lane = tid & 63, wave = tid >> 6;
    LAS float* scr = (LAS float*)(lds + wave * 16384);
    const int gw = bid * 8 + wave, NGW = nb * 8;
    constexpr int I_IN = 16 * 96, I_OUT = 16 * 32, I_1 = 16 * 128, I_2 = 64 * 32, I_L = I_IN + I_OUT + I_1 + I_2;
    for (int it = gw; it < 2 * I_L; it += NGW) {
        const int l = it / I_L; int r = it % I_L;
        unsigned char* wb = p.ws + WS_WB + (size_t)l * WB_LAYER;
        if (r < I_IN) { const int kb = r / 96, nbk = r % 96; transpose_item(p.in[10] + (size_t)l * DM * 2976, 2976, win_src_col(nbk * 32), (bf16_t*)(wb + WB_IN), DM, nbk * 32, kb * 64, scr, lane); continue; } r -= I_IN;
        if (r < I_OUT) { const int kb = r / 32, nbk = r % 32; transpose_item(p.in[11] + (size_t)l * DM * DM, DM, nbk * 32, (bf16_t*)(wb + WB_OUT), DM, nbk * 32, kb * 64, scr, lane); continue; } r -= I_OUT;
        if (r < I_1) { const int kb = r / 128, nbk = r % 128; transpose_item(p.in[28] + (size_t)l * DM * FF, FF, nbk * 32, (bf16_t*)(wb + WB_W1), DM, nbk * 32, kb * 64, scr, lane); continue; } r -= I_1;
        { const int kb = r / 32, nbk = r % 32; transpose_item(p.in[29] + (size_t)l * FF * DM, DM, nbk * 32, (bf16_t*)(wb + WB_W2), FF, nbk * 32, kb * 64, scr, lane); }
    }
    __syncthreads();
    for (int it = bid; it < 192; it += nb) {
        const int l = it / 96, cb = it % 96;
        LAS float* sc = (LAS float*)lds;
        LAS float* red = sc + 9 * 1024;
        for (int e = tid; e < 9 * 1024; e += 512) { const int r = e >> 10, k = e & 1023; const float v = (r < 8) ? p.in[1][r * 1024 + k] : p.in[3][k]; sc[e] = v / (1.f + __expf(-v)); }
        __syncthreads();
        const int ks = tid >> 6, cl = tid & 63, n = cb * 64 + cl;
        float acc[9];
#pragma unroll
        for (int r = 0; r < 9; ++r) acc[r] = 0.f;
        const float* aw = p.in[4] + (size_t)l * DM * 6144;
#pragma unroll 16
        for (int k = ks * 128; k < ks * 128 + 128; ++k) { const float w = aw[(size_t)k * 6144 + n];
#pragma unroll
            for (int r = 0; r < 9; ++r) acc[r] += sc[r * 1024 + k] * w; }
#pragma unroll
        for (int r = 0; r < 9; ++r) red[(ks * 9 + r) * 64 + cl] = acc[r];
        __syncthreads();
        for (int e = tid; e < 9 * 64; e += 512) { const int r = e >> 6, c2 = e & 63; float s = 0.f;
            for (int q = 0; q < 8; ++q) s += red[(q * 9 + r) * 64 + c2];
            ((float*)(p.ws + WS_MOD))[((size_t)l * 9 + r) * 6144 + cb * 64 + c2] = s + p.in[5][(size_t)l * 6144 + cb * 64 + c2]; }
        __syncthreads();
    }
    if (bid == nb - 1) {
        float* tab = (float*)(p.ws + WS_TAB);
        for (int e = tid; e < 64 * 16; e += 512) { const int pos = e >> 4, f = e & 15; const float inv = powf(10000.f, -(float)(2 * f) / 32.f); const float a = (float)pos * inv; tab[e] = cosf(a); tab[1024 + e] = sinf(a); }
        for (int e = tid; e < 64 * 8; e += 512) { const int pos = e >> 3, f = e & 7; const float inv = powf(10000.f, -(float)(2 * f) / 16.f); const float a = (float)pos * inv; tab[2048 + e] = cosf(a); tab[2560 + e] = sinf(a); }
    }
}

struct RowJob { const float* xsrc; const bf16_t* z; const float* gpost; const float* gate; float* xdst; const float* gpre; const float* shift; const float* scale; bf16_t* hdst; };
__device__ __forceinline__ RowJob make_rowjob(const Params& p, int mode, int l, int row) {
    const float* mod = (const float*)(p.ws + WS_MOD);
    bf16_t* HB = (bf16_t*)(p.ws + WS_HB); const bf16_t* Z = (const bf16_t*)(p.ws + WS_Z);
    float* XC = (float*)(p.ws + WS_XC);
    const SeqInfo s = seq_of_row(row);
    const int mr = s.isctx ? 8 : s.b;
    const float* m_l = mod + ((size_t)l * 9 + mr) * 6144;
    float* xs = s.isctx ? XC + (size_t)(row - TMAIN) * DM : p.out + (size_t)row * DM;
    const float* xin = s.isctx ? p.in[2] + (size_t)(row - TMAIN) * DM : p.in[0] + (size_t)row * DM;
    RowJob j;
    if (mode == 0) { j = RowJob{xin, nullptr, nullptr, nullptr, nullptr, p.in[6] + l * DM, m_l + 0, m_l + 1024, HB + (size_t)row * DM}; }
    else if (mode == 1) { j = RowJob{l == 0 ? xin : xs, Z + (size_t)row * DM, p.in[7] + l * DM, m_l + 2048, xs, p.in[8] + l * DM, m_l + 3072, m_l + 4096, HB + (size_t)row * DM}; }
    else { const bool has_next = (l + 1 < 2); const float* m_n = mod + ((size_t)(has_next ? l + 1 : l) * 9 + mr) * 6144;
        j = RowJob{xs, Z + (size_t)row * DM, p.in[9] + l * DM, m_l + 5120, xs, p.in[6] + (has_next ? l + 1 : l) * DM, m_n + 0, m_n + 1024, has_next ? HB + (size_t)row * DM : nullptr}; }
    return j;
}
template <int RB>
__device__ __forceinline__ void rowop_batch(const RowJob (&jb)[RB], const bool (&valid)[RB], int lane) {
    f32x4 v[RB][4]; u32x2 zu[RB][4];
#pragma unroll
    for (int r = 0; r < RB; ++r) if (valid[r]) {
#pragma unroll
        for (int j = 0; j < 4; ++j) { v[r][j] = *(const f32x4*)(jb[r].xsrc + (j * 64 + lane) * 4); if (jb[r].z) zu[r][j] = *(const u32x2*)(jb[r].z + (j * 64 + lane) * 4); }
    }
#pragma unroll
    for (int r = 0; r < RB; ++r) if (valid[r]) {
        const RowJob& J = jb[r];
        if (J.z) {
            f32x4 zz[4], gp[4], gt[4]; float ss = 0.f;
#pragma unroll
            for (int j = 0; j < 4; ++j) { const int c = (j * 64 + lane) * 4; gp[j] = *(const f32x4*)(J.gpost + c); gt[j] = *(const f32x4*)(J.gate + c); }
#pragma unroll
            for (int j = 0; j < 4; ++j) { const u32x2 u = zu[r][j];
                zz[j].x = bf2f((bf16_t)(u.x & 0xffff)); zz[j].y = bf2f((bf16_t)(u.x >> 16)); zz[j].z = bf2f((bf16_t)(u.y & 0xffff)); zz[j].w = bf2f((bf16_t)(u.y >> 16));
                ss += zz[j].x * zz[j].x + zz[j].y * zz[j].y + zz[j].z * zz[j].z + zz[j].w * zz[j].w; }
            const float rinv = 1.f / sqrtf(wave_sum(ss) * (1.f / 1024.f) + 1e-6f);
#pragma unroll
            for (int j = 0; j < 4; ++j) { const int c = (j * 64 + lane) * 4;
                v[r][j].x += gt[j].x * (zz[j].x * rinv * gp[j].x); v[r][j].y += gt[j].y * (zz[j].y * rinv * gp[j].y); v[r][j].z += gt[j].z * (zz[j].z * rinv * gp[j].z); v[r][j].w += gt[j].w * (zz[j].w * rinv * gp[j].w);
                *(f32x4*)(J.xdst + c) = v[r][j]; }
        }
        if (J.hdst) {
            f32x4 g[4], sh[4], sc[4]; float ss = 0.f;
#pragma unroll
            for (int j = 0; j < 4; ++j) { const int c = (j * 64 + lane) * 4; g[j] = *(const f32x4*)(J.gpre + c); sh[j] = *(const f32x4*)(J.shift + c); sc[j] = *(const f32x4*)(J.scale + c); }
#pragma unroll
            for (int j = 0; j < 4; ++j) ss += v[r][j].x * v[r][j].x + v[r][j].y * v[r][j].y + v[r][j].z * v[r][j].z + v[r][j].w * v[r][j].w;
            const float rinv = 1.f / sqrtf(wave_sum(ss) * (1.f / 1024.f) + 1e-6f);
#pragma unroll
            for (int j = 0; j < 4; ++j) { const int c = (j * 64 + lane) * 4;
                u32x2 o; o.x = pk2(v[r][j].x * rinv * g[j].x * (1.f + sc[j].x) + sh[j].x, v[r][j].y * rinv * g[j].y * (1.f + sc[j].y) + sh[j].y);
                o.y = pk2(v[r][j].z * rinv * g[j].z * (1.f + sc[j].z) + sh[j].z, v[r][j].w * rinv * g[j].w * (1.f + sc[j].w) + sh[j].w);
                *(u32x2*)(J.hdst + c) = o; }
        }
    }
}
__device__ __forceinline__ void phase_rowops(const Params& p, int mode, int l, int nrows, int bid, int nb) {
    const int tid = get_tid(), lane = tid & 63, wave = tid >> 6;
    constexpr int RB = 4;
    const int nwaves = nb * 8, gw = bid * 8 + wave;
    for (int base = gw; base < nrows; base += nwaves * RB) {
        RowJob jb[RB]; bool valid[RB];
#pragma unroll
        for (int r = 0; r < RB; ++r) { const int row = base + r * nwaves; valid[r] = row < nrows; jb[r] = make_rowjob(p, mode, l, valid[r] ? row : 0); }
        rowop_batch<RB>(jb, valid, lane);
    }
}

__device__ __forceinline__ void rwkv_prep_item(const Params& p, int l, LAS unsigned char* lds, int tile) {
    const int tid = get_tid();
    const bf16_t* P = (const bf16_t*)(p.ws + WS_P);
    const int t0 = tile * 32; const SeqInfo s0 = seq_of_row(t0);
    const float* mu = p.in[14] + l * 1024;
    LAS float* r_s = (LAS float*)lds;
    LAS float* k_s = r_s + 32 * 256;
    LAS float* v_s = k_s + 32 * 256;
    LAS float* twd = v_s + 32 * 256;
    LAS float* ad_s = twd + 32 * 64;
#pragma unroll
    for (int it = 0; it < 7; ++it) {
        const int pc = tid + it * 512; const int tok = pc / 112, c8 = pc % 112, cc = c8 * 8;
        const int pcol = cc < 256 ? PC_RWR + cc : PC_RWK + (cc - 256);
        const int row = t0 + tok, pos = s0.pos + tok;
        const u32x4 u0 = *(const u32x4*)(P + (size_t)row * NP + pcol);
        const u32x4 um = pos > 0 ? *(const u32x4*)(P + (size_t)(row - 1) * NP + pcol) : (u32x4){0u, 0u, 0u, 0u};
        const u32x4 up = pos < s0.len - 1 ? *(const u32x4*)(P + (size_t)(row + 1) * NP + pcol) : (u32x4){0u, 0u, 0u, 0u};
        const f32x4 mu0 = *(const f32x4*)(mu + cc), mu1 = *(const f32x4*)(mu + cc + 4);
        float z0[8], zm[8], zp[8], zs[8]; unpack8(u0, z0); unpack8(um, zm); unpack8(up, zp);
        const float mm[8] = {mu0.x, mu0.y, mu0.z, mu0.w, mu1.x, mu1.y, mu1.z, mu1.w};
#pragma unroll
        for (int x = 0; x < 8; ++x) zs[x] = z0[x] + mm[x] * (0.5f * (zm[x] + zp[x]) - z0[x]);
        LAS float* dst;
        if (cc < 256) dst = r_s + tok * 256 + cc;
        else if (cc < 512) dst = k_s + tok * 256 + cc - 256;
        else if (cc < 768) dst = v_s + tok * 256 + cc - 512;
        else if (cc < 832) { dst = twd + tok * 64 + cc - 768;
#pragma unroll
            for (int x = 0; x < 8; ++x) zs[x] = 1.f - 2.f / (1.f + __expf(2.f * zs[x])); }
        else dst = ad_s + tok * 64 + cc - 832;
        *(LAS f32x4*)dst = (f32x4){zs[0], zs[1], zs[2], zs[3]}; *(LAS f32x4*)(dst + 4) = (f32x4){zs[4], zs[5], zs[6], zs[7]};
    }
    __syncthreads();
    const int hh = tid >> 8, c = tid & 255, h = c >> 6;
    float aw0[16], aw1[16], aa0[16], aa1[16];
#pragma unroll
    for (int i = 0; i < 16; ++i) { aw0[i] = 0.f; aw1[i] = 0.f; aa0[i] = 0.f; aa1[i] = 0.f; }
    const float* wup = p.in[16] + (size_t)l * 2 * 64 * 256; const float* aup = p.in[18] + (size_t)l * 2 * 64 * 256;
#pragma unroll 4
    for (int j = 0; j < 64; ++j) {
        const float w0 = wup[j * 256 + c], w1 = wup[64 * 256 + j * 256 + c], a0 = aup[j * 256 + c], a1 = aup[64 * 256 + j * 256 + c];
#pragma unroll
        for (int i = 0; i < 16; ++i) { const float tw = twd[(hh * 16 + i) * 64 + j], ta = ad_s[(hh * 16 + i) * 64 + j];
            aw0[i] += tw * w0; aw1[i] += tw * w1; aa0[i] += ta * a0; aa1[i] += ta * a1; }
    }
    const float w0b0 = p.in[15][(l * 2 + 0) * 256 + c], w0b1 = p.in[15][(l * 2 + 1) * 256 + c];
    const float a0b0 = p.in[17][(l * 2 + 0) * 256 + c], a0b1 = p.in[17][(l * 2 + 1) * 256 + c];
    const float ka = p.in[21][l * 256 + c], rk = p.in[22][l * 256 + c];
    bf16_t* RK = (bf16_t*)(p.ws + WS_RWK); bf16_t* RV = (bf16_t*)(p.ws + WS_RWV); bf16_t* RR = (bf16_t*)(p.ws + WS_RWRR);
    bf16_t* RA0 = (bf16_t*)(p.ws + WS_RWA0); bf16_t* RA1 = (bf16_t*)(p.ws + WS_RWA1); bf16_t* RM0 = (bf16_t*)(p.ws + WS_RWM0); bf16_t* RM1 = (bf16_t*)(p.ws + WS_RWM1);
    float* BON = (float*)(p.ws + WS_BON);
#pragma unroll
    for (int i = 0; i < 16; ++i) {
        const int tok = hh * 16 + i, row = t0 + tok;
        const float k = k_s[tok * 256 + c], v = v_s[tok * 256 + c], r = r_s[tok * 256 + c];
        const float sg0 = sigmoidf_(w0b0 + aw0[i]), sg1 = sigmoidf_(w0b1 + aw1[i]);
        const float om0 = 1.f - __expf(-0.60653066f * sg0), om1 = 1.f - __expf(-0.60653066f * sg1);
        const float a0 = sigmoidf_(a0b0 + aa0[i]), a1 = sigmoidf_(a0b1 + aa1[i]);
        const float kt0 = k * (1.f + (a0 - 1.f) * ka), kt1 = k * (1.f + (a1 - 1.f) * ka);
        const float bs = wave_sum(r * (kt0 + kt1) * rk);
        const size_t o = (size_t)row * 256 + c;
        RK[o] = f2bf(k); RV[o] = f2bf(v); RR[o] = f2bf(r); RA0[o] = f2bf(a0); RA1[o] = f2bf(a1); RM0[o] = f2bf(om0); RM1[o] = f2bf(om1);
        if ((tid & 63) == 0) BON[(size_t)row * 4 + h] = bs;
    }
    __syncthreads();
}
__device__ __forceinline__ int ret_chunk_index(int cr, int& b) { if (cr < 256) { b = cr >> 5; return 2 + (cr & 31); } b = (cr - 256) >> 1; return (cr - 256) & 1; }
__device__ __forceinline__ void ret_kv_item(const Params& p, LAS unsigned char* lds, int item) {
    const int tid = get_tid();
    const bf16_t* P = (const bf16_t*)(p.ws + WS_P);
    const int cr = item >> 2, h = item & 3; int b; const int ci = ret_chunk_index(cr, b);
    const int r0 = cr * 128;
    LAS float* Ks = (LAS float*)lds;
    LAS float* Vs = Ks + 128 * 64;
    LAS float* dec = Vs + 128 * 64;
    const float lg = log1pf(-exp2f(-5.f - (float)h));
    for (int e = tid; e < 128 * 64; e += 512) { const int j = e >> 6, d = e & 63;
        Ks[e] = bf2f(P[(size_t)(r0 + j) * NP + PC_RETK + h * 64 + d]) * 0.125f; Vs[e] = bf2f(P[(size_t)(r0 + j) * NP + PC_RETV + h * 64 + d]); }
    if (tid < 128) dec[tid] = expf((float)tid * lg);
    __syncthreads();
    const int d = tid >> 3, e0 = (tid & 7) * 8;
    float af[8], ab[8];
#pragma unroll
    for (int i = 0; i < 8; ++i) { af[i] = 0.f; ab[i] = 0.f; }
    for (int j = 0; j < 128; ++j) { const float kd = Ks[j * 64 + d]; const float kf = kd * dec[127 - j], kb = kd * dec[j];
        const f32x4 v0 = *(const LAS f32x4*)(Vs + j * 64 + e0), v1 = *(const LAS f32x4*)(Vs + j * 64 + e0 + 4);
        af[0] += kf * v0.x; af[1] += kf * v0.y; af[2] += kf * v0.z; af[3] += kf * v0.w; af[4] += kf * v1.x; af[5] += kf * v1.y; af[6] += kf * v1.z; af[7] += kf * v1.w;
        ab[0] += kb * v0.x; ab[1] += kb * v0.y; ab[2] += kb * v0.z; ab[3] += kb * v0.w; ab[4] += kb * v1.x; ab[5] += kb * v1.y; ab[6] += kb * v1.z; ab[7] += kb * v1.w; }
    float* RS = (float*)(p.ws + WS_RET) + ((size_t)((b * 4 + h) * 34 + ci) * 2) * 4096;
#pragma unroll
    for (int i = 0; i < 8; ++i) { RS[d * 64 + e0 + i] = af[i]; RS[4096 + d * 64 + e0 + i] = ab[i]; }
    __syncthreads();
}
__device__ __forceinline__ void swa_prep_item(const Params& p, LAS unsigned char* lds, int tile) {
    const int tid = get_tid();
    bf16_t* P = (bf16_t*)(p.ws + WS_P);
    const float* tabc = (const float*)(p.ws + WS_TAB); const float* tabs = tabc + 1024;
    bf16_t* KS = (bf16_t*)(p.ws + WS_KS); bf16_t* VT = (bf16_t*)(p.ws + WS_VTS);
    const int t0 = tile * 64; const SeqInfo s0 = seq_of_row(t0);
    const int key0 = s0.isctx ? s0.pos : CTXL + s0.pos;
    LAS bf16_t* Vs = (LAS bf16_t*)lds;
    u32x4 vreg[2];
#pragma unroll
    for (int it = 0; it < 2; ++it) { const int pc = tid + it * 512, tok = pc >> 4, c8 = pc & 15; vreg[it] = *(const u32x4*)(P + (size_t)(t0 + tok) * NP + PC_SWAV + c8 * 8); }
    u32x4 x1[3], x2[3];
#pragma unroll
    for (int it = 0; it < 3; ++it) { const int e = tid + it * 512; const int tok = e / 24, rem = e % 24, hd = rem >> 2, axis = (rem >> 1) & 1, fg = rem & 1;
        const int colbase = (hd < 4 ? PC_SWAQ + hd * 64 : PC_SWAK + (hd - 4) * 64) + axis * 32 + fg * 8;
        x1[it] = *(const u32x4*)(P + (size_t)(t0 + tok) * NP + colbase); x2[it] = *(const u32x4*)(P + (size_t)(t0 + tok) * NP + colbase + 16); }
#pragma unroll
    for (int it = 0; it < 2; ++it) { const int pc = tid + it * 512, tok = pc >> 4, c8 = pc & 15; *(LAS u32x4*)(Vs + tok * 136 + c8 * 8) = vreg[it]; }
#pragma unroll
    for (int it = 0; it < 3; ++it) { const int e = tid + it * 512; const int tok = e / 24, rem = e % 24, hd = rem >> 2, axis = (rem >> 1) & 1, fg = rem & 1;
        const int row = t0 + tok, pos = s0.pos + tok;
        const int colbase = (hd < 4 ? PC_SWAQ + hd * 64 : PC_SWAK + (hd - 4) * 64) + axis * 32 + fg * 8;
        float a[8], bb[8]; unpack8(x1[it], a); unpack8(x2[it], bb);
        if (!s0.isctx) { const int pp = axis == 0 ? (pos >> 6) : (pos & 63);
            const f32x4 c0 = *(const f32x4*)(tabc + pp * 16 + fg * 8), c1 = *(const f32x4*)(tabc + pp * 16 + fg * 8 + 4), s0v = *(const f32x4*)(tabs + pp * 16 + fg * 8), s1v = *(const f32x4*)(tabs + pp * 16 + fg * 8 + 4);
            const float cs[8] = {c0.x, c0.y, c0.z, c0.w, c1.x, c1.y, c1.z, c1.w}, sn[8] = {s0v.x, s0v.y, s0v.z, s0v.w, s1v.x, s1v.y, s1v.z, s1v.w};
#pragma unroll
            for (int x = 0; x < 8; ++x) { const float y1 = a[x] * cs[x] - bb[x] * sn[x], y2 = bb[x] * cs[x] + a[x] * sn[x]; a[x] = y1; bb[x] = y2; } }
        u32x4 o1, o2; o1.x = pk2(a[0], a[1]); o1.y = pk2(a[2], a[3]); o1.z = pk2(a[4], a[5]); o1.w = pk2(a[6], a[7]);
        o2.x = pk2(bb[0], bb[1]); o2.y = pk2(bb[2], bb[3]); o2.z = pk2(bb[4], bb[5]); o2.w = pk2(bb[6], bb[7]);
        if (hd < 4) { if (!s0.isctx) { *(u32x4*)(P + (size_t)row * NP + colbase) = o1; *(u32x4*)(P + (size_t)row * NP + colbase + 16) = o2; } }
        else { bf16_t* kd = KS + ((size_t)(s0.b * 2 + (hd - 4)) * NKEYS + key0 + tok) * 64 + axis * 32 + fg * 8; *(u32x4*)kd = o1; *(u32x4*)(kd + 16) = o2; }
    }
    __syncthreads();
#pragma unroll
    for (int it = 0; it < 2; ++it) { const int pc = tid + it * 512, hd = pc >> 3, k8 = pc & 7, hk = hd >> 6, d = hd & 63;
        unsigned w[4];
#pragma unroll
        for (int x = 0; x < 4; ++x) w[x] = (unsigned)Vs[(k8 * 8 + 2 * x) * 136 + hd] | ((unsigned)Vs[(k8 * 8 + 2 * x + 1) * 136 + hd] << 16);
        *(u32x4*)(VT + ((size_t)(s0.b * 2 + hk) * 64 + d) * NKEYS + key0 + k8 * 8) = (u32x4){w[0], w[1], w[2], w[3]}; }
    __syncthreads();
}
__device__ __forceinline__ void phase_prepA(const Params& p, int l, LAS unsigned char* lds, int bid, int nb) {
    constexpr int N1 = TT / 32, N2 = 272 * 4, N3 = TT / 64;
    for (int it = bid; it < N1 + N2 + N3; it += nb) {
        if (it < N1) rwkv_prep_item(p, l, lds, it);
        else if (it < N1 + N2) ret_kv_item(p, lds, it - N1);
        else swa_prep_item(p, lds, it - N1 - N2);
    }
}

__device__ __forceinline__ void mla_proj_item(const Params& p, int l, LAS unsigned char* lds, int tile) {
    const int tid = get_tid(), lane = tid & 63, wave = tid >> 6;
    const bf16_t* P = (const bf16_t*)(p.ws + WS_P);
    const float* tabc = (const float*)(p.ws + WS_TAB) + 2048; const float* tabs = tabc + 512;
    const int t0 = tile * 32; const SeqInfo s0 = seq_of_row(t0);
    const int key0 = s0.isctx ? s0.pos : CTXL + s0.pos;
    LAS float* qn = (LAS float*)lds;
    LAS float* kvn = qn + 32 * 256;
    LAS float* qo = kvn + 32 * 128;
    const float* qg = p.in[24] + l * 256; const float* kvg = p.in[26] + l * 128;
    for (int i = 0; i < 4; ++i) { const int tok = wave * 4 + i, row = t0 + tok;
        float x[4]; float ss = 0.f;
#pragma unroll
        for (int j = 0; j < 4; ++j) { x[j] = bf2f(P[(size_t)row * NP + PC_MLAQD + j * 64 + lane]); ss += x[j] * x[j]; }
        const float rq = 1.f / sqrtf(wave_sum(ss) * (1.f / 256.f) + 1e-6f);
#pragma unroll
        for (int j = 0; j < 4; ++j) qn[tok * 256 + j * 64 + lane] = x[j] * rq * qg[j * 64 + lane];
        float y[2]; float s2 = 0.f;
#pragma unroll
        for (int j = 0; j < 2; ++j) { y[j] = bf2f(P[(size_t)row * NP + PC_MLAKVD + j * 64 + lane]); s2 += y[j] * y[j]; }
        const float rk = 1.f / sqrtf(wave_sum(s2) * (1.f / 128.f) + 1e-6f);
#pragma unroll
        for (int j = 0; j < 2; ++j) kvn[tok * 128 + j * 64 + lane] = y[j] * rk * kvg[j * 64 + lane];
    }
    __syncthreads();
    if (tid < 384) {
        const float* wq = p.in[25] + (size_t)l * 256 * 384;
        float acc[32];
#pragma unroll
        for (int i = 0; i < 32; ++i) acc[i] = 0.f;
        for (int k = 0; k < 256; k += 4) {
            const float w0 = wq[(size_t)k * 384 + tid], w1 = wq[(size_t)(k + 1) * 384 + tid], w2 = wq[(size_t)(k + 2) * 384 + tid], w3 = wq[(size_t)(k + 3) * 384 + tid];
#pragma unroll
            for (int i = 0; i < 32; ++i) { const f32x4 a = *(const LAS f32x4*)(qn + i * 256 + k); acc[i] += a.x * w0 + a.y * w1 + a.z * w2 + a.w * w3; }
        }
#pragma unroll
        for (int i = 0; i < 32; ++i) qo[i * 384 + tid] = acc[i];
    }
    {
        const float* wkv = p.in[27] + (size_t)l * 128 * 512;
        float acc[32];
#pragma unroll
        for (int i = 0; i < 32; ++i) acc[i] = 0.f;
        for (int k = 0; k < 128; k += 4) {
            const float w0 = wkv[(size_t)k * 512 + tid], w1 = wkv[(size_t)(k + 1) * 512 + tid], w2 = wkv[(size_t)(k + 2) * 512 + tid], w3 = wkv[(size_t)(k + 3) * 512 + tid];
#pragma unroll
            for (int i = 0; i < 32; ++i) { const f32x4 a = *(const LAS f32x4*)(kvn + i * 128 + k); acc[i] += a.x * w0 + a.y * w1 + a.z * w2 + a.w * w3; }
        }
        const int h = tid >> 7, dd = tid & 127;
        if (dd < 64) { bf16_t* KM = (bf16_t*)(p.ws + WS_KM) + ((size_t)(s0.b * 4 + h) * NKEYS + key0) * 96 + dd;
#pragma unroll
            for (int i = 0; i < 32; ++i) KM[(size_t)i * 96] = f2bf(acc[i]); }
        else { bf16_t* VT = (bf16_t*)(p.ws + WS_VTM) + ((size_t)(s0.b * 4 + h) * 64 + (dd - 64)) * NKEYS + key0;
#pragma unroll
            for (int i = 0; i < 32; ++i) VT[i] = f2bf(acc[i]); }
    }
    __syncthreads();
    bf16_t* MQ = (bf16_t*)(p.ws + WS_MQ);
    for (int e = tid; e < 32 * 384; e += 512) { const int tok = e / 384, c = e % 384, dd = c % 96; const int pos = s0.pos + tok;
        float v = qo[e];
        if (dd >= 64 && !s0.isctx) { const int pe = dd - 64, axis = pe >> 4, half = (pe >> 3) & 1, f = pe & 7; const int pp = axis == 0 ? (pos >> 6) : (pos & 63);
            const float cs = tabc[pp * 8 + f], sn = tabs[pp * 8 + f];
            const float x1 = half ? qo[e - 8] : v, x2 = half ? v : qo[e + 8];
            v = half ? (x2 * cs + x1 * sn) : (x1 * cs - x2 * sn); }
        MQ[(size_t)(t0 + tok) * 384 + c] = f2bf(v); }
    for (int e = tid; e < 32 * 32; e += 512) { const int tok = e >> 5, pe = e & 31, axis = pe >> 4, half = (pe >> 3) & 1, f = pe & 7; const int row = t0 + tok, pos = s0.pos + tok;
        float v = bf2f(P[(size_t)row * NP + PC_MLAKPE + pe]);
        if (!s0.isctx) { const int pp = axis == 0 ? (pos >> 6) : (pos & 63); const float cs = tabc[pp * 8 + f], sn = tabs[pp * 8 + f];
            const float other = bf2f(P[(size_t)row * NP + PC_MLAKPE + (half ? pe - 8 : pe + 8)]);
            const float x1 = half ? other : v, x2 = half ? v : other;
            v = half ? (x2 * cs + x1 * sn) : (x1 * cs - x2 * sn); }
        const bf16_t o = f2bf(v);
#pragma unroll
        for (int h = 0; h < 4; ++h) ((bf16_t*)(p.ws + WS_KM))[((size_t)(s0.b * 4 + h) * NKEYS + key0 + tok) * 96 + 64 + pe] = o; }
    __syncthreads();
}
__device__ __forceinline__ void ret_scan_item(const Params& p, int item) {
    const int tid = get_tid(); const int seq = item >> 1, dir = item & 1, h = seq & 3;
    const float lg = log1pf(-exp2f(-5.f - (float)h)); const float cdec = expf(128.f * lg);
    float* base = (float*)(p.ws + WS_RET) + (size_t)seq * 34 * 2 * 4096 + dir * 4096;
    float S[8];
#pragma unroll
    for (int i = 0; i < 8; ++i) S[i] = 0.f;
    for (int st = 0; st < 34; ++st) {
        const int ci = dir == 0 ? st : (st == 0 ? 1 : (st == 1 ? 0 : 35 - st));
        float* q = base + (size_t)ci * 2 * 4096 + tid * 8;
        const f32x4 t0 = *(const f32x4*)q, t1 = *(const f32x4*)(q + 4);
        *(f32x4*)q = (f32x4){S[0], S[1], S[2], S[3]}; *(f32x4*)(q + 4) = (f32x4){S[4], S[5], S[6], S[7]};
        S[0] = S[0] * cdec + t0.x; S[1] = S[1] * cdec + t0.y; S[2] = S[2] * cdec + t0.z; S[3] = S[3] * cdec + t0.w;
        S[4] = S[4] * cdec + t1.x; S[5] = S[5] * cdec + t1.y; S[6] = S[6] * cdec + t1.z; S[7] = S[7] * cdec + t1.w;
    }
}
__device__ __forceinline__ void phase_prepB(const Params& p, int l, LAS unsigned char* lds, int bid, int nb) {
    constexpr int N1 = TT / 32, N2 = 64;
    for (int it = bid; it < N1 + N2; it += nb) {
        if (it < N1) mla_proj_item(p, l, lds, it); else ret_scan_item(p, it - N1);
    }
}

__device__ __forceinline__ unsigned cvt_pk_bf16(float lo, float hi) { unsigned r; asm("v_cvt_pk_bf16_f32 %0, %1, %2" : "=v"(r) : "v"(lo), "v"(hi)); return r; }
template <int DK>
__device__ __forceinline__ void attn_unit(const bf16_t* Q, int qstride, const bf16_t* K, const bf16_t* Vt, int nctx, int mt0, int mt1, bool masked, int qpos0,
                                          bool has_sink, float sink, float scale, bf16_t* O, int ostride, LAS unsigned char* lds) {
    constexpr int KC = DK / 32, KP = DK + 8, KROW = KP * 2;
    constexpr int PIECES_K = 64 * DK / 8;
    const int tid = get_tid(), lane = tid & 63, wave = tid >> 6, fr = lane & 15, fq = lane >> 4;
    LAS unsigned char* Kt = lds;
    LAS unsigned char* Vl = lds + 64 * KROW;
    const float sl2 = scale * 1.44269504f;
    bf16x8 qf[KC];
#pragma unroll
    for (int kc = 0; kc < KC; ++kc) { const u32x4 u = *(const u32x4*)(Q + (size_t)(wave * 16 + fr) * qstride + kc * 32 + fq * 8); float f[8]; unpack8(u, f);
        u32x4 o; o.x = cvt_pk_bf16(f[0] * sl2, f[1] * sl2); o.y = cvt_pk_bf16(f[2] * sl2, f[3] * sl2); o.z = cvt_pk_bf16(f[4] * sl2, f[5] * sl2); o.w = cvt_pk_bf16(f[6] * sl2, f[7] * sl2);
        qf[kc] = __builtin_bit_cast(bf16x8, o); }
    float mq = 0.f, lsum = 0.f; f32x4 o[4];
#pragma unroll
    for (int n = 0; n < 4; ++n) o[n] = (f32x4){0.f, 0.f, 0.f, 0.f};
    const int ntiles = nctx + (mt1 - mt0);
    u32x4 kr[2], vr;
    auto issue = [&](int ti) {
        const int tile = ti < nctx ? ti : mt0 + (ti - nctx);
        const bf16_t* kb = K + (size_t)tile * 64 * DK;
#pragma unroll
        for (int i = 0; i < 2; ++i) { const int pc = tid + i * 512; if (pc < PIECES_K) kr[i] = *(const u32x4*)(kb + (size_t)pc * 8); }
        { const int d = tid >> 3, c8 = tid & 7; vr = *(const u32x4*)(Vt + (size_t)d * NKEYS + tile * 64 + c8 * 8); }
    };
    issue(0);
    for (int ti = 0; ti < ntiles; ++ti) {
        const int tile = ti < nctx ? ti : mt0 + (ti - nctx);
        __syncthreads();
#pragma unroll
        for (int i = 0; i < 2; ++i) { const int pc = tid + i * 512; if (pc < PIECES_K) { const int row = pc / (DK / 8), c8 = pc % (DK / 8); *(LAS u32x4*)(Kt + row * KROW + c8 * 16) = kr[i]; } }
        { const int d = tid >> 3, c8 = tid & 7; *(LAS u32x4*)(Vl + d * 144 + c8 * 16) = vr; }
        __syncthreads();
        if (ti + 1 < ntiles) issue(ti + 1);
        f32x4 s[4];
        const float init = -mq;
#pragma unroll
        for (int n = 0; n < 4; ++n) { s[n] = (f32x4){init, init, init, init};
#pragma unroll
            for (int kc = 0; kc < KC; ++kc) { const bf16x8 kf = *(const LAS bf16x8*)(Kt + (n * 16 + fr) * KROW + kc * 64 + fq * 16);
                s[n] = __builtin_amdgcn_mfma_f32_16x16x32_bf16(kf, qf[kc], s[n], 0, 0, 0); } }
        if (ti == 0) {
            float t = -INFINITY;
#pragma unroll
            for (int n = 0; n < 4; ++n)
#pragma unroll
                for (int r = 0; r < 4; ++r) t = fmaxf(t, s[n][r]);
            t = fmaxf(t, __shfl_xor(t, 16)); t = fmaxf(t, __shfl_xor(t, 32));
            if (has_sink) t = fmaxf(t, sink * 1.44269504f);
            mq = t;
#pragma unroll
            for (int n = 0; n < 4; ++n)
#pragma unroll
                for (int r = 0; r < 4; ++r) s[n][r] -= mq;
        }
        if (masked && ti >= nctx) {
#pragma unroll
            for (int n = 0; n < 4; ++n)
#pragma unroll
                for (int r = 0; r < 4; ++r) { const int kp = tile * 64 + n * 16 + fq * 4 + r - CTXL, qp = qpos0 + wave * 16 + fr; const int df = qp - kp; if (df > 128 || df < -128) s[n][r] = -INFINITY; }
        }
        float pe[4][4];
#pragma unroll
        for (int n = 0; n < 4; ++n)
#pragma unroll
            for (int r = 0; r < 4; ++r) { pe[n][r] = __builtin_amdgcn_exp2f(s[n][r]); lsum += pe[n][r]; }
#pragma unroll
        for (int c = 0; c < 2; ++c) {
            u32x4 pu; pu.x = cvt_pk_bf16(pe[2 * c][0], pe[2 * c][1]); pu.y = cvt_pk_bf16(pe[2 * c][2], pe[2 * c][3]); pu.z = cvt_pk_bf16(pe[2 * c + 1][0], pe[2 * c + 1][1]); pu.w = cvt_pk_bf16(pe[2 * c + 1][2], pe[2 * c + 1][3]);
            const bf16x8 pf = __builtin_bit_cast(bf16x8, pu);
#pragma unroll
            for (int n = 0; n < 4; ++n) {
                const u32x2 lo = *(const LAS u32x2*)(Vl + (n * 16 + fr) * 144 + ((2 * c) * 16 + fq * 4) * 2), hi = *(const LAS u32x2*)(Vl + (n * 16 + fr) * 144 + ((2 * c + 1) * 16 + fq * 4) * 2);
                const bf16x8 vf = __builtin_bit_cast(bf16x8, (u32x4){lo.x, lo.y, hi.x, hi.y});
                o[n] = __builtin_amdgcn_mfma_f32_16x16x32_bf16(vf, pf, o[n], 0, 0, 0); }
        }
    }
    {
        float t = lsum;
        t += __shfl_xor(t, 16); t += __shfl_xor(t, 32);
        if (has_sink) t += __builtin_amdgcn_exp2f(sink * 1.44269504f - mq);
        const float inv = 1.f / t;
#pragma unroll
        for (int n = 0; n < 4; ++n) { u32x2 ov; ov.x = cvt_pk_bf16(o[n][0] * inv, o[n][1] * inv); ov.y = cvt_pk_bf16(o[n][2] * inv, o[n][3] * inv);
            *(u32x2*)(O + (size_t)(wave * 16 + fr) * ostride + n * 16 + fq * 4) = ov; }
    }
    __syncthreads();
}

__device__ __forceinline__ void ret_out_item(const Params& p, int l, LAS unsigned char* lds, int item) {
    const int tid = get_tid();
    bf16_t* P = (bf16_t*)(p.ws + WS_P);
    const int cr = item >> 2, h = item & 3; int b; const int ci = ret_chunk_index(cr, b);
    const int r0 = cr * 128;
    const float lg = log1pf(-exp2f(-5.f - (float)h));
    LAS bf16_t* Kb = (LAS bf16_t*)lds;
    LAS float* Sf = (LAS float*)lds;
    LAS bf16_t* Qb = (LAS bf16_t*)(lds + 16384);
    LAS bf16_t* Vb = (LAS bf16_t*)(lds + 32768);
    LAS float* Am = (LAS float*)(lds + 49152);
    LAS float* dec = (LAS float*)(lds + 116736);
    LAS float* Sb = (LAS float*)(lds + 117760);
    for (int e = tid; e < 128 * 8; e += 512) { const int j = e >> 3, c8 = e & 7;
        const u32x4 kk = *(const u32x4*)(P + (size_t)(r0 + j) * NP + PC_RETK + h * 64 + c8 * 8);
        float kf[8]; unpack8(kk, kf);
        u32x4 ko; ko.x = pk2(kf[0] * 0.125f, kf[1] * 0.125f); ko.y = pk2(kf[2] * 0.125f, kf[3] * 0.125f); ko.z = pk2(kf[4] * 0.125f, kf[5] * 0.125f); ko.w = pk2(kf[6] * 0.125f, kf[7] * 0.125f);
        *(LAS u32x4*)(Kb + j * 64 + c8 * 8) = ko;
        *(LAS u32x4*)(Vb + j * 64 + c8 * 8) = *(const u32x4*)(P + (size_t)(r0 + j) * NP + PC_RETV + h * 64 + c8 * 8);
        *(LAS u32x4*)(Qb + j * 64 + c8 * 8) = *(const u32x4*)(P + (size_t)(r0 + j) * NP + PC_RETQ + h * 64 + c8 * 8); }
    if (tid < 129) dec[tid] = expf((float)tid * lg);
    const int i = tid >> 2, jq = tid & 3;
    __syncthreads();
#pragma unroll 1
    for (int hf = 0; hf < 4; ++hf) {
        float a[8];
#pragma unroll
        for (int jj = 0; jj < 8; ++jj) a[jj] = 0.f;
        const int jb = jq * 32 + hf * 8;
#pragma unroll 1
        for (int c8 = 0; c8 < 8; ++c8) {
            float q8[8]; unpack8(*(const LAS u32x4*)(Qb + i * 64 + c8 * 8), q8);
#pragma unroll
            for (int jj = 0; jj < 8; ++jj) { float k8[8]; unpack8(*(const LAS u32x4*)(Kb + (jb + jj) * 64 + c8 * 8), k8);
#pragma unroll
                for (int x = 0; x < 8; ++x) a[jj] += q8[x] * k8[x]; }
        }
#pragma unroll
        for (int jj = 0; jj < 8; ++jj) { const int j = jb + jj; const int df = i > j ? i - j : j - i;
            Am[i * 132 + j] = a[jj] * dec[df] * (i == j ? 2.f : 1.f); }
    }
    __syncthreads();
    { const float* RS = (const float*)(p.ws + WS_RET) + ((size_t)((b * 4 + h) * 34 + ci) * 2) * 4096;
      for (int e = tid; e < 4096; e += 512) { Sf[e] = RS[e]; Sb[e] = RS[4096 + e]; } }
    __syncthreads();
    const int e0 = jq * 16;
    float oacc[16];
#pragma unroll
    for (int e = 0; e < 16; ++e) oacc[e] = 0.f;
#pragma unroll 2
    for (int j = 0; j < 128; ++j) { const float a = Am[i * 132 + j];
        float v8[8];
        unpack8(*(const LAS u32x4*)(Vb + j * 64 + e0), v8);
#pragma unroll
        for (int x = 0; x < 8; ++x) oacc[x] += a * v8[x];
        unpack8(*(const LAS u32x4*)(Vb + j * 64 + e0 + 8), v8);
#pragma unroll
        for (int x = 0; x < 8; ++x) oacc[8 + x] += a * v8[x]; }
    const float gf = dec[i + 1], gb = dec[128 - i];
#pragma unroll 1
    for (int d8 = 0; d8 < 8; ++d8) {
        float q8[8]; unpack8(*(const LAS u32x4*)(Qb + i * 64 + d8 * 8), q8);
#pragma unroll
        for (int x = 0; x < 8; ++x) { const int d = d8 * 8 + x; const float qf = q8[x] * gf, qb = q8[x] * gb;
#pragma unroll
            for (int e4 = 0; e4 < 4; ++e4) { const f32x4 sf = *(const LAS f32x4*)(Sf + d * 64 + e0 + e4 * 4), sb = *(const LAS f32x4*)(Sb + d * 64 + e0 + e4 * 4);
                oacc[e4 * 4 + 0] += qf * sf.x + qb * sb.x; oacc[e4 * 4 + 1] += qf * sf.y + qb * sb.y; oacc[e4 * 4 + 2] += qf * sf.z + qb * sb.z; oacc[e4 * 4 + 3] += qf * sf.w + qb * sb.w; } }
    }
    float sm = 0.f;
#pragma unroll
    for (int e = 0; e < 16; ++e) sm += oacc[e];
    sm = red4(sm);
    const float mu = sm * (1.f / 64.f);
    float vs = 0.f;
#pragma unroll
    for (int e = 0; e < 16; ++e) { const float dlt = oacc[e] - mu; vs += dlt * dlt; }
    vs = red4(vs);
    const float rstd = 1.f / sqrtf(vs * (1.f / 64.f) + 1e-5f);
    const float* gn = p.in[13] + l * 256 + h * 64 + e0;
    const bf16_t* gp = P + (size_t)(r0 + i) * NP + PC_RETG + h * 64 + e0;
    bf16_t* yo = P + (size_t)(r0 + i) * NP + PC_RETQ + h * 64 + e0;
    float g16[16]; unpack8(*(const u32x4*)gp, g16); unpack8(*(const u32x4*)(gp + 8), g16 + 8);
    unsigned ow[8];
#pragma unroll
    for (int e = 0; e < 16; e += 2) { const float g0 = g16[e], g1 = g16[e + 1];
        const float y0 = (oacc[e] - mu) * rstd * gn[e] * (g0 / (1.f + __expf(-g0))), y1 = (oacc[e + 1] - mu) * rstd * gn[e + 1] * (g1 / (1.f + __expf(-g1)));
        ow[e >> 1] = pk2(y0, y1); }
    *(u32x4*)yo = (u32x4){ow[0], ow[1], ow[2], ow[3]}; *(u32x4*)(yo + 8) = (u32x4){ow[4], ow[5], ow[6], ow[7]};
    __syncthreads();
}

constexpr int NSCANBLK = 128;
__device__ __forceinline__ void rwkv_scan_item(const Params& p, int l, LAS unsigned char* lds, int item) {
    const int tid = get_tid();
    const int sc = item >> 1, half = item & 1;
    const int b = sc >> 3, h = (sc >> 1) & 3, dir = sc & 1;
    const bf16_t* RK = (const bf16_t*)(p.ws + WS_RWK); const bf16_t* RV = (const bf16_t*)(p.ws + WS_RWV); const bf16_t* RR = (const bf16_t*)(p.ws + WS_RWRR);
    const bf16_t* RA = (const bf16_t*)(p.ws + (dir ? WS_RWA1 : WS_RWA0)); const bf16_t* RM = (const bf16_t*)(p.ws + (dir ? WS_RWM1 : WS_RWM0));
    bf16_t* P = (bf16_t*)(p.ws + WS_P);
    const int ocol = (dir ? PC_RWO1 : PC_RWO0) + h * 64 + half * 32;
    LAS float* KH = (LAS float*)lds;
    LAS float* WW = KH + 4096; LAS float* BB = WW + 4096; LAS float* KT = BB + 4096; LAS float* RRl = KT + 4096; LAS float* VV = RRl + 4096; LAS float* OUT = VV + 4096;
    const int st = tid >> 3, c0 = (tid & 7) * 8;
    float kkp[8], kap[8];
#pragma unroll
    for (int i = 0; i < 8; ++i) { kkp[i] = p.in[20][l * 256 + h * 64 + c0 + i]; kap[i] = p.in[21][l * 256 + h * 64 + c0 + i]; }
    const int row_l = (tid >> 3) & 31, kq = tid & 7;
    const bool compute = tid < 256;
    f32x2 S[4];
#pragma unroll
    for (int i = 0; i < 4; ++i) S[i] = (f32x2){0.f, 0.f};
    auto row_of = [&](int s) -> int {
        if (s < CTXL) return TMAIN + b * CTXL + (dir ? CTXL - 1 - s : s);
        const int t = s - CTXL; return b * SEQL + (dir ? SEQL - 1 - t : t);
    };
    u32x4 gk, gv, gr, ga, gm;
    auto issue = [&](int ch) { const size_t o = (size_t)row_of(ch * 64 + st) * 256 + h * 64 + c0;
        gk = *(const u32x4*)(RK + o); gv = *(const u32x4*)(RV + o); gr = *(const u32x4*)(RR + o); ga = *(const u32x4*)(RA + o); gm = *(const u32x4*)(RM + o); };
    issue(0);
    for (int ch = 0; ch < 68; ++ch) {
        {
            float k[8], a[8], om[8], rr[8], vv8[8]; unpack8(gk, k); unpack8(ga, a); unpack8(gm, om); unpack8(gr, rr); unpack8(gv, vv8);
            float kk[8]; float n2 = 0.f;
#pragma unroll
            for (int i = 0; i < 8; ++i) { kk[i] = k[i] * kkp[i]; n2 += kk[i] * kk[i]; }
            n2 = red8(n2);
            const float rn = 1.f / sqrtf(fmaxf(n2, 1e-12f));
            f32x4 o0, o1;
#define ST8(DST, EXPR) { float t8[8]; _Pragma("unroll") for (int i = 0; i < 8; ++i) t8[i] = (EXPR); \
            *(LAS f32x4*)(DST + st * 64 + c0) = (f32x4){t8[0], t8[1], t8[2], t8[3]}; *(LAS f32x4*)(DST + st * 64 + c0 + 4) = (f32x4){t8[4], t8[5], t8[6], t8[7]}; }
            ST8(KH, kk[i] * rn)
            ST8(WW, 1.f - om[i])
            ST8(BB, kk[i] * rn * a[i])
            ST8(KT, k[i] * (1.f + (a[i] - 1.f) * kap[i]))
            ST8(RRl, rr[i])
            ST8(VV, vv8[i])
#undef ST8
        }
        __syncthreads();
        if (ch + 1 < 68) issue(ch + 1);
        if (compute) {
#pragma unroll 4
            for (int s = 0; s < 64; ++s) {
                const f32x4 kh0 = *(const LAS f32x4*)(KH + s * 64 + kq * 8), kh1 = *(const LAS f32x4*)(KH + s * 64 + kq * 8 + 4);
                const f32x4 w0 = *(const LAS f32x4*)(WW + s * 64 + kq * 8), w1 = *(const LAS f32x4*)(WW + s * 64 + kq * 8 + 4);
                const f32x4 b0 = *(const LAS f32x4*)(BB + s * 64 + kq * 8), b1 = *(const LAS f32x4*)(BB + s * 64 + kq * 8 + 4);
                const f32x4 t0 = *(const LAS f32x4*)(KT + s * 64 + kq * 8), t1 = *(const LAS f32x4*)(KT + s * 64 + kq * 8 + 4);
                const f32x4 r0 = *(const LAS f32x4*)(RRl + s * 64 + kq * 8), r1 = *(const LAS f32x4*)(RRl + s * 64 + kq * 8 + 4);
                const float vv = VV[s * 64 + half * 32 + row_l];
                f32x2 a2 = S[0] * (f32x2){kh0.x, kh0.y};
                a2 = S[1] * (f32x2){kh0.z, kh0.w} + a2; a2 = S[2] * (f32x2){kh1.x, kh1.y} + a2; a2 = S[3] * (f32x2){kh1.z, kh1.w} + a2;
                const float sk = red8(a2.x + a2.y);
                const f32x2 nsk = (f32x2){-sk, -sk}, vv2 = (f32x2){vv, vv};
                S[0] = S[0] * (f32x2){w0.x, w0.y} + (nsk * (f32x2){b0.x, b0.y} + vv2 * (f32x2){t0.x, t0.y});
                S[1] = S[1] * (f32x2){w0.z, w0.w} + (nsk * (f32x2){b0.z, b0.w} + vv2 * (f32x2){t0.z, t0.w});
                S[2] = S[2] * (f32x2){w1.x, w1.y} + (nsk * (f32x2){b1.x, b1.y} + vv2 * (f32x2){t1.x, t1.y});
                S[3] = S[3] * (f32x2){w1.z, w1.w} + (nsk * (f32x2){b1.z, b1.w} + vv2 * (f32x2){t1.z, t1.w});
                f32x2 o2 = S[0] * (f32x2){r0.x, r0.y};
                o2 = S[1] * (f32x2){r0.z, r0.w} + o2; o2 = S[2] * (f32x2){r1.x, r1.y} + o2; o2 = S[3] * (f32x2){r1.z, r1.w} + o2;
                const float ov = red8(o2.x + o2.y);
                if (kq == 0) OUT[s * 32 + row_l] = ov;
            }
        }
        __syncthreads();
        { const int c4 = (tid & 7) * 4; const f32x4 ov = *(const LAS f32x4*)(OUT + st * 32 + c4);
          u32x2 o2; o2.x = pk2(ov.x, ov.y); o2.y = pk2(ov.z, ov.w);
          *(u32x2*)(P + (size_t)row_of(ch * 64 + st) * NP + ocol + c4) = o2; }
    }
    __syncthreads();
}

__device__ __forceinline__ void phase_mixers(const Params& p, int l, LAS unsigned char* lds, int bid, int nb) {
    const bool ectx = (l == 0);
    bf16_t* P = (bf16_t*)(p.ws + WS_P);
    const int NSCAN = NSCANBLK;
#ifndef DIS_SCAN
    if (bid < NSCAN) { rwkv_scan_item(p, l, lds, bid); return; }
#endif
    const int N_MLA = 1024 + (ectx ? 64 : 0), N_SWA = 1024 + (ectx ? 64 : 0), N_RET = 1024 + (ectx ? 64 : 0);
    for (int it = bid - NSCAN; it < N_MLA + N_SWA + N_RET; it += nb - NSCAN) {
        if (it < N_MLA) {
#ifndef DIS_MLA
            const bf16_t* MQ = (const bf16_t*)(p.ws + WS_MQ);
            if (it < 1024) { const int b = it >> 7, h = (it >> 5) & 3, qb = it & 31; const int row0 = b * SEQL + qb * 128;
                attn_unit<96>(MQ + (size_t)row0 * 384 + h * 96, 384, (const bf16_t*)(p.ws + WS_KM) + (size_t)(b * 4 + h) * NKEYS * 96, (const bf16_t*)(p.ws + WS_VTM) + (size_t)(b * 4 + h) * 64 * NKEYS,
                              4, 4, 68, false, 0, false, 0.f, 0.10206207f, P + (size_t)row0 * NP + PC_MLAQD + h * 64, NP, lds); }
            else { const int u = it - 1024, b = u >> 3, h = (u >> 1) & 3, qb = u & 1; const int row0 = TMAIN + b * CTXL + qb * 128;
                attn_unit<96>(MQ + (size_t)row0 * 384 + h * 96, 384, (const bf16_t*)(p.ws + WS_KM) + (size_t)(b * 4 + h) * NKEYS * 96, (const bf16_t*)(p.ws + WS_VTM) + (size_t)(b * 4 + h) * 64 * NKEYS,
                              4, 4, 4, false, 0, false, 0.f, 0.10206207f, P + (size_t)row0 * NP + PC_MLAQD + h * 64, NP, lds); }
#endif
        } else if (it < N_MLA + N_SWA) {
#ifndef DIS_SWA
            const int u0 = it - N_MLA;
            if (u0 < 1024) { const int b = u0 >> 7, h = (u0 >> 5) & 3, qb = u0 & 31, hk = h >> 1; const int row0 = b * SEQL + qb * 128;
                int mt0 = 4 + 2 * (qb - 1), mt1 = 4 + 2 * (qb + 2); if (mt0 < 4) mt0 = 4; if (mt1 > 68) mt1 = 68;
                bf16_t* qp = P + (size_t)row0 * NP + PC_SWAQ + h * 64;
                attn_unit<64>(qp, NP, (const bf16_t*)(p.ws + WS_KS) + (size_t)(b * 2 + hk) * NKEYS * 64, (const bf16_t*)(p.ws + WS_VTS) + (size_t)(b * 2 + hk) * 64 * NKEYS,
                              4, mt0, mt1, true, qb * 128, true, p.in[12][l * 4 + h], 0.125f, qp, NP, lds); }
            else { const int u = u0 - 1024, b = u >> 3, h = (u >> 1) & 3, qb = u & 1, hk = h >> 1; const int row0 = TMAIN + b * CTXL + qb * 128;
                bf16_t* qp = P + (size_t)row0 * NP + PC_SWAQ + h * 64;
                attn_unit<64>(qp, NP, (const bf16_t*)(p.ws + WS_KS) + (size_t)(b * 2 + hk) * NKEYS * 64, (const bf16_t*)(p.ws + WS_VTS) + (size_t)(b * 2 + hk) * 64 * NKEYS,
                              4, 4, 4, false, 0, true, p.in[12][l * 4 + h], 0.125f, qp, NP, lds); }
#endif
        } else {
#ifndef DIS_RET
            ret_out_item(p, l, lds, it - N_MLA - N_SWA);
#endif
        }
    }
}

__device__ __forceinline__ void phase_rwkv_finish(const Params& p, int l, LAS unsigned char* lds, int bid, int nb) {
    const int tid = get_tid();
    bf16_t* P = (bf16_t*)(p.ws + WS_P);
    const int ntiles = (l == 0 ? TT : TMAIN) / 32;
    const float* mu = p.in[14] + l * 1024 + 896;
    const float* gup = p.in[19] + (size_t)l * 128 * 256;
    const bf16_t* RV = (const bf16_t*)(p.ws + WS_RWV); const float* BON = (const float*)(p.ws + WS_BON);
    LAS float* sg = (LAS float*)lds;
    for (int tile = bid; tile < ntiles; tile += nb) {
        const int t0 = tile * 32; const SeqInfo s0 = seq_of_row(t0);
        { const int tok = tid >> 4, j8 = (tid & 15) * 8; const int row = t0 + tok, pos = s0.pos + tok;
          const u32x4 u0 = *(const u32x4*)(P + (size_t)row * NP + PC_RWGD + j8);
          const u32x4 um = pos > 0 ? *(const u32x4*)(P + (size_t)(row - 1) * NP + PC_RWGD + j8) : (u32x4){0u, 0u, 0u, 0u};
          const u32x4 up = pos < s0.len - 1 ? *(const u32x4*)(P + (size_t)(row + 1) * NP + PC_RWGD + j8) : (u32x4){0u, 0u, 0u, 0u};
          float z0[8], zm[8], zp[8]; unpack8(u0, z0); unpack8(um, zm); unpack8(up, zp);
#pragma unroll
          for (int x = 0; x < 8; ++x) sg[tok * 128 + j8 + x] = sigmoidf_(z0[x] + mu[j8 + x] * (0.5f * (zm[x] + zp[x]) - z0[x])); }
        __syncthreads();
        const int hh = tid >> 8, c = tid & 255, h = c >> 6;
        float g[16];
#pragma unroll
        for (int i = 0; i < 16; ++i) g[i] = 0.f;
#pragma unroll 8
        for (int j = 0; j < 128; ++j) { const float w = gup[j * 256 + c];
#pragma unroll
            for (int i = 0; i < 16; ++i) g[i] += sg[(hh * 16 + i) * 128 + j] * w; }
        const float gn = p.in[23][l * 256 + c];
        float ov[16], rv[16], bn[16];
#pragma unroll
        for (int i = 0; i < 16; ++i) { const int row = t0 + hh * 16 + i;
            ov[i] = bf2f(P[(size_t)row * NP + PC_RWO0 + c]) + bf2f(P[(size_t)row * NP + PC_RWO1 + c]); rv[i] = bf2f(RV[(size_t)row * 256 + c]); bn[i] = BON[(size_t)row * 4 + h]; }
#pragma unroll
        for (int i = 0; i < 16; ++i) { const int row = t0 + hh * 16 + i;
            const float o = ov[i];
            const float mean = wave_sum(o) * (1.f / 64.f); const float dl = o - mean; const float var = wave_sum(dl * dl) * (1.f / 64.f);
            float y = dl * (1.f / sqrtf(var + 64e-5f)) * gn + bn[i] * rv[i];
            P[(size_t)row * NP + PC_RWO1 + c] = f2bf(y * g[i]); }
        __syncthreads();
    }
}

#ifndef N_LAUNCH_MODE
#define N_LAUNCH_MODE 1
#endif
template <int Q>
__device__ __forceinline__ void layer_phase(const Params& p, int l, LAS unsigned char* lds, int bid, int nb) {
    unsigned char* wb = p.ws + WS_WB + (size_t)l * WB_LAYER;
    const int Mrows = (l == 0) ? TT : TMAIN;
    pg8::StaticOrder S;
    if constexpr (Q == 0) { pg8::Gemm g{(const bf16_t*)(p.ws + WS_HB), (const bf16_t*)(wb + WB_IN), TT, NP, DM, DM}; S.init(TT, NP, nb, bid);
              pg8::EpiBf16<0> E{(bf16_t*)(p.ws + WS_P), NP}; pg8::gemm_phase(lds, g, S, E); }
    if constexpr (Q == 1) phase_prepA(p, l, lds, bid, nb);
    if constexpr (Q == 2) phase_prepB(p, l, lds, bid, nb);
    if constexpr (Q == 3) phase_mixers(p, l, lds, bid, nb);
    if constexpr (Q == 4) phase_rwkv_finish(p, l, lds, bid, nb);
    if constexpr (Q == 5) { pg8::Gemm g{(const bf16_t*)(p.ws + WS_P), (const bf16_t*)(wb + WB_OUT), Mrows, DM, DM, NP}; S.init(Mrows, DM, nb, bid);
              pg8::EpiBf16<0> E{(bf16_t*)(p.ws + WS_Z), DM}; pg8::gemm_phase(lds, g, S, E); }
    if constexpr (Q == 6) phase_rowops(p, 1, l, Mrows, bid, nb);
    if constexpr (Q == 7) { pg8::Gemm g{(const bf16_t*)(p.ws + WS_HB), (const bf16_t*)(wb + WB_W1), Mrows, FF, DM, DM}; S.init(Mrows, FF, nb, bid);
              pg8::EpiBf16<1> E{(bf16_t*)(p.ws + WS_HID), FF}; pg8::gemm_phase(lds, g, S, E); }
    if constexpr (Q == 8) { pg8::Gemm g{(const bf16_t*)(p.ws + WS_HID), (const bf16_t*)(wb + WB_W2), Mrows, DM, FF, FF}; S.init(Mrows, DM, nb, bid);
              pg8::EpiBf16<0> E{(bf16_t*)(p.ws + WS_Z), DM}; pg8::gemm_phase(lds, g, S, E); }
    if constexpr (Q == 9) phase_rowops(p, 2, l, Mrows, bid, nb);
}

#ifndef PROBE_MASK
#define PROBE_MASK 0
#endif
#define PB(BIT, CALL) do { if ((PROBE_MASK) & (BIT)) { const unsigned long long t0_ = __builtin_amdgcn_s_memrealtime(); CALL; const unsigned long long t1_ = __builtin_amdgcn_s_memrealtime(); \
        while (__builtin_amdgcn_s_memrealtime() - t1_ < (t1_ - t0_)) __builtin_amdgcn_s_sleep(8); } else { CALL; } } while (0)
#define GSYNC() do { asm volatile("s_waitcnt vmcnt(0) lgkmcnt(0)" ::: "memory"); __syncthreads(); if (get_tid() < 64) __threadfence(); grid.sync(); if (get_tid() < 64) __threadfence(); __syncthreads(); } while (0)
__global__ void __launch_bounds__(512, 2) mega_fwd(Params p) {
    extern __shared__ __attribute__((aligned(16))) unsigned char lds_raw[];
    LAS unsigned char* lds = (LAS unsigned char*)lds_raw;
    cg::grid_group grid = cg::this_grid();
    const int bid = blockIdx.x, nb = gridDim.x;
    PB(16, phase_prologue(p, lds, bid, nb)); GSYNC();
    PB(8, phase_rowops(p, 0, 0, TT, bid, nb)); GSYNC();
#define LAYER(L, LAST) \
    PB(1, layer_phase<0>(p, L, lds, bid, nb)); GSYNC(); PB(4, layer_phase<1>(p, L, lds, bid, nb)); GSYNC(); PB(4, layer_phase<2>(p, L, lds, bid, nb)); GSYNC(); \
    PB(2, layer_phase<3>(p, L, lds, bid, nb)); GSYNC(); PB(4, layer_phase<4>(p, L, lds, bid, nb)); GSYNC(); PB(1, layer_phase<5>(p, L, lds, bid, nb)); GSYNC(); \
    PB(8, layer_phase<6>(p, L, lds, bid, nb)); GSYNC(); PB(1, layer_phase<7>(p, L, lds, bid, nb)); GSYNC(); PB(1, layer_phase<8>(p, L, lds, bid, nb)); GSYNC(); \
    PB(8, layer_phase<9>(p, L, lds, bid, nb)); if (!(LAST)) GSYNC();
    LAYER(0, false)
    LAYER(1, true)
}
#if N_LAUNCH_MODE != 1
template <int PH> __global__ void __launch_bounds__(512, 2) one_phase(Params p, int l) {
    extern __shared__ __attribute__((aligned(16))) unsigned char lds_raw[];
    LAS unsigned char* lds = (LAS unsigned char*)lds_raw;
    if constexpr (PH == 100) phase_prologue(p, lds, blockIdx.x, gridDim.x);
    else if constexpr (PH == 101) phase_rowops(p, 0, 0, TT, blockIdx.x, gridDim.x);
    else layer_phase<PH>(p, l, lds, blockIdx.x, gridDim.x);
}
#endif

extern "C" void kernel_launch(void* const* d_in, const int* in_sizes, int n_in, void* d_out, int out_size, void* d_ws, size_t ws_size, hipStream_t stream) {
    if (n_in != 30 || ws_size < WS_NEED || out_size != TMAIN * DM) { fprintf(stderr, "kernel_launch: unexpected shapes (n_in %d, ws %zu, out %d)\n", n_in, ws_size, out_size); return; }
    Params p{};
    for (int i = 0; i < 30; ++i) p.in[i] = (const float*)d_in[i];
    p.out = (float*)d_out; p.ws = (unsigned char*)d_ws;
    static int grid_blocks = 0;
    if (!grid_blocks) {
        int dev = 0, cus = 0, per_cu = 0;
        (void)hipGetDevice(&dev);
        (void)hipDeviceGetAttribute(&cus, hipDeviceAttributeMultiprocessorCount, dev);
        (void)hipFuncSetAttribute((const void*)mega_fwd, hipFuncAttributeMaxDynamicSharedMemorySize, LDS_BYTES);
        (void)hipOccupancyMaxActiveBlocksPerMultiprocessor(&per_cu, mega_fwd, 512, LDS_BYTES);
        if (per_cu < 1) { fprintf(stderr, "kernel_launch: occupancy query says %d blocks/CU\n", per_cu); per_cu = 1; }
        grid_blocks = cus * 1;
        if (grid_blocks < 128) { fprintf(stderr, "kernel_launch: only %d CUs\n", grid_blocks); }
    }
#if N_LAUNCH_MODE == 1
    void* args[] = {&p};
    hipError_t e = hipLaunchCooperativeKernel((const void*)mega_fwd, dim3(grid_blocks), dim3(512), args, LDS_BYTES, stream);
    if (e != hipSuccess) fprintf(stderr, "cooperative launch failed: %s (grid %d)\n", hipGetErrorString(e), grid_blocks);
#else
#define LP(PH, L) do { (void)hipFuncSetAttribute((const void*)one_phase<PH>, hipFuncAttributeMaxDynamicSharedMemorySize, LDS_BYTES); one_phase<PH><<<grid_blocks, 512, LDS_BYTES, stream>>>(p, L); } while (0)
    LP(100, 0); LP(101, 0);
    for (int l = 0; l < 2; ++l) { LP(0, l); LP(1, l); LP(2, l); LP(3, l); LP(4, l); LP(5, l); LP(6, l); LP(7, l); LP(8, l); LP(9, l); }
#endif
}
```

```cpp
#include <hip/hip_runtime.h>
#include <hip/hip_cooperative_groups.h>
#include <cstdio>
#include <cstdint>
#include <cmath>
namespace cg = cooperative_groups;
__device__ __forceinline__ int get_tid() { int t = threadIdx.x; asm volatile("" : "+v"(t)); return t; }
namespace pg8 {
#define PG8_LAS __attribute__((address_space(3)))
typedef unsigned short bf16_t;
typedef short bf16x8 __attribute__((ext_vector_type(8)));
typedef float f32x4 __attribute__((ext_vector_type(4)));
typedef unsigned u32x4 __attribute__((ext_vector_type(4)));
typedef unsigned u32x2 __attribute__((ext_vector_type(2)));
constexpr int BM = 256, BK = 64, HALF = 128, HTB = HALF * BK * 2, STAGE_BYTES = 8 * HTB, NXCD = 8, WGM = 8;

__host__ __device__ __forceinline__ int lds_byte(int r, int c) { const int st = (r >> 4) * 2 + (c >> 5), rr = r & 15, cc = c & 31, ob = rr * 64 + cc * 2; return st * 1024 + (ob ^ (((ob >> 9) & 1) << 5)); }
__host__ __device__ __forceinline__ void stage_rc(int b, int& R, int& C) { const int st = b / 1024, sb = b % 1024, swz = sb ^ (((sb >> 9) & 1) << 5); R = (st >> 1) * 16 + swz / 64; C = (st & 1) * 32 + (swz % 64) / 2; }

struct Unit { int pm, pn; };
struct Gemm { const bf16_t* A; const bf16_t* Bt; int M, N, K, lda; };

struct StaticOrder {
    int nM, nN, nwg, G, c;
    __host__ __device__ void init(int M, int N, int G_, int c_) { nM = M / BM; nN = N / BM; nwg = nM * nN; G = G_; c = c_; }
    __host__ __device__ bool next(int i, Unit& u) const {
        const long L = (long)i * G + c; if (L >= nwg) return false;
        int wgid = (int)L; { const int q = nwg / NXCD, r = nwg % NXCD, xcd = wgid % NXCD, off = wgid / NXCD; wgid = (xcd < r ? xcd * (q + 1) : r * (q + 1) + (xcd - r) * q) + off; }
        const int nig = WGM * nN, gid = wgid / nig, fm = gid * WGM, gsz = (nM - fm) < WGM ? (nM - fm) : WGM;
        u.pm = fm + ((wgid % nig) % gsz); u.pn = (wgid % nig) / gsz; return true;
    }
};

template <class Epi>
__device__ __forceinline__ void gemm_phase(PG8_LAS unsigned char* lds, const Gemm g, const StaticOrder& S, const Epi& E) {
    const int tid = get_tid(), wid = __builtin_amdgcn_readfirstlane(tid >> 6), lane = tid & 63, wr = wid >> 2, wc = wid & 3, fr = lane & 15, fq = lane >> 4;
    const int K = g.K, nt = K / BK, lda = g.lda;
    unsigned voffA[2], voffB[2];
#pragma unroll
    for (int i = 0; i < 2; ++i) { int R, C; stage_rc(tid * 16 + i * 8192, R, C);
        voffA[i] = (unsigned)(R * lda + C) * 2u; voffB[i] = (unsigned)(R * K + C) * 2u; }
    const size_t kstep = (size_t)(BK * 2);
    const size_t hstepA = (size_t)HALF * lda * 2, hstepB = (size_t)HALF * K * 2;
    const size_t tstepA = 2 * hstepA, tstepB = 2 * hstepB;
    const unsigned ldsw = (unsigned)wid * 1024u;
    const int aoff = lds_byte(wr * 64 + fr, fq * 8), boff = lds_byte(wc * 32 + fr, fq * 8);
#define PG8_SA(b, h) (((b) * 2 + (h)) * HTB)
#define PG8_SB(b, h) ((4 + (b) * 2 + (h)) * HTB)
#define PG8_STAGE(bufoff, gbase, voff) do { _Pragma("unroll") for (int _i = 0; _i < 2; ++_i) \
        __builtin_amdgcn_global_load_lds((const unsigned*)((const char*)(gbase) + (voff)[_i]), (PG8_LAS unsigned*)(lds + (bufoff) + ldsw + _i * 8192), 16, 0, 0); } while (0)
#define PG8_LDA(dst, b, h) do { _Pragma("unroll") for (int m = 0; m < 4; ++m) _Pragma("unroll") for (int k = 0; k < 2; ++k) dst[m][k] = *(const PG8_LAS bf16x8*)(lds + PG8_SA(b, h) + aoff + m * 2048 + k * 1024); } while (0)
#define PG8_LDB(dst, b, h) do { _Pragma("unroll") for (int n = 0; n < 2; ++n) _Pragma("unroll") for (int k = 0; k < 2; ++k) dst[n][k] = *(const PG8_LAS bf16x8*)(lds + PG8_SB(b, h) + boff + n * 2048 + k * 1024); } while (0)
#define PG8_MMA(ai, bj, At, Bt) do { __builtin_amdgcn_s_setprio(1); _Pragma("unroll") for (int m = 0; m < 4; ++m) _Pragma("unroll") for (int n = 0; n < 2; ++n) _Pragma("unroll") for (int k = 0; k < 2; ++k) \
        acc[ai][bj][m][n] = __builtin_amdgcn_mfma_f32_16x16x32_bf16(Bt[n][k], At[m][k], acc[ai][bj][m][n], 0, 0, 0); __builtin_amdgcn_s_setprio(0); } while (0)
#define PG8_WAIT_V(n) asm volatile("s_waitcnt vmcnt(" #n ")" ::: "memory")
#define PG8_WAIT_L(n) asm volatile("s_waitcnt lgkmcnt(" #n ")" ::: "memory")
#define PG8_BAR __builtin_amdgcn_s_barrier()
#define PG8_SCHED __builtin_amdgcn_sched_barrier(0)
    Unit cur, nxt; int ui = 0;
    if (!S.next(0, cur)) return;
    f32x4 acc[2][2][4][2];
#pragma unroll
    for (int a = 0; a < 2; ++a)
#pragma unroll
        for (int b = 0; b < 2; ++b)
#pragma unroll
            for (int m = 0; m < 4; ++m)
#pragma unroll
                for (int n = 0; n < 2; ++n) acc[a][b][m][n] = (f32x4){0.f, 0.f, 0.f, 0.f};
    bf16x8 At[4][2], B0[2][2], B1[2][2];
    const char* cA = (const char*)g.A + (size_t)cur.pm * tstepA; const char* cB = (const char*)g.Bt + (size_t)cur.pn * tstepB;
    PG8_STAGE(PG8_SB(0, 0), cB, voffB); PG8_STAGE(PG8_SA(0, 0), cA, voffA); PG8_STAGE(PG8_SB(0, 1), cB + hstepB, voffB); PG8_STAGE(PG8_SA(0, 1), cA + hstepA, voffA);
    if (wr == 1) PG8_BAR;
    PG8_WAIT_V(4); PG8_BAR;
    PG8_STAGE(PG8_SB(1, 0), cB + kstep, voffB); PG8_STAGE(PG8_SA(1, 0), cA + kstep, voffA); PG8_STAGE(PG8_SB(1, 1), cB + hstepB + kstep, voffB);
    PG8_WAIT_V(6); PG8_BAR;
    for (;;) {
        const bool has_next = S.next(ui + 1, nxt);
        const char* nA = has_next ? (const char*)g.A + (size_t)nxt.pm * tstepA : cA; const char* nB = has_next ? (const char*)g.Bt + (size_t)nxt.pn * tstepB : cB;
        for (int t = 0; t < nt; t += 2) {
            const bool last = (t == nt - 2);
            const char* a1 = cA + (size_t)(t + 1) * kstep;
            const char* a2 = last ? nA : cA + (size_t)(t + 2) * kstep; const char* b2 = last ? nB : cB + (size_t)(t + 2) * kstep;
            const char* a3 = a2 + kstep; const char* b3 = b2 + kstep;
            PG8_LDB(B0, 0, 0); PG8_SCHED; PG8_LDA(At, 0, 0); PG8_STAGE(PG8_SA(1, 1), a1 + hstepA, voffA);
            PG8_WAIT_L(8); PG8_BAR; PG8_WAIT_L(0); PG8_MMA(0, 0, At, B0); PG8_BAR; PG8_SCHED;
            PG8_LDB(B1, 0, 1); PG8_STAGE(PG8_SB(0, 0), b2, voffB);
            PG8_BAR; PG8_WAIT_L(0); PG8_MMA(0, 1, At, B1); PG8_BAR;
            PG8_LDA(At, 0, 1); PG8_STAGE(PG8_SA(0, 0), a2, voffA);
            PG8_BAR; PG8_WAIT_L(0); PG8_MMA(1, 0, At, B0); PG8_BAR; PG8_SCHED;
            PG8_STAGE(PG8_SB(0, 1), b2 + hstepB, voffB);
            PG8_WAIT_V(6); PG8_BAR; PG8_MMA(1, 1, At, B1); PG8_BAR;
            PG8_LDB(B0, 1, 0); PG8_SCHED; PG8_LDA(At, 1, 0); PG8_STAGE(PG8_SA(0, 1), a2 + hstepA, voffA);
            PG8_WAIT_L(8); PG8_BAR; PG8_WAIT_L(0); PG8_MMA(0, 0, At, B0); PG8_BAR; PG8_SCHED;
            PG8_LDB(B1, 1, 1); PG8_STAGE(PG8_SB(1, 0), b3, voffB);
            PG8_BAR; PG8_WAIT_L(0); PG8_MMA(0, 1, At, B1); PG8_BAR;
            PG8_LDA(At, 1, 1); PG8_STAGE(PG8_SA(1, 0), a3, voffA);
            PG8_BAR; PG8_WAIT_L(0); PG8_MMA(1, 0, At, B0); PG8_BAR; PG8_SCHED;
            PG8_STAGE(PG8_SB(1, 1), b3 + hstepB, voffB);
            PG8_WAIT_V(6); PG8_BAR; PG8_MMA(1, 1, At, B1); PG8_BAR;
        }
        E(acc, cur, wr, wc, fr, fq);
        if (!has_next) break;
#pragma unroll
        for (int a = 0; a < 2; ++a)
#pragma unroll
            for (int b = 0; b < 2; ++b)
#pragma unroll
                for (int m = 0; m < 4; ++m)
#pragma unroll
                    for (int n = 0; n < 2; ++n) acc[a][b][m][n] = (f32x4){0.f, 0.f, 0.f, 0.f};
        cur = nxt; cA = nA; cB = nB; ++ui;
    }
    PG8_WAIT_V(0);
    if (wr == 0) PG8_BAR;
    PG8_BAR;
#undef PG8_SA
#undef PG8_SB
#undef PG8_STAGE
#undef PG8_LDA
#undef PG8_LDB
#undef PG8_MMA
#undef PG8_WAIT_V
#undef PG8_WAIT_L
#undef PG8_BAR
#undef PG8_SCHED
}

__device__ __forceinline__ unsigned f2bf_u(float f) { unsigned u = __builtin_bit_cast(unsigned, f); return (u + 0x7fffu + ((u >> 16) & 1u)) >> 16; }
template <int ACT> struct EpiBf16 {
    bf16_t* O; int ldc;
    __device__ __forceinline__ void operator()(const f32x4 (&acc)[2][2][4][2], const Unit& u, int wr, int wc, int fr, int fq) const {
        const int row0 = u.pm * BM + wr * 64 + fr, col0 = u.pn * BM + wc * 32 + 4 * fq;
#pragma unroll
        for (int ai = 0; ai < 2; ++ai)
#pragma unroll
            for (int m = 0; m < 4; ++m) { bf16_t* rowp = O + (size_t)(row0 + ai * HALF + m * 16) * ldc + col0;
#pragma unroll
                for (int bj = 0; bj < 2; ++bj)
#pragma unroll
                    for (int n = 0; n < 2; ++n) { f32x4 v = acc[ai][bj][m][n];
                        if (ACT == 1) { v.x = v.x > 0.f ? v.x * v.x : 0.f; v.y = v.y > 0.f ? v.y * v.y : 0.f; v.z = v.z > 0.f ? v.z * v.z : 0.f; v.w = v.w > 0.f ? v.w * v.w : 0.f; }
                        u32x2 o; o.x = f2bf_u(v.x) | (f2bf_u(v.y) << 16); o.y = f2bf_u(v.z) | (f2bf_u(v.w) << 16);
                        *(u32x2*)(rowp + bj * HALF + n * 16) = o; } }
    }
};
}
typedef unsigned short bf16_t;
typedef short bf16x8 __attribute__((ext_vector_type(8)));
typedef float f32x4 __attribute__((ext_vector_type(4)));
typedef unsigned u32x4 __attribute__((ext_vector_type(4)));
typedef unsigned u32x2 __attribute__((ext_vector_type(2)));
#define LAS __attribute__((address_space(3)))

constexpr int NBATCH = 8, SEQL = 4096, DM = 1024, CTXL = 256, TMAIN = 32768, TCTX = 2048, TT = 34816, NP = 3072, FF = 4096;
constexpr int PC_SWAQ = 0, PC_RETQ = 256, PC_RWR = 512, PC_MLAQD = 768, PC_SWAK = 1024, PC_SWAV = 1152, PC_RETK = 1280, PC_RETV = 1536, PC_RETG = 1792,
              PC_RWK = 2048, PC_RWV = 2304, PC_RWWD = 2560, PC_RWAD = 2624, PC_RWGD = 2688, PC_MLAKVD = 2816, PC_MLAKPE = 2944;
constexpr int PC_RWO0 = PC_RWV, PC_RWO1 = PC_RWR;
constexpr int NKEYS = CTXL + SEQL;

constexpr size_t MiB = 1u << 20;
constexpr size_t WS_MOD = 0;
constexpr size_t WS_TAB = 512 * 1024;
constexpr size_t WS_BON = 1 * MiB;
constexpr size_t WS_WB = 2 * MiB;
constexpr size_t WB_LAYER = 24 * MiB, WB_IN = 0, WB_OUT = 6 * MiB, WB_W1 = 8 * MiB, WB_W2 = 16 * MiB;
constexpr size_t WS_XC = 50 * MiB;
constexpr size_t WS_P = 58 * MiB;
constexpr size_t WS_HID = 58 * MiB;
constexpr size_t WS_A = 262 * MiB;
constexpr size_t ARR17 = 17 * MiB;
constexpr size_t WS_RWK = WS_A, WS_RWV = WS_A + ARR17, WS_RWRR = WS_A + 2 * ARR17, WS_RWA0 = WS_A + 3 * ARR17, WS_RWA1 = WS_A + 4 * ARR17,
                 WS_RWM0 = WS_A + 5 * ARR17, WS_RWM1 = WS_A + 6 * ARR17;
constexpr size_t WS_RET = WS_A + 119 * MiB;
constexpr size_t WS_MQ = WS_RET + 34 * MiB;
constexpr size_t WS_KM = WS_MQ + 26738688;
constexpr size_t WS_VTM = WS_KM + 26738688;
constexpr size_t WS_KS = WS_VTM + ARR17;
constexpr size_t WS_VTS = WS_KS + 8912896;
constexpr size_t WS_A_END = WS_VTS + 8912896;
constexpr size_t WS_Z = 330 * MiB;
constexpr size_t WS_HB = 398 * MiB;
constexpr size_t WS_NEED = 500 * MiB;
static_assert(WS_A_END <= WS_NEED && WS_HB + 68 * MiB <= WS_NEED && WS_HID + 272 * MiB <= WS_Z, "ws map");

constexpr int LDS_BYTES = 150 * 1024;

struct Params { const float* in[30]; float* out; unsigned char* ws; };

__device__ __forceinline__ float bf2f(bf16_t v) { return __builtin_bit_cast(float, (unsigned)v << 16); }
__device__ __forceinline__ bf16_t f2bf(float f) { unsigned u = __builtin_bit_cast(unsigned, f); return (bf16_t)((u + 0x7fffu + ((u >> 16) & 1u)) >> 16); }
__device__ __forceinline__ unsigned pk2(float lo, float hi) { return (unsigned)f2bf(lo) | ((unsigned)f2bf(hi) << 16); }
typedef float f32x2 __attribute__((ext_vector_type(2)));
template <int CTRL> __device__ __forceinline__ float dppf(float v) { return __builtin_bit_cast(float, __builtin_amdgcn_update_dpp(0, __builtin_bit_cast(int, v), CTRL, 0xF, 0xF, true)); }
__device__ __forceinline__ float red4(float v) { v += dppf<0xB1>(v); v += dppf<0x4E>(v); return v; }
__device__ __forceinline__ float red8(float v) { v = red4(v); v += dppf<0x141>(v); return v; }
__device__ __forceinline__ float red16(float v) { v = red8(v); v += dppf<0x140>(v); return v; }
__device__ __forceinline__ float max16(float v) { v = fmaxf(v, dppf<0xB1>(v)); v = fmaxf(v, dppf<0x4E>(v)); v = fmaxf(v, dppf<0x141>(v)); v = fmaxf(v, dppf<0x140>(v)); return v; }
__device__ __forceinline__ float wave_sum(float v) {
    v = red16(v);
    const int u = __builtin_bit_cast(int, v);
    return __builtin_bit_cast(float, __builtin_amdgcn_readlane(u, 0)) + __builtin_bit_cast(float, __builtin_amdgcn_readlane(u, 16)) +
           __builtin_bit_cast(float, __builtin_amdgcn_readlane(u, 32)) + __builtin_bit_cast(float, __builtin_amdgcn_readlane(u, 48));
}
__device__ __forceinline__ void unpack8(const u32x4 u, float* f) {
    f[0] = bf2f((bf16_t)(u.x & 0xffff)); f[1] = bf2f((bf16_t)(u.x >> 16)); f[2] = bf2f((bf16_t)(u.y & 0xffff)); f[3] = bf2f((bf16_t)(u.y >> 16));
    f[4] = bf2f((bf16_t)(u.z & 0xffff)); f[5] = bf2f((bf16_t)(u.z >> 16)); f[6] = bf2f((bf16_t)(u.w & 0xffff)); f[7] = bf2f((bf16_t)(u.w >> 16));
}
__device__ __forceinline__ float sigmoidf_(float x) { return 1.f / (1.f + __expf(-x)); }

struct SeqInfo { int b, pos, len, start, isctx; };
__device__ __forceinline__ SeqInfo seq_of_row(int row) {
    SeqInfo s;
    if (row < TMAIN) { s.b = row >> 12; s.pos = row & 4095; s.len = SEQL; s.start = s.b << 12; s.isctx = 0; }
    else { const int r = row - TMAIN; s.b = r >> 8; s.pos = r & 255; s.len = CTXL; s.start = TMAIN + (s.b << 8); s.isctx = 1; }
    return s;
}

__device__ __forceinline__ void transpose_item(const float* W, int N, int nsrc0, bf16_t* WT, int K, int ndst0, int k0, LAS float* scr, int lane) {
    if (nsrc0 >= 0) {
#pragma unroll 32
        for (int i = 0; i < 32; ++i) { const int kk = 2 * i + (lane >> 5); scr[kk * 33 + (lane & 31)] = W[(size_t)(k0 + kk) * N + nsrc0 + (lane & 31)]; }
    } else {
#pragma unroll 8
        for (int i = 0; i < 32; ++i) { const int kk = 2 * i + (lane >> 5); scr[kk * 33 + (lane & 31)] = 0.f; }
    }
    __builtin_amdgcn_wave_barrier(); asm volatile("s_waitcnt lgkmcnt(0)" ::: "memory");
    const int c = lane & 7;
#pragma unroll
    for (int j = 0; j < 4; ++j) { const int n = (lane >> 3) + 8 * j; const LAS float* s = scr + (8 * c) * 33 + n;
        u32x4 o; o.x = pk2(s[0 * 33], s[1 * 33]); o.y = pk2(s[2 * 33], s[3 * 33]); o.z = pk2(s[4 * 33], s[5 * 33]); o.w = pk2(s[6 * 33], s[7 * 33]);
        *(u32x4*)(WT + (size_t)(ndst0 + n) * K + k0 + 8 * c) = o; }
    __builtin_amdgcn_wave_barrier(); asm volatile("s_waitcnt lgkmcnt(0)" ::: "memory");
}
__device__ __forceinline__ int win_src_col(int n) {
    if (n < 256) return n;
    if (n < 512) return 512 + (n - 256);
    if (n < 768) return 1536 + (n - 512);
    if (n < 1024) return 2560 + (n - 768);
    if (n < 1280) return 256 + (n - 1024);
    if (n < 2048) return 768 + (n - 1280);
    if (n < 2816) return 1792 + (n - 2048);
    if (n < 2976) return n;
    return -1;
}
__device__ __forceinline__ void phase_prologue(const Params& p, LAS unsigned char* lds, int bid, int nb) {
    const int tid = get_tid(), lane = tid & 63, wave = tid >> 6;
    LAS float* scr = (LAS float*)(lds + wave * 16384);
    const int gw = bid * 8 + wave, NGW = nb * 8;
    constexpr int I_IN = 16 * 96, I_OUT = 16 * 32, I_1 = 16 * 128, I_2 = 64 * 32, I_L = I_IN + I_OUT + I_1 + I_2;
    for (int it = gw; it < 2 * I_L; it += NGW) {
        const int l = it / I_L; int r = it % I_L;
        unsigned char* wb = p.ws + WS_WB + (size_t)l * WB_LAYER;
        if (r < I_IN) { const int kb = r / 96, nbk = r % 96; transpose_item(p.in[10] + (size_t)l * DM * 2976, 2976, win_src_col(nbk * 32), (bf16_t*)(wb + WB_IN), DM, nbk * 32, kb * 64, scr, lane); continue; } r -= I_IN;
        if (r < I_OUT) { const int kb = r / 32, nbk = r % 32; transpose_item(p.in[11] + (size_t)l * DM * DM, DM, nbk * 32, (bf16_t*)(wb + WB_OUT), DM, nbk * 32, kb * 64, scr, lane); continue; } r -= I_OUT;
        if (r < I_1) { const int kb = r / 128, nbk = r % 128; transpose_item(p.in[28] + (size_t)l * DM * FF, FF, nbk * 32, (bf16_t*)(wb + WB_W1), DM, nbk * 32, kb * 64, scr, lane); continue; } r -= I_1;
        { const int kb = r / 32, nbk = r % 32; transpose_item(p.in[29] + (size_t)l * FF * DM, DM, nbk * 32, (bf16_t*)(wb + WB_W2), FF, nbk * 32, kb * 64, scr, lane); }
    }
    __syncthreads();
    for (int it = bid; it < 192; it += nb) {
        const int l = it / 96, cb = it % 96;
        LAS float* sc = (LAS float*)lds;
        LAS float* red = sc + 9 * 1024;
        for (int e = tid; e < 9 * 1024; e += 512) { const int r = e >> 10, k = e & 1023; const float v = (r < 8) ? p.in[1][r * 1024 + k] : p.in[3][k]; sc[e] = v / (1.f + __expf(-v)); }
        __syncthreads();
        const int ks = tid >> 6, cl = tid & 63, n = cb * 64 + cl;
        float acc[9];
#pragma unroll
        for (int r = 0; r < 9; ++r) acc[r] = 0.f;
        const float* aw = p.in[4] + (size_t)l * DM * 6144;
#pragma unroll 16
        for (int k = ks * 128; k < ks * 128 + 128; ++k) { const float w = aw[(size_t)k * 6144 + n];
#pragma unroll
            for (int r = 0; r < 9; ++r) acc[r] += sc[r * 1024 + k] * w; }
#pragma unroll
        for (int r = 0; r < 9; ++r) red[(ks * 9 + r) * 64 + cl] = acc[r];
        __syncthreads();
        for (int e = tid; e < 9 * 64; e += 512) { const int r = e >> 6, c2 = e & 63; float s = 0.f;
            for (int q = 0; q < 8; ++q) s += red[(q * 9 + r) * 64 + c2];
            ((float*)(p.ws + WS_MOD))[((size_t)l * 9 + r) * 6144 + cb * 64 + c2] = s + p.in[5][(size_t)l * 6144 + cb * 64 + c2]; }
        __syncthreads();
    }
    if (bid == nb - 1) {
        float* tab = (float*)(p.ws + WS_TAB);
        for (int e = tid; e < 64 * 16; e += 512) { const int pos = e >> 4, f = e & 15; const float inv = powf(10000.f, -(float)(2 * f) / 32.f); const float a = (float)pos * inv; tab[e] = cosf(a); tab[1024 + e] = sinf(a); }
        for (int e = tid; e < 64 * 8; e += 512) { const int pos = e >> 3, f = e & 7; const float inv = powf(10000.f, -(float)(2 * f) / 16.f); const float a = (float)pos * inv; tab[2048 + e] = cosf(a); tab[2560 + e] = sinf(a); }
    }
}

struct RowJob { const float* xsrc; const bf16_t* z; const float* gpost; const float* gate; float* xdst; const float* gpre; const float* shift; const float* scale; bf16_t* hdst; };
__device__ __forceinline__ RowJob make_rowjob(const Params& p, int mode, int l, int row) {
    const float* mod = (const float*)(p.ws + WS_MOD);
    bf16_t* HB = (bf16_t*)(p.ws + WS_HB); const bf16_t* Z = (const bf16_t*)(p.ws + WS_Z);
    float* XC = (float*)(p.ws + WS_XC);
    const SeqInfo s = seq_of_row(row);
    const int mr = s.isctx ? 8 : s.b;
    const float* m_l = mod + ((size_t)l * 9 + mr) * 6144;
    float* xs = s.isctx ? XC + (size_t)(row - TMAIN) * DM : p.out + (size_t)row * DM;
    const float* xin = s.isctx ? p.in[2] + (size_t)(row - TMAIN) * DM : p.in[0] + (size_t)row * DM;
    RowJob j;
    if (mode == 0) { j = RowJob{xin, nullptr, nullptr, nullptr, nullptr, p.in[6] + l * DM, m_l + 0, m_l + 1024, HB + (size_t)row * DM}; }
    else if (mode == 1) { j = RowJob{l == 0 ? xin : xs, Z + (size_t)row * DM, p.in[7] + l * DM, m_l + 2048, xs, p.in[8] + l * DM, m_l + 3072, m_l + 4096, HB + (size_t)row * DM}; }
    else { const bool has_next = (l + 1 < 2); const float* m_n = mod + ((size_t)(has_next ? l + 1 : l) * 9 + mr) * 6144;
        j = RowJob{xs, Z + (size_t)row * DM, p.in[9] + l * DM, m_l + 5120, xs, p.in[6] + (has_next ? l + 1 : l) * DM, m_n + 0, m_n + 1024, has_next ? HB + (size_t)row * DM : nullptr}; }
    return j;
}
template <int RB>
__device__ __forceinline__ void rowop_batch(const RowJob (&jb)[RB], const bool (&valid)[RB], int lane) {
    f32x4 v[RB][4]; u32x2 zu[RB][4];
#pragma unroll
    for (int r = 0; r < RB; ++r) if (valid[r]) {
#pragma unroll
        for (int j = 0; j < 4; ++j) { v[r][j] = *(const f32x4*)(jb[r].xsrc + (j * 64 + lane) * 4); if (jb[r].z) zu[r][j] = *(const u32x2*)(jb[r].z + (j * 64 + lane) * 4); }
    }
#pragma unroll
    for (int r = 0; r < RB; ++r) if (valid[r]) {
        const RowJob& J = jb[r];
        if (J.z) {
            f32x4 zz[4], gp[4], gt[4]; float ss = 0.f;
#pragma unroll
            for (int j = 0; j < 4; ++j) { const int c = (j * 64 + lane) * 4; gp[j] = *(const f32x4*)(J.gpost + c); gt[j] = *(const f32x4*)(J.gate + c); }
#pragma unroll
            for (int j = 0; j < 4; ++j) { const u32x2 u = zu[r][j];
                zz[j].x = bf2f((bf16_t)(u.x & 0xffff)); zz[j].y = bf2f((bf16_t)(u.x >> 16)); zz[j].z = bf2f((bf16_t)(u.y & 0xffff)); zz[j].w = bf2f((bf16_t)(u.y >> 16));
                ss += zz[j].x * zz[j].x + zz[j].y * zz[j].y + zz[j].z * zz[j].z + zz[j].w * zz[j].w; }
            const float rinv = 1.f / sqrtf(wave_sum(ss) * (1.f / 1024.f) + 1e-6f);
#pragma unroll
            for (int j = 0; j < 4; ++j) { const int c = (j * 64 + lane) * 4;
                v[r][j].x += gt[j].x * (zz[j].x * rinv * gp[j].x); v[r][j].y += gt[j].y * (zz[j].y * rinv * gp[j].y); v[r][j].z += gt[j].z * (zz[j].z * rinv * gp[j].z); v[r][j].w += gt[j].w * (zz[j].w * rinv * gp[j].w);
                *(f32x4*)(J.xdst + c) = v[r][j]; }
        }
        if (J.hdst) {
            f32x4 g[4], sh[4], sc[4]; float ss = 0.f;
#pragma unroll
            for (int j = 0; j < 4; ++j) { const int c = (j * 64 + lane) * 4; g[j] = *(const f32x4*)(J.gpre + c); sh[j] = *(const f32x4*)(J.shift + c); sc[j] = *(const f32x4*)(J.scale + c); }
#pragma unroll
            for (int j = 0; j < 4; ++j) ss += v[r][j].x * v[r][j].x + v[r][j].y * v[r][j].y + v[r][j].z * v[r][j].z + v[r][j].w * v[r][j].w;
            const float rinv = 1.f / sqrtf(wave_sum(ss) * (1.f / 1024.f) + 1e-6f);
#pragma unroll
            for (int j = 0; j < 4; ++j) { const int c = (j * 64 + lane) * 4;
                u32x2 o; o.x = pk2(v[r][j].x * rinv * g[j].x * (1.f + sc[j].x) + sh[j].x, v[r][j].y * rinv * g[j].y * (1.f + sc[j].y) + sh[j].y);
                o.y = pk2(v[r][j].z * rinv * g[j].z * (1.f + sc[j].z) + sh[j].z, v[r][j].w * rinv * g[j].w * (1.f + sc[j].w) + sh[j].w);
                *(u32x2*)(J.hdst + c) = o; }
        }
    }
}
__device__ __forceinline__ void phase_rowops(const Params& p, int mode, int l, int nrows, int bid, int nb) {
    const int tid = get_tid(), lane = tid & 63, wave = tid >> 6;
    constexpr int RB = 4;
    const int nwaves = nb * 8, gw = bid * 8 + wave;
    for (int base = gw; base < nrows; base += nwaves * RB) {
        RowJob jb[RB]; bool valid[RB];
#pragma unroll
        for (int r = 0; r < RB; ++r) { const int row = base + r * nwaves; valid[r] = row < nrows; jb[r] = make_rowjob(p, mode, l, valid[r] ? row : 0); }
        rowop_batch<RB>(jb, valid, lane);
    }
}

__device__ __forceinline__ void rwkv_prep_item(const Params& p, int l, LAS unsigned char* lds, int tile) {
    const int tid = get_tid();
    const bf16_t* P = (const bf16_t*)(p.ws + WS_P);
    const int t0 = tile * 32; const SeqInfo s0 = seq_of_row(t0);
    const float* mu = p.in[14] + l * 1024;
    LAS float* r_s = (LAS float*)lds;
    LAS float* k_s = r_s + 32 * 256;
    LAS float* v_s = k_s + 32 * 256;
    LAS float* twd = v_s + 32 * 256;
    LAS float* ad_s = twd + 32 * 64;
#pragma unroll
    for (int it = 0; it < 7; ++it) {
        const int pc = tid + it * 512; const int tok = pc / 112, c8 = pc % 112, cc = c8 * 8;
        const int pcol = cc < 256 ? PC_RWR + cc : PC_RWK + (cc - 256);
        const int row = t0 + tok, pos = s0.pos + tok;
        const u32x4 u0 = *(const u32x4*)(P + (size_t)row * NP + pcol);
        const u32x4 um = pos > 0 ? *(const u32x4*)(P + (size_t)(row - 1) * NP + pcol) : (u32x4){0u, 0u, 0u, 0u};
        const u32x4 up = pos < s0.len - 1 ? *(const u32x4*)(P + (size_t)(row + 1) * NP + pcol) : (u32x4){0u, 0u, 0u, 0u};
        const f32x4 mu0 = *(const f32x4*)(mu + cc), mu1 = *(const f32x4*)(mu + cc + 4);
        float z0[8], zm[8], zp[8], zs[8]; unpack8(u0, z0); unpack8(um, zm); unpack8(up, zp);
        const float mm[8] = {mu0.x, mu0.y, mu0.z, mu0.w, mu1.x, mu1.y, mu1.z, mu1.w};
#pragma unroll
        for (int x = 0; x < 8; ++x) zs[x] = z0[x] + mm[x] * (0.5f * (zm[x] + zp[x]) - z0[x]);
        LAS float* dst;
        if (cc < 256) dst = r_s + tok * 256 + cc;
        else if (cc < 512) dst = k_s + tok * 256 + cc - 256;
        else if (cc < 768) dst = v_s + tok * 256 + cc - 512;
        else if (cc < 832) { dst = twd + tok * 64 + cc - 768;
#pragma unroll
            for (int x = 0; x < 8; ++x) zs[x] = 1.f - 2.f / (1.f + __expf(2.f * zs[x])); }
        else dst = ad_s + tok * 64 + cc - 832;
        *(LAS f32x4*)dst = (f32x4){zs[0], zs[1], zs[2], zs[3]}; *(LAS f32x4*)(dst + 4) = (f32x4){zs[4], zs[5], zs[6], zs[7]};
    }
    __syncthreads();
    const int hh = tid >> 8, c = tid & 255, h = c >> 6;
    float aw0[16], aw1[16], aa0[16], aa1[16];
#pragma unroll
    for (int i = 0; i < 16; ++i) { aw0[i] = 0.f; aw1[i] = 0.f; aa0[i] = 0.f; aa1[i] = 0.f; }
    const float* wup = p.in[16] + (size_t)l * 2 * 64 * 256; const float* aup = p.in[18] + (size_t)l * 2 * 64 * 256;
#pragma unroll 4
    for (int j = 0; j < 64; ++j) {
        const float w0 = wup[j * 256 + c], w1 = wup[64 * 256 + j * 256 + c], a0 = aup[j * 256 + c], a1 = aup[64 * 256 + j * 256 + c];
#pragma unroll
        for (int i = 0; i < 16; ++i) { const float tw = twd[(hh * 16 + i) * 64 + j], ta = ad_s[(hh * 16 + i) * 64 + j];
            aw0[i] += tw * w0; aw1[i] += tw * w1; aa0[i] += ta * a0; aa1[i] += ta * a1; }
    }
    const float w0b0 = p.in[15][(l * 2 + 0) * 256 + c], w0b1 = p.in[15][(l * 2 + 1) * 256 + c];
    const float a0b0 = p.in[17][(l * 2 + 0) * 256 + c], a0b1 = p.in[17][(l * 2 + 1) * 256 + c];
    const float ka = p.in[21][l * 256 + c], rk = p.in[22][l * 256 + c];
    bf16_t* RK = (bf16_t*)(p.ws + WS_RWK); bf16_t* RV = (bf16_t*)(p.ws + WS_RWV); bf16_t* RR = (bf16_t*)(p.ws + WS_RWRR);
    bf16_t* RA0 = (bf16_t*)(p.ws + WS_RWA0); bf16_t* RA1 = (bf16_t*)(p.ws + WS_RWA1); bf16_t* RM0 = (bf16_t*)(p.ws + WS_RWM0); bf16_t* RM1 = (bf16_t*)(p.ws + WS_RWM1);
    float* BON = (float*)(p.ws + WS_BON);
#pragma unroll
    for (int i = 0; i < 16; ++i) {
        const int tok = hh * 16 + i, row = t0 + tok;
        const float k = k_s[tok * 256 + c], v = v_s[tok * 256 + c], r = r_s[tok * 256 + c];
        const float sg0 = sigmoidf_(w0b0 + aw0[i]), sg1 = sigmoidf_(w0b1 + aw1[i]);
        const float om0 = 1.f - __expf(-0.60653066f * sg0), om1 = 1.f - __expf(-0.60653066f * sg1);
        const float a0 = sigmoidf_(a0b0 + aa0[i]), a1 = sigmoidf_(a0b1 + aa1[i]);
        const float kt0 = k * (1.f + (a0 - 1.f) * ka), kt1 = k * (1.f + (a1 - 1.f) * ka);
        const float bs = wave_sum(r * (kt0 + kt1) * rk);
        const size_t o = (size_t)row * 256 + c;
        RK[o] = f2bf(k); RV[o] = f2bf(v); RR[o] = f2bf(r); RA0[o] = f2bf(a0); RA1[o] = f2bf(a1); RM0[o] = f2bf(om0); RM1[o] = f2bf(om1);
        if ((tid & 63) == 0) BON[(size_t)row * 4 + h] = bs;
    }
    __syncthreads();
}
__device__ __forceinline__ int ret_chunk_index(int cr, int& b) { if (cr < 256) { b = cr >> 5; return 2 + (cr & 31); } b = (cr - 256) >> 1; return (cr - 256) & 1; }
__device__ __forceinline__ void ret_kv_item(const Params& p, LAS unsigned char* lds, int item) {
    const int tid = get_tid();
    const bf16_t* P = (const bf16_t*)(p.ws + WS_P);
    const int cr = item >> 2, h = item & 3; int b; const int ci = ret_chunk_index(cr, b);
    const int r0 = cr * 128;
    LAS float* Ks = (LAS float*)lds;
    LAS float* Vs = Ks + 128 * 64;
    LAS float* dec = Vs + 128 * 64;
    const float lg = log1pf(-exp2f(-5.f - (float)h));
    for (int e = tid; e < 128 * 64; e += 512) { const int j = e >> 6, d = e & 63;
        Ks[e] = bf2f(P[(size_t)(r0 + j) * NP + PC_RETK + h * 64 + d]) * 0.125f; Vs[e] = bf2f(P[(size_t)(r0 + j) * NP + PC_RETV + h * 64 + d]); }
    if (tid < 128) dec[tid] = expf((float)tid * lg);
    __syncthreads();
    const int d = tid >> 3, e0 = (tid & 7) * 8;
    float af[8], ab[8];
#pragma unroll
    for (int i = 0; i < 8; ++i) { af[i] = 0.f; ab[i] = 0.f; }
    for (int j = 0; j < 128; ++j) { const float kd = Ks[j * 64 + d]; const float kf = kd * dec[127 - j], kb = kd * dec[j];
        const f32x4 v0 = *(const LAS f32x4*)(Vs + j * 64 + e0), v1 = *(const LAS f32x4*)(Vs + j * 64 + e0 + 4);
        af[0] += kf * v0.x; af[1] += kf * v0.y; af[2] += kf * v0.z; af[3] += kf * v0.w; af[4] += kf * v1.x; af[5] += kf * v1.y; af[6] += kf * v1.z; af[7] += kf * v1.w;
        ab[0] += kb * v0.x; ab[1] += kb * v0.y; ab[2] += kb * v0.z; ab[3] += kb * v0.w; ab[4] += kb * v1.x; ab[5] += kb * v1.y; ab[6] += kb * v1.z; ab[7] += kb * v1.w; }
    float* RS = (float*)(p.ws + WS_RET) + ((size_t)((b * 4 + h) * 34 + ci) * 2) * 4096;
#pragma unroll
    for (int i = 0; i < 8; ++i) { RS[d * 64 + e0 + i] = af[i]; RS[4096 + d * 64 + e0 + i] = ab[i]; }
    __syncthreads();
}
__device__ __forceinline__ void swa_prep_item(const Params& p, LAS unsigned char* lds, int tile) {
    const int tid = get_tid();
    bf16_t* P = (bf16_t*)(p.ws + WS_P);
    const float* tabc = (const float*)(p.ws + WS_TAB); const float* tabs = tabc + 1024;
    bf16_t* KS = (bf16_t*)(p.ws + WS_KS); bf16_t* VT = (bf16_t*)(p.ws + WS_VTS);
    const int t0 = tile * 64; const SeqInfo s0 = seq_of_row(t0);
    const int key0 = s0.isctx ? s0.pos : CTXL + s0.pos;
    LAS bf16_t* Vs = (LAS bf16_t*)lds;
    u32x4 vreg[2];
#pragma unroll
    for (int it = 0; it < 2; ++it) { const int pc = tid + it * 512, tok = pc >> 4, c8 = pc & 15; vreg[it] = *(const u32x4*)(P + (size_t)(t0 + tok) * NP + PC_SWAV + c8 * 8); }
    u32x4 x1[3], x2[3];
#pragma unroll
    for (int it = 0; it < 3; ++it) { const int e = tid + it * 512; const int tok = e / 24, rem = e % 24, hd = rem >> 2, axis = (rem >> 1) & 1, fg = rem & 1;
        const int colbase = (hd < 4 ? PC_SWAQ + hd * 64 : PC_SWAK + (hd - 4) * 64) + axis * 32 + fg * 8;
        x1[it] = *(const u32x4*)(P + (size_t)(t0 + tok) * NP + colbase); x2[it] = *(const u32x4*)(P + (size_t)(t0 + tok) * NP + colbase + 16); }
#pragma unroll
    for (int it = 0; it < 2; ++it) { const int pc = tid + it * 512, tok = pc >> 4, c8 = pc & 15; *(LAS u32x4*)(Vs + tok * 136 + c8 * 8) = vreg[it]; }
#pragma unroll
    for (int it = 0; it < 3; ++it) { const int e = tid + it * 512; const int tok = e / 24, rem = e % 24, hd = rem >> 2, axis = (rem >> 1) & 1, fg = rem & 1;
        const int row = t0 + tok, pos = s0.pos + tok;
        const int colbase = (hd < 4 ? PC_SWAQ + hd * 64 : PC_SWAK + (hd - 4) * 64) + axis * 32 + fg * 8;
        float a[8], bb[8]; unpack8(x1[it], a); unpack8(x2[it], bb);
        if (!s0.isctx) { const int pp = axis == 0 ? (pos >> 6) : (pos & 63);
            const f32x4 c0 = *(const f32x4*)(tabc + pp * 16 + fg * 8), c1 = *(const f32x4*)(tabc + pp * 16 + fg * 8 + 4), s0v = *(const f32x4*)(tabs + pp * 16 + fg * 8), s1v = *(const f32x4*)(tabs + pp * 16 + fg * 8 + 4);
            const float cs[8] = {c0.x, c0.y, c0.z, c0.w, c1.x, c1.y, c1.z, c1.w}, sn[8] = {s0v.x, s0v.y, s0v.z, s0v.w, s1v.x, s1v.y, s1v.z, s1v.w};
#pragma unroll
            for (int x = 0; x < 8; ++x) { const float y1 = a[x] * cs[x] - bb[x] * sn[x], y2 = bb[x] * cs[x] + a[x] * sn[x]; a[x] = y1; bb[x] = y2; } }
        u32x4 o1, o2; o1.x = pk2(a[0], a[1]); o1.y = pk2(a[2], a[3]); o1.z = pk2(a[4], a[5]); o1.w = pk2(a[6], a[7]);
        o2.x = pk2(bb[0], bb[1]); o2.y = pk2(bb[2], bb[3]); o2.z = pk2(bb[4], bb[5]); o2.w = pk2(bb[6], bb[7]);
        if (hd < 4) { if (!s0.isctx) { *(u32x4*)(P + (size_t)row * NP + colbase) = o1; *(u32x4*)(P + (size_t)row * NP + colbase + 16) = o2; } }
        else { bf16_t* kd = KS + ((size_t)(s0.b * 2 + (hd - 4)) * NKEYS + key0 + tok) * 64 + axis * 32 + fg * 8; *(u32x4*)kd = o1; *(u32x4*)(kd + 16) = o2; }
    }
    __syncthreads();
#pragma unroll
    for (int it = 0; it < 2; ++it) { const int pc = tid + it * 512, hd = pc >> 3, k8 = pc & 7, hk = hd >> 6, d = hd & 63;
        unsigned w[4];
#pragma unroll
        for (int x = 0; x < 4; ++x) w[x] = (unsigned)Vs[(k8 * 8 + 2 * x) * 136 + hd] | ((unsigned)Vs[(k8 * 8 + 2 * x + 1) * 136 + hd] << 16);
        *(u32x4*)(VT + ((size_t)(s0.b * 2 + hk) * 64 + d) * NKEYS + key0 + k8 * 8) = (u32x4){w[0], w[1], w[2], w[3]}; }
    __syncthreads();
}
__device__ __forceinline__ void phase_prepA(const Params& p, int l, LAS unsigned char* lds, int bid, int nb) {
    constexpr int N1 = TT / 32, N2 = 272 * 4, N3 = TT / 64;
    for (int it = bid; it < N1 + N2 + N3; it += nb) {
        if (it < N1) rwkv_prep_item(p, l, lds, it);
        else if (it < N1 + N2) ret_kv_item(p, lds, it - N1);
        else swa_prep_item(p, lds, it - N1 - N2);
    }
}

__device__ __forceinline__ void mla_proj_item(const Params& p, int l, LAS unsigned char* lds, int tile) {
    const int tid = get_tid(), lane = tid & 63, wave = tid >> 6;
    const bf16_t* P = (const bf16_t*)(p.ws + WS_P);
    const float* tabc = (const float*)(p.ws + WS_TAB) + 2048; const float* tabs = tabc + 512;
    const int t0 = tile * 32; const SeqInfo s0 = seq_of_row(t0);
    const int key0 = s0.isctx ? s0.pos : CTXL + s0.pos;
    LAS float* qn = (LAS float*)lds;
    LAS float* kvn = qn + 32 * 256;
    LAS float* qo = kvn + 32 * 128;
    const float* qg = p.in[24] + l * 256; const float* kvg = p.in[26] + l * 128;
    for (int i = 0; i < 4; ++i) { const int tok = wave * 4 + i, row = t0 + tok;
        float x[4]; float ss = 0.f;
#pragma unroll
        for (int j = 0; j < 4; ++j) { x[j] = bf2f(P[(size_t)row * NP + PC_MLAQD + j * 64 + lane]); ss += x[j] * x[j]; }
        const float rq = 1.f / sqrtf(wave_sum(ss) * (1.f / 256.f) + 1e-6f);
#pragma unroll
        for (int j = 0; j < 4; ++j) qn[tok * 256 + j * 64 + lane] = x[j] * rq * qg[j * 64 + lane];
        float y[2]; float s2 = 0.f;
#pragma unroll
        for (int j = 0; j < 2; ++j) { y[j] = bf2f(P[(size_t)row * NP + PC_MLAKVD + j * 64 + lane]); s2 += y[j] * y[j]; }
        const float rk = 1.f / sqrtf(wave_sum(s2) * (1.f / 128.f) + 1e-6f);
#pragma unroll
        for (int j = 0; j < 2; ++j) kvn[tok * 128 + j * 64 + lane] = y[j] * rk * kvg[j * 64 + lane];
    }
    __syncthreads();
    if (tid < 384) {
        const float* wq = p.in[25] + (size_t)l * 256 * 384;
        float acc[32];
#pragma unroll
        for (int i = 0; i < 32; ++i) acc[i] = 0.f;
        for (int k = 0; k < 256; k += 4) {
            const float w0 = wq[(size_t)k * 384 + tid], w1 = wq[(size_t)(k + 1) * 384 + tid], w2 = wq[(size_t)(k + 2) * 384 + tid], w3 = wq[(size_t)(k + 3) * 384 + tid];
#pragma unroll
            for (int i = 0; i < 32; ++i) { const f32x4 a = *(const LAS f32x4*)(qn + i * 256 + k); acc[i] += a.x * w0 + a.y * w1 + a.z * w2 + a.w * w3; }
        }
#pragma unroll
        for (int i = 0; i < 32; ++i) qo[i * 384 + tid] = acc[i];
    }
    {
        const float* wkv = p.in[27] + (size_t)l * 128 * 512;
        float acc[32];
#pragma unroll
        for (int i = 0; i < 32; ++i) acc[i] = 0.f;
        for (int k = 0; k < 128; k += 4) {
            const float w0 = wkv[(size_t)k * 512 + tid], w1 = wkv[(size_t)(k + 1) * 512 + tid], w2 = wkv[(size_t)(k + 2) * 512 + tid], w3 = wkv[(size_t)(k + 3) * 512 + tid];
#pragma unroll
            for (int i = 0; i < 32; ++i) { const f32x4 a = *(const LAS f32x4*)(kvn + i * 128 + k); acc[i] += a.x * w0 + a.y * w1 + a.z * w2 + a.w * w3; }
        }
        const int h = tid >> 7, dd = tid & 127;
        if (dd < 64) { bf16_t* KM = (bf16_t*)(p.ws + WS_KM) + ((size_t)(s0.b * 4 + h) * NKEYS + key0) * 96 + dd;
#pragma unroll
            for (int i = 0; i < 32; ++i) KM[(size_t)i * 96] = f2bf(acc[i]); }
        else { bf16_t* VT = (bf16_t*)(p.ws + WS_VTM) + ((size_t)(s0.b * 4 + h) * 64 + (dd - 64)) * NKEYS + key0;
#pragma unroll
            for (int i = 0; i < 32; ++i) VT[i] = f2bf(acc[i]); }
    }
    __syncthreads();
    bf16_t* MQ = (bf16_t*)(p.ws + WS_MQ);
    for (int e = tid; e < 32 * 384; e += 512) { const int tok = e / 384, c = e % 384, dd = c % 96; const int pos = s0.pos + tok;
        float v = qo[e];
        if (dd >= 64 && !s0.isctx) { const int pe = dd - 64, axis = pe >> 4, half = (pe >> 3) & 1, f = pe & 7; const int pp = axis == 0 ? (pos >> 6) : (pos & 63);
            const float cs = tabc[pp * 8 + f], sn = tabs[pp * 8 + f];
            const float x1 = half ? qo[e - 8] : v, x2 = half ? v : qo[e + 8];
            v = half ? (x2 * cs + x1 * sn) : (x1 * cs - x2 * sn); }
        MQ[(size_t)(t0 + tok) * 384 + c] = f2bf(v); }
    for (int e = tid; e < 32 * 32; e += 512) { const int tok = e >> 5, pe = e & 31, axis = pe >> 4, half = (pe >> 3) & 1, f = pe & 7; const int row = t0 + tok, pos = s0.pos + tok;
        float v = bf2f(P[(size_t)row * NP + PC_MLAKPE + pe]);
        if (!s0.isctx) { const int pp = axis == 0 ? (pos >> 6) : (pos & 63); const float cs = tabc[pp * 8 + f], sn = tabs[pp * 8 + f];
            const float other = bf2f(P[(size_t)row * NP + PC_MLAKPE + (half ? pe - 8 : pe + 8)]);
            const float x1 = half ? other : v, x2 = half ? v : other;
            v = half ? (x2 * cs + x1 * sn) : (x1 * cs - x2 * sn); }
        const bf16_t o = f2bf(v);
#pragma unroll
        for (int h = 0; h < 4; ++h) ((bf16_t*)(p.ws + WS_KM))[((size_t)(s0.b * 4 + h) * NKEYS + key0 + tok) * 96 + 64 + pe] = o; }
    __syncthreads();
}
__device__ __forceinline__ void ret_scan_item(const Params& p, int item) {
    const int tid = get_tid(); const int seq = item >> 1, dir = item & 1, h = seq & 3;
    const float lg = log1pf(-exp2f(-5.f - (float)h)); const float cdec = expf(128.f * lg);
    float* base = (float*)(p.ws + WS_RET) + (size_t)seq * 34 * 2 * 4096 + dir * 4096;
    float S[8];
#pragma unroll
    for (int i = 0; i < 8; ++i) S[i] = 0.f;
    for (int st = 0; st < 34; ++st) {
        const int ci = dir == 0 ? st : (st == 0 ? 1 : (st == 1 ? 0 : 35 - st));
        float* q = base + (size_t)ci * 2 * 4096 + tid * 8;
        const f32x4 t0 = *(const f32x4*)q, t1 = *(const f32x4*)(q + 4);
        *(f32x4*)q = (f32x4){S[0], S[1], S[2], S[3]}; *(f32x4*)(q + 4) = (f32x4){S[4], S[5], S[6], S[7]};
        S[0] = S[0] * cdec + t0.x; S[1] = S[1] * cdec + t0.y; S[2] = S[2] * cdec + t0.z; S[3] = S[3] * cdec + t0.w;
        S[4] = S[4] * cdec + t1.x; S[5] = S[5] * cdec + t1.y; S[6] = S[6] * cdec + t1.z; S[7] = S[7] * cdec + t1.w;
    }
}
__device__ __forceinline__ void phase_prepB(const Params& p, int l, LAS unsigned char* lds, int bid, int nb) {
    constexpr int N1 = TT / 32, N2 = 64;
    for (int it = bid; it < N1 + N2; it += nb) {
        if (it < N1) mla_proj_item(p, l, lds, it); else ret_scan_item(p, it - N1);
    }
}

__device__ __forceinline__ unsigned cvt_pk_bf16(float lo, float hi) { unsigned r; asm("v_cvt_pk_bf16_f32 %0, %1, %2" : "=v"(r) : "v"(lo), "v"(hi)); return r; }
template <int DK>
__device__ __forceinline__ void attn_unit(const bf16_t* Q, int qstride, const bf16_t* K, const bf16_t* Vt, int nctx, int mt0, int mt1, bool masked, int qpos0,
                                          bool has_sink, float sink, float scale, bf16_t* O, int ostride, LAS unsigned char* lds) {
    constexpr int KC = DK / 32, KP = DK + 8, KROW = KP * 2;
    constexpr int PIECES_K = 64 * DK / 8;
    const int tid = get_tid(), lane = tid & 63, wave = tid >> 6, fr = lane & 15, fq = lane >> 4;
    LAS unsigned char* Kt = lds;
    LAS unsigned char* Vl = lds + 64 * KROW;
    const float sl2 = scale * 1.44269504f;
    bf16x8 qf[KC];
#pragma unroll
    for (int kc = 0; kc < KC; ++kc) { const u32x4 u = *(const u32x4*)(Q + (size_t)(wave * 16 + fr) * qstride + kc * 32 + fq * 8); float f[8]; unpack8(u, f);
        u32x4 o; o.x = cvt_pk_bf16(f[0] * sl2, f[1] * sl2); o.y = cvt_pk_bf16(f[2] * sl2, f[3] * sl2); o.z = cvt_pk_bf16(f[4] * sl2, f[5] * sl2); o.w = cvt_pk_bf16(f[6] * sl2, f[7] * sl2);
        qf[kc] = __builtin_bit_cast(bf16x8, o); }
    float mq = 0.f, lsum = 0.f; f32x4 o[4];
#pragma unroll
    for (int n = 0; n < 4; ++n) o[n] = (f32x4){0.f, 0.f, 0.f, 0.f};
    const int ntiles = nctx + (mt1 - mt0);
    u32x4 kr[2], vr;
    auto issue = [&](int ti) {
        const int tile = ti < nctx ? ti : mt0 + (ti - nctx);
        const bf16_t* kb = K + (size_t)tile * 64 * DK;
#pragma unroll
        for (int i = 0; i < 2; ++i) { const int pc = tid + i * 512; if (pc < PIECES_K) kr[i] = *(const u32x4*)(kb + (size_t)pc * 8); }
        { const int d = tid >> 3, c8 = tid & 7; vr = *(const u32x4*)(Vt + (size_t)d * NKEYS + tile * 64 + c8 * 8); }
    };
    issue(0);
    for (int ti = 0; ti < ntiles; ++ti) {
        const int tile = ti < nctx ? ti : mt0 + (ti - nctx);
        __syncthreads();
#pragma unroll
        for (int i = 0; i < 2; ++i) { const int pc = tid + i * 512; if (pc < PIECES_K) { const int row = pc / (DK / 8), c8 = pc % (DK / 8); *(LAS u32x4*)(Kt + row * KROW + c8 * 16) = kr[i]; } }
        { const int d = tid >> 3, c8 = tid & 7; *(LAS u32x4*)(Vl + d * 144 + c8 * 16) = vr; }
        __syncthreads();
        if (ti + 1 < ntiles) issue(ti + 1);
        f32x4 s[4];
        const float init = -mq;
#pragma unroll
        for (int n = 0; n < 4; ++n) { s[n] = (f32x4){init, init, init, init};
#pragma unroll
            for (int kc = 0; kc < KC; ++kc) { const bf16x8 kf = *(const LAS bf16x8*)(Kt + (n * 16 + fr) * KROW + kc * 64 + fq * 16);
                s[n] = __builtin_amdgcn_mfma_f32_16x16x32_bf16(kf, qf[kc], s[n], 0, 0, 0); } }
        if (ti == 0) {
            float t = -INFINITY;
#pragma unroll
            for (int n = 0; n < 4; ++n)
#pragma unroll
                for (int r = 0; r < 4; ++r) t = fmaxf(t, s[n][r]);
            t = fmaxf(t, __shfl_xor(t, 16)); t = fmaxf(t, __shfl_xor(t, 32));
            if (has_sink) t = fmaxf(t, sink * 1.44269504f);
            mq = t;
#pragma unroll
            for (int n = 0; n < 4; ++n)
#pragma unroll
                for (int r = 0; r < 4; ++r) s[n][r] -= mq;
        }
        if (masked && ti >= nctx) {
#pragma unroll
            for (int n = 0; n < 4; ++n)
#pragma unroll
                for (int r = 0; r < 4; ++r) { const int kp = tile * 64 + n * 16 + fq * 4 + r - CTXL, qp = qpos0 + wave * 16 + fr; const int df = qp - kp; if (df > 128 || df < -128) s[n][r] = -INFINITY; }
        }
        float pe[4][4];
#pragma unroll
        for (int n = 0; n < 4; ++n)
#pragma unroll
            for (int r = 0; r < 4; ++r) { pe[n][r] = __builtin_amdgcn_exp2f(s[n][r]); lsum += pe[n][r]; }
#pragma unroll
        for (int c = 0; c < 2; ++c) {
            u32x4 pu; pu.x = cvt_pk_bf16(pe[2 * c][0], pe[2 * c][1]); pu.y = cvt_pk_bf16(pe[2 * c][2], pe[2 * c][3]); pu.z = cvt_pk_bf16(pe[2 * c + 1][0], pe[2 * c + 1][1]); pu.w = cvt_pk_bf16(pe[2 * c + 1][2], pe[2 * c + 1][3]);
            const bf16x8 pf = __builtin_bit_cast(bf16x8, pu);
#pragma unroll
            for (int n = 0; n < 4; ++n) {
                const u32x2 lo = *(const LAS u32x2*)(Vl + (n * 16 + fr) * 144 + ((2 * c) * 16 + fq * 4) * 2), hi = *(const LAS u32x2*)(Vl + (n * 16 + fr) * 144 + ((2 * c + 1) * 16 + fq * 4) * 2);
                const bf16x8 vf = __builtin_bit_cast(bf16x8, (u32x4){lo.x, lo.y, hi.x, hi.y});
                o[n] = __builtin_amdgcn_mfma_f32_16x16x32_bf16(vf, pf, o[n], 0, 0, 0); }
        }
    }
    {
        float t = lsum;
        t += __shfl_xor(t, 16); t += __shfl_xor(t, 32);
        if (has_sink) t += __builtin_amdgcn_exp2f(sink * 1.44269504f - mq);
        const float inv = 1.f / t;
#pragma unroll
        for (int n = 0; n < 4; ++n) { u32x2 ov; ov.x = cvt_pk_bf16(o[n][0] * inv, o[n][1] * inv); ov.y = cvt_pk_bf16(o[n][2] * inv, o[n][3] * inv);
            *(u32x2*)(O + (size_t)(wave * 16 + fr) * ostride + n * 16 + fq * 4) = ov; }
    }
    __syncthreads();
}

__device__ __forceinline__ void ret_out_item(const Params& p, int l, LAS unsigned char* lds, int item) {
    const int tid = get_tid();
    bf16_t* P = (bf16_t*)(p.ws + WS_P);
    const int cr = item >> 2, h = item & 3; int b; const int ci = ret_chunk_index(cr, b);
    const int r0 = cr * 128;
    const float lg = log1pf(-exp2f(-5.f - (float)h));
    LAS bf16_t* Kb = (LAS bf16_t*)lds;
    LAS float* Sf = (LAS float*)lds;
    LAS bf16_t* Qb = (LAS bf16_t*)(lds + 16384);
    LAS bf16_t* Vb = (LAS bf16_t*)(lds + 32768);
    LAS float* Am = (LAS float*)(lds + 49152);
    LAS float* dec = (LAS float*)(lds + 116736);
    LAS float* Sb = (LAS float*)(lds + 117760);
    for (int e = tid; e < 128 * 8; e += 512) { const int j = e >> 3, c8 = e & 7;
        const u32x4 kk = *(const u32x4*)(P + (size_t)(r0 + j) * NP + PC_RETK + h * 64 + c8 * 8);
        float kf[8]; unpack8(kk, kf);
        u32x4 ko; ko.x = pk2(kf[0] * 0.125f, kf[1] * 0.125f); ko.y = pk2(kf[2] * 0.125f, kf[3] * 0.125f); ko.z = pk2(kf[4] * 0.125f, kf[5] * 0.125f); ko.w = pk2(kf[6] * 0.125f, kf[7] * 0.125f);
        *(LAS u32x4*)(Kb + j * 64 + c8 * 8) = ko;
        *(LAS u32x4*)(Vb + j * 64 + c8 * 8) = *(const u32x4*)(P + (size_t)(r0 + j) * NP + PC_RETV + h * 64 + c8 * 8);
        *(LAS u32x4*)(Qb + j * 64 + c8 * 8) = *(const u32x4*)(P + (size_t)(r0 + j) * NP + PC_RETQ + h * 64 + c8 * 8); }
    if (tid < 129) dec[tid] = expf((float)tid * lg);
    const int i = tid >> 2, jq = tid & 3;
    __syncthreads();
#pragma unroll 1
    for (int hf = 0; hf < 4; ++hf) {
        float a[8];
#pragma unroll
        for (int jj = 0; jj < 8; ++jj) a[jj] = 0.f;
        const int jb = jq * 32 + hf * 8;
#pragma unroll 1
        for (int c8 = 0; c8 < 8; ++c8) {
            float q8[8]; unpack8(*(const LAS u32x4*)(Qb + i * 64 + c8 * 8), q8);
#pragma unroll
            for (int jj = 0; jj < 8; ++jj) { float k8[8]; unpack8(*(const LAS u32x4*)(Kb + (jb + jj) * 64 + c8 * 8), k8);
#pragma unroll
                for (int x = 0; x < 8; ++x) a[jj] += q8[x] * k8[x]; }
        }
#pragma unroll
        for (int jj = 0; jj < 8; ++jj) { const int j = jb + jj; const int df = i > j ? i - j : j - i;
            Am[i * 132 + j] = a[jj] * dec[df] * (i == j ? 2.f : 1.f); }
    }
    __syncthreads();
    { const float* RS = (const float*)(p.ws + WS_RET) + ((size_t)((b * 4 + h) * 34 + ci) * 2) * 4096;
      for (int e = tid; e < 4096; e += 512) { Sf[e] = RS[e]; Sb[e] = RS[4096 + e]; } }
    __syncthreads();
    const int e0 = jq * 16;
    float oacc[16];
#pragma unroll
    for (int e = 0; e < 16; ++e) oacc[e] = 0.f;
#pragma unroll 2
    for (int j = 0; j < 128; ++j) { const float a = Am[i * 132 + j];
        float v8[8];
        unpack8(*(const LAS u32x4*)(Vb + j * 64 + e0), v8);
#pragma unroll
        for (int x = 0; x < 8; ++x) oacc[x] += a * v8[x];
        unpack8(*(const LAS u32x4*)(Vb + j * 64 + e0 + 8), v8);
#pragma unroll
        for (int x = 0; x < 8; ++x) oacc[8 + x] += a * v8[x]; }
    const float gf = dec[i + 1], gb = dec[128 - i];
#pragma unroll 1
    for (int d8 = 0; d8 < 8; ++d8) {
        float q8[8]; unpack8(*(const LAS u32x4*)(Qb + i * 64 + d8 * 8), q8);
#pragma unroll
        for (int x = 0; x < 8; ++x) { const int d = d8 * 8 + x; const float qf = q8[x] * gf, qb = q8[x] * gb;
#pragma unroll
            for (int e4 = 0; e4 < 4; ++e4) { const f32x4 sf = *(const LAS f32x4*)(Sf + d * 64 + e0 + e4 * 4), sb = *(const LAS f32x4*)(Sb + d * 64 + e0 + e4 * 4);
                oacc[e4 * 4 + 0] += qf * sf.x + qb * sb.x; oacc[e4 * 4 + 1] += qf * sf.y + qb * sb.y; oacc[e4 * 4 + 2] += qf * sf.z + qb * sb.z; oacc[e4 * 4 + 3] += qf * sf.w + qb * sb.w; } }
    }
    float sm = 0.f;
#pragma unroll
    for (int e = 0; e < 16; ++e) sm += oacc[e];
    sm = red4(sm);
    const float mu = sm * (1.f / 64.f);
    float vs = 0.f;
#pragma unroll
    for (int e = 0; e < 16; ++e) { const float dlt = oacc[e] - mu; vs += dlt * dlt; }
    vs = red4(vs);
    const float rstd = 1.f / sqrtf(vs * (1.f / 64.f) + 1e-5f);
    const float* gn = p.in[13] + l * 256 + h * 64 + e0;
    const bf16_t* gp = P + (size_t)(r0 + i) * NP + PC_RETG + h * 64 + e0;
    bf16_t* yo = P + (size_t)(r0 + i) * NP + PC_RETQ + h * 64 + e0;
    float g16[16]; unpack8(*(const u32x4*)gp, g16); unpack8(*(const u32x4*)(gp + 8), g16 + 8);
    unsigned ow[8];
#pragma unroll
    for (int e = 0; e < 16; e += 2) { const float g0 = g16[e], g1 = g16[e + 1];
        const float y0 = (oacc[e] - mu) * rstd * gn[e] * (g0 / (1.f + __expf(-g0))), y1 = (oacc[e + 1] - mu) * rstd * gn[e + 1] * (g1 / (1.f + __expf(-g1)));
        ow[e >> 1] = pk2(y0, y1); }
    *(u32x4*)yo = (u32x4){ow[0], ow[1], ow[2], ow[3]}; *(u32x4*)(yo + 8) = (u32x4){ow[4], ow[5], ow[6], ow[7]};
    __syncthreads();
}

constexpr int NSCANBLK = 128;
__device__ __forceinline__ void rwkv_scan_item(const Params& p, int l, LAS unsigned char* lds, int item) {
    const int tid = get_tid();
    const int sc = item >> 1, half = item & 1;
    const int b = sc >> 3, h = (sc >> 1) & 3, dir = sc & 1;
    const bf16_t* RK = (const bf16_t*)(p.ws + WS_RWK); const bf16_t* RV = (const bf16_t*)(p.ws + WS_RWV); const bf16_t* RR = (const bf16_t*)(p.ws + WS_RWRR);
    const bf16_t* RA = (const bf16_t*)(p.ws + (dir ? WS_RWA1 : WS_RWA0)); const bf16_t* RM = (const bf16_t*)(p.ws + (dir ? WS_RWM1 : WS_RWM0));
    bf16_t* P = (bf16_t*)(p.ws + WS_P);
    const int ocol = (dir ? PC_RWO1 : PC_RWO0) + h * 64 + half * 32;
    LAS float* KH = (LAS float*)lds;
    LAS float* WW = KH + 4096; LAS float* BB = WW + 4096; LAS float* KT = BB + 4096; LAS float* RRl = KT + 4096; LAS float* VV = RRl + 4096; LAS float* OUT = VV + 4096;
    const int st = tid >> 3, c0 = (tid & 7) * 8;
    float kkp[8], kap[8];
#pragma unroll
    for (int i = 0; i < 8; ++i) { kkp[i] = p.in[20][l * 256 + h * 64 + c0 + i]; kap[i] = p.in[21][l * 256 + h * 64 + c0 + i]; }
    const int row_l = (tid >> 3) & 31, kq = tid & 7;
    const bool compute = tid < 256;
    f32x2 S[4];
#pragma unroll
    for (int i = 0; i < 4; ++i) S[i] = (f32x2){0.f, 0.f};
    auto row_of = [&](int s) -> int {
        if (s < CTXL) return TMAIN + b * CTXL + (dir ? CTXL - 1 - s : s);
        const int t = s - CTXL; return b * SEQL + (dir ? SEQL - 1 - t : t);
    };
    u32x4 gk, gv, gr, ga, gm;
    auto issue = [&](int ch) { const size_t o = (size_t)row_of(ch * 64 + st) * 256 + h * 64 + c0;
        gk = *(const u32x4*)(RK + o); gv = *(const u32x4*)(RV + o); gr = *(const u32x4*)(RR + o); ga = *(const u32x4*)(RA + o); gm = *(const u32x4*)(RM + o); };
    issue(0);
    for (int ch = 0; ch < 68; ++ch) {
        {
            float k[8], a[8], om[8], rr[8], vv8[8]; unpack8(gk, k); unpack8(ga, a); unpack8(gm, om); unpack8(gr, rr); unpack8(gv, vv8);
            float kk[8]; float n2 = 0.f;
#pragma unroll
            for (int i = 0; i < 8; ++i) { kk[i] = k[i] * kkp[i]; n2 += kk[i] * kk[i]; }
            n2 = red8(n2);
            const float rn = 1.f / sqrtf(fmaxf(n2, 1e-12f));
            f32x4 o0, o1;
#define ST8(DST, EXPR) { float t8[8]; _Pragma("unroll") for (int i = 0; i < 8; ++i) t8[i] = (EXPR); \
            *(LAS f32x4*)(DST + st * 64 + c0) = (f32x4){t8[0], t8[1], t8[2], t8[3]}; *(LAS f32x4*)(DST + st * 64 + c0 + 4) = (f32x4){t8[4], t8[5], t8[6], t8[7]}; }
            ST8(KH, kk[i] * rn)
            ST8(WW, 1.f - om[i])
            ST8(BB, kk[i] * rn * a[i])
            ST8(KT, k[i] * (1.f + (a[i] - 1.f) * kap[i]))
            ST8(RRl, rr[i])
            ST8(VV, vv8[i])
#undef ST8
        }
        __syncthreads();
        if (ch + 1 < 68) issue(ch + 1);
        if (compute) {
            struct Ops { f32x4 kh0, kh1, w0, w1, b0, b1, t0, t1, r0, r1; float vv; };
            auto ldops = [&](int s) -> Ops { Ops q;
                q.kh0 = *(const LAS f32x4*)(KH + s * 64 + kq * 8); q.kh1 = *(const LAS f32x4*)(KH + s * 64 + kq * 8 + 4);
                q.w0 = *(const LAS f32x4*)(WW + s * 64 + kq * 8); q.w1 = *(const LAS f32x4*)(WW + s * 64 + kq * 8 + 4);
                q.b0 = *(const LAS f32x4*)(BB + s * 64 + kq * 8); q.b1 = *(const LAS f32x4*)(BB + s * 64 + kq * 8 + 4);
                q.t0 = *(const LAS f32x4*)(KT + s * 64 + kq * 8); q.t1 = *(const LAS f32x4*)(KT + s * 64 + kq * 8 + 4);
                q.r0 = *(const LAS f32x4*)(RRl + s * 64 + kq * 8); q.r1 = *(const LAS f32x4*)(RRl + s * 64 + kq * 8 + 4);
                q.vv = VV[s * 64 + half * 32 + row_l]; return q; };
            Ops nx = ldops(0);
#pragma unroll 2
            for (int s = 0; s < 64; ++s) {
                const Ops c = nx;
                nx = ldops(s + 1 < 64 ? s + 1 : 63);
                f32x2 a2 = S[0] * (f32x2){c.kh0.x, c.kh0.y};
                a2 = S[1] * (f32x2){c.kh0.z, c.kh0.w} + a2; a2 = S[2] * (f32x2){c.kh1.x, c.kh1.y} + a2; a2 = S[3] * (f32x2){c.kh1.z, c.kh1.w} + a2;
                const float sk = red8(a2.x + a2.y);
                const f32x2 nsk = (f32x2){-sk, -sk}, vv2 = (f32x2){c.vv, c.vv};
                S[0] = S[0] * (f32x2){c.w0.x, c.w0.y} + (nsk * (f32x2){c.b0.x, c.b0.y} + vv2 * (f32x2){c.t0.x, c.t0.y});
                S[1] = S[1] * (f32x2){c.w0.z, c.w0.w} + (nsk * (f32x2){c.b0.z, c.b0.w} + vv2 * (f32x2){c.t0.z, c.t0.w});
                S[2] = S[2] * (f32x2){c.w1.x, c.w1.y} + (nsk * (f32x2){c.b1.x, c.b1.y} + vv2 * (f32x2){c.t1.x, c.t1.y});
                S[3] = S[3] * (f32x2){c.w1.z, c.w1.w} + (nsk * (f32x2){c.b1.z, c.b1.w} + vv2 * (f32x2){c.t1.z, c.t1.w});
                f32x2 o2 = S[0] * (f32x2){c.r0.x, c.r0.y};
                o2 = S[1] * (f32x2){c.r0.z, c.r0.w} + o2; o2 = S[2] * (f32x2){c.r1.x, c.r1.y} + o2; o2 = S[3] * (f32x2){c.r1.z, c.r1.w} + o2;
                const float ov = red8(o2.x + o2.y);
                if (kq == 0) OUT[s * 32 + row_l] = ov;
            }
        }
        __syncthreads();
        { const int c4 = (tid & 7) * 4; const f32x4 ov = *(const LAS f32x4*)(OUT + st * 32 + c4);
          u32x2 o2; o2.x = pk2(ov.x, ov.y); o2.y = pk2(ov.z, ov.w);
          *(u32x2*)(P + (size_t)row_of(ch * 64 + st) * NP + ocol + c4) = o2; }
    }
    __syncthreads();
}

__device__ __forceinline__ void mixer_mla(const Params& p, LAS unsigned char* lds, int it) {
    bf16_t* P = (bf16_t*)(p.ws + WS_P);
    const bf16_t* MQ = (const bf16_t*)(p.ws + WS_MQ);
    if (it < 1024) { const int b = it >> 7, h = (it >> 5) & 3, qb = it & 31; const int row0 = b * SEQL + qb * 128;
        attn_unit<96>(MQ + (size_t)row0 * 384 + h * 96, 384, (const bf16_t*)(p.ws + WS_KM) + (size_t)(b * 4 + h) * NKEYS * 96, (const bf16_t*)(p.ws + WS_VTM) + (size_t)(b * 4 + h) * 64 * NKEYS,
                      4, 4, 68, false, 0, false, 0.f, 0.10206207f, P + (size_t)row0 * NP + PC_MLAQD + h * 64, NP, lds); }
    else { const int u = it - 1024, b = u >> 3, h = (u >> 1) & 3, qb = u & 1; const int row0 = TMAIN + b * CTXL + qb * 128;
        attn_unit<96>(MQ + (size_t)row0 * 384 + h * 96, 384, (const bf16_t*)(p.ws + WS_KM) + (size_t)(b * 4 + h) * NKEYS * 96, (const bf16_t*)(p.ws + WS_VTM) + (size_t)(b * 4 + h) * 64 * NKEYS,
                      4, 4, 4, false, 0, false, 0.f, 0.10206207f, P + (size_t)row0 * NP + PC_MLAQD + h * 64, NP, lds); }
}
__device__ __forceinline__ void mixer_swa(const Params& p, int l, LAS unsigned char* lds, int u0) {
    bf16_t* P = (bf16_t*)(p.ws + WS_P);
    if (u0 < 1024) { const int b = u0 >> 7, h = (u0 >> 5) & 3, qb = u0 & 31, hk = h >> 1; const int row0 = b * SEQL + qb * 128;
        int mt0 = 4 + 2 * (qb - 1), mt1 = 4 + 2 * (qb + 2); if (mt0 < 4) mt0 = 4; if (mt1 > 68) mt1 = 68;
        bf16_t* qp = P + (size_t)row0 * NP + PC_SWAQ + h * 64;
        attn_unit<64>(qp, NP, (const bf16_t*)(p.ws + WS_KS) + (size_t)(b * 2 + hk) * NKEYS * 64, (const bf16_t*)(p.ws + WS_VTS) + (size_t)(b * 2 + hk) * 64 * NKEYS,
                      4, mt0, mt1, true, qb * 128, true, p.in[12][l * 4 + h], 0.125f, qp, NP, lds); }
    else { const int u = u0 - 1024, b = u >> 3, h = (u >> 1) & 3, qb = u & 1, hk = h >> 1; const int row0 = TMAIN + b * CTXL + qb * 128;
        bf16_t* qp = P + (size_t)row0 * NP + PC_SWAQ + h * 64;
        attn_unit<64>(qp, NP, (const bf16_t*)(p.ws + WS_KS) + (size_t)(b * 2 + hk) * NKEYS * 64, (const bf16_t*)(p.ws + WS_VTS) + (size_t)(b * 2 + hk) * 64 * NKEYS,
                      4, 4, 4, false, 0, true, p.in[12][l * 4 + h], 0.125f, qp, NP, lds); }
}
__device__ __forceinline__ void phase_mixers(const Params& p, int l, LAS unsigned char* lds, int bid, int nb) {
    const bool ectx = (l == 0);
    const int N_MLA = 1024 + (ectx ? 64 : 0), N_SWA = 1024 + (ectx ? 64 : 0), N_RET = 1024 + (ectx ? 64 : 0);
    const int RB_CNT = (N_RET / 5) * 2 + ((N_RET % 5) < 2 ? (N_RET % 5) : 2), RA_CNT = N_RET - RB_CNT;
    if (bid < NSCANBLK) {
        rwkv_scan_item(p, l, lds, bid);
        for (int it = bid; it < N_SWA + RB_CNT; it += NSCANBLK) {
            if (it < N_SWA) mixer_swa(p, l, lds, it);
            else { const int k = it - N_SWA; ret_out_item(p, l, lds, (k >> 1) * 5 + (k & 1)); }
        }
    } else {
        for (int it = bid - NSCANBLK; it < N_MLA + RA_CNT; it += nb - NSCANBLK) {
            if (it < N_MLA) mixer_mla(p, lds, it);
            else { const int k = it - N_MLA; ret_out_item(p, l, lds, (k / 3) * 5 + 2 + (k % 3)); }
        }
    }
}

__device__ __forceinline__ void phase_rwkv_finish(const Params& p, int l, LAS unsigned char* lds, int bid, int nb) {
    const int tid = get_tid();
    bf16_t* P = (bf16_t*)(p.ws + WS_P);
    const int ntiles = (l == 0 ? TT : TMAIN) / 32;
    const float* mu = p.in[14] + l * 1024 + 896;
    const float* gup = p.in[19] + (size_t)l * 128 * 256;
    const bf16_t* RV = (const bf16_t*)(p.ws + WS_RWV); const float* BON = (const float*)(p.ws + WS_BON);
    LAS float* sg = (LAS float*)lds;
    for (int tile = bid; tile < ntiles; tile += nb) {
        const int t0 = tile * 32; const SeqInfo s0 = seq_of_row(t0);
        { const int tok = tid >> 4, j8 = (tid & 15) * 8; const int row = t0 + tok, pos = s0.pos + tok;
          const u32x4 u0 = *(const u32x4*)(P + (size_t)row * NP + PC_RWGD + j8);
          const u32x4 um = pos > 0 ? *(const u32x4*)(P + (size_t)(row - 1) * NP + PC_RWGD + j8) : (u32x4){0u, 0u, 0u, 0u};
          const u32x4 up = pos < s0.len - 1 ? *(const u32x4*)(P + (size_t)(row + 1) * NP + PC_RWGD + j8) : (u32x4){0u, 0u, 0u, 0u};
          float z0[8], zm[8], zp[8]; unpack8(u0, z0); unpack8(um, zm); unpack8(up, zp);
#pragma unroll
          for (int x = 0; x < 8; ++x) sg[tok * 128 + j8 + x] = sigmoidf_(z0[x] + mu[j8 + x] * (0.5f * (zm[x] + zp[x]) - z0[x])); }
        __syncthreads();
        const int hh = tid >> 8, c = tid & 255, h = c >> 6;
        float g[16];
#pragma unroll
        for (int i = 0; i < 16; ++i) g[i] = 0.f;
#pragma unroll 8
        for (int j = 0; j < 128; ++j) { const float w = gup[j * 256 + c];
#pragma unroll
            for (int i = 0; i < 16; ++i) g[i] += sg[(hh * 16 + i) * 128 + j] * w; }
        const float gn = p.in[23][l * 256 + c];
        float ov[16], rv[16], bn[16];
#pragma unroll
        for (int i = 0; i < 16; ++i) { const int row = t0 + hh * 16 + i;
            ov[i] = bf2f(P[(size_t)row * NP + PC_RWO0 + c]) + bf2f(P[(size_t)row * NP + PC_RWO1 + c]); rv[i] = bf2f(RV[(size_t)row * 256 + c]); bn[i] = BON[(size_t)row * 4 + h]; }
#pragma unroll
        for (int i = 0; i < 16; ++i) { const int row = t0 + hh * 16 + i;
            const float o = ov[i];
            const float mean = wave_sum(o) * (1.f / 64.f); const float dl = o - mean; const float var = wave_sum(dl * dl) * (1.f / 64.f);
            float y = dl * (1.f / sqrtf(var + 64e-5f)) * gn + bn[i] * rv[i];
            P[(size_t)row * NP + PC_RWO1 + c] = f2bf(y * g[i]); }
        __syncthreads();
    }
}

#ifndef N_LAUNCH_MODE
#define N_LAUNCH_MODE 1
#endif
template <int Q>
__device__ __forceinline__ void layer_phase(const Params& p, int l, LAS unsigned char* lds, int bid, int nb) {
    unsigned char* wb = p.ws + WS_WB + (size_t)l * WB_LAYER;
    const int Mrows = (l == 0) ? TT : TMAIN;
    pg8::StaticOrder S;
    if constexpr (Q == 0) { pg8::Gemm g{(const bf16_t*)(p.ws + WS_HB), (const bf16_t*)(wb + WB_IN), TT, NP, DM, DM}; S.init(TT, NP, nb, bid);
              pg8::EpiBf16<0> E{(bf16_t*)(p.ws + WS_P), NP}; pg8::gemm_phase(lds, g, S, E); }
    if constexpr (Q == 1) phase_prepA(p, l, lds, bid, nb);
    if constexpr (Q == 2) phase_prepB(p, l, lds, bid, nb);
    if constexpr (Q == 3) phase_mixers(p, l, lds, bid, nb);
    if constexpr (Q == 4) phase_rwkv_finish(p, l, lds, bid, nb);
    if constexpr (Q == 5) { pg8::Gemm g{(const bf16_t*)(p.ws + WS_P), (const bf16_t*)(wb + WB_OUT), Mrows, DM, DM, NP}; S.init(Mrows, DM, nb, bid);
              pg8::EpiBf16<0> E{(bf16_t*)(p.ws + WS_Z), DM}; pg8::gemm_phase(lds, g, S, E); }
    if constexpr (Q == 6) phase_rowops(p, 1, l, Mrows, bid, nb);
    if constexpr (Q == 7) { pg8::Gemm g{(const bf16_t*)(p.ws + WS_HB), (const bf16_t*)(wb + WB_W1), Mrows, FF, DM, DM}; S.init(Mrows, FF, nb, bid);
              pg8::EpiBf16<1> E{(bf16_t*)(p.ws + WS_HID), FF}; pg8::gemm_phase(lds, g, S, E); }
    if constexpr (Q == 8) { pg8::Gemm g{(const bf16_t*)(p.ws + WS_HID), (const bf16_t*)(wb + WB_W2), Mrows, DM, FF, FF}; S.init(Mrows, DM, nb, bid);
              pg8::EpiBf16<0> E{(bf16_t*)(p.ws + WS_Z), DM}; pg8::gemm_phase(lds, g, S, E); }
    if constexpr (Q == 9) phase_rowops(p, 2, l, Mrows, bid, nb);
}

#ifndef PROBE_MASK
#define PROBE_MASK 0
#endif
#define PB(BIT, CALL) do { if ((PROBE_MASK) & (BIT)) { const unsigned long long t0_ = __builtin_amdgcn_s_memrealtime(); CALL; const unsigned long long t1_ = __builtin_amdgcn_s_memrealtime(); \
        while (__builtin_amdgcn_s_memrealtime() - t1_ < (t1_ - t0_)) __builtin_amdgcn_s_sleep(8); } else { CALL; } } while (0)
#define GSYNC() do { asm volatile("s_waitcnt vmcnt(0) lgkmcnt(0)" ::: "memory"); __syncthreads(); if (get_tid() < 64) __threadfence(); grid.sync(); if (get_tid() < 64) __threadfence(); __syncthreads(); } while (0)
__global__ void __launch_bounds__(512, 2) mega_fwd(Params p) {
    extern __shared__ __attribute__((aligned(16))) unsigned char lds_raw[];
    LAS unsigned char* lds = (LAS unsigned char*)lds_raw;
    cg::grid_group grid = cg::this_grid();
    const int bid = blockIdx.x, nb = gridDim.x;
    PB(16, phase_prologue(p, lds, bid, nb)); GSYNC();
    PB(8, phase_rowops(p, 0, 0, TT, bid, nb)); GSYNC();
#define LAYER(L, LAST) \
    PB(1, layer_phase<0>(p, L, lds, bid, nb)); GSYNC(); PB(4, layer_phase<1>(p, L, lds, bid, nb)); GSYNC(); PB(4, layer_phase<2>(p, L, lds, bid, nb)); GSYNC(); \
    PB(2, layer_phase<3>(p, L, lds, bid, nb)); GSYNC(); PB(4, layer_phase<4>(p, L, lds, bid, nb)); GSYNC(); PB(1, layer_phase<5>(p, L, lds, bid, nb)); GSYNC(); \
    PB(8, layer_phase<6>(p, L, lds, bid, nb)); GSYNC(); PB(1, layer_phase<7>(p, L, lds, bid, nb)); GSYNC(); PB(1, layer_phase<8>(p, L, lds, bid, nb)); GSYNC(); \
    PB(8, layer_phase<9>(p, L, lds, bid, nb)); if (!(LAST)) GSYNC();
    LAYER(0, false)
    LAYER(1, true)
}
#if N_LAUNCH_MODE != 1
template <int PH> __global__ void __launch_bounds__(512, 2) one_phase(Params p, int l) {
    extern __shared__ __attribute__((aligned(16))) unsigned char lds_raw[];
    LAS unsigned char* lds = (LAS unsigned char*)lds_raw;
    if constexpr (PH == 100) phase_prologue(p, lds, blockIdx.x, gridDim.x);
    else if constexpr (PH == 101) phase_rowops(p, 0, 0, TT, blockIdx.x, gridDim.x);
    else layer_phase<PH>(p, l, lds, blockIdx.x, gridDim.x);
}
#endif

extern "C" void kernel_launch(void* const* d_in, const int* in_sizes, int n_in, void* d_out, int out_size, void* d_ws, size_t ws_size, hipStream_t stream) {
    if (n_in != 30 || ws_size < WS_NEED || out_size != TMAIN * DM) { fprintf(stderr, "kernel_launch: unexpected shapes (n_in %d, ws %zu, out %d)\n", n_in, ws_size, out_size); return; }
    Params p{};
    for (int i = 0; i < 30; ++i) p.in[i] = (const float*)d_in[i];
    p.out = (float*)d_out; p.ws = (unsigned char*)d_ws;
    static int grid_blocks = 0;
    if (!grid_blocks) {
        int dev = 0, cus = 0, per_cu = 0;
        (void)hipGetDevice(&dev);
        (void)hipDeviceGetAttribute(&cus, hipDeviceAttributeMultiprocessorCount, dev);
        (void)hipFuncSetAttribute((const void*)mega_fwd, hipFuncAttributeMaxDynamicSharedMemorySize, LDS_BYTES);
        (void)hipOccupancyMaxActiveBlocksPerMultiprocessor(&per_cu, mega_fwd, 512, LDS_BYTES);
        if (per_cu < 1) { fprintf(stderr, "kernel_launch: occupancy query says %d blocks/CU\n", per_cu); per_cu = 1; }
        grid_blocks = cus * 1;
        if (grid_blocks < 128) { fprintf(stderr, "kernel_launch: only %d CUs\n", grid_blocks); }
    }
#if N_LAUNCH_MODE == 1
    void* args[] = {&p};
    hipError_t e = hipLaunchCooperativeKernel((const void*)mega_fwd, dim3(grid_blocks), dim3(512), args, LDS_BYTES, stream);
    if (e != hipSuccess) fprintf(stderr, "cooperative launch failed: %s (grid %d)\n", hipGetErrorString(e), grid_blocks);
#else
#define LP(PH, L) do { (void)hipFuncSetAttribute((const void*)one_phase<PH>, hipFuncAttributeMaxDynamicSharedMemorySize, LDS_BYTES); one_phase<PH><<<grid_blocks, 512, LDS_BYTES, stream>>>(p, L); } while (0)
    LP(100, 0); LP(101, 0);
    for (int l = 0; l < 2; ++l) { LP(0, l); LP(1, l); LP(2, l); LP(3, l); LP(4, l); LP(5, l); LP(6, l); LP(7, l); LP(8, l); LP(9, l); }
#endif
}
```

```cpp
#include <hip/hip_runtime.h>
#include <hip/hip_cooperative_groups.h>
#include <cstdio>
#include <cstdint>
#include <cmath>
namespace cg = cooperative_groups;
__device__ __forceinline__ int get_tid() { int t = threadIdx.x; asm volatile("" : "+v"(t)); return t; }
namespace pg8 {
#define PG8_LAS __attribute__((address_space(3)))
typedef unsigned short bf16_t;
typedef short bf16x8 __attribute__((ext_vector_type(8)));
typedef float f32x4 __attribute__((ext_vector_type(4)));
typedef unsigned u32x4 __attribute__((ext_vector_type(4)));
typedef unsigned u32x2 __attribute__((ext_vector_type(2)));
constexpr int BM = 256, BK = 64, HALF = 128, HTB = HALF * BK * 2, STAGE_BYTES = 8 * HTB, NXCD = 8, WGM = 8;

__host__ __device__ __forceinline__ int lds_byte(int r, int c) { const int st = (r >> 4) * 2 + (c >> 5), rr = r & 15, cc = c & 31, ob = rr * 64 + cc * 2; return st * 1024 + (ob ^ (((ob >> 9) & 1) << 5)); }
__host__ __device__ __forceinline__ void stage_rc(int b, int& R, int& C) { const int st = b / 1024, sb = b % 1024, swz = sb ^ (((sb >> 9) & 1) << 5); R = (st >> 1) * 16 + swz / 64; C = (st & 1) * 32 + (swz % 64) / 2; }

struct Unit { int pm, pn; };
struct Gemm { const bf16_t* A; const bf16_t* Bt; int M, N, K, lda; };

struct StaticOrder {
    int nM, nN, nwg, G, c;
    __host__ __device__ void init(int M, int N, int G_, int c_) { nM = M / BM; nN = N / BM; nwg = nM * nN; G = G_; c = c_; }
    __host__ __device__ bool next(int i, Unit& u) const {
        const long L = (long)i * G + c; if (L >= nwg) return false;
        int wgid = (int)L; { const int q = nwg / NXCD, r = nwg % NXCD, xcd = wgid % NXCD, off = wgid / NXCD; wgid = (xcd < r ? xcd * (q + 1) : r * (q + 1) + (xcd - r) * q) + off; }
        const int nig = WGM * nN, gid = wgid / nig, fm = gid * WGM, gsz = (nM - fm) < WGM ? (nM - fm) : WGM;
        u.pm = fm + ((wgid % nig) % gsz); u.pn = (wgid % nig) / gsz; return true;
    }
};

template <class Epi>
__device__ __forceinline__ void gemm_phase(PG8_LAS unsigned char* lds, const Gemm g, const StaticOrder& S, const Epi& E) {
    const int tid = get_tid(), wid = __builtin_amdgcn_readfirstlane(tid >> 6), lane = tid & 63, wr = wid >> 2, wc = wid & 3, fr = lane & 15, fq = lane >> 4;
    const int K = g.K, nt = K / BK, lda = g.lda;
    unsigned voffA[2], voffB[2];
#pragma unroll
    for (int i = 0; i < 2; ++i) { int R, C; stage_rc(tid * 16 + i * 8192, R, C);
        voffA[i] = (unsigned)(R * lda + C) * 2u; voffB[i] = (unsigned)(R * K + C) * 2u; }
    const size_t kstep = (size_t)(BK * 2);
    const size_t hstepA = (size_t)HALF * lda * 2, hstepB = (size_t)HALF * K * 2;
    const size_t tstepA = 2 * hstepA, tstepB = 2 * hstepB;
    const unsigned ldsw = (unsigned)wid * 1024u;
    const int aoff = lds_byte(wr * 64 + fr, fq * 8), boff = lds_byte(wc * 32 + fr, fq * 8);
#define PG8_SA(b, h) (((b) * 2 + (h)) * HTB)
#define PG8_SB(b, h) ((4 + (b) * 2 + (h)) * HTB)
#define PG8_STAGE(bufoff, gbase, voff) do { _Pragma("unroll") for (int _i = 0; _i < 2; ++_i) \
        __builtin_amdgcn_global_load_lds((const unsigned*)((const char*)(gbase) + (voff)[_i]), (PG8_LAS unsigned*)(lds + (bufoff) + ldsw + _i * 8192), 16, 0, 0); } while (0)
#define PG8_LDA(dst, b, h) do { _Pragma("unroll") for (int m = 0; m < 4; ++m) _Pragma("unroll") for (int k = 0; k < 2; ++k) dst[m][k] = *(const PG8_LAS bf16x8*)(lds + PG8_SA(b, h) + aoff + m * 2048 + k * 1024); } while (0)
#define PG8_LDB(dst, b, h) do { _Pragma("unroll") for (int n = 0; n < 2; ++n) _Pragma("unroll") for (int k = 0; k < 2; ++k) dst[n][k] = *(const PG8_LAS bf16x8*)(lds + PG8_SB(b, h) + boff + n * 2048 + k * 1024); } while (0)
#define PG8_MMA(ai, bj, At, Bt) do { __builtin_amdgcn_s_setprio(1); _Pragma("unroll") for (int m = 0; m < 4; ++m) _Pragma("unroll") for (int n = 0; n < 2; ++n) _Pragma("unroll") for (int k = 0; k < 2; ++k) \
        acc[ai][bj][m][n] = __builtin_amdgcn_mfma_f32_16x16x32_bf16(Bt[n][k], At[m][k], acc[ai][bj][m][n], 0, 0, 0); __builtin_amdgcn_s_setprio(0); } while (0)
#define PG8_WAIT_V(n) asm volatile("s_waitcnt vmcnt(" #n ")" ::: "memory")
#define PG8_WAIT_L(n) asm volatile("s_waitcnt lgkmcnt(" #n ")" ::: "memory")
#define PG8_BAR __builtin_amdgcn_s_barrier()
#define PG8_SCHED __builtin_amdgcn_sched_barrier(0)
    Unit cur, nxt; int ui = 0;
    if (!S.next(0, cur)) return;
    f32x4 acc[2][2][4][2];
#pragma unroll
    for (int a = 0; a < 2; ++a)
#pragma unroll
        for (int b = 0; b < 2; ++b)
#pragma unroll
            for (int m = 0; m < 4; ++m)
#pragma unroll
                for (int n = 0; n < 2; ++n) acc[a][b][m][n] = (f32x4){0.f, 0.f, 0.f, 0.f};
    bf16x8 At[4][2], B0[2][2], B1[2][2];
    const char* cA = (const char*)g.A + (size_t)cur.pm * tstepA; const char* cB = (const char*)g.Bt + (size_t)cur.pn * tstepB;
    PG8_STAGE(PG8_SB(0, 0), cB, voffB); PG8_STAGE(PG8_SA(0, 0), cA, voffA); PG8_STAGE(PG8_SB(0, 1), cB + hstepB, voffB); PG8_STAGE(PG8_SA(0, 1), cA + hstepA, voffA);
    if (wr == 1) PG8_BAR;
    PG8_WAIT_V(4); PG8_BAR;
    PG8_STAGE(PG8_SB(1, 0), cB + kstep, voffB); PG8_STAGE(PG8_SA(1, 0), cA + kstep, voffA); PG8_STAGE(PG8_SB(1, 1), cB + hstepB + kstep, voffB);
    PG8_WAIT_V(6); PG8_BAR;
    for (;;) {
        const bool has_next = S.next(ui + 1, nxt);
        const char* nA = has_next ? (const char*)g.A + (size_t)nxt.pm * tstepA : cA; const char* nB = has_next ? (const char*)g.Bt + (size_t)nxt.pn * tstepB : cB;
        for (int t = 0; t < nt; t += 2) {
            const bool last = (t == nt - 2);
            const char* a1 = cA + (size_t)(t + 1) * kstep;
            const char* a2 = last ? nA : cA + (size_t)(t + 2) * kstep; const char* b2 = last ? nB : cB + (size_t)(t + 2) * kstep;
            const char* a3 = a2 + kstep; const char* b3 = b2 + kstep;
            PG8_LDB(B0, 0, 0); PG8_SCHED; PG8_LDA(At, 0, 0); PG8_STAGE(PG8_SA(1, 1), a1 + hstepA, voffA);
            PG8_WAIT_L(8); PG8_BAR; PG8_WAIT_L(0); PG8_MMA(0, 0, At, B0); PG8_BAR; PG8_SCHED;
            PG8_LDB(B1, 0, 1); PG8_STAGE(PG8_SB(0, 0), b2, voffB);
            PG8_BAR; PG8_WAIT_L(0); PG8_MMA(0, 1, At, B1); PG8_BAR;
            PG8_LDA(At, 0, 1); PG8_STAGE(PG8_SA(0, 0), a2, voffA);
            PG8_BAR; PG8_WAIT_L(0); PG8_MMA(1, 0, At, B0); PG8_BAR; PG8_SCHED;
            PG8_STAGE(PG8_SB(0, 1), b2 + hstepB, voffB);
            PG8_WAIT_V(6); PG8_BAR; PG8_MMA(1, 1, At, B1); PG8_BAR;
            PG8_LDB(B0, 1, 0); PG8_SCHED; PG8_LDA(At, 1, 0); PG8_STAGE(PG8_SA(0, 1), a2 + hstepA, voffA);
            PG8_WAIT_L(8); PG8_BAR; PG8_WAIT_L(0); PG8_MMA(0, 0, At, B0); PG8_BAR; PG8_SCHED;
            PG8_LDB(B1, 1, 1); PG8_STAGE(PG8_SB(1, 0), b3, voffB);
            PG8_BAR; PG8_WAIT_L(0); PG8_MMA(0, 1, At, B1); PG8_BAR;
            PG8_LDA(At, 1, 1); PG8_STAGE(PG8_SA(1, 0), a3, voffA);
            PG8_BAR; PG8_WAIT_L(0); PG8_MMA(1, 0, At, B0); PG8_BAR; PG8_SCHED;
            PG8_STAGE(PG8_SB(1, 1), b3 + hstepB, voffB);
            PG8_WAIT_V(6); PG8_BAR; PG8_MMA(1, 1, At, B1); PG8_BAR;
        }
        E(acc, cur, wr, wc, fr, fq);
        if (!has_next) break;
#pragma unroll
        for (int a = 0; a < 2; ++a)
#pragma unroll
            for (int b = 0; b < 2; ++b)
#pragma unroll
                for (int m = 0; m < 4; ++m)
#pragma unroll
                    for (int n = 0; n < 2; ++n) acc[a][b][m][n] = (f32x4){0.f, 0.f, 0.f, 0.f};
        cur = nxt; cA = nA; cB = nB; ++ui;
    }
    PG8_WAIT_V(0);
    if (wr == 0) PG8_BAR;
    PG8_BAR;
#undef PG8_SA
#undef PG8_SB
#undef PG8_STAGE
#undef PG8_LDA
#undef PG8_LDB
#undef PG8_MMA
#undef PG8_WAIT_V
#undef PG8_WAIT_L
#undef PG8_BAR
#undef PG8_SCHED
}

__device__ __forceinline__ unsigned f2bf_u(float f) { unsigned u = __builtin_bit_cast(unsigned, f); return (u + 0x7fffu + ((u >> 16) & 1u)) >> 16; }
template <int ACT> struct EpiBf16 {
    bf16_t* O; int ldc;
    __device__ __forceinline__ void operator()(const f32x4 (&acc)[2][2][4][2], const Unit& u, int wr, int wc, int fr, int fq) const {
        const int row0 = u.pm * BM + wr * 64 + fr, col0 = u.pn * BM + wc * 32 + 4 * fq;
#pragma unroll
        for (int ai = 0; ai < 2; ++ai)
#pragma unroll
            for (int m = 0; m < 4; ++m) { bf16_t* rowp = O + (size_t)(row0 + ai * HALF + m * 16) * ldc + col0;
#pragma unroll
                for (int bj = 0; bj < 2; ++bj)
#pragma unroll
                    for (int n = 0; n < 2; ++n) { f32x4 v = acc[ai][bj][m][n];
                        if (ACT == 1) { v.x = v.x > 0.f ? v.x * v.x : 0.f; v.y = v.y > 0.f ? v.y * v.y : 0.f; v.z = v.z > 0.f ? v.z * v.z : 0.f; v.w = v.w > 0.f ? v.w * v.w : 0.f; }
                        u32x2 o; o.x = f2bf_u(v.x) | (f2bf_u(v.y) << 16); o.y = f2bf_u(v.z) | (f2bf_u(v.w) << 16);
                        *(u32x2*)(rowp + bj * HALF + n * 16) = o; } }
    }
};
}
typedef unsigned short bf16_t;
typedef short bf16x8 __attribute__((ext_vector_type(8)));
typedef float f32x4 __attribute__((ext_vector_type(4)));
typedef unsigned u32x4 __attribute__((ext_vector_type(4)));
typedef unsigned u32x2 __attribute__((ext_vector_type(2)));
#define LAS __attribute__((address_space(3)))

constexpr int NBATCH = 8, SEQL = 4096, DM = 1024, CTXL = 256, TMAIN = 32768, TCTX = 2048, TT = 34816, NP = 3072, FF = 4096;
constexpr int PC_SWAQ = 0, PC_RETQ = 256, PC_RWR = 512, PC_MLAQD = 768, PC_SWAK = 1024, PC_SWAV = 1152, PC_RETK = 1280, PC_RETV = 1536, PC_RETG = 1792,
              PC_RWK = 2048, PC_RWV = 2304, PC_RWWD = 2560, PC_RWAD = 2624, PC_RWGD = 2688, PC_MLAKVD = 2816, PC_MLAKPE = 2944;
constexpr int PC_RWO0 = PC_RWV, PC_RWO1 = PC_RWR;
constexpr int NKEYS = CTXL + SEQL;

constexpr size_t MiB = 1u << 20;
constexpr size_t WS_MOD = 0;
constexpr size_t WS_TAB = 512 * 1024;
constexpr size_t WS_BON = 1 * MiB;
constexpr size_t WS_WB = 2 * MiB;
constexpr size_t WB_LAYER = 24 * MiB, WB_IN = 0, WB_OUT = 6 * MiB, WB_W1 = 8 * MiB, WB_W2 = 16 * MiB;
constexpr size_t WS_XC = 50 * MiB;
constexpr size_t WS_P = 58 * MiB;
constexpr size_t WS_HID = 58 * MiB;
constexpr size_t WS_A = 262 * MiB;
constexpr size_t ARR17 = 17 * MiB;
constexpr size_t WS_RWK = WS_A, WS_RWV = WS_A + ARR17, WS_RWRR = WS_A + 2 * ARR17, WS_RWA0 = WS_A + 3 * ARR17, WS_RWA1 = WS_A + 4 * ARR17,
                 WS_RWM0 = WS_A + 5 * ARR17, WS_RWM1 = WS_A + 6 * ARR17;
constexpr size_t WS_RET = WS_A + 119 * MiB;
constexpr size_t WS_MQ = WS_RET + 34 * MiB;
constexpr size_t WS_KM = WS_MQ + 26738688;
constexpr size_t WS_VTM = WS_KM + 26738688;
constexpr size_t WS_KS = WS_VTM + ARR17;
constexpr size_t WS_VTS = WS_KS + 8912896;
constexpr size_t WS_A_END = WS_VTS + 8912896;
constexpr size_t WS_Z = 330 * MiB;
constexpr size_t WS_HB = 398 * MiB;
constexpr size_t WS_NEED = 500 * MiB;
static_assert(WS_A_END <= WS_NEED && WS_HB + 68 * MiB <= WS_NEED && WS_HID + 272 * MiB <= WS_Z, "ws map");

constexpr int LDS_BYTES = 150 * 1024;

struct Params { const float* in[30]; float* out; unsigned char* ws; };

__device__ __forceinline__ float bf2f(bf16_t v) { return __builtin_bit_cast(float, (unsigned)v << 16); }
__device__ __forceinline__ bf16_t f2bf(float f) { unsigned u = __builtin_bit_cast(unsigned, f); return (bf16_t)((u + 0x7fffu + ((u >> 16) & 1u)) >> 16); }
__device__ __forceinline__ unsigned pk2(float lo, float hi) { return (unsigned)f2bf(lo) | ((unsigned)f2bf(hi) << 16); }
typedef float f32x2 __attribute__((ext_vector_type(2)));
template <int CTRL> __device__ __forceinline__ float dppf(float v) { return __builtin_bit_cast(float, __builtin_amdgcn_update_dpp(0, __builtin_bit_cast(int, v), CTRL, 0xF, 0xF, true)); }
__device__ __forceinline__ float red4(float v) { v += dppf<0xB1>(v); v += dppf<0x4E>(v); return v; }
__device__ __forceinline__ float red8(float v) { v = red4(v); v += dppf<0x141>(v); return v; }
__device__ __forceinline__ float red16(float v) { v = red8(v); v += dppf<0x140>(v); return v; }
__device__ __forceinline__ float max16(float v) { v = fmaxf(v, dppf<0xB1>(v)); v = fmaxf(v, dppf<0x4E>(v)); v = fmaxf(v, dppf<0x141>(v)); v = fmaxf(v, dppf<0x140>(v)); return v; }
__device__ __forceinline__ float wave_sum(float v) {
    v = red16(v);
    const int u = __builtin_bit_cast(int, v);
    return __builtin_bit_cast(float, __builtin_amdgcn_readlane(u, 0)) + __builtin_bit_cast(float, __builtin_amdgcn_readlane(u, 16)) +
           __builtin_bit_cast(float, __builtin_amdgcn_readlane(u, 32)) + __builtin_bit_cast(float, __builtin_amdgcn_readlane(u, 48));
}
__device__ __forceinline__ void unpack8(const u32x4 u, float* f) {
    f[0] = bf2f((bf16_t)(u.x & 0xffff)); f[1] = bf2f((bf16_t)(u.x >> 16)); f[2] = bf2f((bf16_t)(u.y & 0xffff)); f[3] = bf2f((bf16_t)(u.y >> 16));
    f[4] = bf2f((bf16_t)(u.z & 0xffff)); f[5] = bf2f((bf16_t)(u.z >> 16)); f[6] = bf2f((bf16_t)(u.w & 0xffff)); f[7] = bf2f((bf16_t)(u.w >> 16));
}
__device__ __forceinline__ float sigmoidf_(float x) { return 1.f / (1.f + __expf(-x)); }

struct SeqInfo { int b, pos, len, start, isctx; };
__device__ __forceinline__ SeqInfo seq_of_row(int row) {
    SeqInfo s;
    if (row < TMAIN) { s.b = row >> 12; s.pos = row & 4095; s.len = SEQL; s.start = s.b << 12; s.isctx = 0; }
    else { const int r = row - TMAIN; s.b = r >> 8; s.pos = r & 255; s.len = CTXL; s.start = TMAIN + (s.b << 8); s.isctx = 1; }
    return s;
}

__device__ __forceinline__ void transpose_item(const float* W, int N, int nsrc0, bf16_t* WT, int K, int ndst0, int k0, LAS float* scr, int lane) {
    if (nsrc0 >= 0) {
#pragma unroll 32
        for (int i = 0; i < 32; ++i) { const int kk = 2 * i + (lane >> 5); scr[kk * 33 + (lane & 31)] = W[(size_t)(k0 + kk) * N + nsrc0 + (lane & 31)]; }
    } else {
#pragma unroll 8
        for (int i = 0; i < 32; ++i) { const int kk = 2 * i + (lane >> 5); scr[kk * 33 + (lane & 31)] = 0.f; }
    }
    __builtin_amdgcn_wave_barrier(); asm volatile("s_waitcnt lgkmcnt(0)" ::: "memory");
    const int c = lane & 7;
#pragma unroll
    for (int j = 0; j < 4; ++j) { const int n = (lane >> 3) + 8 * j; const LAS float* s = scr + (8 * c) * 33 + n;
        u32x4 o; o.x = pk2(s[0 * 33], s[1 * 33]); o.y = pk2(s[2 * 33], s[3 * 33]); o.z = pk2(s[4 * 33], s[5 * 33]); o.w = pk2(s[6 * 33], s[7 * 33]);
        *(u32x4*)(WT + (size_t)(ndst0 + n) * K + k0 + 8 * c) = o; }
    __builtin_amdgcn_wave_barrier(); asm volatile("s_waitcnt lgkmcnt(0)" ::: "memory");
}
__device__ __forceinline__ int win_src_col(int n) {
    if (n < 256) return n;
    if (n < 512) return 512 + (n - 256);
    if (n < 768) return 1536 + (n - 512);
    if (n < 1024) return 2560 + (n - 768);
    if (n < 1280) return 256 + (n - 1024);
    if (n < 2048) return 768 + (n - 1280);
    if (n < 2816) return 1792 + (n - 2048);
    if (n < 2976) return n;
    return -1;
}
__device__ __forceinline__ void phase_prologue(const Params& p, LAS unsigned char* lds, int bid, int nb) {
    const int tid = get_tid(), lane = tid & 63, wave = tid >> 6;
    LAS float* scr = (LAS float*)(lds + wave * 16384);
    const int gw = bid * 8 + wave, NGW = nb * 8;
    constexpr int I_IN = 16 * 96, I_OUT = 16 * 32, I_1 = 16 * 128, I_2 = 64 * 32, I_L = I_IN + I_OUT + I_1 + I_2;
    for (int it = gw; it < 2 * I_L; it += NGW) {
        const int l = it / I_L; int r = it % I_L;
        unsigned char* wb = p.ws + WS_WB + (size_t)l * WB_LAYER;
        if (r < I_IN) { const int kb = r / 96, nbk = r % 96; transpose_item(p.in[10] + (size_t)l * DM * 2976, 2976, win_src_col(nbk * 32), (bf16_t*)(wb + WB_IN), DM, nbk * 32, kb * 64, scr, lane); continue; } r -= I_IN;
        if (r < I_OUT) { const int kb = r / 32, nbk = r % 32; transpose_item(p.in[11] + (size_t)l * DM * DM, DM, nbk * 32, (bf16_t*)(wb + WB_OUT), DM, nbk * 32, kb * 64, scr, lane); continue; } r -= I_OUT;
        if (r < I_1) { const int kb = r / 128, nbk = r % 128; transpose_item(p.in[28] + (size_t)l * DM * FF, FF, nbk * 32, (bf16_t*)(wb + WB_W1), DM, nbk * 32, kb * 64, scr, lane); continue; } r -= I_1;
        { const int kb = r / 32, nbk = r % 32; transpose_item(p.in[29] + (size_t)l * FF * DM, DM, nbk * 32, (bf16_t*)(wb + WB_W2), FF, nbk * 32, kb * 64, scr, lane); }
    }
    __syncthreads();
    for (int it = bid; it < 192; it += nb) {
        const int l = it / 96, cb = it % 96;
        LAS float* sc = (LAS float*)lds;
        LAS float* red = sc + 9 * 1024;
        for (int e = tid; e < 9 * 1024; e += 512) { const int r = e >> 10, k = e & 1023; const float v = (r < 8) ? p.in[1][r * 1024 + k] : p.in[3][k]; sc[e] = v / (1.f + __expf(-v)); }
        __syncthreads();
        const int ks = tid >> 6, cl = tid & 63, n = cb * 64 + cl;
        float acc[9];
#pragma unroll
        for (int r = 0; r < 9; ++r) acc[r] = 0.f;
        const float* aw = p.in[4] + (size_t)l * DM * 6144;
#pragma unroll 16
        for (int k = ks * 128; k < ks * 128 + 128; ++k) { const float w = aw[(size_t)k * 6144 + n];
#pragma unroll
            for (int r = 0; r < 9; ++r) acc[r] += sc[r * 1024 + k] * w; }
#pragma unroll
        for (int r = 0; r < 9; ++r) red[(ks * 9 + r) * 64 + cl] = acc[r];
        __syncthreads();
        for (int e = tid; e < 9 * 64; e += 512) { const int r = e >> 6, c2 = e & 63; float s = 0.f;
            for (int q = 0; q < 8; ++q) s += red[(q * 9 + r) * 64 + c2];
            ((float*)(p.ws + WS_MOD))[((size_t)l * 9 + r) * 6144 + cb * 64 + c2] = s + p.in[5][(size_t)l * 6144 + cb * 64 + c2]; }
        __syncthreads();
    }
    if (bid == nb - 1) {
        float* tab = (float*)(p.ws + WS_TAB);
        for (int e = tid; e < 64 * 16; e += 512) { const int pos = e >> 4, f = e & 15; const float inv = powf(10000.f, -(float)(2 * f) / 32.f); const float a = (float)pos * inv; tab[e] = cosf(a); tab[1024 + e] = sinf(a); }
        for (int e = tid; e < 64 * 8; e += 512) { const int pos = e >> 3, f = e & 7; const float inv = powf(10000.f, -(float)(2 * f) / 16.f); const float a = (float)pos * inv; tab[2048 + e] = cosf(a); tab[2560 + e] = sinf(a); }
    }
}

struct RowJob { const float* xsrc; const bf16_t* z; const float* gpost; const float* gate; float* xdst; const float* gpre; const float* shift; const float* scale; bf16_t* hdst; };
__device__ __forceinline__ RowJob make_rowjob(const Params& p, int mode, int l, int row) {
    const float* mod = (const float*)(p.ws + WS_MOD);
    bf16_t* HB = (bf16_t*)(p.ws + WS_HB); const bf16_t* Z = (const bf16_t*)(p.ws + WS_Z);
    float* XC = (float*)(p.ws + WS_XC);
    const SeqInfo s = seq_of_row(row);
    const int mr = s.isctx ? 8 : s.b;
    const float* m_l = mod + ((size_t)l * 9 + mr) * 6144;
    float* xs = s.isctx ? XC + (size_t)(row - TMAIN) * DM : p.out + (size_t)row * DM;
    const float* xin = s.isctx ? p.in[2] + (size_t)(row - TMAIN) * DM : p.in[0] + (size_t)row * DM;
    RowJob j;
    if (mode == 0) { j = RowJob{xin, nullptr, nullptr, nullptr, nullptr, p.in[6] + l * DM, m_l + 0, m_l + 1024, HB + (size_t)row * DM}; }
    else if (mode == 1) { j = RowJob{l == 0 ? xin : xs, Z + (size_t)row * DM, p.in[7] + l * DM, m_l + 2048, xs, p.in[8] + l * DM, m_l + 3072, m_l + 4096, HB + (size_t)row * DM}; }
    else { const bool has_next = (l + 1 < 2); const float* m_n = mod + ((size_t)(has_next ? l + 1 : l) * 9 + mr) * 6144;
        j = RowJob{xs, Z + (size_t)row * DM, p.in[9] + l * DM, m_l + 5120, xs, p.in[6] + (has_next ? l + 1 : l) * DM, m_n + 0, m_n + 1024, has_next ? HB + (size_t)row * DM : nullptr}; }
    return j;
}
template <int RB>
__device__ __forceinline__ void rowop_batch(const RowJob (&jb)[RB], const bool (&valid)[RB], int lane) {
    f32x4 v[RB][4]; u32x2 zu[RB][4];
#pragma unroll
    for (int r = 0; r < RB; ++r) if (valid[r]) {
#pragma unroll
        for (int j = 0; j < 4; ++j) { v[r][j] = *(const f32x4*)(jb[r].xsrc + (j * 64 + lane) * 4); if (jb[r].z) zu[r][j] = *(const u32x2*)(jb[r].z + (j * 64 + lane) * 4); }
    }
#pragma unroll
    for (int r = 0; r < RB; ++r) if (valid[r]) {
        const RowJob& J = jb[r];
        if (J.z) {
            f32x4 zz[4], gp[4], gt[4]; float ss = 0.f;
#pragma unroll
            for (int j = 0; j < 4; ++j) { const int c = (j * 64 + lane) * 4; gp[j] = *(const f32x4*)(J.gpost + c); gt[j] = *(const f32x4*)(J.gate + c); }
#pragma unroll
            for (int j = 0; j < 4; ++j) { const u32x2 u = zu[r][j];
                zz[j].x = bf2f((bf16_t)(u.x & 0xffff)); zz[j].y = bf2f((bf16_t)(u.x >> 16)); zz[j].z = bf2f((bf16_t)(u.y & 0xffff)); zz[j].w = bf2f((bf16_t)(u.y >> 16));
                ss += zz[j].x * zz[j].x + zz[j].y * zz[j].y + zz[j].z * zz[j].z + zz[j].w * zz[j].w; }
            const float rinv = 1.f / sqrtf(wave_sum(ss) * (1.f / 1024.f) + 1e-6f);
#pragma unroll
            for (int j = 0; j < 4; ++j) { const int c = (j * 64 + lane) * 4;
                v[r][j].x += gt[j].x * (zz[j].x * rinv * gp[j].x); v[r][j].y += gt[j].y * (zz[j].y * rinv * gp[j].y); v[r][j].z += gt[j].z * (zz[j].z * rinv * gp[j].z); v[r][j].w += gt[j].w * (zz[j].w * rinv * gp[j].w);
                *(f32x4*)(J.xdst + c) = v[r][j]; }
        }
        if (J.hdst) {
            f32x4 g[4], sh[4], sc[4]; float ss = 0.f;
#pragma unroll
            for (int j = 0; j < 4; ++j) { const int c = (j * 64 + lane) * 4; g[j] = *(const f32x4*)(J.gpre + c); sh[j] = *(const f32x4*)(J.shift + c); sc[j] = *(const f32x4*)(J.scale + c); }
#pragma unroll
            for (int j = 0; j < 4; ++j) ss += v[r][j].x * v[r][j].x + v[r][j].y * v[r][j].y + v[r][j].z * v[r][j].z + v[r][j].w * v[r][j].w;
            const float rinv = 1.f / sqrtf(wave_sum(ss) * (1.f / 1024.f) + 1e-6f);
#pragma unroll
            for (int j = 0; j < 4; ++j) { const int c = (j * 64 + lane) * 4;
                u32x2 o; o.x = pk2(v[r][j].x * rinv * g[j].x * (1.f + sc[j].x) + sh[j].x, v[r][j].y * rinv * g[j].y * (1.f + sc[j].y) + sh[j].y);
                o.y = pk2(v[r][j].z * rinv * g[j].z * (1.f + sc[j].z) + sh[j].z, v[r][j].w * rinv * g[j].w * (1.f + sc[j].w) + sh[j].w);
                *(u32x2*)(J.hdst + c) = o; }
        }
    }
}
__device__ __forceinline__ void phase_rowops(const Params& p, int mode, int l, int nrows, int bid, int nb) {
    const int tid = get_tid(), lane = tid & 63, wave = tid >> 6;
    constexpr int RB = 4;
    const int nwaves = nb * 8, gw = bid * 8 + wave;
    for (int base = gw; base < nrows; base += nwaves * RB) {
        RowJob jb[RB]; bool valid[RB];
#pragma unroll
        for (int r = 0; r < RB; ++r) { const int row = base + r * nwaves; valid[r] = row < nrows; jb[r] = make_rowjob(p, mode, l, valid[r] ? row : 0); }
        rowop_batch<RB>(jb, valid, lane);
    }
}

__device__ __forceinline__ void rwkv_prep_item(const Params& p, int l, LAS unsigned char* lds, int tile) {
    const int tid = get_tid();
    const bf16_t* P = (const bf16_t*)(p.ws + WS_P);
    const int t0 = tile * 32; const SeqInfo s0 = seq_of_row(t0);
    const float* mu = p.in[14] + l * 1024;
    LAS float* r_s = (LAS float*)lds;
    LAS float* k_s = r_s + 32 * 256;
    LAS float* v_s = k_s + 32 * 256;
    LAS float* twd = v_s + 32 * 256;
    LAS float* ad_s = twd + 32 * 64;
#pragma unroll
    for (int it = 0; it < 7; ++it) {
        const int pc = tid + it * 512; const int tok = pc / 112, c8 = pc % 112, cc = c8 * 8;
        const int pcol = cc < 256 ? PC_RWR + cc : PC_RWK + (cc - 256);
        const int row = t0 + tok, pos = s0.pos + tok;
        const u32x4 u0 = *(const u32x4*)(P + (size_t)row * NP + pcol);
        const u32x4 um = pos > 0 ? *(const u32x4*)(P + (size_t)(row - 1) * NP + pcol) : (u32x4){0u, 0u, 0u, 0u};
        const u32x4 up = pos < s0.len - 1 ? *(const u32x4*)(P + (size_t)(row + 1) * NP + pcol) : (u32x4){0u, 0u, 0u, 0u};
        const f32x4 mu0 = *(const f32x4*)(mu + cc), mu1 = *(const f32x4*)(mu + cc + 4);
        float z0[8], zm[8], zp[8], zs[8]; unpack8(u0, z0); unpack8(um, zm); unpack8(up, zp);
        const float mm[8] = {mu0.x, mu0.y, mu0.z, mu0.w, mu1.x, mu1.y, mu1.z, mu1.w};
#pragma unroll
        for (int x = 0; x < 8; ++x) zs[x] = z0[x] + mm[x] * (0.5f * (zm[x] + zp[x]) - z0[x]);
        LAS float* dst;
        if (cc < 256) dst = r_s + tok * 256 + cc;
        else if (cc < 512) dst = k_s + tok * 256 + cc - 256;
        else if (cc < 768) dst = v_s + tok * 256 + cc - 512;
        else if (cc < 832) { dst = twd + tok * 64 + cc - 768;
#pragma unroll
            for (int x = 0; x < 8; ++x) zs[x] = 1.f - 2.f / (1.f + __expf(2.f * zs[x])); }
        else dst = ad_s + tok * 64 + cc - 832;
        *(LAS f32x4*)dst = (f32x4){zs[0], zs[1], zs[2], zs[3]}; *(LAS f32x4*)(dst + 4) = (f32x4){zs[4], zs[5], zs[6], zs[7]};
    }
    __syncthreads();
    const int hh = tid >> 8, c = tid & 255, h = c >> 6;
    float aw0[16], aw1[16], aa0[16], aa1[16];
#pragma unroll
    for (int i = 0; i < 16; ++i) { aw0[i] = 0.f; aw1[i] = 0.f; aa0[i] = 0.f; aa1[i] = 0.f; }
    const float* wup = p.in[16] + (size_t)l * 2 * 64 * 256; const float* aup = p.in[18] + (size_t)l * 2 * 64 * 256;
#pragma unroll 4
    for (int j = 0; j < 64; ++j) {
        const float w0 = wup[j * 256 + c], w1 = wup[64 * 256 + j * 256 + c], a0 = aup[j * 256 + c], a1 = aup[64 * 256 + j * 256 + c];
#pragma unroll
        for (int i = 0; i < 16; ++i) { const float tw = twd[(hh * 16 + i) * 64 + j], ta = ad_s[(hh * 16 + i) * 64 + j];
            aw0[i] += tw * w0; aw1[i] += tw * w1; aa0[i] += ta * a0; aa1[i] += ta * a1; }
    }
    const float w0b0 = p.in[15][(l * 2 + 0) * 256 + c], w0b1 = p.in[15][(l * 2 + 1) * 256 + c];
    const float a0b0 = p.in[17][(l * 2 + 0) * 256 + c], a0b1 = p.in[17][(l * 2 + 1) * 256 + c];
    const float ka = p.in[21][l * 256 + c], rk = p.in[22][l * 256 + c];
    bf16_t* RK = (bf16_t*)(p.ws + WS_RWK); bf16_t* RV = (bf16_t*)(p.ws + WS_RWV); bf16_t* RR = (bf16_t*)(p.ws + WS_RWRR);
    bf16_t* RA0 = (bf16_t*)(p.ws + WS_RWA0); bf16_t* RA1 = (bf16_t*)(p.ws + WS_RWA1); bf16_t* RM0 = (bf16_t*)(p.ws + WS_RWM0); bf16_t* RM1 = (bf16_t*)(p.ws + WS_RWM1);
    float* BON = (float*)(p.ws + WS_BON);
#pragma unroll
    for (int i = 0; i < 16; ++i) {
        const int tok = hh * 16 + i, row = t0 + tok;
        const float k = k_s[tok * 256 + c], v = v_s[tok * 256 + c], r = r_s[tok * 256 + c];
        const float sg0 = sigmoidf_(w0b0 + aw0[i]), sg1 = sigmoidf_(w0b1 + aw1[i]);
        const float om0 = 1.f - __expf(-0.60653066f * sg0), om1 = 1.f - __expf(-0.60653066f * sg1);
        const float a0 = sigmoidf_(a0b0 + aa0[i]), a1 = sigmoidf_(a0b1 + aa1[i]);
        const float kt0 = k * (1.f + (a0 - 1.f) * ka), kt1 = k * (1.f + (a1 - 1.f) * ka);
        const float bs = wave_sum(r * (kt0 + kt1) * rk);
        const size_t o = (size_t)row * 256 + c;
        RK[o] = f2bf(k); RV[o] = f2bf(v); RR[o] = f2bf(r); RA0[o] = f2bf(a0); RA1[o] = f2bf(a1); RM0[o] = f2bf(om0); RM1[o] = f2bf(om1);
        if ((tid & 63) == 0) BON[(size_t)row * 4 + h] = bs;
    }
    __syncthreads();
}
__device__ __forceinline__ int ret_chunk_index(int cr, int& b) { if (cr < 256) { b = cr >> 5; return 2 + (cr & 31); } b = (cr - 256) >> 1; return (cr - 256) & 1; }
__device__ __forceinline__ void ret_kv_item(const Params& p, LAS unsigned char* lds, int item) {
    const int tid = get_tid();
    const bf16_t* P = (const bf16_t*)(p.ws + WS_P);
    const int cr = item >> 2, h = item & 3; int b; const int ci = ret_chunk_index(cr, b);
    const int r0 = cr * 128;
    LAS float* Ks = (LAS float*)lds;
    LAS float* Vs = Ks + 128 * 64;
    LAS float* dec = Vs + 128 * 64;
    const float lg = log1pf(-exp2f(-5.f - (float)h));
    for (int e = tid; e < 128 * 64; e += 512) { const int j = e >> 6, d = e & 63;
        Ks[e] = bf2f(P[(size_t)(r0 + j) * NP + PC_RETK + h * 64 + d]) * 0.125f; Vs[e] = bf2f(P[(size_t)(r0 + j) * NP + PC_RETV + h * 64 + d]); }
    if (tid < 128) dec[tid] = expf((float)tid * lg);
    __syncthreads();
    const int d = tid >> 3, e0 = (tid & 7) * 8;
    float af[8], ab[8];
#pragma unroll
    for (int i = 0; i < 8; ++i) { af[i] = 0.f; ab[i] = 0.f; }
    for (int j = 0; j < 128; ++j) { const float kd = Ks[j * 64 + d]; const float kf = kd * dec[127 - j], kb = kd * dec[j];
        const f32x4 v0 = *(const LAS f32x4*)(Vs + j * 64 + e0), v1 = *(const LAS f32x4*)(Vs + j * 64 + e0 + 4);
        af[0] += kf * v0.x; af[1] += kf * v0.y; af[2] += kf * v0.z; af[3] += kf * v0.w; af[4] += kf * v1.x; af[5] += kf * v1.y; af[6] += kf * v1.z; af[7] += kf * v1.w;
        ab[0] += kb * v0.x; ab[1] += kb * v0.y; ab[2] += kb * v0.z; ab[3] += kb * v0.w; ab[4] += kb * v1.x; ab[5] += kb * v1.y; ab[6] += kb * v1.z; ab[7] += kb * v1.w; }
    float* RS = (float*)(p.ws + WS_RET) + ((size_t)((b * 4 + h) * 34 + ci) * 2) * 4096;
#pragma unroll
    for (int i = 0; i < 8; ++i) { RS[d * 64 + e0 + i] = af[i]; RS[4096 + d * 64 + e0 + i] = ab[i]; }
    __syncthreads();
}
__device__ __forceinline__ void swa_prep_item(const Params& p, LAS unsigned char* lds, int tile) {
    const int tid = get_tid();
    bf16_t* P = (bf16_t*)(p.ws + WS_P);
    const float* tabc = (const float*)(p.ws + WS_TAB); const float* tabs = tabc + 1024;
    bf16_t* KS = (bf16_t*)(p.ws + WS_KS); bf16_t* VT = (bf16_t*)(p.ws + WS_VTS);
    const int t0 = tile * 64; const SeqInfo s0 = seq_of_row(t0);
    const int key0 = s0.isctx ? s0.pos : CTXL + s0.pos;
    LAS bf16_t* Vs = (LAS bf16_t*)lds;
    u32x4 vreg[2];
#pragma unroll
    for (int it = 0; it < 2; ++it) { const int pc = tid + it * 512, tok = pc >> 4, c8 = pc & 15; vreg[it] = *(const u32x4*)(P + (size_t)(t0 + tok) * NP + PC_SWAV + c8 * 8); }
    u32x4 x1[3], x2[3];
#pragma unroll
    for (int it = 0; it < 3; ++it) { const int e = tid + it * 512; const int tok = e / 24, rem = e % 24, hd = rem >> 2, axis = (rem >> 1) & 1, fg = rem & 1;
        const int colbase = (hd < 4 ? PC_SWAQ + hd * 64 : PC_SWAK + (hd - 4) * 64) + axis * 32 + fg * 8;
        x1[it] = *(const u32x4*)(P + (size_t)(t0 + tok) * NP + colbase); x2[it] = *(const u32x4*)(P + (size_t)(t0 + tok) * NP + colbase + 16); }
#pragma unroll
    for (int it = 0; it < 2; ++it) { const int pc = tid + it * 512, tok = pc >> 4, c8 = pc & 15; *(LAS u32x4*)(Vs + tok * 136 + c8 * 8) = vreg[it]; }
#pragma unroll
    for (int it = 0; it < 3; ++it) { const int e = tid + it * 512; const int tok = e / 24, rem = e % 24, hd = rem >> 2, axis = (rem >> 1) & 1, fg = rem & 1;
        const int row = t0 + tok, pos = s0.pos + tok;
        const int colbase = (hd < 4 ? PC_SWAQ + hd * 64 : PC_SWAK + (hd - 4) * 64) + axis * 32 + fg * 8;
        float a[8], bb[8]; unpack8(x1[it], a); unpack8(x2[it], bb);
        if (!s0.isctx) { const int pp = axis == 0 ? (pos >> 6) : (pos & 63);
            const f32x4 c0 = *(const f32x4*)(tabc + pp * 16 + fg * 8), c1 = *(const f32x4*)(tabc + pp * 16 + fg * 8 + 4), s0v = *(const f32x4*)(tabs + pp * 16 + fg * 8), s1v = *(const f32x4*)(tabs + pp * 16 + fg * 8 + 4);
            const float cs[8] = {c0.x, c0.y, c0.z, c0.w, c1.x, c1.y, c1.z, c1.w}, sn[8] = {s0v.x, s0v.y, s0v.z, s0v.w, s1v.x, s1v.y, s1v.z, s1v.w};
#pragma unroll
            for (int x = 0; x < 8; ++x) { const float y1 = a[x] * cs[x] - bb[x] * sn[x], y2 = bb[x] * cs[x] + a[x] * sn[x]; a[x] = y1; bb[x] = y2; } }
        u32x4 o1, o2; o1.x = pk2(a[0], a[1]); o1.y = pk2(a[2], a[3]); o1.z = pk2(a[4], a[5]); o1.w = pk2(a[6], a[7]);
        o2.x = pk2(bb[0], bb[1]); o2.y = pk2(bb[2], bb[3]); o2.z = pk2(bb[4], bb[5]); o2.w = pk2(bb[6], bb[7]);
        if (hd < 4) { if (!s0.isctx) { *(u32x4*)(P + (size_t)row * NP + colbase) = o1; *(u32x4*)(P + (size_t)row * NP + colbase + 16) = o2; } }
        else { bf16_t* kd = KS + ((size_t)(s0.b * 2 + (hd - 4)) * NKEYS + key0 + tok) * 64 + axis * 32 + fg * 8; *(u32x4*)kd = o1; *(u32x4*)(kd + 16) = o2; }
    }
    __syncthreads();
#pragma unroll
    for (int it = 0; it < 2; ++it) { const int pc = tid + it * 512, hd = pc >> 3, k8 = pc & 7, hk = hd >> 6, d = hd & 63;
        unsigned w[4];
#pragma unroll
        for (int x = 0; x < 4; ++x) w[x] = (unsigned)Vs[(k8 * 8 + 2 * x) * 136 + hd] | ((unsigned)Vs[(k8 * 8 + 2 * x + 1) * 136 + hd] << 16);
        *(u32x4*)(VT + ((size_t)(s0.b * 2 + hk) * 64 + d) * NKEYS + key0 + k8 * 8) = (u32x4){w[0], w[1], w[2], w[3]}; }
    __syncthreads();
}
__device__ __forceinline__ void phase_prepA(const Params& p, int l, LAS unsigned char* lds, int bid, int nb) {
    constexpr int N1 = TT / 32, N2 = 272 * 4, N3 = TT / 64;
    for (int it = bid; it < N1 + N2 + N3; it += nb) {
        if (it < N1) rwkv_prep_item(p, l, lds, it);
        else if (it < N1 + N2) ret_kv_item(p, lds, it - N1);
        else swa_prep_item(p, lds, it - N1 - N2);
    }
}

__device__ __forceinline__ void mla_proj_item(const Params& p, int l, LAS unsigned char* lds, int tile) {
    const int tid = get_tid(), lane = tid & 63, wave = tid >> 6;
    const bf16_t* P = (const bf16_t*)(p.ws + WS_P);
    const float* tabc = (const float*)(p.ws + WS_TAB) + 2048; const float* tabs = tabc + 512;
    const int t0 = tile * 32; const SeqInfo s0 = seq_of_row(t0);
    const int key0 = s0.isctx ? s0.pos : CTXL + s0.pos;
    LAS float* qn = (LAS float*)lds;
    LAS float* kvn = qn + 32 * 256;
    LAS float* qo = kvn + 32 * 128;
    const float* qg = p.in[24] + l * 256; const float* kvg = p.in[26] + l * 128;
    for (int i = 0; i < 4; ++i) { const int tok = wave * 4 + i, row = t0 + tok;
        float x[4]; float ss = 0.f;
#pragma unroll
        for (int j = 0; j < 4; ++j) { x[j] = bf2f(P[(size_t)row * NP + PC_MLAQD + j * 64 + lane]); ss += x[j] * x[j]; }
        const float rq = 1.f / sqrtf(wave_sum(ss) * (1.f / 256.f) + 1e-6f);
#pragma unroll
        for (int j = 0; j < 4; ++j) qn[tok * 256 + j * 64 + lane] = x[j] * rq * qg[j * 64 + lane];
        float y[2]; float s2 = 0.f;
#pragma unroll
        for (int j = 0; j < 2; ++j) { y[j] = bf2f(P[(size_t)row * NP + PC_MLAKVD + j * 64 + lane]); s2 += y[j] * y[j]; }
        const float rk = 1.f / sqrtf(wave_sum(s2) * (1.f / 128.f) + 1e-6f);
#pragma unroll
        for (int j = 0; j < 2; ++j) kvn[tok * 128 + j * 64 + lane] = y[j] * rk * kvg[j * 64 + lane];
    }
    __syncthreads();
    if (tid < 384) {
        const float* wq = p.in[25] + (size_t)l * 256 * 384;
        float acc[32];
#pragma unroll
        for (int i = 0; i < 32; ++i) acc[i] = 0.f;
        for (int k = 0; k < 256; k += 4) {
            const float w0 = wq[(size_t)k * 384 + tid], w1 = wq[(size_t)(k + 1) * 384 + tid], w2 = wq[(size_t)(k + 2) * 384 + tid], w3 = wq[(size_t)(k + 3) * 384 + tid];
#pragma unroll
            for (int i = 0; i < 32; ++i) { const f32x4 a = *(const LAS f32x4*)(qn + i * 256 + k); acc[i] += a.x * w0 + a.y * w1 + a.z * w2 + a.w * w3; }
        }
#pragma unroll
        for (int i = 0; i < 32; ++i) qo[i * 384 + tid] = acc[i];
    }
    {
        const float* wkv = p.in[27] + (size_t)l * 128 * 512;
        float acc[32];
#pragma unroll
        for (int i = 0; i < 32; ++i) acc[i] = 0.f;
        for (int k = 0; k < 128; k += 4) {
            const float w0 = wkv[(size_t)k * 512 + tid], w1 = wkv[(size_t)(k + 1) * 512 + tid], w2 = wkv[(size_t)(k + 2) * 512 + tid], w3 = wkv[(size_t)(k + 3) * 512 + tid];
#pragma unroll
            for (int i = 0; i < 32; ++i) { const f32x4 a = *(const LAS f32x4*)(kvn + i * 128 + k); acc[i] += a.x * w0 + a.y * w1 + a.z * w2 + a.w * w3; }
        }
        const int h = tid >> 7, dd = tid & 127;
        if (dd < 64) { bf16_t* KM = (bf16_t*)(p.ws + WS_KM) + ((size_t)(s0.b * 4 + h) * NKEYS + key0) * 96 + dd;
#pragma unroll
            for (int i = 0; i < 32; ++i) KM[(size_t)i * 96] = f2bf(acc[i]); }
        else { bf16_t* VT = (bf16_t*)(p.ws + WS_VTM) + ((size_t)(s0.b * 4 + h) * 64 + (dd - 64)) * NKEYS + key0;
#pragma unroll
            for (int i = 0; i < 32; ++i) VT[i] = f2bf(acc[i]); }
    }
    __syncthreads();
    bf16_t* MQ = (bf16_t*)(p.ws + WS_MQ);
    for (int e = tid; e < 32 * 384; e += 512) { const int tok = e / 384, c = e % 384, dd = c % 96; const int pos = s0.pos + tok;
        float v = qo[e];
        if (dd >= 64 && !s0.isctx) { const int pe = dd - 64, axis = pe >> 4, half = (pe >> 3) & 1, f = pe & 7; const int pp = axis == 0 ? (pos >> 6) : (pos & 63);
            const float cs = tabc[pp * 8 + f], sn = tabs[pp * 8 + f];
            const float x1 = half ? qo[e - 8] : v, x2 = half ? v : qo[e + 8];
            v = half ? (x2 * cs + x1 * sn) : (x1 * cs - x2 * sn); }
        MQ[(size_t)(t0 + tok) * 384 + c] = f2bf(v); }
    for (int e = tid; e < 32 * 32; e += 512) { const int tok = e >> 5, pe = e & 31, axis = pe >> 4, half = (pe >> 3) & 1, f = pe & 7; const int row = t0 + tok, pos = s0.pos + tok;
        float v = bf2f(P[(size_t)row * NP + PC_MLAKPE + pe]);
        if (!s0.isctx) { const int pp = axis == 0 ? (pos >> 6) : (pos & 63); const float cs = tabc[pp * 8 + f], sn = tabs[pp * 8 + f];
            const float other = bf2f(P[(size_t)row * NP + PC_MLAKPE + (half ? pe - 8 : pe + 8)]);
            const float x1 = half ? other : v, x2 = half ? v : other;
            v = half ? (x2 * cs + x1 * sn) : (x1 * cs - x2 * sn); }
        const bf16_t o = f2bf(v);
#pragma unroll
        for (int h = 0; h < 4; ++h) ((bf16_t*)(p.ws + WS_KM))[((size_t)(s0.b * 4 + h) * NKEYS + key0 + tok) * 96 + 64 + pe] = o; }
    __syncthreads();
}
__device__ __forceinline__ void ret_scan_item(const Params& p, int item) {
    const int tid = get_tid(); const int seq = item >> 1, dir = item & 1, h = seq & 3;
    const float lg = log1pf(-exp2f(-5.f - (float)h)); const float cdec = expf(128.f * lg);
    float* base = (float*)(p.ws + WS_RET) + (size_t)seq * 34 * 2 * 4096 + dir * 4096;
    float S[8];
#pragma unroll
    for (int i = 0; i < 8; ++i) S[i] = 0.f;
    for (int st = 0; st < 34; ++st) {
        const int ci = dir == 0 ? st : (st == 0 ? 1 : (st == 1 ? 0 : 35 - st));
        float* q = base + (size_t)ci * 2 * 4096 + tid * 8;
        const f32x4 t0 = *(const f32x4*)q, t1 = *(const f32x4*)(q + 4);
        *(f32x4*)q = (f32x4){S[0], S[1], S[2], S[3]}; *(f32x4*)(q + 4) = (f32x4){S[4], S[5], S[6], S[7]};
        S[0] = S[0] * cdec + t0.x; S[1] = S[1] * cdec + t0.y; S[2] = S[2] * cdec + t0.z; S[3] = S[3] * cdec + t0.w;
        S[4] = S[4] * cdec + t1.x; S[5] = S[5] * cdec + t1.y; S[6] = S[6] * cdec + t1.z; S[7] = S[7] * cdec + t1.w;
    }
}
__device__ __forceinline__ void phase_prepB(const Params& p, int l, LAS unsigned char* lds, int bid, int nb) {
    constexpr int N1 = TT / 32, N2 = 64;
    for (int it = bid; it < N1 + N2; it += nb) {
        if (it < N1) mla_proj_item(p, l, lds, it); else ret_scan_item(p, it - N1);
    }
}

typedef __bf16 bf16x2_t __attribute__((ext_vector_type(2)));
__device__ __forceinline__ unsigned cvt_pk_bf16(float lo, float hi) { const f32x2 v = {lo, hi}; return __builtin_bit_cast(unsigned, __builtin_convertvector(v, bf16x2_t)); }
template <int DK>
__device__ __forceinline__ void attn_unit(const bf16_t* Q, int qstride, const bf16_t* K, const bf16_t* Vt, int nctx, int mt0, int mt1, bool masked, int qpos0,
                                          bool has_sink, float sink, float scale, bf16_t* O, int ostride, LAS unsigned char* lds) {
    constexpr int KC = DK / 32, KP = DK + 8, KROW = KP * 2;
    constexpr int PIECES_K = 64 * DK / 8;
    constexpr int BUFB = 64 * KROW + 64 * 144;
    const int tid = get_tid(), lane = tid & 63, wave = tid >> 6, fr = lane & 15, fq = lane >> 4;
    const float sl2 = scale * 1.44269504f;
    bf16x8 qf[2][KC];
#pragma unroll
    for (int g = 0; g < 2; ++g)
#pragma unroll
        for (int kc = 0; kc < KC; ++kc) { const u32x4 u = *(const u32x4*)(Q + (size_t)(wave * 32 + g * 16 + fr) * qstride + kc * 32 + fq * 8); float f[8]; unpack8(u, f);
            u32x4 o; o.x = cvt_pk_bf16(f[0] * sl2, f[1] * sl2); o.y = cvt_pk_bf16(f[2] * sl2, f[3] * sl2); o.z = cvt_pk_bf16(f[4] * sl2, f[5] * sl2); o.w = cvt_pk_bf16(f[6] * sl2, f[7] * sl2);
            qf[g][kc] = __builtin_bit_cast(bf16x8, o); }
    float mq[2] = {0.f, 0.f}, lsum[2] = {0.f, 0.f}; f32x4 o[2][4];
#pragma unroll
    for (int g = 0; g < 2; ++g)
#pragma unroll
        for (int n = 0; n < 4; ++n) o[g][n] = (f32x4){0.f, 0.f, 0.f, 0.f};
    const int ntiles = nctx + (mt1 - mt0);
    u32x4 kr[2], vr;
    auto issue = [&](int ti) {
        const int tile = ti < nctx ? ti : mt0 + (ti - nctx);
        const bf16_t* kb = K + (size_t)tile * 64 * DK;
#pragma unroll
        for (int i = 0; i < 2; ++i) { const int pc = tid + i * 512; if (pc < PIECES_K) kr[i] = *(const u32x4*)(kb + (size_t)pc * 8); }
        { const int d = tid >> 3, c8 = tid & 7; vr = *(const u32x4*)(Vt + (size_t)d * NKEYS + tile * 64 + c8 * 8); }
    };
    auto stash = [&](int bufi) {
        LAS unsigned char* Kt = lds + bufi * BUFB; LAS unsigned char* Vl = Kt + 64 * KROW;
#pragma unroll
        for (int i = 0; i < 2; ++i) { const int pc = tid + i * 512; if (pc < PIECES_K) { const int row = pc / (DK / 8), c8 = pc % (DK / 8); *(LAS u32x4*)(Kt + row * KROW + c8 * 16) = kr[i]; } }
        { const int d = tid >> 3, c8 = tid & 7; *(LAS u32x4*)(Vl + d * 144 + c8 * 16) = vr; }
    };
    issue(0); stash(0);
    if (ntiles > 1) issue(1);
    __syncthreads();
    for (int ti = 0; ti < ntiles; ++ti) {
        const int tile = ti < nctx ? ti : mt0 + (ti - nctx);
        LAS unsigned char* Kt = lds + (ti & 1) * BUFB; LAS unsigned char* Vl = Kt + 64 * KROW;
        if (ti + 1 < ntiles) { stash((ti + 1) & 1); if (ti + 2 < ntiles) issue(ti + 2); }
        f32x4 s[2][4];
#pragma unroll
        for (int n = 0; n < 4; ++n) {
            s[0][n] = (f32x4){-mq[0], -mq[0], -mq[0], -mq[0]}; s[1][n] = (f32x4){-mq[1], -mq[1], -mq[1], -mq[1]};
#pragma unroll
            for (int kc = 0; kc < KC; ++kc) { const bf16x8 kf = *(const LAS bf16x8*)(Kt + (n * 16 + fr) * KROW + kc * 64 + fq * 16);
                s[0][n] = __builtin_amdgcn_mfma_f32_16x16x32_bf16(kf, qf[0][kc], s[0][n], 0, 0, 0);
                s[1][n] = __builtin_amdgcn_mfma_f32_16x16x32_bf16(kf, qf[1][kc], s[1][n], 0, 0, 0); } }
        if (ti == 0) {
#pragma unroll
            for (int g = 0; g < 2; ++g) {
                float t = -INFINITY;
#pragma unroll
                for (int n = 0; n < 4; ++n)
#pragma unroll
                    for (int r = 0; r < 4; ++r) t = fmaxf(t, s[g][n][r]);
                t = fmaxf(t, __shfl_xor(t, 16)); t = fmaxf(t, __shfl_xor(t, 32));
                if (has_sink) t = fmaxf(t, sink * 1.44269504f);
                mq[g] = t;
#pragma unroll
                for (int n = 0; n < 4; ++n)
#pragma unroll
                    for (int r = 0; r < 4; ++r) s[g][n][r] -= t;
            }
        }
        if (masked && ti >= nctx) {
#pragma unroll
            for (int g = 0; g < 2; ++g)
#pragma unroll
                for (int n = 0; n < 4; ++n)
#pragma unroll
                    for (int r = 0; r < 4; ++r) { const int kp = tile * 64 + n * 16 + fq * 4 + r - CTXL, qp = qpos0 + wave * 32 + g * 16 + fr; const int df = qp - kp; if (df > 128 || df < -128) s[g][n][r] = -INFINITY; }
        }
#pragma unroll
        for (int g = 0; g < 2; ++g)
#pragma unroll
            for (int n = 0; n < 4; ++n)
#pragma unroll
                for (int r = 0; r < 4; ++r) { s[g][n][r] = __builtin_amdgcn_exp2f(s[g][n][r]); lsum[g] += s[g][n][r]; }
#pragma unroll
        for (int c = 0; c < 2; ++c) {
            bf16x8 pf[2];
#pragma unroll
            for (int g = 0; g < 2; ++g) { u32x4 pu; pu.x = cvt_pk_bf16(s[g][2 * c][0], s[g][2 * c][1]); pu.y = cvt_pk_bf16(s[g][2 * c][2], s[g][2 * c][3]);
                pu.z = cvt_pk_bf16(s[g][2 * c + 1][0], s[g][2 * c + 1][1]); pu.w = cvt_pk_bf16(s[g][2 * c + 1][2], s[g][2 * c + 1][3]); pf[g] = __builtin_bit_cast(bf16x8, pu); }
#pragma unroll
            for (int n = 0; n < 4; ++n) {
                const u32x2 lo = *(const LAS u32x2*)(Vl + (n * 16 + fr) * 144 + ((2 * c) * 16 + fq * 4) * 2), hi = *(const LAS u32x2*)(Vl + (n * 16 + fr) * 144 + ((2 * c + 1) * 16 + fq * 4) * 2);
                const bf16x8 vf = __builtin_bit_cast(bf16x8, (u32x4){lo.x, lo.y, hi.x, hi.y});
                o[0][n] = __builtin_amdgcn_mfma_f32_16x16x32_bf16(vf, pf[0], o[0][n], 0, 0, 0);
                o[1][n] = __builtin_amdgcn_mfma_f32_16x16x32_bf16(vf, pf[1], o[1][n], 0, 0, 0); }
        }
        __syncthreads();
    }
#pragma unroll
    for (int g = 0; g < 2; ++g) {
        float t = lsum[g];
        t += __shfl_xor(t, 16); t += __shfl_xor(t, 32);
        if (has_sink) t += __builtin_amdgcn_exp2f(sink * 1.44269504f - mq[g]);
        const float inv = 1.f / t;
#pragma unroll
        for (int n = 0; n < 4; ++n) { u32x2 ov; ov.x = cvt_pk_bf16(o[g][n][0] * inv, o[g][n][1] * inv); ov.y = cvt_pk_bf16(o[g][n][2] * inv, o[g][n][3] * inv);
            *(u32x2*)(O + (size_t)(wave * 32 + g * 16 + fr) * ostride + n * 16 + fq * 4) = ov; }
    }
}

__device__ __forceinline__ void ret_out_item(const Params& p, int l, LAS unsigned char* lds, int item) {
    const int tid = get_tid(), lane = tid & 63, wave = tid >> 6, fr = lane & 15, fq = lane >> 4;
    bf16_t* P = (bf16_t*)(p.ws + WS_P);
    const int cr = item >> 2, h = item & 3; int b; const int ci = ret_chunk_index(cr, b);
    const int r0 = cr * 128;
    const float lg2 = log1pf(-exp2f(-5.f - (float)h)) * 1.44269504f;
    LAS unsigned char* Kb = lds;
    LAS unsigned char* Vt = lds + 18432;
    LAS unsigned char* SfT = lds + 35840;
    LAS unsigned char* SbT = lds + 45056;
    for (int pc = tid; pc < 1024; pc += 512) { const int j = pc >> 3, c8 = pc & 7;
        const u32x4 kk = *(const u32x4*)(P + (size_t)(r0 + j) * NP + PC_RETK + h * 64 + c8 * 8);
        const u32x4 vv = *(const u32x4*)(P + (size_t)(r0 + j) * NP + PC_RETV + h * 64 + c8 * 8);
        float kf[8]; unpack8(kk, kf);
        u32x4 ko; ko.x = pk2(kf[0] * 0.125f, kf[1] * 0.125f); ko.y = pk2(kf[2] * 0.125f, kf[3] * 0.125f); ko.z = pk2(kf[4] * 0.125f, kf[5] * 0.125f); ko.w = pk2(kf[6] * 0.125f, kf[7] * 0.125f);
        *(LAS u32x4*)(Kb + j * 144 + c8 * 16) = ko;
        const unsigned vw[4] = {vv.x, vv.y, vv.z, vv.w};
#pragma unroll
        for (int x = 0; x < 8; ++x) *(LAS bf16_t*)(Vt + (c8 * 8 + x) * 272 + j * 2) = (bf16_t)((x & 1) ? (vw[x >> 1] >> 16) : (vw[x >> 1] & 0xffff)); }
    { const float* RS = (const float*)(p.ws + WS_RET) + ((size_t)((b * 4 + h) * 34 + ci) * 2) * 4096;
      for (int pc = tid; pc < 1024; pc += 512) { const int d = pc >> 4, e4 = (pc & 15) * 4;
          const f32x4 a = *(const f32x4*)(RS + d * 64 + e4), bb = *(const f32x4*)(RS + 4096 + d * 64 + e4);
#pragma unroll
          for (int x = 0; x < 4; ++x) { *(LAS bf16_t*)(SfT + (e4 + x) * 144 + d * 2) = f2bf(a[x]); *(LAS bf16_t*)(SbT + (e4 + x) * 144 + d * 2) = f2bf(bb[x]); } } }
    const int i = wave * 16 + fr;
    u32x4 qraw[2];
#pragma unroll
    for (int kc = 0; kc < 2; ++kc) qraw[kc] = *(const u32x4*)(P + (size_t)(r0 + i) * NP + PC_RETQ + h * 64 + kc * 32 + fq * 8);
    __syncthreads();
    f32x4 s[8];
#pragma unroll
    for (int nb = 0; nb < 8; ++nb) { s[nb] = (f32x4){0.f, 0.f, 0.f, 0.f};
#pragma unroll
        for (int kc = 0; kc < 2; ++kc) { const bf16x8 kf = *(const LAS bf16x8*)(Kb + (nb * 16 + fr) * 144 + kc * 64 + fq * 16);
            s[nb] = __builtin_amdgcn_mfma_f32_16x16x32_bf16(kf, __builtin_bit_cast(bf16x8, qraw[kc]), s[nb], 0, 0, 0); } }
#pragma unroll
    for (int nb = 0; nb < 8; ++nb)
#pragma unroll
        for (int r = 0; r < 4; ++r) { const int j = nb * 16 + fq * 4 + r; const int df = i - j; const int adf = df < 0 ? -df : df;
            float dcy = __builtin_amdgcn_exp2f((float)adf * lg2); if (df == 0) dcy = 2.f; s[nb][r] *= dcy; }
    f32x4 o[4];
#pragma unroll
    for (int n = 0; n < 4; ++n) o[n] = (f32x4){0.f, 0.f, 0.f, 0.f};
#pragma unroll
    for (int c = 0; c < 4; ++c) {
        u32x4 pu; pu.x = cvt_pk_bf16(s[2 * c][0], s[2 * c][1]); pu.y = cvt_pk_bf16(s[2 * c][2], s[2 * c][3]); pu.z = cvt_pk_bf16(s[2 * c + 1][0], s[2 * c + 1][1]); pu.w = cvt_pk_bf16(s[2 * c + 1][2], s[2 * c + 1][3]);
        const bf16x8 pf = __builtin_bit_cast(bf16x8, pu);
#pragma unroll
        for (int n = 0; n < 4; ++n) {
            const u32x2 lo = *(const LAS u32x2*)(Vt + (n * 16 + fr) * 272 + ((2 * c) * 16 + fq * 4) * 2), hi = *(const LAS u32x2*)(Vt + (n * 16 + fr) * 272 + ((2 * c + 1) * 16 + fq * 4) * 2);
            const bf16x8 vf = __builtin_bit_cast(bf16x8, (u32x4){lo.x, lo.y, hi.x, hi.y});
            o[n] = __builtin_amdgcn_mfma_f32_16x16x32_bf16(vf, pf, o[n], 0, 0, 0); }
    }
    const float gf = __builtin_amdgcn_exp2f((float)(i + 1) * lg2), gb = __builtin_amdgcn_exp2f((float)(128 - i) * lg2);
#pragma unroll
    for (int kc = 0; kc < 2; ++kc) {
        float f[8]; unpack8(qraw[kc], f);
        u32x4 uf, ub;
        uf.x = cvt_pk_bf16(f[0] * gf, f[1] * gf); uf.y = cvt_pk_bf16(f[2] * gf, f[3] * gf); uf.z = cvt_pk_bf16(f[4] * gf, f[5] * gf); uf.w = cvt_pk_bf16(f[6] * gf, f[7] * gf);
        ub.x = cvt_pk_bf16(f[0] * gb, f[1] * gb); ub.y = cvt_pk_bf16(f[2] * gb, f[3] * gb); ub.z = cvt_pk_bf16(f[4] * gb, f[5] * gb); ub.w = cvt_pk_bf16(f[6] * gb, f[7] * gb);
        const bf16x8 qF = __builtin_bit_cast(bf16x8, uf), qB = __builtin_bit_cast(bf16x8, ub);
#pragma unroll
        for (int n = 0; n < 4; ++n) {
            const bf16x8 af = *(const LAS bf16x8*)(SfT + (n * 16 + fr) * 144 + kc * 64 + fq * 16), ab = *(const LAS bf16x8*)(SbT + (n * 16 + fr) * 144 + kc * 64 + fq * 16);
            o[n] = __builtin_amdgcn_mfma_f32_16x16x32_bf16(af, qF, o[n], 0, 0, 0);
            o[n] = __builtin_amdgcn_mfma_f32_16x16x32_bf16(ab, qB, o[n], 0, 0, 0); }
    }
    float sm = 0.f;
#pragma unroll
    for (int n = 0; n < 4; ++n) sm += (o[n][0] + o[n][1]) + (o[n][2] + o[n][3]);
    sm += __shfl_xor(sm, 16); sm += __shfl_xor(sm, 32);
    const float mu = sm * (1.f / 64.f);
    float vs = 0.f;
#pragma unroll
    for (int n = 0; n < 4; ++n)
#pragma unroll
        for (int r = 0; r < 4; ++r) { const float dl = o[n][r] - mu; vs += dl * dl; }
    vs += __shfl_xor(vs, 16); vs += __shfl_xor(vs, 32);
    const float rstd = 1.f / sqrtf(vs * (1.f / 64.f) + 1e-5f);
#pragma unroll
    for (int n = 0; n < 4; ++n) { const int e0 = n * 16 + fq * 4;
        const u32x2 gu = *(const u32x2*)(P + (size_t)(r0 + i) * NP + PC_RETG + h * 64 + e0);
        const f32x4 gn = *(const f32x4*)(p.in[13] + l * 256 + h * 64 + e0);
        const float g0 = bf2f((bf16_t)(gu.x & 0xffff)), g1 = bf2f((bf16_t)(gu.x >> 16)), g2 = bf2f((bf16_t)(gu.y & 0xffff)), g3 = bf2f((bf16_t)(gu.y >> 16));
        u32x2 yo;
        yo.x = cvt_pk_bf16((o[n][0] - mu) * rstd * gn.x * (g0 / (1.f + __expf(-g0))), (o[n][1] - mu) * rstd * gn.y * (g1 / (1.f + __expf(-g1))));
        yo.y = cvt_pk_bf16((o[n][2] - mu) * rstd * gn.z * (g2 / (1.f + __expf(-g2))), (o[n][3] - mu) * rstd * gn.w * (g3 / (1.f + __expf(-g3))));
        *(u32x2*)(P + (size_t)(r0 + i) * NP + PC_RETQ + h * 64 + e0) = yo; }
    __syncthreads();
}

constexpr int NSCANBLK = 128;
__device__ __forceinline__ void rwkv_scan_item(const Params& p, int l, LAS unsigned char* lds, int item) {
    const int tid = get_tid();
    const int sc = item >> 1, half = item & 1;
    const int b = sc >> 3, h = (sc >> 1) & 3, dir = sc & 1;
    const bf16_t* RK = (const bf16_t*)(p.ws + WS_RWK); const bf16_t* RV = (const bf16_t*)(p.ws + WS_RWV); const bf16_t* RR = (const bf16_t*)(p.ws + WS_RWRR);
    const bf16_t* RA = (const bf16_t*)(p.ws + (dir ? WS_RWA1 : WS_RWA0)); const bf16_t* RM = (const bf16_t*)(p.ws + (dir ? WS_RWM1 : WS_RWM0));
    bf16_t* P = (bf16_t*)(p.ws + WS_P);
    const int ocol = (dir ? PC_RWO1 : PC_RWO0) + h * 64 + half * 32;
    LAS float* KH = (LAS float*)lds;
    LAS float* WW = KH + 4096; LAS float* BB = WW + 4096; LAS float* KT = BB + 4096; LAS float* RRl = KT + 4096; LAS float* VV = RRl + 4096; LAS float* OUT = VV + 4096;
    const int st = tid >> 3, c0 = (tid & 7) * 8;
    float kkp[8], kap[8];
#pragma unroll
    for (int i = 0; i < 8; ++i) { kkp[i] = p.in[20][l * 256 + h * 64 + c0 + i]; kap[i] = p.in[21][l * 256 + h * 64 + c0 + i]; }
    const int row_l = (tid >> 3) & 31, kq = tid & 7;
    const bool compute = tid < 256;
    f32x2 S[4];
#pragma unroll
    for (int i = 0; i < 4; ++i) S[i] = (f32x2){0.f, 0.f};
    auto row_of = [&](int s) -> int {
        if (s < CTXL) return TMAIN + b * CTXL + (dir ? CTXL - 1 - s : s);
        const int t = s - CTXL; return b * SEQL + (dir ? SEQL - 1 - t : t);
    };
    u32x4 gk, gv, gr, ga, gm;
    auto issue = [&](int ch) { const size_t o = (size_t)row_of(ch * 64 + st) * 256 + h * 64 + c0;
        gk = *(const u32x4*)(RK + o); gv = *(const u32x4*)(RV + o); gr = *(const u32x4*)(RR + o); ga = *(const u32x4*)(RA + o); gm = *(const u32x4*)(RM + o); };
    issue(0);
    for (int ch = 0; ch < 68; ++ch) {
        {
            float k[8], a[8], om[8], rr[8], vv8[8]; unpack8(gk, k); unpack8(ga, a); unpack8(gm, om); unpack8(gr, rr); unpack8(gv, vv8);
            float kk[8]; float n2 = 0.f;
#pragma unroll
            for (int i = 0; i < 8; ++i) { kk[i] = k[i] * kkp[i]; n2 += kk[i] * kk[i]; }
            n2 = red8(n2);
            const float rn = 1.f / sqrtf(fmaxf(n2, 1e-12f));
            f32x4 o0, o1;
#define ST8(DST, EXPR) { float t8[8]; _Pragma("unroll") for (int i = 0; i < 8; ++i) t8[i] = (EXPR); \
            *(LAS f32x4*)(DST + st * 64 + c0) = (f32x4){t8[0], t8[1], t8[2], t8[3]}; *(LAS f32x4*)(DST + st * 64 + c0 + 4) = (f32x4){t8[4], t8[5], t8[6], t8[7]}; }
            ST8(KH, kk[i] * rn)
            ST8(WW, 1.f - om[i])
            ST8(BB, kk[i] * rn * a[i])
            ST8(KT, k[i] * (1.f + (a[i] - 1.f) * kap[i]))
            ST8(RRl, rr[i])
            ST8(VV, vv8[i])
#undef ST8
        }
        __syncthreads();
        if (ch + 1 < 68) issue(ch + 1);
        if (compute) {
            struct Ops { f32x4 kh0, kh1, w0, w1, b0, b1, t0, t1, r0, r1; float vv; };
            auto ldops = [&](int s) -> Ops { Ops q;
                q.kh0 = *(const LAS f32x4*)(KH + s * 64 + kq * 8); q.kh1 = *(const LAS f32x4*)(KH + s * 64 + kq * 8 + 4);
                q.w0 = *(const LAS f32x4*)(WW + s * 64 + kq * 8); q.w1 = *(const LAS f32x4*)(WW + s * 64 + kq * 8 + 4);
                q.b0 = *(const LAS f32x4*)(BB + s * 64 + kq * 8); q.b1 = *(const LAS f32x4*)(BB + s * 64 + kq * 8 + 4);
                q.t0 = *(const LAS f32x4*)(KT + s * 64 + kq * 8); q.t1 = *(const LAS f32x4*)(KT + s * 64 + kq * 8 + 4);
                q.r0 = *(const LAS f32x4*)(RRl + s * 64 + kq * 8); q.r1 = *(const LAS f32x4*)(RRl + s * 64 + kq * 8 + 4);
                q.vv = VV[s * 64 + half * 32 + row_l]; return q; };
            Ops nx = ldops(0);
#pragma unroll 2
            for (int s = 0; s < 64; ++s) {
                const Ops c = nx;
                nx = ldops(s + 1 < 64 ? s + 1 : 63);
                f32x2 a2 = S[0] * (f32x2){c.kh0.x, c.kh0.y};
                a2 = S[1] * (f32x2){c.kh0.z, c.kh0.w} + a2; a2 = S[2] * (f32x2){c.kh1.x, c.kh1.y} + a2; a2 = S[3] * (f32x2){c.kh1.z, c.kh1.w} + a2;
                const float sk = red8(a2.x + a2.y);
                const f32x2 nsk = (f32x2){-sk, -sk}, vv2 = (f32x2){c.vv, c.vv};
                S[0] = S[0] * (f32x2){c.w0.x, c.w0.y} + (nsk * (f32x2){c.b0.x, c.b0.y} + vv2 * (f32x2){c.t0.x, c.t0.y});
                S[1] = S[1] * (f32x2){c.w0.z, c.w0.w} + (nsk * (f32x2){c.b0.z, c.b0.w} + vv2 * (f32x2){c.t0.z, c.t0.w});
                S[2] = S[2] * (f32x2){c.w1.x, c.w1.y} + (nsk * (f32x2){c.b1.x, c.b1.y} + vv2 * (f32x2){c.t1.x, c.t1.y});
                S[3] = S[3] * (f32x2){c.w1.z, c.w1.w} + (nsk * (f32x2){c.b1.z, c.b1.w} + vv2 * (f32x2){c.t1.z, c.t1.w});
                f32x2 o2 = S[0] * (f32x2){c.r0.x, c.r0.y};
                o2 = S[1] * (f32x2){c.r0.z, c.r0.w} + o2; o2 = S[2] * (f32x2){c.r1.x, c.r1.y} + o2; o2 = S[3] * (f32x2){c.r1.z, c.r1.w} + o2;
                const float ov = red8(o2.x + o2.y);
                if (kq == 0) OUT[s * 32 + row_l] = ov;
            }
        }
        __syncthreads();
        { const int c4 = (tid & 7) * 4; const f32x4 ov = *(const LAS f32x4*)(OUT + st * 32 + c4);
          u32x2 o2; o2.x = pk2(ov.x, ov.y); o2.y = pk2(ov.z, ov.w);
          *(u32x2*)(P + (size_t)row_of(ch * 64 + st) * NP + ocol + c4) = o2; }
    }
    __syncthreads();
}

__device__ __forceinline__ void mixer_mla(const Params& p, LAS unsigned char* lds, int it) {
    bf16_t* P = (bf16_t*)(p.ws + WS_P);
    const bf16_t* MQ = (const bf16_t*)(p.ws + WS_MQ);
    int b, h, row0, nm1;
    if (it < 512) { b = it >> 6; h = (it >> 4) & 3; row0 = b * SEQL + (it & 15) * 256; nm1 = 68; }
    else { const int u = it - 512; b = u >> 2; h = u & 3; row0 = TMAIN + b * CTXL; nm1 = 4; }
    attn_unit<96>(MQ + (size_t)row0 * 384 + h * 96, 384, (const bf16_t*)(p.ws + WS_KM) + (size_t)(b * 4 + h) * NKEYS * 96, (const bf16_t*)(p.ws + WS_VTM) + (size_t)(b * 4 + h) * 64 * NKEYS,
                  4, 4, nm1, false, 0, false, 0.f, 0.10206207f, P + (size_t)row0 * NP + PC_MLAQD + h * 64, NP, lds);
}
__device__ __forceinline__ void mixer_swa(const Params& p, int l, LAS unsigned char* lds, int u0) {
    bf16_t* P = (bf16_t*)(p.ws + WS_P);
    int b, h, row0, nm0, nm1, qp0; bool msk;
    if (u0 < 512) { b = u0 >> 6; h = (u0 >> 4) & 3; const int qb = u0 & 15; row0 = b * SEQL + qb * 256; nm0 = 4 + 4 * qb - 2; nm1 = 4 + 4 * qb + 6; if (nm0 < 4) nm0 = 4; if (nm1 > 68) nm1 = 68; qp0 = qb * 256; msk = true; }
    else { const int u = u0 - 512; b = u >> 2; h = u & 3; row0 = TMAIN + b * CTXL; nm0 = 4; nm1 = 4; qp0 = 0; msk = false; }
    const int hk = h >> 1;
    bf16_t* qp = P + (size_t)row0 * NP + PC_SWAQ + h * 64;
    attn_unit<64>(qp, NP, (const bf16_t*)(p.ws + WS_KS) + (size_t)(b * 2 + hk) * NKEYS * 64, (const bf16_t*)(p.ws + WS_VTS) + (size_t)(b * 2 + hk) * 64 * NKEYS,
                  4, nm0, nm1, msk, qp0, true, p.in[12][l * 4 + h], 0.125f, qp, NP, lds);
}
__device__ __forceinline__ void phase_mixers(const Params& p, int l, LAS unsigned char* lds, int bid, int nb) {
    const bool ectx = (l == 0);
    const int N_MLA = 512 + (ectx ? 32 : 0), N_SWA = 512 + (ectx ? 32 : 0), N_RET = 1024 + (ectx ? 64 : 0);
    if (bid < NSCANBLK) {
        rwkv_scan_item(p, l, lds, bid);
    } else {
        for (int it = bid - NSCANBLK; it < N_MLA + N_SWA + N_RET; it += nb - NSCANBLK) {
            if (it < N_MLA) mixer_mla(p, lds, it);
            else if (it < N_MLA + N_SWA) mixer_swa(p, l, lds, it - N_MLA);
            else ret_out_item(p, l, lds, it - N_MLA - N_SWA);
        }
    }
}

__device__ __forceinline__ void phase_rwkv_finish(const Params& p, int l, LAS unsigned char* lds, int bid, int nb) {
    const int tid = get_tid();
    bf16_t* P = (bf16_t*)(p.ws + WS_P);
    const int ntiles = (l == 0 ? TT : TMAIN) / 32;
    const float* mu = p.in[14] + l * 1024 + 896;
    const float* gup = p.in[19] + (size_t)l * 128 * 256;
    const bf16_t* RV = (const bf16_t*)(p.ws + WS_RWV); const float* BON = (const float*)(p.ws + WS_BON);
    LAS float* sg = (LAS float*)lds;
    for (int tile = bid; tile < ntiles; tile += nb) {
        const int t0 = tile * 32; const SeqInfo s0 = seq_of_row(t0);
        { const int tok = tid >> 4, j8 = (tid & 15) * 8; const int row = t0 + tok, pos = s0.pos + tok;
          const u32x4 u0 = *(const u32x4*)(P + (size_t)row * NP + PC_RWGD + j8);
          const u32x4 um = pos > 0 ? *(const u32x4*)(P + (size_t)(row - 1) * NP + PC_RWGD + j8) : (u32x4){0u, 0u, 0u, 0u};
          const u32x4 up = pos < s0.len - 1 ? *(const u32x4*)(P + (size_t)(row + 1) * NP + PC_RWGD + j8) : (u32x4){0u, 0u, 0u, 0u};
          float z0[8], zm[8], zp[8]; unpack8(u0, z0); unpack8(um, zm); unpack8(up, zp);
#pragma unroll
          for (int x = 0; x < 8; ++x) sg[tok * 128 + j8 + x] = sigmoidf_(z0[x] + mu[j8 + x] * (0.5f * (zm[x] + zp[x]) - z0[x])); }
        __syncthreads();
        const int hh = tid >> 8, c = tid & 255, h = c >> 6;
        float g[16];
#pragma unroll
        for (int i = 0; i < 16; ++i) g[i] = 0.f;
#pragma unroll 8
        for (int j = 0; j < 128; ++j) { const float w = gup[j * 256 + c];
#pragma unroll
            for (int i = 0; i < 16; ++i) g[i] += sg[(hh * 16 + i) * 128 + j] * w; }
        const float gn = p.in[23][l * 256 + c];
        float ov[16], rv[16], bn[16];
#pragma unroll
        for (int i = 0; i < 16; ++i) { const int row = t0 + hh * 16 + i;
            ov[i] = bf2f(P[(size_t)row * NP + PC_RWO0 + c]) + bf2f(P[(size_t)row * NP + PC_RWO1 + c]); rv[i] = bf2f(RV[(size_t)row * 256 + c]); bn[i] = BON[(size_t)row * 4 + h]; }
#pragma unroll
        for (int i = 0; i < 16; ++i) { const int row = t0 + hh * 16 + i;
            const float o = ov[i];
            const float mean = wave_sum(o) * (1.f / 64.f); const float dl = o - mean; const float var = wave_sum(dl * dl) * (1.f / 64.f);
            float y = dl * (1.f / sqrtf(var + 64e-5f)) * gn + bn[i] * rv[i];
            P[(size_t)row * NP + PC_RWO1 + c] = f2bf(y * g[i]); }
        __syncthreads();
    }
}

#ifndef N_LAUNCH_MODE
#define N_LAUNCH_MODE 1
#endif
template <int Q>
__device__ __forceinline__ void layer_phase(const Params& p, int l, LAS unsigned char* lds, int bid, int nb) {
    unsigned char* wb = p.ws + WS_WB + (size_t)l * WB_LAYER;
    const int Mrows = (l == 0) ? TT : TMAIN;
    pg8::StaticOrder S;
    if constexpr (Q == 0) { pg8::Gemm g{(const bf16_t*)(p.ws + WS_HB), (const bf16_t*)(wb + WB_IN), TT, NP, DM, DM}; S.init(TT, NP, nb, bid);
              pg8::EpiBf16<0> E{(bf16_t*)(p.ws + WS_P), NP}; pg8::gemm_phase(lds, g, S, E); }
    if constexpr (Q == 1) phase_prepA(p, l, lds, bid, nb);
    if constexpr (Q == 2) phase_prepB(p, l, lds, bid, nb);
    if constexpr (Q == 3) phase_mixers(p, l, lds, bid, nb);
    if constexpr (Q == 4) phase_rwkv_finish(p, l, lds, bid, nb);
    if constexpr (Q == 5) { pg8::Gemm g{(const bf16_t*)(p.ws + WS_P), (const bf16_t*)(wb + WB_OUT), Mrows, DM, DM, NP}; S.init(Mrows, DM, nb, bid);
              pg8::EpiBf16<0> E{(bf16_t*)(p.ws + WS_Z), DM}; pg8::gemm_phase(lds, g, S, E); }
    if constexpr (Q == 6) phase_rowops(p, 1, l, Mrows, bid, nb);
    if constexpr (Q == 7) { pg8::Gemm g{(const bf16_t*)(p.ws + WS_HB), (const bf16_t*)(wb + WB_W1), Mrows, FF, DM, DM}; S.init(Mrows, FF, nb, bid);
              pg8::EpiBf16<1> E{(bf16_t*)(p.ws + WS_HID), FF}; pg8::gemm_phase(lds, g, S, E); }
    if constexpr (Q == 8) { pg8::Gemm g{(const bf16_t*)(p.ws + WS_HID), (const bf16_t*)(wb + WB_W2), Mrows, DM, FF, FF}; S.init(Mrows, DM, nb, bid);
              pg8::EpiBf16<0> E{(bf16_t*)(p.ws + WS_Z), DM}; pg8::gemm_phase(lds, g, S, E); }
    if constexpr (Q == 9) phase_rowops(p, 2, l, Mrows, bid, nb);
}

#ifndef PROBE_MASK
#define PROBE_MASK 0
#endif
#define PB(BIT, CALL) do { if ((PROBE_MASK) & (BIT)) { const unsigned long long t0_ = __builtin_amdgcn_s_memrealtime(); CALL; const unsigned long long t1_ = __builtin_amdgcn_s_memrealtime(); \
        while (__builtin_amdgcn_s_memrealtime() - t1_ < (t1_ - t0_)) __builtin_amdgcn_s_sleep(8); } else { CALL; } } while (0)
#define GSYNC() do { asm volatile("s_waitcnt vmcnt(0) lgkmcnt(0)" ::: "memory"); __syncthreads(); if (get_tid() < 64) { __builtin_amdgcn_fence(__ATOMIC_RELEASE, "agent"); asm volatile("s_waitcnt vmcnt(0) lgkmcnt(0)" ::: "memory"); } grid.sync(); \
    if (get_tid() < 64) { __builtin_amdgcn_fence(__ATOMIC_ACQUIRE, "agent"); asm volatile("s_waitcnt vmcnt(0) lgkmcnt(0)" ::: "memory"); } __syncthreads(); } while (0)
__global__ void __launch_bounds__(512, 2) mega_fwd(Params p) {
    extern __shared__ __attribute__((aligned(16))) unsigned char lds_raw[];
    LAS unsigned char* lds = (LAS unsigned char*)lds_raw;
    cg::grid_group grid = cg::this_grid();
    const int bid = blockIdx.x, nb = gridDim.x;
    PB(16, phase_prologue(p, lds, bid, nb)); GSYNC();
    PB(8, phase_rowops(p, 0, 0, TT, bid, nb)); GSYNC();
#define LAYER(L, LAST) \
    PB(1, layer_phase<0>(p, L, lds, bid, nb)); GSYNC(); PB(4, layer_phase<1>(p, L, lds, bid, nb)); GSYNC(); PB(4, layer_phase<2>(p, L, lds, bid, nb)); GSYNC(); \
    PB(2, layer_phase<3>(p, L, lds, bid, nb)); GSYNC(); PB(4, layer_phase<4>(p, L, lds, bid, nb)); GSYNC(); PB(1, layer_phase<5>(p, L, lds, bid, nb)); GSYNC(); \
    PB(8, layer_phase<6>(p, L, lds, bid, nb)); GSYNC(); PB(1, layer_phase<7>(p, L, lds, bid, nb)); GSYNC(); PB(1, layer_phase<8>(p, L, lds, bid, nb)); GSYNC(); \
    PB(8, layer_phase<9>(p, L, lds, bid, nb)); if (!(LAST)) GSYNC();
    LAYER(0, false)
    LAYER(1, true)
}
#if N_LAUNCH_MODE != 1
template <int PH> __global__ void __launch_bounds__(512, 2) one_phase(Params p, int l) {
    extern __shared__ __attribute__((aligned(16))) unsigned char lds_raw[];
    LAS unsigned char* lds = (LAS unsigned char*)lds_raw;
    if constexpr (PH == 100) phase_prologue(p, lds, blockIdx.x, gridDim.x);
    else if constexpr (PH == 101) phase_rowops(p, 0, 0, TT, blockIdx.x, gridDim.x);
    else layer_phase<PH>(p, l, lds, blockIdx.x, gridDim.x);
}
#endif

extern "C" void kernel_launch(void* const* d_in, const int* in_sizes, int n_in, void* d_out, int out_size, void* d_ws, size_t ws_size, hipStream_t stream) {
    if (n_in != 30 || ws_size < WS_NEED || out_size != TMAIN * DM) { fprintf(stderr, "kernel_launch: unexpected shapes (n_in %d, ws %zu, out %d)\n", n_in, ws_size, out_size); return; }
    Params p{};
    for (int i = 0; i < 30; ++i) p.in[i] = (const float*)d_in[i];
    p.out = (float*)d_out; p.ws = (unsigned char*)d_ws;
    static int grid_blocks = 0;
    if (!grid_blocks) {
        int dev = 0, cus = 0, per_cu = 0;
        (void)hipGetDevice(&dev);
        (void)hipDeviceGetAttribute(&cus, hipDeviceAttributeMultiprocessorCount, dev);
        (void)hipFuncSetAttribute((const void*)mega_fwd, hipFuncAttributeMaxDynamicSharedMemorySize, LDS_BYTES);
        (void)hipOccupancyMaxActiveBlocksPerMultiprocessor(&per_cu, mega_fwd, 512, LDS_BYTES);
        if (per_cu < 1) { fprintf(stderr, "kernel_launch: occupancy query says %d blocks/CU\n", per_cu); per_cu = 1; }
        grid_blocks = cus * 1;
        if (grid_blocks < 128) { fprintf(stderr, "kernel_launch: only %d CUs\n", grid_blocks); }
    }
#if N_LAUNCH_MODE == 1
    void* args[] = {&p};
    hipError_t e = hipLaunchCooperativeKernel((const void*)mega_fwd, dim3(grid_blocks), dim3(512), args, LDS_BYTES, stream);
    if (e != hipSuccess) fprintf(stderr, "cooperative launch failed: %s (grid %d)\n", hipGetErrorString(e), grid_blocks);
#else
#define LP(PH, L) do { (void)hipFuncSetAttribute((const void*)one_phase<PH>, hipFuncAttributeMaxDynamicSharedMemorySize, LDS_BYTES); one_phase<PH><<<grid_blocks, 512, LDS_BYTES, stream>>>(p, L); } while (0)
    LP(100, 0); LP(101, 0);
    for (int l = 0; l < 2; ++l) { LP(0, l); LP(1, l); LP(2, l); LP(3, l); LP(4, l); LP(5, l); LP(6, l); LP(7, l); LP(8, l); LP(9, l); }
#endif
}
```

```cpp
#include <hip/hip_runtime.h>
#include <hip/hip_cooperative_groups.h>
#include <cstdio>
#include <cstdint>
#include <cmath>
namespace cg = cooperative_groups;
__device__ __forceinline__ int get_tid() { int t = threadIdx.x; asm volatile("" : "+v"(t)); return t; }
namespace pg8 {
#define PG8_LAS __attribute__((address_space(3)))
typedef unsigned short bf16_t;
typedef short bf16x8 __attribute__((ext_vector_type(8)));
typedef float f32x4 __attribute__((ext_vector_type(4)));
typedef unsigned u32x4 __attribute__((ext_vector_type(4)));
typedef unsigned u32x2 __attribute__((ext_vector_type(2)));
constexpr int BM = 256, BK = 64, HALF = 128, HTB = HALF * BK * 2, STAGE_BYTES = 8 * HTB, NXCD = 8, WGM = 8;

__host__ __device__ __forceinline__ int lds_byte(int r, int c) { const int st = (r >> 4) * 2 + (c >> 5), rr = r & 15, cc = c & 31, ob = rr * 64 + cc * 2; return st * 1024 + (ob ^ (((ob >> 9) & 1) << 5)); }
__host__ __device__ __forceinline__ void stage_rc(int b, int& R, int& C) { const int st = b / 1024, sb = b % 1024, swz = sb ^ (((sb >> 9) & 1) << 5); R = (st >> 1) * 16 + swz / 64; C = (st & 1) * 32 + (swz % 64) / 2; }

struct Unit { int pm, pn; };
struct Gemm { const bf16_t* A; const bf16_t* Bt; int M, N, K, lda; };

struct StaticOrder {
    int nM, nN, nwg, G, c;
    __host__ __device__ void init(int M, int N, int G_, int c_) { nM = M / BM; nN = N / BM; nwg = nM * nN; G = G_; c = c_; }
    __host__ __device__ bool next(int i, Unit& u) const {
        const long L = (long)i * G + c; if (L >= nwg) return false;
        int wgid = (int)L; { const int q = nwg / NXCD, r = nwg % NXCD, xcd = wgid % NXCD, off = wgid / NXCD; wgid = (xcd < r ? xcd * (q + 1) : r * (q + 1) + (xcd - r) * q) + off; }
        const int nig = WGM * nN, gid = wgid / nig, fm = gid * WGM, gsz = (nM - fm) < WGM ? (nM - fm) : WGM;
        u.pm = fm + ((wgid % nig) % gsz); u.pn = (wgid % nig) / gsz; return true;
    }
};

template <class Epi>
__device__ __forceinline__ void gemm_phase(PG8_LAS unsigned char* lds, const Gemm g, const StaticOrder& S, const Epi& E) {
    const int tid = get_tid(), wid = __builtin_amdgcn_readfirstlane(tid >> 6), lane = tid & 63, wr = wid >> 2, wc = wid & 3, fr = lane & 15, fq = lane >> 4;
    const int K = g.K, nt = K / BK, lda = g.lda;
    unsigned voffA[2], voffB[2];
#pragma unroll
    for (int i = 0; i < 2; ++i) { int R, C; stage_rc(tid * 16 + i * 8192, R, C);
        voffA[i] = (unsigned)(R * lda + C) * 2u; voffB[i] = (unsigned)(R * K + C) * 2u; }
    const size_t kstep = (size_t)(BK * 2);
    const size_t hstepA = (size_t)HALF * lda * 2, hstepB = (size_t)HALF * K * 2;
    const size_t tstepA = 2 * hstepA, tstepB = 2 * hstepB;
    const unsigned ldsw = (unsigned)wid * 1024u;
    const int aoff = lds_byte(wr * 64 + fr, fq * 8), boff = lds_byte(wc * 32 + fr, fq * 8);
#define PG8_SA(b, h) (((b) * 2 + (h)) * HTB)
#define PG8_SB(b, h) ((4 + (b) * 2 + (h)) * HTB)
#define PG8_STAGE(bufoff, gbase, voff) do { _Pragma("unroll") for (int _i = 0; _i < 2; ++_i) \
        __builtin_amdgcn_global_load_lds((const unsigned*)((const char*)(gbase) + (voff)[_i]), (PG8_LAS unsigned*)(lds + (bufoff) + ldsw + _i * 8192), 16, 0, 0); } while (0)
#define PG8_LDA(dst, b, h) do { _Pragma("unroll") for (int m = 0; m < 4; ++m) _Pragma("unroll") for (int k = 0; k < 2; ++k) dst[m][k] = *(const PG8_LAS bf16x8*)(lds + PG8_SA(b, h) + aoff + m * 2048 + k * 1024); } while (0)
#define PG8_LDB(dst, b, h) do { _Pragma("unroll") for (int n = 0; n < 2; ++n) _Pragma("unroll") for (int k = 0; k < 2; ++k) dst[n][k] = *(const PG8_LAS bf16x8*)(lds + PG8_SB(b, h) + boff + n * 2048 + k * 1024); } while (0)
#define PG8_MMA(ai, bj, At, Bt) do { __builtin_amdgcn_s_setprio(1); _Pragma("unroll") for (int m = 0; m < 4; ++m) _Pragma("unroll") for (int n = 0; n < 2; ++n) _Pragma("unroll") for (int k = 0; k < 2; ++k) \
        acc[ai][bj][m][n] = __builtin_amdgcn_mfma_f32_16x16x32_bf16(Bt[n][k], At[m][k], acc[ai][bj][m][n], 0, 0, 0); __builtin_amdgcn_s_setprio(0); } while (0)
#define PG8_WAIT_V(n) asm volatile("s_waitcnt vmcnt(" #n ")" ::: "memory")
#define PG8_WAIT_L(n) asm volatile("s_waitcnt lgkmcnt(" #n ")" ::: "memory")
#define PG8_BAR __builtin_amdgcn_s_barrier()
#define PG8_SCHED __builtin_amdgcn_sched_barrier(0)
    Unit cur, nxt; int ui = 0;
    if (!S.next(0, cur)) return;
    f32x4 acc[2][2][4][2];
#pragma unroll
    for (int a = 0; a < 2; ++a)
#pragma unroll
        for (int b = 0; b < 2; ++b)
#pragma unroll
            for (int m = 0; m < 4; ++m)
#pragma unroll
                for (int n = 0; n < 2; ++n) acc[a][b][m][n] = (f32x4){0.f, 0.f, 0.f, 0.f};
    bf16x8 At[4][2], B0[2][2], B1[2][2];
    const char* cA = (const char*)g.A + (size_t)cur.pm * tstepA; const char* cB = (const char*)g.Bt + (size_t)cur.pn * tstepB;
    PG8_STAGE(PG8_SB(0, 0), cB, voffB); PG8_STAGE(PG8_SA(0, 0), cA, voffA); PG8_STAGE(PG8_SB(0, 1), cB + hstepB, voffB); PG8_STAGE(PG8_SA(0, 1), cA + hstepA, voffA);
    if (wr == 1) PG8_BAR;
    PG8_WAIT_V(4); PG8_BAR;
    PG8_STAGE(PG8_SB(1, 0), cB + kstep, voffB); PG8_STAGE(PG8_SA(1, 0), cA + kstep, voffA); PG8_STAGE(PG8_SB(1, 1), cB + hstepB + kstep, voffB);
    PG8_WAIT_V(6); PG8_BAR;
    for (;;) {
        const bool has_next = S.next(ui + 1, nxt);
        const char* nA = has_next ? (const char*)g.A + (size_t)nxt.pm * tstepA : cA; const char* nB = has_next ? (const char*)g.Bt + (size_t)nxt.pn * tstepB : cB;
        for (int t = 0; t < nt; t += 2) {
            const bool last = (t == nt - 2);
            const char* a1 = cA + (size_t)(t + 1) * kstep;
            const char* a2 = last ? nA : cA + (size_t)(t + 2) * kstep; const char* b2 = last ? nB : cB + (size_t)(t + 2) * kstep;
            const char* a3 = a2 + kstep; const char* b3 = b2 + kstep;
            PG8_LDB(B0, 0, 0); PG8_SCHED; PG8_LDA(At, 0, 0); PG8_STAGE(PG8_SA(1, 1), a1 + hstepA, voffA);
            PG8_WAIT_L(8); PG8_BAR; PG8_WAIT_L(0); PG8_MMA(0, 0, At, B0); PG8_BAR; PG8_SCHED;
            PG8_LDB(B1, 0, 1); PG8_STAGE(PG8_SB(0, 0), b2, voffB);
            PG8_BAR; PG8_WAIT_L(0); PG8_MMA(0, 1, At, B1); PG8_BAR;
            PG8_LDA(At, 0, 1); PG8_STAGE(PG8_SA(0, 0), a2, voffA);
            PG8_BAR; PG8_WAIT_L(0); PG8_MMA(1, 0, At, B0); PG8_BAR; PG8_SCHED;
            PG8_STAGE(PG8_SB(0, 1), b2 + hstepB, voffB);
            PG8_WAIT_V(6); PG8_BAR; PG8_MMA(1, 1, At, B1); PG8_BAR;
            PG8_LDB(B0, 1, 0); PG8_SCHED; PG8_LDA(At, 1, 0); PG8_STAGE(PG8_SA(0, 1), a2 + hstepA, voffA);
            PG8_WAIT_L(8); PG8_BAR; PG8_WAIT_L(0); PG8_MMA(0, 0, At, B0); PG8_BAR; PG8_SCHED;
            PG8_LDB(B1, 1, 1); PG8_STAGE(PG8_SB(1, 0), b3, voffB);
            PG8_BAR; PG8_WAIT_L(0); PG8_MMA(0, 1, At, B1); PG8_BAR;
            PG8_LDA(At, 1, 1); PG8_STAGE(PG8_SA(1, 0), a3, voffA);
            PG8_BAR; PG8_WAIT_L(0); PG8_MMA(1, 0, At, B0); PG8_BAR; PG8_SCHED;
            PG8_STAGE(PG8_SB(1, 1), b3 + hstepB, voffB);
            PG8_WAIT_V(6); PG8_BAR; PG8_MMA(1, 1, At, B1); PG8_BAR;
        }
        E(acc, cur, wr, wc, fr, fq);
        if (!has_next) break;
#pragma unroll
        for (int a = 0; a < 2; ++a)
#pragma unroll
            for (int b = 0; b < 2; ++b)
#pragma unroll
                for (int m = 0; m < 4; ++m)
#pragma unroll
                    for (int n = 0; n < 2; ++n) acc[a][b][m][n] = (f32x4){0.f, 0.f, 0.f, 0.f};
        cur = nxt; cA = nA; cB = nB; ++ui;
    }
    PG8_WAIT_V(0);
    if (wr == 0) PG8_BAR;
    PG8_BAR;
#undef PG8_SA
#undef PG8_SB
#undef PG8_STAGE
#undef PG8_LDA
#undef PG8_LDB
#undef PG8_MMA
#undef PG8_WAIT_V
#undef PG8_WAIT_L
#undef PG8_BAR
#undef PG8_SCHED
}

__device__ __forceinline__ unsigned f2bf_u(float f) { unsigned u = __builtin_bit_cast(unsigned, f); return (u + 0x7fffu + ((u >> 16) & 1u)) >> 16; }
template <int ACT> struct EpiBf16 {
    bf16_t* O; int ldc;
    __device__ __forceinline__ void operator()(const f32x4 (&acc)[2][2][4][2], const Unit& u, int wr, int wc, int fr, int fq) const {
        const int row0 = u.pm * BM + wr * 64 + fr, col0 = u.pn * BM + wc * 32 + 4 * fq;
#pragma unroll
        for (int ai = 0; ai < 2; ++ai)
#pragma unroll
            for (int m = 0; m < 4; ++m) { bf16_t* rowp = O + (size_t)(row0 + ai * HALF + m * 16) * ldc + col0;
#pragma unroll
                for (int bj = 0; bj < 2; ++bj)
#pragma unroll
                    for (int n = 0; n < 2; ++n) { f32x4 v = acc[ai][bj][m][n];
                        if (ACT == 1) { v.x = v.x > 0.f ? v.x * v.x : 0.f; v.y = v.y > 0.f ? v.y * v.y : 0.f; v.z = v.z > 0.f ? v.z * v.z : 0.f; v.w = v.w > 0.f ? v.w * v.w : 0.f; }
                        u32x2 o; o.x = f2bf_u(v.x) | (f2bf_u(v.y) << 16); o.y = f2bf_u(v.z) | (f2bf_u(v.w) << 16);
                        *(u32x2*)(rowp + bj * HALF + n * 16) = o; } }
    }
};
}
typedef unsigned short bf16_t;
typedef short bf16x8 __attribute__((ext_vector_type(8)));
typedef float f32x4 __attribute__((ext_vector_type(4)));
typedef unsigned u32x4 __attribute__((ext_vector_type(4)));
typedef unsigned u32x2 __attribute__((ext_vector_type(2)));
#define LAS __attribute__((address_space(3)))

constexpr int NBATCH = 8, SEQL = 4096, DM = 1024, CTXL = 256, TMAIN = 32768, TCTX = 2048, TT = 34816, NP = 3072, FF = 4096;
constexpr int PC_SWAQ = 0, PC_RETQ = 256, PC_RWR = 512, PC_MLAQD = 768, PC_SWAK = 1024, PC_SWAV = 1152, PC_RETK = 1280, PC_RETV = 1536, PC_RETG = 1792,
              PC_RWK = 2048, PC_RWV = 2304, PC_RWWD = 2560, PC_RWAD = 2624, PC_RWGD = 2688, PC_MLAKVD = 2816, PC_MLAKPE = 2944;
constexpr int PC_RWO0 = PC_RWV, PC_RWO1 = PC_RWR;
constexpr int NKEYS = CTXL + SEQL;

constexpr size_t MiB = 1u << 20;
constexpr size_t WS_MOD = 0;
constexpr size_t WS_TAB = 512 * 1024;
constexpr size_t WS_BON = 1 * MiB;
constexpr size_t WS_WB = 2 * MiB;
constexpr size_t WB_LAYER = 24 * MiB, WB_IN = 0, WB_OUT = 6 * MiB, WB_W1 = 8 * MiB, WB_W2 = 16 * MiB;
constexpr size_t WS_XC = 50 * MiB;
constexpr size_t WS_P = 58 * MiB;
constexpr size_t WS_HID = 58 * MiB;
constexpr size_t WS_A = 262 * MiB;
constexpr size_t ARR17 = 17 * MiB;
constexpr size_t WS_RWK = WS_A, WS_RWV = WS_A + ARR17, WS_RWRR = WS_A + 2 * ARR17, WS_RWA0 = WS_A + 3 * ARR17, WS_RWA1 = WS_A + 4 * ARR17,
                 WS_RWM0 = WS_A + 5 * ARR17, WS_RWM1 = WS_A + 6 * ARR17;
constexpr size_t WS_RET = WS_A + 119 * MiB;
constexpr size_t WS_MQ = WS_RET + 34 * MiB;
constexpr size_t WS_KM = WS_MQ + 26738688;
constexpr size_t WS_VTM = WS_KM + 26738688;
constexpr size_t WS_KS = WS_VTM + ARR17;
constexpr size_t WS_VTS = WS_KS + 8912896;
constexpr size_t WS_A_END = WS_VTS + 8912896;
constexpr size_t WS_Z = 330 * MiB;
constexpr size_t WS_HB = 398 * MiB;
constexpr size_t WS_MLAW = 500 * MiB;
constexpr size_t MLAW_LAYER = 384 * 256 * 2 + 512 * 128 * 2, MLAW_KV = 384 * 256 * 2;
constexpr size_t WS_NEED = 501 * MiB;
static_assert(WS_A_END <= WS_NEED && WS_HB + 68 * MiB <= WS_NEED && WS_HID + 272 * MiB <= WS_Z, "ws map");

constexpr int LDS_BYTES = 150 * 1024;

struct Params { const float* in[30]; float* out; unsigned char* ws; };

__device__ __forceinline__ float bf2f(bf16_t v) { return __builtin_bit_cast(float, (unsigned)v << 16); }
__device__ __forceinline__ bf16_t f2bf(float f) { unsigned u = __builtin_bit_cast(unsigned, f); return (bf16_t)((u + 0x7fffu + ((u >> 16) & 1u)) >> 16); }
__device__ __forceinline__ unsigned pk2(float lo, float hi) { return (unsigned)f2bf(lo) | ((unsigned)f2bf(hi) << 16); }
typedef float f32x2 __attribute__((ext_vector_type(2)));
template <int CTRL> __device__ __forceinline__ float dppf(float v) { return __builtin_bit_cast(float, __builtin_amdgcn_update_dpp(0, __builtin_bit_cast(int, v), CTRL, 0xF, 0xF, true)); }
__device__ __forceinline__ float red4(float v) { v += dppf<0xB1>(v); v += dppf<0x4E>(v); return v; }
__device__ __forceinline__ float red8(float v) { v = red4(v); v += dppf<0x141>(v); return v; }
__device__ __forceinline__ float red16(float v) { v = red8(v); v += dppf<0x140>(v); return v; }
__device__ __forceinline__ float max16(float v) { v = fmaxf(v, dppf<0xB1>(v)); v = fmaxf(v, dppf<0x4E>(v)); v = fmaxf(v, dppf<0x141>(v)); v = fmaxf(v, dppf<0x140>(v)); return v; }
__device__ __forceinline__ float wave_sum(float v) {
    v = red16(v);
    const int u = __builtin_bit_cast(int, v);
    return __builtin_bit_cast(float, __builtin_amdgcn_readlane(u, 0)) + __builtin_bit_cast(float, __builtin_amdgcn_readlane(u, 16)) +
           __builtin_bit_cast(float, __builtin_amdgcn_readlane(u, 32)) + __builtin_bit_cast(float, __builtin_amdgcn_readlane(u, 48));
}
__device__ __forceinline__ void unpack8(const u32x4 u, float* f) {
    f[0] = bf2f((bf16_t)(u.x & 0xffff)); f[1] = bf2f((bf16_t)(u.x >> 16)); f[2] = bf2f((bf16_t)(u.y & 0xffff)); f[3] = bf2f((bf16_t)(u.y >> 16));
    f[4] = bf2f((bf16_t)(u.z & 0xffff)); f[5] = bf2f((bf16_t)(u.z >> 16)); f[6] = bf2f((bf16_t)(u.w & 0xffff)); f[7] = bf2f((bf16_t)(u.w >> 16));
}
__device__ __forceinline__ float sigmoidf_(float x) { return 1.f / (1.f + __expf(-x)); }

struct SeqInfo { int b, pos, len, start, isctx; };
__device__ __forceinline__ SeqInfo seq_of_row(int row) {
    SeqInfo s;
    if (row < TMAIN) { s.b = row >> 12; s.pos = row & 4095; s.len = SEQL; s.start = s.b << 12; s.isctx = 0; }
    else { const int r = row - TMAIN; s.b = r >> 8; s.pos = r & 255; s.len = CTXL; s.start = TMAIN + (s.b << 8); s.isctx = 1; }
    return s;
}

__device__ __forceinline__ void transpose_item(const float* W, int N, int nsrc0, bf16_t* WT, int K, int ndst0, int k0, LAS float* scr, int lane) {
    if (nsrc0 >= 0) {
#pragma unroll 32
        for (int i = 0; i < 32; ++i) { const int kk = 2 * i + (lane >> 5); scr[kk * 33 + (lane & 31)] = W[(size_t)(k0 + kk) * N + nsrc0 + (lane & 31)]; }
    } else {
#pragma unroll 8
        for (int i = 0; i < 32; ++i) { const int kk = 2 * i + (lane >> 5); scr[kk * 33 + (lane & 31)] = 0.f; }
    }
    __builtin_amdgcn_wave_barrier(); asm volatile("s_waitcnt lgkmcnt(0)" ::: "memory");
    const int c = lane & 7;
#pragma unroll
    for (int j = 0; j < 4; ++j) { const int n = (lane >> 3) + 8 * j; const LAS float* s = scr + (8 * c) * 33 + n;
        u32x4 o; o.x = pk2(s[0 * 33], s[1 * 33]); o.y = pk2(s[2 * 33], s[3 * 33]); o.z = pk2(s[4 * 33], s[5 * 33]); o.w = pk2(s[6 * 33], s[7 * 33]);
        *(u32x4*)(WT + (size_t)(ndst0 + n) * K + k0 + 8 * c) = o; }
    __builtin_amdgcn_wave_barrier(); asm volatile("s_waitcnt lgkmcnt(0)" ::: "memory");
}
__device__ __forceinline__ int win_src_col(int n) {
    if (n < 256) return n;
    if (n < 512) return 512 + (n - 256);
    if (n < 768) return 1536 + (n - 512);
    if (n < 1024) return 2560 + (n - 768);
    if (n < 1280) return 256 + (n - 1024);
    if (n < 2048) return 768 + (n - 1280);
    if (n < 2816) return 1792 + (n - 2048);
    if (n < 2976) return n;
    return -1;
}
__device__ __forceinline__ void phase_prologue(const Params& p, LAS unsigned char* lds, int bid, int nb) {
    const int tid = get_tid(), lane = tid & 63, wave = tid >> 6;
    LAS float* scr = (LAS float*)(lds + wave * 16384);
    const int gw = bid * 8 + wave, NGW = nb * 8;
    constexpr int I_IN = 16 * 96, I_OUT = 16 * 32, I_1 = 16 * 128, I_2 = 64 * 32, I_Q = 4 * 12, I_KV = 2 * 16, I_L = I_IN + I_OUT + I_1 + I_2 + I_Q + I_KV;
    for (int it = gw; it < 2 * I_L; it += NGW) {
        const int l = it / I_L; int r = it % I_L;
        unsigned char* wb = p.ws + WS_WB + (size_t)l * WB_LAYER;
        if (r < I_IN) { const int kb = r / 96, nbk = r % 96; transpose_item(p.in[10] + (size_t)l * DM * 2976, 2976, win_src_col(nbk * 32), (bf16_t*)(wb + WB_IN), DM, nbk * 32, kb * 64, scr, lane); continue; } r -= I_IN;
        if (r < I_OUT) { const int kb = r / 32, nbk = r % 32; transpose_item(p.in[11] + (size_t)l * DM * DM, DM, nbk * 32, (bf16_t*)(wb + WB_OUT), DM, nbk * 32, kb * 64, scr, lane); continue; } r -= I_OUT;
        if (r < I_1) { const int kb = r / 128, nbk = r % 128; transpose_item(p.in[28] + (size_t)l * DM * FF, FF, nbk * 32, (bf16_t*)(wb + WB_W1), DM, nbk * 32, kb * 64, scr, lane); continue; } r -= I_1;
        if (r < I_2) { const int kb = r / 32, nbk = r % 32; transpose_item(p.in[29] + (size_t)l * FF * DM, DM, nbk * 32, (bf16_t*)(wb + WB_W2), FF, nbk * 32, kb * 64, scr, lane); continue; } r -= I_2;
        unsigned char* mw = p.ws + WS_MLAW + (size_t)l * MLAW_LAYER;
        if (r < I_Q) { const int kb = r / 12, nbk = r % 12; transpose_item(p.in[25] + (size_t)l * 256 * 384, 384, nbk * 32, (bf16_t*)mw, 256, nbk * 32, kb * 64, scr, lane); continue; } r -= I_Q;
        { const int kb = r / 16, nbk = r % 16; transpose_item(p.in[27] + (size_t)l * 128 * 512, 512, nbk * 32, (bf16_t*)(mw + MLAW_KV), 128, nbk * 32, kb * 64, scr, lane); }
    }
    __syncthreads();
    for (int it = bid; it < 192; it += nb) {
        const int l = it / 96, cb = it % 96;
        LAS float* sc = (LAS float*)lds;
        LAS float* red = sc + 9 * 1024;
        for (int e = tid; e < 9 * 1024; e += 512) { const int r = e >> 10, k = e & 1023; const float v = (r < 8) ? p.in[1][r * 1024 + k] : p.in[3][k]; sc[e] = v / (1.f + __expf(-v)); }
        __syncthreads();
        const int ks = tid >> 6, cl = tid & 63, n = cb * 64 + cl;
        float acc[9];
#pragma unroll
        for (int r = 0; r < 9; ++r) acc[r] = 0.f;
        const float* aw = p.in[4] + (size_t)l * DM * 6144;
#pragma unroll 16
        for (int k = ks * 128; k < ks * 128 + 128; ++k) { const float w = aw[(size_t)k * 6144 + n];
#pragma unroll
            for (int r = 0; r < 9; ++r) acc[r] += sc[r * 1024 + k] * w; }
#pragma unroll
        for (int r = 0; r < 9; ++r) red[(ks * 9 + r) * 64 + cl] = acc[r];
        __syncthreads();
        for (int e = tid; e < 9 * 64; e += 512) { const int r = e >> 6, c2 = e & 63; float s = 0.f;
            for (int q = 0; q < 8; ++q) s += red[(q * 9 + r) * 64 + c2];
            ((float*)(p.ws + WS_MOD))[((size_t)l * 9 + r) * 6144 + cb * 64 + c2] = s + p.in[5][(size_t)l * 6144 + cb * 64 + c2]; }
        __syncthreads();
    }
    if (bid == nb - 1) {
        float* tab = (float*)(p.ws + WS_TAB);
        for (int e = tid; e < 64 * 16; e += 512) { const int pos = e >> 4, f = e & 15; const float inv = powf(10000.f, -(float)(2 * f) / 32.f); const float a = (float)pos * inv; tab[e] = cosf(a); tab[1024 + e] = sinf(a); }
        for (int e = tid; e < 64 * 8; e += 512) { const int pos = e >> 3, f = e & 7; const float inv = powf(10000.f, -(float)(2 * f) / 16.f); const float a = (float)pos * inv; tab[2048 + e] = cosf(a); tab[2560 + e] = sinf(a); }
    }
}

struct RowJob { const float* xsrc; const bf16_t* z; const float* gpost; const float* gate; float* xdst; const float* gpre; const float* shift; const float* scale; bf16_t* hdst; };
__device__ __forceinline__ RowJob make_rowjob(const Params& p, int mode, int l, int row) {
    const float* mod = (const float*)(p.ws + WS_MOD);
    bf16_t* HB = (bf16_t*)(p.ws + WS_HB); const bf16_t* Z = (const bf16_t*)(p.ws + WS_Z);
    float* XC = (float*)(p.ws + WS_XC);
    const SeqInfo s = seq_of_row(row);
    const int mr = s.isctx ? 8 : s.b;
    const float* m_l = mod + ((size_t)l * 9 + mr) * 6144;
    float* xs = s.isctx ? XC + (size_t)(row - TMAIN) * DM : p.out + (size_t)row * DM;
    const float* xin = s.isctx ? p.in[2] + (size_t)(row - TMAIN) * DM : p.in[0] + (size_t)row * DM;
    RowJob j;
    if (mode == 0) { j = RowJob{xin, nullptr, nullptr, nullptr, nullptr, p.in[6] + l * DM, m_l + 0, m_l + 1024, HB + (size_t)row * DM}; }
    else if (mode == 1) { j = RowJob{l == 0 ? xin : xs, Z + (size_t)row * DM, p.in[7] + l * DM, m_l + 2048, xs, p.in[8] + l * DM, m_l + 3072, m_l + 4096, HB + (size_t)row * DM}; }
    else { const bool has_next = (l + 1 < 2); const float* m_n = mod + ((size_t)(has_next ? l + 1 : l) * 9 + mr) * 6144;
        j = RowJob{xs, Z + (size_t)row * DM, p.in[9] + l * DM, m_l + 5120, xs, p.in[6] + (has_next ? l + 1 : l) * DM, m_n + 0, m_n + 1024, has_next ? HB + (size_t)row * DM : nullptr}; }
    return j;
}
template <int RB>
__device__ __forceinline__ void rowop_batch(const RowJob (&jb)[RB], const bool (&valid)[RB], int lane) {
    f32x4 v[RB][4]; u32x2 zu[RB][4];
#pragma unroll
    for (int r = 0; r < RB; ++r) if (valid[r]) {
#pragma unroll
        for (int j = 0; j < 4; ++j) { v[r][j] = *(const f32x4*)(jb[r].xsrc + (j * 64 + lane) * 4); if (jb[r].z) zu[r][j] = *(const u32x2*)(jb[r].z + (j * 64 + lane) * 4); }
    }
#pragma unroll
    for (int r = 0; r < RB; ++r) if (valid[r]) {
        const RowJob& J = jb[r];
        if (J.z) {
            f32x4 zz[4], gp[4], gt[4]; float ss = 0.f;
#pragma unroll
            for (int j = 0; j < 4; ++j) { const int c = (j * 64 + lane) * 4; gp[j] = *(const f32x4*)(J.gpost + c); gt[j] = *(const f32x4*)(J.gate + c); }
#pragma unroll
            for (int j = 0; j < 4; ++j) { const u32x2 u = zu[r][j];
                zz[j].x = bf2f((bf16_t)(u.x & 0xffff)); zz[j].y = bf2f((bf16_t)(u.x >> 16)); zz[j].z = bf2f((bf16_t)(u.y & 0xffff)); zz[j].w = bf2f((bf16_t)(u.y >> 16));
                ss += zz[j].x * zz[j].x + zz[j].y * zz[j].y + zz[j].z * zz[j].z + zz[j].w * zz[j].w; }
            const float rinv = 1.f / sqrtf(wave_sum(ss) * (1.f / 1024.f) + 1e-6f);
#pragma unroll
            for (int j = 0; j < 4; ++j) { const int c = (j * 64 + lane) * 4;
                v[r][j].x += gt[j].x * (zz[j].x * rinv * gp[j].x); v[r][j].y += gt[j].y * (zz[j].y * rinv * gp[j].y); v[r][j].z += gt[j].z * (zz[j].z * rinv * gp[j].z); v[r][j].w += gt[j].w * (zz[j].w * rinv * gp[j].w);
                *(f32x4*)(J.xdst + c) = v[r][j]; }
        }
        if (J.hdst) {
            f32x4 g[4], sh[4], sc[4]; float ss = 0.f;
#pragma unroll
            for (int j = 0; j < 4; ++j) { const int c = (j * 64 + lane) * 4; g[j] = *(const f32x4*)(J.gpre + c); sh[j] = *(const f32x4*)(J.shift + c); sc[j] = *(const f32x4*)(J.scale + c); }
#pragma unroll
            for (int j = 0; j < 4; ++j) ss += v[r][j].x * v[r][j].x + v[r][j].y * v[r][j].y + v[r][j].z * v[r][j].z + v[r][j].w * v[r][j].w;
            const float rinv = 1.f / sqrtf(wave_sum(ss) * (1.f / 1024.f) + 1e-6f);
#pragma unroll
            for (int j = 0; j < 4; ++j) { const int c = (j * 64 + lane) * 4;
                u32x2 o; o.x = pk2(v[r][j].x * rinv * g[j].x * (1.f + sc[j].x) + sh[j].x, v[r][j].y * rinv * g[j].y * (1.f + sc[j].y) + sh[j].y);
                o.y = pk2(v[r][j].z * rinv * g[j].z * (1.f + sc[j].z) + sh[j].z, v[r][j].w * rinv * g[j].w * (1.f + sc[j].w) + sh[j].w);
                *(u32x2*)(J.hdst + c) = o; }
        }
    }
}
__device__ __forceinline__ void phase_rowops(const Params& p, int mode, int l, int nrows, int bid, int nb) {
    const int tid = get_tid(), lane = tid & 63, wave = tid >> 6;
    constexpr int RB = 4;
    const int nwaves = nb * 8, gw = bid * 8 + wave;
    for (int base = gw; base < nrows; base += nwaves * RB) {
        RowJob jb[RB]; bool valid[RB];
#pragma unroll
        for (int r = 0; r < RB; ++r) { const int row = base + r * nwaves; valid[r] = row < nrows; jb[r] = make_rowjob(p, mode, l, valid[r] ? row : 0); }
        rowop_batch<RB>(jb, valid, lane);
    }
}

__device__ __forceinline__ void rwkv_prep_item(const Params& p, int l, LAS unsigned char* lds, int tile) {
    const int tid = get_tid();
    const bf16_t* P = (const bf16_t*)(p.ws + WS_P);
    const int t0 = tile * 32; const SeqInfo s0 = seq_of_row(t0);
    const float* mu = p.in[14] + l * 1024;
    LAS float* r_s = (LAS float*)lds;
    LAS float* k_s = r_s + 32 * 256;
    LAS float* v_s = k_s + 32 * 256;
    LAS float* twd = v_s + 32 * 256;
    LAS float* ad_s = twd + 32 * 64;
#pragma unroll
    for (int it = 0; it < 7; ++it) {
        const int pc = tid + it * 512; const int tok = pc / 112, c8 = pc % 112, cc = c8 * 8;
        const int pcol = cc < 256 ? PC_RWR + cc : PC_RWK + (cc - 256);
        const int row = t0 + tok, pos = s0.pos + tok;
        const u32x4 u0 = *(const u32x4*)(P + (size_t)row * NP + pcol);
        const u32x4 um = pos > 0 ? *(const u32x4*)(P + (size_t)(row - 1) * NP + pcol) : (u32x4){0u, 0u, 0u, 0u};
        const u32x4 up = pos < s0.len - 1 ? *(const u32x4*)(P + (size_t)(row + 1) * NP + pcol) : (u32x4){0u, 0u, 0u, 0u};
        const f32x4 mu0 = *(const f32x4*)(mu + cc), mu1 = *(const f32x4*)(mu + cc + 4);
        float z0[8], zm[8], zp[8], zs[8]; unpack8(u0, z0); unpack8(um, zm); unpack8(up, zp);
        const float mm[8] = {mu0.x, mu0.y, mu0.z, mu0.w, mu1.x, mu1.y, mu1.z, mu1.w};
#pragma unroll
        for (int x = 0; x < 8; ++x) zs[x] = z0[x] + mm[x] * (0.5f * (zm[x] + zp[x]) - z0[x]);
        LAS float* dst;
        if (cc < 256) dst = r_s + tok * 256 + cc;
        else if (cc < 512) dst = k_s + tok * 256 + cc - 256;
        else if (cc < 768) dst = v_s + tok * 256 + cc - 512;
        else if (cc < 832) { dst = twd + tok * 64 + cc - 768;
#pragma unroll
            for (int x = 0; x < 8; ++x) zs[x] = 1.f - 2.f / (1.f + __expf(2.f * zs[x])); }
        else dst = ad_s + tok * 64 + cc - 832;
        *(LAS f32x4*)dst = (f32x4){zs[0], zs[1], zs[2], zs[3]}; *(LAS f32x4*)(dst + 4) = (f32x4){zs[4], zs[5], zs[6], zs[7]};
    }
    __syncthreads();
    const int hh = tid >> 8, c = tid & 255, h = c >> 6;
    float aw0[16], aw1[16], aa0[16], aa1[16];
#pragma unroll
    for (int i = 0; i < 16; ++i) { aw0[i] = 0.f; aw1[i] = 0.f; aa0[i] = 0.f; aa1[i] = 0.f; }
    const float* wup = p.in[16] + (size_t)l * 2 * 64 * 256; const float* aup = p.in[18] + (size_t)l * 2 * 64 * 256;
#pragma unroll 4
    for (int j = 0; j < 64; ++j) {
        const float w0 = wup[j * 256 + c], w1 = wup[64 * 256 + j * 256 + c], a0 = aup[j * 256 + c], a1 = aup[64 * 256 + j * 256 + c];
#pragma unroll
        for (int i = 0; i < 16; ++i) { const float tw = twd[(hh * 16 + i) * 64 + j], ta = ad_s[(hh * 16 + i) * 64 + j];
            aw0[i] += tw * w0; aw1[i] += tw * w1; aa0[i] += ta * a0; aa1[i] += ta * a1; }
    }
    const float w0b0 = p.in[15][(l * 2 + 0) * 256 + c], w0b1 = p.in[15][(l * 2 + 1) * 256 + c];
    const float a0b0 = p.in[17][(l * 2 + 0) * 256 + c], a0b1 = p.in[17][(l * 2 + 1) * 256 + c];
    const float ka = p.in[21][l * 256 + c], rk = p.in[22][l * 256 + c];
    bf16_t* RK = (bf16_t*)(p.ws + WS_RWK); bf16_t* RV = (bf16_t*)(p.ws + WS_RWV); bf16_t* RR = (bf16_t*)(p.ws + WS_RWRR);
    bf16_t* RA0 = (bf16_t*)(p.ws + WS_RWA0); bf16_t* RA1 = (bf16_t*)(p.ws + WS_RWA1); bf16_t* RM0 = (bf16_t*)(p.ws + WS_RWM0); bf16_t* RM1 = (bf16_t*)(p.ws + WS_RWM1);
    float* BON = (float*)(p.ws + WS_BON);
#pragma unroll
    for (int i = 0; i < 16; ++i) {
        const int tok = hh * 16 + i, row = t0 + tok;
        const float k = k_s[tok * 256 + c], v = v_s[tok * 256 + c], r = r_s[tok * 256 + c];
        const float sg0 = sigmoidf_(w0b0 + aw0[i]), sg1 = sigmoidf_(w0b1 + aw1[i]);
        const float om0 = 1.f - __expf(-0.60653066f * sg0), om1 = 1.f - __expf(-0.60653066f * sg1);
        const float a0 = sigmoidf_(a0b0 + aa0[i]), a1 = sigmoidf_(a0b1 + aa1[i]);
        const float kt0 = k * (1.f + (a0 - 1.f) * ka), kt1 = k * (1.f + (a1 - 1.f) * ka);
        const float bs = wave_sum(r * (kt0 + kt1) * rk);
        const size_t o = (size_t)row * 256 + c;
        RK[o] = f2bf(k); RV[o] = f2bf(v); RR[o] = f2bf(r); RA0[o] = f2bf(a0); RA1[o] = f2bf(a1); RM0[o] = f2bf(om0); RM1[o] = f2bf(om1);
        if ((tid & 63) == 0) BON[(size_t)row * 4 + h] = bs;
    }
    __syncthreads();
}
__device__ __forceinline__ int ret_chunk_index(int cr, int& b) { if (cr < 256) { b = cr >> 5; return 2 + (cr & 31); } b = (cr - 256) >> 1; return (cr - 256) & 1; }
__device__ __forceinline__ void ret_kv_item(const Params& p, LAS unsigned char* lds, int item) {
    const int tid = get_tid();
    const bf16_t* P = (const bf16_t*)(p.ws + WS_P);
    const int cr = item >> 2, h = item & 3; int b; const int ci = ret_chunk_index(cr, b);
    const int r0 = cr * 128;
    LAS float* Ks = (LAS float*)lds;
    LAS float* Vs = Ks + 128 * 64;
    LAS float* dec = Vs + 128 * 64;
    const float lg = log1pf(-exp2f(-5.f - (float)h));
    for (int e = tid; e < 128 * 64; e += 512) { const int j = e >> 6, d = e & 63;
        Ks[e] = bf2f(P[(size_t)(r0 + j) * NP + PC_RETK + h * 64 + d]) * 0.125f; Vs[e] = bf2f(P[(size_t)(r0 + j) * NP + PC_RETV + h * 64 + d]); }
    if (tid < 128) dec[tid] = expf((float)tid * lg);
    __syncthreads();
    const int d = tid >> 3, e0 = (tid & 7) * 8;
    float af[8], ab[8];
#pragma unroll
    for (int i = 0; i < 8; ++i) { af[i] = 0.f; ab[i] = 0.f; }
    for (int j = 0; j < 128; ++j) { const float kd = Ks[j * 64 + d]; const float kf = kd * dec[127 - j], kb = kd * dec[j];
        const f32x4 v0 = *(const LAS f32x4*)(Vs + j * 64 + e0), v1 = *(const LAS f32x4*)(Vs + j * 64 + e0 + 4);
        af[0] += kf * v0.x; af[1] += kf * v0.y; af[2] += kf * v0.z; af[3] += kf * v0.w; af[4] += kf * v1.x; af[5] += kf * v1.y; af[6] += kf * v1.z; af[7] += kf * v1.w;
        ab[0] += kb * v0.x; ab[1] += kb * v0.y; ab[2] += kb * v0.z; ab[3] += kb * v0.w; ab[4] += kb * v1.x; ab[5] += kb * v1.y; ab[6] += kb * v1.z; ab[7] += kb * v1.w; }
    float* RS = (float*)(p.ws + WS_RET) + ((size_t)((b * 4 + h) * 34 + ci) * 2) * 4096;
#pragma unroll
    for (int i = 0; i < 8; ++i) { RS[d * 64 + e0 + i] = af[i]; RS[4096 + d * 64 + e0 + i] = ab[i]; }
    __syncthreads();
}
__device__ __forceinline__ void swa_prep_item(const Params& p, LAS unsigned char* lds, int tile) {
    const int tid = get_tid();
    bf16_t* P = (bf16_t*)(p.ws + WS_P);
    const float* tabc = (const float*)(p.ws + WS_TAB); const float* tabs = tabc + 1024;
    bf16_t* KS = (bf16_t*)(p.ws + WS_KS); bf16_t* VT = (bf16_t*)(p.ws + WS_VTS);
    const int t0 = tile * 64; const SeqInfo s0 = seq_of_row(t0);
    const int key0 = s0.isctx ? s0.pos : CTXL + s0.pos;
    LAS bf16_t* Vs = (LAS bf16_t*)lds;
    u32x4 vreg[2];
#pragma unroll
    for (int it = 0; it < 2; ++it) { const int pc = tid + it * 512, tok = pc >> 4, c8 = pc & 15; vreg[it] = *(const u32x4*)(P + (size_t)(t0 + tok) * NP + PC_SWAV + c8 * 8); }
    u32x4 x1[3], x2[3];
#pragma unroll
    for (int it = 0; it < 3; ++it) { const int e = tid + it * 512; const int tok = e / 24, rem = e % 24, hd = rem >> 2, axis = (rem >> 1) & 1, fg = rem & 1;
        const int colbase = (hd < 4 ? PC_SWAQ + hd * 64 : PC_SWAK + (hd - 4) * 64) + axis * 32 + fg * 8;
        x1[it] = *(const u32x4*)(P + (size_t)(t0 + tok) * NP + colbase); x2[it] = *(const u32x4*)(P + (size_t)(t0 + tok) * NP + colbase + 16); }
#pragma unroll
    for (int it = 0; it < 2; ++it) { const int pc = tid + it * 512, tok = pc >> 4, c8 = pc & 15; *(LAS u32x4*)(Vs + tok * 136 + c8 * 8) = vreg[it]; }
#pragma unroll
    for (int it = 0; it < 3; ++it) { const int e = tid + it * 512; const int tok = e / 24, rem = e % 24, hd = rem >> 2, axis = (rem >> 1) & 1, fg = rem & 1;
        const int row = t0 + tok, pos = s0.pos + tok;
        const int colbase = (hd < 4 ? PC_SWAQ + hd * 64 : PC_SWAK + (hd - 4) * 64) + axis * 32 + fg * 8;
        float a[8], bb[8]; unpack8(x1[it], a); unpack8(x2[it], bb);
        if (!s0.isctx) { const int pp = axis == 0 ? (pos >> 6) : (pos & 63);
            const f32x4 c0 = *(const f32x4*)(tabc + pp * 16 + fg * 8), c1 = *(const f32x4*)(tabc + pp * 16 + fg * 8 + 4), s0v = *(const f32x4*)(tabs + pp * 16 + fg * 8), s1v = *(const f32x4*)(tabs + pp * 16 + fg * 8 + 4);
            const float cs[8] = {c0.x, c0.y, c0.z, c0.w, c1.x, c1.y, c1.z, c1.w}, sn[8] = {s0v.x, s0v.y, s0v.z, s0v.w, s1v.x, s1v.y, s1v.z, s1v.w};
#pragma unroll
            for (int x = 0; x < 8; ++x) { const float y1 = a[x] * cs[x] - bb[x] * sn[x], y2 = bb[x] * cs[x] + a[x] * sn[x]; a[x] = y1; bb[x] = y2; } }
        u32x4 o1, o2; o1.x = pk2(a[0], a[1]); o1.y = pk2(a[2], a[3]); o1.z = pk2(a[4], a[5]); o1.w = pk2(a[6], a[7]);
        o2.x = pk2(bb[0], bb[1]); o2.y = pk2(bb[2], bb[3]); o2.z = pk2(bb[4], bb[5]); o2.w = pk2(bb[6], bb[7]);
        if (hd < 4) { if (!s0.isctx) { *(u32x4*)(P + (size_t)row * NP + colbase) = o1; *(u32x4*)(P + (size_t)row * NP + colbase + 16) = o2; } }
        else { bf16_t* kd = KS + ((size_t)(s0.b * 2 + (hd - 4)) * NKEYS + key0 + tok) * 64 + axis * 32 + fg * 8; *(u32x4*)kd = o1; *(u32x4*)(kd + 16) = o2; }
    }
    __syncthreads();
#pragma unroll
    for (int it = 0; it < 2; ++it) { const int pc = tid + it * 512, hd = pc >> 3, k8 = pc & 7, hk = hd >> 6, d = hd & 63;
        unsigned w[4];
#pragma unroll
        for (int x = 0; x < 4; ++x) w[x] = (unsigned)Vs[(k8 * 8 + 2 * x) * 136 + hd] | ((unsigned)Vs[(k8 * 8 + 2 * x + 1) * 136 + hd] << 16);
        *(u32x4*)(VT + ((size_t)(s0.b * 2 + hk) * 64 + d) * NKEYS + key0 + k8 * 8) = (u32x4){w[0], w[1], w[2], w[3]}; }
    __syncthreads();
}
__device__ __forceinline__ void phase_prepA(const Params& p, int l, LAS unsigned char* lds, int bid, int nb) {
    constexpr int N1 = TT / 32, N2 = 272 * 4, N3 = TT / 64;
    for (int it = bid; it < N1 + N2 + N3; it += nb) {
        if (it < N1) rwkv_prep_item(p, l, lds, it);
        else if (it < N1 + N2) ret_kv_item(p, lds, it - N1);
        else swa_prep_item(p, lds, it - N1 - N2);
    }
}

__device__ __forceinline__ void mla_proj_item(const Params& p, int l, LAS unsigned char* lds, int tile) {
    const int tid = get_tid(), lane = tid & 63, wave = tid >> 6, fr = lane & 15, fq = lane >> 4;
    const bf16_t* P = (const bf16_t*)(p.ws + WS_P);
    const float* tabc = (const float*)(p.ws + WS_TAB) + 2048; const float* tabs = tabc + 512;
    const int t0 = tile * 32; const SeqInfo s0 = seq_of_row(t0);
    const int key0 = s0.isctx ? s0.pos : CTXL + s0.pos;
    LAS unsigned char* qn = lds;
    LAS unsigned char* kvn = lds + 32 * 528;
    LAS float* qo = (LAS float*)(lds + 32 * 528 + 32 * 272);
    LAS float* kvo = qo + 32 * 384;
    const float* qg = p.in[24] + l * 256; const float* kvg = p.in[26] + l * 128;
    for (int i = 0; i < 4; ++i) { const int tok = wave * 4 + i, row = t0 + tok;
        float x[4]; float ss = 0.f;
#pragma unroll
        for (int j = 0; j < 4; ++j) { x[j] = bf2f(P[(size_t)row * NP + PC_MLAQD + j * 64 + lane]); ss += x[j] * x[j]; }
        const float rq = 1.f / sqrtf(wave_sum(ss) * (1.f / 256.f) + 1e-6f);
#pragma unroll
        for (int j = 0; j < 4; ++j) *(LAS bf16_t*)(qn + tok * 528 + (j * 64 + lane) * 2) = f2bf(x[j] * rq * qg[j * 64 + lane]);
        float y[2]; float s2 = 0.f;
#pragma unroll
        for (int j = 0; j < 2; ++j) { y[j] = bf2f(P[(size_t)row * NP + PC_MLAKVD + j * 64 + lane]); s2 += y[j] * y[j]; }
        const float rk = 1.f / sqrtf(wave_sum(s2) * (1.f / 128.f) + 1e-6f);
#pragma unroll
        for (int j = 0; j < 2; ++j) *(LAS bf16_t*)(kvn + tok * 272 + (j * 64 + lane) * 2) = f2bf(y[j] * rk * kvg[j * 64 + lane]);
    }
    __syncthreads();
    {
        const bf16_t* WqT = (const bf16_t*)(p.ws + WS_MLAW + (size_t)l * MLAW_LAYER);
        const bf16_t* WkvT = (const bf16_t*)(p.ws + WS_MLAW + (size_t)l * MLAW_LAYER + MLAW_KV);
        for (int nt = wave; nt < 56; nt += 8) {
            f32x4 a0 = (f32x4){0.f, 0.f, 0.f, 0.f}, a1 = a0;
            if (nt < 24) {
                const bf16_t* wrow = WqT + (size_t)(nt * 16 + fr) * 256 + fq * 8;
#pragma unroll
                for (int kc = 0; kc < 8; ++kc) { const bf16x8 bfr = *(const bf16x8*)(wrow + kc * 32);
                    const bf16x8 x0 = *(const LAS bf16x8*)(qn + fr * 528 + kc * 64 + fq * 16), x1 = *(const LAS bf16x8*)(qn + (16 + fr) * 528 + kc * 64 + fq * 16);
                    a0 = __builtin_amdgcn_mfma_f32_16x16x32_bf16(x0, bfr, a0, 0, 0, 0); a1 = __builtin_amdgcn_mfma_f32_16x16x32_bf16(x1, bfr, a1, 0, 0, 0); }
#pragma unroll
                for (int r = 0; r < 4; ++r) { qo[(fq * 4 + r) * 384 + nt * 16 + fr] = a0[r]; qo[(16 + fq * 4 + r) * 384 + nt * 16 + fr] = a1[r]; }
            } else {
                const int n0 = (nt - 24) * 16;
                const bf16_t* wrow = WkvT + (size_t)(n0 + fr) * 128 + fq * 8;
#pragma unroll
                for (int kc = 0; kc < 4; ++kc) { const bf16x8 bfr = *(const bf16x8*)(wrow + kc * 32);
                    const bf16x8 x0 = *(const LAS bf16x8*)(kvn + fr * 272 + kc * 64 + fq * 16), x1 = *(const LAS bf16x8*)(kvn + (16 + fr) * 272 + kc * 64 + fq * 16);
                    a0 = __builtin_amdgcn_mfma_f32_16x16x32_bf16(x0, bfr, a0, 0, 0, 0); a1 = __builtin_amdgcn_mfma_f32_16x16x32_bf16(x1, bfr, a1, 0, 0, 0); }
#pragma unroll
                for (int r = 0; r < 4; ++r) { kvo[(fq * 4 + r) * 512 + n0 + fr] = a0[r]; kvo[(16 + fq * 4 + r) * 512 + n0 + fr] = a1[r]; }
            }
        }
    }
    __syncthreads();
    {
        const int h = tid >> 7, dd = tid & 127;
        if (dd < 64) { bf16_t* KM = (bf16_t*)(p.ws + WS_KM) + ((size_t)(s0.b * 4 + h) * NKEYS + key0) * 96 + dd;
#pragma unroll
            for (int i = 0; i < 32; ++i) KM[(size_t)i * 96] = f2bf(kvo[i * 512 + tid]); }
        else { bf16_t* VT = (bf16_t*)(p.ws + WS_VTM) + ((size_t)(s0.b * 4 + h) * 64 + (dd - 64)) * NKEYS + key0;
            unsigned w[16];
#pragma unroll
            for (int i = 0; i < 16; ++i) w[i] = pk2(kvo[(2 * i) * 512 + tid], kvo[(2 * i + 1) * 512 + tid]);
#pragma unroll
            for (int i = 0; i < 4; ++i) *(u32x4*)(VT + i * 8) = (u32x4){w[4 * i], w[4 * i + 1], w[4 * i + 2], w[4 * i + 3]}; }
    }
    bf16_t* MQ = (bf16_t*)(p.ws + WS_MQ);
    for (int e = tid; e < 32 * 384; e += 512) { const int tok = e / 384, c = e % 384, dd = c % 96; const int pos = s0.pos + tok;
        float v = qo[e];
        if (dd >= 64 && !s0.isctx) { const int pe = dd - 64, axis = pe >> 4, half = (pe >> 3) & 1, f = pe & 7; const int pp = axis == 0 ? (pos >> 6) : (pos & 63);
            const float cs = tabc[pp * 8 + f], sn = tabs[pp * 8 + f];
            const float x1 = half ? qo[e - 8] : v, x2 = half ? v : qo[e + 8];
            v = half ? (x2 * cs + x1 * sn) : (x1 * cs - x2 * sn); }
        MQ[(size_t)(t0 + tok) * 384 + c] = f2bf(v); }
    for (int e = tid; e < 32 * 32; e += 512) { const int tok = e >> 5, pe = e & 31, axis = pe >> 4, half = (pe >> 3) & 1, f = pe & 7; const int row = t0 + tok, pos = s0.pos + tok;
        float v = bf2f(P[(size_t)row * NP + PC_MLAKPE + pe]);
        if (!s0.isctx) { const int pp = axis == 0 ? (pos >> 6) : (pos & 63); const float cs = tabc[pp * 8 + f], sn = tabs[pp * 8 + f];
            const float other = bf2f(P[(size_t)row * NP + PC_MLAKPE + (half ? pe - 8 : pe + 8)]);
            const float x1 = half ? other : v, x2 = half ? v : other;
            v = half ? (x2 * cs + x1 * sn) : (x1 * cs - x2 * sn); }
        const bf16_t o = f2bf(v);
#pragma unroll
        for (int h = 0; h < 4; ++h) ((bf16_t*)(p.ws + WS_KM))[((size_t)(s0.b * 4 + h) * NKEYS + key0 + tok) * 96 + 64 + pe] = o; }
    __syncthreads();
}
__device__ __forceinline__ void ret_scan_item(const Params& p, int item) {
    const int tid = get_tid(); const int seq = item >> 1, dir = item & 1, h = seq & 3;
    const float lg = log1pf(-exp2f(-5.f - (float)h)); const float cdec = expf(128.f * lg);
    float* base = (float*)(p.ws + WS_RET) + (size_t)seq * 34 * 2 * 4096 + dir * 4096;
    float S[8];
#pragma unroll
    for (int i = 0; i < 8; ++i) S[i] = 0.f;
    for (int st = 0; st < 34; ++st) {
        const int ci = dir == 0 ? st : (st == 0 ? 1 : (st == 1 ? 0 : 35 - st));
        float* q = base + (size_t)ci * 2 * 4096 + tid * 8;
        const f32x4 t0 = *(const f32x4*)q, t1 = *(const f32x4*)(q + 4);
        *(f32x4*)q = (f32x4){S[0], S[1], S[2], S[3]}; *(f32x4*)(q + 4) = (f32x4){S[4], S[5], S[6], S[7]};
        S[0] = S[0] * cdec + t0.x; S[1] = S[1] * cdec + t0.y; S[2] = S[2] * cdec + t0.z; S[3] = S[3] * cdec + t0.w;
        S[4] = S[4] * cdec + t1.x; S[5] = S[5] * cdec + t1.y; S[6] = S[6] * cdec + t1.z; S[7] = S[7] * cdec + t1.w;
    }
}
__device__ __forceinline__ void phase_prepB(const Params& p, int l, LAS unsigned char* lds, int bid, int nb) {
    constexpr int N1 = TT / 32, N2 = 64;
    for (int it = bid; it < N1 + N2; it += nb) {
        if (it < N1) mla_proj_item(p, l, lds, it); else ret_scan_item(p, it - N1);
    }
}

typedef __bf16 bf16x2_t __attribute__((ext_vector_type(2)));
__device__ __forceinline__ unsigned cvt_pk_bf16(float lo, float hi) { const f32x2 v = {lo, hi}; return __builtin_bit_cast(unsigned, __builtin_convertvector(v, bf16x2_t)); }
template <int DK>
__device__ __forceinline__ void attn_unit(const bf16_t* Q, int qstride, const bf16_t* K, const bf16_t* Vt, int nctx, int mt0, int mt1, bool masked, int qpos0,
                                          bool has_sink, float sink, float scale, bf16_t* O, int ostride, LAS unsigned char* lds) {
    constexpr int KC = DK / 32, KP = DK + 8, KROW = KP * 2;
    constexpr int PIECES_K = 64 * DK / 8;
    constexpr int BUFB = 64 * KROW + 64 * 144;
    const int tid = get_tid(), lane = tid & 63, wave = tid >> 6, fr = lane & 15, fq = lane >> 4;
    const float sl2 = scale * 1.44269504f;
    bf16x8 qf[2][KC];
#pragma unroll
    for (int g = 0; g < 2; ++g)
#pragma unroll
        for (int kc = 0; kc < KC; ++kc) { const u32x4 u = *(const u32x4*)(Q + (size_t)(wave * 32 + g * 16 + fr) * qstride + kc * 32 + fq * 8); float f[8]; unpack8(u, f);
            u32x4 o; o.x = cvt_pk_bf16(f[0] * sl2, f[1] * sl2); o.y = cvt_pk_bf16(f[2] * sl2, f[3] * sl2); o.z = cvt_pk_bf16(f[4] * sl2, f[5] * sl2); o.w = cvt_pk_bf16(f[6] * sl2, f[7] * sl2);
            qf[g][kc] = __builtin_bit_cast(bf16x8, o); }
    float mq[2] = {0.f, 0.f}, lsum[2] = {0.f, 0.f}; f32x4 o[2][4];
#pragma unroll
    for (int g = 0; g < 2; ++g)
#pragma unroll
        for (int n = 0; n < 4; ++n) o[g][n] = (f32x4){0.f, 0.f, 0.f, 0.f};
    const int ntiles = nctx + (mt1 - mt0);
    u32x4 kr[2], vr;
    auto issue = [&](int ti) {
        const int tile = ti < nctx ? ti : mt0 + (ti - nctx);
        const bf16_t* kb = K + (size_t)tile * 64 * DK;
#pragma unroll
        for (int i = 0; i < 2; ++i) { const int pc = tid + i * 512; if (pc < PIECES_K) kr[i] = *(const u32x4*)(kb + (size_t)pc * 8); }
        { const int d = tid >> 3, c8 = tid & 7; vr = *(const u32x4*)(Vt + (size_t)d * NKEYS + tile * 64 + c8 * 8); }
    };
    auto stash = [&](int bufi) {
        LAS unsigned char* Kt = lds + bufi * BUFB; LAS unsigned char* Vl = Kt + 64 * KROW;
#pragma unroll
        for (int i = 0; i < 2; ++i) { const int pc = tid + i * 512; if (pc < PIECES_K) { const int row = pc / (DK / 8), c8 = pc % (DK / 8); *(LAS u32x4*)(Kt + row * KROW + c8 * 16) = kr[i]; } }
        { const int d = tid >> 3, c8 = tid & 7; *(LAS u32x4*)(Vl + d * 144 + c8 * 16) = vr; }
    };
    issue(0); stash(0);
    if (ntiles > 1) issue(1);
    __syncthreads();
    for (int ti = 0; ti < ntiles; ++ti) {
        const int tile = ti < nctx ? ti : mt0 + (ti - nctx);
        LAS unsigned char* Kt = lds + (ti & 1) * BUFB; LAS unsigned char* Vl = Kt + 64 * KROW;
        if (ti + 1 < ntiles) { stash((ti + 1) & 1); if (ti + 2 < ntiles) issue(ti + 2); }
        f32x4 s[2][4];
#pragma unroll
        for (int n = 0; n < 4; ++n) {
            s[0][n] = (f32x4){-mq[0], -mq[0], -mq[0], -mq[0]}; s[1][n] = (f32x4){-mq[1], -mq[1], -mq[1], -mq[1]};
#pragma unroll
            for (int kc = 0; kc < KC; ++kc) { const bf16x8 kf = *(const LAS bf16x8*)(Kt + (n * 16 + fr) * KROW + kc * 64 + fq * 16);
                s[0][n] = __builtin_amdgcn_mfma_f32_16x16x32_bf16(kf, qf[0][kc], s[0][n], 0, 0, 0);
                s[1][n] = __builtin_amdgcn_mfma_f32_16x16x32_bf16(kf, qf[1][kc], s[1][n], 0, 0, 0); } }
        if (ti == 0) {
#pragma unroll
            for (int g = 0; g < 2; ++g) {
                float t = -INFINITY;
#pragma unroll
                for (int n = 0; n < 4; ++n)
#pragma unroll
                    for (int r = 0; r < 4; ++r) t = fmaxf(t, s[g][n][r]);
                t = fmaxf(t, __shfl_xor(t, 16)); t = fmaxf(t, __shfl_xor(t, 32));
                if (has_sink) t = fmaxf(t, sink * 1.44269504f);
                mq[g] = t;
#pragma unroll
                for (int n = 0; n < 4; ++n)
#pragma unroll
                    for (int r = 0; r < 4; ++r) s[g][n][r] -= t;
            }
        }
        if (masked && ti >= nctx) {
#pragma unroll
            for (int g = 0; g < 2; ++g)
#pragma unroll
                for (int n = 0; n < 4; ++n)
#pragma unroll
                    for (int r = 0; r < 4; ++r) { const int kp = tile * 64 + n * 16 + fq * 4 + r - CTXL, qp = qpos0 + wave * 32 + g * 16 + fr; const int df = qp - kp; if (df > 128 || df < -128) s[g][n][r] = -INFINITY; }
        }
#pragma unroll
        for (int g = 0; g < 2; ++g)
#pragma unroll
            for (int n = 0; n < 4; ++n)
#pragma unroll
                for (int r = 0; r < 4; ++r) { s[g][n][r] = __builtin_amdgcn_exp2f(s[g][n][r]); lsum[g] += s[g][n][r]; }
#pragma unroll
        for (int c = 0; c < 2; ++c) {
            bf16x8 pf[2];
#pragma unroll
            for (int g = 0; g < 2; ++g) { u32x4 pu; pu.x = cvt_pk_bf16(s[g][2 * c][0], s[g][2 * c][1]); pu.y = cvt_pk_bf16(s[g][2 * c][2], s[g][2 * c][3]);
                pu.z = cvt_pk_bf16(s[g][2 * c + 1][0], s[g][2 * c + 1][1]); pu.w = cvt_pk_bf16(s[g][2 * c + 1][2], s[g][2 * c + 1][3]); pf[g] = __builtin_bit_cast(bf16x8, pu); }
#pragma unroll
            for (int n = 0; n < 4; ++n) {
                const u32x2 lo = *(const LAS u32x2*)(Vl + (n * 16 + fr) * 144 + ((2 * c) * 16 + fq * 4) * 2), hi = *(const LAS u32x2*)(Vl + (n * 16 + fr) * 144 + ((2 * c + 1) * 16 + fq * 4) * 2);
                const bf16x8 vf = __builtin_bit_cast(bf16x8, (u32x4){lo.x, lo.y, hi.x, hi.y});
                o[0][n] = __builtin_amdgcn_mfma_f32_16x16x32_bf16(vf, pf[0], o[0][n], 0, 0, 0);
                o[1][n] = __builtin_amdgcn_mfma_f32_16x16x32_bf16(vf, pf[1], o[1][n], 0, 0, 0); }
        }
        __syncthreads();
    }
#pragma unroll
    for (int g = 0; g < 2; ++g) {
        float t = lsum[g];
        t += __shfl_xor(t, 16); t += __shfl_xor(t, 32);
        if (has_sink) t += __builtin_amdgcn_exp2f(sink * 1.44269504f - mq[g]);
        const float inv = 1.f / t;
#pragma unroll
        for (int n = 0; n < 4; ++n) { u32x2 ov; ov.x = cvt_pk_bf16(o[g][n][0] * inv, o[g][n][1] * inv); ov.y = cvt_pk_bf16(o[g][n][2] * inv, o[g][n][3] * inv);
            *(u32x2*)(O + (size_t)(wave * 32 + g * 16 + fr) * ostride + n * 16 + fq * 4) = ov; }
    }
}

__device__ __forceinline__ void ret_out_item(const Params& p, int l, LAS unsigned char* lds, int item) {
    const int tid = get_tid(), lane = tid & 63, wave = tid >> 6, fr = lane & 15, fq = lane >> 4;
    bf16_t* P = (bf16_t*)(p.ws + WS_P);
    const int cr = item >> 2, h = item & 3; int b; const int ci = ret_chunk_index(cr, b);
    const int r0 = cr * 128;
    const float lg2 = log1pf(-exp2f(-5.f - (float)h)) * 1.44269504f;
    LAS unsigned char* Kb = lds;
    LAS unsigned char* Vt = lds + 18432;
    LAS unsigned char* SfT = lds + 35840;
    LAS unsigned char* SbT = lds + 45056;
    for (int pc = tid; pc < 1024; pc += 512) { const int j = pc >> 3, c8 = pc & 7;
        const u32x4 kk = *(const u32x4*)(P + (size_t)(r0 + j) * NP + PC_RETK + h * 64 + c8 * 8);
        const u32x4 vv = *(const u32x4*)(P + (size_t)(r0 + j) * NP + PC_RETV + h * 64 + c8 * 8);
        float kf[8]; unpack8(kk, kf);
        u32x4 ko; ko.x = pk2(kf[0] * 0.125f, kf[1] * 0.125f); ko.y = pk2(kf[2] * 0.125f, kf[3] * 0.125f); ko.z = pk2(kf[4] * 0.125f, kf[5] * 0.125f); ko.w = pk2(kf[6] * 0.125f, kf[7] * 0.125f);
        *(LAS u32x4*)(Kb + j * 144 + c8 * 16) = ko;
        const unsigned vw[4] = {vv.x, vv.y, vv.z, vv.w};
#pragma unroll
        for (int x = 0; x < 8; ++x) *(LAS bf16_t*)(Vt + (c8 * 8 + x) * 272 + j * 2) = (bf16_t)((x & 1) ? (vw[x >> 1] >> 16) : (vw[x >> 1] & 0xffff)); }
    { const float* RS = (const float*)(p.ws + WS_RET) + ((size_t)((b * 4 + h) * 34 + ci) * 2) * 4096;
      for (int pc = tid; pc < 1024; pc += 512) { const int d = pc >> 4, e4 = (pc & 15) * 4;
          const f32x4 a = *(const f32x4*)(RS + d * 64 + e4), bb = *(const f32x4*)(RS + 4096 + d * 64 + e4);
#pragma unroll
          for (int x = 0; x < 4; ++x) { *(LAS bf16_t*)(SfT + (e4 + x) * 144 + d * 2) = f2bf(a[x]); *(LAS bf16_t*)(SbT + (e4 + x) * 144 + d * 2) = f2bf(bb[x]); } } }
    const int i = wave * 16 + fr;
    u32x4 qraw[2];
#pragma unroll
    for (int kc = 0; kc < 2; ++kc) qraw[kc] = *(const u32x4*)(P + (size_t)(r0 + i) * NP + PC_RETQ + h * 64 + kc * 32 + fq * 8);
    __syncthreads();
    f32x4 s[8];
#pragma unroll
    for (int nb = 0; nb < 8; ++nb) { s[nb] = (f32x4){0.f, 0.f, 0.f, 0.f};
#pragma unroll
        for (int kc = 0; kc < 2; ++kc) { const bf16x8 kf = *(const LAS bf16x8*)(Kb + (nb * 16 + fr) * 144 + kc * 64 + fq * 16);
            s[nb] = __builtin_amdgcn_mfma_f32_16x16x32_bf16(kf, __builtin_bit_cast(bf16x8, qraw[kc]), s[nb], 0, 0, 0); } }
#pragma unroll
    for (int nb = 0; nb < 8; ++nb)
#pragma unroll
        for (int r = 0; r < 4; ++r) { const int j = nb * 16 + fq * 4 + r; const int df = i - j; const int adf = df < 0 ? -df : df;
            float dcy = __builtin_amdgcn_exp2f((float)adf * lg2); if (df == 0) dcy = 2.f; s[nb][r] *= dcy; }
    f32x4 o[4];
#pragma unroll
    for (int n = 0; n < 4; ++n) o[n] = (f32x4){0.f, 0.f, 0.f, 0.f};
#pragma unroll
    for (int c = 0; c < 4; ++c) {
        u32x4 pu; pu.x = cvt_pk_bf16(s[2 * c][0], s[2 * c][1]); pu.y = cvt_pk_bf16(s[2 * c][2], s[2 * c][3]); pu.z = cvt_pk_bf16(s[2 * c + 1][0], s[2 * c + 1][1]); pu.w = cvt_pk_bf16(s[2 * c + 1][2], s[2 * c + 1][3]);
        const bf16x8 pf = __builtin_bit_cast(bf16x8, pu);
#pragma unroll
        for (int n = 0; n < 4; ++n) {
            const u32x2 lo = *(const LAS u32x2*)(Vt + (n * 16 + fr) * 272 + ((2 * c) * 16 + fq * 4) * 2), hi = *(const LAS u32x2*)(Vt + (n * 16 + fr) * 272 + ((2 * c + 1) * 16 + fq * 4) * 2);
            const bf16x8 vf = __builtin_bit_cast(bf16x8, (u32x4){lo.x, lo.y, hi.x, hi.y});
            o[n] = __builtin_amdgcn_mfma_f32_16x16x32_bf16(vf, pf, o[n], 0, 0, 0); }
    }
    const float gf = __builtin_amdgcn_exp2f((float)(i + 1) * lg2), gb = __builtin_amdgcn_exp2f((float)(128 - i) * lg2);
#pragma unroll
    for (int kc = 0; kc < 2; ++kc) {
        float f[8]; unpack8(qraw[kc], f);
        u32x4 uf, ub;
        uf.x = cvt_pk_bf16(f[0] * gf, f[1] * gf); uf.y = cvt_pk_bf16(f[2] * gf, f[3] * gf); uf.z = cvt_pk_bf16(f[4] * gf, f[5] * gf); uf.w = cvt_pk_bf16(f[6] * gf, f[7] * gf);
        ub.x = cvt_pk_bf16(f[0] * gb, f[1] * gb); ub.y = cvt_pk_bf16(f[2] * gb, f[3] * gb); ub.z = cvt_pk_bf16(f[4] * gb, f[5] * gb); ub.w = cvt_pk_bf16(f[6] * gb, f[7] * gb);
        const bf16x8 qF = __builtin_bit_cast(bf16x8, uf), qB = __builtin_bit_cast(bf16x8, ub);
#pragma unroll
        for (int n = 0; n < 4; ++n) {
            const bf16x8 af = *(const LAS bf16x8*)(SfT + (n * 16 + fr) * 144 + kc * 64 + fq * 16), ab = *(const LAS bf16x8*)(SbT + (n * 16 + fr) * 144 + kc * 64 + fq * 16);
            o[n] = __builtin_amdgcn_mfma_f32_16x16x32_bf16(af, qF, o[n], 0, 0, 0);
            o[n] = __builtin_amdgcn_mfma_f32_16x16x32_bf16(ab, qB, o[n], 0, 0, 0); }
    }
    float sm = 0.f;
#pragma unroll
    for (int n = 0; n < 4; ++n) sm += (o[n][0] + o[n][1]) + (o[n][2] + o[n][3]);
    sm += __shfl_xor(sm, 16); sm += __shfl_xor(sm, 32);
    const float mu = sm * (1.f / 64.f);
    float vs = 0.f;
#pragma unroll
    for (int n = 0; n < 4; ++n)
#pragma unroll
        for (int r = 0; r < 4; ++r) { const float dl = o[n][r] - mu; vs += dl * dl; }
    vs += __shfl_xor(vs, 16); vs += __shfl_xor(vs, 32);
    const float rstd = 1.f / sqrtf(vs * (1.f / 64.f) + 1e-5f);
#pragma unroll
    for (int n = 0; n < 4; ++n) { const int e0 = n * 16 + fq * 4;
        const u32x2 gu = *(const u32x2*)(P + (size_t)(r0 + i) * NP + PC_RETG + h * 64 + e0);
        const f32x4 gn = *(const f32x4*)(p.in[13] + l * 256 + h * 64 + e0);
        const float g0 = bf2f((bf16_t)(gu.x & 0xffff)), g1 = bf2f((bf16_t)(gu.x >> 16)), g2 = bf2f((bf16_t)(gu.y & 0xffff)), g3 = bf2f((bf16_t)(gu.y >> 16));
        u32x2 yo;
        yo.x = cvt_pk_bf16((o[n][0] - mu) * rstd * gn.x * (g0 / (1.f + __expf(-g0))), (o[n][1] - mu) * rstd * gn.y * (g1 / (1.f + __expf(-g1))));
        yo.y = cvt_pk_bf16((o[n][2] - mu) * rstd * gn.z * (g2 / (1.f + __expf(-g2))), (o[n][3] - mu) * rstd * gn.w * (g3 / (1.f + __expf(-g3))));
        *(u32x2*)(P + (size_t)(r0 + i) * NP + PC_RETQ + h * 64 + e0) = yo; }
    __syncthreads();
}

constexpr int NSCANBLK = 128;
__device__ __forceinline__ void rwkv_scan_item(const Params& p, int l, LAS unsigned char* lds, int item) {
    const int tid = get_tid();
    const int sc = item >> 1, half = item & 1;
    const int b = sc >> 3, h = (sc >> 1) & 3, dir = sc & 1;
    const bf16_t* RK = (const bf16_t*)(p.ws + WS_RWK); const bf16_t* RV = (const bf16_t*)(p.ws + WS_RWV); const bf16_t* RR = (const bf16_t*)(p.ws + WS_RWRR);
    const bf16_t* RA = (const bf16_t*)(p.ws + (dir ? WS_RWA1 : WS_RWA0)); const bf16_t* RM = (const bf16_t*)(p.ws + (dir ? WS_RWM1 : WS_RWM0));
    bf16_t* P = (bf16_t*)(p.ws + WS_P);
    const int ocol = (dir ? PC_RWO1 : PC_RWO0) + h * 64 + half * 32;
    LAS float* KH = (LAS float*)lds;
    LAS float* WW = KH + 4096; LAS float* BB = WW + 4096; LAS float* KT = BB + 4096; LAS float* RRl = KT + 4096; LAS float* VV = RRl + 4096; LAS float* OUT = VV + 4096;
    const int st = tid >> 3, c0 = (tid & 7) * 8;
    float kkp[8], kap[8];
#pragma unroll
    for (int i = 0; i < 8; ++i) { kkp[i] = p.in[20][l * 256 + h * 64 + c0 + i]; kap[i] = p.in[21][l * 256 + h * 64 + c0 + i]; }
    const int row_l = (tid >> 3) & 31, kq = tid & 7;
    const bool compute = tid < 256;
    f32x2 S[4];
#pragma unroll
    for (int i = 0; i < 4; ++i) S[i] = (f32x2){0.f, 0.f};
    auto row_of = [&](int s) -> int {
        if (s < CTXL) return TMAIN + b * CTXL + (dir ? CTXL - 1 - s : s);
        const int t = s - CTXL; return b * SEQL + (dir ? SEQL - 1 - t : t);
    };
    u32x4 gk, gv, gr, ga, gm;
    auto issue = [&](int ch) { const size_t o = (size_t)row_of(ch * 64 + st) * 256 + h * 64 + c0;
        gk = *(const u32x4*)(RK + o); gv = *(const u32x4*)(RV + o); gr = *(const u32x4*)(RR + o); ga = *(const u32x4*)(RA + o); gm = *(const u32x4*)(RM + o); };
    issue(0);
    for (int ch = 0; ch < 68; ++ch) {
        {
            float k[8], a[8], om[8], rr[8], vv8[8]; unpack8(gk, k); unpack8(ga, a); unpack8(gm, om); unpack8(gr, rr); unpack8(gv, vv8);
            float kk[8]; float n2 = 0.f;
#pragma unroll
            for (int i = 0; i < 8; ++i) { kk[i] = k[i] * kkp[i]; n2 += kk[i] * kk[i]; }
            n2 = red8(n2);
            const float rn = 1.f / sqrtf(fmaxf(n2, 1e-12f));
            f32x4 o0, o1;
#define ST8(DST, EXPR) { float t8[8]; _Pragma("unroll") for (int i = 0; i < 8; ++i) t8[i] = (EXPR); \
            *(LAS f32x4*)(DST + st * 64 + c0) = (f32x4){t8[0], t8[1], t8[2], t8[3]}; *(LAS f32x4*)(DST + st * 64 + c0 + 4) = (f32x4){t8[4], t8[5], t8[6], t8[7]}; }
            ST8(KH, kk[i] * rn)
            ST8(WW, 1.f - om[i])
            ST8(BB, kk[i] * rn * a[i])
            ST8(KT, k[i] * (1.f + (a[i] - 1.f) * kap[i]))
            ST8(RRl, rr[i])
            ST8(VV, vv8[i])
#undef ST8
        }
        __syncthreads();
        if (ch + 1 < 68) issue(ch + 1);
        if (compute) {
            struct Ops { f32x4 kh0, kh1, w0, w1, b0, b1, t0, t1, r0, r1; float vv; };
            auto ldops = [&](int s) -> Ops { Ops q;
                q.kh0 = *(const LAS f32x4*)(KH + s * 64 + kq * 8); q.kh1 = *(const LAS f32x4*)(KH + s * 64 + kq * 8 + 4);
                q.w0 = *(const LAS f32x4*)(WW + s * 64 + kq * 8); q.w1 = *(const LAS f32x4*)(WW + s * 64 + kq * 8 + 4);
                q.b0 = *(const LAS f32x4*)(BB + s * 64 + kq * 8); q.b1 = *(const LAS f32x4*)(BB + s * 64 + kq * 8 + 4);
                q.t0 = *(const LAS f32x4*)(KT + s * 64 + kq * 8); q.t1 = *(const LAS f32x4*)(KT + s * 64 + kq * 8 + 4);
                q.r0 = *(const LAS f32x4*)(RRl + s * 64 + kq * 8); q.r1 = *(const LAS f32x4*)(RRl + s * 64 + kq * 8 + 4);
                q.vv = VV[s * 64 + half * 32 + row_l]; return q; };
            Ops nx = ldops(0);
#pragma unroll 2
            for (int s = 0; s < 64; ++s) {
                const Ops c = nx;
                nx = ldops(s + 1 < 64 ? s + 1 : 63);
                f32x2 a2 = S[0] * (f32x2){c.kh0.x, c.kh0.y};
                a2 = S[1] * (f32x2){c.kh0.z, c.kh0.w} + a2; a2 = S[2] * (f32x2){c.kh1.x, c.kh1.y} + a2; a2 = S[3] * (f32x2){c.kh1.z, c.kh1.w} + a2;
                const float sk = red8(a2.x + a2.y);
                const f32x2 nsk = (f32x2){-sk, -sk}, vv2 = (f32x2){c.vv, c.vv};
                S[0] = S[0] * (f32x2){c.w0.x, c.w0.y} + (nsk * (f32x2){c.b0.x, c.b0.y} + vv2 * (f32x2){c.t0.x, c.t0.y});
                S[1] = S[1] * (f32x2){c.w0.z, c.w0.w} + (nsk * (f32x2){c.b0.z, c.b0.w} + vv2 * (f32x2){c.t0.z, c.t0.w});
                S[2] = S[2] * (f32x2){c.w1.x, c.w1.y} + (nsk * (f32x2){c.b1.x, c.b1.y} + vv2 * (f32x2){c.t1.x, c.t1.y});
                S[3] = S[3] * (f32x2){c.w1.z, c.w1.w} + (nsk * (f32x2){c.b1.z, c.b1.w} + vv2 * (f32x2){c.t1.z, c.t1.w});
                f32x2 o2 = S[0] * (f32x2){c.r0.x, c.r0.y};
                o2 = S[1] * (f32x2){c.r0.z, c.r0.w} + o2; o2 = S[2] * (f32x2){c.r1.x, c.r1.y} + o2; o2 = S[3] * (f32x2){c.r1.z, c.r1.w} + o2;
                const float ov = red8(o2.x + o2.y);
                if (kq == 0) OUT[s * 32 + row_l] = ov;
            }
        }
        __syncthreads();
        { const int c4 = (tid & 7) * 4; const f32x4 ov = *(const LAS f32x4*)(OUT + st * 32 + c4);
          u32x2 o2; o2.x = pk2(ov.x, ov.y); o2.y = pk2(ov.z, ov.w);
          *(u32x2*)(P + (size_t)row_of(ch * 64 + st) * NP + ocol + c4) = o2; }
    }
    __syncthreads();
}

__device__ __forceinline__ void mixer_mla(const Params& p, LAS unsigned char* lds, int it) {
    bf16_t* P = (bf16_t*)(p.ws + WS_P);
    const bf16_t* MQ = (const bf16_t*)(p.ws + WS_MQ);
    int b, h, row0, nm1;
    if (it < 512) { b = it >> 6; h = (it >> 4) & 3; row0 = b * SEQL + (it & 15) * 256; nm1 = 68; }
    else { const int u = it - 512; b = u >> 2; h = u & 3; row0 = TMAIN + b * CTXL; nm1 = 4; }
    attn_unit<96>(MQ + (size_t)row0 * 384 + h * 96, 384, (const bf16_t*)(p.ws + WS_KM) + (size_t)(b * 4 + h) * NKEYS * 96, (const bf16_t*)(p.ws + WS_VTM) + (size_t)(b * 4 + h) * 64 * NKEYS,
                  4, 4, nm1, false, 0, false, 0.f, 0.10206207f, P + (size_t)row0 * NP + PC_MLAQD + h * 64, NP, lds);
}
__device__ __forceinline__ void mixer_swa(const Params& p, int l, LAS unsigned char* lds, int u0) {
    bf16_t* P = (bf16_t*)(p.ws + WS_P);
    int b, h, row0, nm0, nm1, qp0; bool msk;
    if (u0 < 512) { b = u0 >> 6; h = (u0 >> 4) & 3; const int qb = u0 & 15; row0 = b * SEQL + qb * 256; nm0 = 4 + 4 * qb - 2; nm1 = 4 + 4 * qb + 6; if (nm0 < 4) nm0 = 4; if (nm1 > 68) nm1 = 68; qp0 = qb * 256; msk = true; }
    else { const int u = u0 - 512; b = u >> 2; h = u & 3; row0 = TMAIN + b * CTXL; nm0 = 4; nm1 = 4; qp0 = 0; msk = false; }
    const int hk = h >> 1;
    bf16_t* qp = P + (size_t)row0 * NP + PC_SWAQ + h * 64;
    attn_unit<64>(qp, NP, (const bf16_t*)(p.ws + WS_KS) + (size_t)(b * 2 + hk) * NKEYS * 64, (const bf16_t*)(p.ws + WS_VTS) + (size_t)(b * 2 + hk) * 64 * NKEYS,
                  4, nm0, nm1, msk, qp0, true, p.in[12][l * 4 + h], 0.125f, qp, NP, lds);
}
__device__ __forceinline__ void phase_mixers(const Params& p, int l, LAS unsigned char* lds, int bid, int nb) {
    const bool ectx = (l == 0);
    const int N_MLA = 512 + (ectx ? 32 : 0), N_SWA = 512 + (ectx ? 32 : 0), N_RET = 1024 + (ectx ? 64 : 0);
    if (bid < NSCANBLK) {
        rwkv_scan_item(p, l, lds, bid);
    } else {
        for (int it = bid - NSCANBLK; it < N_MLA + N_SWA + N_RET; it += nb - NSCANBLK) {
            if (it < N_MLA) mixer_mla(p, lds, it);
            else if (it < N_MLA + N_SWA) mixer_swa(p, l, lds, it - N_MLA);
            else ret_out_item(p, l, lds, it - N_MLA - N_SWA);
        }
    }
}

__device__ __forceinline__ void phase_rwkv_finish(const Params& p, int l, LAS unsigned char* lds, int bid, int nb) {
    const int tid = get_tid();
    bf16_t* P = (bf16_t*)(p.ws + WS_P);
    const int ntiles = (l == 0 ? TT : TMAIN) / 32;
    const float* mu = p.in[14] + l * 1024 + 896;
    const float* gup = p.in[19] + (size_t)l * 128 * 256;
    const bf16_t* RV = (const bf16_t*)(p.ws + WS_RWV); const float* BON = (const float*)(p.ws + WS_BON);
    LAS float* sg = (LAS float*)lds;
    for (int tile = bid; tile < ntiles; tile += nb) {
        const int t0 = tile * 32; const SeqInfo s0 = seq_of_row(t0);
        { const int tok = tid >> 4, j8 = (tid & 15) * 8; const int row = t0 + tok, pos = s0.pos + tok;
          const u32x4 u0 = *(const u32x4*)(P + (size_t)row * NP + PC_RWGD + j8);
          const u32x4 um = pos > 0 ? *(const u32x4*)(P + (size_t)(row - 1) * NP + PC_RWGD + j8) : (u32x4){0u, 0u, 0u, 0u};
          const u32x4 up = pos < s0.len - 1 ? *(const u32x4*)(P + (size_t)(row + 1) * NP + PC_RWGD + j8) : (u32x4){0u, 0u, 0u, 0u};
          float z0[8], zm[8], zp[8]; unpack8(u0, z0); unpack8(um, zm); unpack8(up, zp);
#pragma unroll
          for (int x = 0; x < 8; ++x) sg[tok * 128 + j8 + x] = sigmoidf_(z0[x] + mu[j8 + x] * (0.5f * (zm[x] + zp[x]) - z0[x])); }
        __syncthreads();
        const int hh = tid >> 8, c = tid & 255, h = c >> 6;
        float g[16];
#pragma unroll
        for (int i = 0; i < 16; ++i) g[i] = 0.f;
#pragma unroll 8
        for (int j = 0; j < 128; ++j) { const float w = gup[j * 256 + c];
#pragma unroll
            for (int i = 0; i < 16; ++i) g[i] += sg[(hh * 16 + i) * 128 + j] * w; }
        const float gn = p.in[23][l * 256 + c];
        float ov[16], rv[16], bn[16];
#pragma unroll
        for (int i = 0; i < 16; ++i) { const int row = t0 + hh * 16 + i;
            ov[i] = bf2f(P[(size_t)row * NP + PC_RWO0 + c]) + bf2f(P[(size_t)row * NP + PC_RWO1 + c]); rv[i] = bf2f(RV[(size_t)row * 256 + c]); bn[i] = BON[(size_t)row * 4 + h]; }
#pragma unroll
        for (int i = 0; i < 16; ++i) { const int row = t0 + hh * 16 + i;
            const float o = ov[i];
            const float mean = wave_sum(o) * (1.f / 64.f); const float dl = o - mean; const float var = wave_sum(dl * dl) * (1.f / 64.f);
            float y = dl * (1.f / sqrtf(var + 64e-5f)) * gn + bn[i] * rv[i];
            P[(size_t)row * NP + PC_RWO1 + c] = f2bf(y * g[i]); }
        __syncthreads();
    }
}

#ifndef N_LAUNCH_MODE
#define N_LAUNCH_MODE 1
#endif
template <int Q>
__device__ __forceinline__ void layer_phase(const Params& p, int l, LAS unsigned char* lds, int bid, int nb) {
    unsigned char* wb = p.ws + WS_WB + (size_t)l * WB_LAYER;
    const int Mrows = (l == 0) ? TT : TMAIN;
    pg8::StaticOrder S;
    if constexpr (Q == 0) { pg8::Gemm g{(const bf16_t*)(p.ws + WS_HB), (const bf16_t*)(wb + WB_IN), TT, NP, DM, DM}; S.init(TT, NP, nb, bid);
              pg8::EpiBf16<0> E{(bf16_t*)(p.ws + WS_P), NP}; pg8::gemm_phase(lds, g, S, E); }
    if constexpr (Q == 1) phase_prepA(p, l, lds, bid, nb);
    if constexpr (Q == 2) phase_prepB(p, l, lds, bid, nb);
    if constexpr (Q == 3) phase_mixers(p, l, lds, bid, nb);
    if constexpr (Q == 4) phase_rwkv_finish(p, l, lds, bid, nb);
    if constexpr (Q == 5) { pg8::Gemm g{(const bf16_t*)(p.ws + WS_P), (const bf16_t*)(wb + WB_OUT), Mrows, DM, DM, NP}; S.init(Mrows, DM, nb, bid);
              pg8::EpiBf16<0> E{(bf16_t*)(p.ws + WS_Z), DM}; pg8::gemm_phase(lds, g, S, E); }
    if constexpr (Q == 6) phase_rowops(p, 1, l, Mrows, bid, nb);
    if constexpr (Q == 7) { pg8::Gemm g{(const bf16_t*)(p.ws + WS_HB), (const bf16_t*)(wb + WB_W1), Mrows, FF, DM, DM}; S.init(Mrows, FF, nb, bid);
              pg8::EpiBf16<1> E{(bf16_t*)(p.ws + WS_HID), FF}; pg8::gemm_phase(lds, g, S, E); }
    if constexpr (Q == 8) { pg8::Gemm g{(const bf16_t*)(p.ws + WS_HID), (const bf16_t*)(wb + WB_W2), Mrows, DM, FF, FF}; S.init(Mrows, DM, nb, bid);
              pg8::EpiBf16<0> E{(bf16_t*)(p.ws + WS_Z), DM}; pg8::gemm_phase(lds, g, S, E); }
    if constexpr (Q == 9) phase_rowops(p, 2, l, Mrows, bid, nb);
}

#ifndef PROBE_MASK
#define PROBE_MASK 0
#endif
#define PB(BIT, CALL) do { if ((PROBE_MASK) & (BIT)) { const unsigned long long t0_ = __builtin_amdgcn_s_memrealtime(); CALL; const unsigned long long t1_ = __builtin_amdgcn_s_memrealtime(); \
        while (__builtin_amdgcn_s_memrealtime() - t1_ < (t1_ - t0_)) __builtin_amdgcn_s_sleep(8); } else { CALL; } } while (0)
#define GSYNC() do { asm volatile("s_waitcnt vmcnt(0) lgkmcnt(0)" ::: "memory"); __syncthreads(); if (get_tid() < 64) { __builtin_amdgcn_fence(__ATOMIC_RELEASE, "agent"); asm volatile("s_waitcnt vmcnt(0) lgkmcnt(0)" ::: "memory"); } grid.sync(); \
    if (get_tid() < 64) { __builtin_amdgcn_fence(__ATOMIC_ACQUIRE, "agent"); asm volatile("s_waitcnt vmcnt(0) lgkmcnt(0)" ::: "memory"); } __syncthreads(); } while (0)
__global__ void __launch_bounds__(512, 2) mega_fwd(Params p) {
    extern __shared__ __attribute__((aligned(16))) unsigned char lds_raw[];
    LAS unsigned char* lds = (LAS unsigned char*)lds_raw;
    cg::grid_group grid = cg::this_grid();
    const int bid = blockIdx.x, nb = gridDim.x;
    PB(16, phase_prologue(p, lds, bid, nb)); GSYNC();
    PB(8, phase_rowops(p, 0, 0, TT, bid, nb)); GSYNC();
#define LAYER(L, LAST) \
    PB(1, layer_phase<0>(p, L, lds, bid, nb)); GSYNC(); PB(4, layer_phase<1>(p, L, lds, bid, nb)); GSYNC(); PB(4, layer_phase<2>(p, L, lds, bid, nb)); GSYNC(); \
    PB(2, layer_phase<3>(p, L, lds, bid, nb)); GSYNC(); PB(4, layer_phase<4>(p, L, lds, bid, nb)); GSYNC(); PB(1, layer_phase<5>(p, L, lds, bid, nb)); GSYNC(); \
    PB(8, layer_phase<6>(p, L, lds, bid, nb)); GSYNC(); PB(1, layer_phase<7>(p, L, lds, bid, nb)); GSYNC(); PB(1, layer_phase<8>(p, L, lds, bid, nb)); GSYNC(); \
    PB(8, layer_phase<9>(p, L, lds, bid, nb)); if (!(LAST)) GSYNC();
    LAYER(0, false)
    LAYER(1, true)
}
#if N_LAUNCH_MODE != 1
template <int PH> __global__ void __launch_bounds__(512, 2) one_phase(Params p, int l) {
    extern __shared__ __attribute__((aligned(16))) unsigned char lds_raw[];
    LAS unsigned char* lds = (LAS unsigned char*)lds_raw;
    if constexpr (PH == 100) phase_prologue(p, lds, blockIdx.x, gridDim.x);
    else if constexpr (PH == 101) phase_rowops(p, 0, 0, TT, blockIdx.x, gridDim.x);
    else layer_phase<PH>(p, l, lds, blockIdx.x, gridDim.x);
}
#endif

extern "C" void kernel_launch(void* const* d_in, const int* in_sizes, int n_in, void* d_out, int out_size, void* d_ws, size_t ws_size, hipStream_t stream) {
    if (n_in != 30 || ws_size < WS_NEED || out_size != TMAIN * DM) { fprintf(stderr, "kernel_launch: unexpected shapes (n_in %d, ws %zu, out %d)\n", n_in, ws_size, out_size); return; }
    Params p{};
    for (int i = 0; i < 30; ++i) p.in[i] = (const float*)d_in[i];
    p.out = (float*)d_out; p.ws = (unsigned char*)d_ws;
    static int grid_blocks = 0;
    if (!grid_blocks) {
        int dev = 0, cus = 0, per_cu = 0;
        (void)hipGetDevice(&dev);
        (void)hipDeviceGetAttribute(&cus, hipDeviceAttributeMultiprocessorCount, dev);
        (void)hipFuncSetAttribute((const void*)mega_fwd, hipFuncAttributeMaxDynamicSharedMemorySize, LDS_BYTES);
        (void)hipOccupancyMaxActiveBlocksPerMultiprocessor(&per_cu, mega_fwd, 512, LDS_BYTES);
        if (per_cu < 1) { fprintf(stderr, "kernel_launch: occupancy query says %d blocks/CU\n", per_cu); per_cu = 1; }
        grid_blocks = cus * 1;
        if (grid_blocks < 128) { fprintf(stderr, "kernel_launch: only %d CUs\n", grid_blocks); }
    }
#if N_LAUNCH_MODE == 1
    void* args[] = {&p};
    hipError_t e = hipLaunchCooperativeKernel((const void*)mega_fwd, dim3(grid_blocks), dim3(512), args, LDS_BYTES, stream);
    if (e != hipSuccess) fprintf(stderr, "cooperative launch failed: %s (grid %d)\n", hipGetErrorString(e), grid_blocks);
#else
#define LP(PH, L) do { (void)hipFuncSetAttribute((const void*)one_phase<PH>, hipFuncAttributeMaxDynamicSharedMemorySize, LDS_BYTES); one_phase<PH><<<grid_blocks, 512, LDS_BYTES, stream>>>(p, L); } while (0)
    LP(100, 0); LP(101, 0);
    for (int l = 0; l < 2; ++l) { LP(0, l); LP(1, l); LP(2, l); LP(3, l); LP(4, l); LP(5, l); LP(6, l); LP(7, l); LP(8, l); LP(9, l); }
#endif
}
```

```cpp
#include <hip/hip_runtime.h>
#include <hip/hip_cooperative_groups.h>
#include <cstdio>
#include <cstdint>
#include <cmath>
namespace cg = cooperative_groups;
__device__ __forceinline__ int get_tid() { int t = threadIdx.x; asm volatile("" : "+v"(t)); return t; }
namespace pg8 {
#define PG8_LAS __attribute__((address_space(3)))
typedef unsigned short bf16_t;
typedef short bf16x8 __attribute__((ext_vector_type(8)));
typedef float f32x4 __attribute__((ext_vector_type(4)));
typedef unsigned u32x4 __attribute__((ext_vector_type(4)));
typedef unsigned u32x2 __attribute__((ext_vector_type(2)));
constexpr int BM = 256, BK = 64, HALF = 128, HTB = HALF * BK * 2, STAGE_BYTES = 8 * HTB, NXCD = 8, WGM = 8;

__host__ __device__ __forceinline__ int lds_byte(int r, int c) { const int st = (r >> 4) * 2 + (c >> 5), rr = r & 15, cc = c & 31, ob = rr * 64 + cc * 2; return st * 1024 + (ob ^ (((ob >> 9) & 1) << 5)); }
__host__ __device__ __forceinline__ void stage_rc(int b, int& R, int& C) { const int st = b / 1024, sb = b % 1024, swz = sb ^ (((sb >> 9) & 1) << 5); R = (st >> 1) * 16 + swz / 64; C = (st & 1) * 32 + (swz % 64) / 2; }

struct Unit { int pm, pn; };
struct Gemm { const bf16_t* A; const bf16_t* Bt; int M, N, K, lda; };

struct StaticOrder {
    int nM, nN, nwg, G, c;
    __host__ __device__ void init(int M, int N, int G_, int c_) { nM = M / BM; nN = N / BM; nwg = nM * nN; G = G_; c = c_; }
    __host__ __device__ bool next(int i, Unit& u) const {
        const long L = (long)i * G + c; if (L >= nwg) return false;
        int wgid = (int)L; { const int q = nwg / NXCD, r = nwg % NXCD, xcd = wgid % NXCD, off = wgid / NXCD; wgid = (xcd < r ? xcd * (q + 1) : r * (q + 1) + (xcd - r) * q) + off; }
        const int nig = WGM * nN, gid = wgid / nig, fm = gid * WGM, gsz = (nM - fm) < WGM ? (nM - fm) : WGM;
        u.pm = fm + ((wgid % nig) % gsz); u.pn = (wgid % nig) / gsz; return true;
    }
};

template <class Epi>
__device__ __forceinline__ void gemm_phase(PG8_LAS unsigned char* lds, const Gemm g, const StaticOrder& S, const Epi& E) {
    const int tid = get_tid(), wid = __builtin_amdgcn_readfirstlane(tid >> 6), lane = tid & 63, wr = wid >> 2, wc = wid & 3, fr = lane & 15, fq = lane >> 4;
    const int K = g.K, nt = K / BK, lda = g.lda;
    unsigned voffA[2], voffB[2];
#pragma unroll
    for (int i = 0; i < 2; ++i) { int R, C; stage_rc(tid * 16 + i * 8192, R, C);
        voffA[i] = (unsigned)(R * lda + C) * 2u; voffB[i] = (unsigned)(R * K + C) * 2u; }
    const size_t kstep = (size_t)(BK * 2);
    const size_t hstepA = (size_t)HALF * lda * 2, hstepB = (size_t)HALF * K * 2;
    const size_t tstepA = 2 * hstepA, tstepB = 2 * hstepB;
    const unsigned ldsw = (unsigned)wid * 1024u;
    const int aoff = lds_byte(wr * 64 + fr, fq * 8), boff = lds_byte(wc * 32 + fr, fq * 8);
#define PG8_SA(b, h) (((b) * 2 + (h)) * HTB)
#define PG8_SB(b, h) ((4 + (b) * 2 + (h)) * HTB)
#define PG8_STAGE(bufoff, gbase, voff) do { _Pragma("unroll") for (int _i = 0; _i < 2; ++_i) \
        __builtin_amdgcn_global_load_lds((const unsigned*)((const char*)(gbase) + (voff)[_i]), (PG8_LAS unsigned*)(lds + (bufoff) + ldsw + _i * 8192), 16, 0, 0); } while (0)
#define PG8_LDA(dst, b, h) do { _Pragma("unroll") for (int m = 0; m < 4; ++m) _Pragma("unroll") for (int k = 0; k < 2; ++k) dst[m][k] = *(const PG8_LAS bf16x8*)(lds + PG8_SA(b, h) + aoff + m * 2048 + k * 1024); } while (0)
#define PG8_LDB(dst, b, h) do { _Pragma("unroll") for (int n = 0; n < 2; ++n) _Pragma("unroll") for (int k = 0; k < 2; ++k) dst[n][k] = *(const PG8_LAS bf16x8*)(lds + PG8_SB(b, h) + boff + n * 2048 + k * 1024); } while (0)
#define PG8_MMA(ai, bj, At, Bt) do { __builtin_amdgcn_s_setprio(1); _Pragma("unroll") for (int m = 0; m < 4; ++m) _Pragma("unroll") for (int n = 0; n < 2; ++n) _Pragma("unroll") for (int k = 0; k < 2; ++k) \
        acc[ai][bj][m][n] = __builtin_amdgcn_mfma_f32_16x16x32_bf16(Bt[n][k], At[m][k], acc[ai][bj][m][n], 0, 0, 0); __builtin_amdgcn_s_setprio(0); } while (0)
#define PG8_WAIT_V(n) asm volatile("s_waitcnt vmcnt(" #n ")" ::: "memory")
#define PG8_WAIT_L(n) asm volatile("s_waitcnt lgkmcnt(" #n ")" ::: "memory")
#define PG8_BAR __builtin_amdgcn_s_barrier()
#define PG8_SCHED __builtin_amdgcn_sched_barrier(0)
    Unit cur, nxt; int ui = 0;
    if (!S.next(0, cur)) return;
    f32x4 acc[2][2][4][2];
#pragma unroll
    for (int a = 0; a < 2; ++a)
#pragma unroll
        for (int b = 0; b < 2; ++b)
#pragma unroll
            for (int m = 0; m < 4; ++m)
#pragma unroll
                for (int n = 0; n < 2; ++n) acc[a][b][m][n] = (f32x4){0.f, 0.f, 0.f, 0.f};
    bf16x8 At[4][2], B0[2][2], B1[2][2];
    const char* cA = (const char*)g.A + (size_t)cur.pm * tstepA; const char* cB = (const char*)g.Bt + (size_t)cur.pn * tstepB;
    PG8_STAGE(PG8_SB(0, 0), cB, voffB); PG8_STAGE(PG8_SA(0, 0), cA, voffA); PG8_STAGE(PG8_SB(0, 1), cB + hstepB, voffB); PG8_STAGE(PG8_SA(0, 1), cA + hstepA, voffA);
    if (wr == 1) PG8_BAR;
    PG8_WAIT_V(4); PG8_BAR;
    PG8_STAGE(PG8_SB(1, 0), cB + kstep, voffB); PG8_STAGE(PG8_SA(1, 0), cA + kstep, voffA); PG8_STAGE(PG8_SB(1, 1), cB + hstepB + kstep, voffB);
    PG8_WAIT_V(6); PG8_BAR;
    for (;;) {
        const bool has_next = S.next(ui + 1, nxt);
        const char* nA = has_next ? (const char*)g.A + (size_t)nxt.pm * tstepA : cA; const char* nB = has_next ? (const char*)g.Bt + (size_t)nxt.pn * tstepB : cB;
        for (int t = 0; t < nt; t += 2) {
            const bool last = (t == nt - 2);
            const char* a1 = cA + (size_t)(t + 1) * kstep;
            const char* a2 = last ? nA : cA + (size_t)(t + 2) * kstep; const char* b2 = last ? nB : cB + (size_t)(t + 2) * kstep;
            const char* a3 = a2 + kstep; const char* b3 = b2 + kstep;
            PG8_LDB(B0, 0, 0); PG8_SCHED; PG8_LDA(At, 0, 0); PG8_STAGE(PG8_SA(1, 1), a1 + hstepA, voffA);
            PG8_WAIT_L(8); PG8_BAR; PG8_WAIT_L(0); PG8_MMA(0, 0, At, B0); PG8_BAR; PG8_SCHED;
            PG8_LDB(B1, 0, 1); PG8_STAGE(PG8_SB(0, 0), b2, voffB);
            PG8_BAR; PG8_WAIT_L(0); PG8_MMA(0, 1, At, B1); PG8_BAR;
            PG8_LDA(At, 0, 1); PG8_STAGE(PG8_SA(0, 0), a2, voffA);
            PG8_BAR; PG8_WAIT_L(0); PG8_MMA(1, 0, At, B0); PG8_BAR; PG8_SCHED;
            PG8_STAGE(PG8_SB(0, 1), b2 + hstepB, voffB);
            PG8_WAIT_V(6); PG8_BAR; PG8_MMA(1, 1, At, B1); PG8_BAR;
            PG8_LDB(B0, 1, 0); PG8_SCHED; PG8_LDA(At, 1, 0); PG8_STAGE(PG8_SA(0, 1), a2 + hstepA, voffA);
            PG8_WAIT_L(8); PG8_BAR; PG8_WAIT_L(0); PG8_MMA(0, 0, At, B0); PG8_BAR; PG8_SCHED;
            PG8_LDB(B1, 1, 1); PG8_STAGE(PG8_SB(1, 0), b3, voffB);
            PG8_BAR; PG8_WAIT_L(0); PG8_MMA(0, 1, At, B1); PG8_BAR;
            PG8_LDA(At, 1, 1); PG8_STAGE(PG8_SA(1, 0), a3, voffA);
            PG8_BAR; PG8_WAIT_L(0); PG8_MMA(1, 0, At, B0); PG8_BAR; PG8_SCHED;
            PG8_STAGE(PG8_SB(1, 1), b3 + hstepB, voffB);
            PG8_WAIT_V(6); PG8_BAR; PG8_MMA(1, 1, At, B1); PG8_BAR;
        }
        E(acc, cur, wr, wc, fr, fq);
        if (!has_next) break;
#pragma unroll
        for (int a = 0; a < 2; ++a)
#pragma unroll
            for (int b = 0; b < 2; ++b)
#pragma unroll
                for (int m = 0; m < 4; ++m)
#pragma unroll
                    for (int n = 0; n < 2; ++n) acc[a][b][m][n] = (f32x4){0.f, 0.f, 0.f, 0.f};
        cur = nxt; cA = nA; cB = nB; ++ui;
    }
    PG8_WAIT_V(0);
    if (wr == 0) PG8_BAR;
    PG8_BAR;
#undef PG8_SA
#undef PG8_SB
#undef PG8_STAGE
#undef PG8_LDA
#undef PG8_LDB
#undef PG8_MMA
#undef PG8_WAIT_V
#undef PG8_WAIT_L
#undef PG8_BAR
#undef PG8_SCHED
}

__device__ __forceinline__ unsigned f2bf_u(float f) { unsigned u = __builtin_bit_cast(unsigned, f); return (u + 0x7fffu + ((u >> 16) & 1u)) >> 16; }
template <int ACT> struct EpiBf16 {
    bf16_t* O; int ldc;
    __device__ __forceinline__ void operator()(const f32x4 (&acc)[2][2][4][2], const Unit& u, int wr, int wc, int fr, int fq) const {
        const int row0 = u.pm * BM + wr * 64 + fr, col0 = u.pn * BM + wc * 32 + 4 * fq;
#pragma unroll
        for (int ai = 0; ai < 2; ++ai)
#pragma unroll
            for (int m = 0; m < 4; ++m) { bf16_t* rowp = O + (size_t)(row0 + ai * HALF + m * 16) * ldc + col0;
#pragma unroll
                for (int bj = 0; bj < 2; ++bj)
#pragma unroll
                    for (int n = 0; n < 2; ++n) { f32x4 v = acc[ai][bj][m][n];
                        if (ACT == 1) { v.x = v.x > 0.f ? v.x * v.x : 0.f; v.y = v.y > 0.f ? v.y * v.y : 0.f; v.z = v.z > 0.f ? v.z * v.z : 0.f; v.w = v.w > 0.f ? v.w * v.w : 0.f; }
                        u32x2 o; o.x = f2bf_u(v.x) | (f2bf_u(v.y) << 16); o.y = f2bf_u(v.z) | (f2bf_u(v.w) << 16);
                        *(u32x2*)(rowp + bj * HALF + n * 16) = o; } }
    }
};
}
typedef unsigned short bf16_t;
typedef short bf16x8 __attribute__((ext_vector_type(8)));
typedef float f32x4 __attribute__((ext_vector_type(4)));
typedef unsigned u32x4 __attribute__((ext_vector_type(4)));
typedef unsigned u32x2 __attribute__((ext_vector_type(2)));
#define LAS __attribute__((address_space(3)))

constexpr int NBATCH = 8, SEQL = 4096, DM = 1024, CTXL = 256, TMAIN = 32768, TCTX = 2048, TT = 34816, NP = 3072, FF = 4096;
constexpr int PC_SWAQ = 0, PC_RETQ = 256, PC_RWR = 512, PC_MLAQD = 768, PC_SWAK = 1024, PC_SWAV = 1152, PC_RETK = 1280, PC_RETV = 1536, PC_RETG = 1792,
              PC_RWK = 2048, PC_RWV = 2304, PC_RWWD = 2560, PC_RWAD = 2624, PC_RWGD = 2688, PC_MLAKVD = 2816, PC_MLAKPE = 2944;
constexpr int PC_RWO0 = PC_RWV, PC_RWO1 = PC_RWR;
constexpr int NKEYS = CTXL + SEQL;

constexpr size_t MiB = 1u << 20;
constexpr size_t WS_MOD = 0;
constexpr size_t WS_TAB = 512 * 1024;
constexpr size_t WS_CTR = 768 * 1024;
constexpr size_t WS_BON = 1 * MiB;
constexpr size_t WS_WB = 2 * MiB;
constexpr size_t WB_LAYER = 24 * MiB, WB_IN = 0, WB_OUT = 6 * MiB, WB_W1 = 8 * MiB, WB_W2 = 16 * MiB;
constexpr size_t WS_XC = 50 * MiB;
constexpr size_t WS_P = 58 * MiB;
constexpr size_t WS_HID = 58 * MiB;
constexpr size_t WS_A = 262 * MiB;
constexpr size_t ARR17 = 17 * MiB;
constexpr size_t WS_RWK = WS_A, WS_RWV = WS_A + ARR17, WS_RWRR = WS_A + 2 * ARR17, WS_RWA0 = WS_A + 3 * ARR17, WS_RWA1 = WS_A + 4 * ARR17,
                 WS_RWM0 = WS_A + 5 * ARR17, WS_RWM1 = WS_A + 6 * ARR17;
constexpr size_t WS_RET = WS_A + 119 * MiB;
constexpr size_t WS_MQ = WS_RET + 34 * MiB;
constexpr size_t WS_KM = WS_MQ + 26738688;
constexpr size_t WS_VTM = WS_KM + 26738688;
constexpr size_t WS_KS = WS_VTM + ARR17;
constexpr size_t WS_VTS = WS_KS + 8912896;
constexpr size_t WS_A_END = WS_VTS + 8912896;
constexpr size_t WS_Z = 330 * MiB;
constexpr size_t WS_HB = 398 * MiB;
constexpr size_t WS_MLAW = 500 * MiB;
constexpr size_t MLAW_LAYER = 384 * 256 * 2 + 512 * 128 * 2, MLAW_KV = 384 * 256 * 2;
constexpr size_t WS_NEED = 501 * MiB;
static_assert(WS_A_END <= WS_NEED && WS_HB + 68 * MiB <= WS_NEED && WS_HID + 272 * MiB <= WS_Z, "ws map");

constexpr int LDS_BYTES = 150 * 1024;

struct Params { const float* in[30]; float* out; unsigned char* ws; };

__device__ __forceinline__ float bf2f(bf16_t v) { return __builtin_bit_cast(float, (unsigned)v << 16); }
__device__ __forceinline__ bf16_t f2bf(float f) { unsigned u = __builtin_bit_cast(unsigned, f); return (bf16_t)((u + 0x7fffu + ((u >> 16) & 1u)) >> 16); }
__device__ __forceinline__ unsigned pk2(float lo, float hi) { return (unsigned)f2bf(lo) | ((unsigned)f2bf(hi) << 16); }
typedef float f32x2 __attribute__((ext_vector_type(2)));
template <int CTRL> __device__ __forceinline__ float dppf(float v) { return __builtin_bit_cast(float, __builtin_amdgcn_update_dpp(0, __builtin_bit_cast(int, v), CTRL, 0xF, 0xF, true)); }
__device__ __forceinline__ float red4(float v) { v += dppf<0xB1>(v); v += dppf<0x4E>(v); return v; }
__device__ __forceinline__ float red8(float v) { v = red4(v); v += dppf<0x141>(v); return v; }
__device__ __forceinline__ float red16(float v) { v = red8(v); v += dppf<0x140>(v); return v; }
__device__ __forceinline__ float max16(float v) { v = fmaxf(v, dppf<0xB1>(v)); v = fmaxf(v, dppf<0x4E>(v)); v = fmaxf(v, dppf<0x141>(v)); v = fmaxf(v, dppf<0x140>(v)); return v; }
__device__ __forceinline__ float wave_sum(float v) {
    v = red16(v);
    const int u = __builtin_bit_cast(int, v);
    return __builtin_bit_cast(float, __builtin_amdgcn_readlane(u, 0)) + __builtin_bit_cast(float, __builtin_amdgcn_readlane(u, 16)) +
           __builtin_bit_cast(float, __builtin_amdgcn_readlane(u, 32)) + __builtin_bit_cast(float, __builtin_amdgcn_readlane(u, 48));
}
__device__ __forceinline__ void unpack8(const u32x4 u, float* f) {
    f[0] = bf2f((bf16_t)(u.x & 0xffff)); f[1] = bf2f((bf16_t)(u.x >> 16)); f[2] = bf2f((bf16_t)(u.y & 0xffff)); f[3] = bf2f((bf16_t)(u.y >> 16));
    f[4] = bf2f((bf16_t)(u.z & 0xffff)); f[5] = bf2f((bf16_t)(u.z >> 16)); f[6] = bf2f((bf16_t)(u.w & 0xffff)); f[7] = bf2f((bf16_t)(u.w >> 16));
}
__device__ __forceinline__ float sigmoidf_(float x) { return 1.f / (1.f + __expf(-x)); }

struct SeqInfo { int b, pos, len, start, isctx; };
__device__ __forceinline__ SeqInfo seq_of_row(int row) {
    SeqInfo s;
    if (row < TMAIN) { s.b = row >> 12; s.pos = row & 4095; s.len = SEQL; s.start = s.b << 12; s.isctx = 0; }
    else { const int r = row - TMAIN; s.b = r >> 8; s.pos = r & 255; s.len = CTXL; s.start = TMAIN + (s.b << 8); s.isctx = 1; }
    return s;
}

__device__ __forceinline__ void transpose_item(const float* W, int N, int nsrc0, bf16_t* WT, int K, int ndst0, int k0, LAS float* scr, int lane) {
    if (nsrc0 >= 0) {
#pragma unroll 32
        for (int i = 0; i < 32; ++i) { const int kk = 2 * i + (lane >> 5); scr[kk * 33 + (lane & 31)] = W[(size_t)(k0 + kk) * N + nsrc0 + (lane & 31)]; }
    } else {
#pragma unroll 8
        for (int i = 0; i < 32; ++i) { const int kk = 2 * i + (lane >> 5); scr[kk * 33 + (lane & 31)] = 0.f; }
    }
    __builtin_amdgcn_wave_barrier(); asm volatile("s_waitcnt lgkmcnt(0)" ::: "memory");
    const int c = lane & 7;
#pragma unroll
    for (int j = 0; j < 4; ++j) { const int n = (lane >> 3) + 8 * j; const LAS float* s = scr + (8 * c) * 33 + n;
        u32x4 o; o.x = pk2(s[0 * 33], s[1 * 33]); o.y = pk2(s[2 * 33], s[3 * 33]); o.z = pk2(s[4 * 33], s[5 * 33]); o.w = pk2(s[6 * 33], s[7 * 33]);
        *(u32x4*)(WT + (size_t)(ndst0 + n) * K + k0 + 8 * c) = o; }
    __builtin_amdgcn_wave_barrier(); asm volatile("s_waitcnt lgkmcnt(0)" ::: "memory");
}
__device__ __forceinline__ int win_src_col(int n) {
    if (n < 256) return n;
    if (n < 512) return 512 + (n - 256);
    if (n < 768) return 1536 + (n - 512);
    if (n < 1024) return 2560 + (n - 768);
    if (n < 1280) return 256 + (n - 1024);
    if (n < 2048) return 768 + (n - 1280);
    if (n < 2816) return 1792 + (n - 2048);
    if (n < 2976) return n;
    return -1;
}
__device__ __forceinline__ void phase_prologue(const Params& p, LAS unsigned char* lds, int bid, int nb) {
    const int tid = get_tid(), lane = tid & 63, wave = tid >> 6;
    LAS float* scr = (LAS float*)(lds + wave * 16384);
    const int gw = bid * 8 + wave, NGW = nb * 8;
    constexpr int I_IN = 16 * 96, I_OUT = 16 * 32, I_1 = 16 * 128, I_2 = 64 * 32, I_Q = 4 * 12, I_KV = 2 * 16, I_L = I_IN + I_OUT + I_1 + I_2 + I_Q + I_KV;
    for (int it = gw; it < 2 * I_L; it += NGW) {
        const int l = it / I_L; int r = it % I_L;
        unsigned char* wb = p.ws + WS_WB + (size_t)l * WB_LAYER;
        if (r < I_IN) { const int kb = r / 96, nbk = r % 96; transpose_item(p.in[10] + (size_t)l * DM * 2976, 2976, win_src_col(nbk * 32), (bf16_t*)(wb + WB_IN), DM, nbk * 32, kb * 64, scr, lane); continue; } r -= I_IN;
        if (r < I_OUT) { const int kb = r / 32, nbk = r % 32; transpose_item(p.in[11] + (size_t)l * DM * DM, DM, nbk * 32, (bf16_t*)(wb + WB_OUT), DM, nbk * 32, kb * 64, scr, lane); continue; } r -= I_OUT;
        if (r < I_1) { const int kb = r / 128, nbk = r % 128; transpose_item(p.in[28] + (size_t)l * DM * FF, FF, nbk * 32, (bf16_t*)(wb + WB_W1), DM, nbk * 32, kb * 64, scr, lane); continue; } r -= I_1;
        if (r < I_2) { const int kb = r / 32, nbk = r % 32; transpose_item(p.in[29] + (size_t)l * FF * DM, DM, nbk * 32, (bf16_t*)(wb + WB_W2), FF, nbk * 32, kb * 64, scr, lane); continue; } r -= I_2;
        unsigned char* mw = p.ws + WS_MLAW + (size_t)l * MLAW_LAYER;
        if (r < I_Q) { const int kb = r / 12, nbk = r % 12; transpose_item(p.in[25] + (size_t)l * 256 * 384, 384, nbk * 32, (bf16_t*)mw, 256, nbk * 32, kb * 64, scr, lane); continue; } r -= I_Q;
        { const int kb = r / 16, nbk = r % 16; transpose_item(p.in[27] + (size_t)l * 128 * 512, 512, nbk * 32, (bf16_t*)(mw + MLAW_KV), 128, nbk * 32, kb * 64, scr, lane); }
    }
    __syncthreads();
    for (int it = bid; it < 192; it += nb) {
        const int l = it / 96, cb = it % 96;
        LAS float* sc = (LAS float*)lds;
        LAS float* red = sc + 9 * 1024;
        for (int e = tid; e < 9 * 1024; e += 512) { const int r = e >> 10, k = e & 1023; const float v = (r < 8) ? p.in[1][r * 1024 + k] : p.in[3][k]; sc[e] = v / (1.f + __expf(-v)); }
        __syncthreads();
        const int ks = tid >> 6, cl = tid & 63, n = cb * 64 + cl;
        float acc[9];
#pragma unroll
        for (int r = 0; r < 9; ++r) acc[r] = 0.f;
        const float* aw = p.in[4] + (size_t)l * DM * 6144;
#pragma unroll 16
        for (int k = ks * 128; k < ks * 128 + 128; ++k) { const float w = aw[(size_t)k * 6144 + n];
#pragma unroll
            for (int r = 0; r < 9; ++r) acc[r] += sc[r * 1024 + k] * w; }
#pragma unroll
        for (int r = 0; r < 9; ++r) red[(ks * 9 + r) * 64 + cl] = acc[r];
        __syncthreads();
        for (int e = tid; e < 9 * 64; e += 512) { const int r = e >> 6, c2 = e & 63; float s = 0.f;
            for (int q = 0; q < 8; ++q) s += red[(q * 9 + r) * 64 + c2];
            ((float*)(p.ws + WS_MOD))[((size_t)l * 9 + r) * 6144 + cb * 64 + c2] = s + p.in[5][(size_t)l * 6144 + cb * 64 + c2]; }
        __syncthreads();
    }
    if (bid == 0 && tid < 4) ((unsigned*)(p.ws + WS_CTR))[tid] = 0u;
    if (bid == nb - 1) {
        float* tab = (float*)(p.ws + WS_TAB);
        for (int e = tid; e < 64 * 16; e += 512) { const int pos = e >> 4, f = e & 15; const float inv = powf(10000.f, -(float)(2 * f) / 32.f); const float a = (float)pos * inv; tab[e] = cosf(a); tab[1024 + e] = sinf(a); }
        for (int e = tid; e < 64 * 8; e += 512) { const int pos = e >> 3, f = e & 7; const float inv = powf(10000.f, -(float)(2 * f) / 16.f); const float a = (float)pos * inv; tab[2048 + e] = cosf(a); tab[2560 + e] = sinf(a); }
    }
}

struct RowJob { const float* xsrc; const bf16_t* z; const float* gpost; const float* gate; float* xdst; const float* gpre; const float* shift; const float* scale; bf16_t* hdst; };
__device__ __forceinline__ RowJob make_rowjob(const Params& p, int mode, int l, int row) {
    const float* mod = (const float*)(p.ws + WS_MOD);
    bf16_t* HB = (bf16_t*)(p.ws + WS_HB); const bf16_t* Z = (const bf16_t*)(p.ws + WS_Z);
    float* XC = (float*)(p.ws + WS_XC);
    const SeqInfo s = seq_of_row(row);
    const int mr = s.isctx ? 8 : s.b;
    const float* m_l = mod + ((size_t)l * 9 + mr) * 6144;
    float* xs = s.isctx ? XC + (size_t)(row - TMAIN) * DM : p.out + (size_t)row * DM;
    const float* xin = s.isctx ? p.in[2] + (size_t)(row - TMAIN) * DM : p.in[0] + (size_t)row * DM;
    RowJob j;
    if (mode == 0) { j = RowJob{xin, nullptr, nullptr, nullptr, nullptr, p.in[6] + l * DM, m_l + 0, m_l + 1024, HB + (size_t)row * DM}; }
    else if (mode == 1) { j = RowJob{l == 0 ? xin : xs, Z + (size_t)row * DM, p.in[7] + l * DM, m_l + 2048, xs, p.in[8] + l * DM, m_l + 3072, m_l + 4096, HB + (size_t)row * DM}; }
    else { const bool has_next = (l + 1 < 2); const float* m_n = mod + ((size_t)(has_next ? l + 1 : l) * 9 + mr) * 6144;
        j = RowJob{xs, Z + (size_t)row * DM, p.in[9] + l * DM, m_l + 5120, xs, p.in[6] + (has_next ? l + 1 : l) * DM, m_n + 0, m_n + 1024, has_next ? HB + (size_t)row * DM : nullptr}; }
    return j;
}
template <int RB>
__device__ __forceinline__ void rowop_batch(const RowJob (&jb)[RB], const bool (&valid)[RB], int lane) {
    f32x4 v[RB][4]; u32x2 zu[RB][4];
#pragma unroll
    for (int r = 0; r < RB; ++r) if (valid[r]) {
#pragma unroll
        for (int j = 0; j < 4; ++j) { v[r][j] = *(const f32x4*)(jb[r].xsrc + (j * 64 + lane) * 4); if (jb[r].z) zu[r][j] = *(const u32x2*)(jb[r].z + (j * 64 + lane) * 4); }
    }
#pragma unroll
    for (int r = 0; r < RB; ++r) if (valid[r]) {
        const RowJob& J = jb[r];
        if (J.z) {
            f32x4 zz[4], gp[4], gt[4]; float ss = 0.f;
#pragma unroll
            for (int j = 0; j < 4; ++j) { const int c = (j * 64 + lane) * 4; gp[j] = *(const f32x4*)(J.gpost + c); gt[j] = *(const f32x4*)(J.gate + c); }
#pragma unroll
            for (int j = 0; j < 4; ++j) { const u32x2 u = zu[r][j];
                zz[j].x = bf2f((bf16_t)(u.x & 0xffff)); zz[j].y = bf2f((bf16_t)(u.x >> 16)); zz[j].z = bf2f((bf16_t)(u.y & 0xffff)); zz[j].w = bf2f((bf16_t)(u.y >> 16));
                ss += zz[j].x * zz[j].x + zz[j].y * zz[j].y + zz[j].z * zz[j].z + zz[j].w * zz[j].w; }
            const float rinv = 1.f / sqrtf(wave_sum(ss) * (1.f / 1024.f) + 1e-6f);
#pragma unroll
            for (int j = 0; j < 4; ++j) { const int c = (j * 64 + lane) * 4;
                v[r][j].x += gt[j].x * (zz[j].x * rinv * gp[j].x); v[r][j].y += gt[j].y * (zz[j].y * rinv * gp[j].y); v[r][j].z += gt[j].z * (zz[j].z * rinv * gp[j].z); v[r][j].w += gt[j].w * (zz[j].w * rinv * gp[j].w);
                *(f32x4*)(J.xdst + c) = v[r][j]; }
        }
        if (J.hdst) {
            f32x4 g[4], sh[4], sc[4]; float ss = 0.f;
#pragma unroll
            for (int j = 0; j < 4; ++j) { const int c = (j * 64 + lane) * 4; g[j] = *(const f32x4*)(J.gpre + c); sh[j] = *(const f32x4*)(J.shift + c); sc[j] = *(const f32x4*)(J.scale + c); }
#pragma unroll
            for (int j = 0; j < 4; ++j) ss += v[r][j].x * v[r][j].x + v[r][j].y * v[r][j].y + v[r][j].z * v[r][j].z + v[r][j].w * v[r][j].w;
            const float rinv = 1.f / sqrtf(wave_sum(ss) * (1.f / 1024.f) + 1e-6f);
#pragma unroll
            for (int j = 0; j < 4; ++j) { const int c = (j * 64 + lane) * 4;
                u32x2 o; o.x = pk2(v[r][j].x * rinv * g[j].x * (1.f + sc[j].x) + sh[j].x, v[r][j].y * rinv * g[j].y * (1.f + sc[j].y) + sh[j].y);
                o.y = pk2(v[r][j].z * rinv * g[j].z * (1.f + sc[j].z) + sh[j].z, v[r][j].w * rinv * g[j].w * (1.f + sc[j].w) + sh[j].w);
                *(u32x2*)(J.hdst + c) = o; }
        }
    }
}
__device__ __forceinline__ void phase_rowops(const Params& p, int mode, int l, int nrows, int bid, int nb) {
    const int tid = get_tid(), lane = tid & 63, wave = tid >> 6;
    constexpr int RB = 4;
    const int nwaves = nb * 8, gw = bid * 8 + wave;
    for (int base = gw; base < nrows; base += nwaves * RB) {
        RowJob jb[RB]; bool valid[RB];
#pragma unroll
        for (int r = 0; r < RB; ++r) { const int row = base + r * nwaves; valid[r] = row < nrows; jb[r] = make_rowjob(p, mode, l, valid[r] ? row : 0); }
        rowop_batch<RB>(jb, valid, lane);
    }
}

__device__ __forceinline__ void rwkv_prep_item(const Params& p, int l, LAS unsigned char* lds, int tile) {
    const int tid = get_tid();
    const bf16_t* P = (const bf16_t*)(p.ws + WS_P);
    const int t0 = tile * 32; const SeqInfo s0 = seq_of_row(t0);
    const float* mu = p.in[14] + l * 1024;
    LAS float* r_s = (LAS float*)lds;
    LAS float* k_s = r_s + 32 * 256;
    LAS float* v_s = k_s + 32 * 256;
    LAS float* twd = v_s + 32 * 256;
    LAS float* ad_s = twd + 32 * 64;
#pragma unroll
    for (int it = 0; it < 7; ++it) {
        const int pc = tid + it * 512; const int tok = pc / 112, c8 = pc % 112, cc = c8 * 8;
        const int pcol = cc < 256 ? PC_RWR + cc : PC_RWK + (cc - 256);
        const int row = t0 + tok, pos = s0.pos + tok;
        const u32x4 u0 = *(const u32x4*)(P + (size_t)row * NP + pcol);
        const u32x4 um = pos > 0 ? *(const u32x4*)(P + (size_t)(row - 1) * NP + pcol) : (u32x4){0u, 0u, 0u, 0u};
        const u32x4 up = pos < s0.len - 1 ? *(const u32x4*)(P + (size_t)(row + 1) * NP + pcol) : (u32x4){0u, 0u, 0u, 0u};
        const f32x4 mu0 = *(const f32x4*)(mu + cc), mu1 = *(const f32x4*)(mu + cc + 4);
        float z0[8], zm[8], zp[8], zs[8]; unpack8(u0, z0); unpack8(um, zm); unpack8(up, zp);
        const float mm[8] = {mu0.x, mu0.y, mu0.z, mu0.w, mu1.x, mu1.y, mu1.z, mu1.w};
#pragma unroll
        for (int x = 0; x < 8; ++x) zs[x] = z0[x] + mm[x] * (0.5f * (zm[x] + zp[x]) - z0[x]);
        LAS float* dst;
        if (cc < 256) dst = r_s + tok * 256 + cc;
        else if (cc < 512) dst = k_s + tok * 256 + cc - 256;
        else if (cc < 768) dst = v_s + tok * 256 + cc - 512;
        else if (cc < 832) { dst = twd + tok * 64 + cc - 768;
#pragma unroll
            for (int x = 0; x < 8; ++x) zs[x] = 1.f - 2.f / (1.f + __expf(2.f * zs[x])); }
        else dst = ad_s + tok * 64 + cc - 832;
        *(LAS f32x4*)dst = (f32x4){zs[0], zs[1], zs[2], zs[3]}; *(LAS f32x4*)(dst + 4) = (f32x4){zs[4], zs[5], zs[6], zs[7]};
    }
    __syncthreads();
    const int hh = tid >> 8, c = tid & 255, h = c >> 6;
    float aw0[16], aw1[16], aa0[16], aa1[16];
#pragma unroll
    for (int i = 0; i < 16; ++i) { aw0[i] = 0.f; aw1[i] = 0.f; aa0[i] = 0.f; aa1[i] = 0.f; }
    const float* wup = p.in[16] + (size_t)l * 2 * 64 * 256; const float* aup = p.in[18] + (size_t)l * 2 * 64 * 256;
#pragma unroll 4
    for (int j = 0; j < 64; ++j) {
        const float w0 = wup[j * 256 + c], w1 = wup[64 * 256 + j * 256 + c], a0 = aup[j * 256 + c], a1 = aup[64 * 256 + j * 256 + c];
#pragma unroll
        for (int i = 0; i < 16; ++i) { const float tw = twd[(hh * 16 + i) * 64 + j], ta = ad_s[(hh * 16 + i) * 64 + j];
            aw0[i] += tw * w0; aw1[i] += tw * w1; aa0[i] += ta * a0; aa1[i] += ta * a1; }
    }
    const float w0b0 = p.in[15][(l * 2 + 0) * 256 + c], w0b1 = p.in[15][(l * 2 + 1) * 256 + c];
    const float a0b0 = p.in[17][(l * 2 + 0) * 256 + c], a0b1 = p.in[17][(l * 2 + 1) * 256 + c];
    const float ka = p.in[21][l * 256 + c], rk = p.in[22][l * 256 + c];
    bf16_t* RK = (bf16_t*)(p.ws + WS_RWK); bf16_t* RV = (bf16_t*)(p.ws + WS_RWV); bf16_t* RR = (bf16_t*)(p.ws + WS_RWRR);
    bf16_t* RA0 = (bf16_t*)(p.ws + WS_RWA0); bf16_t* RA1 = (bf16_t*)(p.ws + WS_RWA1); bf16_t* RM0 = (bf16_t*)(p.ws + WS_RWM0); bf16_t* RM1 = (bf16_t*)(p.ws + WS_RWM1);
    float* BON = (float*)(p.ws + WS_BON);
#pragma unroll
    for (int i = 0; i < 16; ++i) {
        const int tok = hh * 16 + i, row = t0 + tok;
        const float k = k_s[tok * 256 + c], v = v_s[tok * 256 + c], r = r_s[tok * 256 + c];
        const float sg0 = sigmoidf_(w0b0 + aw0[i]), sg1 = sigmoidf_(w0b1 + aw1[i]);
        const float om0 = 1.f - __expf(-0.60653066f * sg0), om1 = 1.f - __expf(-0.60653066f * sg1);
        const float a0 = sigmoidf_(a0b0 + aa0[i]), a1 = sigmoidf_(a0b1 + aa1[i]);
        const float kt0 = k * (1.f + (a0 - 1.f) * ka), kt1 = k * (1.f + (a1 - 1.f) * ka);
        const float bs = wave_sum(r * (kt0 + kt1) * rk);
        const size_t o = (size_t)row * 256 + c;
        RK[o] = f2bf(k); RV[o] = f2bf(v); RR[o] = f2bf(r); RA0[o] = f2bf(a0); RA1[o] = f2bf(a1); RM0[o] = f2bf(om0); RM1[o] = f2bf(om1);
        if ((tid & 63) == 0) BON[(size_t)row * 4 + h] = bs;
    }
    __syncthreads();
}
__device__ __forceinline__ int ret_chunk_index(int cr, int& b) { if (cr < 256) { b = cr >> 5; return 2 + (cr & 31); } b = (cr - 256) >> 1; return (cr - 256) & 1; }
__device__ __forceinline__ void ret_kv_item(const Params& p, LAS unsigned char* lds, int item) {
    const int tid = get_tid();
    const bf16_t* P = (const bf16_t*)(p.ws + WS_P);
    const int cr = item >> 2, h = item & 3; int b; const int ci = ret_chunk_index(cr, b);
    const int r0 = cr * 128;
    LAS float* Ks = (LAS float*)lds;
    LAS float* Vs = Ks + 128 * 64;
    LAS float* dec = Vs + 128 * 64;
    const float lg = log1pf(-exp2f(-5.f - (float)h));
    for (int e = tid; e < 128 * 64; e += 512) { const int j = e >> 6, d = e & 63;
        Ks[e] = bf2f(P[(size_t)(r0 + j) * NP + PC_RETK + h * 64 + d]) * 0.125f; Vs[e] = bf2f(P[(size_t)(r0 + j) * NP + PC_RETV + h * 64 + d]); }
    if (tid < 128) dec[tid] = expf((float)tid * lg);
    __syncthreads();
    const int d = tid >> 3, e0 = (tid & 7) * 8;
    float af[8], ab[8];
#pragma unroll
    for (int i = 0; i < 8; ++i) { af[i] = 0.f; ab[i] = 0.f; }
    for (int j = 0; j < 128; ++j) { const float kd = Ks[j * 64 + d]; const float kf = kd * dec[127 - j], kb = kd * dec[j];
        const f32x4 v0 = *(const LAS f32x4*)(Vs + j * 64 + e0), v1 = *(const LAS f32x4*)(Vs + j * 64 + e0 + 4);
        af[0] += kf * v0.x; af[1] += kf * v0.y; af[2] += kf * v0.z; af[3] += kf * v0.w; af[4] += kf * v1.x; af[5] += kf * v1.y; af[6] += kf * v1.z; af[7] += kf * v1.w;
        ab[0] += kb * v0.x; ab[1] += kb * v0.y; ab[2] += kb * v0.z; ab[3] += kb * v0.w; ab[4] += kb * v1.x; ab[5] += kb * v1.y; ab[6] += kb * v1.z; ab[7] += kb * v1.w; }
    float* RS = (float*)(p.ws + WS_RET) + ((size_t)((b * 4 + h) * 34 + ci) * 2) * 4096;
#pragma unroll
    for (int i = 0; i < 8; ++i) { RS[d * 64 + e0 + i] = af[i]; RS[4096 + d * 64 + e0 + i] = ab[i]; }
    __syncthreads();
}
__device__ __forceinline__ void swa_prep_item(const Params& p, LAS unsigned char* lds, int tile) {
    const int tid = get_tid();
    bf16_t* P = (bf16_t*)(p.ws + WS_P);
    const float* tabc = (const float*)(p.ws + WS_TAB); const float* tabs = tabc + 1024;
    bf16_t* KS = (bf16_t*)(p.ws + WS_KS); bf16_t* VT = (bf16_t*)(p.ws + WS_VTS);
    const int t0 = tile * 64; const SeqInfo s0 = seq_of_row(t0);
    const int key0 = s0.isctx ? s0.pos : CTXL + s0.pos;
    LAS bf16_t* Vs = (LAS bf16_t*)lds;
    u32x4 vreg[2];
#pragma unroll
    for (int it = 0; it < 2; ++it) { const int pc = tid + it * 512, tok = pc >> 4, c8 = pc & 15; vreg[it] = *(const u32x4*)(P + (size_t)(t0 + tok) * NP + PC_SWAV + c8 * 8); }
    u32x4 x1[3], x2[3];
#pragma unroll
    for (int it = 0; it < 3; ++it) { const int e = tid + it * 512; const int tok = e / 24, rem = e % 24, hd = rem >> 2, axis = (rem >> 1) & 1, fg = rem & 1;
        const int colbase = (hd < 4 ? PC_SWAQ + hd * 64 : PC_SWAK + (hd - 4) * 64) + axis * 32 + fg * 8;
        x1[it] = *(const u32x4*)(P + (size_t)(t0 + tok) * NP + colbase); x2[it] = *(const u32x4*)(P + (size_t)(t0 + tok) * NP + colbase + 16); }
#pragma unroll
    for (int it = 0; it < 2; ++it) { const int pc = tid + it * 512, tok = pc >> 4, c8 = pc & 15; *(LAS u32x4*)(Vs + tok * 136 + c8 * 8) = vreg[it]; }
#pragma unroll
    for (int it = 0; it < 3; ++it) { const int e = tid + it * 512; const int tok = e / 24, rem = e % 24, hd = rem >> 2, axis = (rem >> 1) & 1, fg = rem & 1;
        const int row = t0 + tok, pos = s0.pos + tok;
        const int colbase = (hd < 4 ? PC_SWAQ + hd * 64 : PC_SWAK + (hd - 4) * 64) + axis * 32 + fg * 8;
        float a[8], bb[8]; unpack8(x1[it], a); unpack8(x2[it], bb);
        if (!s0.isctx) { const int pp = axis == 0 ? (pos >> 6) : (pos & 63);
            const f32x4 c0 = *(const f32x4*)(tabc + pp * 16 + fg * 8), c1 = *(const f32x4*)(tabc + pp * 16 + fg * 8 + 4), s0v = *(const f32x4*)(tabs + pp * 16 + fg * 8), s1v = *(const f32x4*)(tabs + pp * 16 + fg * 8 + 4);
            const float cs[8] = {c0.x, c0.y, c0.z, c0.w, c1.x, c1.y, c1.z, c1.w}, sn[8] = {s0v.x, s0v.y, s0v.z, s0v.w, s1v.x, s1v.y, s1v.z, s1v.w};
#pragma unroll
            for (int x = 0; x < 8; ++x) { const float y1 = a[x] * cs[x] - bb[x] * sn[x], y2 = bb[x] * cs[x] + a[x] * sn[x]; a[x] = y1; bb[x] = y2; } }
        u32x4 o1, o2; o1.x = pk2(a[0], a[1]); o1.y = pk2(a[2], a[3]); o1.z = pk2(a[4], a[5]); o1.w = pk2(a[6], a[7]);
        o2.x = pk2(bb[0], bb[1]); o2.y = pk2(bb[2], bb[3]); o2.z = pk2(bb[4], bb[5]); o2.w = pk2(bb[6], bb[7]);
        if (hd < 4) { if (!s0.isctx) { *(u32x4*)(P + (size_t)row * NP + colbase) = o1; *(u32x4*)(P + (size_t)row * NP + colbase + 16) = o2; } }
        else { bf16_t* kd = KS + ((size_t)(s0.b * 2 + (hd - 4)) * NKEYS + key0 + tok) * 64 + axis * 32 + fg * 8; *(u32x4*)kd = o1; *(u32x4*)(kd + 16) = o2; }
    }
    __syncthreads();
#pragma unroll
    for (int it = 0; it < 2; ++it) { const int pc = tid + it * 512, hd = pc >> 3, k8 = pc & 7, hk = hd >> 6, d = hd & 63;
        unsigned w[4];
#pragma unroll
        for (int x = 0; x < 4; ++x) w[x] = (unsigned)Vs[(k8 * 8 + 2 * x) * 136 + hd] | ((unsigned)Vs[(k8 * 8 + 2 * x + 1) * 136 + hd] << 16);
        *(u32x4*)(VT + ((size_t)(s0.b * 2 + hk) * 64 + d) * NKEYS + key0 + k8 * 8) = (u32x4){w[0], w[1], w[2], w[3]}; }
    __syncthreads();
}
__device__ __forceinline__ void phase_prepA(const Params& p, int l, LAS unsigned char* lds, int bid, int nb) {
    constexpr int N1 = TT / 32, N2 = 272 * 4, N3 = TT / 64;
    for (int it = bid; it < N1 + N2 + N3; it += nb) {
        if (it < N1) rwkv_prep_item(p, l, lds, it);
        else if (it < N1 + N2) ret_kv_item(p, lds, it - N1);
        else swa_prep_item(p, lds, it - N1 - N2);
    }
}

__device__ __forceinline__ void mla_proj_item(const Params& p, int l, LAS unsigned char* lds, int tile) {
    const int tid = get_tid(), lane = tid & 63, wave = tid >> 6, fr = lane & 15, fq = lane >> 4;
    const bf16_t* P = (const bf16_t*)(p.ws + WS_P);
    const float* tabc = (const float*)(p.ws + WS_TAB) + 2048; const float* tabs = tabc + 512;
    const int t0 = tile * 32; const SeqInfo s0 = seq_of_row(t0);
    const int key0 = s0.isctx ? s0.pos : CTXL + s0.pos;
    LAS unsigned char* qn = lds;
    LAS unsigned char* kvn = lds + 32 * 528;
    LAS float* qo = (LAS float*)(lds + 32 * 528 + 32 * 272);
    LAS float* kvo = qo + 32 * 384;
    const float* qg = p.in[24] + l * 256; const float* kvg = p.in[26] + l * 128;
    for (int i = 0; i < 4; ++i) { const int tok = wave * 4 + i, row = t0 + tok;
        float x[4]; float ss = 0.f;
#pragma unroll
        for (int j = 0; j < 4; ++j) { x[j] = bf2f(P[(size_t)row * NP + PC_MLAQD + j * 64 + lane]); ss += x[j] * x[j]; }
        const float rq = 1.f / sqrtf(wave_sum(ss) * (1.f / 256.f) + 1e-6f);
#pragma unroll
        for (int j = 0; j < 4; ++j) *(LAS bf16_t*)(qn + tok * 528 + (j * 64 + lane) * 2) = f2bf(x[j] * rq * qg[j * 64 + lane]);
        float y[2]; float s2 = 0.f;
#pragma unroll
        for (int j = 0; j < 2; ++j) { y[j] = bf2f(P[(size_t)row * NP + PC_MLAKVD + j * 64 + lane]); s2 += y[j] * y[j]; }
        const float rk = 1.f / sqrtf(wave_sum(s2) * (1.f / 128.f) + 1e-6f);
#pragma unroll
        for (int j = 0; j < 2; ++j) *(LAS bf16_t*)(kvn + tok * 272 + (j * 64 + lane) * 2) = f2bf(y[j] * rk * kvg[j * 64 + lane]);
    }
    __syncthreads();
    {
        const bf16_t* WqT = (const bf16_t*)(p.ws + WS_MLAW + (size_t)l * MLAW_LAYER);
        const bf16_t* WkvT = (const bf16_t*)(p.ws + WS_MLAW + (size_t)l * MLAW_LAYER + MLAW_KV);
        for (int nt = wave; nt < 56; nt += 8) {
            f32x4 a0 = (f32x4){0.f, 0.f, 0.f, 0.f}, a1 = a0;
            if (nt < 24) {
                const bf16_t* wrow = WqT + (size_t)(nt * 16 + fr) * 256 + fq * 8;
#pragma unroll
                for (int kc = 0; kc < 8; ++kc) { const bf16x8 bfr = *(const bf16x8*)(wrow + kc * 32);
                    const bf16x8 x0 = *(const LAS bf16x8*)(qn + fr * 528 + kc * 64 + fq * 16), x1 = *(const LAS bf16x8*)(qn + (16 + fr) * 528 + kc * 64 + fq * 16);
                    a0 = __builtin_amdgcn_mfma_f32_16x16x32_bf16(x0, bfr, a0, 0, 0, 0); a1 = __builtin_amdgcn_mfma_f32_16x16x32_bf16(x1, bfr, a1, 0, 0, 0); }
#pragma unroll
                for (int r = 0; r < 4; ++r) { qo[(fq * 4 + r) * 384 + nt * 16 + fr] = a0[r]; qo[(16 + fq * 4 + r) * 384 + nt * 16 + fr] = a1[r]; }
            } else {
                const int n0 = (nt - 24) * 16;
                const bf16_t* wrow = WkvT + (size_t)(n0 + fr) * 128 + fq * 8;
#pragma unroll
                for (int kc = 0; kc < 4; ++kc) { const bf16x8 bfr = *(const bf16x8*)(wrow + kc * 32);
                    const bf16x8 x0 = *(const LAS bf16x8*)(kvn + fr * 272 + kc * 64 + fq * 16), x1 = *(const LAS bf16x8*)(kvn + (16 + fr) * 272 + kc * 64 + fq * 16);
                    a0 = __builtin_amdgcn_mfma_f32_16x16x32_bf16(x0, bfr, a0, 0, 0, 0); a1 = __builtin_amdgcn_mfma_f32_16x16x32_bf16(x1, bfr, a1, 0, 0, 0); }
#pragma unroll
                for (int r = 0; r < 4; ++r) { kvo[(fq * 4 + r) * 512 + n0 + fr] = a0[r]; kvo[(16 + fq * 4 + r) * 512 + n0 + fr] = a1[r]; }
            }
        }
    }
    __syncthreads();
    {
        const int h = tid >> 7, dd = tid & 127;
        if (dd < 64) { bf16_t* KM = (bf16_t*)(p.ws + WS_KM) + ((size_t)(s0.b * 4 + h) * NKEYS + key0) * 96 + dd;
#pragma unroll
            for (int i = 0; i < 32; ++i) KM[(size_t)i * 96] = f2bf(kvo[i * 512 + tid]); }
        else { bf16_t* VT = (bf16_t*)(p.ws + WS_VTM) + ((size_t)(s0.b * 4 + h) * 64 + (dd - 64)) * NKEYS + key0;
            unsigned w[16];
#pragma unroll
            for (int i = 0; i < 16; ++i) w[i] = pk2(kvo[(2 * i) * 512 + tid], kvo[(2 * i + 1) * 512 + tid]);
#pragma unroll
            for (int i = 0; i < 4; ++i) *(u32x4*)(VT + i * 8) = (u32x4){w[4 * i], w[4 * i + 1], w[4 * i + 2], w[4 * i + 3]}; }
    }
    bf16_t* MQ = (bf16_t*)(p.ws + WS_MQ);
    for (int e = tid; e < 32 * 384; e += 512) { const int tok = e / 384, c = e % 384, dd = c % 96; const int pos = s0.pos + tok;
        float v = qo[e];
        if (dd >= 64 && !s0.isctx) { const int pe = dd - 64, axis = pe >> 4, half = (pe >> 3) & 1, f = pe & 7; const int pp = axis == 0 ? (pos >> 6) : (pos & 63);
            const float cs = tabc[pp * 8 + f], sn = tabs[pp * 8 + f];
            const float x1 = half ? qo[e - 8] : v, x2 = half ? v : qo[e + 8];
            v = half ? (x2 * cs + x1 * sn) : (x1 * cs - x2 * sn); }
        MQ[(size_t)(t0 + tok) * 384 + c] = f2bf(v); }
    for (int e = tid; e < 32 * 32; e += 512) { const int tok = e >> 5, pe = e & 31, axis = pe >> 4, half = (pe >> 3) & 1, f = pe & 7; const int row = t0 + tok, pos = s0.pos + tok;
        float v = bf2f(P[(size_t)row * NP + PC_MLAKPE + pe]);
        if (!s0.isctx) { const int pp = axis == 0 ? (pos >> 6) : (pos & 63); const float cs = tabc[pp * 8 + f], sn = tabs[pp * 8 + f];
            const float other = bf2f(P[(size_t)row * NP + PC_MLAKPE + (half ? pe - 8 : pe + 8)]);
            const float x1 = half ? other : v, x2 = half ? v : other;
            v = half ? (x2 * cs + x1 * sn) : (x1 * cs - x2 * sn); }
        const bf16_t o = f2bf(v);
#pragma unroll
        for (int h = 0; h < 4; ++h) ((bf16_t*)(p.ws + WS_KM))[((size_t)(s0.b * 4 + h) * NKEYS + key0 + tok) * 96 + 64 + pe] = o; }
    __syncthreads();
}
__device__ __forceinline__ void ret_scan_item(const Params& p, int item) {
    const int tid = get_tid(); const int seq = item >> 1, dir = item & 1, h = seq & 3;
    const float lg = log1pf(-exp2f(-5.f - (float)h)); const float cdec = expf(128.f * lg);
    float* base = (float*)(p.ws + WS_RET) + (size_t)seq * 34 * 2 * 4096 + dir * 4096;
    float S[8];
#pragma unroll
    for (int i = 0; i < 8; ++i) S[i] = 0.f;
    for (int st = 0; st < 34; ++st) {
        const int ci = dir == 0 ? st : (st == 0 ? 1 : (st == 1 ? 0 : 35 - st));
        float* q = base + (size_t)ci * 2 * 4096 + tid * 8;
        const f32x4 t0 = *(const f32x4*)q, t1 = *(const f32x4*)(q + 4);
        *(f32x4*)q = (f32x4){S[0], S[1], S[2], S[3]}; *(f32x4*)(q + 4) = (f32x4){S[4], S[5], S[6], S[7]};
        S[0] = S[0] * cdec + t0.x; S[1] = S[1] * cdec + t0.y; S[2] = S[2] * cdec + t0.z; S[3] = S[3] * cdec + t0.w;
        S[4] = S[4] * cdec + t1.x; S[5] = S[5] * cdec + t1.y; S[6] = S[6] * cdec + t1.z; S[7] = S[7] * cdec + t1.w;
    }
}
__device__ __forceinline__ void phase_prepB(const Params& p, int l, LAS unsigned char* lds, int bid, int nb) {
    constexpr int N1 = TT / 32, N2 = 64;
    for (int it = bid; it < N1 + N2; it += nb) {
        if (it < N1) mla_proj_item(p, l, lds, it); else ret_scan_item(p, it - N1);
    }
}

typedef __bf16 bf16x2_t __attribute__((ext_vector_type(2)));
__device__ __forceinline__ unsigned cvt_pk_bf16(float lo, float hi) { const f32x2 v = {lo, hi}; return __builtin_bit_cast(unsigned, __builtin_convertvector(v, bf16x2_t)); }
template <int DK>
__device__ __forceinline__ void attn_unit(const bf16_t* Q, int qstride, const bf16_t* K, const bf16_t* Vt, int nctx, int mt0, int mt1, bool masked, int qpos0,
                                          bool has_sink, float sink, float scale, bf16_t* O, int ostride, LAS unsigned char* lds) {
    constexpr int KC = DK / 32, KP = DK + 8, KROW = KP * 2;
    constexpr int PIECES_K = 64 * DK / 8;
    constexpr int BUFB = 64 * KROW + 64 * 144;
    const int tid = get_tid(), lane = tid & 63, wave = tid >> 6, fr = lane & 15, fq = lane >> 4;
    const float sl2 = scale * 1.44269504f;
    bf16x8 qf[2][KC];
#pragma unroll
    for (int g = 0; g < 2; ++g)
#pragma unroll
        for (int kc = 0; kc < KC; ++kc) { const u32x4 u = *(const u32x4*)(Q + (size_t)(wave * 32 + g * 16 + fr) * qstride + kc * 32 + fq * 8); float f[8]; unpack8(u, f);
            u32x4 o; o.x = cvt_pk_bf16(f[0] * sl2, f[1] * sl2); o.y = cvt_pk_bf16(f[2] * sl2, f[3] * sl2); o.z = cvt_pk_bf16(f[4] * sl2, f[5] * sl2); o.w = cvt_pk_bf16(f[6] * sl2, f[7] * sl2);
            qf[g][kc] = __builtin_bit_cast(bf16x8, o); }
    float mq[2] = {0.f, 0.f}, lsum[2] = {0.f, 0.f}; f32x4 o[2][4];
#pragma unroll
    for (int g = 0; g < 2; ++g)
#pragma unroll
        for (int n = 0; n < 4; ++n) o[g][n] = (f32x4){0.f, 0.f, 0.f, 0.f};
    const int ntiles = nctx + (mt1 - mt0);
    u32x4 kr[2], vr;
    auto issue = [&](int ti) {
        const int tile = ti < nctx ? ti : mt0 + (ti - nctx);
        const bf16_t* kb = K + (size_t)tile * 64 * DK;
#pragma unroll
        for (int i = 0; i < 2; ++i) { const int pc = tid + i * 512; if (pc < PIECES_K) kr[i] = *(const u32x4*)(kb + (size_t)pc * 8); }
        { const int d = tid >> 3, c8 = tid & 7; vr = *(const u32x4*)(Vt + (size_t)d * NKEYS + tile * 64 + c8 * 8); }
    };
    auto stash = [&](int bufi) {
        LAS unsigned char* Kt = lds + bufi * BUFB; LAS unsigned char* Vl = Kt + 64 * KROW;
#pragma unroll
        for (int i = 0; i < 2; ++i) { const int pc = tid + i * 512; if (pc < PIECES_K) { const int row = pc / (DK / 8), c8 = pc % (DK / 8); *(LAS u32x4*)(Kt + row * KROW + c8 * 16) = kr[i]; } }
        { const int d = tid >> 3, c8 = tid & 7; *(LAS u32x4*)(Vl + d * 144 + c8 * 16) = vr; }
    };
    issue(0); stash(0);
    if (ntiles > 1) issue(1);
    __syncthreads();
    for (int ti = 0; ti < ntiles; ++ti) {
        const int tile = ti < nctx ? ti : mt0 + (ti - nctx);
        LAS unsigned char* Kt = lds + (ti & 1) * BUFB; LAS unsigned char* Vl = Kt + 64 * KROW;
        if (ti + 1 < ntiles) { stash((ti + 1) & 1); if (ti + 2 < ntiles) issue(ti + 2); }
        f32x4 s[2][4];
#pragma unroll
        for (int n = 0; n < 4; ++n) {
            s[0][n] = (f32x4){-mq[0], -mq[0], -mq[0], -mq[0]}; s[1][n] = (f32x4){-mq[1], -mq[1], -mq[1], -mq[1]};
#pragma unroll
            for (int kc = 0; kc < KC; ++kc) { const bf16x8 kf = *(const LAS bf16x8*)(Kt + (n * 16 + fr) * KROW + kc * 64 + fq * 16);
                s[0][n] = __builtin_amdgcn_mfma_f32_16x16x32_bf16(kf, qf[0][kc], s[0][n], 0, 0, 0);
                s[1][n] = __builtin_amdgcn_mfma_f32_16x16x32_bf16(kf, qf[1][kc], s[1][n], 0, 0, 0); } }
        if (ti == 0) {
#pragma unroll
            for (int g = 0; g < 2; ++g) {
                float t = -INFINITY;
#pragma unroll
                for (int n = 0; n < 4; ++n)
#pragma unroll
                    for (int r = 0; r < 4; ++r) t = fmaxf(t, s[g][n][r]);
                t = fmaxf(t, __shfl_xor(t, 16)); t = fmaxf(t, __shfl_xor(t, 32));
                if (has_sink) t = fmaxf(t, sink * 1.44269504f);
                mq[g] = t;
#pragma unroll
                for (int n = 0; n < 4; ++n)
#pragma unroll
                    for (int r = 0; r < 4; ++r) s[g][n][r] -= t;
            }
        }
        if (masked && ti >= nctx) {
#pragma unroll
            for (int g = 0; g < 2; ++g)
#pragma unroll
                for (int n = 0; n < 4; ++n)
#pragma unroll
                    for (int r = 0; r < 4; ++r) { const int kp = tile * 64 + n * 16 + fq * 4 + r - CTXL, qp = qpos0 + wave * 32 + g * 16 + fr; const int df = qp - kp; if (df > 128 || df < -128) s[g][n][r] = -INFINITY; }
        }
#pragma unroll
        for (int g = 0; g < 2; ++g)
#pragma unroll
            for (int n = 0; n < 4; ++n)
#pragma unroll
                for (int r = 0; r < 4; ++r) { s[g][n][r] = __builtin_amdgcn_exp2f(s[g][n][r]); lsum[g] += s[g][n][r]; }
#pragma unroll
        for (int c = 0; c < 2; ++c) {
            bf16x8 pf[2];
#pragma unroll
            for (int g = 0; g < 2; ++g) { u32x4 pu; pu.x = cvt_pk_bf16(s[g][2 * c][0], s[g][2 * c][1]); pu.y = cvt_pk_bf16(s[g][2 * c][2], s[g][2 * c][3]);
                pu.z = cvt_pk_bf16(s[g][2 * c + 1][0], s[g][2 * c + 1][1]); pu.w = cvt_pk_bf16(s[g][2 * c + 1][2], s[g][2 * c + 1][3]); pf[g] = __builtin_bit_cast(bf16x8, pu); }
#pragma unroll
            for (int n = 0; n < 4; ++n) {
                const u32x2 lo = *(const LAS u32x2*)(Vl + (n * 16 + fr) * 144 + ((2 * c) * 16 + fq * 4) * 2), hi = *(const LAS u32x2*)(Vl + (n * 16 + fr) * 144 + ((2 * c + 1) * 16 + fq * 4) * 2);
                const bf16x8 vf = __builtin_bit_cast(bf16x8, (u32x4){lo.x, lo.y, hi.x, hi.y});
                o[0][n] = __builtin_amdgcn_mfma_f32_16x16x32_bf16(vf, pf[0], o[0][n], 0, 0, 0);
                o[1][n] = __builtin_amdgcn_mfma_f32_16x16x32_bf16(vf, pf[1], o[1][n], 0, 0, 0); }
        }
        __syncthreads();
    }
#pragma unroll
    for (int g = 0; g < 2; ++g) {
        float t = lsum[g];
        t += __shfl_xor(t, 16); t += __shfl_xor(t, 32);
        if (has_sink) t += __builtin_amdgcn_exp2f(sink * 1.44269504f - mq[g]);
        const float inv = 1.f / t;
#pragma unroll
        for (int n = 0; n < 4; ++n) { u32x2 ov; ov.x = cvt_pk_bf16(o[g][n][0] * inv, o[g][n][1] * inv); ov.y = cvt_pk_bf16(o[g][n][2] * inv, o[g][n][3] * inv);
            *(u32x2*)(O + (size_t)(wave * 32 + g * 16 + fr) * ostride + n * 16 + fq * 4) = ov; }
    }
}

__device__ __forceinline__ void ret_out_item(const Params& p, int l, LAS unsigned char* lds, int item) {
    const int tid = get_tid(), lane = tid & 63, wave = tid >> 6, fr = lane & 15, fq = lane >> 4;
    bf16_t* P = (bf16_t*)(p.ws + WS_P);
    const int cr = item >> 2, h = item & 3; int b; const int ci = ret_chunk_index(cr, b);
    const int r0 = cr * 128;
    const float lg2 = log1pf(-exp2f(-5.f - (float)h)) * 1.44269504f;
    LAS unsigned char* Kb = lds;
    LAS unsigned char* Vt = lds + 18432;
    LAS unsigned char* SfT = lds + 35840;
    LAS unsigned char* SbT = lds + 45056;
    for (int pc = tid; pc < 1024; pc += 512) { const int j = pc >> 3, c8 = pc & 7;
        const u32x4 kk = *(const u32x4*)(P + (size_t)(r0 + j) * NP + PC_RETK + h * 64 + c8 * 8);
        const u32x4 vv = *(const u32x4*)(P + (size_t)(r0 + j) * NP + PC_RETV + h * 64 + c8 * 8);
        float kf[8]; unpack8(kk, kf);
        u32x4 ko; ko.x = pk2(kf[0] * 0.125f, kf[1] * 0.125f); ko.y = pk2(kf[2] * 0.125f, kf[3] * 0.125f); ko.z = pk2(kf[4] * 0.125f, kf[5] * 0.125f); ko.w = pk2(kf[6] * 0.125f, kf[7] * 0.125f);
        *(LAS u32x4*)(Kb + j * 144 + c8 * 16) = ko;
        const unsigned vw[4] = {vv.x, vv.y, vv.z, vv.w};
#pragma unroll
        for (int x = 0; x < 8; ++x) *(LAS bf16_t*)(Vt + (c8 * 8 + x) * 272 + j * 2) = (bf16_t)((x & 1) ? (vw[x >> 1] >> 16) : (vw[x >> 1] & 0xffff)); }
    { const float* RS = (const float*)(p.ws + WS_RET) + ((size_t)((b * 4 + h) * 34 + ci) * 2) * 4096;
      for (int pc = tid; pc < 1024; pc += 512) { const int d = pc >> 4, e4 = (pc & 15) * 4;
          const f32x4 a = *(const f32x4*)(RS + d * 64 + e4), bb = *(const f32x4*)(RS + 4096 + d * 64 + e4);
#pragma unroll
          for (int x = 0; x < 4; ++x) { *(LAS bf16_t*)(SfT + (e4 + x) * 144 + d * 2) = f2bf(a[x]); *(LAS bf16_t*)(SbT + (e4 + x) * 144 + d * 2) = f2bf(bb[x]); } } }
    const int i = wave * 16 + fr;
    u32x4 qraw[2];
#pragma unroll
    for (int kc = 0; kc < 2; ++kc) qraw[kc] = *(const u32x4*)(P + (size_t)(r0 + i) * NP + PC_RETQ + h * 64 + kc * 32 + fq * 8);
    __syncthreads();
    f32x4 s[8];
#pragma unroll
    for (int nb = 0; nb < 8; ++nb) { s[nb] = (f32x4){0.f, 0.f, 0.f, 0.f};
#pragma unroll
        for (int kc = 0; kc < 2; ++kc) { const bf16x8 kf = *(const LAS bf16x8*)(Kb + (nb * 16 + fr) * 144 + kc * 64 + fq * 16);
            s[nb] = __builtin_amdgcn_mfma_f32_16x16x32_bf16(kf, __builtin_bit_cast(bf16x8, qraw[kc]), s[nb], 0, 0, 0); } }
#pragma unroll
    for (int nb = 0; nb < 8; ++nb)
#pragma unroll
        for (int r = 0; r < 4; ++r) { const int j = nb * 16 + fq * 4 + r; const int df = i - j; const int adf = df < 0 ? -df : df;
            float dcy = __builtin_amdgcn_exp2f((float)adf * lg2); if (df == 0) dcy = 2.f; s[nb][r] *= dcy; }
    f32x4 o[4];
#pragma unroll
    for (int n = 0; n < 4; ++n) o[n] = (f32x4){0.f, 0.f, 0.f, 0.f};
#pragma unroll
    for (int c = 0; c < 4; ++c) {
        u32x4 pu; pu.x = cvt_pk_bf16(s[2 * c][0], s[2 * c][1]); pu.y = cvt_pk_bf16(s[2 * c][2], s[2 * c][3]); pu.z = cvt_pk_bf16(s[2 * c + 1][0], s[2 * c + 1][1]); pu.w = cvt_pk_bf16(s[2 * c + 1][2], s[2 * c + 1][3]);
        const bf16x8 pf = __builtin_bit_cast(bf16x8, pu);
#pragma unroll
        for (int n = 0; n < 4; ++n) {
            const u32x2 lo = *(const LAS u32x2*)(Vt + (n * 16 + fr) * 272 + ((2 * c) * 16 + fq * 4) * 2), hi = *(const LAS u32x2*)(Vt + (n * 16 + fr) * 272 + ((2 * c + 1) * 16 + fq * 4) * 2);
            const bf16x8 vf = __builtin_bit_cast(bf16x8, (u32x4){lo.x, lo.y, hi.x, hi.y});
            o[n] = __builtin_amdgcn_mfma_f32_16x16x32_bf16(vf, pf, o[n], 0, 0, 0); }
    }
    const float gf = __builtin_amdgcn_exp2f((float)(i + 1) * lg2), gb = __builtin_amdgcn_exp2f((float)(128 - i) * lg2);
#pragma unroll
    for (int kc = 0; kc < 2; ++kc) {
        float f[8]; unpack8(qraw[kc], f);
        u32x4 uf, ub;
        uf.x = cvt_pk_bf16(f[0] * gf, f[1] * gf); uf.y = cvt_pk_bf16(f[2] * gf, f[3] * gf); uf.z = cvt_pk_bf16(f[4] * gf, f[5] * gf); uf.w = cvt_pk_bf16(f[6] * gf, f[7] * gf);
        ub.x = cvt_pk_bf16(f[0] * gb, f[1] * gb); ub.y = cvt_pk_bf16(f[2] * gb, f[3] * gb); ub.z = cvt_pk_bf16(f[4] * gb, f[5] * gb); ub.w = cvt_pk_bf16(f[6] * gb, f[7] * gb);
        const bf16x8 qF = __builtin_bit_cast(bf16x8, uf), qB = __builtin_bit_cast(bf16x8, ub);
#pragma unroll
        for (int n = 0; n < 4; ++n) {
            const bf16x8 af = *(const LAS bf16x8*)(SfT + (n * 16 + fr) * 144 + kc * 64 + fq * 16), ab = *(const LAS bf16x8*)(SbT + (n * 16 + fr) * 144 + kc * 64 + fq * 16);
            o[n] = __builtin_amdgcn_mfma_f32_16x16x32_bf16(af, qF, o[n], 0, 0, 0);
            o[n] = __builtin_amdgcn_mfma_f32_16x16x32_bf16(ab, qB, o[n], 0, 0, 0); }
    }
    float sm = 0.f;
#pragma unroll
    for (int n = 0; n < 4; ++n) sm += (o[n][0] + o[n][1]) + (o[n][2] + o[n][3]);
    sm += __shfl_xor(sm, 16); sm += __shfl_xor(sm, 32);
    const float mu = sm * (1.f / 64.f);
    float vs = 0.f;
#pragma unroll
    for (int n = 0; n < 4; ++n)
#pragma unroll
        for (int r = 0; r < 4; ++r) { const float dl = o[n][r] - mu; vs += dl * dl; }
    vs += __shfl_xor(vs, 16); vs += __shfl_xor(vs, 32);
    const float rstd = 1.f / sqrtf(vs * (1.f / 64.f) + 1e-5f);
#pragma unroll
    for (int n = 0; n < 4; ++n) { const int e0 = n * 16 + fq * 4;
        const u32x2 gu = *(const u32x2*)(P + (size_t)(r0 + i) * NP + PC_RETG + h * 64 + e0);
        const f32x4 gn = *(const f32x4*)(p.in[13] + l * 256 + h * 64 + e0);
        const float g0 = bf2f((bf16_t)(gu.x & 0xffff)), g1 = bf2f((bf16_t)(gu.x >> 16)), g2 = bf2f((bf16_t)(gu.y & 0xffff)), g3 = bf2f((bf16_t)(gu.y >> 16));
        u32x2 yo;
        yo.x = cvt_pk_bf16((o[n][0] - mu) * rstd * gn.x * (g0 / (1.f + __expf(-g0))), (o[n][1] - mu) * rstd * gn.y * (g1 / (1.f + __expf(-g1))));
        yo.y = cvt_pk_bf16((o[n][2] - mu) * rstd * gn.z * (g2 / (1.f + __expf(-g2))), (o[n][3] - mu) * rstd * gn.w * (g3 / (1.f + __expf(-g3))));
        *(u32x2*)(P + (size_t)(r0 + i) * NP + PC_RETQ + h * 64 + e0) = yo; }
    __syncthreads();
}

constexpr int NSCANBLK = 128;
__device__ __forceinline__ void rwkv_scan_item(const Params& p, int l, LAS unsigned char* lds, int item) {
    const int tid = get_tid();
    const int sc = item >> 1, half = item & 1;
    const int b = sc >> 3, h = (sc >> 1) & 3, dir = sc & 1;
    const bf16_t* RK = (const bf16_t*)(p.ws + WS_RWK); const bf16_t* RV = (const bf16_t*)(p.ws + WS_RWV); const bf16_t* RR = (const bf16_t*)(p.ws + WS_RWRR);
    const bf16_t* RA = (const bf16_t*)(p.ws + (dir ? WS_RWA1 : WS_RWA0)); const bf16_t* RM = (const bf16_t*)(p.ws + (dir ? WS_RWM1 : WS_RWM0));
    bf16_t* P = (bf16_t*)(p.ws + WS_P);
    const int ocol = (dir ? PC_RWO1 : PC_RWO0) + h * 64 + half * 32;
    LAS float* KH = (LAS float*)lds;
    LAS float* WW = KH + 4096; LAS float* BB = WW + 4096; LAS float* KT = BB + 4096; LAS float* RRl = KT + 4096; LAS float* VV = RRl + 4096; LAS float* OUT = VV + 4096;
    const int st = tid >> 3, c0 = (tid & 7) * 8;
    float kkp[8], kap[8];
#pragma unroll
    for (int i = 0; i < 8; ++i) { kkp[i] = p.in[20][l * 256 + h * 64 + c0 + i]; kap[i] = p.in[21][l * 256 + h * 64 + c0 + i]; }
    const int row_l = tid >> 4, kq = tid & 15;
    f32x2 S[2];
#pragma unroll
    for (int i = 0; i < 2; ++i) S[i] = (f32x2){0.f, 0.f};
    auto row_of = [&](int s) -> int {
        if (s < CTXL) return TMAIN + b * CTXL + (dir ? CTXL - 1 - s : s);
        const int t = s - CTXL; return b * SEQL + (dir ? SEQL - 1 - t : t);
    };
    u32x4 gk, gv, gr, ga, gm;
    auto issue = [&](int ch) { const size_t o = (size_t)row_of(ch * 64 + st) * 256 + h * 64 + c0;
        gk = *(const u32x4*)(RK + o); gv = *(const u32x4*)(RV + o); gr = *(const u32x4*)(RR + o); ga = *(const u32x4*)(RA + o); gm = *(const u32x4*)(RM + o); };
    issue(0);
    for (int ch = 0; ch < 68; ++ch) {
        {
            float k[8], a[8], om[8], rr[8], vv8[8]; unpack8(gk, k); unpack8(ga, a); unpack8(gm, om); unpack8(gr, rr); unpack8(gv, vv8);
            float kk[8]; float n2 = 0.f;
#pragma unroll
            for (int i = 0; i < 8; ++i) { kk[i] = k[i] * kkp[i]; n2 += kk[i] * kk[i]; }
            n2 = red8(n2);
            const float rn = 1.f / sqrtf(fmaxf(n2, 1e-12f));
            f32x4 o0, o1;
#define ST8(DST, EXPR) { float t8[8]; _Pragma("unroll") for (int i = 0; i < 8; ++i) t8[i] = (EXPR); \
            *(LAS f32x4*)(DST + st * 64 + c0) = (f32x4){t8[0], t8[1], t8[2], t8[3]}; *(LAS f32x4*)(DST + st * 64 + c0 + 4) = (f32x4){t8[4], t8[5], t8[6], t8[7]}; }
            ST8(KH, kk[i] * rn)
            ST8(WW, 1.f - om[i])
            ST8(BB, kk[i] * rn * a[i])
            ST8(KT, k[i] * (1.f + (a[i] - 1.f) * kap[i]))
            ST8(RRl, rr[i])
            ST8(VV, vv8[i])
#undef ST8
        }
        __syncthreads();
        if (ch + 1 < 68) issue(ch + 1);
        {
            struct Ops { f32x4 kh, w, b, t, r; float vv; };
            auto ldops = [&](int s) -> Ops { Ops q;
                q.kh = *(const LAS f32x4*)(KH + s * 64 + kq * 4); q.w = *(const LAS f32x4*)(WW + s * 64 + kq * 4); q.b = *(const LAS f32x4*)(BB + s * 64 + kq * 4);
                q.t = *(const LAS f32x4*)(KT + s * 64 + kq * 4); q.r = *(const LAS f32x4*)(RRl + s * 64 + kq * 4);
                q.vv = VV[s * 64 + half * 32 + row_l]; return q; };
            Ops nx = ldops(0);
#pragma unroll 2
            for (int s = 0; s < 64; ++s) {
                const Ops c = nx;
                nx = ldops(s + 1 < 64 ? s + 1 : 63);
                f32x2 a2 = S[0] * (f32x2){c.kh.x, c.kh.y}; a2 = S[1] * (f32x2){c.kh.z, c.kh.w} + a2;
                const float sk = red16(a2.x + a2.y);
                const f32x2 nsk = (f32x2){-sk, -sk}, vv2 = (f32x2){c.vv, c.vv};
                S[0] = S[0] * (f32x2){c.w.x, c.w.y} + (nsk * (f32x2){c.b.x, c.b.y} + vv2 * (f32x2){c.t.x, c.t.y});
                S[1] = S[1] * (f32x2){c.w.z, c.w.w} + (nsk * (f32x2){c.b.z, c.b.w} + vv2 * (f32x2){c.t.z, c.t.w});
                f32x2 o2 = S[0] * (f32x2){c.r.x, c.r.y}; o2 = S[1] * (f32x2){c.r.z, c.r.w} + o2;
                const float ov = red16(o2.x + o2.y);
                if (kq == 0) OUT[s * 32 + row_l] = ov;
            }
        }
        __syncthreads();
        { const int c4 = (tid & 7) * 4; const f32x4 ov = *(const LAS f32x4*)(OUT + st * 32 + c4);
          u32x2 o2; o2.x = pk2(ov.x, ov.y); o2.y = pk2(ov.z, ov.w);
          *(u32x2*)(P + (size_t)row_of(ch * 64 + st) * NP + ocol + c4) = o2; }
    }
    __syncthreads();
}

__device__ __forceinline__ void mixer_mla(const Params& p, LAS unsigned char* lds, int it) {
    bf16_t* P = (bf16_t*)(p.ws + WS_P);
    const bf16_t* MQ = (const bf16_t*)(p.ws + WS_MQ);
    int b, h, row0, nm1;
    if (it < 512) { b = it >> 6; h = (it >> 4) & 3; row0 = b * SEQL + (it & 15) * 256; nm1 = 68; }
    else { const int u = it - 512; b = u >> 2; h = u & 3; row0 = TMAIN + b * CTXL; nm1 = 4; }
    attn_unit<96>(MQ + (size_t)row0 * 384 + h * 96, 384, (const bf16_t*)(p.ws + WS_KM) + (size_t)(b * 4 + h) * NKEYS * 96, (const bf16_t*)(p.ws + WS_VTM) + (size_t)(b * 4 + h) * 64 * NKEYS,
                  4, 4, nm1, false, 0, false, 0.f, 0.10206207f, P + (size_t)row0 * NP + PC_MLAQD + h * 64, NP, lds);
}
__device__ __forceinline__ void mixer_swa(const Params& p, int l, LAS unsigned char* lds, int u0) {
    bf16_t* P = (bf16_t*)(p.ws + WS_P);
    int b, h, row0, nm0, nm1, qp0; bool msk;
    if (u0 < 512) { b = u0 >> 6; h = (u0 >> 4) & 3; const int qb = u0 & 15; row0 = b * SEQL + qb * 256; nm0 = 4 + 4 * qb - 2; nm1 = 4 + 4 * qb + 6; if (nm0 < 4) nm0 = 4; if (nm1 > 68) nm1 = 68; qp0 = qb * 256; msk = true; }
    else { const int u = u0 - 512; b = u >> 2; h = u & 3; row0 = TMAIN + b * CTXL; nm0 = 4; nm1 = 4; qp0 = 0; msk = false; }
    const int hk = h >> 1;
    bf16_t* qp = P + (size_t)row0 * NP + PC_SWAQ + h * 64;
    attn_unit<64>(qp, NP, (const bf16_t*)(p.ws + WS_KS) + (size_t)(b * 2 + hk) * NKEYS * 64, (const bf16_t*)(p.ws + WS_VTS) + (size_t)(b * 2 + hk) * 64 * NKEYS,
                  4, nm0, nm1, msk, qp0, true, p.in[12][l * 4 + h], 0.125f, qp, NP, lds);
}
__device__ __forceinline__ void phase_mixers(const Params& p, int l, LAS unsigned char* lds, int bid, int nb) {
    const bool ectx = (l == 0);
    const int N_MLA = 512 + (ectx ? 32 : 0), N_SWA = 512 + (ectx ? 32 : 0), N_RET = 1024 + (ectx ? 64 : 0);
    if (bid < NSCANBLK) rwkv_scan_item(p, l, lds, bid);
    unsigned* ctr = (unsigned*)(p.ws + WS_CTR) + l;
    LAS unsigned* slot = (LAS unsigned*)(lds + LDS_BYTES - 16);
    const int tid0 = get_tid();
    for (;;) {
        __syncthreads();
        if (tid0 == 0) *slot = atomicAdd(ctr, 1u);
        __syncthreads();
        const int it = (int)*slot;
        if (it >= N_MLA + N_SWA + N_RET) break;
        if (it < N_MLA) mixer_mla(p, lds, it);
        else if (it < N_MLA + N_SWA) mixer_swa(p, l, lds, it - N_MLA);
        else ret_out_item(p, l, lds, it - N_MLA - N_SWA);
    }
}

__device__ __forceinline__ void phase_rwkv_finish(const Params& p, int l, LAS unsigned char* lds, int bid, int nb) {
    const int tid = get_tid();
    bf16_t* P = (bf16_t*)(p.ws + WS_P);
    const int ntiles = (l == 0 ? TT : TMAIN) / 32;
    const float* mu = p.in[14] + l * 1024 + 896;
    const float* gup = p.in[19] + (size_t)l * 128 * 256;
    const bf16_t* RV = (const bf16_t*)(p.ws + WS_RWV); const float* BON = (const float*)(p.ws + WS_BON);
    LAS float* sg = (LAS float*)lds;
    for (int tile = bid; tile < ntiles; tile += nb) {
        const int t0 = tile * 32; const SeqInfo s0 = seq_of_row(t0);
        { const int tok = tid >> 4, j8 = (tid & 15) * 8; const int row = t0 + tok, pos = s0.pos + tok;
          const u32x4 u0 = *(const u32x4*)(P + (size_t)row * NP + PC_RWGD + j8);
          const u32x4 um = pos > 0 ? *(const u32x4*)(P + (size_t)(row - 1) * NP + PC_RWGD + j8) : (u32x4){0u, 0u, 0u, 0u};
          const u32x4 up = pos < s0.len - 1 ? *(const u32x4*)(P + (size_t)(row + 1) * NP + PC_RWGD + j8) : (u32x4){0u, 0u, 0u, 0u};
          float z0[8], zm[8], zp[8]; unpack8(u0, z0); unpack8(um, zm); unpack8(up, zp);
#pragma unroll
          for (int x = 0; x < 8; ++x) sg[tok * 128 + j8 + x] = sigmoidf_(z0[x] + mu[j8 + x] * (0.5f * (zm[x] + zp[x]) - z0[x])); }
        __syncthreads();
        const int hh = tid >> 8, c = tid & 255, h = c >> 6;
        float g[16];
#pragma unroll
        for (int i = 0; i < 16; ++i) g[i] = 0.f;
#pragma unroll 8
        for (int j = 0; j < 128; ++j) { const float w = gup[j * 256 + c];
#pragma unroll
            for (int i = 0; i < 16; ++i) g[i] += sg[(hh * 16 + i) * 128 + j] * w; }
        const float gn = p.in[23][l * 256 + c];
        float ov[16], rv[16], bn[16];
#pragma unroll
        for (int i = 0; i < 16; ++i) { const int row = t0 + hh * 16 + i;
            ov[i] = bf2f(P[(size_t)row * NP + PC_RWO0 + c]) + bf2f(P[(size_t)row * NP + PC_RWO1 + c]); rv[i] = bf2f(RV[(size_t)row * 256 + c]); bn[i] = BON[(size_t)row * 4 + h]; }
#pragma unroll
        for (int i = 0; i < 16; ++i) { const int row = t0 + hh * 16 + i;
            const float o = ov[i];
            const float mean = wave_sum(o) * (1.f / 64.f); const float dl = o - mean; const float var = wave_sum(dl * dl) * (1.f / 64.f);
            float y = dl * (1.f / sqrtf(var + 64e-5f)) * gn + bn[i] * rv[i];
            P[(size_t)row * NP + PC_RWO1 + c] = f2bf(y * g[i]); }
        __syncthreads();
    }
}

#ifndef N_LAUNCH_MODE
#define N_LAUNCH_MODE 1
#endif
template <int Q>
__device__ __forceinline__ void layer_phase(const Params& p, int l, LAS unsigned char* lds, int bid, int nb) {
    unsigned char* wb = p.ws + WS_WB + (size_t)l * WB_LAYER;
    const int Mrows = (l == 0) ? TT : TMAIN;
    pg8::StaticOrder S;
    if constexpr (Q == 0) { pg8::Gemm g{(const bf16_t*)(p.ws + WS_HB), (const bf16_t*)(wb + WB_IN), TT, NP, DM, DM}; S.init(TT, NP, nb, bid);
              pg8::EpiBf16<0> E{(bf16_t*)(p.ws + WS_P), NP}; pg8::gemm_phase(lds, g, S, E); }
    if constexpr (Q == 1) phase_prepA(p, l, lds, bid, nb);
    if constexpr (Q == 2) phase_prepB(p, l, lds, bid, nb);
    if constexpr (Q == 3) phase_mixers(p, l, lds, bid, nb);
    if constexpr (Q == 4) phase_rwkv_finish(p, l, lds, bid, nb);
    if constexpr (Q == 5) { pg8::Gemm g{(const bf16_t*)(p.ws + WS_P), (const bf16_t*)(wb + WB_OUT), Mrows, DM, DM, NP}; S.init(Mrows, DM, nb, bid);
              pg8::EpiBf16<0> E{(bf16_t*)(p.ws + WS_Z), DM}; pg8::gemm_phase(lds, g, S, E); }
    if constexpr (Q == 6) phase_rowops(p, 1, l, Mrows, bid, nb);
    if constexpr (Q == 7) { pg8::Gemm g{(const bf16_t*)(p.ws + WS_HB), (const bf16_t*)(wb + WB_W1), Mrows, FF, DM, DM}; S.init(Mrows, FF, nb, bid);
              pg8::EpiBf16<1> E{(bf16_t*)(p.ws + WS_HID), FF}; pg8::gemm_phase(lds, g, S, E); }
    if constexpr (Q == 8) { pg8::Gemm g{(const bf16_t*)(p.ws + WS_HID), (const bf16_t*)(wb + WB_W2), Mrows, DM, FF, FF}; S.init(Mrows, DM, nb, bid);
              pg8::EpiBf16<0> E{(bf16_t*)(p.ws + WS_Z), DM}; pg8::gemm_phase(lds, g, S, E); }
    if constexpr (Q == 9) phase_rowops(p, 2, l, Mrows, bid, nb);
}

#ifndef PROBE_MASK
#define PROBE_MASK 0
#endif
#define PB(BIT, CALL) do { if ((PROBE_MASK) & (BIT)) { const unsigned long long t0_ = __builtin_amdgcn_s_memrealtime(); CALL; const unsigned long long t1_ = __builtin_amdgcn_s_memrealtime(); \
        while (__builtin_amdgcn_s_memrealtime() - t1_ < (t1_ - t0_)) __builtin_amdgcn_s_sleep(8); } else { CALL; } } while (0)
#define XB_TMO      128
#define XB_XCNT(j)  (256  + 64 * (j))
#define XB_XSUB(j)  (1280 + 64 * (j))
#define XB_XGEN(j)  (2304 + 64 * (j))
#define XB_TOP      3328
#define XB_TOPGEN   3392
#define XCD_BAR_WORDS 3456
#define XB_SPIN_CAP (1u << 18)

__device__ __forceinline__ unsigned xb_ld(unsigned* p)              { return __hip_atomic_load(p, __ATOMIC_RELAXED, __HIP_MEMORY_SCOPE_AGENT); }
__device__ __forceinline__ unsigned xb_add(unsigned* p, unsigned v) { return __hip_atomic_fetch_add(p, v, __ATOMIC_RELAXED, __HIP_MEMORY_SCOPE_AGENT); }
__device__ __forceinline__ unsigned xb_xcc_id() { return (unsigned)__builtin_amdgcn_s_getreg((3 << 11) | 20) & 0xFu; }
#define XB_SPIN(cond, bar) do { unsigned _sp = 0; while (cond) { __builtin_amdgcn_s_sleep(1); \
    if ((++_sp & 255u) == 0u) { if (xb_ld(&(bar)[XB_TMO])) break; if (_sp > XB_SPIN_CAP) { atomicAdd(&(bar)[XB_TMO], 1u); break; } } } } while (0)

struct XcdBarrier {
    unsigned* bar; unsigned x;
    volatile LAS unsigned* st;
};

__device__ __forceinline__ XcdBarrier xcd_barrier_post(unsigned* bar, volatile LAS unsigned* st) {
    XcdBarrier b; b.bar = bar; b.x = xb_xcc_id(); b.st = st;
    if (threadIdx.x == 0) (void)xb_add(&bar[XB_XCNT(b.x)], 1u);
    return b;
}
__device__ __forceinline__ void xcd_barrier_complete(unsigned* bar, unsigned x, unsigned& nloc, unsigned& nx) {
    const unsigned G = gridDim.x * gridDim.y * gridDim.z;
    unsigned sum, cnt, mine, sp = 0u;
    for (;;) {
        sum = 0u; cnt = 0u; mine = 0u;
#pragma unroll
        for (unsigned j = 0; j < 16; ++j) { const unsigned c = xb_ld(&bar[XB_XCNT(j)]); sum += c; cnt += (c > 0u) ? 1u : 0u; mine = (j == x) ? c : mine; }
        if (sum == G) break;
        __builtin_amdgcn_s_sleep(1);
        if ((++sp & 255u) == 0u) { if (xb_ld(&bar[XB_TMO])) break; if (sp > XB_SPIN_CAP) { atomicAdd(&bar[XB_TMO], 1u); break; } }
    }
    nloc = mine > 0u ? mine : 1u; nx = cnt > 0u ? cnt : 1u;
}

__device__ __forceinline__ void xcd_barrier(const XcdBarrier& b) {
    asm volatile("s_waitcnt vmcnt(0)" ::: "memory");
    __syncthreads();
    if (threadIdx.x == 0) {
        unsigned* bar = b.bar;
        __builtin_amdgcn_s_waitcnt(0);
        unsigned nloc = b.st[0], nx = b.st[1];
        if (nloc == 0u) { xcd_barrier_complete(bar, b.x, nloc, nx); b.st[0] = nloc; b.st[1] = nx; }
        const unsigned old = xb_add(&bar[XB_XSUB(b.x)], 1u);
        const unsigned gen = old / nloc;
        if (old + 1u == (gen + 1u) * nloc) {
            __builtin_amdgcn_fence(__ATOMIC_RELEASE, "agent");
            asm volatile("s_waitcnt vmcnt(0)" ::: "memory");
            const unsigned og = xb_add(&bar[XB_TOP], 1u);
            const unsigned tg = og / nx;
            if (og + 1u == (tg + 1u) * nx) xb_add(&bar[XB_TOPGEN], 1u);
            else XB_SPIN(xb_ld(&bar[XB_TOPGEN]) == tg, bar);
            __builtin_amdgcn_fence(__ATOMIC_ACQUIRE, "agent");
            xb_add(&bar[XB_XGEN(b.x)], 1u);
            asm volatile("s_waitcnt vmcnt(0)" ::: "memory");
        } else {
            XB_SPIN(xb_ld(&bar[XB_XGEN(b.x)]) == gen, bar);
            __builtin_amdgcn_fence(__ATOMIC_ACQUIRE, "agent");
            asm volatile("s_waitcnt vmcnt(0)" ::: "memory");
        }
    }
    __syncthreads();
}


constexpr size_t WS_XBAR = 772 * 1024;
#define GSYNC() xcd_barrier(xb)

__global__ void __launch_bounds__(512, 2) mega_fwd(Params p) {
    extern __shared__ __attribute__((aligned(16))) unsigned char lds_raw[];
    LAS unsigned char* lds = (LAS unsigned char*)lds_raw;
    cg::grid_group grid = cg::this_grid();
    const int bid = blockIdx.x, nb = gridDim.x;
    { LAS unsigned* st_ = (LAS unsigned*)(lds + LDS_BYTES - 32); if (get_tid() == 0) { st_[0] = 0u; st_[1] = 0u; } __syncthreads(); }
    XcdBarrier xb = xcd_barrier_post((unsigned*)(p.ws + WS_XBAR), (volatile LAS unsigned*)(lds + LDS_BYTES - 32));
    PB(16, phase_prologue(p, lds, bid, nb));
    { asm volatile("s_waitcnt vmcnt(0) lgkmcnt(0)" ::: "memory"); __syncthreads(); if (get_tid() < 64) { __builtin_amdgcn_fence(__ATOMIC_RELEASE, "agent"); asm volatile("s_waitcnt vmcnt(0) lgkmcnt(0)" ::: "memory"); } grid.sync();
      if (get_tid() < 64) { __builtin_amdgcn_fence(__ATOMIC_ACQUIRE, "agent"); asm volatile("s_waitcnt vmcnt(0) lgkmcnt(0)" ::: "memory"); } __syncthreads(); }
    PB(8, phase_rowops(p, 0, 0, TT, bid, nb)); GSYNC();
#define LAYER(L, LAST) \
    PB(1, layer_phase<0>(p, L, lds, bid, nb)); GSYNC(); PB(4, layer_phase<1>(p, L, lds, bid, nb)); GSYNC(); PB(4, layer_phase<2>(p, L, lds, bid, nb)); GSYNC(); \
    PB(2, layer_phase<3>(p, L, lds, bid, nb)); GSYNC(); PB(4, layer_phase<4>(p, L, lds, bid, nb)); GSYNC(); PB(1, layer_phase<5>(p, L, lds, bid, nb)); GSYNC(); \
    PB(8, layer_phase<6>(p, L, lds, bid, nb)); GSYNC(); PB(1, layer_phase<7>(p, L, lds, bid, nb)); GSYNC(); PB(1, layer_phase<8>(p, L, lds, bid, nb)); GSYNC(); \
    PB(8, layer_phase<9>(p, L, lds, bid, nb)); if (!(LAST)) GSYNC();
    LAYER(0, false)
    LAYER(1, true)
}
#if N_LAUNCH_MODE != 1
template <int PH> __global__ void __launch_bounds__(512, 2) one_phase(Params p, int l) {
    extern __shared__ __attribute__((aligned(16))) unsigned char lds_raw[];
    LAS unsigned char* lds = (LAS unsigned char*)lds_raw;
    if constexpr (PH == 100) phase_prologue(p, lds, blockIdx.x, gridDim.x);
    else if constexpr (PH == 101) phase_rowops(p, 0, 0, TT, blockIdx.x, gridDim.x);
    else layer_phase<PH>(p, l, lds, blockIdx.x, gridDim.x);
}
#endif

extern "C" void kernel_launch(void* const* d_in, const int* in_sizes, int n_in, void* d_out, int out_size, void* d_ws, size_t ws_size, hipStream_t stream) {
    if (n_in != 30 || ws_size < WS_NEED || out_size != TMAIN * DM) { fprintf(stderr, "kernel_launch: unexpected shapes (n_in %d, ws %zu, out %d)\n", n_in, ws_size, out_size); return; }
    Params p{};
    for (int i = 0; i < 30; ++i) p.in[i] = (const float*)d_in[i];
    p.out = (float*)d_out; p.ws = (unsigned char*)d_ws;
    static int grid_blocks = 0;
    if (!grid_blocks) {
        int dev = 0, cus = 0, per_cu = 0;
        (void)hipGetDevice(&dev);
        (void)hipDeviceGetAttribute(&cus, hipDeviceAttributeMultiprocessorCount, dev);
        (void)hipFuncSetAttribute((const void*)mega_fwd, hipFuncAttributeMaxDynamicSharedMemorySize, LDS_BYTES);
        (void)hipOccupancyMaxActiveBlocksPerMultiprocessor(&per_cu, mega_fwd, 512, LDS_BYTES);
        if (per_cu < 1) { fprintf(stderr, "kernel_launch: occupancy query says %d blocks/CU\n", per_cu); per_cu = 1; }
        grid_blocks = cus * 1;
        if (grid_blocks < 128) { fprintf(stderr, "kernel_launch: only %d CUs\n", grid_blocks); }
    }
#if N_LAUNCH_MODE == 1
    (void)hipMemsetAsync((char*)d_ws + 768 * 1024, 0, 32 * 1024, stream);
    void* args[] = {&p};
    hipError_t e = hipLaunchCooperativeKernel((const void*)mega_fwd, dim3(grid_blocks), dim3(512), args, LDS_BYTES, stream);
    if (e != hipSuccess) fprintf(stderr, "cooperative launch failed: %s (grid %d)\n", hipGetErrorString(e), grid_blocks);
#else
#define LP(PH, L) do { (void)hipFuncSetAttribute((const void*)one_phase<PH>, hipFuncAttributeMaxDynamicSharedMemorySize, LDS_BYTES); one_phase<PH><<<grid_blocks, 512, LDS_BYTES, stream>>>(p, L); } while (0)
    LP(100, 0); LP(101, 0);
    for (int l = 0; l < 2; ++l) { LP(0, l); LP(1, l); LP(2, l); LP(3, l); LP(4, l); LP(5, l); LP(6, l); LP(7, l); LP(8, l); LP(9, l); }
#endif
}
```

```cpp
#include <hip/hip_runtime.h>
#include <hip/hip_cooperative_groups.h>
#include <cstdio>
#include <cstdint>
#include <cmath>
namespace cg = cooperative_groups;
__device__ __forceinline__ int get_tid() { int t = threadIdx.x; asm volatile("" : "+v"(t)); return t; }
namespace pg8 {
#define PG8_LAS __attribute__((address_space(3)))
typedef unsigned short bf16_t;
typedef short bf16x8 __attribute__((ext_vector_type(8)));
typedef float f32x4 __attribute__((ext_vector_type(4)));
typedef unsigned u32x4 __attribute__((ext_vector_type(4)));
typedef unsigned u32x2 __attribute__((ext_vector_type(2)));
constexpr int BM = 256, BK = 64, HALF = 128, HTB = HALF * BK * 2, STAGE_BYTES = 8 * HTB, NXCD = 8, WGM = 8;

__host__ __device__ __forceinline__ int lds_byte(int r, int c) { const int st = (r >> 4) * 2 + (c >> 5), rr = r & 15, cc = c & 31, ob = rr * 64 + cc * 2; return st * 1024 + (ob ^ (((ob >> 9) & 1) << 5)); }
__host__ __device__ __forceinline__ void stage_rc(int b, int& R, int& C) { const int st = b / 1024, sb = b % 1024, swz = sb ^ (((sb >> 9) & 1) << 5); R = (st >> 1) * 16 + swz / 64; C = (st & 1) * 32 + (swz % 64) / 2; }

struct Unit { int pm, pn; };
struct Gemm { const bf16_t* A; const bf16_t* Bt; int M, N, K, lda; };

struct StaticOrder {
    int nM, nN, nwg, G, c;
    __host__ __device__ void init(int M, int N, int G_, int c_) { nM = M / BM; nN = N / BM; nwg = nM * nN; G = G_; c = c_; }
    __host__ __device__ bool next(int i, Unit& u) const {
        const long L = (long)i * G + c; if (L >= nwg) return false;
        int wgid = (int)L; { const int q = nwg / NXCD, r = nwg % NXCD, xcd = wgid % NXCD, off = wgid / NXCD; wgid = (xcd < r ? xcd * (q + 1) : r * (q + 1) + (xcd - r) * q) + off; }
        const int nig = WGM * nN, gid = wgid / nig, fm = gid * WGM, gsz = (nM - fm) < WGM ? (nM - fm) : WGM;
        u.pm = fm + ((wgid % nig) % gsz); u.pn = (wgid % nig) / gsz; return true;
    }
};

template <class Epi>
__device__ __forceinline__ void gemm_phase(PG8_LAS unsigned char* lds, const Gemm g, const StaticOrder& S, const Epi& E) {
    const int tid = get_tid(), wid = __builtin_amdgcn_readfirstlane(tid >> 6), lane = tid & 63, wr = wid >> 2, wc = wid & 3, fr = lane & 15, fq = lane >> 4;
    const int K = g.K, nt = K / BK, lda = g.lda;
    unsigned voffA[2], voffB[2];
#pragma unroll
    for (int i = 0; i < 2; ++i) { int R, C; stage_rc(tid * 16 + i * 8192, R, C);
        voffA[i] = (unsigned)(R * lda + C) * 2u; voffB[i] = (unsigned)(R * K + C) * 2u; }
    const size_t kstep = (size_t)(BK * 2);
    const size_t hstepA = (size_t)HALF * lda * 2, hstepB = (size_t)HALF * K * 2;
    const size_t tstepA = 2 * hstepA, tstepB = 2 * hstepB;
    const unsigned ldsw = (unsigned)wid * 1024u;
    const int aoff = lds_byte(wr * 64 + fr, fq * 8), boff = lds_byte(wc * 32 + fr, fq * 8);
#define PG8_SA(b, h) (((b) * 2 + (h)) * HTB)
#define PG8_SB(b, h) ((4 + (b) * 2 + (h)) * HTB)
#define PG8_STAGE(bufoff, gbase, voff) do { _Pragma("unroll") for (int _i = 0; _i < 2; ++_i) \
        __builtin_amdgcn_global_load_lds((const unsigned*)((const char*)(gbase) + (voff)[_i]), (PG8_LAS unsigned*)(lds + (bufoff) + ldsw + _i * 8192), 16, 0, 0); } while (0)
#define PG8_LDA(dst, b, h) do { _Pragma("unroll") for (int m = 0; m < 4; ++m) _Pragma("unroll") for (int k = 0; k < 2; ++k) dst[m][k] = *(const PG8_LAS bf16x8*)(lds + PG8_SA(b, h) + aoff + m * 2048 + k * 1024); } while (0)
#define PG8_LDB(dst, b, h) do { _Pragma("unroll") for (int n = 0; n < 2; ++n) _Pragma("unroll") for (int k = 0; k < 2; ++k) dst[n][k] = *(const PG8_LAS bf16x8*)(lds + PG8_SB(b, h) + boff + n * 2048 + k * 1024); } while (0)
#define PG8_MMA(ai, bj, At, Bt) do { __builtin_amdgcn_s_setprio(1); _Pragma("unroll") for (int m = 0; m < 4; ++m) _Pragma("unroll") for (int n = 0; n < 2; ++n) _Pragma("unroll") for (int k = 0; k < 2; ++k) \
        acc[ai][bj][m][n] = __builtin_amdgcn_mfma_f32_16x16x32_bf16(Bt[n][k], At[m][k], acc[ai][bj][m][n], 0, 0, 0); __builtin_amdgcn_s_setprio(0); } while (0)
#define PG8_WAIT_V(n) asm volatile("s_waitcnt vmcnt(" #n ")" ::: "memory")
#define PG8_WAIT_L(n) asm volatile("s_waitcnt lgkmcnt(" #n ")" ::: "memory")
#define PG8_BAR __builtin_amdgcn_s_barrier()
#define PG8_SCHED __builtin_amdgcn_sched_barrier(0)
    Unit cur, nxt; int ui = 0;
    if (!S.next(0, cur)) return;
    f32x4 acc[2][2][4][2];
#pragma unroll
    for (int a = 0; a < 2; ++a)
#pragma unroll
        for (int b = 0; b < 2; ++b)
#pragma unroll
            for (int m = 0; m < 4; ++m)
#pragma unroll
                for (int n = 0; n < 2; ++n) acc[a][b][m][n] = (f32x4){0.f, 0.f, 0.f, 0.f};
    bf16x8 At[4][2], B0[2][2], B1[2][2];
    const char* cA = (const char*)g.A + (size_t)cur.pm * tstepA; const char* cB = (const char*)g.Bt + (size_t)cur.pn * tstepB;
    PG8_STAGE(PG8_SB(0, 0), cB, voffB); PG8_STAGE(PG8_SA(0, 0), cA, voffA); PG8_STAGE(PG8_SB(0, 1), cB + hstepB, voffB); PG8_STAGE(PG8_SA(0, 1), cA + hstepA, voffA);
    if (wr == 1) PG8_BAR;
    PG8_WAIT_V(4); PG8_BAR;
    PG8_STAGE(PG8_SB(1, 0), cB + kstep, voffB); PG8_STAGE(PG8_SA(1, 0), cA + kstep, voffA); PG8_STAGE(PG8_SB(1, 1), cB + hstepB + kstep, voffB);
    PG8_WAIT_V(6); PG8_BAR;
    for (;;) {
        const bool has_next = S.next(ui + 1, nxt);
        const char* nA = has_next ? (const char*)g.A + (size_t)nxt.pm * tstepA : cA; const char* nB = has_next ? (const char*)g.Bt + (size_t)nxt.pn * tstepB : cB;
        for (int t = 0; t < nt; t += 2) {
            const bool last = (t == nt - 2);
            const char* a1 = cA + (size_t)(t + 1) * kstep;
            const char* a2 = last ? nA : cA + (size_t)(t + 2) * kstep; const char* b2 = last ? nB : cB + (size_t)(t + 2) * kstep;
            const char* a3 = a2 + kstep; const char* b3 = b2 + kstep;
            PG8_LDB(B0, 0, 0); PG8_SCHED; PG8_LDA(At, 0, 0); PG8_STAGE(PG8_SA(1, 1), a1 + hstepA, voffA);
            PG8_WAIT_L(8); PG8_BAR; PG8_WAIT_L(0); PG8_MMA(0, 0, At, B0); PG8_BAR; PG8_SCHED;
            PG8_LDB(B1, 0, 1); PG8_STAGE(PG8_SB(0, 0), b2, voffB);
            PG8_BAR; PG8_WAIT_L(0); PG8_MMA(0, 1, At, B1); PG8_BAR;
            PG8_LDA(At, 0, 1); PG8_STAGE(PG8_SA(0, 0), a2, voffA);
            PG8_BAR; PG8_WAIT_L(0); PG8_MMA(1, 0, At, B0); PG8_BAR; PG8_SCHED;
            PG8_STAGE(PG8_SB(0, 1), b2 + hstepB, voffB);
            PG8_WAIT_V(6); PG8_BAR; PG8_MMA(1, 1, At, B1); PG8_BAR;
            PG8_LDB(B0, 1, 0); PG8_SCHED; PG8_LDA(At, 1, 0); PG8_STAGE(PG8_SA(0, 1), a2 + hstepA, voffA);
            PG8_WAIT_L(8); PG8_BAR; PG8_WAIT_L(0); PG8_MMA(0, 0, At, B0); PG8_BAR; PG8_SCHED;
            PG8_LDB(B1, 1, 1); PG8_STAGE(PG8_SB(1, 0), b3, voffB);
            PG8_BAR; PG8_WAIT_L(0); PG8_MMA(0, 1, At, B1); PG8_BAR;
            PG8_LDA(At, 1, 1); PG8_STAGE(PG8_SA(1, 0), a3, voffA);
            PG8_BAR; PG8_WAIT_L(0); PG8_MMA(1, 0, At, B0); PG8_BAR; PG8_SCHED;
            PG8_STAGE(PG8_SB(1, 1), b3 + hstepB, voffB);
            PG8_WAIT_V(6); PG8_BAR; PG8_MMA(1, 1, At, B1); PG8_BAR;
        }
        E(acc, cur, wr, wc, fr, fq);
        if (!has_next) break;
#pragma unroll
        for (int a = 0; a < 2; ++a)
#pragma unroll
            for (int b = 0; b < 2; ++b)
#pragma unroll
                for (int m = 0; m < 4; ++m)
#pragma unroll
                    for (int n = 0; n < 2; ++n) acc[a][b][m][n] = (f32x4){0.f, 0.f, 0.f, 0.f};
        cur = nxt; cA = nA; cB = nB; ++ui;
    }
    PG8_WAIT_V(0);
    if (wr == 0) PG8_BAR;
    PG8_BAR;
#undef PG8_SA
#undef PG8_SB
#undef PG8_STAGE
#undef PG8_LDA
#undef PG8_LDB
#undef PG8_MMA
#undef PG8_WAIT_V
#undef PG8_WAIT_L
#undef PG8_BAR
#undef PG8_SCHED
}

__device__ __forceinline__ unsigned f2bf_u(float f) { unsigned u = __builtin_bit_cast(unsigned, f); return (u + 0x7fffu + ((u >> 16) & 1u)) >> 16; }
template <int ACT> struct EpiBf16 {
    bf16_t* O; int ldc;
    __device__ __forceinline__ void operator()(const f32x4 (&acc)[2][2][4][2], const Unit& u, int wr, int wc, int fr, int fq) const {
        const int row0 = u.pm * BM + wr * 64 + fr, col0 = u.pn * BM + wc * 32 + 4 * fq;
#pragma unroll
        for (int ai = 0; ai < 2; ++ai)
#pragma unroll
            for (int m = 0; m < 4; ++m) { bf16_t* rowp = O + (size_t)(row0 + ai * HALF + m * 16) * ldc + col0;
#pragma unroll
                for (int bj = 0; bj < 2; ++bj)
#pragma unroll
                    for (int n = 0; n < 2; ++n) { f32x4 v = acc[ai][bj][m][n];
                        if (ACT == 1) { v.x = v.x > 0.f ? v.x * v.x : 0.f; v.y = v.y > 0.f ? v.y * v.y : 0.f; v.z = v.z > 0.f ? v.z * v.z : 0.f; v.w = v.w > 0.f ? v.w * v.w : 0.f; }
                        u32x2 o; o.x = f2bf_u(v.x) | (f2bf_u(v.y) << 16); o.y = f2bf_u(v.z) | (f2bf_u(v.w) << 16);
                        *(u32x2*)(rowp + bj * HALF + n * 16) = o; } }
    }
};
}
typedef unsigned short bf16_t;
typedef short bf16x8 __attribute__((ext_vector_type(8)));
typedef float f32x4 __attribute__((ext_vector_type(4)));
typedef unsigned u32x4 __attribute__((ext_vector_type(4)));
typedef unsigned u32x2 __attribute__((ext_vector_type(2)));
#define LAS __attribute__((address_space(3)))

constexpr int NBATCH = 8, SEQL = 4096, DM = 1024, CTXL = 256, TMAIN = 32768, TCTX = 2048, TT = 34816, NP = 3072, FF = 4096;
constexpr int PC_SWAQ = 0, PC_RETQ = 256, PC_RWR = 512, PC_MLAQD = 768, PC_SWAK = 1024, PC_SWAV = 1152, PC_RETK = 1280, PC_RETV = 1536, PC_RETG = 1792,
              PC_RWK = 2048, PC_RWV = 2304, PC_RWWD = 2560, PC_RWAD = 2624, PC_RWGD = 2688, PC_MLAKVD = 2816, PC_MLAKPE = 2944;
constexpr int PC_RWO0 = PC_RWV, PC_RWO1 = PC_RWR;
constexpr int NKEYS = CTXL + SEQL;

constexpr size_t MiB = 1u << 20;
constexpr size_t WS_MOD = 0;
constexpr size_t WS_TAB = 512 * 1024;
constexpr size_t WS_CTR = 768 * 1024;
constexpr size_t WS_BON = 1 * MiB;
constexpr size_t WS_WB = 2 * MiB;
constexpr size_t WB_LAYER = 24 * MiB, WB_IN = 0, WB_OUT = 6 * MiB, WB_W1 = 8 * MiB, WB_W2 = 16 * MiB;
constexpr size_t WS_XC = 50 * MiB;
constexpr size_t WS_P = 58 * MiB;
constexpr size_t WS_HID = 58 * MiB;
constexpr size_t WS_A = 262 * MiB;
constexpr size_t ARR17 = 17 * MiB;
constexpr size_t WS_RWK = WS_A, WS_RWV = WS_A + ARR17, WS_RWRR = WS_A + 2 * ARR17, WS_RWA0 = WS_A + 3 * ARR17, WS_RWA1 = WS_A + 4 * ARR17,
                 WS_RWM0 = WS_A + 5 * ARR17, WS_RWM1 = WS_A + 6 * ARR17;
constexpr size_t WS_RET = WS_A + 119 * MiB;
constexpr size_t WS_MQ = WS_RET + 34 * MiB;
constexpr size_t WS_KM = WS_MQ + 26738688;
constexpr size_t WS_VTM = WS_KM + 26738688;
constexpr size_t WS_KS = WS_VTM + ARR17;
constexpr size_t WS_VTS = WS_KS + 8912896;
constexpr size_t WS_A_END = WS_VTS + 8912896;
constexpr size_t WS_Z = 330 * MiB;
constexpr size_t WS_HB = 398 * MiB;
constexpr size_t WS_MLAW = 500 * MiB;
constexpr size_t MLAW_LAYER = 384 * 256 * 2 + 512 * 128 * 2, MLAW_KV = 384 * 256 * 2;
constexpr size_t WS_NEED = 501 * MiB;
static_assert(WS_A_END <= WS_NEED && WS_HB + 68 * MiB <= WS_NEED && WS_HID + 272 * MiB <= WS_Z, "ws map");

constexpr int LDS_BYTES = 150 * 1024;

struct Params { const float* in[30]; float* out; unsigned char* ws; };

__device__ __forceinline__ float bf2f(bf16_t v) { return __builtin_bit_cast(float, (unsigned)v << 16); }
__device__ __forceinline__ bf16_t f2bf(float f) { unsigned u = __builtin_bit_cast(unsigned, f); return (bf16_t)((u + 0x7fffu + ((u >> 16) & 1u)) >> 16); }
__device__ __forceinline__ unsigned pk2(float lo, float hi) { return (unsigned)f2bf(lo) | ((unsigned)f2bf(hi) << 16); }
typedef float f32x2 __attribute__((ext_vector_type(2)));
template <int CTRL> __device__ __forceinline__ float dppf(float v) { return __builtin_bit_cast(float, __builtin_amdgcn_update_dpp(0, __builtin_bit_cast(int, v), CTRL, 0xF, 0xF, true)); }
__device__ __forceinline__ float red4(float v) { v += dppf<0xB1>(v); v += dppf<0x4E>(v); return v; }
__device__ __forceinline__ float red8(float v) { v = red4(v); v += dppf<0x141>(v); return v; }
__device__ __forceinline__ float red16(float v) { v = red8(v); v += dppf<0x140>(v); return v; }
__device__ __forceinline__ float max16(float v) { v = fmaxf(v, dppf<0xB1>(v)); v = fmaxf(v, dppf<0x4E>(v)); v = fmaxf(v, dppf<0x141>(v)); v = fmaxf(v, dppf<0x140>(v)); return v; }
__device__ __forceinline__ float wave_sum(float v) {
    v = red16(v);
    const int u = __builtin_bit_cast(int, v);
    return __builtin_bit_cast(float, __builtin_amdgcn_readlane(u, 0)) + __builtin_bit_cast(float, __builtin_amdgcn_readlane(u, 16)) +
           __builtin_bit_cast(float, __builtin_amdgcn_readlane(u, 32)) + __builtin_bit_cast(float, __builtin_amdgcn_readlane(u, 48));
}
__device__ __forceinline__ void unpack8(const u32x4 u, float* f) {
    f[0] = bf2f((bf16_t)(u.x & 0xffff)); f[1] = bf2f((bf16_t)(u.x >> 16)); f[2] = bf2f((bf16_t)(u.y & 0xffff)); f[3] = bf2f((bf16_t)(u.y >> 16));
    f[4] = bf2f((bf16_t)(u.z & 0xffff)); f[5] = bf2f((bf16_t)(u.z >> 16)); f[6] = bf2f((bf16_t)(u.w & 0xffff)); f[7] = bf2f((bf16_t)(u.w >> 16));
}
__device__ __forceinline__ float sigmoidf_(float x) { return __builtin_amdgcn_rcpf(1.f + __expf(-x)); }

struct SeqInfo { int b, pos, len, start, isctx; };
__device__ __forceinline__ SeqInfo seq_of_row(int row) {
    SeqInfo s;
    if (row < TMAIN) { s.b = row >> 12; s.pos = row & 4095; s.len = SEQL; s.start = s.b << 12; s.isctx = 0; }
    else { const int r = row - TMAIN; s.b = r >> 8; s.pos = r & 255; s.len = CTXL; s.start = TMAIN + (s.b << 8); s.isctx = 1; }
    return s;
}

__device__ __forceinline__ void transpose_item(const float* W, int N, int nsrc0, bf16_t* WT, int K, int ndst0, int k0, LAS float* scr, int lane) {
    if (nsrc0 >= 0) {
#pragma unroll 32
        for (int i = 0; i < 32; ++i) { const int kk = 2 * i + (lane >> 5); scr[kk * 33 + (lane & 31)] = W[(size_t)(k0 + kk) * N + nsrc0 + (lane & 31)]; }
    } else {
#pragma unroll 8
        for (int i = 0; i < 32; ++i) { const int kk = 2 * i + (lane >> 5); scr[kk * 33 + (lane & 31)] = 0.f; }
    }
    __builtin_amdgcn_wave_barrier(); asm volatile("s_waitcnt lgkmcnt(0)" ::: "memory");
    const int c = lane & 7;
#pragma unroll
    for (int j = 0; j < 4; ++j) { const int n = (lane >> 3) + 8 * j; const LAS float* s = scr + (8 * c) * 33 + n;
        u32x4 o; o.x = pk2(s[0 * 33], s[1 * 33]); o.y = pk2(s[2 * 33], s[3 * 33]); o.z = pk2(s[4 * 33], s[5 * 33]); o.w = pk2(s[6 * 33], s[7 * 33]);
        *(u32x4*)(WT + (size_t)(ndst0 + n) * K + k0 + 8 * c) = o; }
    __builtin_amdgcn_wave_barrier(); asm volatile("s_waitcnt lgkmcnt(0)" ::: "memory");
}
__device__ __forceinline__ int win_src_col(int n) {
    if (n < 256) return n;
    if (n < 512) return 512 + (n - 256);
    if (n < 768) return 1536 + (n - 512);
    if (n < 1024) return 2560 + (n - 768);
    if (n < 1280) return 256 + (n - 1024);
    if (n < 2048) return 768 + (n - 1280);
    if (n < 2816) return 1792 + (n - 2048);
    if (n < 2976) return n;
    return -1;
}
__device__ __forceinline__ void phase_prologue(const Params& p, LAS unsigned char* lds, int bid, int nb) {
    const int tid = get_tid(), lane = tid & 63, wave = tid >> 6;
    LAS float* scr = (LAS float*)(lds + wave * 16384);
    const int gw = bid * 8 + wave, NGW = nb * 8;
    constexpr int I_IN = 16 * 96, I_OUT = 16 * 32, I_1 = 16 * 128, I_2 = 64 * 32, I_Q = 4 * 12, I_KV = 2 * 16, I_L = I_IN + I_OUT + I_1 + I_2 + I_Q + I_KV;
    for (int it = gw; it < 2 * I_L; it += NGW) {
        const int l = it / I_L; int r = it % I_L;
        unsigned char* wb = p.ws + WS_WB + (size_t)l * WB_LAYER;
        if (r < I_IN) { const int kb = r / 96, nbk = r % 96; transpose_item(p.in[10] + (size_t)l * DM * 2976, 2976, win_src_col(nbk * 32), (bf16_t*)(wb + WB_IN), DM, nbk * 32, kb * 64, scr, lane); continue; } r -= I_IN;
        if (r < I_OUT) { const int kb = r / 32, nbk = r % 32; transpose_item(p.in[11] + (size_t)l * DM * DM, DM, nbk * 32, (bf16_t*)(wb + WB_OUT), DM, nbk * 32, kb * 64, scr, lane); continue; } r -= I_OUT;
        if (r < I_1) { const int kb = r / 128, nbk = r % 128; transpose_item(p.in[28] + (size_t)l * DM * FF, FF, nbk * 32, (bf16_t*)(wb + WB_W1), DM, nbk * 32, kb * 64, scr, lane); continue; } r -= I_1;
        if (r < I_2) { const int kb = r / 32, nbk = r % 32; transpose_item(p.in[29] + (size_t)l * FF * DM, DM, nbk * 32, (bf16_t*)(wb + WB_W2), FF, nbk * 32, kb * 64, scr, lane); continue; } r -= I_2;
        unsigned char* mw = p.ws + WS_MLAW + (size_t)l * MLAW_LAYER;
        if (r < I_Q) { const int kb = r / 12, nbk = r % 12; transpose_item(p.in[25] + (size_t)l * 256 * 384, 384, nbk * 32, (bf16_t*)mw, 256, nbk * 32, kb * 64, scr, lane); continue; } r -= I_Q;
        { const int kb = r / 16, nbk = r % 16; transpose_item(p.in[27] + (size_t)l * 128 * 512, 512, nbk * 32, (bf16_t*)(mw + MLAW_KV), 128, nbk * 32, kb * 64, scr, lane); }
    }
    __syncthreads();
    for (int it = bid; it < 192; it += nb) {
        const int l = it / 96, cb = it % 96;
        LAS float* sc = (LAS float*)lds;
        LAS float* red = sc + 9 * 1024;
        for (int e = tid; e < 9 * 1024; e += 512) { const int r = e >> 10, k = e & 1023; const float v = (r < 8) ? p.in[1][r * 1024 + k] : p.in[3][k]; sc[e] = v / (1.f + __expf(-v)); }
        __syncthreads();
        const int ks = tid >> 6, cl = tid & 63, n = cb * 64 + cl;
        float acc[9];
#pragma unroll
        for (int r = 0; r < 9; ++r) acc[r] = 0.f;
        const float* aw = p.in[4] + (size_t)l * DM * 6144;
#pragma unroll 16
        for (int k = ks * 128; k < ks * 128 + 128; ++k) { const float w = aw[(size_t)k * 6144 + n];
#pragma unroll
            for (int r = 0; r < 9; ++r) acc[r] += sc[r * 1024 + k] * w; }
#pragma unroll
        for (int r = 0; r < 9; ++r) red[(ks * 9 + r) * 64 + cl] = acc[r];
        __syncthreads();
        for (int e = tid; e < 9 * 64; e += 512) { const int r = e >> 6, c2 = e & 63; float s = 0.f;
            for (int q = 0; q < 8; ++q) s += red[(q * 9 + r) * 64 + c2];
            ((float*)(p.ws + WS_MOD))[((size_t)l * 9 + r) * 6144 + cb * 64 + c2] = s + p.in[5][(size_t)l * 6144 + cb * 64 + c2]; }
        __syncthreads();
    }
    if (bid == 0 && tid < 4) ((unsigned*)(p.ws + WS_CTR))[tid] = 0u;
    if (bid == nb - 1) {
        float* tab = (float*)(p.ws + WS_TAB);
        for (int e = tid; e < 64 * 16; e += 512) { const int pos = e >> 4, f = e & 15; const float inv = powf(10000.f, -(float)(2 * f) / 32.f); const float a = (float)pos * inv; tab[e] = cosf(a); tab[1024 + e] = sinf(a); }
        for (int e = tid; e < 64 * 8; e += 512) { const int pos = e >> 3, f = e & 7; const float inv = powf(10000.f, -(float)(2 * f) / 16.f); const float a = (float)pos * inv; tab[2048 + e] = cosf(a); tab[2560 + e] = sinf(a); }
    }
}

struct RowJob { const float* xsrc; const bf16_t* z; const float* gpost; const float* gate; float* xdst; const float* gpre; const float* shift; const float* scale; bf16_t* hdst; };
__device__ __forceinline__ RowJob make_rowjob(const Params& p, int mode, int l, int row) {
    const float* mod = (const float*)(p.ws + WS_MOD);
    bf16_t* HB = (bf16_t*)(p.ws + WS_HB); const bf16_t* Z = (const bf16_t*)(p.ws + WS_Z);
    float* XC = (float*)(p.ws + WS_XC);
    const SeqInfo s = seq_of_row(row);
    const int mr = s.isctx ? 8 : s.b;
    const float* m_l = mod + ((size_t)l * 9 + mr) * 6144;
    float* xs = s.isctx ? XC + (size_t)(row - TMAIN) * DM : p.out + (size_t)row * DM;
    const float* xin = s.isctx ? p.in[2] + (size_t)(row - TMAIN) * DM : p.in[0] + (size_t)row * DM;
    RowJob j;
    if (mode == 0) { j = RowJob{xin, nullptr, nullptr, nullptr, nullptr, p.in[6] + l * DM, m_l + 0, m_l + 1024, HB + (size_t)row * DM}; }
    else if (mode == 1) { j = RowJob{l == 0 ? xin : xs, Z + (size_t)row * DM, p.in[7] + l * DM, m_l + 2048, xs, p.in[8] + l * DM, m_l + 3072, m_l + 4096, HB + (size_t)row * DM}; }
    else { const bool has_next = (l + 1 < 2); const float* m_n = mod + ((size_t)(has_next ? l + 1 : l) * 9 + mr) * 6144;
        j = RowJob{xs, Z + (size_t)row * DM, p.in[9] + l * DM, m_l + 5120, xs, p.in[6] + (has_next ? l + 1 : l) * DM, m_n + 0, m_n + 1024, has_next ? HB + (size_t)row * DM : nullptr}; }
    return j;
}
template <int RB>
__device__ __forceinline__ void rowop_batch(const RowJob (&jb)[RB], const bool (&valid)[RB], int lane) {
    f32x4 v[RB][4]; u32x2 zu[RB][4];
#pragma unroll
    for (int r = 0; r < RB; ++r) if (valid[r]) {
#pragma unroll
        for (int j = 0; j < 4; ++j) { v[r][j] = *(const f32x4*)(jb[r].xsrc + (j * 64 + lane) * 4); if (jb[r].z) zu[r][j] = *(const u32x2*)(jb[r].z + (j * 64 + lane) * 4); }
    }
#pragma unroll
    for (int r = 0; r < RB; ++r) if (valid[r]) {
        const RowJob& J = jb[r];
        if (J.z) {
            f32x4 zz[4], gp[4], gt[4]; float ss = 0.f;
#pragma unroll
            for (int j = 0; j < 4; ++j) { const int c = (j * 64 + lane) * 4; gp[j] = *(const f32x4*)(J.gpost + c); gt[j] = *(const f32x4*)(J.gate + c); }
#pragma unroll
            for (int j = 0; j < 4; ++j) { const u32x2 u = zu[r][j];
                zz[j].x = bf2f((bf16_t)(u.x & 0xffff)); zz[j].y = bf2f((bf16_t)(u.x >> 16)); zz[j].z = bf2f((bf16_t)(u.y & 0xffff)); zz[j].w = bf2f((bf16_t)(u.y >> 16));
                ss += zz[j].x * zz[j].x + zz[j].y * zz[j].y + zz[j].z * zz[j].z + zz[j].w * zz[j].w; }
            const float rinv = 1.f / sqrtf(wave_sum(ss) * (1.f / 1024.f) + 1e-6f);
#pragma unroll
            for (int j = 0; j < 4; ++j) { const int c = (j * 64 + lane) * 4;
                v[r][j].x += gt[j].x * (zz[j].x * rinv * gp[j].x); v[r][j].y += gt[j].y * (zz[j].y * rinv * gp[j].y); v[r][j].z += gt[j].z * (zz[j].z * rinv * gp[j].z); v[r][j].w += gt[j].w * (zz[j].w * rinv * gp[j].w);
                *(f32x4*)(J.xdst + c) = v[r][j]; }
        }
        if (J.hdst) {
            f32x4 g[4], sh[4], sc[4]; float ss = 0.f;
#pragma unroll
            for (int j = 0; j < 4; ++j) { const int c = (j * 64 + lane) * 4; g[j] = *(const f32x4*)(J.gpre + c); sh[j] = *(const f32x4*)(J.shift + c); sc[j] = *(const f32x4*)(J.scale + c); }
#pragma unroll
            for (int j = 0; j < 4; ++j) ss += v[r][j].x * v[r][j].x + v[r][j].y * v[r][j].y + v[r][j].z * v[r][j].z + v[r][j].w * v[r][j].w;
            const float rinv = 1.f / sqrtf(wave_sum(ss) * (1.f / 1024.f) + 1e-6f);
#pragma unroll
            for (int j = 0; j < 4; ++j) { const int c = (j * 64 + lane) * 4;
                u32x2 o; o.x = pk2(v[r][j].x * rinv * g[j].x * (1.f + sc[j].x) + sh[j].x, v[r][j].y * rinv * g[j].y * (1.f + sc[j].y) + sh[j].y);
                o.y = pk2(v[r][j].z * rinv * g[j].z * (1.f + sc[j].z) + sh[j].z, v[r][j].w * rinv * g[j].w * (1.f + sc[j].w) + sh[j].w);
                *(u32x2*)(J.hdst + c) = o; }
        }
    }
}
__device__ __forceinline__ void phase_rowops(const Params& p, int mode, int l, int nrows, int bid, int nb) {
    const int tid = get_tid(), lane = tid & 63, wave = tid >> 6;
    constexpr int RB = 4;
    const int nwaves = nb * 8, gw = bid * 8 + wave;
    for (int base = gw; base < nrows; base += nwaves * RB) {
        RowJob jb[RB]; bool valid[RB];
#pragma unroll
        for (int r = 0; r < RB; ++r) { const int row = base + r * nwaves; valid[r] = row < nrows; jb[r] = make_rowjob(p, mode, l, valid[r] ? row : 0); }
        rowop_batch<RB>(jb, valid, lane);
    }
}

__device__ __forceinline__ void rwkv_prep_item(const Params& p, int l, LAS unsigned char* lds, int tile) {
    const int tid = get_tid();
    const bf16_t* P = (const bf16_t*)(p.ws + WS_P);
    const int t0 = tile * 32; const SeqInfo s0 = seq_of_row(t0);
    const float* mu = p.in[14] + l * 1024;
    LAS float* r_s = (LAS float*)lds;
    LAS float* k_s = r_s + 32 * 256;
    LAS float* v_s = k_s + 32 * 256;
    LAS float* twd = v_s + 32 * 256;
    LAS float* ad_s = twd + 32 * 64;
#pragma unroll
    for (int it = 0; it < 7; ++it) {
        const int pc = tid + it * 512; const int tok = pc / 112, c8 = pc % 112, cc = c8 * 8;
        const int pcol = cc < 256 ? PC_RWR + cc : PC_RWK + (cc - 256);
        const int row = t0 + tok, pos = s0.pos + tok;
        const u32x4 u0 = *(const u32x4*)(P + (size_t)row * NP + pcol);
        const u32x4 um = pos > 0 ? *(const u32x4*)(P + (size_t)(row - 1) * NP + pcol) : (u32x4){0u, 0u, 0u, 0u};
        const u32x4 up = pos < s0.len - 1 ? *(const u32x4*)(P + (size_t)(row + 1) * NP + pcol) : (u32x4){0u, 0u, 0u, 0u};
        const f32x4 mu0 = *(const f32x4*)(mu + cc), mu1 = *(const f32x4*)(mu + cc + 4);
        float z0[8], zm[8], zp[8], zs[8]; unpack8(u0, z0); unpack8(um, zm); unpack8(up, zp);
        const float mm[8] = {mu0.x, mu0.y, mu0.z, mu0.w, mu1.x, mu1.y, mu1.z, mu1.w};
#pragma unroll
        for (int x = 0; x < 8; ++x) zs[x] = z0[x] + mm[x] * (0.5f * (zm[x] + zp[x]) - z0[x]);
        LAS float* dst;
        if (cc < 256) dst = r_s + tok * 256 + cc;
        else if (cc < 512) dst = k_s + tok * 256 + cc - 256;
        else if (cc < 768) dst = v_s + tok * 256 + cc - 512;
        else if (cc < 832) { dst = twd + tok * 64 + cc - 768;
#pragma unroll
            for (int x = 0; x < 8; ++x) zs[x] = 1.f - 2.f / (1.f + __expf(2.f * zs[x])); }
        else dst = ad_s + tok * 64 + cc - 832;
        *(LAS f32x4*)dst = (f32x4){zs[0], zs[1], zs[2], zs[3]}; *(LAS f32x4*)(dst + 4) = (f32x4){zs[4], zs[5], zs[6], zs[7]};
    }
    __syncthreads();
    const int hh = tid >> 8, c = tid & 255, h = c >> 6;
    float aw0[16], aw1[16], aa0[16], aa1[16];
#pragma unroll
    for (int i = 0; i < 16; ++i) { aw0[i] = 0.f; aw1[i] = 0.f; aa0[i] = 0.f; aa1[i] = 0.f; }
    const float* wup = p.in[16] + (size_t)l * 2 * 64 * 256; const float* aup = p.in[18] + (size_t)l * 2 * 64 * 256;
#pragma unroll 2
    for (int j = 0; j < 64; j += 4) {
        float w0[4], w1[4], a0[4], a1[4];
#pragma unroll
        for (int x = 0; x < 4; ++x) { w0[x] = wup[(j + x) * 256 + c]; w1[x] = wup[64 * 256 + (j + x) * 256 + c]; a0[x] = aup[(j + x) * 256 + c]; a1[x] = aup[64 * 256 + (j + x) * 256 + c]; }
#pragma unroll
        for (int i = 0; i < 16; ++i) { const f32x4 tw = *(const LAS f32x4*)(twd + (hh * 16 + i) * 64 + j), ta = *(const LAS f32x4*)(ad_s + (hh * 16 + i) * 64 + j);
            aw0[i] += tw.x * w0[0] + tw.y * w0[1] + tw.z * w0[2] + tw.w * w0[3]; aw1[i] += tw.x * w1[0] + tw.y * w1[1] + tw.z * w1[2] + tw.w * w1[3];
            aa0[i] += ta.x * a0[0] + ta.y * a0[1] + ta.z * a0[2] + ta.w * a0[3]; aa1[i] += ta.x * a1[0] + ta.y * a1[1] + ta.z * a1[2] + ta.w * a1[3]; }
    }
    const float w0b0 = p.in[15][(l * 2 + 0) * 256 + c], w0b1 = p.in[15][(l * 2 + 1) * 256 + c];
    const float a0b0 = p.in[17][(l * 2 + 0) * 256 + c], a0b1 = p.in[17][(l * 2 + 1) * 256 + c];
    const float ka = p.in[21][l * 256 + c], rk = p.in[22][l * 256 + c];
    bf16_t* RK = (bf16_t*)(p.ws + WS_RWK); bf16_t* RV = (bf16_t*)(p.ws + WS_RWV); bf16_t* RR = (bf16_t*)(p.ws + WS_RWRR);
    bf16_t* RA0 = (bf16_t*)(p.ws + WS_RWA0); bf16_t* RA1 = (bf16_t*)(p.ws + WS_RWA1); bf16_t* RM0 = (bf16_t*)(p.ws + WS_RWM0); bf16_t* RM1 = (bf16_t*)(p.ws + WS_RWM1);
    float* BON = (float*)(p.ws + WS_BON);
#pragma unroll
    for (int i = 0; i < 16; ++i) {
        const int tok = hh * 16 + i, row = t0 + tok;
        const float k = k_s[tok * 256 + c], v = v_s[tok * 256 + c], r = r_s[tok * 256 + c];
        const float sg0 = sigmoidf_(w0b0 + aw0[i]), sg1 = sigmoidf_(w0b1 + aw1[i]);
        const float om0 = 1.f - __expf(-0.60653066f * sg0), om1 = 1.f - __expf(-0.60653066f * sg1);
        const float a0 = sigmoidf_(a0b0 + aa0[i]), a1 = sigmoidf_(a0b1 + aa1[i]);
        const float kt0 = k * (1.f + (a0 - 1.f) * ka), kt1 = k * (1.f + (a1 - 1.f) * ka);
        const float bs = wave_sum(r * (kt0 + kt1) * rk);
        const size_t o = (size_t)row * 256 + c;
        RK[o] = f2bf(k); RV[o] = f2bf(v); RR[o] = f2bf(r); RA0[o] = f2bf(a0); RA1[o] = f2bf(a1); RM0[o] = f2bf(om0); RM1[o] = f2bf(om1);
        if ((tid & 63) == 0) BON[(size_t)row * 4 + h] = bs;
    }
    __syncthreads();
}
__device__ __forceinline__ int ret_chunk_index(int cr, int& b) { if (cr < 256) { b = cr >> 5; return 2 + (cr & 31); } b = (cr - 256) >> 1; return (cr - 256) & 1; }
__device__ __forceinline__ void ret_kv_item(const Params& p, LAS unsigned char* lds, int item) {
    const int tid = get_tid();
    const bf16_t* P = (const bf16_t*)(p.ws + WS_P);
    const int cr = item >> 2, h = item & 3; int b; const int ci = ret_chunk_index(cr, b);
    const int r0 = cr * 128;
    LAS float* Ks = (LAS float*)lds;
    LAS float* Vs = Ks + 128 * 64;
    LAS float* dec = Vs + 128 * 64;
    const float lg = log1pf(-exp2f(-5.f - (float)h));
    for (int e = tid; e < 128 * 64; e += 512) { const int j = e >> 6, d = e & 63;
        Ks[e] = bf2f(P[(size_t)(r0 + j) * NP + PC_RETK + h * 64 + d]) * 0.125f; Vs[e] = bf2f(P[(size_t)(r0 + j) * NP + PC_RETV + h * 64 + d]); }
    if (tid < 128) dec[tid] = expf((float)tid * lg);
    __syncthreads();
    const int d = tid >> 3, e0 = (tid & 7) * 8;
    float af[8], ab[8];
#pragma unroll
    for (int i = 0; i < 8; ++i) { af[i] = 0.f; ab[i] = 0.f; }
    for (int j = 0; j < 128; ++j) { const float kd = Ks[j * 64 + d]; const float kf = kd * dec[127 - j], kb = kd * dec[j];
        const f32x4 v0 = *(const LAS f32x4*)(Vs + j * 64 + e0), v1 = *(const LAS f32x4*)(Vs + j * 64 + e0 + 4);
        af[0] += kf * v0.x; af[1] += kf * v0.y; af[2] += kf * v0.z; af[3] += kf * v0.w; af[4] += kf * v1.x; af[5] += kf * v1.y; af[6] += kf * v1.z; af[7] += kf * v1.w;
        ab[0] += kb * v0.x; ab[1] += kb * v0.y; ab[2] += kb * v0.z; ab[3] += kb * v0.w; ab[4] += kb * v1.x; ab[5] += kb * v1.y; ab[6] += kb * v1.z; ab[7] += kb * v1.w; }
    float* RS = (float*)(p.ws + WS_RET) + ((size_t)((b * 4 + h) * 34 + ci) * 2) * 4096;
#pragma unroll
    for (int i = 0; i < 8; ++i) { RS[d * 64 + e0 + i] = af[i]; RS[4096 + d * 64 + e0 + i] = ab[i]; }
    __syncthreads();
}
__device__ __forceinline__ void swa_prep_item(const Params& p, LAS unsigned char* lds, int tile) {
    const int tid = get_tid();
    bf16_t* P = (bf16_t*)(p.ws + WS_P);
    const float* tabc = (const float*)(p.ws + WS_TAB); const float* tabs = tabc + 1024;
    bf16_t* KS = (bf16_t*)(p.ws + WS_KS); bf16_t* VT = (bf16_t*)(p.ws + WS_VTS);
    const int t0 = tile * 64; const SeqInfo s0 = seq_of_row(t0);
    const int key0 = s0.isctx ? s0.pos : CTXL + s0.pos;
    LAS bf16_t* Vs = (LAS bf16_t*)lds;
    u32x4 vreg[2];
#pragma unroll
    for (int it = 0; it < 2; ++it) { const int pc = tid + it * 512, tok = pc >> 4, c8 = pc & 15; vreg[it] = *(const u32x4*)(P + (size_t)(t0 + tok) * NP + PC_SWAV + c8 * 8); }
    u32x4 x1[3], x2[3];
#pragma unroll
    for (int it = 0; it < 3; ++it) { const int e = tid + it * 512; const int tok = e / 24, rem = e % 24, hd = rem >> 2, axis = (rem >> 1) & 1, fg = rem & 1;
        const int colbase = (hd < 4 ? PC_SWAQ + hd * 64 : PC_SWAK + (hd - 4) * 64) + axis * 32 + fg * 8;
        x1[it] = *(const u32x4*)(P + (size_t)(t0 + tok) * NP + colbase); x2[it] = *(const u32x4*)(P + (size_t)(t0 + tok) * NP + colbase + 16); }
#pragma unroll
    for (int it = 0; it < 2; ++it) { const int pc = tid + it * 512, tok = pc >> 4, c8 = pc & 15; *(LAS u32x4*)(Vs + tok * 136 + c8 * 8) = vreg[it]; }
#pragma unroll
    for (int it = 0; it < 3; ++it) { const int e = tid + it * 512; const int tok = e / 24, rem = e % 24, hd = rem >> 2, axis = (rem >> 1) & 1, fg = rem & 1;
        const int row = t0 + tok, pos = s0.pos + tok;
        const int colbase = (hd < 4 ? PC_SWAQ + hd * 64 : PC_SWAK + (hd - 4) * 64) + axis * 32 + fg * 8;
        float a[8], bb[8]; unpack8(x1[it], a); unpack8(x2[it], bb);
        if (!s0.isctx) { const int pp = axis == 0 ? (pos >> 6) : (pos & 63);
            const f32x4 c0 = *(const f32x4*)(tabc + pp * 16 + fg * 8), c1 = *(const f32x4*)(tabc + pp * 16 + fg * 8 + 4), s0v = *(const f32x4*)(tabs + pp * 16 + fg * 8), s1v = *(const f32x4*)(tabs + pp * 16 + fg * 8 + 4);
            const float cs[8] = {c0.x, c0.y, c0.z, c0.w, c1.x, c1.y, c1.z, c1.w}, sn[8] = {s0v.x, s0v.y, s0v.z, s0v.w, s1v.x, s1v.y, s1v.z, s1v.w};
#pragma unroll
            for (int x = 0; x < 8; ++x) { const float y1 = a[x] * cs[x] - bb[x] * sn[x], y2 = bb[x] * cs[x] + a[x] * sn[x]; a[x] = y1; bb[x] = y2; } }
        u32x4 o1, o2; o1.x = pk2(a[0], a[1]); o1.y = pk2(a[2], a[3]); o1.z = pk2(a[4], a[5]); o1.w = pk2(a[6], a[7]);
        o2.x = pk2(bb[0], bb[1]); o2.y = pk2(bb[2], bb[3]); o2.z = pk2(bb[4], bb[5]); o2.w = pk2(bb[6], bb[7]);
        if (hd < 4) { if (!s0.isctx) { *(u32x4*)(P + (size_t)row * NP + colbase) = o1; *(u32x4*)(P + (size_t)row * NP + colbase + 16) = o2; } }
        else { bf16_t* kd = KS + ((size_t)(s0.b * 2 + (hd - 4)) * NKEYS + key0 + tok) * 64 + axis * 32 + fg * 8; *(u32x4*)kd = o1; *(u32x4*)(kd + 16) = o2; }
    }
    __syncthreads();
#pragma unroll
    for (int it = 0; it < 2; ++it) { const int pc = tid + it * 512, hd = pc >> 3, k8 = pc & 7, hk = hd >> 6, d = hd & 63;
        unsigned w[4];
#pragma unroll
        for (int x = 0; x < 4; ++x) w[x] = (unsigned)Vs[(k8 * 8 + 2 * x) * 136 + hd] | ((unsigned)Vs[(k8 * 8 + 2 * x + 1) * 136 + hd] << 16);
        *(u32x4*)(VT + ((size_t)(s0.b * 2 + hk) * 64 + d) * NKEYS + key0 + k8 * 8) = (u32x4){w[0], w[1], w[2], w[3]}; }
    __syncthreads();
}
__device__ __forceinline__ void mla_proj_item(const Params& p, int l, LAS unsigned char* lds, int tile);
__device__ __forceinline__ void phase_prepA(const Params& p, int l, LAS unsigned char* lds, int bid, int nb) {
    constexpr int N1 = TT / 32, N2 = 272 * 4, N3 = TT / 64, N4 = TT / 32;
    for (int it = bid; it < N1 + N2 + N3 + N4; it += nb) {
        if (it < N1) rwkv_prep_item(p, l, lds, it);
        else if (it < N1 + N2) ret_kv_item(p, lds, it - N1);
        else if (it < N1 + N2 + N3) swa_prep_item(p, lds, it - N1 - N2);
        else mla_proj_item(p, l, lds, it - N1 - N2 - N3);
    }
}

__device__ __forceinline__ void mla_proj_item(const Params& p, int l, LAS unsigned char* lds, int tile) {
    const int tid = get_tid(), lane = tid & 63, wave = tid >> 6, fr = lane & 15, fq = lane >> 4;
    const bf16_t* P = (const bf16_t*)(p.ws + WS_P);
    const float* tabc = (const float*)(p.ws + WS_TAB) + 2048; const float* tabs = tabc + 512;
    const int t0 = tile * 32; const SeqInfo s0 = seq_of_row(t0);
    const int key0 = s0.isctx ? s0.pos : CTXL + s0.pos;
    LAS unsigned char* qn = lds;
    LAS unsigned char* kvn = lds + 32 * 528;
    LAS float* qo = (LAS float*)(lds + 32 * 528 + 32 * 272);
    LAS float* kvo = qo + 32 * 384;
    const float* qg = p.in[24] + l * 256; const float* kvg = p.in[26] + l * 128;
    for (int i = 0; i < 4; ++i) { const int tok = wave * 4 + i, row = t0 + tok;
        float x[4]; float ss = 0.f;
#pragma unroll
        for (int j = 0; j < 4; ++j) { x[j] = bf2f(P[(size_t)row * NP + PC_MLAQD + j * 64 + lane]); ss += x[j] * x[j]; }
        const float rq = 1.f / sqrtf(wave_sum(ss) * (1.f / 256.f) + 1e-6f);
#pragma unroll
        for (int j = 0; j < 4; ++j) *(LAS bf16_t*)(qn + tok * 528 + (j * 64 + lane) * 2) = f2bf(x[j] * rq * qg[j * 64 + lane]);
        float y[2]; float s2 = 0.f;
#pragma unroll
        for (int j = 0; j < 2; ++j) { y[j] = bf2f(P[(size_t)row * NP + PC_MLAKVD + j * 64 + lane]); s2 += y[j] * y[j]; }
        const float rk = 1.f / sqrtf(wave_sum(s2) * (1.f / 128.f) + 1e-6f);
#pragma unroll
        for (int j = 0; j < 2; ++j) *(LAS bf16_t*)(kvn + tok * 272 + (j * 64 + lane) * 2) = f2bf(y[j] * rk * kvg[j * 64 + lane]);
    }
    __syncthreads();
    {
        const bf16_t* WqT = (const bf16_t*)(p.ws + WS_MLAW + (size_t)l * MLAW_LAYER);
        const bf16_t* WkvT = (const bf16_t*)(p.ws + WS_MLAW + (size_t)l * MLAW_LAYER + MLAW_KV);
        for (int nt = wave; nt < 56; nt += 8) {
            f32x4 a0 = (f32x4){0.f, 0.f, 0.f, 0.f}, a1 = a0;
            if (nt < 24) {
                const bf16_t* wrow = WqT + (size_t)(nt * 16 + fr) * 256 + fq * 8;
#pragma unroll
                for (int kc = 0; kc < 8; ++kc) { const bf16x8 bfr = *(const bf16x8*)(wrow + kc * 32);
                    const bf16x8 x0 = *(const LAS bf16x8*)(qn + fr * 528 + kc * 64 + fq * 16), x1 = *(const LAS bf16x8*)(qn + (16 + fr) * 528 + kc * 64 + fq * 16);
                    a0 = __builtin_amdgcn_mfma_f32_16x16x32_bf16(x0, bfr, a0, 0, 0, 0); a1 = __builtin_amdgcn_mfma_f32_16x16x32_bf16(x1, bfr, a1, 0, 0, 0); }
#pragma unroll
                for (int r = 0; r < 4; ++r) { qo[(fq * 4 + r) * 384 + nt * 16 + fr] = a0[r]; qo[(16 + fq * 4 + r) * 384 + nt * 16 + fr] = a1[r]; }
            } else {
                const int n0 = (nt - 24) * 16;
                const bf16_t* wrow = WkvT + (size_t)(n0 + fr) * 128 + fq * 8;
#pragma unroll
                for (int kc = 0; kc < 4; ++kc) { const bf16x8 bfr = *(const bf16x8*)(wrow + kc * 32);
                    const bf16x8 x0 = *(const LAS bf16x8*)(kvn + fr * 272 + kc * 64 + fq * 16), x1 = *(const LAS bf16x8*)(kvn + (16 + fr) * 272 + kc * 64 + fq * 16);
                    a0 = __builtin_amdgcn_mfma_f32_16x16x32_bf16(x0, bfr, a0, 0, 0, 0); a1 = __builtin_amdgcn_mfma_f32_16x16x32_bf16(x1, bfr, a1, 0, 0, 0); }
#pragma unroll
                for (int r = 0; r < 4; ++r) { kvo[(fq * 4 + r) * 512 + n0 + fr] = a0[r]; kvo[(16 + fq * 4 + r) * 512 + n0 + fr] = a1[r]; }
            }
        }
    }
    __syncthreads();
    {
        const int h = tid >> 7, dd = tid & 127;
        if (dd < 64) { bf16_t* KM = (bf16_t*)(p.ws + WS_KM) + ((size_t)(s0.b * 4 + h) * NKEYS + key0) * 96 + dd;
#pragma unroll
            for (int i = 0; i < 32; ++i) KM[(size_t)i * 96] = f2bf(kvo[i * 512 + tid]); }
        else { bf16_t* VT = (bf16_t*)(p.ws + WS_VTM) + ((size_t)(s0.b * 4 + h) * 64 + (dd - 64)) * NKEYS + key0;
            unsigned w[16];
#pragma unroll
            for (int i = 0; i < 16; ++i) w[i] = pk2(kvo[(2 * i) * 512 + tid], kvo[(2 * i + 1) * 512 + tid]);
#pragma unroll
            for (int i = 0; i < 4; ++i) *(u32x4*)(VT + i * 8) = (u32x4){w[4 * i], w[4 * i + 1], w[4 * i + 2], w[4 * i + 3]}; }
    }
    bf16_t* MQ = (bf16_t*)(p.ws + WS_MQ);
    for (int e = tid; e < 32 * 384; e += 512) { const int tok = e / 384, c = e % 384, dd = c % 96; const int pos = s0.pos + tok;
        float v = qo[e];
        if (dd >= 64 && !s0.isctx) { const int pe = dd - 64, axis = pe >> 4, half = (pe >> 3) & 1, f = pe & 7; const int pp = axis == 0 ? (pos >> 6) : (pos & 63);
            const float cs = tabc[pp * 8 + f], sn = tabs[pp * 8 + f];
            const float x1 = half ? qo[e - 8] : v, x2 = half ? v : qo[e + 8];
            v = half ? (x2 * cs + x1 * sn) : (x1 * cs - x2 * sn); }
        MQ[(size_t)(t0 + tok) * 384 + c] = f2bf(v); }
    for (int e = tid; e < 32 * 32; e += 512) { const int tok = e >> 5, pe = e & 31, axis = pe >> 4, half = (pe >> 3) & 1, f = pe & 7; const int row = t0 + tok, pos = s0.pos + tok;
        float v = bf2f(P[(size_t)row * NP + PC_MLAKPE + pe]);
        if (!s0.isctx) { const int pp = axis == 0 ? (pos >> 6) : (pos & 63); const float cs = tabc[pp * 8 + f], sn = tabs[pp * 8 + f];
            const float other = bf2f(P[(size_t)row * NP + PC_MLAKPE + (half ? pe - 8 : pe + 8)]);
            const float x1 = half ? other : v, x2 = half ? v : other;
            v = half ? (x2 * cs + x1 * sn) : (x1 * cs - x2 * sn); }
        const bf16_t o = f2bf(v);
#pragma unroll
        for (int h = 0; h < 4; ++h) ((bf16_t*)(p.ws + WS_KM))[((size_t)(s0.b * 4 + h) * NKEYS + key0 + tok) * 96 + 64 + pe] = o; }
    __syncthreads();
}
__device__ __forceinline__ void ret_scan_item(const Params& p, int l, int item) {
    const int tid = get_tid(); const int seq = item >> 1, dir = item & 1, h = seq & 3;
    const float lg = log1pf(-exp2f(-5.f - (float)h)); const float cdec = expf(128.f * lg);
    float* base = (float*)(p.ws + WS_RET) + (size_t)seq * 34 * 2 * 4096 + dir * 4096;
    auto ci_of = [&](int st) -> int { return dir == 0 ? st : (st == 0 ? 1 : (st == 1 ? 0 : 35 - st)); };
    float S[8];
#pragma unroll
    for (int i = 0; i < 8; ++i) S[i] = 0.f;
    f32x4 pa[4], pb[4];
#pragma unroll
    for (int k = 0; k < 4; ++k) { const float* q = base + (size_t)ci_of(k) * 2 * 4096 + tid * 8; pa[k] = *(const f32x4*)q; pb[k] = *(const f32x4*)(q + 4); }
#pragma unroll 1
    for (int st0 = 0; st0 < 36; st0 += 4) {
#pragma unroll
        for (int k = 0; k < 4; ++k) { const int st = st0 + k;
            if (st < 34) {
                float* q = base + (size_t)ci_of(st) * 2 * 4096 + tid * 8;
                const f32x4 t0 = pa[k], t1 = pb[k];
                if (st + 4 < 34) { const float* qn = base + (size_t)ci_of(st + 4) * 2 * 4096 + tid * 8; pa[k] = *(const f32x4*)qn; pb[k] = *(const f32x4*)(qn + 4); }
                *(f32x4*)q = (f32x4){S[0], S[1], S[2], S[3]}; *(f32x4*)(q + 4) = (f32x4){S[4], S[5], S[6], S[7]};
                S[0] = S[0] * cdec + t0.x; S[1] = S[1] * cdec + t0.y; S[2] = S[2] * cdec + t0.z; S[3] = S[3] * cdec + t0.w;
                S[4] = S[4] * cdec + t1.x; S[5] = S[5] * cdec + t1.y; S[6] = S[6] * cdec + t1.z; S[7] = S[7] * cdec + t1.w;
            } }
    }
    asm volatile("s_waitcnt vmcnt(0)" ::: "memory");
    __syncthreads();
    if (tid == 0) { __builtin_amdgcn_fence(__ATOMIC_RELEASE, "agent"); asm volatile("s_waitcnt vmcnt(0)" ::: "memory");
        __hip_atomic_fetch_add((unsigned*)(p.ws + WS_CTR) + 2 + l, 1u, __ATOMIC_RELAXED, __HIP_MEMORY_SCOPE_AGENT); }
}
__device__ __forceinline__ void ret_wait_states(const Params& p, int l) {
    if (get_tid() == 0) { unsigned* f = (unsigned*)(p.ws + WS_CTR) + 2 + l; unsigned sp = 0;
        while (__hip_atomic_load(f, __ATOMIC_RELAXED, __HIP_MEMORY_SCOPE_AGENT) < 64u) { __builtin_amdgcn_s_sleep(4); if (++sp > (1u << 22)) break; }
        __builtin_amdgcn_fence(__ATOMIC_ACQUIRE, "agent"); asm volatile("s_waitcnt vmcnt(0)" ::: "memory"); }
    __syncthreads();
}
typedef __bf16 bf16x2_t __attribute__((ext_vector_type(2)));
__device__ __forceinline__ unsigned cvt_pk_bf16(float lo, float hi) { const f32x2 v = {lo, hi}; return __builtin_bit_cast(unsigned, __builtin_convertvector(v, bf16x2_t)); }
template <int DK>
__device__ __forceinline__ void attn_unit(const bf16_t* Q, int qstride, const bf16_t* K, const bf16_t* Vt, int nctx, int mt0, int mt1, bool masked, int qpos0,
                                          bool has_sink, float sink, float scale, bf16_t* O, int ostride, LAS unsigned char* lds) {
    constexpr int KC = DK / 32, KP = DK + 8, KROW = KP * 2;
    constexpr int PIECES_K = 64 * DK / 8;
    constexpr int BUFB = 64 * KROW + 64 * 144;
    const int tid = get_tid(), lane = tid & 63, wave = tid >> 6, fr = lane & 15, fq = lane >> 4;
    const float sl2 = scale * 1.44269504f;
    bf16x8 qf[2][KC];
#pragma unroll
    for (int g = 0; g < 2; ++g)
#pragma unroll
        for (int kc = 0; kc < KC; ++kc) { const u32x4 u = *(const u32x4*)(Q + (size_t)(wave * 32 + g * 16 + fr) * qstride + kc * 32 + fq * 8); float f[8]; unpack8(u, f);
            u32x4 o; o.x = cvt_pk_bf16(f[0] * sl2, f[1] * sl2); o.y = cvt_pk_bf16(f[2] * sl2, f[3] * sl2); o.z = cvt_pk_bf16(f[4] * sl2, f[5] * sl2); o.w = cvt_pk_bf16(f[6] * sl2, f[7] * sl2);
            qf[g][kc] = __builtin_bit_cast(bf16x8, o); }
    float mq[2] = {0.f, 0.f}, lsum[2] = {0.f, 0.f}; f32x4 o[2][4];
#pragma unroll
    for (int g = 0; g < 2; ++g)
#pragma unroll
        for (int n = 0; n < 4; ++n) o[g][n] = (f32x4){0.f, 0.f, 0.f, 0.f};
    const int ntiles = nctx + (mt1 - mt0);
    u32x4 kr[2], vr;
    auto issue = [&](int ti) {
        const int tile = ti < nctx ? ti : mt0 + (ti - nctx);
        const bf16_t* kb = K + (size_t)tile * 64 * DK;
#pragma unroll
        for (int i = 0; i < 2; ++i) { const int pc = tid + i * 512; if (pc < PIECES_K) kr[i] = *(const u32x4*)(kb + (size_t)pc * 8); }
        { const int d = tid >> 3, c8 = tid & 7; vr = *(const u32x4*)(Vt + (size_t)d * NKEYS + tile * 64 + c8 * 8); }
    };
    auto stash = [&](int bufi) {
        LAS unsigned char* Kt = lds + bufi * BUFB; LAS unsigned char* Vl = Kt + 64 * KROW;
#pragma unroll
        for (int i = 0; i < 2; ++i) { const int pc = tid + i * 512; if (pc < PIECES_K) { const int row = pc / (DK / 8), c8 = pc % (DK / 8); *(LAS u32x4*)(Kt + row * KROW + c8 * 16) = kr[i]; } }
        { const int d = tid >> 3, c8 = tid & 7; *(LAS u32x4*)(Vl + d * 144 + c8 * 16) = vr; }
    };
    issue(0); stash(0);
    if (ntiles > 1) issue(1);
    __syncthreads();
    for (int ti = 0; ti < ntiles; ++ti) {
        const int tile = ti < nctx ? ti : mt0 + (ti - nctx);
        LAS unsigned char* Kt = lds + (ti & 1) * BUFB; LAS unsigned char* Vl = Kt + 64 * KROW;
        if (ti + 1 < ntiles) { stash((ti + 1) & 1); if (ti + 2 < ntiles) issue(ti + 2); }
        f32x4 s[2][4];
#pragma unroll
        for (int n = 0; n < 4; ++n) {
            s[0][n] = (f32x4){-mq[0], -mq[0], -mq[0], -mq[0]}; s[1][n] = (f32x4){-mq[1], -mq[1], -mq[1], -mq[1]};
#pragma unroll
            for (int kc = 0; kc < KC; ++kc) { const bf16x8 kf = *(const LAS bf16x8*)(Kt + (n * 16 + fr) * KROW + kc * 64 + fq * 16);
                s[0][n] = __builtin_amdgcn_mfma_f32_16x16x32_bf16(kf, qf[0][kc], s[0][n], 0, 0, 0);
                s[1][n] = __builtin_amdgcn_mfma_f32_16x16x32_bf16(kf, qf[1][kc], s[1][n], 0, 0, 0); } }
        if (ti == 0) {
#pragma unroll
            for (int g = 0; g < 2; ++g) {
                float t = -INFINITY;
#pragma unroll
                for (int n = 0; n < 4; ++n)
#pragma unroll
                    for (int r = 0; r < 4; ++r) t = fmaxf(t, s[g][n][r]);
                t = fmaxf(t, __shfl_xor(t, 16)); t = fmaxf(t, __shfl_xor(t, 32));
                if (has_sink) t = fmaxf(t, sink * 1.44269504f);
                mq[g] = t;
#pragma unroll
                for (int n = 0; n < 4; ++n)
#pragma unroll
                    for (int r = 0; r < 4; ++r) s[g][n][r] -= t;
            }
        }
        if (masked && ti >= nctx) {
#pragma unroll
            for (int g = 0; g < 2; ++g)
#pragma unroll
                for (int n = 0; n < 4; ++n)
#pragma unroll
                    for (int r = 0; r < 4; ++r) { const int kp = tile * 64 + n * 16 + fq * 4 + r - CTXL, qp = qpos0 + wave * 32 + g * 16 + fr; const int df = qp - kp; if (df > 128 || df < -128) s[g][n][r] = -INFINITY; }
        }
#pragma unroll
        for (int g = 0; g < 2; ++g)
#pragma unroll
            for (int n = 0; n < 4; ++n)
#pragma unroll
                for (int r = 0; r < 4; ++r) { s[g][n][r] = __builtin_amdgcn_exp2f(s[g][n][r]); lsum[g] += s[g][n][r]; }
#pragma unroll
        for (int c = 0; c < 2; ++c) {
            bf16x8 pf[2];
#pragma unroll
            for (int g = 0; g < 2; ++g) { u32x4 pu; pu.x = cvt_pk_bf16(s[g][2 * c][0], s[g][2 * c][1]); pu.y = cvt_pk_bf16(s[g][2 * c][2], s[g][2 * c][3]);
                pu.z = cvt_pk_bf16(s[g][2 * c + 1][0], s[g][2 * c + 1][1]); pu.w = cvt_pk_bf16(s[g][2 * c + 1][2], s[g][2 * c + 1][3]); pf[g] = __builtin_bit_cast(bf16x8, pu); }
#pragma unroll
            for (int n = 0; n < 4; ++n) {
                const u32x2 lo = *(const LAS u32x2*)(Vl + (n * 16 + fr) * 144 + ((2 * c) * 16 + fq * 4) * 2), hi = *(const LAS u32x2*)(Vl + (n * 16 + fr) * 144 + ((2 * c + 1) * 16 + fq * 4) * 2);
                const bf16x8 vf = __builtin_bit_cast(bf16x8, (u32x4){lo.x, lo.y, hi.x, hi.y});
                o[0][n] = __builtin_amdgcn_mfma_f32_16x16x32_bf16(vf, pf[0], o[0][n], 0, 0, 0);
                o[1][n] = __builtin_amdgcn_mfma_f32_16x16x32_bf16(vf, pf[1], o[1][n], 0, 0, 0); }
        }
        __syncthreads();
    }
#pragma unroll
    for (int g = 0; g < 2; ++g) {
        float t = lsum[g];
        t += __shfl_xor(t, 16); t += __shfl_xor(t, 32);
        if (has_sink) t += __builtin_amdgcn_exp2f(sink * 1.44269504f - mq[g]);
        const float inv = 1.f / t;
#pragma unroll
        for (int n = 0; n < 4; ++n) { u32x2 ov; ov.x = cvt_pk_bf16(o[g][n][0] * inv, o[g][n][1] * inv); ov.y = cvt_pk_bf16(o[g][n][2] * inv, o[g][n][3] * inv);
            *(u32x2*)(O + (size_t)(wave * 32 + g * 16 + fr) * ostride + n * 16 + fq * 4) = ov; }
    }
}

__device__ __forceinline__ void ret_out_item(const Params& p, int l, LAS unsigned char* lds, int item) {
    const int tid = get_tid(), lane = tid & 63, wave = tid >> 6, fr = lane & 15, fq = lane >> 4;
    bf16_t* P = (bf16_t*)(p.ws + WS_P);
    const int cr = item >> 2, h = item & 3; int b; const int ci = ret_chunk_index(cr, b);
    const int r0 = cr * 128;
    const float lg2 = log1pf(-exp2f(-5.f - (float)h)) * 1.44269504f;
    LAS unsigned char* Kb = lds;
    LAS unsigned char* Vt = lds + 18432;
    LAS unsigned char* SfT = lds + 35840;
    LAS unsigned char* SbT = lds + 45056;
    for (int pc = tid; pc < 1024; pc += 512) { const int j = pc >> 3, c8 = pc & 7;
        const u32x4 kk = *(const u32x4*)(P + (size_t)(r0 + j) * NP + PC_RETK + h * 64 + c8 * 8);
        const u32x4 vv = *(const u32x4*)(P + (size_t)(r0 + j) * NP + PC_RETV + h * 64 + c8 * 8);
        float kf[8]; unpack8(kk, kf);
        u32x4 ko; ko.x = pk2(kf[0] * 0.125f, kf[1] * 0.125f); ko.y = pk2(kf[2] * 0.125f, kf[3] * 0.125f); ko.z = pk2(kf[4] * 0.125f, kf[5] * 0.125f); ko.w = pk2(kf[6] * 0.125f, kf[7] * 0.125f);
        *(LAS u32x4*)(Kb + j * 144 + c8 * 16) = ko;
        const unsigned vw[4] = {vv.x, vv.y, vv.z, vv.w};
#pragma unroll
        for (int x = 0; x < 8; ++x) *(LAS bf16_t*)(Vt + (c8 * 8 + x) * 272 + j * 2) = (bf16_t)((x & 1) ? (vw[x >> 1] >> 16) : (vw[x >> 1] & 0xffff)); }
    { const float* RS = (const float*)(p.ws + WS_RET) + ((size_t)((b * 4 + h) * 34 + ci) * 2) * 4096;
      for (int pc = tid; pc < 1024; pc += 512) { const int d = pc >> 4, e4 = (pc & 15) * 4;
          const f32x4 a = *(const f32x4*)(RS + d * 64 + e4), bb = *(const f32x4*)(RS + 4096 + d * 64 + e4);
#pragma unroll
          for (int x = 0; x < 4; ++x) { *(LAS bf16_t*)(SfT + (e4 + x) * 144 + d * 2) = f2bf(a[x]); *(LAS bf16_t*)(SbT + (e4 + x) * 144 + d * 2) = f2bf(bb[x]); } } }
    const int i = wave * 16 + fr;
    u32x4 qraw[2];
#pragma unroll
    for (int kc = 0; kc < 2; ++kc) qraw[kc] = *(const u32x4*)(P + (size_t)(r0 + i) * NP + PC_RETQ + h * 64 + kc * 32 + fq * 8);
    __syncthreads();
    f32x4 s[8];
#pragma unroll
    for (int nb = 0; nb < 8; ++nb) { s[nb] = (f32x4){0.f, 0.f, 0.f, 0.f};
#pragma unroll
        for (int kc = 0; kc < 2; ++kc) { const bf16x8 kf = *(const LAS bf16x8*)(Kb + (nb * 16 + fr) * 144 + kc * 64 + fq * 16);
            s[nb] = __builtin_amdgcn_mfma_f32_16x16x32_bf16(kf, __builtin_bit_cast(bf16x8, qraw[kc]), s[nb], 0, 0, 0); } }
#pragma unroll
    for (int nb = 0; nb < 8; ++nb)
#pragma unroll
        for (int r = 0; r < 4; ++r) { const int j = nb * 16 + fq * 4 + r; const int df = i - j; const int adf = df < 0 ? -df : df;
            float dcy = __builtin_amdgcn_exp2f((float)adf * lg2); if (df == 0) dcy = 2.f; s[nb][r] *= dcy; }
    f32x4 o[4];
#pragma unroll
    for (int n = 0; n < 4; ++n) o[n] = (f32x4){0.f, 0.f, 0.f, 0.f};
#pragma unroll
    for (int c = 0; c < 4; ++c) {
        u32x4 pu; pu.x = cvt_pk_bf16(s[2 * c][0], s[2 * c][1]); pu.y = cvt_pk_bf16(s[2 * c][2], s[2 * c][3]); pu.z = cvt_pk_bf16(s[2 * c + 1][0], s[2 * c + 1][1]); pu.w = cvt_pk_bf16(s[2 * c + 1][2], s[2 * c + 1][3]);
        const bf16x8 pf = __builtin_bit_cast(bf16x8, pu);
#pragma unroll
        for (int n = 0; n < 4; ++n) {
            const u32x2 lo = *(const LAS u32x2*)(Vt + (n * 16 + fr) * 272 + ((2 * c) * 16 + fq * 4) * 2), hi = *(const LAS u32x2*)(Vt + (n * 16 + fr) * 272 + ((2 * c + 1) * 16 + fq * 4) * 2);
            const bf16x8 vf = __builtin_bit_cast(bf16x8, (u32x4){lo.x, lo.y, hi.x, hi.y});
            o[n] = __builtin_amdgcn_mfma_f32_16x16x32_bf16(vf, pf, o[n], 0, 0, 0); }
    }
    const float gf = __builtin_amdgcn_exp2f((float)(i + 1) * lg2), gb = __builtin_amdgcn_exp2f((float)(128 - i) * lg2);
#pragma unroll
    for (int kc = 0; kc < 2; ++kc) {
        float f[8]; unpack8(qraw[kc], f);
        u32x4 uf, ub;
        uf.x = cvt_pk_bf16(f[0] * gf, f[1] * gf); uf.y = cvt_pk_bf16(f[2] * gf, f[3] * gf); uf.z = cvt_pk_bf16(f[4] * gf, f[5] * gf); uf.w = cvt_pk_bf16(f[6] * gf, f[7] * gf);
        ub.x = cvt_pk_bf16(f[0] * gb, f[1] * gb); ub.y = cvt_pk_bf16(f[2] * gb, f[3] * gb); ub.z = cvt_pk_bf16(f[4] * gb, f[5] * gb); ub.w = cvt_pk_bf16(f[6] * gb, f[7] * gb);
        const bf16x8 qF = __builtin_bit_cast(bf16x8, uf), qB = __builtin_bit_cast(bf16x8, ub);
#pragma unroll
        for (int n = 0; n < 4; ++n) {
            const bf16x8 af = *(const LAS bf16x8*)(SfT + (n * 16 + fr) * 144 + kc * 64 + fq * 16), ab = *(const LAS bf16x8*)(SbT + (n * 16 + fr) * 144 + kc * 64 + fq * 16);
            o[n] = __builtin_amdgcn_mfma_f32_16x16x32_bf16(af, qF, o[n], 0, 0, 0);
            o[n] = __builtin_amdgcn_mfma_f32_16x16x32_bf16(ab, qB, o[n], 0, 0, 0); }
    }
    float sm = 0.f;
#pragma unroll
    for (int n = 0; n < 4; ++n) sm += (o[n][0] + o[n][1]) + (o[n][2] + o[n][3]);
    sm += __shfl_xor(sm, 16); sm += __shfl_xor(sm, 32);
    const float mu = sm * (1.f / 64.f);
    float vs = 0.f;
#pragma unroll
    for (int n = 0; n < 4; ++n)
#pragma unroll
        for (int r = 0; r < 4; ++r) { const float dl = o[n][r] - mu; vs += dl * dl; }
    vs += __shfl_xor(vs, 16); vs += __shfl_xor(vs, 32);
    const float rstd = 1.f / sqrtf(vs * (1.f / 64.f) + 1e-5f);
#pragma unroll
    for (int n = 0; n < 4; ++n) { const int e0 = n * 16 + fq * 4;
        const u32x2 gu = *(const u32x2*)(P + (size_t)(r0 + i) * NP + PC_RETG + h * 64 + e0);
        const f32x4 gn = *(const f32x4*)(p.in[13] + l * 256 + h * 64 + e0);
        const float g0 = bf2f((bf16_t)(gu.x & 0xffff)), g1 = bf2f((bf16_t)(gu.x >> 16)), g2 = bf2f((bf16_t)(gu.y & 0xffff)), g3 = bf2f((bf16_t)(gu.y >> 16));
        u32x2 yo;
        yo.x = cvt_pk_bf16((o[n][0] - mu) * rstd * gn.x * (g0 / (1.f + __expf(-g0))), (o[n][1] - mu) * rstd * gn.y * (g1 / (1.f + __expf(-g1))));
        yo.y = cvt_pk_bf16((o[n][2] - mu) * rstd * gn.z * (g2 / (1.f + __expf(-g2))), (o[n][3] - mu) * rstd * gn.w * (g3 / (1.f + __expf(-g3))));
        *(u32x2*)(P + (size_t)(r0 + i) * NP + PC_RETQ + h * 64 + e0) = yo; }
    __syncthreads();
}

constexpr int NSCANBLK = 128;
__device__ __forceinline__ void rwkv_scan_item(const Params& p, int l, LAS unsigned char* lds, int item) {
    const int tid = get_tid();
    const int sc = item >> 1, half = item & 1;
    const int b = sc >> 3, h = (sc >> 1) & 3, dir = sc & 1;
    const bf16_t* RK = (const bf16_t*)(p.ws + WS_RWK); const bf16_t* RV = (const bf16_t*)(p.ws + WS_RWV); const bf16_t* RR = (const bf16_t*)(p.ws + WS_RWRR);
    const bf16_t* RA = (const bf16_t*)(p.ws + (dir ? WS_RWA1 : WS_RWA0)); const bf16_t* RM = (const bf16_t*)(p.ws + (dir ? WS_RWM1 : WS_RWM0));
    bf16_t* P = (bf16_t*)(p.ws + WS_P);
    const int ocol = (dir ? PC_RWO1 : PC_RWO0) + h * 64 + half * 32;
    LAS float* KH = (LAS float*)lds;
    LAS float* WW = KH + 4096; LAS float* BB = WW + 4096; LAS float* KT = BB + 4096; LAS float* RRl = KT + 4096; LAS float* VV = RRl + 4096; LAS float* OUT = VV + 4096;
    const int st = tid >> 3, c0 = (tid & 7) * 8;
    float kkp[8], kap[8];
#pragma unroll
    for (int i = 0; i < 8; ++i) { kkp[i] = p.in[20][l * 256 + h * 64 + c0 + i]; kap[i] = p.in[21][l * 256 + h * 64 + c0 + i]; }
    const int row_l = tid >> 4, kq = tid & 15;
    f32x2 S[2];
#pragma unroll
    for (int i = 0; i < 2; ++i) S[i] = (f32x2){0.f, 0.f};
    auto row_of = [&](int s) -> int {
        if (s < CTXL) return TMAIN + b * CTXL + (dir ? CTXL - 1 - s : s);
        const int t = s - CTXL; return b * SEQL + (dir ? SEQL - 1 - t : t);
    };
    u32x4 gk, gv, gr, ga, gm;
    auto issue = [&](int ch) { const size_t o = (size_t)row_of(ch * 64 + st) * 256 + h * 64 + c0;
        gk = *(const u32x4*)(RK + o); gv = *(const u32x4*)(RV + o); gr = *(const u32x4*)(RR + o); ga = *(const u32x4*)(RA + o); gm = *(const u32x4*)(RM + o); };
    issue(0);
    for (int ch = 0; ch < 68; ++ch) {
        {
            float k[8], a[8], om[8], rr[8], vv8[8]; unpack8(gk, k); unpack8(ga, a); unpack8(gm, om); unpack8(gr, rr); unpack8(gv, vv8);
            float kk[8]; float n2 = 0.f;
#pragma unroll
            for (int i = 0; i < 8; ++i) { kk[i] = k[i] * kkp[i]; n2 += kk[i] * kk[i]; }
            n2 = red8(n2);
            const float rn = 1.f / sqrtf(fmaxf(n2, 1e-12f));
            f32x4 o0, o1;
#define ST8(DST, EXPR) { float t8[8]; _Pragma("unroll") for (int i = 0; i < 8; ++i) t8[i] = (EXPR); \
            *(LAS f32x4*)(DST + st * 64 + c0) = (f32x4){t8[0], t8[1], t8[2], t8[3]}; *(LAS f32x4*)(DST + st * 64 + c0 + 4) = (f32x4){t8[4], t8[5], t8[6], t8[7]}; }
            ST8(KH, kk[i] * rn)
            ST8(WW, 1.f - om[i])
            ST8(BB, kk[i] * rn * a[i])
            ST8(KT, k[i] * (1.f + (a[i] - 1.f) * kap[i]))
            ST8(RRl, rr[i])
            ST8(VV, vv8[i])
#undef ST8
        }
        __syncthreads();
        if (ch + 1 < 68) issue(ch + 1);
        {
            struct Ops { f32x4 kh, w, b, t, r; float vv; };
            auto ldops = [&](int s) -> Ops { Ops q;
                q.kh = *(const LAS f32x4*)(KH + s * 64 + kq * 4); q.w = *(const LAS f32x4*)(WW + s * 64 + kq * 4); q.b = *(const LAS f32x4*)(BB + s * 64 + kq * 4);
                q.t = *(const LAS f32x4*)(KT + s * 64 + kq * 4); q.r = *(const LAS f32x4*)(RRl + s * 64 + kq * 4);
                q.vv = VV[s * 64 + half * 32 + row_l]; return q; };
            Ops nx = ldops(0);
#pragma unroll 2
            for (int s = 0; s < 64; ++s) {
                const Ops c = nx;
                nx = ldops(s + 1 < 64 ? s + 1 : 63);
                f32x2 a2 = S[0] * (f32x2){c.kh.x, c.kh.y}; a2 = S[1] * (f32x2){c.kh.z, c.kh.w} + a2;
                const float sk = red16(a2.x + a2.y);
                const f32x2 nsk = (f32x2){-sk, -sk}, vv2 = (f32x2){c.vv, c.vv};
                S[0] = S[0] * (f32x2){c.w.x, c.w.y} + (nsk * (f32x2){c.b.x, c.b.y} + vv2 * (f32x2){c.t.x, c.t.y});
                S[1] = S[1] * (f32x2){c.w.z, c.w.w} + (nsk * (f32x2){c.b.z, c.b.w} + vv2 * (f32x2){c.t.z, c.t.w});
                f32x2 o2 = S[0] * (f32x2){c.r.x, c.r.y}; o2 = S[1] * (f32x2){c.r.z, c.r.w} + o2;
                const float ov = red16(o2.x + o2.y);
                if (kq == 0) OUT[s * 32 + row_l] = ov;
            }
        }
        __syncthreads();
        { const int c4 = (tid & 7) * 4; const f32x4 ov = *(const LAS f32x4*)(OUT + st * 32 + c4);
          u32x2 o2; o2.x = pk2(ov.x, ov.y); o2.y = pk2(ov.z, ov.w);
          *(u32x2*)(P + (size_t)row_of(ch * 64 + st) * NP + ocol + c4) = o2; }
    }
    __syncthreads();
}

__device__ __forceinline__ void mixer_mla(const Params& p, LAS unsigned char* lds, int it) {
    bf16_t* P = (bf16_t*)(p.ws + WS_P);
    const bf16_t* MQ = (const bf16_t*)(p.ws + WS_MQ);
    int b, h, row0, nm1;
    if (it < 512) { b = it >> 6; h = (it >> 4) & 3; row0 = b * SEQL + (it & 15) * 256; nm1 = 68; }
    else { const int u = it - 512; b = u >> 2; h = u & 3; row0 = TMAIN + b * CTXL; nm1 = 4; }
    attn_unit<96>(MQ + (size_t)row0 * 384 + h * 96, 384, (const bf16_t*)(p.ws + WS_KM) + (size_t)(b * 4 + h) * NKEYS * 96, (const bf16_t*)(p.ws + WS_VTM) + (size_t)(b * 4 + h) * 64 * NKEYS,
                  4, 4, nm1, false, 0, false, 0.f, 0.10206207f, P + (size_t)row0 * NP + PC_MLAQD + h * 64, NP, lds);
}
__device__ __forceinline__ void mixer_swa(const Params& p, int l, LAS unsigned char* lds, int u0) {
    bf16_t* P = (bf16_t*)(p.ws + WS_P);
    int b, h, row0, nm0, nm1, qp0; bool msk;
    if (u0 < 512) { b = u0 >> 6; h = (u0 >> 4) & 3; const int qb = u0 & 15; row0 = b * SEQL + qb * 256; nm0 = 4 + 4 * qb - 2; nm1 = 4 + 4 * qb + 6; if (nm0 < 4) nm0 = 4; if (nm1 > 68) nm1 = 68; qp0 = qb * 256; msk = true; }
    else { const int u = u0 - 512; b = u >> 2; h = u & 3; row0 = TMAIN + b * CTXL; nm0 = 4; nm1 = 4; qp0 = 0; msk = false; }
    const int hk = h >> 1;
    bf16_t* qp = P + (size_t)row0 * NP + PC_SWAQ + h * 64;
    attn_unit<64>(qp, NP, (const bf16_t*)(p.ws + WS_KS) + (size_t)(b * 2 + hk) * NKEYS * 64, (const bf16_t*)(p.ws + WS_VTS) + (size_t)(b * 2 + hk) * 64 * NKEYS,
                  4, nm0, nm1, msk, qp0, true, p.in[12][l * 4 + h], 0.125f, qp, NP, lds);
}
__device__ __forceinline__ void phase_mixers(const Params& p, int l, LAS unsigned char* lds, int bid, int nb) {
    const bool ectx = (l == 0);
    const int N_MLA = 512 + (ectx ? 32 : 0), N_SWA = 512 + (ectx ? 32 : 0), N_RET = 1024 + (ectx ? 64 : 0);
    if (bid < NSCANBLK) rwkv_scan_item(p, l, lds, bid);
    else if (bid < NSCANBLK + 64) ret_scan_item(p, l, bid - NSCANBLK);
    bool ret_ready = false;
    unsigned* ctr = (unsigned*)(p.ws + WS_CTR) + l;
    LAS unsigned* slot = (LAS unsigned*)(lds + LDS_BYTES - 16);
    const int tid0 = get_tid();
    for (;;) {
        __syncthreads();
        if (tid0 == 0) *slot = atomicAdd(ctr, 1u);
        __syncthreads();
        const int it = (int)*slot;
        if (it >= N_MLA + N_SWA + N_RET) break;
        if (it < N_MLA) mixer_mla(p, lds, it);
        else if (it < N_MLA + N_SWA) mixer_swa(p, l, lds, it - N_MLA);
        else { if (!ret_ready) { ret_wait_states(p, l); ret_ready = true; } ret_out_item(p, l, lds, it - N_MLA - N_SWA); }
    }
}

__device__ __forceinline__ void phase_rwkv_finish(const Params& p, int l, LAS unsigned char* lds, int bid, int nb) {
    const int tid = get_tid();
    bf16_t* P = (bf16_t*)(p.ws + WS_P);
    const int ntiles = (l == 0 ? TT : TMAIN) / 32;
    const float* mu = p.in[14] + l * 1024 + 896;
    const float* gup = p.in[19] + (size_t)l * 128 * 256;
    const bf16_t* RV = (const bf16_t*)(p.ws + WS_RWV); const float* BON = (const float*)(p.ws + WS_BON);
    LAS float* sg = (LAS float*)lds;
    for (int tile = bid; tile < ntiles; tile += nb) {
        const int t0 = tile * 32; const SeqInfo s0 = seq_of_row(t0);
        { const int tok = tid >> 4, j8 = (tid & 15) * 8; const int row = t0 + tok, pos = s0.pos + tok;
          const u32x4 u0 = *(const u32x4*)(P + (size_t)row * NP + PC_RWGD + j8);
          const u32x4 um = pos > 0 ? *(const u32x4*)(P + (size_t)(row - 1) * NP + PC_RWGD + j8) : (u32x4){0u, 0u, 0u, 0u};
          const u32x4 up = pos < s0.len - 1 ? *(const u32x4*)(P + (size_t)(row + 1) * NP + PC_RWGD + j8) : (u32x4){0u, 0u, 0u, 0u};
          float z0[8], zm[8], zp[8]; unpack8(u0, z0); unpack8(um, zm); unpack8(up, zp);
#pragma unroll
          for (int x = 0; x < 8; ++x) sg[tok * 128 + j8 + x] = sigmoidf_(z0[x] + mu[j8 + x] * (0.5f * (zm[x] + zp[x]) - z0[x])); }
        __syncthreads();
        const int hh = tid >> 8, c = tid & 255, h = c >> 6;
        float g[16];
#pragma unroll
        for (int i = 0; i < 16; ++i) g[i] = 0.f;
#pragma unroll 2
        for (int j = 0; j < 128; j += 4) { const float w0 = gup[j * 256 + c], w1 = gup[(j + 1) * 256 + c], w2 = gup[(j + 2) * 256 + c], w3 = gup[(j + 3) * 256 + c];
#pragma unroll
            for (int i = 0; i < 16; ++i) { const f32x4 sv = *(const LAS f32x4*)(sg + (hh * 16 + i) * 128 + j); g[i] += sv.x * w0 + sv.y * w1 + sv.z * w2 + sv.w * w3; } }
        const float gn = p.in[23][l * 256 + c];
        float ov[16], rv[16], bn[16];
#pragma unroll
        for (int i = 0; i < 16; ++i) { const int row = t0 + hh * 16 + i;
            ov[i] = bf2f(P[(size_t)row * NP + PC_RWO0 + c]) + bf2f(P[(size_t)row * NP + PC_RWO1 + c]); rv[i] = bf2f(RV[(size_t)row * 256 + c]); bn[i] = BON[(size_t)row * 4 + h]; }
#pragma unroll
        for (int i = 0; i < 16; ++i) { const int row = t0 + hh * 16 + i;
            const float o = ov[i];
            const float mean = wave_sum(o) * (1.f / 64.f); const float dl = o - mean; const float var = wave_sum(dl * dl) * (1.f / 64.f);
            float y = dl * (1.f / sqrtf(var + 64e-5f)) * gn + bn[i] * rv[i];
            P[(size_t)row * NP + PC_RWO1 + c] = f2bf(y * g[i]); }
        __syncthreads();
    }
}

#ifndef N_LAUNCH_MODE
#define N_LAUNCH_MODE 1
#endif
template <int Q>
__device__ __forceinline__ void layer_phase(const Params& p, int l, LAS unsigned char* lds, int bid, int nb) {
    unsigned char* wb = p.ws + WS_WB + (size_t)l * WB_LAYER;
    const int Mrows = (l == 0) ? TT : TMAIN;
    pg8::StaticOrder S;
    if constexpr (Q == 0) { pg8::Gemm g{(const bf16_t*)(p.ws + WS_HB), (const bf16_t*)(wb + WB_IN), TT, NP, DM, DM}; S.init(TT, NP, nb, bid);
              pg8::EpiBf16<0> E{(bf16_t*)(p.ws + WS_P), NP}; pg8::gemm_phase(lds, g, S, E); }
    if constexpr (Q == 1) phase_prepA(p, l, lds, bid, nb);
    if constexpr (Q == 3) phase_mixers(p, l, lds, bid, nb);
    if constexpr (Q == 4) phase_rwkv_finish(p, l, lds, bid, nb);
    if constexpr (Q == 5) { pg8::Gemm g{(const bf16_t*)(p.ws + WS_P), (const bf16_t*)(wb + WB_OUT), Mrows, DM, DM, NP}; S.init(Mrows, DM, nb, bid);
              pg8::EpiBf16<0> E{(bf16_t*)(p.ws + WS_Z), DM}; pg8::gemm_phase(lds, g, S, E); }
    if constexpr (Q == 6) phase_rowops(p, 1, l, Mrows, bid, nb);
    if constexpr (Q == 7) { pg8::Gemm g{(const bf16_t*)(p.ws + WS_HB), (const bf16_t*)(wb + WB_W1), Mrows, FF, DM, DM}; S.init(Mrows, FF, nb, bid);
              pg8::EpiBf16<1> E{(bf16_t*)(p.ws + WS_HID), FF}; pg8::gemm_phase(lds, g, S, E); }
    if constexpr (Q == 8) { pg8::Gemm g{(const bf16_t*)(p.ws + WS_HID), (const bf16_t*)(wb + WB_W2), Mrows, DM, FF, FF}; S.init(Mrows, DM, nb, bid);
              pg8::EpiBf16<0> E{(bf16_t*)(p.ws + WS_Z), DM}; pg8::gemm_phase(lds, g, S, E); }
    if constexpr (Q == 9) phase_rowops(p, 2, l, Mrows, bid, nb);
}

#ifndef PROBE_MASK
#define PROBE_MASK 0
#endif
#define PB(BIT, CALL) do { if ((PROBE_MASK) & (BIT)) { const unsigned long long t0_ = __builtin_amdgcn_s_memrealtime(); CALL; const unsigned long long t1_ = __builtin_amdgcn_s_memrealtime(); \
        while (__builtin_amdgcn_s_memrealtime() - t1_ < (t1_ - t0_)) __builtin_amdgcn_s_sleep(8); } else { CALL; } } while (0)
#define XB_TMO      128
#define XB_XCNT(j)  (256  + 64 * (j))
#define XB_XSUB(j)  (1280 + 64 * (j))
#define XB_XGEN(j)  (2304 + 64 * (j))
#define XB_TOP      3328
#define XB_TOPGEN   3392
#define XCD_BAR_WORDS 3456
#define XB_SPIN_CAP (1u << 18)

__device__ __forceinline__ unsigned xb_ld(unsigned* p)              { return __hip_atomic_load(p, __ATOMIC_RELAXED, __HIP_MEMORY_SCOPE_AGENT); }
__device__ __forceinline__ unsigned xb_add(unsigned* p, unsigned v) { return __hip_atomic_fetch_add(p, v, __ATOMIC_RELAXED, __HIP_MEMORY_SCOPE_AGENT); }
__device__ __forceinline__ unsigned xb_xcc_id() { return (unsigned)__builtin_amdgcn_s_getreg((3 << 11) | 20) & 0xFu; }
#define XB_SPIN(cond, bar) do { unsigned _sp = 0; while (cond) { __builtin_amdgcn_s_sleep(1); \
    if ((++_sp & 255u) == 0u) { if (xb_ld(&(bar)[XB_TMO])) break; if (_sp > XB_SPIN_CAP) { atomicAdd(&(bar)[XB_TMO], 1u); break; } } } } while (0)

struct XcdBarrier {
    unsigned* bar; unsigned x;
    volatile LAS unsigned* st;
};

__device__ __forceinline__ XcdBarrier xcd_barrier_post(unsigned* bar, volatile LAS unsigned* st) {
    XcdBarrier b; b.bar = bar; b.x = xb_xcc_id(); b.st = st;
    if (threadIdx.x == 0) (void)xb_add(&bar[XB_XCNT(b.x)], 1u);
    return b;
}
__device__ __forceinline__ void xcd_barrier_complete(unsigned* bar, unsigned x, unsigned& nloc, unsigned& nx) {
    const unsigned G = gridDim.x * gridDim.y * gridDim.z;
    unsigned sum, cnt, mine, sp = 0u;
    for (;;) {
        sum = 0u; cnt = 0u; mine = 0u;
#pragma unroll
        for (unsigned j = 0; j < 16; ++j) { const unsigned c = xb_ld(&bar[XB_XCNT(j)]); sum += c; cnt += (c > 0u) ? 1u : 0u; mine = (j == x) ? c : mine; }
        if (sum == G) break;
        __builtin_amdgcn_s_sleep(1);
        if ((++sp & 255u) == 0u) { if (xb_ld(&bar[XB_TMO])) break; if (sp > XB_SPIN_CAP) { atomicAdd(&bar[XB_TMO], 1u); break; } }
    }
    nloc = mine > 0u ? mine : 1u; nx = cnt > 0u ? cnt : 1u;
}

__device__ __forceinline__ void xcd_barrier(const XcdBarrier& b) {
    asm volatile("s_waitcnt vmcnt(0)" ::: "memory");
    __syncthreads();
    if (threadIdx.x == 0) {
        unsigned* bar = b.bar;
        __builtin_amdgcn_s_waitcnt(0);
        unsigned nloc = b.st[0], nx = b.st[1];
        if (nloc == 0u) { xcd_barrier_complete(bar, b.x, nloc, nx); b.st[0] = nloc; b.st[1] = nx; }
        const unsigned old = xb_add(&bar[XB_XSUB(b.x)], 1u);
        const unsigned gen = old / nloc;
        if (old + 1u == (gen + 1u) * nloc) {
            __builtin_amdgcn_fence(__ATOMIC_RELEASE, "agent");
            asm volatile("s_waitcnt vmcnt(0)" ::: "memory");
            const unsigned og = xb_add(&bar[XB_TOP], 1u);
            const unsigned tg = og / nx;
            if (og + 1u == (tg + 1u) * nx) xb_add(&bar[XB_TOPGEN], 1u);
            else XB_SPIN(xb_ld(&bar[XB_TOPGEN]) == tg, bar);
            __builtin_amdgcn_fence(__ATOMIC_ACQUIRE, "agent");
            xb_add(&bar[XB_XGEN(b.x)], 1u);
            asm volatile("s_waitcnt vmcnt(0)" ::: "memory");
        } else {
            XB_SPIN(xb_ld(&bar[XB_XGEN(b.x)]) == gen, bar);
            __builtin_amdgcn_fence(__ATOMIC_ACQUIRE, "agent");
            asm volatile("s_waitcnt vmcnt(0)" ::: "memory");
        }
    }
    __syncthreads();
}


constexpr size_t WS_XBAR = 772 * 1024;
#define GSYNC() xcd_barrier(xb)

__global__ void __launch_bounds__(512, 2) mega_fwd(Params p) {
    extern __shared__ __attribute__((aligned(16))) unsigned char lds_raw[];
    LAS unsigned char* lds = (LAS unsigned char*)lds_raw;
    cg::grid_group grid = cg::this_grid();
    const int bid = blockIdx.x, nb = gridDim.x;
    { LAS unsigned* st_ = (LAS unsigned*)(lds + LDS_BYTES - 32); if (get_tid() == 0) { st_[0] = 0u; st_[1] = 0u; } __syncthreads(); }
    XcdBarrier xb = xcd_barrier_post((unsigned*)(p.ws + WS_XBAR), (volatile LAS unsigned*)(lds + LDS_BYTES - 32));
    PB(16, phase_prologue(p, lds, bid, nb));
    { asm volatile("s_waitcnt vmcnt(0) lgkmcnt(0)" ::: "memory"); __syncthreads(); if (get_tid() < 64) { __builtin_amdgcn_fence(__ATOMIC_RELEASE, "agent"); asm volatile("s_waitcnt vmcnt(0) lgkmcnt(0)" ::: "memory"); } grid.sync();
      if (get_tid() < 64) { __builtin_amdgcn_fence(__ATOMIC_ACQUIRE, "agent"); asm volatile("s_waitcnt vmcnt(0) lgkmcnt(0)" ::: "memory"); } __syncthreads(); }
    PB(8, phase_rowops(p, 0, 0, TT, bid, nb)); GSYNC();
#define LAYER(L, LAST) \
    PB(1, layer_phase<0>(p, L, lds, bid, nb)); GSYNC(); PB(4, layer_phase<1>(p, L, lds, bid, nb)); GSYNC(); \
    PB(2, layer_phase<3>(p, L, lds, bid, nb)); GSYNC(); PB(4, layer_phase<4>(p, L, lds, bid, nb)); GSYNC(); PB(1, layer_phase<5>(p, L, lds, bid, nb)); GSYNC(); \
    PB(8, layer_phase<6>(p, L, lds, bid, nb)); GSYNC(); PB(1, layer_phase<7>(p, L, lds, bid, nb)); GSYNC(); PB(1, layer_phase<8>(p, L, lds, bid, nb)); GSYNC(); \
    PB(8, layer_phase<9>(p, L, lds, bid, nb)); if (!(LAST)) GSYNC();
    LAYER(0, false)
    LAYER(1, true)
}
#if N_LAUNCH_MODE != 1
template <int PH> __global__ void __launch_bounds__(512, 2) one_phase(Params p, int l) {
    extern __shared__ __attribute__((aligned(16))) unsigned char lds_raw[];
    LAS unsigned char* lds = (LAS unsigned char*)lds_raw;
    if constexpr (PH == 100) phase_prologue(p, lds, blockIdx.x, gridDim.x);
    else if constexpr (PH == 101) phase_rowops(p, 0, 0, TT, blockIdx.x, gridDim.x);
    else layer_phase<PH>(p, l, lds, blockIdx.x, gridDim.x);
}
#endif

extern "C" void kernel_launch(void* const* d_in, const int* in_sizes, int n_in, void* d_out, int out_size, void* d_ws, size_t ws_size, hipStream_t stream) {
    if (n_in != 30 || ws_size < WS_NEED || out_size != TMAIN * DM) { fprintf(stderr, "kernel_launch: unexpected shapes (n_in %d, ws %zu, out %d)\n", n_in, ws_size, out_size); return; }
    Params p{};
    for (int i = 0; i < 30; ++i) p.in[i] = (const float*)d_in[i];
    p.out = (float*)d_out; p.ws = (unsigned char*)d_ws;
    static int grid_blocks = 0;
    if (!grid_blocks) {
        int dev = 0, cus = 0, per_cu = 0;
        (void)hipGetDevice(&dev);
        (void)hipDeviceGetAttribute(&cus, hipDeviceAttributeMultiprocessorCount, dev);
        (void)hipFuncSetAttribute((const void*)mega_fwd, hipFuncAttributeMaxDynamicSharedMemorySize, LDS_BYTES);
        (void)hipOccupancyMaxActiveBlocksPerMultiprocessor(&per_cu, mega_fwd, 512, LDS_BYTES);
        if (per_cu < 1) { fprintf(stderr, "kernel_launch: occupancy query says %d blocks/CU\n", per_cu); per_cu = 1; }
        grid_blocks = cus * 1;
        if (grid_blocks < 128) { fprintf(stderr, "kernel_launch: only %d CUs\n", grid_blocks); }
    }
#if N_LAUNCH_MODE == 1
    (void)hipMemsetAsync((char*)d_ws + 768 * 1024, 0, 32 * 1024, stream);
    void* args[] = {&p};
    hipError_t e = hipLaunchCooperativeKernel((const void*)mega_fwd, dim3(grid_blocks), dim3(512), args, LDS_BYTES, stream);
    if (e != hipSuccess) fprintf(stderr, "cooperative launch failed: %s (grid %d)\n", hipGetErrorString(e), grid_blocks);
#else
#define LP(PH, L) do { (void)hipFuncSetAttribute((const void*)one_phase<PH>, hipFuncAttributeMaxDynamicSharedMemorySize, LDS_BYTES); one_phase<PH><<<grid_blocks, 512, LDS_BYTES, stream>>>(p, L); } while (0)
    LP(100, 0); LP(101, 0);
    for (int l = 0; l < 2; ++l) { LP(0, l); LP(1, l); LP(2, l); LP(3, l); LP(4, l); LP(5, l); LP(6, l); LP(7, l); LP(8, l); LP(9, l); }
#endif
}
```

```cpp
#include <hip/hip_runtime.h>
#include <hip/hip_cooperative_groups.h>
#include <cstdio>
#include <cstdint>
#include <cmath>
namespace cg = cooperative_groups;
__device__ __forceinline__ int get_tid() { int t = threadIdx.x; asm volatile("" : "+v"(t)); return t; }
namespace pg8 {
#define PG8_LAS __attribute__((address_space(3)))
typedef unsigned short bf16_t;
typedef short bf16x8 __attribute__((ext_vector_type(8)));
typedef float f32x4 __attribute__((ext_vector_type(4)));
typedef unsigned u32x4 __attribute__((ext_vector_type(4)));
typedef unsigned u32x2 __attribute__((ext_vector_type(2)));
constexpr int BM = 256, BK = 64, HALF = 128, HTB = HALF * BK * 2, STAGE_BYTES = 8 * HTB, NXCD = 8, WGM = 8;

__host__ __device__ __forceinline__ int lds_byte(int r, int c) { const int st = (r >> 4) * 2 + (c >> 5), rr = r & 15, cc = c & 31, ob = rr * 64 + cc * 2; return st * 1024 + (ob ^ (((ob >> 9) & 1) << 5)); }
__host__ __device__ __forceinline__ void stage_rc(int b, int& R, int& C) { const int st = b / 1024, sb = b % 1024, swz = sb ^ (((sb >> 9) & 1) << 5); R = (st >> 1) * 16 + swz / 64; C = (st & 1) * 32 + (swz % 64) / 2; }

struct Unit { int pm, pn; };
struct Gemm { const bf16_t* A; const bf16_t* Bt; int M, N, K, lda; };

struct StaticOrder {
    int nM, nN, nwg, G, c;
    __host__ __device__ void init(int M, int N, int G_, int c_) { nM = M / BM; nN = N / BM; nwg = nM * nN; G = G_; c = c_; }
    __host__ __device__ bool next(int i, Unit& u) const {
        const long L = (long)i * G + c; if (L >= nwg) return false;
        int wgid = (int)L; { const int q = nwg / NXCD, r = nwg % NXCD, xcd = wgid % NXCD, off = wgid / NXCD; wgid = (xcd < r ? xcd * (q + 1) : r * (q + 1) + (xcd - r) * q) + off; }
        const int nig = WGM * nN, gid = wgid / nig, fm = gid * WGM, gsz = (nM - fm) < WGM ? (nM - fm) : WGM;
        u.pm = fm + ((wgid % nig) % gsz); u.pn = (wgid % nig) / gsz; return true;
    }
};

template <class Epi>
__device__ __forceinline__ void gemm_phase(PG8_LAS unsigned char* lds, const Gemm g, const StaticOrder& S, const Epi& E) {
    const int tid = get_tid(), wid = __builtin_amdgcn_readfirstlane(tid >> 6), lane = tid & 63, wr = wid >> 2, wc = wid & 3, fr = lane & 15, fq = lane >> 4;
    const int K = g.K, nt = K / BK, lda = g.lda;
    unsigned voffA[2], voffB[2];
#pragma unroll
    for (int i = 0; i < 2; ++i) { int R, C; stage_rc(tid * 16 + i * 8192, R, C);
        voffA[i] = (unsigned)(R * lda + C) * 2u; voffB[i] = (unsigned)(R * K + C) * 2u; }
    const size_t kstep = (size_t)(BK * 2);
    const size_t hstepA = (size_t)HALF * lda * 2, hstepB = (size_t)HALF * K * 2;
    const size_t tstepA = 2 * hstepA, tstepB = 2 * hstepB;
    const unsigned ldsw = (unsigned)wid * 1024u;
    const int aoff = lds_byte(wr * 64 + fr, fq * 8), boff = lds_byte(wc * 32 + fr, fq * 8);
#define PG8_SA(b, h) (((b) * 2 + (h)) * HTB)
#define PG8_SB(b, h) ((4 + (b) * 2 + (h)) * HTB)
#define PG8_STAGE(bufoff, gbase, voff) do { _Pragma("unroll") for (int _i = 0; _i < 2; ++_i) \
        __builtin_amdgcn_global_load_lds((const unsigned*)((const char*)(gbase) + (voff)[_i]), (PG8_LAS unsigned*)(lds + (bufoff) + ldsw + _i * 8192), 16, 0, 0); } while (0)
#define PG8_LDA(dst, b, h) do { _Pragma("unroll") for (int m = 0; m < 4; ++m) _Pragma("unroll") for (int k = 0; k < 2; ++k) dst[m][k] = *(const PG8_LAS bf16x8*)(lds + PG8_SA(b, h) + aoff + m * 2048 + k * 1024); } while (0)
#define PG8_LDB(dst, b, h) do { _Pragma("unroll") for (int n = 0; n < 2; ++n) _Pragma("unroll") for (int k = 0; k < 2; ++k) dst[n][k] = *(const PG8_LAS bf16x8*)(lds + PG8_SB(b, h) + boff + n * 2048 + k * 1024); } while (0)
#define PG8_MMA(ai, bj, At, Bt) do { __builtin_amdgcn_s_setprio(1); _Pragma("unroll") for (int m = 0; m < 4; ++m) _Pragma("unroll") for (int n = 0; n < 2; ++n) _Pragma("unroll") for (int k = 0; k < 2; ++k) \
        acc[ai][bj][m][n] = __builtin_amdgcn_mfma_f32_16x16x32_bf16(Bt[n][k], At[m][k], acc[ai][bj][m][n], 0, 0, 0); __builtin_amdgcn_s_setprio(0); } while (0)
#define PG8_WAIT_V(n) asm volatile("s_waitcnt vmcnt(" #n ")" ::: "memory")
#define PG8_WAIT_L(n) asm volatile("s_waitcnt lgkmcnt(" #n ")" ::: "memory")
#define PG8_BAR __builtin_amdgcn_s_barrier()
#define PG8_SCHED __builtin_amdgcn_sched_barrier(0)
    Unit cur, nxt; int ui = 0;
    if (!S.next(0, cur)) return;
    f32x4 acc[2][2][4][2];
#pragma unroll
    for (int a = 0; a < 2; ++a)
#pragma unroll
        for (int b = 0; b < 2; ++b)
#pragma unroll
            for (int m = 0; m < 4; ++m)
#pragma unroll
                for (int n = 0; n < 2; ++n) acc[a][b][m][n] = (f32x4){0.f, 0.f, 0.f, 0.f};
    bf16x8 At[4][2], B0[2][2], B1[2][2];
    const char* cA = (const char*)g.A + (size_t)cur.pm * tstepA; const char* cB = (const char*)g.Bt + (size_t)cur.pn * tstepB;
    PG8_STAGE(PG8_SB(0, 0), cB, voffB); PG8_STAGE(PG8_SA(0, 0), cA, voffA); PG8_STAGE(PG8_SB(0, 1), cB + hstepB, voffB); PG8_STAGE(PG8_SA(0, 1), cA + hstepA, voffA);
    if (wr == 1) PG8_BAR;
    PG8_WAIT_V(4); PG8_BAR;
    PG8_STAGE(PG8_SB(1, 0), cB + kstep, voffB); PG8_STAGE(PG8_SA(1, 0), cA + kstep, voffA); PG8_STAGE(PG8_SB(1, 1), cB + hstepB + kstep, voffB);
    PG8_WAIT_V(6); PG8_BAR;
    for (;;) {
        const bool has_next = S.next(ui + 1, nxt);
        const char* nA = has_next ? (const char*)g.A + (size_t)nxt.pm * tstepA : cA; const char* nB = has_next ? (const char*)g.Bt + (size_t)nxt.pn * tstepB : cB;
        for (int t = 0; t < nt; t += 2) {
            const bool last = (t == nt - 2);
            const char* a1 = cA + (size_t)(t + 1) * kstep;
            const char* a2 = last ? nA : cA + (size_t)(t + 2) * kstep; const char* b2 = last ? nB : cB + (size_t)(t + 2) * kstep;
            const char* a3 = a2 + kstep; const char* b3 = b2 + kstep;
            PG8_LDB(B0, 0, 0); PG8_SCHED; PG8_LDA(At, 0, 0); PG8_STAGE(PG8_SA(1, 1), a1 + hstepA, voffA);
            PG8_WAIT_L(8); PG8_BAR; PG8_WAIT_L(0); PG8_MMA(0, 0, At, B0); PG8_BAR; PG8_SCHED;
            PG8_LDB(B1, 0, 1); PG8_STAGE(PG8_SB(0, 0), b2, voffB);
            PG8_BAR; PG8_WAIT_L(0); PG8_MMA(0, 1, At, B1); PG8_BAR;
            PG8_LDA(At, 0, 1); PG8_STAGE(PG8_SA(0, 0), a2, voffA);
            PG8_BAR; PG8_WAIT_L(0); PG8_MMA(1, 0, At, B0); PG8_BAR; PG8_SCHED;
            PG8_STAGE(PG8_SB(0, 1), b2 + hstepB, voffB);
            PG8_WAIT_V(6); PG8_BAR; PG8_MMA(1, 1, At, B1); PG8_BAR;
            PG8_LDB(B0, 1, 0); PG8_SCHED; PG8_LDA(At, 1, 0); PG8_STAGE(PG8_SA(0, 1), a2 + hstepA, voffA);
            PG8_WAIT_L(8); PG8_BAR; PG8_WAIT_L(0); PG8_MMA(0, 0, At, B0); PG8_BAR; PG8_SCHED;
            PG8_LDB(B1, 1, 1); PG8_STAGE(PG8_SB(1, 0), b3, voffB);
            PG8_BAR; PG8_WAIT_L(0); PG8_MMA(0, 1, At, B1); PG8_BAR;
            PG8_LDA(At, 1, 1); PG8_STAGE(PG8_SA(1, 0), a3, voffA);
            PG8_BAR; PG8_WAIT_L(0); PG8_MMA(1, 0, At, B0); PG8_BAR; PG8_SCHED;
            PG8_STAGE(PG8_SB(1, 1), b3 + hstepB, voffB);
            PG8_WAIT_V(6); PG8_BAR; PG8_MMA(1, 1, At, B1); PG8_BAR;
        }
        E(acc, cur, wr, wc, fr, fq);
        if (!has_next) break;
#pragma unroll
        for (int a = 0; a < 2; ++a)
#pragma unroll
            for (int b = 0; b < 2; ++b)
#pragma unroll
                for (int m = 0; m < 4; ++m)
#pragma unroll
                    for (int n = 0; n < 2; ++n) acc[a][b][m][n] = (f32x4){0.f, 0.f, 0.f, 0.f};
        cur = nxt; cA = nA; cB = nB; ++ui;
    }
    PG8_WAIT_V(0);
    if (wr == 0) PG8_BAR;
    PG8_BAR;
#undef PG8_SA
#undef PG8_SB
#undef PG8_STAGE
#undef PG8_LDA
#undef PG8_LDB
#undef PG8_MMA
#undef PG8_WAIT_V
#undef PG8_WAIT_L
#undef PG8_BAR
#undef PG8_SCHED
}

__device__ __forceinline__ unsigned f2bf_u(float f) { unsigned u = __builtin_bit_cast(unsigned, f); return (u + 0x7fffu + ((u >> 16) & 1u)) >> 16; }
template <int ACT> struct EpiBf16 {
    bf16_t* O; int ldc;
    __device__ __forceinline__ void operator()(const f32x4 (&acc)[2][2][4][2], const Unit& u, int wr, int wc, int fr, int fq) const {
        const int row0 = u.pm * BM + wr * 64 + fr, col0 = u.pn * BM + wc * 32 + 4 * fq;
#pragma unroll
        for (int ai = 0; ai < 2; ++ai)
#pragma unroll
            for (int m = 0; m < 4; ++m) { bf16_t* rowp = O + (size_t)(row0 + ai * HALF + m * 16) * ldc + col0;
#pragma unroll
                for (int bj = 0; bj < 2; ++bj)
#pragma unroll
                    for (int n = 0; n < 2; ++n) { f32x4 v = acc[ai][bj][m][n];
                        if (ACT == 1) { v.x = v.x > 0.f ? v.x * v.x : 0.f; v.y = v.y > 0.f ? v.y * v.y : 0.f; v.z = v.z > 0.f ? v.z * v.z : 0.f; v.w = v.w > 0.f ? v.w * v.w : 0.f; }
                        u32x2 o; o.x = f2bf_u(v.x) | (f2bf_u(v.y) << 16); o.y = f2bf_u(v.z) | (f2bf_u(v.w) << 16);
                        *(u32x2*)(rowp + bj * HALF + n * 16) = o; } }
    }
};
}
typedef unsigned short bf16_t;
typedef short bf16x8 __attribute__((ext_vector_type(8)));
typedef float f32x4 __attribute__((ext_vector_type(4)));
typedef unsigned u32x4 __attribute__((ext_vector_type(4)));
typedef unsigned u32x2 __attribute__((ext_vector_type(2)));
#define LAS __attribute__((address_space(3)))

constexpr int NBATCH = 8, SEQL = 4096, DM = 1024, CTXL = 256, TMAIN = 32768, TCTX = 2048, TT = 34816, NP = 3072, FF = 4096;
constexpr int PC_SWAQ = 0, PC_RETQ = 256, PC_RWR = 512, PC_MLAQD = 768, PC_SWAK = 1024, PC_SWAV = 1152, PC_RETK = 1280, PC_RETV = 1536, PC_RETG = 1792,
              PC_RWK = 2048, PC_RWV = 2304, PC_RWWD = 2560, PC_RWAD = 2624, PC_RWGD = 2688, PC_MLAKVD = 2816, PC_MLAKPE = 2944;
constexpr int PC_RWO0 = PC_RWV, PC_RWO1 = PC_RWR;
constexpr int NKEYS = CTXL + SEQL;

constexpr size_t MiB = 1u << 20;
constexpr size_t WS_MOD = 0;
constexpr size_t WS_TAB = 512 * 1024;
constexpr size_t WS_CTR = 768 * 1024;
constexpr size_t WS_BON = 1 * MiB;
constexpr size_t WS_WB = 2 * MiB;
constexpr size_t WB_LAYER = 24 * MiB, WB_IN = 0, WB_OUT = 6 * MiB, WB_W1 = 8 * MiB, WB_W2 = 16 * MiB;
constexpr size_t WS_XC = 50 * MiB;
constexpr size_t WS_P = 58 * MiB;
constexpr size_t WS_HID = 58 * MiB;
constexpr size_t WS_A = 262 * MiB;
constexpr size_t ARR17 = 17 * MiB;
constexpr size_t WS_RWK = WS_A, WS_RWV = WS_A + ARR17, WS_RWRR = WS_A + 2 * ARR17, WS_RWA0 = WS_A + 3 * ARR17, WS_RWA1 = WS_A + 4 * ARR17,
                 WS_RWM0 = WS_A + 5 * ARR17, WS_RWM1 = WS_A + 6 * ARR17;
constexpr size_t WS_RET = WS_A + 119 * MiB;
constexpr size_t WS_MQ = WS_RET + 34 * MiB;
constexpr size_t WS_KM = WS_MQ + 26738688;
constexpr size_t WS_VTM = WS_KM + 26738688;
constexpr size_t WS_KS = WS_VTM + ARR17;
constexpr size_t WS_VTS = WS_KS + 8912896;
constexpr size_t WS_A_END = WS_VTS + 8912896;
constexpr size_t WS_Z = 330 * MiB;
constexpr size_t WS_HB = 398 * MiB;
constexpr size_t WS_MLAW = 500 * MiB;
constexpr size_t MLAW_LAYER = 384 * 256 * 2 + 512 * 128 * 2, MLAW_KV = 384 * 256 * 2;
constexpr size_t WS_GUPT = 501 * MiB;
constexpr size_t WS_LORAT = 502 * MiB;
constexpr size_t WS_NEED = 503 * MiB;
static_assert(WS_A_END <= WS_NEED && WS_HB + 68 * MiB <= WS_NEED && WS_HID + 272 * MiB <= WS_Z, "ws map");

constexpr int LDS_BYTES = 150 * 1024;

struct Params { const float* in[30]; float* out; unsigned char* ws; };

__device__ __forceinline__ float bf2f(bf16_t v) { return __builtin_bit_cast(float, (unsigned)v << 16); }
__device__ __forceinline__ bf16_t f2bf(float f) { unsigned u = __builtin_bit_cast(unsigned, f); return (bf16_t)((u + 0x7fffu + ((u >> 16) & 1u)) >> 16); }
__device__ __forceinline__ unsigned pk2(float lo, float hi) { return (unsigned)f2bf(lo) | ((unsigned)f2bf(hi) << 16); }
typedef float f32x2 __attribute__((ext_vector_type(2)));
typedef __bf16 bf16x2_t __attribute__((ext_vector_type(2)));
__device__ __forceinline__ unsigned cvt_pk_bf16(float lo, float hi) { const f32x2 v = {lo, hi}; return __builtin_bit_cast(unsigned, __builtin_convertvector(v, bf16x2_t)); }
template <int CTRL> __device__ __forceinline__ float dppf(float v) { return __builtin_bit_cast(float, __builtin_amdgcn_update_dpp(0, __builtin_bit_cast(int, v), CTRL, 0xF, 0xF, true)); }
__device__ __forceinline__ float red4(float v) { v += dppf<0xB1>(v); v += dppf<0x4E>(v); return v; }
__device__ __forceinline__ float red8(float v) { v = red4(v); v += dppf<0x141>(v); return v; }
__device__ __forceinline__ float red16(float v) { v = red8(v); v += dppf<0x140>(v); return v; }
__device__ __forceinline__ float max16(float v) { v = fmaxf(v, dppf<0xB1>(v)); v = fmaxf(v, dppf<0x4E>(v)); v = fmaxf(v, dppf<0x141>(v)); v = fmaxf(v, dppf<0x140>(v)); return v; }
__device__ __forceinline__ float wave_sum(float v) {
    v = red16(v);
    const int u = __builtin_bit_cast(int, v);
    return __builtin_bit_cast(float, __builtin_amdgcn_readlane(u, 0)) + __builtin_bit_cast(float, __builtin_amdgcn_readlane(u, 16)) +
           __builtin_bit_cast(float, __builtin_amdgcn_readlane(u, 32)) + __builtin_bit_cast(float, __builtin_amdgcn_readlane(u, 48));
}
__device__ __forceinline__ void unpack8(const u32x4 u, float* f) {
    f[0] = bf2f((bf16_t)(u.x & 0xffff)); f[1] = bf2f((bf16_t)(u.x >> 16)); f[2] = bf2f((bf16_t)(u.y & 0xffff)); f[3] = bf2f((bf16_t)(u.y >> 16));
    f[4] = bf2f((bf16_t)(u.z & 0xffff)); f[5] = bf2f((bf16_t)(u.z >> 16)); f[6] = bf2f((bf16_t)(u.w & 0xffff)); f[7] = bf2f((bf16_t)(u.w >> 16));
}
__device__ __forceinline__ float sigmoidf_(float x) { return __builtin_amdgcn_rcpf(1.f + __expf(-x)); }

struct SeqInfo { int b, pos, len, start, isctx; };
__device__ __forceinline__ SeqInfo seq_of_row(int row) {
    SeqInfo s;
    if (row < TMAIN) { s.b = row >> 12; s.pos = row & 4095; s.len = SEQL; s.start = s.b << 12; s.isctx = 0; }
    else { const int r = row - TMAIN; s.b = r >> 8; s.pos = r & 255; s.len = CTXL; s.start = TMAIN + (s.b << 8); s.isctx = 1; }
    return s;
}

__device__ __forceinline__ void transpose_item(const float* W, int N, int nsrc0, bf16_t* WT, int K, int ndst0, int k0, LAS float* scr, int lane) {
    if (nsrc0 >= 0) {
#pragma unroll 32
        for (int i = 0; i < 32; ++i) { const int kk = 2 * i + (lane >> 5); scr[kk * 33 + (lane & 31)] = W[(size_t)(k0 + kk) * N + nsrc0 + (lane & 31)]; }
    } else {
#pragma unroll 8
        for (int i = 0; i < 32; ++i) { const int kk = 2 * i + (lane >> 5); scr[kk * 33 + (lane & 31)] = 0.f; }
    }
    __builtin_amdgcn_wave_barrier(); asm volatile("s_waitcnt lgkmcnt(0)" ::: "memory");
    const int c = lane & 7;
#pragma unroll
    for (int j = 0; j < 4; ++j) { const int n = (lane >> 3) + 8 * j; const LAS float* s = scr + (8 * c) * 33 + n;
        u32x4 o; o.x = pk2(s[0 * 33], s[1 * 33]); o.y = pk2(s[2 * 33], s[3 * 33]); o.z = pk2(s[4 * 33], s[5 * 33]); o.w = pk2(s[6 * 33], s[7 * 33]);
        *(u32x4*)(WT + (size_t)(ndst0 + n) * K + k0 + 8 * c) = o; }
    __builtin_amdgcn_wave_barrier(); asm volatile("s_waitcnt lgkmcnt(0)" ::: "memory");
}
__device__ __forceinline__ int win_src_col(int n) {
    if (n < 256) return n;
    if (n < 512) return 512 + (n - 256);
    if (n < 768) return 1536 + (n - 512);
    if (n < 1024) return 2560 + (n - 768);
    if (n < 1280) return 256 + (n - 1024);
    if (n < 2048) return 768 + (n - 1280);
    if (n < 2816) return 1792 + (n - 2048);
    if (n < 2976) return n;
    return -1;
}
__device__ __forceinline__ void phase_prologue(const Params& p, LAS unsigned char* lds, int bid, int nb) {
    const int tid = get_tid(), lane = tid & 63, wave = tid >> 6;
    LAS float* scr = (LAS float*)(lds + wave * 16384);
    const int gw = bid * 8 + wave, NGW = nb * 8;
    constexpr int I_IN = 16 * 96, I_OUT = 16 * 32, I_1 = 16 * 128, I_2 = 64 * 32, I_Q = 4 * 12, I_KV = 2 * 16, I_G = 2 * 8, I_LO = 4 * 8, I_L = I_IN + I_OUT + I_1 + I_2 + I_Q + I_KV + I_G + I_LO;
    for (int it = gw; it < 2 * I_L; it += NGW) {
        const int l = it / I_L; int r = it % I_L;
        unsigned char* wb = p.ws + WS_WB + (size_t)l * WB_LAYER;
        if (r < I_IN) { const int kb = r / 96, nbk = r % 96; transpose_item(p.in[10] + (size_t)l * DM * 2976, 2976, win_src_col(nbk * 32), (bf16_t*)(wb + WB_IN), DM, nbk * 32, kb * 64, scr, lane); continue; } r -= I_IN;
        if (r < I_OUT) { const int kb = r / 32, nbk = r % 32; transpose_item(p.in[11] + (size_t)l * DM * DM, DM, nbk * 32, (bf16_t*)(wb + WB_OUT), DM, nbk * 32, kb * 64, scr, lane); continue; } r -= I_OUT;
        if (r < I_1) { const int kb = r / 128, nbk = r % 128; transpose_item(p.in[28] + (size_t)l * DM * FF, FF, nbk * 32, (bf16_t*)(wb + WB_W1), DM, nbk * 32, kb * 64, scr, lane); continue; } r -= I_1;
        if (r < I_2) { const int kb = r / 32, nbk = r % 32; transpose_item(p.in[29] + (size_t)l * FF * DM, DM, nbk * 32, (bf16_t*)(wb + WB_W2), FF, nbk * 32, kb * 64, scr, lane); continue; } r -= I_2;
        unsigned char* mw = p.ws + WS_MLAW + (size_t)l * MLAW_LAYER;
        if (r < I_Q) { const int kb = r / 12, nbk = r % 12; transpose_item(p.in[25] + (size_t)l * 256 * 384, 384, nbk * 32, (bf16_t*)mw, 256, nbk * 32, kb * 64, scr, lane); continue; } r -= I_Q;
        if (r < I_KV) { const int kb = r / 16, nbk = r % 16; transpose_item(p.in[27] + (size_t)l * 128 * 512, 512, nbk * 32, (bf16_t*)(mw + MLAW_KV), 128, nbk * 32, kb * 64, scr, lane); continue; } r -= I_KV;
        if (r < I_G) { const int kb = r / 8, nbk = r % 8; transpose_item(p.in[19] + (size_t)l * 128 * 256, 256, nbk * 32, (bf16_t*)(p.ws + WS_GUPT + (size_t)l * 256 * 128 * 2), 128, nbk * 32, kb * 64, scr, lane); continue; } r -= I_G;
        { const int m = r / 8, nbk = r % 8; const float* src = (m < 2 ? p.in[16] : p.in[18]) + ((size_t)l * 2 + (m & 1)) * 64 * 256;
          transpose_item(src, 256, nbk * 32, (bf16_t*)(p.ws + WS_LORAT + ((size_t)l * 4 + m) * 256 * 64 * 2), 64, nbk * 32, 0, scr, lane); }
    }
    __syncthreads();
    for (int it = bid; it < 192; it += nb) {
        const int l = it / 96, cb = it % 96;
        LAS float* sc = (LAS float*)lds;
        LAS float* red = sc + 9 * 1024;
        for (int e = tid; e < 9 * 1024; e += 512) { const int r = e >> 10, k = e & 1023; const float v = (r < 8) ? p.in[1][r * 1024 + k] : p.in[3][k]; sc[e] = v / (1.f + __expf(-v)); }
        __syncthreads();
        const int ks = tid >> 6, cl = tid & 63, n = cb * 64 + cl;
        float acc[9];
#pragma unroll
        for (int r = 0; r < 9; ++r) acc[r] = 0.f;
        const float* aw = p.in[4] + (size_t)l * DM * 6144;
#pragma unroll 16
        for (int k = ks * 128; k < ks * 128 + 128; ++k) { const float w = aw[(size_t)k * 6144 + n];
#pragma unroll
            for (int r = 0; r < 9; ++r) acc[r] += sc[r * 1024 + k] * w; }
#pragma unroll
        for (int r = 0; r < 9; ++r) red[(ks * 9 + r) * 64 + cl] = acc[r];
        __syncthreads();
        for (int e = tid; e < 9 * 64; e += 512) { const int r = e >> 6, c2 = e & 63; float s = 0.f;
            for (int q = 0; q < 8; ++q) s += red[(q * 9 + r) * 64 + c2];
            ((float*)(p.ws + WS_MOD))[((size_t)l * 9 + r) * 6144 + cb * 64 + c2] = s + p.in[5][(size_t)l * 6144 + cb * 64 + c2]; }
        __syncthreads();
    }
    if (bid == 0 && tid < 4) ((unsigned*)(p.ws + WS_CTR))[tid] = 0u;
    if (bid == nb - 1) {
        float* tab = (float*)(p.ws + WS_TAB);
        for (int e = tid; e < 64 * 16; e += 512) { const int pos = e >> 4, f = e & 15; const float inv = powf(10000.f, -(float)(2 * f) / 32.f); const float a = (float)pos * inv; tab[e] = cosf(a); tab[1024 + e] = sinf(a); }
        for (int e = tid; e < 64 * 8; e += 512) { const int pos = e >> 3, f = e & 7; const float inv = powf(10000.f, -(float)(2 * f) / 16.f); const float a = (float)pos * inv; tab[2048 + e] = cosf(a); tab[2560 + e] = sinf(a); }
    }
}

struct RowJob { const float* xsrc; const bf16_t* z; const float* gpost; const float* gate; float* xdst; const float* gpre; const float* shift; const float* scale; bf16_t* hdst; };
__device__ __forceinline__ RowJob make_rowjob(const Params& p, int mode, int l, int row) {
    const float* mod = (const float*)(p.ws + WS_MOD);
    bf16_t* HB = (bf16_t*)(p.ws + WS_HB); const bf16_t* Z = (const bf16_t*)(p.ws + WS_Z);
    float* XC = (float*)(p.ws + WS_XC);
    const SeqInfo s = seq_of_row(row);
    const int mr = s.isctx ? 8 : s.b;
    const float* m_l = mod + ((size_t)l * 9 + mr) * 6144;
    float* xs = s.isctx ? XC + (size_t)(row - TMAIN) * DM : p.out + (size_t)row * DM;
    const float* xin = s.isctx ? p.in[2] + (size_t)(row - TMAIN) * DM : p.in[0] + (size_t)row * DM;
    RowJob j;
    if (mode == 0) { j = RowJob{xin, nullptr, nullptr, nullptr, nullptr, p.in[6] + l * DM, m_l + 0, m_l + 1024, HB + (size_t)row * DM}; }
    else if (mode == 1) { j = RowJob{l == 0 ? xin : xs, Z + (size_t)row * DM, p.in[7] + l * DM, m_l + 2048, xs, p.in[8] + l * DM, m_l + 3072, m_l + 4096, HB + (size_t)row * DM}; }
    else { const bool has_next = (l + 1 < 2); const float* m_n = mod + ((size_t)(has_next ? l + 1 : l) * 9 + mr) * 6144;
        j = RowJob{xs, Z + (size_t)row * DM, p.in[9] + l * DM, m_l + 5120, xs, p.in[6] + (has_next ? l + 1 : l) * DM, m_n + 0, m_n + 1024, has_next ? HB + (size_t)row * DM : nullptr}; }
    return j;
}
template <int RB>
__device__ __forceinline__ void rowop_batch(const RowJob (&jb)[RB], const bool (&valid)[RB], int lane) {
    f32x4 v[RB][4]; u32x2 zu[RB][4];
#pragma unroll
    for (int r = 0; r < RB; ++r) if (valid[r]) {
#pragma unroll
        for (int j = 0; j < 4; ++j) { v[r][j] = *(const f32x4*)(jb[r].xsrc + (j * 64 + lane) * 4); if (jb[r].z) zu[r][j] = *(const u32x2*)(jb[r].z + (j * 64 + lane) * 4); }
    }
#pragma unroll
    for (int r = 0; r < RB; ++r) if (valid[r]) {
        const RowJob& J = jb[r];
        if (J.z) {
            f32x4 zz[4], gp[4], gt[4]; float ss = 0.f;
#pragma unroll
            for (int j = 0; j < 4; ++j) { const int c = (j * 64 + lane) * 4; gp[j] = *(const f32x4*)(J.gpost + c); gt[j] = *(const f32x4*)(J.gate + c); }
#pragma unroll
            for (int j = 0; j < 4; ++j) { const u32x2 u = zu[r][j];
                zz[j].x = bf2f((bf16_t)(u.x & 0xffff)); zz[j].y = bf2f((bf16_t)(u.x >> 16)); zz[j].z = bf2f((bf16_t)(u.y & 0xffff)); zz[j].w = bf2f((bf16_t)(u.y >> 16));
                ss += zz[j].x * zz[j].x + zz[j].y * zz[j].y + zz[j].z * zz[j].z + zz[j].w * zz[j].w; }
            const float rinv = 1.f / sqrtf(wave_sum(ss) * (1.f / 1024.f) + 1e-6f);
#pragma unroll
            for (int j = 0; j < 4; ++j) { const int c = (j * 64 + lane) * 4;
                v[r][j].x += gt[j].x * (zz[j].x * rinv * gp[j].x); v[r][j].y += gt[j].y * (zz[j].y * rinv * gp[j].y); v[r][j].z += gt[j].z * (zz[j].z * rinv * gp[j].z); v[r][j].w += gt[j].w * (zz[j].w * rinv * gp[j].w);
                *(f32x4*)(J.xdst + c) = v[r][j]; }
        }
        if (J.hdst) {
            f32x4 g[4], sh[4], sc[4]; float ss = 0.f;
#pragma unroll
            for (int j = 0; j < 4; ++j) { const int c = (j * 64 + lane) * 4; g[j] = *(const f32x4*)(J.gpre + c); sh[j] = *(const f32x4*)(J.shift + c); sc[j] = *(const f32x4*)(J.scale + c); }
#pragma unroll
            for (int j = 0; j < 4; ++j) ss += v[r][j].x * v[r][j].x + v[r][j].y * v[r][j].y + v[r][j].z * v[r][j].z + v[r][j].w * v[r][j].w;
            const float rinv = 1.f / sqrtf(wave_sum(ss) * (1.f / 1024.f) + 1e-6f);
#pragma unroll
            for (int j = 0; j < 4; ++j) { const int c = (j * 64 + lane) * 4;
                u32x2 o; o.x = pk2(v[r][j].x * rinv * g[j].x * (1.f + sc[j].x) + sh[j].x, v[r][j].y * rinv * g[j].y * (1.f + sc[j].y) + sh[j].y);
                o.y = pk2(v[r][j].z * rinv * g[j].z * (1.f + sc[j].z) + sh[j].z, v[r][j].w * rinv * g[j].w * (1.f + sc[j].w) + sh[j].w);
                *(u32x2*)(J.hdst + c) = o; }
        }
    }
}
__device__ __forceinline__ void phase_rowops(const Params& p, int mode, int l, int nrows, int bid, int nb) {
    const int tid = get_tid(), lane = tid & 63, wave = tid >> 6;
    constexpr int RB = 4;
    const int nwaves = nb * 8, gw = bid * 8 + wave;
    for (int base = gw; base < nrows; base += nwaves * RB) {
        RowJob jb[RB]; bool valid[RB];
#pragma unroll
        for (int r = 0; r < RB; ++r) { const int row = base + r * nwaves; valid[r] = row < nrows; jb[r] = make_rowjob(p, mode, l, valid[r] ? row : 0); }
        rowop_batch<RB>(jb, valid, lane);
    }
}

__device__ __forceinline__ void rwkv_prep_item(const Params& p, int l, LAS unsigned char* lds, int tile) {
    const int tid = get_tid(), lane = tid & 63, wave = tid >> 6, fr = lane & 15, fq = lane >> 4;
    const bf16_t* P = (const bf16_t*)(p.ws + WS_P);
    const int t0 = tile * 32; const SeqInfo s0 = seq_of_row(t0);
    const float* mu = p.in[14] + l * 1024;
    LAS bf16_t* r_s = (LAS bf16_t*)lds;
    LAS bf16_t* k_s = r_s + 32 * 256;
    LAS bf16_t* v_s = k_s + 32 * 256;
    LAS unsigned char* twd = lds + 3 * 16384;
    LAS unsigned char* ads = twd + 32 * 144;
    LAS float* O1 = (LAS float*)(ads + 32 * 144);
#pragma unroll
    for (int it = 0; it < 7; ++it) {
        const int pc = tid + it * 512; const int tok = pc / 112, c8 = pc % 112, cc = c8 * 8;
        const int pcol = cc < 256 ? PC_RWR + cc : PC_RWK + (cc - 256);
        const int row = t0 + tok, pos = s0.pos + tok;
        const u32x4 u0 = *(const u32x4*)(P + (size_t)row * NP + pcol);
        const u32x4 um = pos > 0 ? *(const u32x4*)(P + (size_t)(row - 1) * NP + pcol) : (u32x4){0u, 0u, 0u, 0u};
        const u32x4 up = pos < s0.len - 1 ? *(const u32x4*)(P + (size_t)(row + 1) * NP + pcol) : (u32x4){0u, 0u, 0u, 0u};
        const f32x4 mu0 = *(const f32x4*)(mu + cc), mu1 = *(const f32x4*)(mu + cc + 4);
        float z0[8], zm[8], zp[8], zs[8]; unpack8(u0, z0); unpack8(um, zm); unpack8(up, zp);
        const float mm[8] = {mu0.x, mu0.y, mu0.z, mu0.w, mu1.x, mu1.y, mu1.z, mu1.w};
#pragma unroll
        for (int x = 0; x < 8; ++x) zs[x] = z0[x] + mm[x] * (0.5f * (zm[x] + zp[x]) - z0[x]);
        LAS unsigned char* dst;
        if (cc < 256) dst = (LAS unsigned char*)(r_s + tok * 256 + cc);
        else if (cc < 512) dst = (LAS unsigned char*)(k_s + tok * 256 + cc - 256);
        else if (cc < 768) dst = (LAS unsigned char*)(v_s + tok * 256 + cc - 512);
        else if (cc < 832) { dst = twd + tok * 144 + (cc - 768) * 2;
#pragma unroll
            for (int x = 0; x < 8; ++x) zs[x] = 1.f - 2.f * __builtin_amdgcn_rcpf(1.f + __expf(2.f * zs[x])); }
        else dst = ads + tok * 144 + (cc - 832) * 2;
        *(LAS u32x4*)dst = (u32x4){cvt_pk_bf16(zs[0], zs[1]), cvt_pk_bf16(zs[2], zs[3]), cvt_pk_bf16(zs[4], zs[5]), cvt_pk_bf16(zs[6], zs[7])};
    }
    __syncthreads();
    const int hh = tid >> 8, c = tid & 255, h = c >> 6;
    bf16_t* RK = (bf16_t*)(p.ws + WS_RWK); bf16_t* RV = (bf16_t*)(p.ws + WS_RWV); bf16_t* RR = (bf16_t*)(p.ws + WS_RWRR);
    bf16_t* RA0 = (bf16_t*)(p.ws + WS_RWA0); bf16_t* RA1 = (bf16_t*)(p.ws + WS_RWA1); bf16_t* RM0 = (bf16_t*)(p.ws + WS_RWM0); bf16_t* RM1 = (bf16_t*)(p.ws + WS_RWM1);
    float* BON = (float*)(p.ws + WS_BON);
#pragma unroll
    for (int pass = 0; pass < 2; ++pass) {
        { const bf16_t* WT = (const bf16_t*)(p.ws + WS_LORAT + ((size_t)l * 4 + pass * 2) * 256 * 64 * 2);
          LAS unsigned char* A = pass ? ads : twd;
          const bf16x8 x00 = *(const LAS bf16x8*)(A + fr * 144 + fq * 16), x01 = *(const LAS bf16x8*)(A + fr * 144 + 64 + fq * 16);
          const bf16x8 x10 = *(const LAS bf16x8*)(A + (16 + fr) * 144 + fq * 16), x11 = *(const LAS bf16x8*)(A + (16 + fr) * 144 + 64 + fq * 16);
          bf16x8 b0[4], b1[4];
#pragma unroll
          for (int q = 0; q < 4; ++q) { const int t = wave * 4 + q, m = t >> 4, nt = t & 15; const bf16_t* wrow = WT + (size_t)m * 256 * 64 + (size_t)(nt * 16 + fr) * 64 + fq * 8;
              b0[q] = *(const bf16x8*)wrow; b1[q] = *(const bf16x8*)(wrow + 32); }
#pragma unroll
          for (int q = 0; q < 4; ++q) { const int t = wave * 4 + q, m = t >> 4, nt = t & 15;
              f32x4 a0 = (f32x4){0.f, 0.f, 0.f, 0.f}, a1 = a0;
              a0 = __builtin_amdgcn_mfma_f32_16x16x32_bf16(x00, b0[q], a0, 0, 0, 0); a0 = __builtin_amdgcn_mfma_f32_16x16x32_bf16(x01, b1[q], a0, 0, 0, 0);
              a1 = __builtin_amdgcn_mfma_f32_16x16x32_bf16(x10, b0[q], a1, 0, 0, 0); a1 = __builtin_amdgcn_mfma_f32_16x16x32_bf16(x11, b1[q], a1, 0, 0, 0);
#pragma unroll
              for (int r = 0; r < 4; ++r) { O1[(m * 32 + fq * 4 + r) * 256 + nt * 16 + fr] = a0[r]; O1[(m * 32 + 16 + fq * 4 + r) * 256 + nt * 16 + fr] = a1[r]; } } }
        __syncthreads();
        if (pass == 0) {
            const float w0b0 = p.in[15][(l * 2 + 0) * 256 + c], w0b1 = p.in[15][(l * 2 + 1) * 256 + c];
#pragma unroll
            for (int i = 0; i < 16; ++i) { const int tok = hh * 16 + i; const size_t o = (size_t)(t0 + tok) * 256 + c;
                const float sg0 = sigmoidf_(w0b0 + O1[tok * 256 + c]), sg1 = sigmoidf_(w0b1 + O1[(32 + tok) * 256 + c]);
                RM0[o] = f2bf(1.f - __expf(-0.60653066f * sg0)); RM1[o] = f2bf(1.f - __expf(-0.60653066f * sg1)); }
        } else {
            const float a0b0 = p.in[17][(l * 2 + 0) * 256 + c], a0b1 = p.in[17][(l * 2 + 1) * 256 + c];
            const float ka = p.in[21][l * 256 + c], rk = p.in[22][l * 256 + c];
#pragma unroll
            for (int i = 0; i < 16; ++i) { const int tok = hh * 16 + i, row = t0 + tok; const size_t o = (size_t)row * 256 + c;
                const bf16_t kb = k_s[tok * 256 + c], vb = v_s[tok * 256 + c], rb = r_s[tok * 256 + c];
                const float k = bf2f(kb), r = bf2f(rb);
                const float a0 = sigmoidf_(a0b0 + O1[tok * 256 + c]), a1 = sigmoidf_(a0b1 + O1[(32 + tok) * 256 + c]);
                const float kt0 = k * (1.f + (a0 - 1.f) * ka), kt1 = k * (1.f + (a1 - 1.f) * ka);
                const float bs = wave_sum(r * (kt0 + kt1) * rk);
                RK[o] = kb; RV[o] = vb; RR[o] = rb; RA0[o] = f2bf(a0); RA1[o] = f2bf(a1);
                if ((tid & 63) == 0) BON[(size_t)row * 4 + h] = bs; }
        }
        __syncthreads();
    }
}
__device__ __forceinline__ int ret_chunk_index(int cr, int& b) { if (cr < 256) { b = cr >> 5; return 2 + (cr & 31); } b = (cr - 256) >> 1; return (cr - 256) & 1; }
__device__ __forceinline__ void ret_kv_item(const Params& p, LAS unsigned char* lds, int item) {
    const int tid = get_tid();
    const bf16_t* P = (const bf16_t*)(p.ws + WS_P);
    const int cr = item >> 2, h = item & 3; int b; const int ci = ret_chunk_index(cr, b);
    const int r0 = cr * 128;
    LAS float* Ks = (LAS float*)lds;
    LAS float* Vs = Ks + 128 * 64;
    LAS float* dec = Vs + 128 * 64;
    const float lg = log1pf(-exp2f(-5.f - (float)h));
    for (int e = tid; e < 128 * 64; e += 512) { const int j = e >> 6, d = e & 63;
        Ks[e] = bf2f(P[(size_t)(r0 + j) * NP + PC_RETK + h * 64 + d]) * 0.125f; Vs[e] = bf2f(P[(size_t)(r0 + j) * NP + PC_RETV + h * 64 + d]); }
    if (tid < 128) dec[tid] = expf((float)tid * lg);
    __syncthreads();
    const int d = tid >> 3, e0 = (tid & 7) * 8;
    float af[8], ab[8];
#pragma unroll
    for (int i = 0; i < 8; ++i) { af[i] = 0.f; ab[i] = 0.f; }
    for (int j = 0; j < 128; ++j) { const float kd = Ks[j * 64 + d]; const float kf = kd * dec[127 - j], kb = kd * dec[j];
        const f32x4 v0 = *(const LAS f32x4*)(Vs + j * 64 + e0), v1 = *(const LAS f32x4*)(Vs + j * 64 + e0 + 4);
        af[0] += kf * v0.x; af[1] += kf * v0.y; af[2] += kf * v0.z; af[3] += kf * v0.w; af[4] += kf * v1.x; af[5] += kf * v1.y; af[6] += kf * v1.z; af[7] += kf * v1.w;
        ab[0] += kb * v0.x; ab[1] += kb * v0.y; ab[2] += kb * v0.z; ab[3] += kb * v0.w; ab[4] += kb * v1.x; ab[5] += kb * v1.y; ab[6] += kb * v1.z; ab[7] += kb * v1.w; }
    float* RS = (float*)(p.ws + WS_RET) + ((size_t)((b * 4 + h) * 34 + ci) * 2) * 4096;
#pragma unroll
    for (int i = 0; i < 8; ++i) { RS[d * 64 + e0 + i] = af[i]; RS[4096 + d * 64 + e0 + i] = ab[i]; }
    __syncthreads();
}
__device__ __forceinline__ void swa_prep_item(const Params& p, LAS unsigned char* lds, int tile) {
    const int tid = get_tid();
    bf16_t* P = (bf16_t*)(p.ws + WS_P);
    const float* tabc = (const float*)(p.ws + WS_TAB); const float* tabs = tabc + 1024;
    bf16_t* KS = (bf16_t*)(p.ws + WS_KS); bf16_t* VT = (bf16_t*)(p.ws + WS_VTS);
    const int t0 = tile * 64; const SeqInfo s0 = seq_of_row(t0);
    const int key0 = s0.isctx ? s0.pos : CTXL + s0.pos;
    LAS bf16_t* Vs = (LAS bf16_t*)lds;
    u32x4 vreg[2];
#pragma unroll
    for (int it = 0; it < 2; ++it) { const int pc = tid + it * 512, tok = pc >> 4, c8 = pc & 15; vreg[it] = *(const u32x4*)(P + (size_t)(t0 + tok) * NP + PC_SWAV + c8 * 8); }
    u32x4 x1[3], x2[3];
#pragma unroll
    for (int it = 0; it < 3; ++it) { const int e = tid + it * 512; const int tok = e / 24, rem = e % 24, hd = rem >> 2, axis = (rem >> 1) & 1, fg = rem & 1;
        const int colbase = (hd < 4 ? PC_SWAQ + hd * 64 : PC_SWAK + (hd - 4) * 64) + axis * 32 + fg * 8;
        x1[it] = *(const u32x4*)(P + (size_t)(t0 + tok) * NP + colbase); x2[it] = *(const u32x4*)(P + (size_t)(t0 + tok) * NP + colbase + 16); }
#pragma unroll
    for (int it = 0; it < 2; ++it) { const int pc = tid + it * 512, tok = pc >> 4, c8 = pc & 15; *(LAS u32x4*)(Vs + tok * 136 + c8 * 8) = vreg[it]; }
#pragma unroll
    for (int it = 0; it < 3; ++it) { const int e = tid + it * 512; const int tok = e / 24, rem = e % 24, hd = rem >> 2, axis = (rem >> 1) & 1, fg = rem & 1;
        const int row = t0 + tok, pos = s0.pos + tok;
        const int colbase = (hd < 4 ? PC_SWAQ + hd * 64 : PC_SWAK + (hd - 4) * 64) + axis * 32 + fg * 8;
        float a[8], bb[8]; unpack8(x1[it], a); unpack8(x2[it], bb);
        if (!s0.isctx) { const int pp = axis == 0 ? (pos >> 6) : (pos & 63);
            const f32x4 c0 = *(const f32x4*)(tabc + pp * 16 + fg * 8), c1 = *(const f32x4*)(tabc + pp * 16 + fg * 8 + 4), s0v = *(const f32x4*)(tabs + pp * 16 + fg * 8), s1v = *(const f32x4*)(tabs + pp * 16 + fg * 8 + 4);
            const float cs[8] = {c0.x, c0.y, c0.z, c0.w, c1.x, c1.y, c1.z, c1.w}, sn[8] = {s0v.x, s0v.y, s0v.z, s0v.w, s1v.x, s1v.y, s1v.z, s1v.w};
#pragma unroll
            for (int x = 0; x < 8; ++x) { const float y1 = a[x] * cs[x] - bb[x] * sn[x], y2 = bb[x] * cs[x] + a[x] * sn[x]; a[x] = y1; bb[x] = y2; } }
        u32x4 o1, o2; o1.x = pk2(a[0], a[1]); o1.y = pk2(a[2], a[3]); o1.z = pk2(a[4], a[5]); o1.w = pk2(a[6], a[7]);
        o2.x = pk2(bb[0], bb[1]); o2.y = pk2(bb[2], bb[3]); o2.z = pk2(bb[4], bb[5]); o2.w = pk2(bb[6], bb[7]);
        if (hd < 4) { if (!s0.isctx) { *(u32x4*)(P + (size_t)row * NP + colbase) = o1; *(u32x4*)(P + (size_t)row * NP + colbase + 16) = o2; } }
        else { bf16_t* kd = KS + ((size_t)(s0.b * 2 + (hd - 4)) * NKEYS + key0 + tok) * 64 + axis * 32 + fg * 8; *(u32x4*)kd = o1; *(u32x4*)(kd + 16) = o2; }
    }
    __syncthreads();
#pragma unroll
    for (int it = 0; it < 2; ++it) { const int pc = tid + it * 512, hd = pc >> 3, k8 = pc & 7, hk = hd >> 6, d = hd & 63;
        unsigned w[4];
#pragma unroll
        for (int x = 0; x < 4; ++x) w[x] = (unsigned)Vs[(k8 * 8 + 2 * x) * 136 + hd] | ((unsigned)Vs[(k8 * 8 + 2 * x + 1) * 136 + hd] << 16);
        *(u32x4*)(VT + ((size_t)(s0.b * 2 + hk) * 64 + d) * NKEYS + key0 + k8 * 8) = (u32x4){w[0], w[1], w[2], w[3]}; }
    __syncthreads();
}
__device__ __forceinline__ void mla_proj_item(const Params& p, int l, LAS unsigned char* lds, int tile);
__device__ __forceinline__ void phase_prepA(const Params& p, int l, LAS unsigned char* lds, int bid, int nb) {
    constexpr int N1 = TT / 32, N2 = 272 * 4, N3 = TT / 64, N4 = TT / 32;
    for (int it = bid; it < N1 + N2 + N3 + N4; it += nb) {
        if (it < N1) rwkv_prep_item(p, l, lds, it);
        else if (it < N1 + N2) ret_kv_item(p, lds, it - N1);
        else if (it < N1 + N2 + N3) swa_prep_item(p, lds, it - N1 - N2);
        else mla_proj_item(p, l, lds, it - N1 - N2 - N3);
    }
}

__device__ __forceinline__ void mla_proj_item(const Params& p, int l, LAS unsigned char* lds, int tile) {
    const int tid = get_tid(), lane = tid & 63, wave = tid >> 6, fr = lane & 15, fq = lane >> 4;
    const bf16_t* P = (const bf16_t*)(p.ws + WS_P);
    const float* tabc = (const float*)(p.ws + WS_TAB) + 2048; const float* tabs = tabc + 512;
    const int t0 = tile * 32; const SeqInfo s0 = seq_of_row(t0);
    const int key0 = s0.isctx ? s0.pos : CTXL + s0.pos;
    LAS unsigned char* qn = lds;
    LAS unsigned char* kvn = lds + 32 * 528;
    LAS float* qo = (LAS float*)(lds + 32 * 528 + 32 * 272);
    LAS float* kvo = qo + 32 * 384;
    const float* qg = p.in[24] + l * 256; const float* kvg = p.in[26] + l * 128;
    for (int i = 0; i < 4; ++i) { const int tok = wave * 4 + i, row = t0 + tok;
        float x[4]; float ss = 0.f;
#pragma unroll
        for (int j = 0; j < 4; ++j) { x[j] = bf2f(P[(size_t)row * NP + PC_MLAQD + j * 64 + lane]); ss += x[j] * x[j]; }
        const float rq = 1.f / sqrtf(wave_sum(ss) * (1.f / 256.f) + 1e-6f);
#pragma unroll
        for (int j = 0; j < 4; ++j) *(LAS bf16_t*)(qn + tok * 528 + (j * 64 + lane) * 2) = f2bf(x[j] * rq * qg[j * 64 + lane]);
        float y[2]; float s2 = 0.f;
#pragma unroll
        for (int j = 0; j < 2; ++j) { y[j] = bf2f(P[(size_t)row * NP + PC_MLAKVD + j * 64 + lane]); s2 += y[j] * y[j]; }
        const float rk = 1.f / sqrtf(wave_sum(s2) * (1.f / 128.f) + 1e-6f);
#pragma unroll
        for (int j = 0; j < 2; ++j) *(LAS bf16_t*)(kvn + tok * 272 + (j * 64 + lane) * 2) = f2bf(y[j] * rk * kvg[j * 64 + lane]);
    }
    __syncthreads();
    {
        const bf16_t* WqT = (const bf16_t*)(p.ws + WS_MLAW + (size_t)l * MLAW_LAYER);
        const bf16_t* WkvT = (const bf16_t*)(p.ws + WS_MLAW + (size_t)l * MLAW_LAYER + MLAW_KV);
        for (int nt = wave; nt < 56; nt += 8) {
            f32x4 a0 = (f32x4){0.f, 0.f, 0.f, 0.f}, a1 = a0;
            if (nt < 24) {
                const bf16_t* wrow = WqT + (size_t)(nt * 16 + fr) * 256 + fq * 8;
#pragma unroll
                for (int kc = 0; kc < 8; ++kc) { const bf16x8 bfr = *(const bf16x8*)(wrow + kc * 32);
                    const bf16x8 x0 = *(const LAS bf16x8*)(qn + fr * 528 + kc * 64 + fq * 16), x1 = *(const LAS bf16x8*)(qn + (16 + fr) * 528 + kc * 64 + fq * 16);
                    a0 = __builtin_amdgcn_mfma_f32_16x16x32_bf16(x0, bfr, a0, 0, 0, 0); a1 = __builtin_amdgcn_mfma_f32_16x16x32_bf16(x1, bfr, a1, 0, 0, 0); }
#pragma unroll
                for (int r = 0; r < 4; ++r) { qo[(fq * 4 + r) * 384 + nt * 16 + fr] = a0[r]; qo[(16 + fq * 4 + r) * 384 + nt * 16 + fr] = a1[r]; }
            } else {
                const int n0 = (nt - 24) * 16;
                const bf16_t* wrow = WkvT + (size_t)(n0 + fr) * 128 + fq * 8;
#pragma unroll
                for (int kc = 0; kc < 4; ++kc) { const bf16x8 bfr = *(const bf16x8*)(wrow + kc * 32);
                    const bf16x8 x0 = *(const LAS bf16x8*)(kvn + fr * 272 + kc * 64 + fq * 16), x1 = *(const LAS bf16x8*)(kvn + (16 + fr) * 272 + kc * 64 + fq * 16);
                    a0 = __builtin_amdgcn_mfma_f32_16x16x32_bf16(x0, bfr, a0, 0, 0, 0); a1 = __builtin_amdgcn_mfma_f32_16x16x32_bf16(x1, bfr, a1, 0, 0, 0); }
#pragma unroll
                for (int r = 0; r < 4; ++r) { kvo[(fq * 4 + r) * 512 + n0 + fr] = a0[r]; kvo[(16 + fq * 4 + r) * 512 + n0 + fr] = a1[r]; }
            }
        }
    }
    __syncthreads();
    {
        const int h = tid >> 7, dd = tid & 127;
        if (dd < 64) { bf16_t* KM = (bf16_t*)(p.ws + WS_KM) + ((size_t)(s0.b * 4 + h) * NKEYS + key0) * 96 + dd;
#pragma unroll
            for (int i = 0; i < 32; ++i) KM[(size_t)i * 96] = f2bf(kvo[i * 512 + tid]); }
        else { bf16_t* VT = (bf16_t*)(p.ws + WS_VTM) + ((size_t)(s0.b * 4 + h) * 64 + (dd - 64)) * NKEYS + key0;
            unsigned w[16];
#pragma unroll
            for (int i = 0; i < 16; ++i) w[i] = pk2(kvo[(2 * i) * 512 + tid], kvo[(2 * i + 1) * 512 + tid]);
#pragma unroll
            for (int i = 0; i < 4; ++i) *(u32x4*)(VT + i * 8) = (u32x4){w[4 * i], w[4 * i + 1], w[4 * i + 2], w[4 * i + 3]}; }
    }
    bf16_t* MQ = (bf16_t*)(p.ws + WS_MQ);
    for (int e = tid; e < 32 * 384; e += 512) { const int tok = e / 384, c = e % 384, dd = c % 96; const int pos = s0.pos + tok;
        float v = qo[e];
        if (dd >= 64 && !s0.isctx) { const int pe = dd - 64, axis = pe >> 4, half = (pe >> 3) & 1, f = pe & 7; const int pp = axis == 0 ? (pos >> 6) : (pos & 63);
            const float cs = tabc[pp * 8 + f], sn = tabs[pp * 8 + f];
            const float x1 = half ? qo[e - 8] : v, x2 = half ? v : qo[e + 8];
            v = half ? (x2 * cs + x1 * sn) : (x1 * cs - x2 * sn); }
        MQ[(size_t)(t0 + tok) * 384 + c] = f2bf(v); }
    for (int e = tid; e < 32 * 32; e += 512) { const int tok = e >> 5, pe = e & 31, axis = pe >> 4, half = (pe >> 3) & 1, f = pe & 7; const int row = t0 + tok, pos = s0.pos + tok;
        float v = bf2f(P[(size_t)row * NP + PC_MLAKPE + pe]);
        if (!s0.isctx) { const int pp = axis == 0 ? (pos >> 6) : (pos & 63); const float cs = tabc[pp * 8 + f], sn = tabs[pp * 8 + f];
            const float other = bf2f(P[(size_t)row * NP + PC_MLAKPE + (half ? pe - 8 : pe + 8)]);
            const float x1 = half ? other : v, x2 = half ? v : other;
            v = half ? (x2 * cs + x1 * sn) : (x1 * cs - x2 * sn); }
        const bf16_t o = f2bf(v);
#pragma unroll
        for (int h = 0; h < 4; ++h) ((bf16_t*)(p.ws + WS_KM))[((size_t)(s0.b * 4 + h) * NKEYS + key0 + tok) * 96 + 64 + pe] = o; }
    __syncthreads();
}
__device__ __forceinline__ void ret_scan_item(const Params& p, int l, int item) {
    const int tid = get_tid(); const int seq = item >> 1, dir = item & 1, h = seq & 3;
    const float lg = log1pf(-exp2f(-5.f - (float)h)); const float cdec = expf(128.f * lg);
    float* base = (float*)(p.ws + WS_RET) + (size_t)seq * 34 * 2 * 4096 + dir * 4096;
    auto ci_of = [&](int st) -> int { return dir == 0 ? st : (st == 0 ? 1 : (st == 1 ? 0 : 35 - st)); };
    float S[8];
#pragma unroll
    for (int i = 0; i < 8; ++i) S[i] = 0.f;
    f32x4 pa[4], pb[4];
#pragma unroll
    for (int k = 0; k < 4; ++k) { const float* q = base + (size_t)ci_of(k) * 2 * 4096 + tid * 8; pa[k] = *(const f32x4*)q; pb[k] = *(const f32x4*)(q + 4); }
#pragma unroll 1
    for (int st0 = 0; st0 < 36; st0 += 4) {
#pragma unroll
        for (int k = 0; k < 4; ++k) { const int st = st0 + k;
            if (st < 34) {
                float* q = base + (size_t)ci_of(st) * 2 * 4096 + tid * 8;
                const f32x4 t0 = pa[k], t1 = pb[k];
                if (st + 4 < 34) { const float* qn = base + (size_t)ci_of(st + 4) * 2 * 4096 + tid * 8; pa[k] = *(const f32x4*)qn; pb[k] = *(const f32x4*)(qn + 4); }
                *(f32x4*)q = (f32x4){S[0], S[1], S[2], S[3]}; *(f32x4*)(q + 4) = (f32x4){S[4], S[5], S[6], S[7]};
                S[0] = S[0] * cdec + t0.x; S[1] = S[1] * cdec + t0.y; S[2] = S[2] * cdec + t0.z; S[3] = S[3] * cdec + t0.w;
                S[4] = S[4] * cdec + t1.x; S[5] = S[5] * cdec + t1.y; S[6] = S[6] * cdec + t1.z; S[7] = S[7] * cdec + t1.w;
            } }
    }
    asm volatile("s_waitcnt vmcnt(0)" ::: "memory");
    __syncthreads();
    if (tid == 0) { __builtin_amdgcn_fence(__ATOMIC_RELEASE, "agent"); asm volatile("s_waitcnt vmcnt(0)" ::: "memory");
        __hip_atomic_fetch_add((unsigned*)(p.ws + WS_CTR) + 2 + l, 1u, __ATOMIC_RELAXED, __HIP_MEMORY_SCOPE_AGENT); }
}
__device__ __forceinline__ void ret_wait_states(const Params& p, int l) {
    if (get_tid() == 0) { unsigned* f = (unsigned*)(p.ws + WS_CTR) + 2 + l; unsigned sp = 0;
        while (__hip_atomic_load(f, __ATOMIC_RELAXED, __HIP_MEMORY_SCOPE_AGENT) < 64u) { __builtin_amdgcn_s_sleep(4); if (++sp > (1u << 22)) break; }
        __builtin_amdgcn_fence(__ATOMIC_ACQUIRE, "agent"); asm volatile("s_waitcnt vmcnt(0)" ::: "memory"); }
    __syncthreads();
}
template <int DK>
__device__ __forceinline__ void attn_unit(const bf16_t* Q, int qstride, const bf16_t* K, const bf16_t* Vt, int nctx, int mt0, int mt1, bool masked, int qpos0,
                                          bool has_sink, float sink, float scale, bf16_t* O, int ostride, LAS unsigned char* lds) {
    constexpr int KC = DK / 32, KP = DK + 8, KROW = KP * 2;
    constexpr int PIECES_K = 64 * DK / 8;
    constexpr int BUFB = 64 * KROW + 64 * 144;
    const int tid = get_tid(), lane = tid & 63, wave = tid >> 6, fr = lane & 15, fq = lane >> 4;
    const float sl2 = scale * 1.44269504f;
    bf16x8 qf[2][KC];
#pragma unroll
    for (int g = 0; g < 2; ++g)
#pragma unroll
        for (int kc = 0; kc < KC; ++kc) { const u32x4 u = *(const u32x4*)(Q + (size_t)(wave * 32 + g * 16 + fr) * qstride + kc * 32 + fq * 8); float f[8]; unpack8(u, f);
            u32x4 o; o.x = cvt_pk_bf16(f[0] * sl2, f[1] * sl2); o.y = cvt_pk_bf16(f[2] * sl2, f[3] * sl2); o.z = cvt_pk_bf16(f[4] * sl2, f[5] * sl2); o.w = cvt_pk_bf16(f[6] * sl2, f[7] * sl2);
            qf[g][kc] = __builtin_bit_cast(bf16x8, o); }
    float mq[2] = {0.f, 0.f}, lsum[2] = {0.f, 0.f}; f32x4 o[2][4];
#pragma unroll
    for (int g = 0; g < 2; ++g)
#pragma unroll
        for (int n = 0; n < 4; ++n) o[g][n] = (f32x4){0.f, 0.f, 0.f, 0.f};
    const int ntiles = nctx + (mt1 - mt0);
    u32x4 kr[2], vr;
    auto issue = [&](int ti) {
        const int tile = ti < nctx ? ti : mt0 + (ti - nctx);
        const bf16_t* kb = K + (size_t)tile * 64 * DK;
#pragma unroll
        for (int i = 0; i < 2; ++i) { const int pc = tid + i * 512; if (pc < PIECES_K) kr[i] = *(const u32x4*)(kb + (size_t)pc * 8); }
        { const int d = tid >> 3, c8 = tid & 7; vr = *(const u32x4*)(Vt + (size_t)d * NKEYS + tile * 64 + c8 * 8); }
    };
    auto stash = [&](int bufi) {
        LAS unsigned char* Kt = lds + bufi * BUFB; LAS unsigned char* Vl = Kt + 64 * KROW;
#pragma unroll
        for (int i = 0; i < 2; ++i) { const int pc = tid + i * 512; if (pc < PIECES_K) { const int row = pc / (DK / 8), c8 = pc % (DK / 8); *(LAS u32x4*)(Kt + row * KROW + c8 * 16) = kr[i]; } }
        { const int d = tid >> 3, c8 = tid & 7; *(LAS u32x4*)(Vl + d * 144 + c8 * 16) = vr; }
    };
    issue(0); stash(0);
    if (ntiles > 1) issue(1);
    __syncthreads();
    for (int ti = 0; ti < ntiles; ++ti) {
        const int tile = ti < nctx ? ti : mt0 + (ti - nctx);
        LAS unsigned char* Kt = lds + (ti & 1) * BUFB; LAS unsigned char* Vl = Kt + 64 * KROW;
        if (ti + 1 < ntiles) { stash((ti + 1) & 1); if (ti + 2 < ntiles) issue(ti + 2); }
        f32x4 s[2][4];
#pragma unroll
        for (int n = 0; n < 4; ++n) {
            s[0][n] = (f32x4){-mq[0], -mq[0], -mq[0], -mq[0]}; s[1][n] = (f32x4){-mq[1], -mq[1], -mq[1], -mq[1]};
#pragma unroll
            for (int kc = 0; kc < KC; ++kc) { const bf16x8 kf = *(const LAS bf16x8*)(Kt + (n * 16 + fr) * KROW + kc * 64 + fq * 16);
                s[0][n] = __builtin_amdgcn_mfma_f32_16x16x32_bf16(kf, qf[0][kc], s[0][n], 0, 0, 0);
                s[1][n] = __builtin_amdgcn_mfma_f32_16x16x32_bf16(kf, qf[1][kc], s[1][n], 0, 0, 0); } }
        if (ti == 0) {
#pragma unroll
            for (int g = 0; g < 2; ++g) {
                float t = -INFINITY;
#pragma unroll
                for (int n = 0; n < 4; ++n)
#pragma unroll
                    for (int r = 0; r < 4; ++r) t = fmaxf(t, s[g][n][r]);
                t = fmaxf(t, __shfl_xor(t, 16)); t = fmaxf(t, __shfl_xor(t, 32));
                if (has_sink) t = fmaxf(t, sink * 1.44269504f);
                mq[g] = t;
#pragma unroll
                for (int n = 0; n < 4; ++n)
#pragma unroll
                    for (int r = 0; r < 4; ++r) s[g][n][r] -= t;
            }
        }
        if (masked && ti >= nctx) {
#pragma unroll
            for (int g = 0; g < 2; ++g)
#pragma unroll
                for (int n = 0; n < 4; ++n)
#pragma unroll
                    for (int r = 0; r < 4; ++r) { const int kp = tile * 64 + n * 16 + fq * 4 + r - CTXL, qp = qpos0 + wave * 32 + g * 16 + fr; const int df = qp - kp; if (df > 128 || df < -128) s[g][n][r] = -INFINITY; }
        }
#pragma unroll
        for (int g = 0; g < 2; ++g)
#pragma unroll
            for (int n = 0; n < 4; ++n)
#pragma unroll
                for (int r = 0; r < 4; ++r) { s[g][n][r] = __builtin_amdgcn_exp2f(s[g][n][r]); lsum[g] += s[g][n][r]; }
#pragma unroll
        for (int c = 0; c < 2; ++c) {
            bf16x8 pf[2];
#pragma unroll
            for (int g = 0; g < 2; ++g) { u32x4 pu; pu.x = cvt_pk_bf16(s[g][2 * c][0], s[g][2 * c][1]); pu.y = cvt_pk_bf16(s[g][2 * c][2], s[g][2 * c][3]);
                pu.z = cvt_pk_bf16(s[g][2 * c + 1][0], s[g][2 * c + 1][1]); pu.w = cvt_pk_bf16(s[g][2 * c + 1][2], s[g][2 * c + 1][3]); pf[g] = __builtin_bit_cast(bf16x8, pu); }
#pragma unroll
            for (int n = 0; n < 4; ++n) {
                const u32x2 lo = *(const LAS u32x2*)(Vl + (n * 16 + fr) * 144 + ((2 * c) * 16 + fq * 4) * 2), hi = *(const LAS u32x2*)(Vl + (n * 16 + fr) * 144 + ((2 * c + 1) * 16 + fq * 4) * 2);
                const bf16x8 vf = __builtin_bit_cast(bf16x8, (u32x4){lo.x, lo.y, hi.x, hi.y});
                o[0][n] = __builtin_amdgcn_mfma_f32_16x16x32_bf16(vf, pf[0], o[0][n], 0, 0, 0);
                o[1][n] = __builtin_amdgcn_mfma_f32_16x16x32_bf16(vf, pf[1], o[1][n], 0, 0, 0); }
        }
        __syncthreads();
    }
#pragma unroll
    for (int g = 0; g < 2; ++g) {
        float t = lsum[g];
        t += __shfl_xor(t, 16); t += __shfl_xor(t, 32);
        if (has_sink) t += __builtin_amdgcn_exp2f(sink * 1.44269504f - mq[g]);
        const float inv = 1.f / t;
#pragma unroll
        for (int n = 0; n < 4; ++n) { u32x2 ov; ov.x = cvt_pk_bf16(o[g][n][0] * inv, o[g][n][1] * inv); ov.y = cvt_pk_bf16(o[g][n][2] * inv, o[g][n][3] * inv);
            *(u32x2*)(O + (size_t)(wave * 32 + g * 16 + fr) * ostride + n * 16 + fq * 4) = ov; }
    }
}

__device__ __forceinline__ void ret_out_item(const Params& p, int l, LAS unsigned char* lds, int item) {
    const int tid = get_tid(), lane = tid & 63, wave = tid >> 6, fr = lane & 15, fq = lane >> 4;
    bf16_t* P = (bf16_t*)(p.ws + WS_P);
    const int cr = item >> 2, h = item & 3; int b; const int ci = ret_chunk_index(cr, b);
    const int r0 = cr * 128;
    const float lg2 = log1pf(-exp2f(-5.f - (float)h)) * 1.44269504f;
    LAS unsigned char* Kb = lds;
    LAS unsigned char* Vt = lds + 18432;
    LAS unsigned char* SfT = lds + 35840;
    LAS unsigned char* SbT = lds + 45056;
    for (int pc = tid; pc < 1024; pc += 512) { const int j = pc >> 3, c8 = pc & 7;
        const u32x4 kk = *(const u32x4*)(P + (size_t)(r0 + j) * NP + PC_RETK + h * 64 + c8 * 8);
        const u32x4 vv = *(const u32x4*)(P + (size_t)(r0 + j) * NP + PC_RETV + h * 64 + c8 * 8);
        float kf[8]; unpack8(kk, kf);
        u32x4 ko; ko.x = pk2(kf[0] * 0.125f, kf[1] * 0.125f); ko.y = pk2(kf[2] * 0.125f, kf[3] * 0.125f); ko.z = pk2(kf[4] * 0.125f, kf[5] * 0.125f); ko.w = pk2(kf[6] * 0.125f, kf[7] * 0.125f);
        *(LAS u32x4*)(Kb + j * 144 + c8 * 16) = ko;
        const unsigned vw[4] = {vv.x, vv.y, vv.z, vv.w};
#pragma unroll
        for (int x = 0; x < 8; ++x) *(LAS bf16_t*)(Vt + (c8 * 8 + x) * 272 + j * 2) = (bf16_t)((x & 1) ? (vw[x >> 1] >> 16) : (vw[x >> 1] & 0xffff)); }
    { const float* RS = (const float*)(p.ws + WS_RET) + ((size_t)((b * 4 + h) * 34 + ci) * 2) * 4096;
      for (int pc = tid; pc < 1024; pc += 512) { const int d = pc >> 4, e4 = (pc & 15) * 4;
          const f32x4 a = *(const f32x4*)(RS + d * 64 + e4), bb = *(const f32x4*)(RS + 4096 + d * 64 + e4);
#pragma unroll
          for (int x = 0; x < 4; ++x) { *(LAS bf16_t*)(SfT + (e4 + x) * 144 + d * 2) = f2bf(a[x]); *(LAS bf16_t*)(SbT + (e4 + x) * 144 + d * 2) = f2bf(bb[x]); } } }
    const int i = wave * 16 + fr;
    u32x4 qraw[2];
#pragma unroll
    for (int kc = 0; kc < 2; ++kc) qraw[kc] = *(const u32x4*)(P + (size_t)(r0 + i) * NP + PC_RETQ + h * 64 + kc * 32 + fq * 8);
    __syncthreads();
    f32x4 s[8];
#pragma unroll
    for (int nb = 0; nb < 8; ++nb) { s[nb] = (f32x4){0.f, 0.f, 0.f, 0.f};
#pragma unroll
        for (int kc = 0; kc < 2; ++kc) { const bf16x8 kf = *(const LAS bf16x8*)(Kb + (nb * 16 + fr) * 144 + kc * 64 + fq * 16);
            s[nb] = __builtin_amdgcn_mfma_f32_16x16x32_bf16(kf, __builtin_bit_cast(bf16x8, qraw[kc]), s[nb], 0, 0, 0); } }
#pragma unroll
    for (int nb = 0; nb < 8; ++nb)
#pragma unroll
        for (int r = 0; r < 4; ++r) { const int j = nb * 16 + fq * 4 + r; const int df = i - j; const int adf = df < 0 ? -df : df;
            float dcy = __builtin_amdgcn_exp2f((float)adf * lg2); if (df == 0) dcy = 2.f; s[nb][r] *= dcy; }
    f32x4 o[4];
#pragma unroll
    for (int n = 0; n < 4; ++n) o[n] = (f32x4){0.f, 0.f, 0.f, 0.f};
#pragma unroll
    for (int c = 0; c < 4; ++c) {
        u32x4 pu; pu.x = cvt_pk_bf16(s[2 * c][0], s[2 * c][1]); pu.y = cvt_pk_bf16(s[2 * c][2], s[2 * c][3]); pu.z = cvt_pk_bf16(s[2 * c + 1][0], s[2 * c + 1][1]); pu.w = cvt_pk_bf16(s[2 * c + 1][2], s[2 * c + 1][3]);
        const bf16x8 pf = __builtin_bit_cast(bf16x8, pu);
#pragma unroll
        for (int n = 0; n < 4; ++n) {
            const u32x2 lo = *(const LAS u32x2*)(Vt + (n * 16 + fr) * 272 + ((2 * c) * 16 + fq * 4) * 2), hi = *(const LAS u32x2*)(Vt + (n * 16 + fr) * 272 + ((2 * c + 1) * 16 + fq * 4) * 2);
            const bf16x8 vf = __builtin_bit_cast(bf16x8, (u32x4){lo.x, lo.y, hi.x, hi.y});
            o[n] = __builtin_amdgcn_mfma_f32_16x16x32_bf16(vf, pf, o[n], 0, 0, 0); }
    }
    const float gf = __builtin_amdgcn_exp2f((float)(i + 1) * lg2), gb = __builtin_amdgcn_exp2f((float)(128 - i) * lg2);
#pragma unroll
    for (int kc = 0; kc < 2; ++kc) {
        float f[8]; unpack8(qraw[kc], f);
        u32x4 uf, ub;
        uf.x = cvt_pk_bf16(f[0] * gf, f[1] * gf); uf.y = cvt_pk_bf16(f[2] * gf, f[3] * gf); uf.z = cvt_pk_bf16(f[4] * gf, f[5] * gf); uf.w = cvt_pk_bf16(f[6] * gf, f[7] * gf);
        ub.x = cvt_pk_bf16(f[0] * gb, f[1] * gb); ub.y = cvt_pk_bf16(f[2] * gb, f[3] * gb); ub.z = cvt_pk_bf16(f[4] * gb, f[5] * gb); ub.w = cvt_pk_bf16(f[6] * gb, f[7] * gb);
        const bf16x8 qF = __builtin_bit_cast(bf16x8, uf), qB = __builtin_bit_cast(bf16x8, ub);
#pragma unroll
        for (int n = 0; n < 4; ++n) {
            const bf16x8 af = *(const LAS bf16x8*)(SfT + (n * 16 + fr) * 144 + kc * 64 + fq * 16), ab = *(const LAS bf16x8*)(SbT + (n * 16 + fr) * 144 + kc * 64 + fq * 16);
            o[n] = __builtin_amdgcn_mfma_f32_16x16x32_bf16(af, qF, o[n], 0, 0, 0);
            o[n] = __builtin_amdgcn_mfma_f32_16x16x32_bf16(ab, qB, o[n], 0, 0, 0); }
    }
    float sm = 0.f;
#pragma unroll
    for (int n = 0; n < 4; ++n) sm += (o[n][0] + o[n][1]) + (o[n][2] + o[n][3]);
    sm += __shfl_xor(sm, 16); sm += __shfl_xor(sm, 32);
    const float mu = sm * (1.f / 64.f);
    float vs = 0.f;
#pragma unroll
    for (int n = 0; n < 4; ++n)
#pragma unroll
        for (int r = 0; r < 4; ++r) { const float dl = o[n][r] - mu; vs += dl * dl; }
    vs += __shfl_xor(vs, 16); vs += __shfl_xor(vs, 32);
    const float rstd = 1.f / sqrtf(vs * (1.f / 64.f) + 1e-5f);
#pragma unroll
    for (int n = 0; n < 4; ++n) { const int e0 = n * 16 + fq * 4;
        const u32x2 gu = *(const u32x2*)(P + (size_t)(r0 + i) * NP + PC_RETG + h * 64 + e0);
        const f32x4 gn = *(const f32x4*)(p.in[13] + l * 256 + h * 64 + e0);
        const float g0 = bf2f((bf16_t)(gu.x & 0xffff)), g1 = bf2f((bf16_t)(gu.x >> 16)), g2 = bf2f((bf16_t)(gu.y & 0xffff)), g3 = bf2f((bf16_t)(gu.y >> 16));
        u32x2 yo;
        yo.x = cvt_pk_bf16((o[n][0] - mu) * rstd * gn.x * (g0 / (1.f + __expf(-g0))), (o[n][1] - mu) * rstd * gn.y * (g1 / (1.f + __expf(-g1))));
        yo.y = cvt_pk_bf16((o[n][2] - mu) * rstd * gn.z * (g2 / (1.f + __expf(-g2))), (o[n][3] - mu) * rstd * gn.w * (g3 / (1.f + __expf(-g3))));
        *(u32x2*)(P + (size_t)(r0 + i) * NP + PC_RETQ + h * 64 + e0) = yo; }
    __syncthreads();
}

constexpr int NSCANBLK = 128;
__device__ __forceinline__ void rwkv_scan_item(const Params& p, int l, LAS unsigned char* lds, int item) {
    const int tid = get_tid();
    const int sc = item >> 1, half = item & 1;
    const int b = sc >> 3, h = (sc >> 1) & 3, dir = sc & 1;
    const bf16_t* RK = (const bf16_t*)(p.ws + WS_RWK); const bf16_t* RV = (const bf16_t*)(p.ws + WS_RWV); const bf16_t* RR = (const bf16_t*)(p.ws + WS_RWRR);
    const bf16_t* RA = (const bf16_t*)(p.ws + (dir ? WS_RWA1 : WS_RWA0)); const bf16_t* RM = (const bf16_t*)(p.ws + (dir ? WS_RWM1 : WS_RWM0));
    bf16_t* P = (bf16_t*)(p.ws + WS_P);
    const int ocol = (dir ? PC_RWO1 : PC_RWO0) + h * 64 + half * 32;
    LAS float* KH = (LAS float*)lds;
    LAS float* WW = KH + 4096; LAS float* BB = WW + 4096; LAS float* KT = BB + 4096; LAS float* RRl = KT + 4096; LAS float* VV = RRl + 4096; LAS float* OUT = VV + 4096;
    const int st = tid >> 3, c0 = (tid & 7) * 8;
    float kkp[8], kap[8];
#pragma unroll
    for (int i = 0; i < 8; ++i) { kkp[i] = p.in[20][l * 256 + h * 64 + c0 + i]; kap[i] = p.in[21][l * 256 + h * 64 + c0 + i]; }
    const int row_l = tid >> 4, kq = tid & 15;
    f32x2 S[2];
#pragma unroll
    for (int i = 0; i < 2; ++i) S[i] = (f32x2){0.f, 0.f};
    auto row_of = [&](int s) -> int {
        if (s < CTXL) return TMAIN + b * CTXL + (dir ? CTXL - 1 - s : s);
        const int t = s - CTXL; return b * SEQL + (dir ? SEQL - 1 - t : t);
    };
    u32x4 gk, gv, gr, ga, gm;
    auto issue = [&](int ch) { const size_t o = (size_t)row_of(ch * 64 + st) * 256 + h * 64 + c0;
        gk = *(const u32x4*)(RK + o); gv = *(const u32x4*)(RV + o); gr = *(const u32x4*)(RR + o); ga = *(const u32x4*)(RA + o); gm = *(const u32x4*)(RM + o); };
    issue(0);
    for (int ch = 0; ch < 68; ++ch) {
        {
            float k[8], a[8], om[8], rr[8], vv8[8]; unpack8(gk, k); unpack8(ga, a); unpack8(gm, om); unpack8(gr, rr); unpack8(gv, vv8);
            float kk[8]; float n2 = 0.f;
#pragma unroll
            for (int i = 0; i < 8; ++i) { kk[i] = k[i] * kkp[i]; n2 += kk[i] * kk[i]; }
            n2 = red8(n2);
            const float rn = 1.f / sqrtf(fmaxf(n2, 1e-12f));
            f32x4 o0, o1;
#define ST8(DST, EXPR) { float t8[8]; _Pragma("unroll") for (int i = 0; i < 8; ++i) t8[i] = (EXPR); \
            *(LAS f32x4*)(DST + st * 64 + c0) = (f32x4){t8[0], t8[1], t8[2], t8[3]}; *(LAS f32x4*)(DST + st * 64 + c0 + 4) = (f32x4){t8[4], t8[5], t8[6], t8[7]}; }
            ST8(KH, kk[i] * rn)
            ST8(WW, 1.f - om[i])
            ST8(BB, kk[i] * rn * a[i])
            ST8(KT, k[i] * (1.f + (a[i] - 1.f) * kap[i]))
            ST8(RRl, rr[i])
            ST8(VV, vv8[i])
#undef ST8
        }
        __syncthreads();
        if (ch + 1 < 68) issue(ch + 1);
        {
            struct Ops { f32x4 kh, w, b, t, r; float vv; };
            auto ldops = [&](int s) -> Ops { Ops q;
                q.kh = *(const LAS f32x4*)(KH + s * 64 + kq * 4); q.w = *(const LAS f32x4*)(WW + s * 64 + kq * 4); q.b = *(const LAS f32x4*)(BB + s * 64 + kq * 4);
                q.t = *(const LAS f32x4*)(KT + s * 64 + kq * 4); q.r = *(const LAS f32x4*)(RRl + s * 64 + kq * 4);
                q.vv = VV[s * 64 + half * 32 + row_l]; return q; };
            Ops nx = ldops(0);
#pragma unroll 2
            for (int s = 0; s < 64; ++s) {
                const Ops c = nx;
                nx = ldops(s + 1 < 64 ? s + 1 : 63);
                f32x2 a2 = S[0] * (f32x2){c.kh.x, c.kh.y}; a2 = S[1] * (f32x2){c.kh.z, c.kh.w} + a2;
                const float sk = red16(a2.x + a2.y);
                const f32x2 nsk = (f32x2){-sk, -sk}, vv2 = (f32x2){c.vv, c.vv};
                S[0] = S[0] * (f32x2){c.w.x, c.w.y} + (nsk * (f32x2){c.b.x, c.b.y} + vv2 * (f32x2){c.t.x, c.t.y});
                S[1] = S[1] * (f32x2){c.w.z, c.w.w} + (nsk * (f32x2){c.b.z, c.b.w} + vv2 * (f32x2){c.t.z, c.t.w});
                f32x2 o2 = S[0] * (f32x2){c.r.x, c.r.y}; o2 = S[1] * (f32x2){c.r.z, c.r.w} + o2;
                const float ov = red16(o2.x + o2.y);
                if (kq == 0) OUT[s * 32 + row_l] = ov;
            }
        }
        __syncthreads();
        { const int c4 = (tid & 7) * 4; const f32x4 ov = *(const LAS f32x4*)(OUT + st * 32 + c4);
          u32x2 o2; o2.x = pk2(ov.x, ov.y); o2.y = pk2(ov.z, ov.w);
          *(u32x2*)(P + (size_t)row_of(ch * 64 + st) * NP + ocol + c4) = o2; }
    }
    __syncthreads();
}

__device__ __forceinline__ void mixer_mla(const Params& p, LAS unsigned char* lds, int it) {
    bf16_t* P = (bf16_t*)(p.ws + WS_P);
    const bf16_t* MQ = (const bf16_t*)(p.ws + WS_MQ);
    int b, h, row0, nm1;
    if (it < 512) { b = it >> 6; h = (it >> 4) & 3; row0 = b * SEQL + (it & 15) * 256; nm1 = 68; }
    else { const int u = it - 512; b = u >> 2; h = u & 3; row0 = TMAIN + b * CTXL; nm1 = 4; }
    attn_unit<96>(MQ + (size_t)row0 * 384 + h * 96, 384, (const bf16_t*)(p.ws + WS_KM) + (size_t)(b * 4 + h) * NKEYS * 96, (const bf16_t*)(p.ws + WS_VTM) + (size_t)(b * 4 + h) * 64 * NKEYS,
                  4, 4, nm1, false, 0, false, 0.f, 0.10206207f, P + (size_t)row0 * NP + PC_MLAQD + h * 64, NP, lds);
}
__device__ __forceinline__ void mixer_swa(const Params& p, int l, LAS unsigned char* lds, int u0) {
    bf16_t* P = (bf16_t*)(p.ws + WS_P);
    int b, h, row0, nm0, nm1, qp0; bool msk;
    if (u0 < 512) { b = u0 >> 6; h = (u0 >> 4) & 3; const int qb = u0 & 15; row0 = b * SEQL + qb * 256; nm0 = 4 + 4 * qb - 2; nm1 = 4 + 4 * qb + 6; if (nm0 < 4) nm0 = 4; if (nm1 > 68) nm1 = 68; qp0 = qb * 256; msk = true; }
    else { const int u = u0 - 512; b = u >> 2; h = u & 3; row0 = TMAIN + b * CTXL; nm0 = 4; nm1 = 4; qp0 = 0; msk = false; }
    const int hk = h >> 1;
    bf16_t* qp = P + (size_t)row0 * NP + PC_SWAQ + h * 64;
    attn_unit<64>(qp, NP, (const bf16_t*)(p.ws + WS_KS) + (size_t)(b * 2 + hk) * NKEYS * 64, (const bf16_t*)(p.ws + WS_VTS) + (size_t)(b * 2 + hk) * 64 * NKEYS,
                  4, nm0, nm1, msk, qp0, true, p.in[12][l * 4 + h], 0.125f, qp, NP, lds);
}
__device__ __forceinline__ void phase_mixers(const Params& p, int l, LAS unsigned char* lds, int bid, int nb) {
    const bool ectx = (l == 0);
    const int N_MLA = 512 + (ectx ? 32 : 0), N_SWA = 512 + (ectx ? 32 : 0), N_RET = 1024 + (ectx ? 64 : 0);
    if (bid < NSCANBLK) rwkv_scan_item(p, l, lds, bid);
    else if (bid < NSCANBLK + 64) ret_scan_item(p, l, bid - NSCANBLK);
    bool ret_ready = false;
    unsigned* ctr = (unsigned*)(p.ws + WS_CTR) + l;
    LAS unsigned* slot = (LAS unsigned*)(lds + LDS_BYTES - 16);
    const int tid0 = get_tid();
    for (;;) {
        __syncthreads();
        if (tid0 == 0) *slot = atomicAdd(ctr, 1u);
        __syncthreads();
        const int it = (int)*slot;
        if (it >= N_MLA + N_SWA + N_RET) break;
        if (it < N_MLA) mixer_mla(p, lds, it);
        else if (it < N_MLA + N_SWA) mixer_swa(p, l, lds, it - N_MLA);
        else { if (!ret_ready) { ret_wait_states(p, l); ret_ready = true; } ret_out_item(p, l, lds, it - N_MLA - N_SWA); }
    }
}

__device__ __forceinline__ void phase_rwkv_finish(const Params& p, int l, LAS unsigned char* lds, int bid, int nb) {
    const int tid = get_tid();
    bf16_t* P = (bf16_t*)(p.ws + WS_P);
    const int ntiles = (l == 0 ? TT : TMAIN) / 32;
    const float* mu = p.in[14] + l * 1024 + 896;
    const float* gup = p.in[19] + (size_t)l * 128 * 256;
    const bf16_t* RV = (const bf16_t*)(p.ws + WS_RWV); const float* BON = (const float*)(p.ws + WS_BON);
    for (int tile = bid; tile < ntiles; tile += nb) {
        const int t0 = tile * 32; const SeqInfo s0 = seq_of_row(t0);
        LAS unsigned char* sgb = lds;
        LAS float* gout = (LAS float*)(lds + 32 * 272);
        { const int tok = tid >> 4, j8 = (tid & 15) * 8; const int row = t0 + tok, pos = s0.pos + tok;
          const u32x4 u0 = *(const u32x4*)(P + (size_t)row * NP + PC_RWGD + j8);
          const u32x4 um = pos > 0 ? *(const u32x4*)(P + (size_t)(row - 1) * NP + PC_RWGD + j8) : (u32x4){0u, 0u, 0u, 0u};
          const u32x4 up = pos < s0.len - 1 ? *(const u32x4*)(P + (size_t)(row + 1) * NP + PC_RWGD + j8) : (u32x4){0u, 0u, 0u, 0u};
          float z0[8], zm[8], zp[8], sv[8]; unpack8(u0, z0); unpack8(um, zm); unpack8(up, zp);
#pragma unroll
          for (int x = 0; x < 8; ++x) sv[x] = sigmoidf_(z0[x] + mu[j8 + x] * (0.5f * (zm[x] + zp[x]) - z0[x]));
          *(LAS u32x4*)(sgb + tok * 272 + j8 * 2) = (u32x4){cvt_pk_bf16(sv[0], sv[1]), cvt_pk_bf16(sv[2], sv[3]), cvt_pk_bf16(sv[4], sv[5]), cvt_pk_bf16(sv[6], sv[7])}; }
        __syncthreads();
        { const int lane = tid & 63, wave = tid >> 6, fr = lane & 15, fq = lane >> 4;
          const bf16_t* GT = (const bf16_t*)(p.ws + WS_GUPT + (size_t)l * 256 * 128 * 2);
#pragma unroll
          for (int q = 0; q < 2; ++q) { const int nt = wave + q * 8;
              f32x4 a0 = (f32x4){0.f, 0.f, 0.f, 0.f}, a1 = a0;
              const bf16_t* wrow = GT + (size_t)(nt * 16 + fr) * 128 + fq * 8;
              bf16x8 bfr[4];
#pragma unroll
              for (int kc = 0; kc < 4; ++kc) bfr[kc] = *(const bf16x8*)(wrow + kc * 32);
#pragma unroll
              for (int kc = 0; kc < 4; ++kc) { const bf16x8 x0 = *(const LAS bf16x8*)(sgb + fr * 272 + kc * 64 + fq * 16), x1 = *(const LAS bf16x8*)(sgb + (16 + fr) * 272 + kc * 64 + fq * 16);
                  a0 = __builtin_amdgcn_mfma_f32_16x16x32_bf16(x0, bfr[kc], a0, 0, 0, 0); a1 = __builtin_amdgcn_mfma_f32_16x16x32_bf16(x1, bfr[kc], a1, 0, 0, 0); }
#pragma unroll
              for (int r = 0; r < 4; ++r) { gout[(fq * 4 + r) * 256 + nt * 16 + fr] = a0[r]; gout[(16 + fq * 4 + r) * 256 + nt * 16 + fr] = a1[r]; } } }
        __syncthreads();
        const int hh = tid >> 8, c = tid & 255, h = c >> 6;
        float g[16];
#pragma unroll
        for (int i = 0; i < 16; ++i) g[i] = gout[(hh * 16 + i) * 256 + c];
        const float gn = p.in[23][l * 256 + c];
        float ov[16], rv[16], bn[16];
#pragma unroll
        for (int i = 0; i < 16; ++i) { const int row = t0 + hh * 16 + i;
            ov[i] = bf2f(P[(size_t)row * NP + PC_RWO0 + c]) + bf2f(P[(size_t)row * NP + PC_RWO1 + c]); rv[i] = bf2f(RV[(size_t)row * 256 + c]); bn[i] = BON[(size_t)row * 4 + h]; }
#pragma unroll
        for (int i = 0; i < 16; ++i) { const int row = t0 + hh * 16 + i;
            const float o = ov[i];
            const float mean = wave_sum(o) * (1.f / 64.f); const float dl = o - mean; const float var = wave_sum(dl * dl) * (1.f / 64.f);
            float y = dl * (1.f / sqrtf(var + 64e-5f)) * gn + bn[i] * rv[i];
            P[(size_t)row * NP + PC_RWO1 + c] = f2bf(y * g[i]); }
        __syncthreads();
    }
}

#ifndef N_LAUNCH_MODE
#define N_LAUNCH_MODE 1
#endif
template <int Q>
__device__ __forceinline__ void layer_phase(const Params& p, int l, LAS unsigned char* lds, int bid, int nb) {
    unsigned char* wb = p.ws + WS_WB + (size_t)l * WB_LAYER;
    const int Mrows = (l == 0) ? TT : TMAIN;
    pg8::StaticOrder S;
    if constexpr (Q == 0) { pg8::Gemm g{(const bf16_t*)(p.ws + WS_HB), (const bf16_t*)(wb + WB_IN), TT, NP, DM, DM}; S.init(TT, NP, nb, bid);
              pg8::EpiBf16<0> E{(bf16_t*)(p.ws + WS_P), NP}; pg8::gemm_phase(lds, g, S, E); }
    if constexpr (Q == 1) phase_prepA(p, l, lds, bid, nb);
    if constexpr (Q == 3) phase_mixers(p, l, lds, bid, nb);
    if constexpr (Q == 4) phase_rwkv_finish(p, l, lds, bid, nb);
    if constexpr (Q == 5) { pg8::Gemm g{(const bf16_t*)(p.ws + WS_P), (const bf16_t*)(wb + WB_OUT), Mrows, DM, DM, NP}; S.init(Mrows, DM, nb, bid);
              pg8::EpiBf16<0> E{(bf16_t*)(p.ws + WS_Z), DM}; pg8::gemm_phase(lds, g, S, E); }
    if constexpr (Q == 6) phase_rowops(p, 1, l, Mrows, bid, nb);
    if constexpr (Q == 7) { pg8::Gemm g{(const bf16_t*)(p.ws + WS_HB), (const bf16_t*)(wb + WB_W1), Mrows, FF, DM, DM}; S.init(Mrows, FF, nb, bid);
              pg8::EpiBf16<1> E{(bf16_t*)(p.ws + WS_HID), FF}; pg8::gemm_phase(lds, g, S, E); }
    if constexpr (Q == 8) { pg8::Gemm g{(const bf16_t*)(p.ws + WS_HID), (const bf16_t*)(wb + WB_W2), Mrows, DM, FF, FF}; S.init(Mrows, DM, nb, bid);
              pg8::EpiBf16<0> E{(bf16_t*)(p.ws + WS_Z), DM}; pg8::gemm_phase(lds, g, S, E); }
    if constexpr (Q == 9) phase_rowops(p, 2, l, Mrows, bid, nb);
}

#ifndef PROBE_MASK
#define PROBE_MASK 0
#endif
#define PB(BIT, CALL) do { if ((PROBE_MASK) & (BIT)) { const unsigned long long t0_ = __builtin_amdgcn_s_memrealtime(); CALL; const unsigned long long t1_ = __builtin_amdgcn_s_memrealtime(); \
        while (__builtin_amdgcn_s_memrealtime() - t1_ < (t1_ - t0_)) __builtin_amdgcn_s_sleep(8); } else { CALL; } } while (0)
#define XB_TMO      128
#define XB_XCNT(j)  (256  + 64 * (j))
#define XB_XSUB(j)  (1280 + 64 * (j))
#define XB_XGEN(j)  (2304 + 64 * (j))
#define XB_TOP      3328
#define XB_TOPGEN   3392
#define XCD_BAR_WORDS 3456
#define XB_SPIN_CAP (1u << 18)

__device__ __forceinline__ unsigned xb_ld(unsigned* p)              { return __hip_atomic_load(p, __ATOMIC_RELAXED, __HIP_MEMORY_SCOPE_AGENT); }
__device__ __forceinline__ unsigned xb_add(unsigned* p, unsigned v) { return __hip_atomic_fetch_add(p, v, __ATOMIC_RELAXED, __HIP_MEMORY_SCOPE_AGENT); }
__device__ __forceinline__ unsigned xb_xcc_id() { return (unsigned)__builtin_amdgcn_s_getreg((3 << 11) | 20) & 0xFu; }
#define XB_SPIN(cond, bar) do { unsigned _sp = 0; while (cond) { __builtin_amdgcn_s_sleep(1); \
    if ((++_sp & 255u) == 0u) { if (xb_ld(&(bar)[XB_TMO])) break; if (_sp > XB_SPIN_CAP) { atomicAdd(&(bar)[XB_TMO], 1u); break; } } } } while (0)

struct XcdBarrier {
    unsigned* bar; unsigned x;
    volatile LAS unsigned* st;
};

__device__ __forceinline__ XcdBarrier xcd_barrier_post(unsigned* bar, volatile LAS unsigned* st) {
    XcdBarrier b; b.bar = bar; b.x = xb_xcc_id(); b.st = st;
    if (threadIdx.x == 0) (void)xb_add(&bar[XB_XCNT(b.x)], 1u);
    return b;
}
__device__ __forceinline__ void xcd_barrier_complete(unsigned* bar, unsigned x, unsigned& nloc, unsigned& nx) {
    const unsigned G = gridDim.x * gridDim.y * gridDim.z;
    unsigned sum, cnt, mine, sp = 0u;
    for (;;) {
        sum = 0u; cnt = 0u; mine = 0u;
#pragma unroll
        for (unsigned j = 0; j < 16; ++j) { const unsigned c = xb_ld(&bar[XB_XCNT(j)]); sum += c; cnt += (c > 0u) ? 1u : 0u; mine = (j == x) ? c : mine; }
        if (sum == G) break;
        __builtin_amdgcn_s_sleep(1);
        if ((++sp & 255u) == 0u) { if (xb_ld(&bar[XB_TMO])) break; if (sp > XB_SPIN_CAP) { atomicAdd(&bar[XB_TMO], 1u); break; } }
    }
    nloc = mine > 0u ? mine : 1u; nx = cnt > 0u ? cnt : 1u;
}

__device__ __forceinline__ void xcd_barrier(const XcdBarrier& b) {
    asm volatile("s_waitcnt vmcnt(0)" ::: "memory");
    __syncthreads();
    if (threadIdx.x == 0) {
        unsigned* bar = b.bar;
        __builtin_amdgcn_s_waitcnt(0);
        unsigned nloc = b.st[0], nx = b.st[1];
        if (nloc == 0u) { xcd_barrier_complete(bar, b.x, nloc, nx); b.st[0] = nloc; b.st[1] = nx; }
        const unsigned old = xb_add(&bar[XB_XSUB(b.x)], 1u);
        const unsigned gen = old / nloc;
        if (old + 1u == (gen + 1u) * nloc) {
            __builtin_amdgcn_fence(__ATOMIC_RELEASE, "agent");
            asm volatile("s_waitcnt vmcnt(0)" ::: "memory");
            const unsigned og = xb_add(&bar[XB_TOP], 1u);
            const unsigned tg = og / nx;
            if (og + 1u == (tg + 1u) * nx) xb_add(&bar[XB_TOPGEN], 1u);
            else XB_SPIN(xb_ld(&bar[XB_TOPGEN]) == tg, bar);
            __builtin_amdgcn_fence(__ATOMIC_ACQUIRE, "agent");
            xb_add(&bar[XB_XGEN(b.x)], 1u);
            asm volatile("s_waitcnt vmcnt(0)" ::: "memory");
        } else {
            XB_SPIN(xb_ld(&bar[XB_XGEN(b.x)]) == gen, bar);
            __builtin_amdgcn_fence(__ATOMIC_ACQUIRE, "agent");
            asm volatile("s_waitcnt vmcnt(0)" ::: "memory");
        }
    }
    __syncthreads();
}


constexpr size_t WS_XBAR = 772 * 1024;
#define GSYNC() xcd_barrier(xb)

__global__ void __launch_bounds__(512, 2) mega_fwd(Params p) {
    extern __shared__ __attribute__((aligned(16))) unsigned char lds_raw[];
    LAS unsigned char* lds = (LAS unsigned char*)lds_raw;
    cg::grid_group grid = cg::this_grid();
    const int bid = blockIdx.x, nb = gridDim.x;
    { LAS unsigned* st_ = (LAS unsigned*)(lds + LDS_BYTES - 32); if (get_tid() == 0) { st_[0] = 0u; st_[1] = 0u; } __syncthreads(); }
    XcdBarrier xb = xcd_barrier_post((unsigned*)(p.ws + WS_XBAR), (volatile LAS unsigned*)(lds + LDS_BYTES - 32));
    PB(16, phase_prologue(p, lds, bid, nb));
    { asm volatile("s_waitcnt vmcnt(0) lgkmcnt(0)" ::: "memory"); __syncthreads(); if (get_tid() < 64) { __builtin_amdgcn_fence(__ATOMIC_RELEASE, "agent"); asm volatile("s_waitcnt vmcnt(0) lgkmcnt(0)" ::: "memory"); } grid.sync();
      if (get_tid() < 64) { __builtin_amdgcn_fence(__ATOMIC_ACQUIRE, "agent"); asm volatile("s_waitcnt vmcnt(0) lgkmcnt(0)" ::: "memory"); } __syncthreads(); }
    PB(8, phase_rowops(p, 0, 0, TT, bid, nb)); GSYNC();
#define LAYER(L, LAST) \
    PB(1, layer_phase<0>(p, L, lds, bid, nb)); GSYNC(); PB(4, layer_phase<1>(p, L, lds, bid, nb)); GSYNC(); \
    PB(2, layer_phase<3>(p, L, lds, bid, nb)); GSYNC(); PB(4, layer_phase<4>(p, L, lds, bid, nb)); GSYNC(); PB(1, layer_phase<5>(p, L, lds, bid, nb)); GSYNC(); \
    PB(8, layer_phase<6>(p, L, lds, bid, nb)); GSYNC(); PB(1, layer_phase<7>(p, L, lds, bid, nb)); GSYNC(); PB(1, layer_phase<8>(p, L, lds, bid, nb)); GSYNC(); \
    PB(8, layer_phase<9>(p, L, lds, bid, nb)); if (!(LAST)) GSYNC();
    LAYER(0, false)
    LAYER(1, true)
}
#if N_LAUNCH_MODE != 1
template <int PH> __global__ void __launch_bounds__(512, 2) one_phase(Params p, int l) {
    extern __shared__ __attribute__((aligned(16))) unsigned char lds_raw[];
    LAS unsigned char* lds = (LAS unsigned char*)lds_raw;
    if constexpr (PH == 100) phase_prologue(p, lds, blockIdx.x, gridDim.x);
    else if constexpr (PH == 101) phase_rowops(p, 0, 0, TT, blockIdx.x, gridDim.x);
    else layer_phase<PH>(p, l, lds, blockIdx.x, gridDim.x);
}
#endif

extern "C" void kernel_launch(void* const* d_in, const int* in_sizes, int n_in, void* d_out, int out_size, void* d_ws, size_t ws_size, hipStream_t stream) {
    if (n_in != 30 || ws_size < WS_NEED || out_size != TMAIN * DM) { fprintf(stderr, "kernel_launch: unexpected shapes (n_in %d, ws %zu, out %d)\n", n_in, ws_size, out_size); return; }
    Params p{};
    for (int i = 0; i < 30; ++i) p.in[i] = (const float*)d_in[i];
    p.out = (float*)d_out; p.ws = (unsigned char*)d_ws;
    static int grid_blocks = 0;
    if (!grid_blocks) {
        int dev = 0, cus = 0, per_cu = 0;
        (void)hipGetDevice(&dev);
        (void)hipDeviceGetAttribute(&cus, hipDeviceAttributeMultiprocessorCount, dev);
        (void)hipFuncSetAttribute((const void*)mega_fwd, hipFuncAttributeMaxDynamicSharedMemorySize, LDS_BYTES);
        (void)hipOccupancyMaxActiveBlocksPerMultiprocessor(&per_cu, mega_fwd, 512, LDS_BYTES);
        if (per_cu < 1) { fprintf(stderr, "kernel_launch: occupancy query says %d blocks/CU\n", per_cu); per_cu = 1; }
        grid_blocks = cus * 1;
        if (grid_blocks < 128) { fprintf(stderr, "kernel_launch: only %d CUs\n", grid_blocks); }
    }
#if N_LAUNCH_MODE == 1
    (void)hipMemsetAsync((char*)d_ws + 768 * 1024, 0, 32 * 1024, stream);
    void* args[] = {&p};
    hipError_t e = hipLaunchCooperativeKernel((const void*)mega_fwd, dim3(grid_blocks), dim3(512), args, LDS_BYTES, stream);
    if (e != hipSuccess) fprintf(stderr, "cooperative launch failed: %s (grid %d)\n", hipGetErrorString(e), grid_blocks);
#else
#define LP(PH, L) do { (void)hipFuncSetAttribute((const void*)one_phase<PH>, hipFuncAttributeMaxDynamicSharedMemorySize, LDS_BYTES); one_phase<PH><<<grid_blocks, 512, LDS_BYTES, stream>>>(p, L); } while (0)
    LP(100, 0); LP(101, 0);
    for (int l = 0; l < 2; ++l) { LP(0, l); LP(1, l); LP(2, l); LP(3, l); LP(4, l); LP(5, l); LP(6, l); LP(7, l); LP(8, l); LP(9, l); }
#endif
}
```

```cpp
#include <hip/hip_runtime.h>
#include <hip/hip_cooperative_groups.h>
#include <cstdio>
#include <cstdint>
#include <cmath>
namespace cg = cooperative_groups;
__device__ __forceinline__ int get_tid() { int t = threadIdx.x; asm volatile("" : "+v"(t)); return t; }
namespace pg8 {
#define PG8_LAS __attribute__((address_space(3)))
typedef unsigned short bf16_t;
typedef short bf16x8 __attribute__((ext_vector_type(8)));
typedef float f32x4 __attribute__((ext_vector_type(4)));
typedef unsigned u32x4 __attribute__((ext_vector_type(4)));
typedef unsigned u32x2 __attribute__((ext_vector_type(2)));
constexpr int BM = 256, BK = 64, HALF = 128, HTB = HALF * BK * 2, STAGE_BYTES = 8 * HTB, NXCD = 8, WGM = 8;

__host__ __device__ __forceinline__ int lds_byte(int r, int c) { const int st = (r >> 4) * 2 + (c >> 5), rr = r & 15, cc = c & 31, ob = rr * 64 + cc * 2; return st * 1024 + (ob ^ (((ob >> 9) & 1) << 5)); }
__host__ __device__ __forceinline__ void stage_rc(int b, int& R, int& C) { const int st = b / 1024, sb = b % 1024, swz = sb ^ (((sb >> 9) & 1) << 5); R = (st >> 1) * 16 + swz / 64; C = (st & 1) * 32 + (swz % 64) / 2; }

struct Unit { int pm, pn; };
struct Gemm { const bf16_t* A; const bf16_t* Bt; int M, N, K, lda; };

struct StaticOrder {
    int nM, nN, nwg, G, c;
    __host__ __device__ void init(int M, int N, int G_, int c_) { nM = M / BM; nN = N / BM; nwg = nM * nN; G = G_; c = c_; }
    __host__ __device__ bool next(int i, Unit& u) const {
        const long L = (long)i * G + c; if (L >= nwg) return false;
        int wgid = (int)L; { const int q = nwg / NXCD, r = nwg % NXCD, xcd = wgid % NXCD, off = wgid / NXCD; wgid = (xcd < r ? xcd * (q + 1) : r * (q + 1) + (xcd - r) * q) + off; }
        const int nig = WGM * nN, gid = wgid / nig, fm = gid * WGM, gsz = (nM - fm) < WGM ? (nM - fm) : WGM;
        u.pm = fm + ((wgid % nig) % gsz); u.pn = (wgid % nig) / gsz; return true;
    }
};

template <class Epi>
__device__ __forceinline__ void gemm_phase(PG8_LAS unsigned char* lds, const Gemm g, const StaticOrder& S, const Epi& E) {
    const int tid = get_tid(), wid = __builtin_amdgcn_readfirstlane(tid >> 6), lane = tid & 63, wr = wid >> 2, wc = wid & 3, fr = lane & 15, fq = lane >> 4;
    const int K = g.K, nt = K / BK, lda = g.lda;
    unsigned voffA[2], voffB[2];
#pragma unroll
    for (int i = 0; i < 2; ++i) { int R, C; stage_rc(tid * 16 + i * 8192, R, C);
        voffA[i] = (unsigned)(R * lda + C) * 2u; voffB[i] = (unsigned)(R * K + C) * 2u; }
    const size_t kstep = (size_t)(BK * 2);
    const size_t hstepA = (size_t)HALF * lda * 2, hstepB = (size_t)HALF * K * 2;
    const size_t tstepA = 2 * hstepA, tstepB = 2 * hstepB;
    const unsigned ldsw = (unsigned)wid * 1024u;
    const int aoff = lds_byte(wr * 64 + fr, fq * 8), boff = lds_byte(wc * 32 + fr, fq * 8);
#define PG8_SA(b, h) (((b) * 2 + (h)) * HTB)
#define PG8_SB(b, h) ((4 + (b) * 2 + (h)) * HTB)
#define PG8_STAGE(bufoff, gbase, voff) do { _Pragma("unroll") for (int _i = 0; _i < 2; ++_i) \
        __builtin_amdgcn_global_load_lds((const unsigned*)((const char*)(gbase) + (voff)[_i]), (PG8_LAS unsigned*)(lds + (bufoff) + ldsw + _i * 8192), 16, 0, 0); } while (0)
#define PG8_LDA(dst, b, h) do { _Pragma("unroll") for (int m = 0; m < 4; ++m) _Pragma("unroll") for (int k = 0; k < 2; ++k) dst[m][k] = *(const PG8_LAS bf16x8*)(lds + PG8_SA(b, h) + aoff + m * 2048 + k * 1024); } while (0)
#define PG8_LDB(dst, b, h) do { _Pragma("unroll") for (int n = 0; n < 2; ++n) _Pragma("unroll") for (int k = 0; k < 2; ++k) dst[n][k] = *(const PG8_LAS bf16x8*)(lds + PG8_SB(b, h) + boff + n * 2048 + k * 1024); } while (0)
#define PG8_MMA(ai, bj, At, Bt) do { __builtin_amdgcn_s_setprio(1); _Pragma("unroll") for (int m = 0; m < 4; ++m) _Pragma("unroll") for (int n = 0; n < 2; ++n) _Pragma("unroll") for (int k = 0; k < 2; ++k) \
        acc[ai][bj][m][n] = __builtin_amdgcn_mfma_f32_16x16x32_bf16(Bt[n][k], At[m][k], acc[ai][bj][m][n], 0, 0, 0); __builtin_amdgcn_s_setprio(0); } while (0)
#define PG8_WAIT_V(n) asm volatile("s_waitcnt vmcnt(" #n ")" ::: "memory")
#define PG8_WAIT_L(n) asm volatile("s_waitcnt lgkmcnt(" #n ")" ::: "memory")
#define PG8_BAR __builtin_amdgcn_s_barrier()
#define PG8_SCHED __builtin_amdgcn_sched_barrier(0)
    Unit cur, nxt; int ui = 0;
    if (!S.next(0, cur)) return;
    f32x4 acc[2][2][4][2];
#pragma unroll
    for (int a = 0; a < 2; ++a)
#pragma unroll
        for (int b = 0; b < 2; ++b)
#pragma unroll
            for (int m = 0; m < 4; ++m)
#pragma unroll
                for (int n = 0; n < 2; ++n) acc[a][b][m][n] = (f32x4){0.f, 0.f, 0.f, 0.f};
    bf16x8 At[4][2], B0[2][2], B1[2][2];
    const char* cA = (const char*)g.A + (size_t)cur.pm * tstepA; const char* cB = (const char*)g.Bt + (size_t)cur.pn * tstepB;
    PG8_STAGE(PG8_SB(0, 0), cB, voffB); PG8_STAGE(PG8_SA(0, 0), cA, voffA); PG8_STAGE(PG8_SB(0, 1), cB + hstepB, voffB); PG8_STAGE(PG8_SA(0, 1), cA + hstepA, voffA);
    if (wr == 1) PG8_BAR;
    PG8_WAIT_V(4); PG8_BAR;
    PG8_STAGE(PG8_SB(1, 0), cB + kstep, voffB); PG8_STAGE(PG8_SA(1, 0), cA + kstep, voffA); PG8_STAGE(PG8_SB(1, 1), cB + hstepB + kstep, voffB);
    PG8_WAIT_V(6); PG8_BAR;
    for (;;) {
        const bool has_next = S.next(ui + 1, nxt);
        const char* nA = has_next ? (const char*)g.A + (size_t)nxt.pm * tstepA : cA; const char* nB = has_next ? (const char*)g.Bt + (size_t)nxt.pn * tstepB : cB;
        for (int t = 0; t < nt; t += 2) {
            const bool last = (t == nt - 2);
            const char* a1 = cA + (size_t)(t + 1) * kstep;
            const char* a2 = last ? nA : cA + (size_t)(t + 2) * kstep; const char* b2 = last ? nB : cB + (size_t)(t + 2) * kstep;
            const char* a3 = a2 + kstep; const char* b3 = b2 + kstep;
            PG8_LDB(B0, 0, 0); PG8_SCHED; PG8_LDA(At, 0, 0); PG8_STAGE(PG8_SA(1, 1), a1 + hstepA, voffA);
            PG8_WAIT_L(8); PG8_BAR; PG8_WAIT_L(0); PG8_MMA(0, 0, At, B0); PG8_BAR; PG8_SCHED;
            PG8_LDB(B1, 0, 1); PG8_STAGE(PG8_SB(0, 0), b2, voffB);
            PG8_BAR; PG8_WAIT_L(0); PG8_MMA(0, 1, At, B1); PG8_BAR;
            PG8_LDA(At, 0, 1); PG8_STAGE(PG8_SA(0, 0), a2, voffA);
            PG8_BAR; PG8_WAIT_L(0); PG8_MMA(1, 0, At, B0); PG8_BAR; PG8_SCHED;
            PG8_STAGE(PG8_SB(0, 1), b2 + hstepB, voffB);
            PG8_WAIT_V(6); PG8_BAR; PG8_MMA(1, 1, At, B1); PG8_BAR;
            PG8_LDB(B0, 1, 0); PG8_SCHED; PG8_LDA(At, 1, 0); PG8_STAGE(PG8_SA(0, 1), a2 + hstepA, voffA);
            PG8_WAIT_L(8); PG8_BAR; PG8_WAIT_L(0); PG8_MMA(0, 0, At, B0); PG8_BAR; PG8_SCHED;
            PG8_LDB(B1, 1, 1); PG8_STAGE(PG8_SB(1, 0), b3, voffB);
            PG8_BAR; PG8_WAIT_L(0); PG8_MMA(0, 1, At, B1); PG8_BAR;
            PG8_LDA(At, 1, 1); PG8_STAGE(PG8_SA(1, 0), a3, voffA);
            PG8_BAR; PG8_WAIT_L(0); PG8_MMA(1, 0, At, B0); PG8_BAR; PG8_SCHED;
            PG8_STAGE(PG8_SB(1, 1), b3 + hstepB, voffB);
            PG8_WAIT_V(6); PG8_BAR; PG8_MMA(1, 1, At, B1); PG8_BAR;
        }
        E(acc, cur, wr, wc, fr, fq);
        if (!has_next) break;
#pragma unroll
        for (int a = 0; a < 2; ++a)
#pragma unroll
            for (int b = 0; b < 2; ++b)
#pragma unroll
                for (int m = 0; m < 4; ++m)
#pragma unroll
                    for (int n = 0; n < 2; ++n) acc[a][b][m][n] = (f32x4){0.f, 0.f, 0.f, 0.f};
        cur = nxt; cA = nA; cB = nB; ++ui;
    }
    PG8_WAIT_V(0);
    if (wr == 0) PG8_BAR;
    PG8_BAR;
#undef PG8_SA
#undef PG8_SB
#undef PG8_STAGE
#undef PG8_LDA
#undef PG8_LDB
#undef PG8_MMA
#undef PG8_WAIT_V
#undef PG8_WAIT_L
#undef PG8_BAR
#undef PG8_SCHED
}

__device__ __forceinline__ unsigned f2bf_u(float f) { unsigned u = __builtin_bit_cast(unsigned, f); return (u + 0x7fffu + ((u >> 16) & 1u)) >> 16; }
template <int ACT> struct EpiBf16 {
    bf16_t* O; int ldc;
    __device__ __forceinline__ void operator()(const f32x4 (&acc)[2][2][4][2], const Unit& u, int wr, int wc, int fr, int fq) const {
        const int row0 = u.pm * BM + wr * 64 + fr, col0 = u.pn * BM + wc * 32 + 4 * fq;
#pragma unroll
        for (int ai = 0; ai < 2; ++ai)
#pragma unroll
            for (int m = 0; m < 4; ++m) { bf16_t* rowp = O + (size_t)(row0 + ai * HALF + m * 16) * ldc + col0;
#pragma unroll
                for (int bj = 0; bj < 2; ++bj)
#pragma unroll
                    for (int n = 0; n < 2; ++n) { f32x4 v = acc[ai][bj][m][n];
                        if (ACT == 1) { v.x = v.x > 0.f ? v.x * v.x : 0.f; v.y = v.y > 0.f ? v.y * v.y : 0.f; v.z = v.z > 0.f ? v.z * v.z : 0.f; v.w = v.w > 0.f ? v.w * v.w : 0.f; }
                        u32x2 o; o.x = f2bf_u(v.x) | (f2bf_u(v.y) << 16); o.y = f2bf_u(v.z) | (f2bf_u(v.w) << 16);
                        *(u32x2*)(rowp + bj * HALF + n * 16) = o; } }
    }
};
}
typedef unsigned short bf16_t;
typedef short bf16x8 __attribute__((ext_vector_type(8)));
typedef float f32x4 __attribute__((ext_vector_type(4)));
typedef unsigned u32x4 __attribute__((ext_vector_type(4)));
typedef unsigned u32x2 __attribute__((ext_vector_type(2)));
#define LAS __attribute__((address_space(3)))

constexpr int NBATCH = 8, SEQL = 4096, DM = 1024, CTXL = 256, TMAIN = 32768, TCTX = 2048, TT = 34816, NP = 3072, FF = 4096;
constexpr int PC_SWAQ = 0, PC_RETQ = 256, PC_RWR = 512, PC_MLAQD = 768, PC_SWAK = 1024, PC_SWAV = 1152, PC_RETK = 1280, PC_RETV = 1536, PC_RETG = 1792,
              PC_RWK = 2048, PC_RWV = 2304, PC_RWWD = 2560, PC_RWAD = 2624, PC_RWGD = 2688, PC_MLAKVD = 2816, PC_MLAKPE = 2944;
constexpr int PC_RWO0 = PC_RWV, PC_RWO1 = PC_RWR;
constexpr int NKEYS = CTXL + SEQL;

constexpr size_t MiB = 1u << 20;
constexpr size_t WS_MOD = 0;
constexpr size_t WS_TAB = 512 * 1024;
constexpr size_t WS_CTR = 768 * 1024;
constexpr size_t WS_BON = 1 * MiB;
constexpr size_t WS_WB = 2 * MiB;
constexpr size_t WB_LAYER = 24 * MiB, WB_IN = 0, WB_OUT = 6 * MiB, WB_W1 = 8 * MiB, WB_W2 = 16 * MiB;
constexpr size_t WS_XC = 50 * MiB;
constexpr size_t WS_P = 58 * MiB;
constexpr size_t WS_HID = 58 * MiB;
constexpr size_t WS_A = 262 * MiB;
constexpr size_t ARR17 = 17 * MiB;
constexpr size_t WS_RWK = WS_A, WS_RWV = WS_A + ARR17, WS_RWRR = WS_A + 2 * ARR17, WS_RWA0 = WS_A + 3 * ARR17, WS_RWA1 = WS_A + 4 * ARR17,
                 WS_RWM0 = WS_A + 5 * ARR17, WS_RWM1 = WS_A + 6 * ARR17;
constexpr size_t WS_RET = WS_A + 119 * MiB;
constexpr size_t WS_MQ = WS_RET + 34 * MiB;
constexpr size_t WS_KM = WS_MQ + 26738688;
constexpr size_t WS_VTM = WS_KM + 26738688;
constexpr size_t WS_KS = WS_VTM + ARR17;
constexpr size_t WS_VTS = WS_KS + 8912896;
constexpr size_t WS_A_END = WS_VTS + 8912896;
constexpr size_t WS_Z = 330 * MiB;
constexpr size_t WS_HB = 398 * MiB;
constexpr size_t WS_MLAW = 500 * MiB;
constexpr size_t MLAW_LAYER = 384 * 256 * 2 + 512 * 128 * 2, MLAW_KV = 384 * 256 * 2;
constexpr size_t WS_GUPT = 501 * MiB;
constexpr size_t WS_LORAT = 502 * MiB;
constexpr size_t WS_NEED = 503 * MiB;
static_assert(WS_A_END <= WS_NEED && WS_HB + 68 * MiB <= WS_NEED && WS_HID + 272 * MiB <= WS_Z, "ws map");

constexpr int LDS_BYTES = 150 * 1024;

struct Params { const float* in[30]; float* out; unsigned char* ws; };

__device__ __forceinline__ float bf2f(bf16_t v) { return __builtin_bit_cast(float, (unsigned)v << 16); }
__device__ __forceinline__ bf16_t f2bf(float f) { unsigned u = __builtin_bit_cast(unsigned, f); return (bf16_t)((u + 0x7fffu + ((u >> 16) & 1u)) >> 16); }
__device__ __forceinline__ unsigned pk2(float lo, float hi) { return (unsigned)f2bf(lo) | ((unsigned)f2bf(hi) << 16); }
typedef float f32x2 __attribute__((ext_vector_type(2)));
typedef __bf16 bf16x2_t __attribute__((ext_vector_type(2)));
__device__ __forceinline__ unsigned cvt_pk_bf16(float lo, float hi) { const f32x2 v = {lo, hi}; return __builtin_bit_cast(unsigned, __builtin_convertvector(v, bf16x2_t)); }
template <int CTRL> __device__ __forceinline__ float dppf(float v) { return __builtin_bit_cast(float, __builtin_amdgcn_update_dpp(0, __builtin_bit_cast(int, v), CTRL, 0xF, 0xF, true)); }
__device__ __forceinline__ float red4(float v) { v += dppf<0xB1>(v); v += dppf<0x4E>(v); return v; }
__device__ __forceinline__ float red8(float v) { v = red4(v); v += dppf<0x141>(v); return v; }
__device__ __forceinline__ float red16(float v) { v = red8(v); v += dppf<0x140>(v); return v; }
__device__ __forceinline__ float max16(float v) { v = fmaxf(v, dppf<0xB1>(v)); v = fmaxf(v, dppf<0x4E>(v)); v = fmaxf(v, dppf<0x141>(v)); v = fmaxf(v, dppf<0x140>(v)); return v; }
__device__ __forceinline__ float wave_sum(float v) {
    v = red16(v);
    const int u = __builtin_bit_cast(int, v);
    return __builtin_bit_cast(float, __builtin_amdgcn_readlane(u, 0)) + __builtin_bit_cast(float, __builtin_amdgcn_readlane(u, 16)) +
           __builtin_bit_cast(float, __builtin_amdgcn_readlane(u, 32)) + __builtin_bit_cast(float, __builtin_amdgcn_readlane(u, 48));
}
__device__ __forceinline__ void unpack8(const u32x4 u, float* f) {
    f[0] = bf2f((bf16_t)(u.x & 0xffff)); f[1] = bf2f((bf16_t)(u.x >> 16)); f[2] = bf2f((bf16_t)(u.y & 0xffff)); f[3] = bf2f((bf16_t)(u.y >> 16));
    f[4] = bf2f((bf16_t)(u.z & 0xffff)); f[5] = bf2f((bf16_t)(u.z >> 16)); f[6] = bf2f((bf16_t)(u.w & 0xffff)); f[7] = bf2f((bf16_t)(u.w >> 16));
}
__device__ __forceinline__ float sigmoidf_(float x) { return __builtin_amdgcn_rcpf(1.f + __expf(-x)); }

struct SeqInfo { int b, pos, len, start, isctx; };
__device__ __forceinline__ SeqInfo seq_of_row(int row) {
    SeqInfo s;
    if (row < TMAIN) { s.b = row >> 12; s.pos = row & 4095; s.len = SEQL; s.start = s.b << 12; s.isctx = 0; }
    else { const int r = row - TMAIN; s.b = r >> 8; s.pos = r & 255; s.len = CTXL; s.start = TMAIN + (s.b << 8); s.isctx = 1; }
    return s;
}

__device__ __forceinline__ void transpose_item(const float* W, int N, int nsrc0, bf16_t* WT, int K, int ndst0, int k0, LAS float* scr, int lane) {
    if (nsrc0 >= 0) {
#pragma unroll 32
        for (int i = 0; i < 32; ++i) { const int kk = 2 * i + (lane >> 5); scr[kk * 33 + (lane & 31)] = W[(size_t)(k0 + kk) * N + nsrc0 + (lane & 31)]; }
    } else {
#pragma unroll 8
        for (int i = 0; i < 32; ++i) { const int kk = 2 * i + (lane >> 5); scr[kk * 33 + (lane & 31)] = 0.f; }
    }
    __builtin_amdgcn_wave_barrier(); asm volatile("s_waitcnt lgkmcnt(0)" ::: "memory");
    const int c = lane & 7;
#pragma unroll
    for (int j = 0; j < 4; ++j) { const int n = (lane >> 3) + 8 * j; const LAS float* s = scr + (8 * c) * 33 + n;
        u32x4 o; o.x = pk2(s[0 * 33], s[1 * 33]); o.y = pk2(s[2 * 33], s[3 * 33]); o.z = pk2(s[4 * 33], s[5 * 33]); o.w = pk2(s[6 * 33], s[7 * 33]);
        *(u32x4*)(WT + (size_t)(ndst0 + n) * K + k0 + 8 * c) = o; }
    __builtin_amdgcn_wave_barrier(); asm volatile("s_waitcnt lgkmcnt(0)" ::: "memory");
}
__device__ __forceinline__ int win_src_col(int n) {
    if (n < 256) return n;
    if (n < 512) return 512 + (n - 256);
    if (n < 768) return 1536 + (n - 512);
    if (n < 1024) return 2560 + (n - 768);
    if (n < 1280) return 256 + (n - 1024);
    if (n < 2048) return 768 + (n - 1280);
    if (n < 2816) return 1792 + (n - 2048);
    if (n < 2976) return n;
    return -1;
}
__device__ __forceinline__ void phase_prologue(const Params& p, LAS unsigned char* lds, int bid, int nb) {
    const int tid = get_tid(), lane = tid & 63, wave = tid >> 6;
    LAS float* scr = (LAS float*)(lds + wave * 16384);
    const int gw = bid * 8 + wave, NGW = nb * 8;
    constexpr int I_IN = 16 * 96, I_OUT = 16 * 32, I_1 = 16 * 128, I_2 = 64 * 32, I_Q = 4 * 12, I_KV = 2 * 16, I_G = 2 * 8, I_LO = 4 * 8, I_L = I_IN + I_OUT + I_1 + I_2 + I_Q + I_KV + I_G + I_LO;
    for (int it = gw; it < 2 * I_L; it += NGW) {
        const int l = it / I_L; int r = it % I_L;
        unsigned char* wb = p.ws + WS_WB + (size_t)l * WB_LAYER;
        if (r < I_IN) { const int kb = r / 96, nbk = r % 96; transpose_item(p.in[10] + (size_t)l * DM * 2976, 2976, win_src_col(nbk * 32), (bf16_t*)(wb + WB_IN), DM, nbk * 32, kb * 64, scr, lane); continue; } r -= I_IN;
        if (r < I_OUT) { const int kb = r / 32, nbk = r % 32; transpose_item(p.in[11] + (size_t)l * DM * DM, DM, nbk * 32, (bf16_t*)(wb + WB_OUT), DM, nbk * 32, kb * 64, scr, lane); continue; } r -= I_OUT;
        if (r < I_1) { const int kb = r / 128, nbk = r % 128; transpose_item(p.in[28] + (size_t)l * DM * FF, FF, nbk * 32, (bf16_t*)(wb + WB_W1), DM, nbk * 32, kb * 64, scr, lane); continue; } r -= I_1;
        if (r < I_2) { const int kb = r / 32, nbk = r % 32; transpose_item(p.in[29] + (size_t)l * FF * DM, DM, nbk * 32, (bf16_t*)(wb + WB_W2), FF, nbk * 32, kb * 64, scr, lane); continue; } r -= I_2;
        unsigned char* mw = p.ws + WS_MLAW + (size_t)l * MLAW_LAYER;
        if (r < I_Q) { const int kb = r / 12, nbk = r % 12; transpose_item(p.in[25] + (size_t)l * 256 * 384, 384, nbk * 32, (bf16_t*)mw, 256, nbk * 32, kb * 64, scr, lane); continue; } r -= I_Q;
        if (r < I_KV) { const int kb = r / 16, nbk = r % 16; transpose_item(p.in[27] + (size_t)l * 128 * 512, 512, nbk * 32, (bf16_t*)(mw + MLAW_KV), 128, nbk * 32, kb * 64, scr, lane); continue; } r -= I_KV;
        if (r < I_G) { const int kb = r / 8, nbk = r % 8; transpose_item(p.in[19] + (size_t)l * 128 * 256, 256, nbk * 32, (bf16_t*)(p.ws + WS_GUPT + (size_t)l * 256 * 128 * 2), 128, nbk * 32, kb * 64, scr, lane); continue; } r -= I_G;
        { const int m = r / 8, nbk = r % 8; const float* src = (m < 2 ? p.in[16] : p.in[18]) + ((size_t)l * 2 + (m & 1)) * 64 * 256;
          transpose_item(src, 256, nbk * 32, (bf16_t*)(p.ws + WS_LORAT + ((size_t)l * 4 + m) * 256 * 64 * 2), 64, nbk * 32, 0, scr, lane); }
    }
    __syncthreads();
    for (int it = bid; it < 192; it += nb) {
        const int l = it / 96, cb = it % 96;
        LAS float* sc = (LAS float*)lds;
        LAS float* red = sc + 9 * 1024;
        for (int e = tid; e < 9 * 1024; e += 512) { const int r = e >> 10, k = e & 1023; const float v = (r < 8) ? p.in[1][r * 1024 + k] : p.in[3][k]; sc[e] = v / (1.f + __expf(-v)); }
        __syncthreads();
        const int ks = tid >> 6, cl = tid & 63, n = cb * 64 + cl;
        float acc[9];
#pragma unroll
        for (int r = 0; r < 9; ++r) acc[r] = 0.f;
        const float* aw = p.in[4] + (size_t)l * DM * 6144;
#pragma unroll 16
        for (int k = ks * 128; k < ks * 128 + 128; ++k) { const float w = aw[(size_t)k * 6144 + n];
#pragma unroll
            for (int r = 0; r < 9; ++r) acc[r] += sc[r * 1024 + k] * w; }
#pragma unroll
        for (int r = 0; r < 9; ++r) red[(ks * 9 + r) * 64 + cl] = acc[r];
        __syncthreads();
        for (int e = tid; e < 9 * 64; e += 512) { const int r = e >> 6, c2 = e & 63; float s = 0.f;
            for (int q = 0; q < 8; ++q) s += red[(q * 9 + r) * 64 + c2];
            ((float*)(p.ws + WS_MOD))[((size_t)l * 9 + r) * 6144 + cb * 64 + c2] = s + p.in[5][(size_t)l * 6144 + cb * 64 + c2]; }
        __syncthreads();
    }
    if (bid == 0 && tid < 4) ((unsigned*)(p.ws + WS_CTR))[tid] = 0u;
    if (bid == nb - 1) {
        float* tab = (float*)(p.ws + WS_TAB);
        for (int e = tid; e < 64 * 16; e += 512) { const int pos = e >> 4, f = e & 15; const float inv = powf(10000.f, -(float)(2 * f) / 32.f); const float a = (float)pos * inv; tab[e] = cosf(a); tab[1024 + e] = sinf(a); }
        for (int e = tid; e < 64 * 8; e += 512) { const int pos = e >> 3, f = e & 7; const float inv = powf(10000.f, -(float)(2 * f) / 16.f); const float a = (float)pos * inv; tab[2048 + e] = cosf(a); tab[2560 + e] = sinf(a); }
    }
}

struct RowJob { const float* xsrc; const bf16_t* z; const float* gpost; const float* gate; float* xdst; const float* gpre; const float* shift; const float* scale; bf16_t* hdst; };
__device__ __forceinline__ RowJob make_rowjob(const Params& p, int mode, int l, int row) {
    const float* mod = (const float*)(p.ws + WS_MOD);
    bf16_t* HB = (bf16_t*)(p.ws + WS_HB); const bf16_t* Z = (const bf16_t*)(p.ws + WS_Z);
    float* XC = (float*)(p.ws + WS_XC);
    const SeqInfo s = seq_of_row(row);
    const int mr = s.isctx ? 8 : s.b;
    const float* m_l = mod + ((size_t)l * 9 + mr) * 6144;
    float* xs = s.isctx ? XC + (size_t)(row - TMAIN) * DM : p.out + (size_t)row * DM;
    const float* xin = s.isctx ? p.in[2] + (size_t)(row - TMAIN) * DM : p.in[0] + (size_t)row * DM;
    RowJob j;
    if (mode == 0) { j = RowJob{xin, nullptr, nullptr, nullptr, nullptr, p.in[6] + l * DM, m_l + 0, m_l + 1024, HB + (size_t)row * DM}; }
    else if (mode == 1) { j = RowJob{l == 0 ? xin : xs, Z + (size_t)row * DM, p.in[7] + l * DM, m_l + 2048, xs, p.in[8] + l * DM, m_l + 3072, m_l + 4096, HB + (size_t)row * DM}; }
    else { const bool has_next = (l + 1 < 2); const float* m_n = mod + ((size_t)(has_next ? l + 1 : l) * 9 + mr) * 6144;
        j = RowJob{xs, Z + (size_t)row * DM, p.in[9] + l * DM, m_l + 5120, xs, p.in[6] + (has_next ? l + 1 : l) * DM, m_n + 0, m_n + 1024, has_next ? HB + (size_t)row * DM : nullptr}; }
    return j;
}
template <int RB>
__device__ __forceinline__ void rowop_batch(const RowJob (&jb)[RB], const bool (&valid)[RB], int lane) {
    f32x4 v[RB][4]; u32x2 zu[RB][4];
#pragma unroll
    for (int r = 0; r < RB; ++r) if (valid[r]) {
#pragma unroll
        for (int j = 0; j < 4; ++j) { v[r][j] = *(const f32x4*)(jb[r].xsrc + (j * 64 + lane) * 4); if (jb[r].z) zu[r][j] = *(const u32x2*)(jb[r].z + (j * 64 + lane) * 4); }
    }
#pragma unroll
    for (int r = 0; r < RB; ++r) if (valid[r]) {
        const RowJob& J = jb[r];
        if (J.z) {
            f32x4 zz[4], gp[4], gt[4]; float ss = 0.f;
#pragma unroll
            for (int j = 0; j < 4; ++j) { const int c = (j * 64 + lane) * 4; gp[j] = *(const f32x4*)(J.gpost + c); gt[j] = *(const f32x4*)(J.gate + c); }
#pragma unroll
            for (int j = 0; j < 4; ++j) { const u32x2 u = zu[r][j];
                zz[j].x = bf2f((bf16_t)(u.x & 0xffff)); zz[j].y = bf2f((bf16_t)(u.x >> 16)); zz[j].z = bf2f((bf16_t)(u.y & 0xffff)); zz[j].w = bf2f((bf16_t)(u.y >> 16));
                ss += zz[j].x * zz[j].x + zz[j].y * zz[j].y + zz[j].z * zz[j].z + zz[j].w * zz[j].w; }
            const float rinv = 1.f / sqrtf(wave_sum(ss) * (1.f / 1024.f) + 1e-6f);
#pragma unroll
            for (int j = 0; j < 4; ++j) { const int c = (j * 64 + lane) * 4;
                v[r][j].x += gt[j].x * (zz[j].x * rinv * gp[j].x); v[r][j].y += gt[j].y * (zz[j].y * rinv * gp[j].y); v[r][j].z += gt[j].z * (zz[j].z * rinv * gp[j].z); v[r][j].w += gt[j].w * (zz[j].w * rinv * gp[j].w);
                *(f32x4*)(J.xdst + c) = v[r][j]; }
        }
        if (J.hdst) {
            f32x4 g[4], sh[4], sc[4]; float ss = 0.f;
#pragma unroll
            for (int j = 0; j < 4; ++j) { const int c = (j * 64 + lane) * 4; g[j] = *(const f32x4*)(J.gpre + c); sh[j] = *(const f32x4*)(J.shift + c); sc[j] = *(const f32x4*)(J.scale + c); }
#pragma unroll
            for (int j = 0; j < 4; ++j) ss += v[r][j].x * v[r][j].x + v[r][j].y * v[r][j].y + v[r][j].z * v[r][j].z + v[r][j].w * v[r][j].w;
            const float rinv = 1.f / sqrtf(wave_sum(ss) * (1.f / 1024.f) + 1e-6f);
#pragma unroll
            for (int j = 0; j < 4; ++j) { const int c = (j * 64 + lane) * 4;
                u32x2 o; o.x = pk2(v[r][j].x * rinv * g[j].x * (1.f + sc[j].x) + sh[j].x, v[r][j].y * rinv * g[j].y * (1.f + sc[j].y) + sh[j].y);
                o.y = pk2(v[r][j].z * rinv * g[j].z * (1.f + sc[j].z) + sh[j].z, v[r][j].w * rinv * g[j].w * (1.f + sc[j].w) + sh[j].w);
                *(u32x2*)(J.hdst + c) = o; }
        }
    }
}
__device__ __forceinline__ void phase_rowops(const Params& p, int mode, int l, int nrows, int bid, int nb) {
    const int tid = get_tid(), lane = tid & 63, wave = tid >> 6;
    constexpr int RB = 4;
    const int nwaves = nb * 8, gw = bid * 8 + wave;
    for (int base = gw; base < nrows; base += nwaves * RB) {
        RowJob jb[RB]; bool valid[RB];
#pragma unroll
        for (int r = 0; r < RB; ++r) { const int row = base + r * nwaves; valid[r] = row < nrows; jb[r] = make_rowjob(p, mode, l, valid[r] ? row : 0); }
        rowop_batch<RB>(jb, valid, lane);
    }
}

__device__ __forceinline__ void rwkv_prep_item(const Params& p, int l, LAS unsigned char* lds, int tile) {
    const int tid = get_tid(), lane = tid & 63, wave = tid >> 6, fr = lane & 15, fq = lane >> 4;
    const bf16_t* P = (const bf16_t*)(p.ws + WS_P);
    const int t0 = tile * 32; const SeqInfo s0 = seq_of_row(t0);
    const float* mu = p.in[14] + l * 1024;
    LAS bf16_t* r_s = (LAS bf16_t*)lds;
    LAS bf16_t* k_s = r_s + 32 * 256;
    LAS bf16_t* v_s = k_s + 32 * 256;
    LAS unsigned char* twd = lds + 3 * 16384;
    LAS unsigned char* ads = twd + 32 * 144;
    LAS float* O1 = (LAS float*)(ads + 32 * 144);
#pragma unroll
    for (int it = 0; it < 7; ++it) {
        const int pc = tid + it * 512; const int tok = pc / 112, c8 = pc % 112, cc = c8 * 8;
        const int pcol = cc < 256 ? PC_RWR + cc : PC_RWK + (cc - 256);
        const int row = t0 + tok, pos = s0.pos + tok;
        const u32x4 u0 = *(const u32x4*)(P + (size_t)row * NP + pcol);
        const u32x4 um = pos > 0 ? *(const u32x4*)(P + (size_t)(row - 1) * NP + pcol) : (u32x4){0u, 0u, 0u, 0u};
        const u32x4 up = pos < s0.len - 1 ? *(const u32x4*)(P + (size_t)(row + 1) * NP + pcol) : (u32x4){0u, 0u, 0u, 0u};
        const f32x4 mu0 = *(const f32x4*)(mu + cc), mu1 = *(const f32x4*)(mu + cc + 4);
        float z0[8], zm[8], zp[8], zs[8]; unpack8(u0, z0); unpack8(um, zm); unpack8(up, zp);
        const float mm[8] = {mu0.x, mu0.y, mu0.z, mu0.w, mu1.x, mu1.y, mu1.z, mu1.w};
#pragma unroll
        for (int x = 0; x < 8; ++x) zs[x] = z0[x] + mm[x] * (0.5f * (zm[x] + zp[x]) - z0[x]);
        LAS unsigned char* dst;
        if (cc < 256) dst = (LAS unsigned char*)(r_s + tok * 256 + cc);
        else if (cc < 512) dst = (LAS unsigned char*)(k_s + tok * 256 + cc - 256);
        else if (cc < 768) dst = (LAS unsigned char*)(v_s + tok * 256 + cc - 512);
        else if (cc < 832) { dst = twd + tok * 144 + (cc - 768) * 2;
#pragma unroll
            for (int x = 0; x < 8; ++x) zs[x] = 1.f - 2.f * __builtin_amdgcn_rcpf(1.f + __expf(2.f * zs[x])); }
        else dst = ads + tok * 144 + (cc - 832) * 2;
        *(LAS u32x4*)dst = (u32x4){cvt_pk_bf16(zs[0], zs[1]), cvt_pk_bf16(zs[2], zs[3]), cvt_pk_bf16(zs[4], zs[5]), cvt_pk_bf16(zs[6], zs[7])};
    }
    __syncthreads();
    const int hh = tid >> 8, c = tid & 255, h = c >> 6;
    bf16_t* RK = (bf16_t*)(p.ws + WS_RWK); bf16_t* RV = (bf16_t*)(p.ws + WS_RWV); bf16_t* RR = (bf16_t*)(p.ws + WS_RWRR);
    bf16_t* RA0 = (bf16_t*)(p.ws + WS_RWA0); bf16_t* RA1 = (bf16_t*)(p.ws + WS_RWA1); bf16_t* RM0 = (bf16_t*)(p.ws + WS_RWM0); bf16_t* RM1 = (bf16_t*)(p.ws + WS_RWM1);
    float* BON = (float*)(p.ws + WS_BON);
#pragma unroll
    for (int pass = 0; pass < 2; ++pass) {
        { const bf16_t* WT = (const bf16_t*)(p.ws + WS_LORAT + ((size_t)l * 4 + pass * 2) * 256 * 64 * 2);
          LAS unsigned char* A = pass ? ads : twd;
          const bf16x8 x00 = *(const LAS bf16x8*)(A + fr * 144 + fq * 16), x01 = *(const LAS bf16x8*)(A + fr * 144 + 64 + fq * 16);
          const bf16x8 x10 = *(const LAS bf16x8*)(A + (16 + fr) * 144 + fq * 16), x11 = *(const LAS bf16x8*)(A + (16 + fr) * 144 + 64 + fq * 16);
          bf16x8 b0[4], b1[4];
#pragma unroll
          for (int q = 0; q < 4; ++q) { const int t = wave * 4 + q, m = t >> 4, nt = t & 15; const bf16_t* wrow = WT + (size_t)m * 256 * 64 + (size_t)(nt * 16 + fr) * 64 + fq * 8;
              b0[q] = *(const bf16x8*)wrow; b1[q] = *(const bf16x8*)(wrow + 32); }
#pragma unroll
          for (int q = 0; q < 4; ++q) { const int t = wave * 4 + q, m = t >> 4, nt = t & 15;
              f32x4 a0 = (f32x4){0.f, 0.f, 0.f, 0.f}, a1 = a0;
              a0 = __builtin_amdgcn_mfma_f32_16x16x32_bf16(x00, b0[q], a0, 0, 0, 0); a0 = __builtin_amdgcn_mfma_f32_16x16x32_bf16(x01, b1[q], a0, 0, 0, 0);
              a1 = __builtin_amdgcn_mfma_f32_16x16x32_bf16(x10, b0[q], a1, 0, 0, 0); a1 = __builtin_amdgcn_mfma_f32_16x16x32_bf16(x11, b1[q], a1, 0, 0, 0);
#pragma unroll
              for (int r = 0; r < 4; ++r) { O1[(m * 32 + fq * 4 + r) * 256 + nt * 16 + fr] = a0[r]; O1[(m * 32 + 16 + fq * 4 + r) * 256 + nt * 16 + fr] = a1[r]; } } }
        __syncthreads();
        if (pass == 0) {
            const float w0b0 = p.in[15][(l * 2 + 0) * 256 + c], w0b1 = p.in[15][(l * 2 + 1) * 256 + c];
#pragma unroll
            for (int i = 0; i < 16; ++i) { const int tok = hh * 16 + i; const size_t o = (size_t)(t0 + tok) * 256 + c;
                const float sg0 = sigmoidf_(w0b0 + O1[tok * 256 + c]), sg1 = sigmoidf_(w0b1 + O1[(32 + tok) * 256 + c]);
                RM0[o] = f2bf(1.f - __expf(-0.60653066f * sg0)); RM1[o] = f2bf(1.f - __expf(-0.60653066f * sg1)); }
        } else {
            const float a0b0 = p.in[17][(l * 2 + 0) * 256 + c], a0b1 = p.in[17][(l * 2 + 1) * 256 + c];
            const float ka = p.in[21][l * 256 + c], rk = p.in[22][l * 256 + c];
#pragma unroll
            for (int i = 0; i < 16; ++i) { const int tok = hh * 16 + i, row = t0 + tok; const size_t o = (size_t)row * 256 + c;
                const bf16_t kb = k_s[tok * 256 + c], vb = v_s[tok * 256 + c], rb = r_s[tok * 256 + c];
                const float k = bf2f(kb), r = bf2f(rb);
                const float a0 = sigmoidf_(a0b0 + O1[tok * 256 + c]), a1 = sigmoidf_(a0b1 + O1[(32 + tok) * 256 + c]);
                const float kt0 = k * (1.f + (a0 - 1.f) * ka), kt1 = k * (1.f + (a1 - 1.f) * ka);
                const float bs = wave_sum(r * (kt0 + kt1) * rk);
                RK[o] = kb; RV[o] = vb; RR[o] = rb; RA0[o] = f2bf(a0); RA1[o] = f2bf(a1);
                if ((tid & 63) == 0) BON[(size_t)row * 4 + h] = bs; }
        }
        __syncthreads();
    }
}
__device__ __forceinline__ int ret_chunk_index(int cr, int& b) { if (cr < 256) { b = cr >> 5; return 2 + (cr & 31); } b = (cr - 256) >> 1; return (cr - 256) & 1; }
__device__ __forceinline__ void ret_kv_item(const Params& p, LAS unsigned char* lds, int item) {
    const int tid = get_tid(), lane = tid & 63, wave = tid >> 6, fr = lane & 15, fq = lane >> 4;
    const bf16_t* P = (const bf16_t*)(p.ws + WS_P);
    const int cr = item >> 2, h = item & 3; int b; const int ci = ret_chunk_index(cr, b);
    const int r0 = cr * 128;
    LAS unsigned char* Ktf = lds;
    LAS unsigned char* Ktb = lds + 64 * 272;
    LAS unsigned char* Vt = lds + 2 * 64 * 272;
    const float lg2 = log1pf(-exp2f(-5.f - (float)h)) * 1.44269504f;
#pragma unroll
    for (int it = 0; it < 2; ++it) { const int pc = tid + it * 512, j = pc >> 3, c8 = pc & 7;
        const u32x4 kk = *(const u32x4*)(P + (size_t)(r0 + j) * NP + PC_RETK + h * 64 + c8 * 8);
        const u32x4 vv = *(const u32x4*)(P + (size_t)(r0 + j) * NP + PC_RETV + h * 64 + c8 * 8);
        float kf[8]; unpack8(kk, kf);
        const float df = 0.125f * __builtin_amdgcn_exp2f((float)(127 - j) * lg2), db = 0.125f * __builtin_amdgcn_exp2f((float)j * lg2);
        const unsigned vw[4] = {vv.x, vv.y, vv.z, vv.w};
#pragma unroll
        for (int x = 0; x < 8; ++x) { const int d = c8 * 8 + x;
            *(LAS bf16_t*)(Ktf + d * 272 + j * 2) = f2bf(kf[x] * df); *(LAS bf16_t*)(Ktb + d * 272 + j * 2) = f2bf(kf[x] * db);
            *(LAS bf16_t*)(Vt + d * 272 + j * 2) = (bf16_t)((x & 1) ? (vw[x >> 1] >> 16) : (vw[x >> 1] & 0xffff)); } }
    __syncthreads();
    const int dir = wave >> 2, mt = wave & 3;
    LAS unsigned char* A = dir ? Ktb : Ktf;
    bf16x8 af[4];
#pragma unroll
    for (int kc = 0; kc < 4; ++kc) af[kc] = *(const LAS bf16x8*)(A + (mt * 16 + fr) * 272 + kc * 64 + fq * 16);
    float* RS = (float*)(p.ws + WS_RET) + ((size_t)((b * 4 + h) * 34 + ci) * 2 + dir) * 4096;
#pragma unroll
    for (int nt = 0; nt < 4; ++nt) { f32x4 acc = (f32x4){0.f, 0.f, 0.f, 0.f};
#pragma unroll
        for (int kc = 0; kc < 4; ++kc) { const bf16x8 bf = *(const LAS bf16x8*)(Vt + (nt * 16 + fr) * 272 + kc * 64 + fq * 16);
            acc = __builtin_amdgcn_mfma_f32_16x16x32_bf16(af[kc], bf, acc, 0, 0, 0); }
#pragma unroll
        for (int r = 0; r < 4; ++r) RS[(mt * 16 + fq * 4 + r) * 64 + nt * 16 + fr] = acc[r]; }
    __syncthreads();
}
__device__ __forceinline__ void swa_prep_item(const Params& p, LAS unsigned char* lds, int tile) {
    const int tid = get_tid();
    bf16_t* P = (bf16_t*)(p.ws + WS_P);
    const float* tabc = (const float*)(p.ws + WS_TAB); const float* tabs = tabc + 1024;
    bf16_t* KS = (bf16_t*)(p.ws + WS_KS); bf16_t* VT = (bf16_t*)(p.ws + WS_VTS);
    const int t0 = tile * 64; const SeqInfo s0 = seq_of_row(t0);
    const int key0 = s0.isctx ? s0.pos : CTXL + s0.pos;
    LAS bf16_t* Vs = (LAS bf16_t*)lds;
    u32x4 vreg[2];
#pragma unroll
    for (int it = 0; it < 2; ++it) { const int pc = tid + it * 512, tok = pc >> 4, c8 = pc & 15; vreg[it] = *(const u32x4*)(P + (size_t)(t0 + tok) * NP + PC_SWAV + c8 * 8); }
    u32x4 x1[3], x2[3];
#pragma unroll
    for (int it = 0; it < 3; ++it) { const int e = tid + it * 512; const int tok = e / 24, rem = e % 24, hd = rem >> 2, axis = (rem >> 1) & 1, fg = rem & 1;
        const int colbase = (hd < 4 ? PC_SWAQ + hd * 64 : PC_SWAK + (hd - 4) * 64) + axis * 32 + fg * 8;
        x1[it] = *(const u32x4*)(P + (size_t)(t0 + tok) * NP + colbase); x2[it] = *(const u32x4*)(P + (size_t)(t0 + tok) * NP + colbase + 16); }
#pragma unroll
    for (int it = 0; it < 2; ++it) { const int pc = tid + it * 512, tok = pc >> 4, c8 = pc & 15; *(LAS u32x4*)(Vs + tok * 136 + c8 * 8) = vreg[it]; }
#pragma unroll
    for (int it = 0; it < 3; ++it) { const int e = tid + it * 512; const int tok = e / 24, rem = e % 24, hd = rem >> 2, axis = (rem >> 1) & 1, fg = rem & 1;
        const int row = t0 + tok, pos = s0.pos + tok;
        const int colbase = (hd < 4 ? PC_SWAQ + hd * 64 : PC_SWAK + (hd - 4) * 64) + axis * 32 + fg * 8;
        float a[8], bb[8]; unpack8(x1[it], a); unpack8(x2[it], bb);
        if (!s0.isctx) { const int pp = axis == 0 ? (pos >> 6) : (pos & 63);
            const f32x4 c0 = *(const f32x4*)(tabc + pp * 16 + fg * 8), c1 = *(const f32x4*)(tabc + pp * 16 + fg * 8 + 4), s0v = *(const f32x4*)(tabs + pp * 16 + fg * 8), s1v = *(const f32x4*)(tabs + pp * 16 + fg * 8 + 4);
            const float cs[8] = {c0.x, c0.y, c0.z, c0.w, c1.x, c1.y, c1.z, c1.w}, sn[8] = {s0v.x, s0v.y, s0v.z, s0v.w, s1v.x, s1v.y, s1v.z, s1v.w};
#pragma unroll
            for (int x = 0; x < 8; ++x) { const float y1 = a[x] * cs[x] - bb[x] * sn[x], y2 = bb[x] * cs[x] + a[x] * sn[x]; a[x] = y1; bb[x] = y2; } }
        u32x4 o1, o2; o1.x = pk2(a[0], a[1]); o1.y = pk2(a[2], a[3]); o1.z = pk2(a[4], a[5]); o1.w = pk2(a[6], a[7]);
        o2.x = pk2(bb[0], bb[1]); o2.y = pk2(bb[2], bb[3]); o2.z = pk2(bb[4], bb[5]); o2.w = pk2(bb[6], bb[7]);
        if (hd < 4) { if (!s0.isctx) { *(u32x4*)(P + (size_t)row * NP + colbase) = o1; *(u32x4*)(P + (size_t)row * NP + colbase + 16) = o2; } }
        else { bf16_t* kd = KS + ((size_t)(s0.b * 2 + (hd - 4)) * NKEYS + key0 + tok) * 64 + axis * 32 + fg * 8; *(u32x4*)kd = o1; *(u32x4*)(kd + 16) = o2; }
    }
    __syncthreads();
#pragma unroll
    for (int it = 0; it < 2; ++it) { const int pc = tid + it * 512, hd = pc >> 3, k8 = pc & 7, hk = hd >> 6, d = hd & 63;
        unsigned w[4];
#pragma unroll
        for (int x = 0; x < 4; ++x) w[x] = (unsigned)Vs[(k8 * 8 + 2 * x) * 136 + hd] | ((unsigned)Vs[(k8 * 8 + 2 * x + 1) * 136 + hd] << 16);
        *(u32x4*)(VT + ((size_t)(s0.b * 2 + hk) * 64 + d) * NKEYS + key0 + k8 * 8) = (u32x4){w[0], w[1], w[2], w[3]}; }
    __syncthreads();
}
__device__ __forceinline__ void mla_proj_item(const Params& p, int l, LAS unsigned char* lds, int tile);
__device__ __forceinline__ void phase_prepA(const Params& p, int l, LAS unsigned char* lds, int bid, int nb) {
    constexpr int N1 = TT / 32, N2 = 272 * 4, N3 = TT / 64, N4 = TT / 32;
    for (int it = bid; it < N1 + N2 + N3 + N4; it += nb) {
        if (it < N1) rwkv_prep_item(p, l, lds, it);
        else if (it < N1 + N2) ret_kv_item(p, lds, it - N1);
        else if (it < N1 + N2 + N3) swa_prep_item(p, lds, it - N1 - N2);
        else mla_proj_item(p, l, lds, it - N1 - N2 - N3);
    }
}

__device__ __forceinline__ void mla_proj_item(const Params& p, int l, LAS unsigned char* lds, int tile) {
    const int tid = get_tid(), lane = tid & 63, wave = tid >> 6, fr = lane & 15, fq = lane >> 4;
    const bf16_t* P = (const bf16_t*)(p.ws + WS_P);
    const float* tabc = (const float*)(p.ws + WS_TAB) + 2048; const float* tabs = tabc + 512;
    const int t0 = tile * 32; const SeqInfo s0 = seq_of_row(t0);
    const int key0 = s0.isctx ? s0.pos : CTXL + s0.pos;
    LAS unsigned char* qn = lds;
    LAS unsigned char* kvn = lds + 32 * 528;
    LAS float* qo = (LAS float*)(lds + 32 * 528 + 32 * 272);
    LAS float* kvo = qo + 32 * 384;
    const float* qg = p.in[24] + l * 256; const float* kvg = p.in[26] + l * 128;
    for (int i = 0; i < 4; ++i) { const int tok = wave * 4 + i, row = t0 + tok;
        float x[4]; float ss = 0.f;
#pragma unroll
        for (int j = 0; j < 4; ++j) { x[j] = bf2f(P[(size_t)row * NP + PC_MLAQD + j * 64 + lane]); ss += x[j] * x[j]; }
        const float rq = 1.f / sqrtf(wave_sum(ss) * (1.f / 256.f) + 1e-6f);
#pragma unroll
        for (int j = 0; j < 4; ++j) *(LAS bf16_t*)(qn + tok * 528 + (j * 64 + lane) * 2) = f2bf(x[j] * rq * qg[j * 64 + lane]);
        float y[2]; float s2 = 0.f;
#pragma unroll
        for (int j = 0; j < 2; ++j) { y[j] = bf2f(P[(size_t)row * NP + PC_MLAKVD + j * 64 + lane]); s2 += y[j] * y[j]; }
        const float rk = 1.f / sqrtf(wave_sum(s2) * (1.f / 128.f) + 1e-6f);
#pragma unroll
        for (int j = 0; j < 2; ++j) *(LAS bf16_t*)(kvn + tok * 272 + (j * 64 + lane) * 2) = f2bf(y[j] * rk * kvg[j * 64 + lane]);
    }
    __syncthreads();
    {
        const bf16_t* WqT = (const bf16_t*)(p.ws + WS_MLAW + (size_t)l * MLAW_LAYER);
        const bf16_t* WkvT = (const bf16_t*)(p.ws + WS_MLAW + (size_t)l * MLAW_LAYER + MLAW_KV);
        {
            bf16x8 bq[3][8];
#pragma unroll
            for (int q = 0; q < 3; ++q) { const bf16_t* wrow = WqT + (size_t)((wave + 8 * q) * 16 + fr) * 256 + fq * 8;
#pragma unroll
                for (int kc = 0; kc < 8; ++kc) bq[q][kc] = *(const bf16x8*)(wrow + kc * 32); }
#pragma unroll
            for (int q = 0; q < 3; ++q) { const int nt = wave + 8 * q;
                f32x4 a0 = (f32x4){0.f, 0.f, 0.f, 0.f}, a1 = a0;
#pragma unroll
                for (int kc = 0; kc < 8; ++kc) { const bf16x8 x0 = *(const LAS bf16x8*)(qn + fr * 528 + kc * 64 + fq * 16), x1 = *(const LAS bf16x8*)(qn + (16 + fr) * 528 + kc * 64 + fq * 16);
                    a0 = __builtin_amdgcn_mfma_f32_16x16x32_bf16(x0, bq[q][kc], a0, 0, 0, 0); a1 = __builtin_amdgcn_mfma_f32_16x16x32_bf16(x1, bq[q][kc], a1, 0, 0, 0); }
#pragma unroll
                for (int r = 0; r < 4; ++r) { qo[(fq * 4 + r) * 384 + nt * 16 + fr] = a0[r]; qo[(16 + fq * 4 + r) * 384 + nt * 16 + fr] = a1[r]; } }
        }
        {
            bf16x8 bk[4][4];
#pragma unroll
            for (int q = 0; q < 4; ++q) { const bf16_t* wrow = WkvT + (size_t)((wave + 8 * q) * 16 + fr) * 128 + fq * 8;
#pragma unroll
                for (int kc = 0; kc < 4; ++kc) bk[q][kc] = *(const bf16x8*)(wrow + kc * 32); }
#pragma unroll
            for (int q = 0; q < 4; ++q) { const int n0 = (wave + 8 * q) * 16;
                f32x4 a0 = (f32x4){0.f, 0.f, 0.f, 0.f}, a1 = a0;
#pragma unroll
                for (int kc = 0; kc < 4; ++kc) { const bf16x8 x0 = *(const LAS bf16x8*)(kvn + fr * 272 + kc * 64 + fq * 16), x1 = *(const LAS bf16x8*)(kvn + (16 + fr) * 272 + kc * 64 + fq * 16);
                    a0 = __builtin_amdgcn_mfma_f32_16x16x32_bf16(x0, bk[q][kc], a0, 0, 0, 0); a1 = __builtin_amdgcn_mfma_f32_16x16x32_bf16(x1, bk[q][kc], a1, 0, 0, 0); }
#pragma unroll
                for (int r = 0; r < 4; ++r) { kvo[(fq * 4 + r) * 512 + n0 + fr] = a0[r]; kvo[(16 + fq * 4 + r) * 512 + n0 + fr] = a1[r]; } }
        }
    }
    __syncthreads();
    {
        const int h = tid >> 7, dd = tid & 127;
        if (dd < 64) { bf16_t* KM = (bf16_t*)(p.ws + WS_KM) + ((size_t)(s0.b * 4 + h) * NKEYS + key0) * 96 + dd;
#pragma unroll
            for (int i = 0; i < 32; ++i) KM[(size_t)i * 96] = f2bf(kvo[i * 512 + tid]); }
        else { bf16_t* VT = (bf16_t*)(p.ws + WS_VTM) + ((size_t)(s0.b * 4 + h) * 64 + (dd - 64)) * NKEYS + key0;
            unsigned w[16];
#pragma unroll
            for (int i = 0; i < 16; ++i) w[i] = pk2(kvo[(2 * i) * 512 + tid], kvo[(2 * i + 1) * 512 + tid]);
#pragma unroll
            for (int i = 0; i < 4; ++i) *(u32x4*)(VT + i * 8) = (u32x4){w[4 * i], w[4 * i + 1], w[4 * i + 2], w[4 * i + 3]}; }
    }
    bf16_t* MQ = (bf16_t*)(p.ws + WS_MQ);
    for (int e = tid; e < 32 * 384; e += 512) { const int tok = e / 384, c = e % 384, dd = c % 96; const int pos = s0.pos + tok;
        float v = qo[e];
        if (dd >= 64 && !s0.isctx) { const int pe = dd - 64, axis = pe >> 4, half = (pe >> 3) & 1, f = pe & 7; const int pp = axis == 0 ? (pos >> 6) : (pos & 63);
            const float cs = tabc[pp * 8 + f], sn = tabs[pp * 8 + f];
            const float x1 = half ? qo[e - 8] : v, x2 = half ? v : qo[e + 8];
            v = half ? (x2 * cs + x1 * sn) : (x1 * cs - x2 * sn); }
        MQ[(size_t)(t0 + tok) * 384 + c] = f2bf(v); }
    for (int e = tid; e < 32 * 32; e += 512) { const int tok = e >> 5, pe = e & 31, axis = pe >> 4, half = (pe >> 3) & 1, f = pe & 7; const int row = t0 + tok, pos = s0.pos + tok;
        float v = bf2f(P[(size_t)row * NP + PC_MLAKPE + pe]);
        if (!s0.isctx) { const int pp = axis == 0 ? (pos >> 6) : (pos & 63); const float cs = tabc[pp * 8 + f], sn = tabs[pp * 8 + f];
            const float other = bf2f(P[(size_t)row * NP + PC_MLAKPE + (half ? pe - 8 : pe + 8)]);
            const float x1 = half ? other : v, x2 = half ? v : other;
            v = half ? (x2 * cs + x1 * sn) : (x1 * cs - x2 * sn); }
        const bf16_t o = f2bf(v);
#pragma unroll
        for (int h = 0; h < 4; ++h) ((bf16_t*)(p.ws + WS_KM))[((size_t)(s0.b * 4 + h) * NKEYS + key0 + tok) * 96 + 64 + pe] = o; }
    __syncthreads();
}
__device__ __forceinline__ void ret_scan_item(const Params& p, int l, int item) {
    const int tid = get_tid(); const int seq = item >> 1, dir = item & 1, h = seq & 3;
    const float lg = log1pf(-exp2f(-5.f - (float)h)); const float cdec = expf(128.f * lg);
    float* base = (float*)(p.ws + WS_RET) + (size_t)seq * 34 * 2 * 4096 + dir * 4096;
    auto ci_of = [&](int st) -> int { return dir == 0 ? st : (st == 0 ? 1 : (st == 1 ? 0 : 35 - st)); };
    float S[8];
#pragma unroll
    for (int i = 0; i < 8; ++i) S[i] = 0.f;
    f32x4 pa[4], pb[4];
#pragma unroll
    for (int k = 0; k < 4; ++k) { const float* q = base + (size_t)ci_of(k) * 2 * 4096 + tid * 8; pa[k] = *(const f32x4*)q; pb[k] = *(const f32x4*)(q + 4); }
#pragma unroll 1
    for (int st0 = 0; st0 < 36; st0 += 4) {
#pragma unroll
        for (int k = 0; k < 4; ++k) { const int st = st0 + k;
            if (st < 34) {
                float* q = base + (size_t)ci_of(st) * 2 * 4096 + tid * 8;
                const f32x4 t0 = pa[k], t1 = pb[k];
                if (st + 4 < 34) { const float* qn = base + (size_t)ci_of(st + 4) * 2 * 4096 + tid * 8; pa[k] = *(const f32x4*)qn; pb[k] = *(const f32x4*)(qn + 4); }
                *(f32x4*)q = (f32x4){S[0], S[1], S[2], S[3]}; *(f32x4*)(q + 4) = (f32x4){S[4], S[5], S[6], S[7]};
                S[0] = S[0] * cdec + t0.x; S[1] = S[1] * cdec + t0.y; S[2] = S[2] * cdec + t0.z; S[3] = S[3] * cdec + t0.w;
                S[4] = S[4] * cdec + t1.x; S[5] = S[5] * cdec + t1.y; S[6] = S[6] * cdec + t1.z; S[7] = S[7] * cdec + t1.w;
            } }
    }
    asm volatile("s_waitcnt vmcnt(0)" ::: "memory");
    __syncthreads();
    if (tid == 0) { __builtin_amdgcn_fence(__ATOMIC_RELEASE, "agent"); asm volatile("s_waitcnt vmcnt(0)" ::: "memory");
        __hip_atomic_fetch_add((unsigned*)(p.ws + WS_CTR) + 2 + l, 1u, __ATOMIC_RELAXED, __HIP_MEMORY_SCOPE_AGENT); }
}
__device__ __forceinline__ void ret_wait_states(const Params& p, int l) {
    if (get_tid() == 0) { unsigned* f = (unsigned*)(p.ws + WS_CTR) + 2 + l; unsigned sp = 0;
        while (__hip_atomic_load(f, __ATOMIC_RELAXED, __HIP_MEMORY_SCOPE_AGENT) < 64u) { __builtin_amdgcn_s_sleep(4); if (++sp > (1u << 22)) break; }
        __builtin_amdgcn_fence(__ATOMIC_ACQUIRE, "agent"); asm volatile("s_waitcnt vmcnt(0)" ::: "memory"); }
    __syncthreads();
}
template <int DK>
__device__ __forceinline__ void attn_unit(const bf16_t* Q, int qstride, const bf16_t* K, const bf16_t* Vt, int nctx, int mt0, int mt1, bool masked, int qpos0,
                                          bool has_sink, float sink, float scale, bf16_t* O, int ostride, LAS unsigned char* lds) {
    constexpr int KC = DK / 32, KP = DK + 8, KROW = KP * 2;
    constexpr int PIECES_K = 64 * DK / 8;
    constexpr int BUFB = 64 * KROW + 64 * 144;
    const int tid = get_tid(), lane = tid & 63, wave = tid >> 6, fr = lane & 15, fq = lane >> 4;
    const float sl2 = scale * 1.44269504f;
    bf16x8 qf[2][KC];
#pragma unroll
    for (int g = 0; g < 2; ++g)
#pragma unroll
        for (int kc = 0; kc < KC; ++kc) { const u32x4 u = *(const u32x4*)(Q + (size_t)(wave * 32 + g * 16 + fr) * qstride + kc * 32 + fq * 8); float f[8]; unpack8(u, f);
            u32x4 o; o.x = cvt_pk_bf16(f[0] * sl2, f[1] * sl2); o.y = cvt_pk_bf16(f[2] * sl2, f[3] * sl2); o.z = cvt_pk_bf16(f[4] * sl2, f[5] * sl2); o.w = cvt_pk_bf16(f[6] * sl2, f[7] * sl2);
            qf[g][kc] = __builtin_bit_cast(bf16x8, o); }
    float mq[2] = {0.f, 0.f}, lsum[2] = {0.f, 0.f}; f32x4 o[2][4];
#pragma unroll
    for (int g = 0; g < 2; ++g)
#pragma unroll
        for (int n = 0; n < 4; ++n) o[g][n] = (f32x4){0.f, 0.f, 0.f, 0.f};
    const int ntiles = nctx + (mt1 - mt0);
    u32x4 kr[2], vr;
    auto issue = [&](int ti) {
        const int tile = ti < nctx ? ti : mt0 + (ti - nctx);
        const bf16_t* kb = K + (size_t)tile * 64 * DK;
#pragma unroll
        for (int i = 0; i < 2; ++i) { const int pc = tid + i * 512; if (pc < PIECES_K) kr[i] = *(const u32x4*)(kb + (size_t)pc * 8); }
        { const int d = tid >> 3, c8 = tid & 7; vr = *(const u32x4*)(Vt + (size_t)d * NKEYS + tile * 64 + c8 * 8); }
    };
    auto stash = [&](int bufi) {
        LAS unsigned char* Kt = lds + bufi * BUFB; LAS unsigned char* Vl = Kt + 64 * KROW;
#pragma unroll
        for (int i = 0; i < 2; ++i) { const int pc = tid + i * 512; if (pc < PIECES_K) { const int row = pc / (DK / 8), c8 = pc % (DK / 8); *(LAS u32x4*)(Kt + row * KROW + c8 * 16) = kr[i]; } }
        { const int d = tid >> 3, c8 = tid & 7; *(LAS u32x4*)(Vl + d * 144 + c8 * 16) = vr; }
    };
    issue(0); stash(0);
    if (ntiles > 1) issue(1);
    __syncthreads();
    for (int ti = 0; ti < ntiles; ++ti) {
        const int tile = ti < nctx ? ti : mt0 + (ti - nctx);
        LAS unsigned char* Kt = lds + (ti & 1) * BUFB; LAS unsigned char* Vl = Kt + 64 * KROW;
        if (ti + 1 < ntiles) { stash((ti + 1) & 1); if (ti + 2 < ntiles) issue(ti + 2); }
        f32x4 s[2][4];
#pragma unroll
        for (int n = 0; n < 4; ++n) {
            s[0][n] = (f32x4){-mq[0], -mq[0], -mq[0], -mq[0]}; s[1][n] = (f32x4){-mq[1], -mq[1], -mq[1], -mq[1]};
#pragma unroll
            for (int kc = 0; kc < KC; ++kc) { const bf16x8 kf = *(const LAS bf16x8*)(Kt + (n * 16 + fr) * KROW + kc * 64 + fq * 16);
                s[0][n] = __builtin_amdgcn_mfma_f32_16x16x32_bf16(kf, qf[0][kc], s[0][n], 0, 0, 0);
                s[1][n] = __builtin_amdgcn_mfma_f32_16x16x32_bf16(kf, qf[1][kc], s[1][n], 0, 0, 0); } }
        if (ti == 0) {
#pragma unroll
            for (int g = 0; g < 2; ++g) {
                float t = -INFINITY;
#pragma unroll
                for (int n = 0; n < 4; ++n)
#pragma unroll
                    for (int r = 0; r < 4; ++r) t = fmaxf(t, s[g][n][r]);
                t = fmaxf(t, __shfl_xor(t, 16)); t = fmaxf(t, __shfl_xor(t, 32));
                if (has_sink) t = fmaxf(t, sink * 1.44269504f);
                mq[g] = t;
#pragma unroll
                for (int n = 0; n < 4; ++n)
#pragma unroll
                    for (int r = 0; r < 4; ++r) s[g][n][r] -= t;
            }
        }
        if (masked && ti >= nctx) {
#pragma unroll
            for (int g = 0; g < 2; ++g)
#pragma unroll
                for (int n = 0; n < 4; ++n)
#pragma unroll
                    for (int r = 0; r < 4; ++r) { const int kp = tile * 64 + n * 16 + fq * 4 + r - CTXL, qp = qpos0 + wave * 32 + g * 16 + fr; const int df = qp - kp; if (df > 128 || df < -128) s[g][n][r] = -INFINITY; }
        }
#pragma unroll
        for (int g = 0; g < 2; ++g)
#pragma unroll
            for (int n = 0; n < 4; ++n)
#pragma unroll
                for (int r = 0; r < 4; ++r) { s[g][n][r] = __builtin_amdgcn_exp2f(s[g][n][r]); lsum[g] += s[g][n][r]; }
#pragma unroll
        for (int c = 0; c < 2; ++c) {
            bf16x8 pf[2];
#pragma unroll
            for (int g = 0; g < 2; ++g) { u32x4 pu; pu.x = cvt_pk_bf16(s[g][2 * c][0], s[g][2 * c][1]); pu.y = cvt_pk_bf16(s[g][2 * c][2], s[g][2 * c][3]);
                pu.z = cvt_pk_bf16(s[g][2 * c + 1][0], s[g][2 * c + 1][1]); pu.w = cvt_pk_bf16(s[g][2 * c + 1][2], s[g][2 * c + 1][3]); pf[g] = __builtin_bit_cast(bf16x8, pu); }
#pragma unroll
            for (int n = 0; n < 4; ++n) {
                const u32x2 lo = *(const LAS u32x2*)(Vl + (n * 16 + fr) * 144 + ((2 * c) * 16 + fq * 4) * 2), hi = *(const LAS u32x2*)(Vl + (n * 16 + fr) * 144 + ((2 * c + 1) * 16 + fq * 4) * 2);
                const bf16x8 vf = __builtin_bit_cast(bf16x8, (u32x4){lo.x, lo.y, hi.x, hi.y});
                o[0][n] = __builtin_amdgcn_mfma_f32_16x16x32_bf16(vf, pf[0], o[0][n], 0, 0, 0);
                o[1][n] = __builtin_amdgcn_mfma_f32_16x16x32_bf16(vf, pf[1], o[1][n], 0, 0, 0); }
        }
        __syncthreads();
    }
#pragma unroll
    for (int g = 0; g < 2; ++g) {
        float t = lsum[g];
        t += __shfl_xor(t, 16); t += __shfl_xor(t, 32);
        if (has_sink) t += __builtin_amdgcn_exp2f(sink * 1.44269504f - mq[g]);
        const float inv = 1.f / t;
#pragma unroll
        for (int n = 0; n < 4; ++n) { u32x2 ov; ov.x = cvt_pk_bf16(o[g][n][0] * inv, o[g][n][1] * inv); ov.y = cvt_pk_bf16(o[g][n][2] * inv, o[g][n][3] * inv);
            *(u32x2*)(O + (size_t)(wave * 32 + g * 16 + fr) * ostride + n * 16 + fq * 4) = ov; }
    }
}

__device__ __forceinline__ void ret_out_item(const Params& p, int l, LAS unsigned char* lds, int item) {
    const int tid = get_tid(), lane = tid & 63, wave = tid >> 6, fr = lane & 15, fq = lane >> 4;
    bf16_t* P = (bf16_t*)(p.ws + WS_P);
    const int cr = item >> 2, h = item & 3; int b; const int ci = ret_chunk_index(cr, b);
    const int r0 = cr * 128;
    const float lg2 = log1pf(-exp2f(-5.f - (float)h)) * 1.44269504f;
    LAS unsigned char* Kb = lds;
    LAS unsigned char* Vt = lds + 18432;
    LAS unsigned char* SfT = lds + 35840;
    LAS unsigned char* SbT = lds + 45056;
    for (int pc = tid; pc < 1024; pc += 512) { const int j = pc >> 3, c8 = pc & 7;
        const u32x4 kk = *(const u32x4*)(P + (size_t)(r0 + j) * NP + PC_RETK + h * 64 + c8 * 8);
        const u32x4 vv = *(const u32x4*)(P + (size_t)(r0 + j) * NP + PC_RETV + h * 64 + c8 * 8);
        float kf[8]; unpack8(kk, kf);
        u32x4 ko; ko.x = pk2(kf[0] * 0.125f, kf[1] * 0.125f); ko.y = pk2(kf[2] * 0.125f, kf[3] * 0.125f); ko.z = pk2(kf[4] * 0.125f, kf[5] * 0.125f); ko.w = pk2(kf[6] * 0.125f, kf[7] * 0.125f);
        *(LAS u32x4*)(Kb + j * 144 + c8 * 16) = ko;
        const unsigned vw[4] = {vv.x, vv.y, vv.z, vv.w};
#pragma unroll
        for (int x = 0; x < 8; ++x) *(LAS bf16_t*)(Vt + (c8 * 8 + x) * 272 + j * 2) = (bf16_t)((x & 1) ? (vw[x >> 1] >> 16) : (vw[x >> 1] & 0xffff)); }
    { const float* RS = (const float*)(p.ws + WS_RET) + ((size_t)((b * 4 + h) * 34 + ci) * 2) * 4096;
      for (int pc = tid; pc < 1024; pc += 512) { const int d = pc >> 4, e4 = (pc & 15) * 4;
          const f32x4 a = *(const f32x4*)(RS + d * 64 + e4), bb = *(const f32x4*)(RS + 4096 + d * 64 + e4);
#pragma unroll
          for (int x = 0; x < 4; ++x) { *(LAS bf16_t*)(SfT + (e4 + x) * 144 + d * 2) = f2bf(a[x]); *(LAS bf16_t*)(SbT + (e4 + x) * 144 + d * 2) = f2bf(bb[x]); } } }
    const int i = wave * 16 + fr;
    u32x4 qraw[2];
#pragma unroll
    for (int kc = 0; kc < 2; ++kc) qraw[kc] = *(const u32x4*)(P + (size_t)(r0 + i) * NP + PC_RETQ + h * 64 + kc * 32 + fq * 8);
    __syncthreads();
    f32x4 s[8];
#pragma unroll
    for (int nb = 0; nb < 8; ++nb) { s[nb] = (f32x4){0.f, 0.f, 0.f, 0.f};
#pragma unroll
        for (int kc = 0; kc < 2; ++kc) { const bf16x8 kf = *(const LAS bf16x8*)(Kb + (nb * 16 + fr) * 144 + kc * 64 + fq * 16);
            s[nb] = __builtin_amdgcn_mfma_f32_16x16x32_bf16(kf, __builtin_bit_cast(bf16x8, qraw[kc]), s[nb], 0, 0, 0); } }
#pragma unroll
    for (int nb = 0; nb < 8; ++nb)
#pragma unroll
        for (int r = 0; r < 4; ++r) { const int j = nb * 16 + fq * 4 + r; const int df = i - j; const int adf = df < 0 ? -df : df;
            float dcy = __builtin_amdgcn_exp2f((float)adf * lg2); if (df == 0) dcy = 2.f; s[nb][r] *= dcy; }
    f32x4 o[4];
#pragma unroll
    for (int n = 0; n < 4; ++n) o[n] = (f32x4){0.f, 0.f, 0.f, 0.f};
#pragma unroll
    for (int c = 0; c < 4; ++c) {
        u32x4 pu; pu.x = cvt_pk_bf16(s[2 * c][0], s[2 * c][1]); pu.y = cvt_pk_bf16(s[2 * c][2], s[2 * c][3]); pu.z = cvt_pk_bf16(s[2 * c + 1][0], s[2 * c + 1][1]); pu.w = cvt_pk_bf16(s[2 * c + 1][2], s[2 * c + 1][3]);
        const bf16x8 pf = __builtin_bit_cast(bf16x8, pu);
#pragma unroll
        for (int n = 0; n < 4; ++n) {
            const u32x2 lo = *(const LAS u32x2*)(Vt + (n * 16 + fr) * 272 + ((2 * c) * 16 + fq * 4) * 2), hi = *(const LAS u32x2*)(Vt + (n * 16 + fr) * 272 + ((2 * c + 1) * 16 + fq * 4) * 2);
            const bf16x8 vf = __builtin_bit_cast(bf16x8, (u32x4){lo.x, lo.y, hi.x, hi.y});
            o[n] = __builtin_amdgcn_mfma_f32_16x16x32_bf16(vf, pf, o[n], 0, 0, 0); }
    }
    const float gf = __builtin_amdgcn_exp2f((float)(i + 1) * lg2), gb = __builtin_amdgcn_exp2f((float)(128 - i) * lg2);
#pragma unroll
    for (int kc = 0; kc < 2; ++kc) {
        float f[8]; unpack8(qraw[kc], f);
        u32x4 uf, ub;
        uf.x = cvt_pk_bf16(f[0] * gf, f[1] * gf); uf.y = cvt_pk_bf16(f[2] * gf, f[3] * gf); uf.z = cvt_pk_bf16(f[4] * gf, f[5] * gf); uf.w = cvt_pk_bf16(f[6] * gf, f[7] * gf);
        ub.x = cvt_pk_bf16(f[0] * gb, f[1] * gb); ub.y = cvt_pk_bf16(f[2] * gb, f[3] * gb); ub.z = cvt_pk_bf16(f[4] * gb, f[5] * gb); ub.w = cvt_pk_bf16(f[6] * gb, f[7] * gb);
        const bf16x8 qF = __builtin_bit_cast(bf16x8, uf), qB = __builtin_bit_cast(bf16x8, ub);
#pragma unroll
        for (int n = 0; n < 4; ++n) {
            const bf16x8 af = *(const LAS bf16x8*)(SfT + (n * 16 + fr) * 144 + kc * 64 + fq * 16), ab = *(const LAS bf16x8*)(SbT + (n * 16 + fr) * 144 + kc * 64 + fq * 16);
            o[n] = __builtin_amdgcn_mfma_f32_16x16x32_bf16(af, qF, o[n], 0, 0, 0);
            o[n] = __builtin_amdgcn_mfma_f32_16x16x32_bf16(ab, qB, o[n], 0, 0, 0); }
    }
    float sm = 0.f;
#pragma unroll
    for (int n = 0; n < 4; ++n) sm += (o[n][0] + o[n][1]) + (o[n][2] + o[n][3]);
    sm += __shfl_xor(sm, 16); sm += __shfl_xor(sm, 32);
    const float mu = sm * (1.f / 64.f);
    float vs = 0.f;
#pragma unroll
    for (int n = 0; n < 4; ++n)
#pragma unroll
        for (int r = 0; r < 4; ++r) { const float dl = o[n][r] - mu; vs += dl * dl; }
    vs += __shfl_xor(vs, 16); vs += __shfl_xor(vs, 32);
    const float rstd = 1.f / sqrtf(vs * (1.f / 64.f) + 1e-5f);
#pragma unroll
    for (int n = 0; n < 4; ++n) { const int e0 = n * 16 + fq * 4;
        const u32x2 gu = *(const u32x2*)(P + (size_t)(r0 + i) * NP + PC_RETG + h * 64 + e0);
        const f32x4 gn = *(const f32x4*)(p.in[13] + l * 256 + h * 64 + e0);
        const float g0 = bf2f((bf16_t)(gu.x & 0xffff)), g1 = bf2f((bf16_t)(gu.x >> 16)), g2 = bf2f((bf16_t)(gu.y & 0xffff)), g3 = bf2f((bf16_t)(gu.y >> 16));
        u32x2 yo;
        yo.x = cvt_pk_bf16((o[n][0] - mu) * rstd * gn.x * (g0 / (1.f + __expf(-g0))), (o[n][1] - mu) * rstd * gn.y * (g1 / (1.f + __expf(-g1))));
        yo.y = cvt_pk_bf16((o[n][2] - mu) * rstd * gn.z * (g2 / (1.f + __expf(-g2))), (o[n][3] - mu) * rstd * gn.w * (g3 / (1.f + __expf(-g3))));
        *(u32x2*)(P + (size_t)(r0 + i) * NP + PC_RETQ + h * 64 + e0) = yo; }
    __syncthreads();
}

constexpr int NSCANBLK = 128;
__device__ __forceinline__ void rwkv_scan_item(const Params& p, int l, LAS unsigned char* lds, int item) {
    const int tid = get_tid();
    const int sc = item >> 1, half = item & 1;
    const int b = sc >> 3, h = (sc >> 1) & 3, dir = sc & 1;
    const bf16_t* RK = (const bf16_t*)(p.ws + WS_RWK); const bf16_t* RV = (const bf16_t*)(p.ws + WS_RWV); const bf16_t* RR = (const bf16_t*)(p.ws + WS_RWRR);
    const bf16_t* RA = (const bf16_t*)(p.ws + (dir ? WS_RWA1 : WS_RWA0)); const bf16_t* RM = (const bf16_t*)(p.ws + (dir ? WS_RWM1 : WS_RWM0));
    bf16_t* P = (bf16_t*)(p.ws + WS_P);
    const int ocol = (dir ? PC_RWO1 : PC_RWO0) + h * 64 + half * 32;
    LAS float* KH = (LAS float*)lds;
    LAS float* WW = KH + 4096; LAS float* BB = WW + 4096; LAS float* KT = BB + 4096; LAS float* RRl = KT + 4096; LAS float* VV = RRl + 4096; LAS float* OUT = VV + 4096;
    const int st = tid >> 3, c0 = (tid & 7) * 8;
    float kkp[8], kap[8];
#pragma unroll
    for (int i = 0; i < 8; ++i) { kkp[i] = p.in[20][l * 256 + h * 64 + c0 + i]; kap[i] = p.in[21][l * 256 + h * 64 + c0 + i]; }
    const int row_l = tid >> 4, kq = tid & 15;
    f32x2 S[2];
#pragma unroll
    for (int i = 0; i < 2; ++i) S[i] = (f32x2){0.f, 0.f};
    auto row_of = [&](int s) -> int {
        if (s < CTXL) return TMAIN + b * CTXL + (dir ? CTXL - 1 - s : s);
        const int t = s - CTXL; return b * SEQL + (dir ? SEQL - 1 - t : t);
    };
    u32x4 gk, gv, gr, ga, gm;
    auto issue = [&](int ch) { const size_t o = (size_t)row_of(ch * 64 + st) * 256 + h * 64 + c0;
        gk = *(const u32x4*)(RK + o); gv = *(const u32x4*)(RV + o); gr = *(const u32x4*)(RR + o); ga = *(const u32x4*)(RA + o); gm = *(const u32x4*)(RM + o); };
    issue(0);
    for (int ch = 0; ch < 68; ++ch) {
        {
            float k[8], a[8], om[8], rr[8], vv8[8]; unpack8(gk, k); unpack8(ga, a); unpack8(gm, om); unpack8(gr, rr); unpack8(gv, vv8);
            float kk[8]; float n2 = 0.f;
#pragma unroll
            for (int i = 0; i < 8; ++i) { kk[i] = k[i] * kkp[i]; n2 += kk[i] * kk[i]; }
            n2 = red8(n2);
            const float rn = 1.f / sqrtf(fmaxf(n2, 1e-12f));
            f32x4 o0, o1;
#define ST8(DST, EXPR) { float t8[8]; _Pragma("unroll") for (int i = 0; i < 8; ++i) t8[i] = (EXPR); \
            *(LAS f32x4*)(DST + st * 64 + c0) = (f32x4){t8[0], t8[1], t8[2], t8[3]}; *(LAS f32x4*)(DST + st * 64 + c0 + 4) = (f32x4){t8[4], t8[5], t8[6], t8[7]}; }
            ST8(KH, kk[i] * rn)
            ST8(WW, 1.f - om[i])
            ST8(BB, kk[i] * rn * a[i])
            ST8(KT, k[i] * (1.f + (a[i] - 1.f) * kap[i]))
            ST8(RRl, rr[i])
            ST8(VV, vv8[i])
#undef ST8
        }
        __syncthreads();
        if (ch + 1 < 68) issue(ch + 1);
        {
            struct Ops { f32x4 kh, w, b, t, r; float vv; };
            auto ldops = [&](int s) -> Ops { Ops q;
                q.kh = *(const LAS f32x4*)(KH + s * 64 + kq * 4); q.w = *(const LAS f32x4*)(WW + s * 64 + kq * 4); q.b = *(const LAS f32x4*)(BB + s * 64 + kq * 4);
                q.t = *(const LAS f32x4*)(KT + s * 64 + kq * 4); q.r = *(const LAS f32x4*)(RRl + s * 64 + kq * 4);
                q.vv = VV[s * 64 + half * 32 + row_l]; return q; };
            Ops nx = ldops(0);
#pragma unroll 2
            for (int s = 0; s < 64; ++s) {
                const Ops c = nx;
                nx = ldops(s + 1 < 64 ? s + 1 : 63);
                f32x2 a2 = S[0] * (f32x2){c.kh.x, c.kh.y}; a2 = S[1] * (f32x2){c.kh.z, c.kh.w} + a2;
                const float sk = red16(a2.x + a2.y);
                const f32x2 nsk = (f32x2){-sk, -sk}, vv2 = (f32x2){c.vv, c.vv};
                S[0] = S[0] * (f32x2){c.w.x, c.w.y} + (nsk * (f32x2){c.b.x, c.b.y} + vv2 * (f32x2){c.t.x, c.t.y});
                S[1] = S[1] * (f32x2){c.w.z, c.w.w} + (nsk * (f32x2){c.b.z, c.b.w} + vv2 * (f32x2){c.t.z, c.t.w});
                f32x2 o2 = S[0] * (f32x2){c.r.x, c.r.y}; o2 = S[1] * (f32x2){c.r.z, c.r.w} + o2;
                const float ov = red16(o2.x + o2.y);
                if (kq == 0) OUT[s * 32 + row_l] = ov;
            }
        }
        __syncthreads();
        { const int c4 = (tid & 7) * 4; const f32x4 ov = *(const LAS f32x4*)(OUT + st * 32 + c4);
          u32x2 o2; o2.x = pk2(ov.x, ov.y); o2.y = pk2(ov.z, ov.w);
          *(u32x2*)(P + (size_t)row_of(ch * 64 + st) * NP + ocol + c4) = o2; }
    }
    __syncthreads();
}

__device__ __forceinline__ void mixer_mla(const Params& p, LAS unsigned char* lds, int it) {
    bf16_t* P = (bf16_t*)(p.ws + WS_P);
    const bf16_t* MQ = (const bf16_t*)(p.ws + WS_MQ);
    int b, h, row0, nm1;
    if (it < 512) { b = it >> 6; h = (it >> 4) & 3; row0 = b * SEQL + (it & 15) * 256; nm1 = 68; }
    else { const int u = it - 512; b = u >> 2; h = u & 3; row0 = TMAIN + b * CTXL; nm1 = 4; }
    attn_unit<96>(MQ + (size_t)row0 * 384 + h * 96, 384, (const bf16_t*)(p.ws + WS_KM) + (size_t)(b * 4 + h) * NKEYS * 96, (const bf16_t*)(p.ws + WS_VTM) + (size_t)(b * 4 + h) * 64 * NKEYS,
                  4, 4, nm1, false, 0, false, 0.f, 0.10206207f, P + (size_t)row0 * NP + PC_MLAQD + h * 64, NP, lds);
}
__device__ __forceinline__ void mixer_swa(const Params& p, int l, LAS unsigned char* lds, int u0) {
    bf16_t* P = (bf16_t*)(p.ws + WS_P);
    int b, h, row0, nm0, nm1, qp0; bool msk;
    if (u0 < 512) { b = u0 >> 6; h = (u0 >> 4) & 3; const int qb = u0 & 15; row0 = b * SEQL + qb * 256; nm0 = 4 + 4 * qb - 2; nm1 = 4 + 4 * qb + 6; if (nm0 < 4) nm0 = 4; if (nm1 > 68) nm1 = 68; qp0 = qb * 256; msk = true; }
    else { const int u = u0 - 512; b = u >> 2; h = u & 3; row0 = TMAIN + b * CTXL; nm0 = 4; nm1 = 4; qp0 = 0; msk = false; }
    const int hk = h >> 1;
    bf16_t* qp = P + (size_t)row0 * NP + PC_SWAQ + h * 64;
    attn_unit<64>(qp, NP, (const bf16_t*)(p.ws + WS_KS) + (size_t)(b * 2 + hk) * NKEYS * 64, (const bf16_t*)(p.ws + WS_VTS) + (size_t)(b * 2 + hk) * 64 * NKEYS,
                  4, nm0, nm1, msk, qp0, true, p.in[12][l * 4 + h], 0.125f, qp, NP, lds);
}
__device__ __forceinline__ void phase_mixers(const Params& p, int l, LAS unsigned char* lds, int bid, int nb) {
    const bool ectx = (l == 0);
    const int N_MLA = 512 + (ectx ? 32 : 0), N_SWA = 512 + (ectx ? 32 : 0), N_RET = 1024 + (ectx ? 64 : 0);
    if (bid < NSCANBLK) rwkv_scan_item(p, l, lds, bid);
    else if (bid < NSCANBLK + 64) ret_scan_item(p, l, bid - NSCANBLK);
    bool ret_ready = false;
    unsigned* ctr = (unsigned*)(p.ws + WS_CTR) + l;
    LAS unsigned* slot = (LAS unsigned*)(lds + LDS_BYTES - 16);
    const int tid0 = get_tid();
    for (;;) {
        __syncthreads();
        if (tid0 == 0) *slot = atomicAdd(ctr, 1u);
        __syncthreads();
        const int it = (int)*slot;
        if (it >= N_MLA + N_SWA + N_RET) break;
        if (it < N_MLA) mixer_mla(p, lds, it);
        else if (it < N_MLA + N_SWA) mixer_swa(p, l, lds, it - N_MLA);
        else { if (!ret_ready) { ret_wait_states(p, l); ret_ready = true; } ret_out_item(p, l, lds, it - N_MLA - N_SWA); }
    }
}

__device__ __forceinline__ void phase_rwkv_finish(const Params& p, int l, LAS unsigned char* lds, int bid, int nb) {
    const int tid = get_tid();
    bf16_t* P = (bf16_t*)(p.ws + WS_P);
    const int ntiles = (l == 0 ? TT : TMAIN) / 32;
    const float* mu = p.in[14] + l * 1024 + 896;
    const float* gup = p.in[19] + (size_t)l * 128 * 256;
    const bf16_t* RV = (const bf16_t*)(p.ws + WS_RWV); const float* BON = (const float*)(p.ws + WS_BON);
    for (int tile = bid; tile < ntiles; tile += nb) {
        const int t0 = tile * 32; const SeqInfo s0 = seq_of_row(t0);
        LAS unsigned char* sgb = lds;
        LAS float* gout = (LAS float*)(lds + 32 * 272);
        { const int tok = tid >> 4, j8 = (tid & 15) * 8; const int row = t0 + tok, pos = s0.pos + tok;
          const u32x4 u0 = *(const u32x4*)(P + (size_t)row * NP + PC_RWGD + j8);
          const u32x4 um = pos > 0 ? *(const u32x4*)(P + (size_t)(row - 1) * NP + PC_RWGD + j8) : (u32x4){0u, 0u, 0u, 0u};
          const u32x4 up = pos < s0.len - 1 ? *(const u32x4*)(P + (size_t)(row + 1) * NP + PC_RWGD + j8) : (u32x4){0u, 0u, 0u, 0u};
          float z0[8], zm[8], zp[8], sv[8]; unpack8(u0, z0); unpack8(um, zm); unpack8(up, zp);
#pragma unroll
          for (int x = 0; x < 8; ++x) sv[x] = sigmoidf_(z0[x] + mu[j8 + x] * (0.5f * (zm[x] + zp[x]) - z0[x]));
          *(LAS u32x4*)(sgb + tok * 272 + j8 * 2) = (u32x4){cvt_pk_bf16(sv[0], sv[1]), cvt_pk_bf16(sv[2], sv[3]), cvt_pk_bf16(sv[4], sv[5]), cvt_pk_bf16(sv[6], sv[7])}; }
        __syncthreads();
        { const int lane = tid & 63, wave = tid >> 6, fr = lane & 15, fq = lane >> 4;
          const bf16_t* GT = (const bf16_t*)(p.ws + WS_GUPT + (size_t)l * 256 * 128 * 2);
#pragma unroll
          for (int q = 0; q < 2; ++q) { const int nt = wave + q * 8;
              f32x4 a0 = (f32x4){0.f, 0.f, 0.f, 0.f}, a1 = a0;
              const bf16_t* wrow = GT + (size_t)(nt * 16 + fr) * 128 + fq * 8;
              bf16x8 bfr[4];
#pragma unroll
              for (int kc = 0; kc < 4; ++kc) bfr[kc] = *(const bf16x8*)(wrow + kc * 32);
#pragma unroll
              for (int kc = 0; kc < 4; ++kc) { const bf16x8 x0 = *(const LAS bf16x8*)(sgb + fr * 272 + kc * 64 + fq * 16), x1 = *(const LAS bf16x8*)(sgb + (16 + fr) * 272 + kc * 64 + fq * 16);
                  a0 = __builtin_amdgcn_mfma_f32_16x16x32_bf16(x0, bfr[kc], a0, 0, 0, 0); a1 = __builtin_amdgcn_mfma_f32_16x16x32_bf16(x1, bfr[kc], a1, 0, 0, 0); }
#pragma unroll
              for (int r = 0; r < 4; ++r) { gout[(fq * 4 + r) * 256 + nt * 16 + fr] = a0[r]; gout[(16 + fq * 4 + r) * 256 + nt * 16 + fr] = a1[r]; } } }
        __syncthreads();
        const int hh = tid >> 8, c = tid & 255, h = c >> 6;
        float g[16];
#pragma unroll
        for (int i = 0; i < 16; ++i) g[i] = gout[(hh * 16 + i) * 256 + c];
        const float gn = p.in[23][l * 256 + c];
        float ov[16], rv[16], bn[16];
#pragma unroll
        for (int i = 0; i < 16; ++i) { const int row = t0 + hh * 16 + i;
            ov[i] = bf2f(P[(size_t)row * NP + PC_RWO0 + c]) + bf2f(P[(size_t)row * NP + PC_RWO1 + c]); rv[i] = bf2f(RV[(size_t)row * 256 + c]); bn[i] = BON[(size_t)row * 4 + h]; }
#pragma unroll
        for (int i = 0; i < 16; ++i) { const int row = t0 + hh * 16 + i;
            const float o = ov[i];
            const float mean = wave_sum(o) * (1.f / 64.f); const float dl = o - mean; const float var = wave_sum(dl * dl) * (1.f / 64.f);
            float y = dl * (1.f / sqrtf(var + 64e-5f)) * gn + bn[i] * rv[i];
            P[(size_t)row * NP + PC_RWO1 + c] = f2bf(y * g[i]); }
        __syncthreads();
    }
}

#ifndef N_LAUNCH_MODE
#define N_LAUNCH_MODE 1
#endif
template <int Q>
__device__ __forceinline__ void layer_phase(const Params& p, int l, LAS unsigned char* lds, int bid, int nb) {
    unsigned char* wb = p.ws + WS_WB + (size_t)l * WB_LAYER;
    const int Mrows = (l == 0) ? TT : TMAIN;
    pg8::StaticOrder S;
    if constexpr (Q == 0) { pg8::Gemm g{(const bf16_t*)(p.ws + WS_HB), (const bf16_t*)(wb + WB_IN), TT, NP, DM, DM}; S.init(TT, NP, nb, bid);
              pg8::EpiBf16<0> E{(bf16_t*)(p.ws + WS_P), NP}; pg8::gemm_phase(lds, g, S, E); }
    if constexpr (Q == 1) phase_prepA(p, l, lds, bid, nb);
    if constexpr (Q == 3) phase_mixers(p, l, lds, bid, nb);
    if constexpr (Q == 4) phase_rwkv_finish(p, l, lds, bid, nb);
    if constexpr (Q == 5) { pg8::Gemm g{(const bf16_t*)(p.ws + WS_P), (const bf16_t*)(wb + WB_OUT), Mrows, DM, DM, NP}; S.init(Mrows, DM, nb, bid);
              pg8::EpiBf16<0> E{(bf16_t*)(p.ws + WS_Z), DM}; pg8::gemm_phase(lds, g, S, E); }
    if constexpr (Q == 6) phase_rowops(p, 1, l, Mrows, bid, nb);
    if constexpr (Q == 7) { pg8::Gemm g{(const bf16_t*)(p.ws + WS_HB), (const bf16_t*)(wb + WB_W1), Mrows, FF, DM, DM}; S.init(Mrows, FF, nb, bid);
              pg8::EpiBf16<1> E{(bf16_t*)(p.ws + WS_HID), FF}; pg8::gemm_phase(lds, g, S, E); }
    if constexpr (Q == 8) { pg8::Gemm g{(const bf16_t*)(p.ws + WS_HID), (const bf16_t*)(wb + WB_W2), Mrows, DM, FF, FF}; S.init(Mrows, DM, nb, bid);
              pg8::EpiBf16<0> E{(bf16_t*)(p.ws + WS_Z), DM}; pg8::gemm_phase(lds, g, S, E); }
    if constexpr (Q == 9) phase_rowops(p, 2, l, Mrows, bid, nb);
}

#ifndef PROBE_MASK
#define PROBE_MASK 0
#endif
#define PB(BIT, CALL) do { if ((PROBE_MASK) & (BIT)) { const unsigned long long t0_ = __builtin_amdgcn_s_memrealtime(); CALL; const unsigned long long t1_ = __builtin_amdgcn_s_memrealtime(); \
        while (__builtin_amdgcn_s_memrealtime() - t1_ < (t1_ - t0_)) __builtin_amdgcn_s_sleep(8); } else { CALL; } } while (0)
#define XB_TMO      128
#define XB_XCNT(j)  (256  + 64 * (j))
#define XB_XSUB(j)  (1280 + 64 * (j))
#define XB_XGEN(j)  (2304 + 64 * (j))
#define XB_TOP      3328
#define XB_TOPGEN   3392
#define XCD_BAR_WORDS 3456
#define XB_SPIN_CAP (1u << 18)

__device__ __forceinline__ unsigned xb_ld(unsigned* p)              { return __hip_atomic_load(p, __ATOMIC_RELAXED, __HIP_MEMORY_SCOPE_AGENT); }
__device__ __forceinline__ unsigned xb_add(unsigned* p, unsigned v) { return __hip_atomic_fetch_add(p, v, __ATOMIC_RELAXED, __HIP_MEMORY_SCOPE_AGENT); }
__device__ __forceinline__ unsigned xb_xcc_id() { return (unsigned)__builtin_amdgcn_s_getreg((3 << 11) | 20) & 0xFu; }
#define XB_SPIN(cond, bar) do { unsigned _sp = 0; while (cond) { __builtin_amdgcn_s_sleep(1); \
    if ((++_sp & 255u) == 0u) { if (xb_ld(&(bar)[XB_TMO])) break; if (_sp > XB_SPIN_CAP) { atomicAdd(&(bar)[XB_TMO], 1u); break; } } } } while (0)

struct XcdBarrier {
    unsigned* bar; unsigned x;
    volatile LAS unsigned* st;
};

__device__ __forceinline__ XcdBarrier xcd_barrier_post(unsigned* bar, volatile LAS unsigned* st) {
    XcdBarrier b; b.bar = bar; b.x = xb_xcc_id(); b.st = st;
    if (threadIdx.x == 0) (void)xb_add(&bar[XB_XCNT(b.x)], 1u);
    return b;
}
__device__ __forceinline__ void xcd_barrier_complete(unsigned* bar, unsigned x, unsigned& nloc, unsigned& nx) {
    const unsigned G = gridDim.x * gridDim.y * gridDim.z;
    unsigned sum, cnt, mine, sp = 0u;
    for (;;) {
        sum = 0u; cnt = 0u; mine = 0u;
#pragma unroll
        for (unsigned j = 0; j < 16; ++j) { const unsigned c = xb_ld(&bar[XB_XCNT(j)]); sum += c; cnt += (c > 0u) ? 1u : 0u; mine = (j == x) ? c : mine; }
        if (sum == G) break;
        __builtin_amdgcn_s_sleep(1);
        if ((++sp & 255u) == 0u) { if (xb_ld(&bar[XB_TMO])) break; if (sp > XB_SPIN_CAP) { atomicAdd(&bar[XB_TMO], 1u); break; } }
    }
    nloc = mine > 0u ? mine : 1u; nx = cnt > 0u ? cnt : 1u;
}

__device__ __forceinline__ void xcd_barrier(const XcdBarrier& b) {
    asm volatile("s_waitcnt vmcnt(0)" ::: "memory");
    __syncthreads();
    if (threadIdx.x == 0) {
        unsigned* bar = b.bar;
        __builtin_amdgcn_s_waitcnt(0);
        unsigned nloc = b.st[0], nx = b.st[1];
        if (nloc == 0u) { xcd_barrier_complete(bar, b.x, nloc, nx); b.st[0] = nloc; b.st[1] = nx; }
        const unsigned old = xb_add(&bar[XB_XSUB(b.x)], 1u);
        const unsigned gen = old / nloc;
        if (old + 1u == (gen + 1u) * nloc) {
            __builtin_amdgcn_fence(__ATOMIC_RELEASE, "agent");
            asm volatile("s_waitcnt vmcnt(0)" ::: "memory");
            const unsigned og = xb_add(&bar[XB_TOP], 1u);
            const unsigned tg = og / nx;
            if (og + 1u == (tg + 1u) * nx) xb_add(&bar[XB_TOPGEN], 1u);
            else XB_SPIN(xb_ld(&bar[XB_TOPGEN]) == tg, bar);
            __builtin_amdgcn_fence(__ATOMIC_ACQUIRE, "agent");
            xb_add(&bar[XB_XGEN(b.x)], 1u);
            asm volatile("s_waitcnt vmcnt(0)" ::: "memory");
        } else {
            XB_SPIN(xb_ld(&bar[XB_XGEN(b.x)]) == gen, bar);
            __builtin_amdgcn_fence(__ATOMIC_ACQUIRE, "agent");
            asm volatile("s_waitcnt vmcnt(0)" ::: "memory");
        }
    }
    __syncthreads();
}


constexpr size_t WS_XBAR = 772 * 1024;
#define GSYNC() xcd_barrier(xb)

__global__ void __launch_bounds__(512, 2) mega_fwd(Params p) {
    extern __shared__ __attribute__((aligned(16))) unsigned char lds_raw[];
    LAS unsigned char* lds = (LAS unsigned char*)lds_raw;
    cg::grid_group grid = cg::this_grid();
    const int bid = blockIdx.x, nb = gridDim.x;
    { LAS unsigned* st_ = (LAS unsigned*)(lds + LDS_BYTES - 32); if (get_tid() == 0) { st_[0] = 0u; st_[1] = 0u; } __syncthreads(); }
    XcdBarrier xb = xcd_barrier_post((unsigned*)(p.ws + WS_XBAR), (volatile LAS unsigned*)(lds + LDS_BYTES - 32));
    PB(16, phase_prologue(p, lds, bid, nb));
    { asm volatile("s_waitcnt vmcnt(0) lgkmcnt(0)" ::: "memory"); __syncthreads(); if (get_tid() < 64) { __builtin_amdgcn_fence(__ATOMIC_RELEASE, "agent"); asm volatile("s_waitcnt vmcnt(0) lgkmcnt(0)" ::: "memory"); } grid.sync();
      if (get_tid() < 64) { __builtin_amdgcn_fence(__ATOMIC_ACQUIRE, "agent"); asm volatile("s_waitcnt vmcnt(0) lgkmcnt(0)" ::: "memory"); } __syncthreads(); }
    PB(8, phase_rowops(p, 0, 0, TT, bid, nb)); GSYNC();
#define LAYER(L, LAST) \
    PB(1, layer_phase<0>(p, L, lds, bid, nb)); GSYNC(); PB(4, layer_phase<1>(p, L, lds, bid, nb)); GSYNC(); \
    PB(2, layer_phase<3>(p, L, lds, bid, nb)); GSYNC(); PB(4, layer_phase<4>(p, L, lds, bid, nb)); GSYNC(); PB(1, layer_phase<5>(p, L, lds, bid, nb)); GSYNC(); \
    PB(8, layer_phase<6>(p, L, lds, bid, nb)); GSYNC(); PB(1, layer_phase<7>(p, L, lds, bid, nb)); GSYNC(); PB(1, layer_phase<8>(p, L, lds, bid, nb)); GSYNC(); \
    PB(8, layer_phase<9>(p, L, lds, bid, nb)); if (!(LAST)) GSYNC();
    LAYER(0, false)
    LAYER(1, true)
}
#if N_LAUNCH_MODE != 1
template <int PH> __global__ void __launch_bounds__(512, 2) one_phase(Params p, int l) {
    extern __shared__ __attribute__((aligned(16))) unsigned char lds_raw[];
    LAS unsigned char* lds = (LAS unsigned char*)lds_raw;
    if constexpr (PH == 100) phase_prologue(p, lds, blockIdx.x, gridDim.x);
    else if constexpr (PH == 101) phase_rowops(p, 0, 0, TT, blockIdx.x, gridDim.x);
    else layer_phase<PH>(p, l, lds, blockIdx.x, gridDim.x);
}
#endif

extern "C" void kernel_launch(void* const* d_in, const int* in_sizes, int n_in, void* d_out, int out_size, void* d_ws, size_t ws_size, hipStream_t stream) {
    if (n_in != 30 || ws_size < WS_NEED || out_size != TMAIN * DM) { fprintf(stderr, "kernel_launch: unexpected shapes (n_in %d, ws %zu, out %d)\n", n_in, ws_size, out_size); return; }
    Params p{};
    for (int i = 0; i < 30; ++i) p.in[i] = (const float*)d_in[i];
    p.out = (float*)d_out; p.ws = (unsigned char*)d_ws;
    static int grid_blocks = 0;
    if (!grid_blocks) {
        int dev = 0, cus = 0, per_cu = 0;
        (void)hipGetDevice(&dev);
        (void)hipDeviceGetAttribute(&cus, hipDeviceAttributeMultiprocessorCount, dev);
        (void)hipFuncSetAttribute((const void*)mega_fwd, hipFuncAttributeMaxDynamicSharedMemorySize, LDS_BYTES);
        (void)hipOccupancyMaxActiveBlocksPerMultiprocessor(&per_cu, mega_fwd, 512, LDS_BYTES);
        if (per_cu < 1) { fprintf(stderr, "kernel_launch: occupancy query says %d blocks/CU\n", per_cu); per_cu = 1; }
        grid_blocks = cus * 1;
        if (grid_blocks < 128) { fprintf(stderr, "kernel_launch: only %d CUs\n", grid_blocks); }
    }
#if N_LAUNCH_MODE == 1
    (void)hipMemsetAsync((char*)d_ws + 768 * 1024, 0, 32 * 1024, stream);
    void* args[] = {&p};
    hipError_t e = hipLaunchCooperativeKernel((const void*)mega_fwd, dim3(grid_blocks), dim3(512), args, LDS_BYTES, stream);
    if (e != hipSuccess) fprintf(stderr, "cooperative launch failed: %s (grid %d)\n", hipGetErrorString(e), grid_blocks);
#else
#define LP(PH, L) do { (void)hipFuncSetAttribute((const void*)one_phase<PH>, hipFuncAttributeMaxDynamicSharedMemorySize, LDS_BYTES); one_phase<PH><<<grid_blocks, 512, LDS_BYTES, stream>>>(p, L); } while (0)
    LP(100, 0); LP(101, 0);
    for (int l = 0; l < 2; ++l) { LP(0, l); LP(1, l); LP(2, l); LP(3, l); LP(4, l); LP(5, l); LP(6, l); LP(7, l); LP(8, l); LP(9, l); }
#endif
}
```

```cpp
#include <hip/hip_runtime.h>
#include <hip/hip_cooperative_groups.h>
#include <cstdio>
#include <cstdint>
#include <cmath>
namespace cg = cooperative_groups;
__device__ __forceinline__ int get_tid() { int t = threadIdx.x; asm volatile("" : "+v"(t)); return t; }
namespace pg8 {
#define PG8_LAS __attribute__((address_space(3)))
typedef unsigned short bf16_t;
typedef short bf16x8 __attribute__((ext_vector_type(8)));
typedef float f32x4 __attribute__((ext_vector_type(4)));
typedef unsigned u32x4 __attribute__((ext_vector_type(4)));
typedef unsigned u32x2 __attribute__((ext_vector_type(2)));
constexpr int BM = 256, BK = 64, HALF = 128, HTB = HALF * BK * 2, STAGE_BYTES = 8 * HTB, NXCD = 8, WGM = 8;

__host__ __device__ __forceinline__ int lds_byte(int r, int c) { const int st = (r >> 4) * 2 + (c >> 5), rr = r & 15, cc = c & 31, ob = rr * 64 + cc * 2; return st * 1024 + (ob ^ (((ob >> 9) & 1) << 5)); }
__host__ __device__ __forceinline__ void stage_rc(int b, int& R, int& C) { const int st = b / 1024, sb = b % 1024, swz = sb ^ (((sb >> 9) & 1) << 5); R = (st >> 1) * 16 + swz / 64; C = (st & 1) * 32 + (swz % 64) / 2; }

struct Unit { int pm, pn; };
struct Gemm { const bf16_t* A; const bf16_t* Bt; int M, N, K, lda; };

struct StaticOrder {
    int nM, nN, nwg, G, c;
    __host__ __device__ void init(int M, int N, int G_, int c_) { nM = M / BM; nN = N / BM; nwg = nM * nN; G = G_; c = c_; }
    __host__ __device__ bool next(int i, Unit& u) const {
        const long L = (long)i * G + c; if (L >= nwg) return false;
        int wgid = (int)L; { const int q = nwg / NXCD, r = nwg % NXCD, xcd = wgid % NXCD, off = wgid / NXCD; wgid = (xcd < r ? xcd * (q + 1) : r * (q + 1) + (xcd - r) * q) + off; }
        const int nig = WGM * nN, gid = wgid / nig, fm = gid * WGM, gsz = (nM - fm) < WGM ? (nM - fm) : WGM;
        u.pm = fm + ((wgid % nig) % gsz); u.pn = (wgid % nig) / gsz; return true;
    }
};

template <class Epi>
__device__ __forceinline__ void gemm_phase(PG8_LAS unsigned char* lds, const Gemm g, const StaticOrder& S, const Epi& E) {
    const int tid = get_tid(), wid = __builtin_amdgcn_readfirstlane(tid >> 6), lane = tid & 63, wr = wid >> 2, wc = wid & 3, fr = lane & 15, fq = lane >> 4;
    const int K = g.K, nt = K / BK, lda = g.lda;
    unsigned voffA[2], voffB[2];
#pragma unroll
    for (int i = 0; i < 2; ++i) { int R, C; stage_rc(tid * 16 + i * 8192, R, C);
        voffA[i] = (unsigned)(R * lda + C) * 2u; voffB[i] = (unsigned)(R * K + C) * 2u; }
    const size_t kstep = (size_t)(BK * 2);
    const size_t hstepA = (size_t)HALF * lda * 2, hstepB = (size_t)HALF * K * 2;
    const size_t tstepA = 2 * hstepA, tstepB = 2 * hstepB;
    const unsigned ldsw = (unsigned)wid * 1024u;
    const int aoff = lds_byte(wr * 64 + fr, fq * 8), boff = lds_byte(wc * 32 + fr, fq * 8);
#define PG8_SA(b, h) (((b) * 2 + (h)) * HTB)
#define PG8_SB(b, h) ((4 + (b) * 2 + (h)) * HTB)
#define PG8_STAGE(bufoff, gbase, voff) do { _Pragma("unroll") for (int _i = 0; _i < 2; ++_i) \
        __builtin_amdgcn_global_load_lds((const unsigned*)((const char*)(gbase) + (voff)[_i]), (PG8_LAS unsigned*)(lds + (bufoff) + ldsw + _i * 8192), 16, 0, 0); } while (0)
#define PG8_LDA(dst, b, h) do { _Pragma("unroll") for (int m = 0; m < 4; ++m) _Pragma("unroll") for (int k = 0; k < 2; ++k) dst[m][k] = *(const PG8_LAS bf16x8*)(lds + PG8_SA(b, h) + aoff + m * 2048 + k * 1024); } while (0)
#define PG8_LDB(dst, b, h) do { _Pragma("unroll") for (int n = 0; n < 2; ++n) _Pragma("unroll") for (int k = 0; k < 2; ++k) dst[n][k] = *(const PG8_LAS bf16x8*)(lds + PG8_SB(b, h) + boff + n * 2048 + k * 1024); } while (0)
#define PG8_MMA(ai, bj, At, Bt) do { __builtin_amdgcn_s_setprio(1); _Pragma("unroll") for (int m = 0; m < 4; ++m) _Pragma("unroll") for (int n = 0; n < 2; ++n) _Pragma("unroll") for (int k = 0; k < 2; ++k) \
        acc[ai][bj][m][n] = __builtin_amdgcn_mfma_f32_16x16x32_bf16(Bt[n][k], At[m][k], acc[ai][bj][m][n], 0, 0, 0); __builtin_amdgcn_s_setprio(0); } while (0)
#define PG8_WAIT_V(n) asm volatile("s_waitcnt vmcnt(" #n ")" ::: "memory")
#define PG8_WAIT_L(n) asm volatile("s_waitcnt lgkmcnt(" #n ")" ::: "memory")
#define PG8_BAR __builtin_amdgcn_s_barrier()
#define PG8_SCHED __builtin_amdgcn_sched_barrier(0)
    Unit cur, nxt; int ui = 0;
    if (!S.next(0, cur)) return;
    f32x4 acc[2][2][4][2];
#pragma unroll
    for (int a = 0; a < 2; ++a)
#pragma unroll
        for (int b = 0; b < 2; ++b)
#pragma unroll
            for (int m = 0; m < 4; ++m)
#pragma unroll
                for (int n = 0; n < 2; ++n) acc[a][b][m][n] = (f32x4){0.f, 0.f, 0.f, 0.f};
    bf16x8 At[4][2], B0[2][2], B1[2][2];
    const char* cA = (const char*)g.A + (size_t)cur.pm * tstepA; const char* cB = (const char*)g.Bt + (size_t)cur.pn * tstepB;
    PG8_STAGE(PG8_SB(0, 0), cB, voffB); PG8_STAGE(PG8_SA(0, 0), cA, voffA); PG8_STAGE(PG8_SB(0, 1), cB + hstepB, voffB); PG8_STAGE(PG8_SA(0, 1), cA + hstepA, voffA);
    if (wr == 1) PG8_BAR;
    PG8_WAIT_V(4); PG8_BAR;
    PG8_STAGE(PG8_SB(1, 0), cB + kstep, voffB); PG8_STAGE(PG8_SA(1, 0), cA + kstep, voffA); PG8_STAGE(PG8_SB(1, 1), cB + hstepB + kstep, voffB);
    PG8_WAIT_V(6); PG8_BAR;
    for (;;) {
        const bool has_next = S.next(ui + 1, nxt);
        const char* nA = has_next ? (const char*)g.A + (size_t)nxt.pm * tstepA : cA; const char* nB = has_next ? (const char*)g.Bt + (size_t)nxt.pn * tstepB : cB;
        for (int t = 0; t < nt; t += 2) {
            const bool last = (t == nt - 2);
            const char* a1 = cA + (size_t)(t + 1) * kstep;
            const char* a2 = last ? nA : cA + (size_t)(t + 2) * kstep; const char* b2 = last ? nB : cB + (size_t)(t + 2) * kstep;
            const char* a3 = a2 + kstep; const char* b3 = b2 + kstep;
            PG8_LDB(B0, 0, 0); PG8_SCHED; PG8_LDA(At, 0, 0); PG8_STAGE(PG8_SA(1, 1), a1 + hstepA, voffA);
            PG8_WAIT_L(8); PG8_BAR; PG8_WAIT_L(0); PG8_MMA(0, 0, At, B0); PG8_BAR; PG8_SCHED;
            PG8_LDB(B1, 0, 1); PG8_STAGE(PG8_SB(0, 0), b2, voffB);
            PG8_BAR; PG8_WAIT_L(0); PG8_MMA(0, 1, At, B1); PG8_BAR;
            PG8_LDA(At, 0, 1); PG8_STAGE(PG8_SA(0, 0), a2, voffA);
            PG8_BAR; PG8_WAIT_L(0); PG8_MMA(1, 0, At, B0); PG8_BAR; PG8_SCHED;
            PG8_STAGE(PG8_SB(0, 1), b2 + hstepB, voffB);
            PG8_WAIT_V(6); PG8_BAR; PG8_MMA(1, 1, At, B1); PG8_BAR;
            PG8_LDB(B0, 1, 0); PG8_SCHED; PG8_LDA(At, 1, 0); PG8_STAGE(PG8_SA(0, 1), a2 + hstepA, voffA);
            PG8_WAIT_L(8); PG8_BAR; PG8_WAIT_L(0); PG8_MMA(0, 0, At, B0); PG8_BAR; PG8_SCHED;
            PG8_LDB(B1, 1, 1); PG8_STAGE(PG8_SB(1, 0), b3, voffB);
            PG8_BAR; PG8_WAIT_L(0); PG8_MMA(0, 1, At, B1); PG8_BAR;
            PG8_LDA(At, 1, 1); PG8_STAGE(PG8_SA(1, 0), a3, voffA);
            PG8_BAR; PG8_WAIT_L(0); PG8_MMA(1, 0, At, B0); PG8_BAR; PG8_SCHED;
            PG8_STAGE(PG8_SB(1, 1), b3 + hstepB, voffB);
            PG8_WAIT_V(6); PG8_BAR; PG8_MMA(1, 1, At, B1); PG8_BAR;
        }
        E(acc, cur, wr, wc, fr, fq);
        if (!has_next) break;
#pragma unroll
        for (int a = 0; a < 2; ++a)
#pragma unroll
            for (int b = 0; b < 2; ++b)
#pragma unroll
                for (int m = 0; m < 4; ++m)
#pragma unroll
                    for (int n = 0; n < 2; ++n) acc[a][b][m][n] = (f32x4){0.f, 0.f, 0.f, 0.f};
        cur = nxt; cA = nA; cB = nB; ++ui;
    }
    PG8_WAIT_V(0);
    if (wr == 0) PG8_BAR;
    PG8_BAR;
#undef PG8_SA
#undef PG8_SB
#undef PG8_STAGE
#undef PG8_LDA
#undef PG8_LDB
#undef PG8_MMA
#undef PG8_WAIT_V
#undef PG8_WAIT_L
#undef PG8_BAR
#undef PG8_SCHED
}

__device__ __forceinline__ unsigned f2bf_u(float f) { unsigned u = __builtin_bit_cast(unsigned, f); return (u + 0x7fffu + ((u >> 16) & 1u)) >> 16; }
template <int ACT> struct EpiBf16 {
    bf16_t* O; int ldc;
    __device__ __forceinline__ void operator()(const f32x4 (&acc)[2][2][4][2], const Unit& u, int wr, int wc, int fr, int fq) const {
        const int row0 = u.pm * BM + wr * 64 + fr, col0 = u.pn * BM + wc * 32 + 4 * fq;
#pragma unroll
        for (int ai = 0; ai < 2; ++ai)
#pragma unroll
            for (int m = 0; m < 4; ++m) { bf16_t* rowp = O + (size_t)(row0 + ai * HALF + m * 16) * ldc + col0;
#pragma unroll
                for (int bj = 0; bj < 2; ++bj)
#pragma unroll
                    for (int n = 0; n < 2; ++n) { f32x4 v = acc[ai][bj][m][n];
                        if (ACT == 1) { v.x = v.x > 0.f ? v.x * v.x : 0.f; v.y = v.y > 0.f ? v.y * v.y : 0.f; v.z = v.z > 0.f ? v.z * v.z : 0.f; v.w = v.w > 0.f ? v.w * v.w : 0.f; }
                        u32x2 o; o.x = f2bf_u(v.x) | (f2bf_u(v.y) << 16); o.y = f2bf_u(v.z) | (f2bf_u(v.w) << 16);
                        *(u32x2*)(rowp + bj * HALF + n * 16) = o; } }
    }
};
}
typedef unsigned short bf16_t;
typedef short bf16x8 __attribute__((ext_vector_type(8)));
typedef float f32x4 __attribute__((ext_vector_type(4)));
typedef unsigned u32x4 __attribute__((ext_vector_type(4)));
typedef unsigned u32x2 __attribute__((ext_vector_type(2)));
#define LAS __attribute__((address_space(3)))

constexpr int NBATCH = 8, SEQL = 4096, DM = 1024, CTXL = 256, TMAIN = 32768, TCTX = 2048, TT = 34816, NP = 3072, FF = 4096;
constexpr int PC_SWAQ = 0, PC_RETQ = 256, PC_RWR = 512, PC_MLAQD = 768, PC_SWAK = 1024, PC_SWAV = 1152, PC_RETK = 1280, PC_RETV = 1536, PC_RETG = 1792,
              PC_RWK = 2048, PC_RWV = 2304, PC_RWWD = 2560, PC_RWAD = 2624, PC_RWGD = 2688, PC_MLAKVD = 2816, PC_MLAKPE = 2944;
constexpr int PC_RWO0 = PC_RWV, PC_RWO1 = PC_RWR;
constexpr int NKEYS = CTXL + SEQL;

constexpr size_t MiB = 1u << 20;
constexpr size_t WS_MOD = 0;
constexpr size_t WS_TAB = 512 * 1024;
constexpr size_t WS_CTR = 768 * 1024;
constexpr size_t WS_BON = 1 * MiB;
constexpr size_t WS_WB = 2 * MiB;
constexpr size_t WB_LAYER = 24 * MiB, WB_IN = 0, WB_OUT = 6 * MiB, WB_W1 = 8 * MiB, WB_W2 = 16 * MiB;
constexpr size_t WS_XC = 50 * MiB;
constexpr size_t WS_P = 58 * MiB;
constexpr size_t WS_HID = 58 * MiB;
constexpr size_t WS_A = 262 * MiB;
constexpr size_t ARR17 = 17 * MiB;
constexpr size_t WS_RWK = WS_A, WS_RWV = WS_A + ARR17, WS_RWRR = WS_A + 2 * ARR17, WS_RWA0 = WS_A + 3 * ARR17, WS_RWA1 = WS_A + 4 * ARR17,
                 WS_RWM0 = WS_A + 5 * ARR17, WS_RWM1 = WS_A + 6 * ARR17;
constexpr size_t WS_RET = WS_A + 119 * MiB;
constexpr size_t WS_MQ = WS_RET + 34 * MiB;
constexpr size_t WS_KM = WS_MQ + 26738688;
constexpr size_t WS_VTM = WS_KM + 26738688;
constexpr size_t WS_KS = WS_VTM + ARR17;
constexpr size_t WS_VTS = WS_KS + 8912896;
constexpr size_t WS_A_END = WS_VTS + 8912896;
constexpr size_t WS_Z = 330 * MiB;
constexpr size_t WS_HB = 398 * MiB;
constexpr size_t WS_MLAW = 500 * MiB;
constexpr size_t MLAW_LAYER = 384 * 256 * 2 + 512 * 128 * 2, MLAW_KV = 384 * 256 * 2;
constexpr size_t WS_GUPT = 501 * MiB;
constexpr size_t WS_LORAT = 502 * MiB;
constexpr size_t WS_NEED = 503 * MiB;
static_assert(WS_A_END <= WS_NEED && WS_HB + 68 * MiB <= WS_NEED && WS_HID + 272 * MiB <= WS_Z, "ws map");

constexpr int LDS_BYTES = 150 * 1024;

struct Params { const float* in[30]; float* out; unsigned char* ws; };

__device__ __forceinline__ float bf2f(bf16_t v) { return __builtin_bit_cast(float, (unsigned)v << 16); }
__device__ __forceinline__ bf16_t f2bf(float f) { unsigned u = __builtin_bit_cast(unsigned, f); return (bf16_t)((u + 0x7fffu + ((u >> 16) & 1u)) >> 16); }
__device__ __forceinline__ unsigned pk2(float lo, float hi) { return (unsigned)f2bf(lo) | ((unsigned)f2bf(hi) << 16); }
typedef float f32x2 __attribute__((ext_vector_type(2)));
typedef __bf16 bf16x2_t __attribute__((ext_vector_type(2)));
__device__ __forceinline__ unsigned cvt_pk_bf16(float lo, float hi) { const f32x2 v = {lo, hi}; return __builtin_bit_cast(unsigned, __builtin_convertvector(v, bf16x2_t)); }
template <int CTRL> __device__ __forceinline__ float dppf(float v) { return __builtin_bit_cast(float, __builtin_amdgcn_update_dpp(0, __builtin_bit_cast(int, v), CTRL, 0xF, 0xF, true)); }
__device__ __forceinline__ float red4(float v) { v += dppf<0xB1>(v); v += dppf<0x4E>(v); return v; }
__device__ __forceinline__ float red8(float v) { v = red4(v); v += dppf<0x141>(v); return v; }
__device__ __forceinline__ float red16(float v) { v = red8(v); v += dppf<0x140>(v); return v; }
__device__ __forceinline__ float max16(float v) { v = fmaxf(v, dppf<0xB1>(v)); v = fmaxf(v, dppf<0x4E>(v)); v = fmaxf(v, dppf<0x141>(v)); v = fmaxf(v, dppf<0x140>(v)); return v; }
__device__ __forceinline__ float wave_sum(float v) {
    v = red16(v);
    const int u = __builtin_bit_cast(int, v);
    return __builtin_bit_cast(float, __builtin_amdgcn_readlane(u, 0)) + __builtin_bit_cast(float, __builtin_amdgcn_readlane(u, 16)) +
           __builtin_bit_cast(float, __builtin_amdgcn_readlane(u, 32)) + __builtin_bit_cast(float, __builtin_amdgcn_readlane(u, 48));
}
__device__ __forceinline__ void unpack8(const u32x4 u, float* f) {
    f[0] = bf2f((bf16_t)(u.x & 0xffff)); f[1] = bf2f((bf16_t)(u.x >> 16)); f[2] = bf2f((bf16_t)(u.y & 0xffff)); f[3] = bf2f((bf16_t)(u.y >> 16));
    f[4] = bf2f((bf16_t)(u.z & 0xffff)); f[5] = bf2f((bf16_t)(u.z >> 16)); f[6] = bf2f((bf16_t)(u.w & 0xffff)); f[7] = bf2f((bf16_t)(u.w >> 16));
}
__device__ __forceinline__ float sigmoidf_(float x) { return __builtin_amdgcn_rcpf(1.f + __expf(-x)); }

struct SeqInfo { int b, pos, len, start, isctx; };
__device__ __forceinline__ SeqInfo seq_of_row(int row) {
    SeqInfo s;
    if (row < TMAIN) { s.b = row >> 12; s.pos = row & 4095; s.len = SEQL; s.start = s.b << 12; s.isctx = 0; }
    else { const int r = row - TMAIN; s.b = r >> 8; s.pos = r & 255; s.len = CTXL; s.start = TMAIN + (s.b << 8); s.isctx = 1; }
    return s;
}

__device__ __forceinline__ void transpose_item(const float* W, int N, int nsrc0, bf16_t* WT, int K, int ndst0, int k0, LAS float* scr, int lane) {
    if (nsrc0 >= 0) {
#pragma unroll 32
        for (int i = 0; i < 32; ++i) { const int kk = 2 * i + (lane >> 5); scr[kk * 33 + (lane & 31)] = W[(size_t)(k0 + kk) * N + nsrc0 + (lane & 31)]; }
    } else {
#pragma unroll 8
        for (int i = 0; i < 32; ++i) { const int kk = 2 * i + (lane >> 5); scr[kk * 33 + (lane & 31)] = 0.f; }
    }
    __builtin_amdgcn_wave_barrier(); asm volatile("s_waitcnt lgkmcnt(0)" ::: "memory");
    const int c = lane & 7;
#pragma unroll
    for (int j = 0; j < 4; ++j) { const int n = (lane >> 3) + 8 * j; const LAS float* s = scr + (8 * c) * 33 + n;
        u32x4 o; o.x = pk2(s[0 * 33], s[1 * 33]); o.y = pk2(s[2 * 33], s[3 * 33]); o.z = pk2(s[4 * 33], s[5 * 33]); o.w = pk2(s[6 * 33], s[7 * 33]);
        *(u32x4*)(WT + (size_t)(ndst0 + n) * K + k0 + 8 * c) = o; }
    __builtin_amdgcn_wave_barrier(); asm volatile("s_waitcnt lgkmcnt(0)" ::: "memory");
}
__device__ __forceinline__ int win_src_col(int n) {
    if (n < 256) return n;
    if (n < 512) return 512 + (n - 256);
    if (n < 768) return 1536 + (n - 512);
    if (n < 1024) return 2560 + (n - 768);
    if (n < 1280) return 256 + (n - 1024);
    if (n < 2048) return 768 + (n - 1280);
    if (n < 2816) return 1792 + (n - 2048);
    if (n < 2976) return n;
    return -1;
}
__device__ __forceinline__ void phase_prologue(const Params& p, LAS unsigned char* lds, int bid, int nb) {
    const int tid = get_tid(), lane = tid & 63, wave = tid >> 6;
    LAS float* scr = (LAS float*)(lds + wave * 16384);
    const int gw = bid * 8 + wave, NGW = nb * 8;
    constexpr int I_IN = 16 * 96, I_OUT = 16 * 32, I_1 = 16 * 128, I_2 = 64 * 32, I_Q = 4 * 12, I_KV = 2 * 16, I_G = 2 * 8, I_LO = 4 * 8, I_L = I_IN + I_OUT + I_1 + I_2 + I_Q + I_KV + I_G + I_LO;
    for (int it = gw; it < 2 * I_L; it += NGW) {
        const int l = it / I_L; int r = it % I_L;
        unsigned char* wb = p.ws + WS_WB + (size_t)l * WB_LAYER;
        if (r < I_IN) { const int kb = r / 96, nbk = r % 96; transpose_item(p.in[10] + (size_t)l * DM * 2976, 2976, win_src_col(nbk * 32), (bf16_t*)(wb + WB_IN), DM, nbk * 32, kb * 64, scr, lane); continue; } r -= I_IN;
        if (r < I_OUT) { const int kb = r / 32, nbk = r % 32; transpose_item(p.in[11] + (size_t)l * DM * DM, DM, nbk * 32, (bf16_t*)(wb + WB_OUT), DM, nbk * 32, kb * 64, scr, lane); continue; } r -= I_OUT;
        if (r < I_1) { const int kb = r / 128, nbk = r % 128; transpose_item(p.in[28] + (size_t)l * DM * FF, FF, nbk * 32, (bf16_t*)(wb + WB_W1), DM, nbk * 32, kb * 64, scr, lane); continue; } r -= I_1;
        if (r < I_2) { const int kb = r / 32, nbk = r % 32; transpose_item(p.in[29] + (size_t)l * FF * DM, DM, nbk * 32, (bf16_t*)(wb + WB_W2), FF, nbk * 32, kb * 64, scr, lane); continue; } r -= I_2;
        unsigned char* mw = p.ws + WS_MLAW + (size_t)l * MLAW_LAYER;
        if (r < I_Q) { const int kb = r / 12, nbk = r % 12; transpose_item(p.in[25] + (size_t)l * 256 * 384, 384, nbk * 32, (bf16_t*)mw, 256, nbk * 32, kb * 64, scr, lane); continue; } r -= I_Q;
        if (r < I_KV) { const int kb = r / 16, nbk = r % 16; transpose_item(p.in[27] + (size_t)l * 128 * 512, 512, nbk * 32, (bf16_t*)(mw + MLAW_KV), 128, nbk * 32, kb * 64, scr, lane); continue; } r -= I_KV;
        if (r < I_G) { const int kb = r / 8, nbk = r % 8; transpose_item(p.in[19] + (size_t)l * 128 * 256, 256, nbk * 32, (bf16_t*)(p.ws + WS_GUPT + (size_t)l * 256 * 128 * 2), 128, nbk * 32, kb * 64, scr, lane); continue; } r -= I_G;
        { const int m = r / 8, nbk = r % 8; const float* src = (m < 2 ? p.in[16] : p.in[18]) + ((size_t)l * 2 + (m & 1)) * 64 * 256;
          transpose_item(src, 256, nbk * 32, (bf16_t*)(p.ws + WS_LORAT + ((size_t)l * 4 + m) * 256 * 64 * 2), 64, nbk * 32, 0, scr, lane); }
    }
    __syncthreads();
    for (int it = bid; it < 192; it += nb) {
        const int l = it / 96, cb = it % 96;
        LAS float* sc = (LAS float*)lds;
        LAS float* red = sc + 9 * 1024;
        for (int e = tid; e < 9 * 1024; e += 512) { const int r = e >> 10, k = e & 1023; const float v = (r < 8) ? p.in[1][r * 1024 + k] : p.in[3][k]; sc[e] = v / (1.f + __expf(-v)); }
        __syncthreads();
        const int ks = tid >> 6, cl = tid & 63, n = cb * 64 + cl;
        float acc[9];
#pragma unroll
        for (int r = 0; r < 9; ++r) acc[r] = 0.f;
        const float* aw = p.in[4] + (size_t)l * DM * 6144;
#pragma unroll 16
        for (int k = ks * 128; k < ks * 128 + 128; ++k) { const float w = aw[(size_t)k * 6144 + n];
#pragma unroll
            for (int r = 0; r < 9; ++r) acc[r] += sc[r * 1024 + k] * w; }
#pragma unroll
        for (int r = 0; r < 9; ++r) red[(ks * 9 + r) * 64 + cl] = acc[r];
        __syncthreads();
        for (int e = tid; e < 9 * 64; e += 512) { const int r = e >> 6, c2 = e & 63; float s = 0.f;
            for (int q = 0; q < 8; ++q) s += red[(q * 9 + r) * 64 + c2];
            ((float*)(p.ws + WS_MOD))[((size_t)l * 9 + r) * 6144 + cb * 64 + c2] = s + p.in[5][(size_t)l * 6144 + cb * 64 + c2]; }
        __syncthreads();
    }
    if (bid == 0 && tid < 4) ((unsigned*)(p.ws + WS_CTR))[tid] = 0u;
    if (bid == nb - 1) {
        float* tab = (float*)(p.ws + WS_TAB);
        for (int e = tid; e < 64 * 16; e += 512) { const int pos = e >> 4, f = e & 15; const float inv = powf(10000.f, -(float)(2 * f) / 32.f); const float a = (float)pos * inv; tab[e] = cosf(a); tab[1024 + e] = sinf(a); }
        for (int e = tid; e < 64 * 8; e += 512) { const int pos = e >> 3, f = e & 7; const float inv = powf(10000.f, -(float)(2 * f) / 16.f); const float a = (float)pos * inv; tab[2048 + e] = cosf(a); tab[2560 + e] = sinf(a); }
    }
}

struct RowJob { const float* xsrc; const bf16_t* z; const float* gpost; const float* gate; float* xdst; const float* gpre; const float* shift; const float* scale; bf16_t* hdst; };
__device__ __forceinline__ RowJob make_rowjob(const Params& p, int mode, int l, int row) {
    const float* mod = (const float*)(p.ws + WS_MOD);
    bf16_t* HB = (bf16_t*)(p.ws + WS_HB); const bf16_t* Z = (const bf16_t*)(p.ws + WS_Z);
    float* XC = (float*)(p.ws + WS_XC);
    const SeqInfo s = seq_of_row(row);
    const int mr = s.isctx ? 8 : s.b;
    const float* m_l = mod + ((size_t)l * 9 + mr) * 6144;
    float* xs = s.isctx ? XC + (size_t)(row - TMAIN) * DM : p.out + (size_t)row * DM;
    const float* xin = s.isctx ? p.in[2] + (size_t)(row - TMAIN) * DM : p.in[0] + (size_t)row * DM;
    RowJob j;
    if (mode == 0) { j = RowJob{xin, nullptr, nullptr, nullptr, nullptr, p.in[6] + l * DM, m_l + 0, m_l + 1024, HB + (size_t)row * DM}; }
    else if (mode == 1) { j = RowJob{l == 0 ? xin : xs, Z + (size_t)row * DM, p.in[7] + l * DM, m_l + 2048, xs, p.in[8] + l * DM, m_l + 3072, m_l + 4096, HB + (size_t)row * DM}; }
    else { const bool has_next = (l + 1 < 2); const float* m_n = mod + ((size_t)(has_next ? l + 1 : l) * 9 + mr) * 6144;
        j = RowJob{xs, Z + (size_t)row * DM, p.in[9] + l * DM, m_l + 5120, xs, p.in[6] + (has_next ? l + 1 : l) * DM, m_n + 0, m_n + 1024, has_next ? HB + (size_t)row * DM : nullptr}; }
    return j;
}
template <int RB>
__device__ __forceinline__ void rowop_batch(const RowJob (&jb)[RB], const bool (&valid)[RB], int lane) {
    f32x4 v[RB][4]; u32x2 zu[RB][4];
#pragma unroll
    for (int r = 0; r < RB; ++r) if (valid[r]) {
#pragma unroll
        for (int j = 0; j < 4; ++j) { v[r][j] = *(const f32x4*)(jb[r].xsrc + (j * 64 + lane) * 4); if (jb[r].z) zu[r][j] = *(const u32x2*)(jb[r].z + (j * 64 + lane) * 4); }
    }
#pragma unroll
    for (int r = 0; r < RB; ++r) if (valid[r]) {
        const RowJob& J = jb[r];
        if (J.z) {
            f32x4 zz[4], gp[4], gt[4]; float ss = 0.f;
#pragma unroll
            for (int j = 0; j < 4; ++j) { const int c = (j * 64 + lane) * 4; gp[j] = *(const f32x4*)(J.gpost + c); gt[j] = *(const f32x4*)(J.gate + c); }
#pragma unroll
            for (int j = 0; j < 4; ++j) { const u32x2 u = zu[r][j];
                zz[j].x = bf2f((bf16_t)(u.x & 0xffff)); zz[j].y = bf2f((bf16_t)(u.x >> 16)); zz[j].z = bf2f((bf16_t)(u.y & 0xffff)); zz[j].w = bf2f((bf16_t)(u.y >> 16));
                ss += zz[j].x * zz[j].x + zz[j].y * zz[j].y + zz[j].z * zz[j].z + zz[j].w * zz[j].w; }
            const float rinv = 1.f / sqrtf(wave_sum(ss) * (1.f / 1024.f) + 1e-6f);
#pragma unroll
            for (int j = 0; j < 4; ++j) { const int c = (j * 64 + lane) * 4;
                v[r][j].x += gt[j].x * (zz[j].x * rinv * gp[j].x); v[r][j].y += gt[j].y * (zz[j].y * rinv * gp[j].y); v[r][j].z += gt[j].z * (zz[j].z * rinv * gp[j].z); v[r][j].w += gt[j].w * (zz[j].w * rinv * gp[j].w);
                *(f32x4*)(J.xdst + c) = v[r][j]; }
        }
        if (J.hdst) {
            f32x4 g[4], sh[4], sc[4]; float ss = 0.f;
#pragma unroll
            for (int j = 0; j < 4; ++j) { const int c = (j * 64 + lane) * 4; g[j] = *(const f32x4*)(J.gpre + c); sh[j] = *(const f32x4*)(J.shift + c); sc[j] = *(const f32x4*)(J.scale + c); }
#pragma unroll
            for (int j = 0; j < 4; ++j) ss += v[r][j].x * v[r][j].x + v[r][j].y * v[r][j].y + v[r][j].z * v[r][j].z + v[r][j].w * v[r][j].w;
            const float rinv = 1.f / sqrtf(wave_sum(ss) * (1.f / 1024.f) + 1e-6f);
#pragma unroll
            for (int j = 0; j < 4; ++j) { const int c = (j * 64 + lane) * 4;
                u32x2 o; o.x = pk2(v[r][j].x * rinv * g[j].x * (1.f + sc[j].x) + sh[j].x, v[r][j].y * rinv * g[j].y * (1.f + sc[j].y) + sh[j].y);
                o.y = pk2(v[r][j].z * rinv * g[j].z * (1.f + sc[j].z) + sh[j].z, v[r][j].w * rinv * g[j].w * (1.f + sc[j].w) + sh[j].w);
                *(u32x2*)(J.hdst + c) = o; }
        }
    }
}
__device__ __forceinline__ void phase_rowops(const Params& p, int mode, int l, int nrows, int bid, int nb) {
    const int tid = get_tid(), lane = tid & 63, wave = tid >> 6;
    constexpr int RB = 4;
    const int nwaves = nb * 8, gw = bid * 8 + wave;
    for (int base = gw; base < nrows; base += nwaves * RB) {
        RowJob jb[RB]; bool valid[RB];
#pragma unroll
        for (int r = 0; r < RB; ++r) { const int row = base + r * nwaves; valid[r] = row < nrows; jb[r] = make_rowjob(p, mode, l, valid[r] ? row : 0); }
        rowop_batch<RB>(jb, valid, lane);
    }
}

__device__ __forceinline__ void rwkv_prep_item(const Params& p, int l, LAS unsigned char* lds, int tile) {
    const int tid = get_tid(), lane = tid & 63, wave = tid >> 6, fr = lane & 15, fq = lane >> 4;
    const bf16_t* P = (const bf16_t*)(p.ws + WS_P);
    const int t0 = tile * 32; const SeqInfo s0 = seq_of_row(t0);
    const float* mu = p.in[14] + l * 1024;
    LAS bf16_t* r_s = (LAS bf16_t*)lds;
    LAS bf16_t* k_s = r_s + 32 * 256;
    LAS bf16_t* v_s = k_s + 32 * 256;
    LAS unsigned char* twd = lds + 3 * 16384;
    LAS unsigned char* ads = twd + 32 * 144;
    LAS float* O1 = (LAS float*)(ads + 32 * 144);
#pragma unroll
    for (int it = 0; it < 7; ++it) {
        const int pc = tid + it * 512; const int tok = pc / 112, c8 = pc % 112, cc = c8 * 8;
        const int pcol = cc < 256 ? PC_RWR + cc : PC_RWK + (cc - 256);
        const int row = t0 + tok, pos = s0.pos + tok;
        const u32x4 u0 = *(const u32x4*)(P + (size_t)row * NP + pcol);
        const u32x4 um = pos > 0 ? *(const u32x4*)(P + (size_t)(row - 1) * NP + pcol) : (u32x4){0u, 0u, 0u, 0u};
        const u32x4 up = pos < s0.len - 1 ? *(const u32x4*)(P + (size_t)(row + 1) * NP + pcol) : (u32x4){0u, 0u, 0u, 0u};
        const f32x4 mu0 = *(const f32x4*)(mu + cc), mu1 = *(const f32x4*)(mu + cc + 4);
        float z0[8], zm[8], zp[8], zs[8]; unpack8(u0, z0); unpack8(um, zm); unpack8(up, zp);
        const float mm[8] = {mu0.x, mu0.y, mu0.z, mu0.w, mu1.x, mu1.y, mu1.z, mu1.w};
#pragma unroll
        for (int x = 0; x < 8; ++x) zs[x] = z0[x] + mm[x] * (0.5f * (zm[x] + zp[x]) - z0[x]);
        LAS unsigned char* dst;
        if (cc < 256) dst = (LAS unsigned char*)(r_s + tok * 256 + cc);
        else if (cc < 512) dst = (LAS unsigned char*)(k_s + tok * 256 + cc - 256);
        else if (cc < 768) dst = (LAS unsigned char*)(v_s + tok * 256 + cc - 512);
        else if (cc < 832) { dst = twd + tok * 144 + (cc - 768) * 2;
#pragma unroll
            for (int x = 0; x < 8; ++x) zs[x] = 1.f - 2.f * __builtin_amdgcn_rcpf(1.f + __expf(2.f * zs[x])); }
        else dst = ads + tok * 144 + (cc - 832) * 2;
        *(LAS u32x4*)dst = (u32x4){cvt_pk_bf16(zs[0], zs[1]), cvt_pk_bf16(zs[2], zs[3]), cvt_pk_bf16(zs[4], zs[5]), cvt_pk_bf16(zs[6], zs[7])};
    }
    __syncthreads();
    const int hh = tid >> 8, c = tid & 255, h = c >> 6;
    bf16_t* RK = (bf16_t*)(p.ws + WS_RWK); bf16_t* RV = (bf16_t*)(p.ws + WS_RWV); bf16_t* RR = (bf16_t*)(p.ws + WS_RWRR);
    bf16_t* RA0 = (bf16_t*)(p.ws + WS_RWA0); bf16_t* RA1 = (bf16_t*)(p.ws + WS_RWA1); bf16_t* RM0 = (bf16_t*)(p.ws + WS_RWM0); bf16_t* RM1 = (bf16_t*)(p.ws + WS_RWM1);
    float* BON = (float*)(p.ws + WS_BON);
#pragma unroll
    for (int pass = 0; pass < 2; ++pass) {
        { const bf16_t* WT = (const bf16_t*)(p.ws + WS_LORAT + ((size_t)l * 4 + pass * 2) * 256 * 64 * 2);
          LAS unsigned char* A = pass ? ads : twd;
          const bf16x8 x00 = *(const LAS bf16x8*)(A + fr * 144 + fq * 16), x01 = *(const LAS bf16x8*)(A + fr * 144 + 64 + fq * 16);
          const bf16x8 x10 = *(const LAS bf16x8*)(A + (16 + fr) * 144 + fq * 16), x11 = *(const LAS bf16x8*)(A + (16 + fr) * 144 + 64 + fq * 16);
          bf16x8 b0[4], b1[4];
#pragma unroll
          for (int q = 0; q < 4; ++q) { const int t = wave * 4 + q, m = t >> 4, nt = t & 15; const bf16_t* wrow = WT + (size_t)m * 256 * 64 + (size_t)(nt * 16 + fr) * 64 + fq * 8;
              b0[q] = *(const bf16x8*)wrow; b1[q] = *(const bf16x8*)(wrow + 32); }
#pragma unroll
          for (int q = 0; q < 4; ++q) { const int t = wave * 4 + q, m = t >> 4, nt = t & 15;
              f32x4 a0 = (f32x4){0.f, 0.f, 0.f, 0.f}, a1 = a0;
              a0 = __builtin_amdgcn_mfma_f32_16x16x32_bf16(x00, b0[q], a0, 0, 0, 0); a0 = __builtin_amdgcn_mfma_f32_16x16x32_bf16(x01, b1[q], a0, 0, 0, 0);
              a1 = __builtin_amdgcn_mfma_f32_16x16x32_bf16(x10, b0[q], a1, 0, 0, 0); a1 = __builtin_amdgcn_mfma_f32_16x16x32_bf16(x11, b1[q], a1, 0, 0, 0);
#pragma unroll
              for (int r = 0; r < 4; ++r) { O1[(m * 32 + fq * 4 + r) * 256 + nt * 16 + fr] = a0[r]; O1[(m * 32 + 16 + fq * 4 + r) * 256 + nt * 16 + fr] = a1[r]; } } }
        __syncthreads();
        if (pass == 0) {
            const float w0b0 = p.in[15][(l * 2 + 0) * 256 + c], w0b1 = p.in[15][(l * 2 + 1) * 256 + c];
#pragma unroll
            for (int i = 0; i < 16; ++i) { const int tok = hh * 16 + i; const size_t o = (size_t)(t0 + tok) * 256 + c;
                const float sg0 = sigmoidf_(w0b0 + O1[tok * 256 + c]), sg1 = sigmoidf_(w0b1 + O1[(32 + tok) * 256 + c]);
                RM0[o] = f2bf(1.f - __expf(-0.60653066f * sg0)); RM1[o] = f2bf(1.f - __expf(-0.60653066f * sg1)); }
        } else {
            const float a0b0 = p.in[17][(l * 2 + 0) * 256 + c], a0b1 = p.in[17][(l * 2 + 1) * 256 + c];
            const float ka = p.in[21][l * 256 + c], rk = p.in[22][l * 256 + c];
#pragma unroll
            for (int i = 0; i < 16; ++i) { const int tok = hh * 16 + i, row = t0 + tok; const size_t o = (size_t)row * 256 + c;
                const bf16_t kb = k_s[tok * 256 + c], vb = v_s[tok * 256 + c], rb = r_s[tok * 256 + c];
                const float k = bf2f(kb), r = bf2f(rb);
                const float a0 = sigmoidf_(a0b0 + O1[tok * 256 + c]), a1 = sigmoidf_(a0b1 + O1[(32 + tok) * 256 + c]);
                const float kt0 = k * (1.f + (a0 - 1.f) * ka), kt1 = k * (1.f + (a1 - 1.f) * ka);
                const float bs = wave_sum(r * (kt0 + kt1) * rk);
                RK[o] = kb; RV[o] = vb; RR[o] = rb; RA0[o] = f2bf(a0); RA1[o] = f2bf(a1);
                if ((tid & 63) == 0) BON[(size_t)row * 4 + h] = bs; }
        }
        __syncthreads();
    }
}
__device__ __forceinline__ int ret_chunk_index(int cr, int& b) { if (cr < 256) { b = cr >> 5; return 2 + (cr & 31); } b = (cr - 256) >> 1; return (cr - 256) & 1; }
__device__ __forceinline__ void ret_kv_item(const Params& p, LAS unsigned char* lds, int item) {
    const int tid = get_tid(), lane = tid & 63, wave = tid >> 6, fr = lane & 15, fq = lane >> 4;
    const bf16_t* P = (const bf16_t*)(p.ws + WS_P);
    const int cr = item >> 2, h = item & 3; int b; const int ci = ret_chunk_index(cr, b);
    const int r0 = cr * 128;
    LAS unsigned char* Ktf = lds;
    LAS unsigned char* Ktb = lds + 64 * 272;
    LAS unsigned char* Vt = lds + 2 * 64 * 272;
    const float lg2 = log1pf(-exp2f(-5.f - (float)h)) * 1.44269504f;
#pragma unroll
    for (int it = 0; it < 2; ++it) { const int pc = tid + it * 512, j = pc >> 3, c8 = pc & 7;
        const u32x4 kk = *(const u32x4*)(P + (size_t)(r0 + j) * NP + PC_RETK + h * 64 + c8 * 8);
        const u32x4 vv = *(const u32x4*)(P + (size_t)(r0 + j) * NP + PC_RETV + h * 64 + c8 * 8);
        float kf[8]; unpack8(kk, kf);
        const float df = 0.125f * __builtin_amdgcn_exp2f((float)(127 - j) * lg2), db = 0.125f * __builtin_amdgcn_exp2f((float)j * lg2);
        const unsigned vw[4] = {vv.x, vv.y, vv.z, vv.w};
#pragma unroll
        for (int x = 0; x < 8; ++x) { const int d = c8 * 8 + x;
            *(LAS bf16_t*)(Ktf + d * 272 + j * 2) = f2bf(kf[x] * df); *(LAS bf16_t*)(Ktb + d * 272 + j * 2) = f2bf(kf[x] * db);
            *(LAS bf16_t*)(Vt + d * 272 + j * 2) = (bf16_t)((x & 1) ? (vw[x >> 1] >> 16) : (vw[x >> 1] & 0xffff)); } }
    __syncthreads();
    const int dir = wave >> 2, mt = wave & 3;
    LAS unsigned char* A = dir ? Ktb : Ktf;
    bf16x8 af[4];
#pragma unroll
    for (int kc = 0; kc < 4; ++kc) af[kc] = *(const LAS bf16x8*)(A + (mt * 16 + fr) * 272 + kc * 64 + fq * 16);
    float* RS = (float*)(p.ws + WS_RET) + ((size_t)((b * 4 + h) * 34 + ci) * 2 + dir) * 4096;
#pragma unroll
    for (int nt = 0; nt < 4; ++nt) { f32x4 acc = (f32x4){0.f, 0.f, 0.f, 0.f};
#pragma unroll
        for (int kc = 0; kc < 4; ++kc) { const bf16x8 bf = *(const LAS bf16x8*)(Vt + (nt * 16 + fr) * 272 + kc * 64 + fq * 16);
            acc = __builtin_amdgcn_mfma_f32_16x16x32_bf16(af[kc], bf, acc, 0, 0, 0); }
#pragma unroll
        for (int r = 0; r < 4; ++r) RS[(mt * 16 + fq * 4 + r) * 64 + nt * 16 + fr] = acc[r]; }
    __syncthreads();
}
__device__ __forceinline__ void swa_prep_item(const Params& p, LAS unsigned char* lds, int tile) {
    const int tid = get_tid();
    bf16_t* P = (bf16_t*)(p.ws + WS_P);
    const float* tabc = (const float*)(p.ws + WS_TAB); const float* tabs = tabc + 1024;
    bf16_t* KS = (bf16_t*)(p.ws + WS_KS); bf16_t* VT = (bf16_t*)(p.ws + WS_VTS);
    const int t0 = tile * 64; const SeqInfo s0 = seq_of_row(t0);
    const int key0 = s0.isctx ? s0.pos : CTXL + s0.pos;
    LAS bf16_t* Vs = (LAS bf16_t*)lds;
    u32x4 vreg[2];
#pragma unroll
    for (int it = 0; it < 2; ++it) { const int pc = tid + it * 512, tok = pc >> 4, c8 = pc & 15; vreg[it] = *(const u32x4*)(P + (size_t)(t0 + tok) * NP + PC_SWAV + c8 * 8); }
    u32x4 x1[3], x2[3];
#pragma unroll
    for (int it = 0; it < 3; ++it) { const int e = tid + it * 512; const int tok = e / 24, rem = e % 24, hd = rem >> 2, axis = (rem >> 1) & 1, fg = rem & 1;
        const int colbase = (hd < 4 ? PC_SWAQ + hd * 64 : PC_SWAK + (hd - 4) * 64) + axis * 32 + fg * 8;
        x1[it] = *(const u32x4*)(P + (size_t)(t0 + tok) * NP + colbase); x2[it] = *(const u32x4*)(P + (size_t)(t0 + tok) * NP + colbase + 16); }
#pragma unroll
    for (int it = 0; it < 2; ++it) { const int pc = tid + it * 512, tok = pc >> 4, c8 = pc & 15; *(LAS u32x4*)(Vs + tok * 136 + c8 * 8) = vreg[it]; }
#pragma unroll
    for (int it = 0; it < 3; ++it) { const int e = tid + it * 512; const int tok = e / 24, rem = e % 24, hd = rem >> 2, axis = (rem >> 1) & 1, fg = rem & 1;
        const int row = t0 + tok, pos = s0.pos + tok;
        const int colbase = (hd < 4 ? PC_SWAQ + hd * 64 : PC_SWAK + (hd - 4) * 64) + axis * 32 + fg * 8;
        float a[8], bb[8]; unpack8(x1[it], a); unpack8(x2[it], bb);
        if (!s0.isctx) { const int pp = axis == 0 ? (pos >> 6) : (pos & 63);
            const f32x4 c0 = *(const f32x4*)(tabc + pp * 16 + fg * 8), c1 = *(const f32x4*)(tabc + pp * 16 + fg * 8 + 4), s0v = *(const f32x4*)(tabs + pp * 16 + fg * 8), s1v = *(const f32x4*)(tabs + pp * 16 + fg * 8 + 4);
            const float cs[8] = {c0.x, c0.y, c0.z, c0.w, c1.x, c1.y, c1.z, c1.w}, sn[8] = {s0v.x, s0v.y, s0v.z, s0v.w, s1v.x, s1v.y, s1v.z, s1v.w};
#pragma unroll
            for (int x = 0; x < 8; ++x) { const float y1 = a[x] * cs[x] - bb[x] * sn[x], y2 = bb[x] * cs[x] + a[x] * sn[x]; a[x] = y1; bb[x] = y2; } }
        u32x4 o1, o2; o1.x = pk2(a[0], a[1]); o1.y = pk2(a[2], a[3]); o1.z = pk2(a[4], a[5]); o1.w = pk2(a[6], a[7]);
        o2.x = pk2(bb[0], bb[1]); o2.y = pk2(bb[2], bb[3]); o2.z = pk2(bb[4], bb[5]); o2.w = pk2(bb[6], bb[7]);
        if (hd < 4) { if (!s0.isctx) { *(u32x4*)(P + (size_t)row * NP + colbase) = o1; *(u32x4*)(P + (size_t)row * NP + colbase + 16) = o2; } }
        else { bf16_t* kd = KS + ((size_t)(s0.b * 2 + (hd - 4)) * NKEYS + key0 + tok) * 64 + axis * 32 + fg * 8; *(u32x4*)kd = o1; *(u32x4*)(kd + 16) = o2; }
    }
    __syncthreads();
#pragma unroll
    for (int it = 0; it < 2; ++it) { const int pc = tid + it * 512, hd = pc >> 3, k8 = pc & 7, hk = hd >> 6, d = hd & 63;
        unsigned w[4];
#pragma unroll
        for (int x = 0; x < 4; ++x) w[x] = (unsigned)Vs[(k8 * 8 + 2 * x) * 136 + hd] | ((unsigned)Vs[(k8 * 8 + 2 * x + 1) * 136 + hd] << 16);
        *(u32x4*)(VT + ((size_t)(s0.b * 2 + hk) * 64 + d) * NKEYS + key0 + k8 * 8) = (u32x4){w[0], w[1], w[2], w[3]}; }
    __syncthreads();
}
__device__ __forceinline__ void mla_proj_item(const Params& p, int l, LAS unsigned char* lds, int tile);
__device__ __forceinline__ void phase_prepA(const Params& p, int l, LAS unsigned char* lds, int bid, int nb) {
    for (int it = bid; it < TT / 32; it += nb) rwkv_prep_item(p, l, lds, it);
}
__device__ __forceinline__ void prep_rest_items(const Params& p, int l, LAS unsigned char* lds, int first, int stride) {
    constexpr int N2 = 272 * 4, N3 = TT / 64, N4 = TT / 32;
    for (int it = first; it < N2 + N3 + N4; it += stride) {
        if (it < N4) mla_proj_item(p, l, lds, it);
        else if (it < N4 + N2) ret_kv_item(p, lds, it - N4);
        else swa_prep_item(p, lds, it - N4 - N2);
    }
}

__device__ __forceinline__ void mla_proj_item(const Params& p, int l, LAS unsigned char* lds, int tile) {
    const int tid = get_tid(), lane = tid & 63, wave = tid >> 6, fr = lane & 15, fq = lane >> 4;
    const bf16_t* P = (const bf16_t*)(p.ws + WS_P);
    const float* tabc = (const float*)(p.ws + WS_TAB) + 2048; const float* tabs = tabc + 512;
    const int t0 = tile * 32; const SeqInfo s0 = seq_of_row(t0);
    const int key0 = s0.isctx ? s0.pos : CTXL + s0.pos;
    LAS unsigned char* qn = lds;
    LAS unsigned char* kvn = lds + 32 * 528;
    LAS float* qo = (LAS float*)(lds + 32 * 528 + 32 * 272);
    LAS float* kvo = qo + 32 * 384;
    const float* qg = p.in[24] + l * 256; const float* kvg = p.in[26] + l * 128;
    for (int i = 0; i < 4; ++i) { const int tok = wave * 4 + i, row = t0 + tok;
        float x[4]; float ss = 0.f;
#pragma unroll
        for (int j = 0; j < 4; ++j) { x[j] = bf2f(P[(size_t)row * NP + PC_MLAQD + j * 64 + lane]); ss += x[j] * x[j]; }
        const float rq = 1.f / sqrtf(wave_sum(ss) * (1.f / 256.f) + 1e-6f);
#pragma unroll
        for (int j = 0; j < 4; ++j) *(LAS bf16_t*)(qn + tok * 528 + (j * 64 + lane) * 2) = f2bf(x[j] * rq * qg[j * 64 + lane]);
        float y[2]; float s2 = 0.f;
#pragma unroll
        for (int j = 0; j < 2; ++j) { y[j] = bf2f(P[(size_t)row * NP + PC_MLAKVD + j * 64 + lane]); s2 += y[j] * y[j]; }
        const float rk = 1.f / sqrtf(wave_sum(s2) * (1.f / 128.f) + 1e-6f);
#pragma unroll
        for (int j = 0; j < 2; ++j) *(LAS bf16_t*)(kvn + tok * 272 + (j * 64 + lane) * 2) = f2bf(y[j] * rk * kvg[j * 64 + lane]);
    }
    __syncthreads();
    {
        const bf16_t* WqT = (const bf16_t*)(p.ws + WS_MLAW + (size_t)l * MLAW_LAYER);
        const bf16_t* WkvT = (const bf16_t*)(p.ws + WS_MLAW + (size_t)l * MLAW_LAYER + MLAW_KV);
        {
            bf16x8 bq[3][8];
#pragma unroll
            for (int q = 0; q < 3; ++q) { const bf16_t* wrow = WqT + (size_t)((wave + 8 * q) * 16 + fr) * 256 + fq * 8;
#pragma unroll
                for (int kc = 0; kc < 8; ++kc) bq[q][kc] = *(const bf16x8*)(wrow + kc * 32); }
#pragma unroll
            for (int q = 0; q < 3; ++q) { const int nt = wave + 8 * q;
                f32x4 a0 = (f32x4){0.f, 0.f, 0.f, 0.f}, a1 = a0;
#pragma unroll
                for (int kc = 0; kc < 8; ++kc) { const bf16x8 x0 = *(const LAS bf16x8*)(qn + fr * 528 + kc * 64 + fq * 16), x1 = *(const LAS bf16x8*)(qn + (16 + fr) * 528 + kc * 64 + fq * 16);
                    a0 = __builtin_amdgcn_mfma_f32_16x16x32_bf16(x0, bq[q][kc], a0, 0, 0, 0); a1 = __builtin_amdgcn_mfma_f32_16x16x32_bf16(x1, bq[q][kc], a1, 0, 0, 0); }
#pragma unroll
                for (int r = 0; r < 4; ++r) { qo[(fq * 4 + r) * 384 + nt * 16 + fr] = a0[r]; qo[(16 + fq * 4 + r) * 384 + nt * 16 + fr] = a1[r]; } }
        }
        {
            bf16x8 bk[4][4];
#pragma unroll
            for (int q = 0; q < 4; ++q) { const bf16_t* wrow = WkvT + (size_t)((wave + 8 * q) * 16 + fr) * 128 + fq * 8;
#pragma unroll
                for (int kc = 0; kc < 4; ++kc) bk[q][kc] = *(const bf16x8*)(wrow + kc * 32); }
#pragma unroll
            for (int q = 0; q < 4; ++q) { const int n0 = (wave + 8 * q) * 16;
                f32x4 a0 = (f32x4){0.f, 0.f, 0.f, 0.f}, a1 = a0;
#pragma unroll
                for (int kc = 0; kc < 4; ++kc) { const bf16x8 x0 = *(const LAS bf16x8*)(kvn + fr * 272 + kc * 64 + fq * 16), x1 = *(const LAS bf16x8*)(kvn + (16 + fr) * 272 + kc * 64 + fq * 16);
                    a0 = __builtin_amdgcn_mfma_f32_16x16x32_bf16(x0, bk[q][kc], a0, 0, 0, 0); a1 = __builtin_amdgcn_mfma_f32_16x16x32_bf16(x1, bk[q][kc], a1, 0, 0, 0); }
#pragma unroll
                for (int r = 0; r < 4; ++r) { kvo[(fq * 4 + r) * 512 + n0 + fr] = a0[r]; kvo[(16 + fq * 4 + r) * 512 + n0 + fr] = a1[r]; } }
        }
    }
    __syncthreads();
    {
        const int h = tid >> 7, dd = tid & 127;
        if (dd < 64) { bf16_t* KM = (bf16_t*)(p.ws + WS_KM) + ((size_t)(s0.b * 4 + h) * NKEYS + key0) * 96 + dd;
#pragma unroll
            for (int i = 0; i < 32; ++i) KM[(size_t)i * 96] = f2bf(kvo[i * 512 + tid]); }
        else { bf16_t* VT = (bf16_t*)(p.ws + WS_VTM) + ((size_t)(s0.b * 4 + h) * 64 + (dd - 64)) * NKEYS + key0;
            unsigned w[16];
#pragma unroll
            for (int i = 0; i < 16; ++i) w[i] = pk2(kvo[(2 * i) * 512 + tid], kvo[(2 * i + 1) * 512 + tid]);
#pragma unroll
            for (int i = 0; i < 4; ++i) *(u32x4*)(VT + i * 8) = (u32x4){w[4 * i], w[4 * i + 1], w[4 * i + 2], w[4 * i + 3]}; }
    }
    bf16_t* MQ = (bf16_t*)(p.ws + WS_MQ);
    for (int e = tid; e < 32 * 384; e += 512) { const int tok = e / 384, c = e % 384, dd = c % 96; const int pos = s0.pos + tok;
        float v = qo[e];
        if (dd >= 64 && !s0.isctx) { const int pe = dd - 64, axis = pe >> 4, half = (pe >> 3) & 1, f = pe & 7; const int pp = axis == 0 ? (pos >> 6) : (pos & 63);
            const float cs = tabc[pp * 8 + f], sn = tabs[pp * 8 + f];
            const float x1 = half ? qo[e - 8] : v, x2 = half ? v : qo[e + 8];
            v = half ? (x2 * cs + x1 * sn) : (x1 * cs - x2 * sn); }
        MQ[(size_t)(t0 + tok) * 384 + c] = f2bf(v); }
    for (int e = tid; e < 32 * 32; e += 512) { const int tok = e >> 5, pe = e & 31, axis = pe >> 4, half = (pe >> 3) & 1, f = pe & 7; const int row = t0 + tok, pos = s0.pos + tok;
        float v = bf2f(P[(size_t)row * NP + PC_MLAKPE + pe]);
        if (!s0.isctx) { const int pp = axis == 0 ? (pos >> 6) : (pos & 63); const float cs = tabc[pp * 8 + f], sn = tabs[pp * 8 + f];
            const float other = bf2f(P[(size_t)row * NP + PC_MLAKPE + (half ? pe - 8 : pe + 8)]);
            const float x1 = half ? other : v, x2 = half ? v : other;
            v = half ? (x2 * cs + x1 * sn) : (x1 * cs - x2 * sn); }
        const bf16_t o = f2bf(v);
#pragma unroll
        for (int h = 0; h < 4; ++h) ((bf16_t*)(p.ws + WS_KM))[((size_t)(s0.b * 4 + h) * NKEYS + key0 + tok) * 96 + 64 + pe] = o; }
    __syncthreads();
}
__device__ __forceinline__ void ret_scan_item(const Params& p, int l, int item) {
    const int tid = get_tid(); const int seq = item >> 1, dir = item & 1, h = seq & 3;
    const float lg = log1pf(-exp2f(-5.f - (float)h)); const float cdec = expf(128.f * lg);
    float* base = (float*)(p.ws + WS_RET) + (size_t)seq * 34 * 2 * 4096 + dir * 4096;
    auto ci_of = [&](int st) -> int { return dir == 0 ? st : (st == 0 ? 1 : (st == 1 ? 0 : 35 - st)); };
    float S[8];
#pragma unroll
    for (int i = 0; i < 8; ++i) S[i] = 0.f;
    f32x4 pa[4], pb[4];
#pragma unroll
    for (int k = 0; k < 4; ++k) { const float* q = base + (size_t)ci_of(k) * 2 * 4096 + tid * 8; pa[k] = *(const f32x4*)q; pb[k] = *(const f32x4*)(q + 4); }
#pragma unroll 1
    for (int st0 = 0; st0 < 36; st0 += 4) {
#pragma unroll
        for (int k = 0; k < 4; ++k) { const int st = st0 + k;
            if (st < 34) {
                float* q = base + (size_t)ci_of(st) * 2 * 4096 + tid * 8;
                const f32x4 t0 = pa[k], t1 = pb[k];
                if (st + 4 < 34) { const float* qn = base + (size_t)ci_of(st + 4) * 2 * 4096 + tid * 8; pa[k] = *(const f32x4*)qn; pb[k] = *(const f32x4*)(qn + 4); }
                *(f32x4*)q = (f32x4){S[0], S[1], S[2], S[3]}; *(f32x4*)(q + 4) = (f32x4){S[4], S[5], S[6], S[7]};
                S[0] = S[0] * cdec + t0.x; S[1] = S[1] * cdec + t0.y; S[2] = S[2] * cdec + t0.z; S[3] = S[3] * cdec + t0.w;
                S[4] = S[4] * cdec + t1.x; S[5] = S[5] * cdec + t1.y; S[6] = S[6] * cdec + t1.z; S[7] = S[7] * cdec + t1.w;
            } }
    }
    asm volatile("s_waitcnt vmcnt(0)" ::: "memory");
    __syncthreads();
    if (tid == 0) { __builtin_amdgcn_fence(__ATOMIC_RELEASE, "agent"); asm volatile("s_waitcnt vmcnt(0)" ::: "memory");
        __hip_atomic_fetch_add((unsigned*)(p.ws + WS_CTR) + 2 + l, 1u, __ATOMIC_RELAXED, __HIP_MEMORY_SCOPE_AGENT); }
}
__device__ __forceinline__ void wait_counter(const Params& p, int idx, unsigned need) {
    if (get_tid() == 0) { unsigned* f = (unsigned*)(p.ws + WS_CTR) + idx; unsigned sp = 0;
        while (__hip_atomic_load(f, __ATOMIC_RELAXED, __HIP_MEMORY_SCOPE_AGENT) < need) { __builtin_amdgcn_s_sleep(4); if (++sp > (1u << 22)) break; }
        __builtin_amdgcn_fence(__ATOMIC_ACQUIRE, "agent"); asm volatile("s_waitcnt vmcnt(0)" ::: "memory"); }
    __syncthreads();
}
template <int DK>
__device__ __forceinline__ void attn_unit(const bf16_t* Q, int qstride, const bf16_t* K, const bf16_t* Vt, int nctx, int mt0, int mt1, bool masked, int qpos0,
                                          bool has_sink, float sink, float scale, bf16_t* O, int ostride, LAS unsigned char* lds) {
    constexpr int KC = DK / 32, KP = DK + 8, KROW = KP * 2;
    constexpr int PIECES_K = 64 * DK / 8;
    constexpr int BUFB = 64 * KROW + 64 * 144;
    const int tid = get_tid(), lane = tid & 63, wave = tid >> 6, fr = lane & 15, fq = lane >> 4;
    const float sl2 = scale * 1.44269504f;
    bf16x8 qf[2][KC];
#pragma unroll
    for (int g = 0; g < 2; ++g)
#pragma unroll
        for (int kc = 0; kc < KC; ++kc) { const u32x4 u = *(const u32x4*)(Q + (size_t)(wave * 32 + g * 16 + fr) * qstride + kc * 32 + fq * 8); float f[8]; unpack8(u, f);
            u32x4 o; o.x = cvt_pk_bf16(f[0] * sl2, f[1] * sl2); o.y = cvt_pk_bf16(f[2] * sl2, f[3] * sl2); o.z = cvt_pk_bf16(f[4] * sl2, f[5] * sl2); o.w = cvt_pk_bf16(f[6] * sl2, f[7] * sl2);
            qf[g][kc] = __builtin_bit_cast(bf16x8, o); }
    float mq[2] = {0.f, 0.f}, lsum[2] = {0.f, 0.f}; f32x4 o[2][4];
#pragma unroll
    for (int g = 0; g < 2; ++g)
#pragma unroll
        for (int n = 0; n < 4; ++n) o[g][n] = (f32x4){0.f, 0.f, 0.f, 0.f};
    const int ntiles = nctx + (mt1 - mt0);
    u32x4 kr[2], vr;
    auto issue = [&](int ti) {
        const int tile = ti < nctx ? ti : mt0 + (ti - nctx);
        const bf16_t* kb = K + (size_t)tile * 64 * DK;
#pragma unroll
        for (int i = 0; i < 2; ++i) { const int pc = tid + i * 512; if (pc < PIECES_K) kr[i] = *(const u32x4*)(kb + (size_t)pc * 8); }
        { const int d = tid >> 3, c8 = tid & 7; vr = *(const u32x4*)(Vt + (size_t)d * NKEYS + tile * 64 + c8 * 8); }
    };
    auto stash = [&](int bufi) {
        LAS unsigned char* Kt = lds + bufi * BUFB; LAS unsigned char* Vl = Kt + 64 * KROW;
#pragma unroll
        for (int i = 0; i < 2; ++i) { const int pc = tid + i * 512; if (pc < PIECES_K) { const int row = pc / (DK / 8), c8 = pc % (DK / 8); *(LAS u32x4*)(Kt + row * KROW + c8 * 16) = kr[i]; } }
        { const int d = tid >> 3, c8 = tid & 7; *(LAS u32x4*)(Vl + d * 144 + c8 * 16) = vr; }
    };
    issue(0); stash(0);
    if (ntiles > 1) issue(1);
    __syncthreads();
    for (int ti = 0; ti < ntiles; ++ti) {
        const int tile = ti < nctx ? ti : mt0 + (ti - nctx);
        LAS unsigned char* Kt = lds + (ti & 1) * BUFB; LAS unsigned char* Vl = Kt + 64 * KROW;
        if (ti + 1 < ntiles) { stash((ti + 1) & 1); if (ti + 2 < ntiles) issue(ti + 2); }
        f32x4 s[2][4];
#pragma unroll
        for (int n = 0; n < 4; ++n) {
            s[0][n] = (f32x4){-mq[0], -mq[0], -mq[0], -mq[0]}; s[1][n] = (f32x4){-mq[1], -mq[1], -mq[1], -mq[1]};
#pragma unroll
            for (int kc = 0; kc < KC; ++kc) { const bf16x8 kf = *(const LAS bf16x8*)(Kt + (n * 16 + fr) * KROW + kc * 64 + fq * 16);
                s[0][n] = __builtin_amdgcn_mfma_f32_16x16x32_bf16(kf, qf[0][kc], s[0][n], 0, 0, 0);
                s[1][n] = __builtin_amdgcn_mfma_f32_16x16x32_bf16(kf, qf[1][kc], s[1][n], 0, 0, 0); } }
        if (ti == 0) {
#pragma unroll
            for (int g = 0; g < 2; ++g) {
                float t = -INFINITY;
#pragma unroll
                for (int n = 0; n < 4; ++n)
#pragma unroll
                    for (int r = 0; r < 4; ++r) t = fmaxf(t, s[g][n][r]);
                t = fmaxf(t, __shfl_xor(t, 16)); t = fmaxf(t, __shfl_xor(t, 32));
                if (has_sink) t = fmaxf(t, sink * 1.44269504f);
                mq[g] = t;
#pragma unroll
                for (int n = 0; n < 4; ++n)
#pragma unroll
                    for (int r = 0; r < 4; ++r) s[g][n][r] -= t;
            }
        }
        if (masked && ti >= nctx) {
#pragma unroll
            for (int g = 0; g < 2; ++g)
#pragma unroll
                for (int n = 0; n < 4; ++n)
#pragma unroll
                    for (int r = 0; r < 4; ++r) { const int kp = tile * 64 + n * 16 + fq * 4 + r - CTXL, qp = qpos0 + wave * 32 + g * 16 + fr; const int df = qp - kp; if (df > 128 || df < -128) s[g][n][r] = -INFINITY; }
        }
#pragma unroll
        for (int g = 0; g < 2; ++g)
#pragma unroll
            for (int n = 0; n < 4; ++n)
#pragma unroll
                for (int r = 0; r < 4; ++r) { s[g][n][r] = __builtin_amdgcn_exp2f(s[g][n][r]); lsum[g] += s[g][n][r]; }
#pragma unroll
        for (int c = 0; c < 2; ++c) {
            bf16x8 pf[2];
#pragma unroll
            for (int g = 0; g < 2; ++g) { u32x4 pu; pu.x = cvt_pk_bf16(s[g][2 * c][0], s[g][2 * c][1]); pu.y = cvt_pk_bf16(s[g][2 * c][2], s[g][2 * c][3]);
                pu.z = cvt_pk_bf16(s[g][2 * c + 1][0], s[g][2 * c + 1][1]); pu.w = cvt_pk_bf16(s[g][2 * c + 1][2], s[g][2 * c + 1][3]); pf[g] = __builtin_bit_cast(bf16x8, pu); }
#pragma unroll
            for (int n = 0; n < 4; ++n) {
                const u32x2 lo = *(const LAS u32x2*)(Vl + (n * 16 + fr) * 144 + ((2 * c) * 16 + fq * 4) * 2), hi = *(const LAS u32x2*)(Vl + (n * 16 + fr) * 144 + ((2 * c + 1) * 16 + fq * 4) * 2);
                const bf16x8 vf = __builtin_bit_cast(bf16x8, (u32x4){lo.x, lo.y, hi.x, hi.y});
                o[0][n] = __builtin_amdgcn_mfma_f32_16x16x32_bf16(vf, pf[0], o[0][n], 0, 0, 0);
                o[1][n] = __builtin_amdgcn_mfma_f32_16x16x32_bf16(vf, pf[1], o[1][n], 0, 0, 0); }
        }
        __syncthreads();
    }
#pragma unroll
    for (int g = 0; g < 2; ++g) {
        float t = lsum[g];
        t += __shfl_xor(t, 16); t += __shfl_xor(t, 32);
        if (has_sink) t += __builtin_amdgcn_exp2f(sink * 1.44269504f - mq[g]);
        const float inv = 1.f / t;
#pragma unroll
        for (int n = 0; n < 4; ++n) { u32x2 ov; ov.x = cvt_pk_bf16(o[g][n][0] * inv, o[g][n][1] * inv); ov.y = cvt_pk_bf16(o[g][n][2] * inv, o[g][n][3] * inv);
            *(u32x2*)(O + (size_t)(wave * 32 + g * 16 + fr) * ostride + n * 16 + fq * 4) = ov; }
    }
}

__device__ __forceinline__ void ret_out_item(const Params& p, int l, LAS unsigned char* lds, int item) {
    const int tid = get_tid(), lane = tid & 63, wave = tid >> 6, fr = lane & 15, fq = lane >> 4;
    bf16_t* P = (bf16_t*)(p.ws + WS_P);
    const int cr = item >> 2, h = item & 3; int b; const int ci = ret_chunk_index(cr, b);
    const int r0 = cr * 128;
    const float lg2 = log1pf(-exp2f(-5.f - (float)h)) * 1.44269504f;
    LAS unsigned char* Kb = lds;
    LAS unsigned char* Vt = lds + 18432;
    LAS unsigned char* SfT = lds + 35840;
    LAS unsigned char* SbT = lds + 45056;
    for (int pc = tid; pc < 1024; pc += 512) { const int j = pc >> 3, c8 = pc & 7;
        const u32x4 kk = *(const u32x4*)(P + (size_t)(r0 + j) * NP + PC_RETK + h * 64 + c8 * 8);
        const u32x4 vv = *(const u32x4*)(P + (size_t)(r0 + j) * NP + PC_RETV + h * 64 + c8 * 8);
        float kf[8]; unpack8(kk, kf);
        u32x4 ko; ko.x = pk2(kf[0] * 0.125f, kf[1] * 0.125f); ko.y = pk2(kf[2] * 0.125f, kf[3] * 0.125f); ko.z = pk2(kf[4] * 0.125f, kf[5] * 0.125f); ko.w = pk2(kf[6] * 0.125f, kf[7] * 0.125f);
        *(LAS u32x4*)(Kb + j * 144 + c8 * 16) = ko;
        const unsigned vw[4] = {vv.x, vv.y, vv.z, vv.w};
#pragma unroll
        for (int x = 0; x < 8; ++x) *(LAS bf16_t*)(Vt + (c8 * 8 + x) * 272 + j * 2) = (bf16_t)((x & 1) ? (vw[x >> 1] >> 16) : (vw[x >> 1] & 0xffff)); }
    { const float* RS = (const float*)(p.ws + WS_RET) + ((size_t)((b * 4 + h) * 34 + ci) * 2) * 4096;
      for (int pc = tid; pc < 1024; pc += 512) { const int d = pc >> 4, e4 = (pc & 15) * 4;
          const f32x4 a = *(const f32x4*)(RS + d * 64 + e4), bb = *(const f32x4*)(RS + 4096 + d * 64 + e4);
#pragma unroll
          for (int x = 0; x < 4; ++x) { *(LAS bf16_t*)(SfT + (e4 + x) * 144 + d * 2) = f2bf(a[x]); *(LAS bf16_t*)(SbT + (e4 + x) * 144 + d * 2) = f2bf(bb[x]); } } }
    const int i = wave * 16 + fr;
    u32x4 qraw[2];
#pragma unroll
    for (int kc = 0; kc < 2; ++kc) qraw[kc] = *(const u32x4*)(P + (size_t)(r0 + i) * NP + PC_RETQ + h * 64 + kc * 32 + fq * 8);
    __syncthreads();
    f32x4 s[8];
#pragma unroll
    for (int nb = 0; nb < 8; ++nb) { s[nb] = (f32x4){0.f, 0.f, 0.f, 0.f};
#pragma unroll
        for (int kc = 0; kc < 2; ++kc) { const bf16x8 kf = *(const LAS bf16x8*)(Kb + (nb * 16 + fr) * 144 + kc * 64 + fq * 16);
            s[nb] = __builtin_amdgcn_mfma_f32_16x16x32_bf16(kf, __builtin_bit_cast(bf16x8, qraw[kc]), s[nb], 0, 0, 0); } }
#pragma unroll
    for (int nb = 0; nb < 8; ++nb)
#pragma unroll
        for (int r = 0; r < 4; ++r) { const int j = nb * 16 + fq * 4 + r; const int df = i - j; const int adf = df < 0 ? -df : df;
            float dcy = __builtin_amdgcn_exp2f((float)adf * lg2); if (df == 0) dcy = 2.f; s[nb][r] *= dcy; }
    f32x4 o[4];
#pragma unroll
    for (int n = 0; n < 4; ++n) o[n] = (f32x4){0.f, 0.f, 0.f, 0.f};
#pragma unroll
    for (int c = 0; c < 4; ++c) {
        u32x4 pu; pu.x = cvt_pk_bf16(s[2 * c][0], s[2 * c][1]); pu.y = cvt_pk_bf16(s[2 * c][2], s[2 * c][3]); pu.z = cvt_pk_bf16(s[2 * c + 1][0], s[2 * c + 1][1]); pu.w = cvt_pk_bf16(s[2 * c + 1][2], s[2 * c + 1][3]);
        const bf16x8 pf = __builtin_bit_cast(bf16x8, pu);
#pragma unroll
        for (int n = 0; n < 4; ++n) {
            const u32x2 lo = *(const LAS u32x2*)(Vt + (n * 16 + fr) * 272 + ((2 * c) * 16 + fq * 4) * 2), hi = *(const LAS u32x2*)(Vt + (n * 16 + fr) * 272 + ((2 * c + 1) * 16 + fq * 4) * 2);
            const bf16x8 vf = __builtin_bit_cast(bf16x8, (u32x4){lo.x, lo.y, hi.x, hi.y});
            o[n] = __builtin_amdgcn_mfma_f32_16x16x32_bf16(vf, pf, o[n], 0, 0, 0); }
    }
    const float gf = __builtin_amdgcn_exp2f((float)(i + 1) * lg2), gb = __builtin_amdgcn_exp2f((float)(128 - i) * lg2);
#pragma unroll
    for (int kc = 0; kc < 2; ++kc) {
        float f[8]; unpack8(qraw[kc], f);
        u32x4 uf, ub;
        uf.x = cvt_pk_bf16(f[0] * gf, f[1] * gf); uf.y = cvt_pk_bf16(f[2] * gf, f[3] * gf); uf.z = cvt_pk_bf16(f[4] * gf, f[5] * gf); uf.w = cvt_pk_bf16(f[6] * gf, f[7] * gf);
        ub.x = cvt_pk_bf16(f[0] * gb, f[1] * gb); ub.y = cvt_pk_bf16(f[2] * gb, f[3] * gb); ub.z = cvt_pk_bf16(f[4] * gb, f[5] * gb); ub.w = cvt_pk_bf16(f[6] * gb, f[7] * gb);
        const bf16x8 qF = __builtin_bit_cast(bf16x8, uf), qB = __builtin_bit_cast(bf16x8, ub);
#pragma unroll
        for (int n = 0; n < 4; ++n) {
            const bf16x8 af = *(const LAS bf16x8*)(SfT + (n * 16 + fr) * 144 + kc * 64 + fq * 16), ab = *(const LAS bf16x8*)(SbT + (n * 16 + fr) * 144 + kc * 64 + fq * 16);
            o[n] = __builtin_amdgcn_mfma_f32_16x16x32_bf16(af, qF, o[n], 0, 0, 0);
            o[n] = __builtin_amdgcn_mfma_f32_16x16x32_bf16(ab, qB, o[n], 0, 0, 0); }
    }
    float sm = 0.f;
#pragma unroll
    for (int n = 0; n < 4; ++n) sm += (o[n][0] + o[n][1]) + (o[n][2] + o[n][3]);
    sm += __shfl_xor(sm, 16); sm += __shfl_xor(sm, 32);
    const float mu = sm * (1.f / 64.f);
    float vs = 0.f;
#pragma unroll
    for (int n = 0; n < 4; ++n)
#pragma unroll
        for (int r = 0; r < 4; ++r) { const float dl = o[n][r] - mu; vs += dl * dl; }
    vs += __shfl_xor(vs, 16); vs += __shfl_xor(vs, 32);
    const float rstd = 1.f / sqrtf(vs * (1.f / 64.f) + 1e-5f);
#pragma unroll
    for (int n = 0; n < 4; ++n) { const int e0 = n * 16 + fq * 4;
        const u32x2 gu = *(const u32x2*)(P + (size_t)(r0 + i) * NP + PC_RETG + h * 64 + e0);
        const f32x4 gn = *(const f32x4*)(p.in[13] + l * 256 + h * 64 + e0);
        const float g0 = bf2f((bf16_t)(gu.x & 0xffff)), g1 = bf2f((bf16_t)(gu.x >> 16)), g2 = bf2f((bf16_t)(gu.y & 0xffff)), g3 = bf2f((bf16_t)(gu.y >> 16));
        u32x2 yo;
        yo.x = cvt_pk_bf16((o[n][0] - mu) * rstd * gn.x * (g0 / (1.f + __expf(-g0))), (o[n][1] - mu) * rstd * gn.y * (g1 / (1.f + __expf(-g1))));
        yo.y = cvt_pk_bf16((o[n][2] - mu) * rstd * gn.z * (g2 / (1.f + __expf(-g2))), (o[n][3] - mu) * rstd * gn.w * (g3 / (1.f + __expf(-g3))));
        *(u32x2*)(P + (size_t)(r0 + i) * NP + PC_RETQ + h * 64 + e0) = yo; }
    __syncthreads();
}

constexpr int NSCANBLK = 128;
__device__ __forceinline__ void rwkv_scan_item(const Params& p, int l, LAS unsigned char* lds, int item) {
    const int tid = get_tid();
    const int sc = item >> 1, half = item & 1;
    const int b = sc >> 3, h = (sc >> 1) & 3, dir = sc & 1;
    const bf16_t* RK = (const bf16_t*)(p.ws + WS_RWK); const bf16_t* RV = (const bf16_t*)(p.ws + WS_RWV); const bf16_t* RR = (const bf16_t*)(p.ws + WS_RWRR);
    const bf16_t* RA = (const bf16_t*)(p.ws + (dir ? WS_RWA1 : WS_RWA0)); const bf16_t* RM = (const bf16_t*)(p.ws + (dir ? WS_RWM1 : WS_RWM0));
    bf16_t* P = (bf16_t*)(p.ws + WS_P);
    const int ocol = (dir ? PC_RWO1 : PC_RWO0) + h * 64 + half * 32;
    LAS float* KH = (LAS float*)lds;
    LAS float* WW = KH + 4096; LAS float* BB = WW + 4096; LAS float* KT = BB + 4096; LAS float* RRl = KT + 4096; LAS float* VV = RRl + 4096; LAS float* OUT = VV + 4096;
    const int st = tid >> 3, c0 = (tid & 7) * 8;
    float kkp[8], kap[8];
#pragma unroll
    for (int i = 0; i < 8; ++i) { kkp[i] = p.in[20][l * 256 + h * 64 + c0 + i]; kap[i] = p.in[21][l * 256 + h * 64 + c0 + i]; }
    const int row_l = tid >> 4, kq = tid & 15;
    f32x2 S[2];
#pragma unroll
    for (int i = 0; i < 2; ++i) S[i] = (f32x2){0.f, 0.f};
    auto row_of = [&](int s) -> int {
        if (s < CTXL) return TMAIN + b * CTXL + (dir ? CTXL - 1 - s : s);
        const int t = s - CTXL; return b * SEQL + (dir ? SEQL - 1 - t : t);
    };
    u32x4 gk, gv, gr, ga, gm;
    auto issue = [&](int ch) { const size_t o = (size_t)row_of(ch * 64 + st) * 256 + h * 64 + c0;
        gk = *(const u32x4*)(RK + o); gv = *(const u32x4*)(RV + o); gr = *(const u32x4*)(RR + o); ga = *(const u32x4*)(RA + o); gm = *(const u32x4*)(RM + o); };
    issue(0);
    for (int ch = 0; ch < 68; ++ch) {
        {
            float k[8], a[8], om[8], rr[8], vv8[8]; unpack8(gk, k); unpack8(ga, a); unpack8(gm, om); unpack8(gr, rr); unpack8(gv, vv8);
            float kk[8]; float n2 = 0.f;
#pragma unroll
            for (int i = 0; i < 8; ++i) { kk[i] = k[i] * kkp[i]; n2 += kk[i] * kk[i]; }
            n2 = red8(n2);
            const float rn = 1.f / sqrtf(fmaxf(n2, 1e-12f));
            f32x4 o0, o1;
#define ST8(DST, EXPR) { float t8[8]; _Pragma("unroll") for (int i = 0; i < 8; ++i) t8[i] = (EXPR); \
            *(LAS f32x4*)(DST + st * 64 + c0) = (f32x4){t8[0], t8[1], t8[2], t8[3]}; *(LAS f32x4*)(DST + st * 64 + c0 + 4) = (f32x4){t8[4], t8[5], t8[6], t8[7]}; }
            ST8(KH, kk[i] * rn)
            ST8(WW, 1.f - om[i])
            ST8(BB, kk[i] * rn * a[i])
            ST8(KT, k[i] * (1.f + (a[i] - 1.f) * kap[i]))
            ST8(RRl, rr[i])
            ST8(VV, vv8[i])
#undef ST8
        }
        __syncthreads();
        if (ch + 1 < 68) issue(ch + 1);
        {
            struct Ops { f32x4 kh, w, b, t, r; float vv; };
            auto ldops = [&](int s) -> Ops { Ops q;
                q.kh = *(const LAS f32x4*)(KH + s * 64 + kq * 4); q.w = *(const LAS f32x4*)(WW + s * 64 + kq * 4); q.b = *(const LAS f32x4*)(BB + s * 64 + kq * 4);
                q.t = *(const LAS f32x4*)(KT + s * 64 + kq * 4); q.r = *(const LAS f32x4*)(RRl + s * 64 + kq * 4);
                q.vv = VV[s * 64 + half * 32 + row_l]; return q; };
            Ops nx = ldops(0);
#pragma unroll 2
            for (int s = 0; s < 64; ++s) {
                const Ops c = nx;
                nx = ldops(s + 1 < 64 ? s + 1 : 63);
                f32x2 a2 = S[0] * (f32x2){c.kh.x, c.kh.y}; a2 = S[1] * (f32x2){c.kh.z, c.kh.w} + a2;
                const float sk = red16(a2.x + a2.y);
                const f32x2 nsk = (f32x2){-sk, -sk}, vv2 = (f32x2){c.vv, c.vv};
                S[0] = S[0] * (f32x2){c.w.x, c.w.y} + (nsk * (f32x2){c.b.x, c.b.y} + vv2 * (f32x2){c.t.x, c.t.y});
                S[1] = S[1] * (f32x2){c.w.z, c.w.w} + (nsk * (f32x2){c.b.z, c.b.w} + vv2 * (f32x2){c.t.z, c.t.w});
                f32x2 o2 = S[0] * (f32x2){c.r.x, c.r.y}; o2 = S[1] * (f32x2){c.r.z, c.r.w} + o2;
                const float ov = red16(o2.x + o2.y);
                if (kq == 0) OUT[s * 32 + row_l] = ov;
            }
        }
        __syncthreads();
        { const int c4 = (tid & 7) * 4; const f32x4 ov = *(const LAS f32x4*)(OUT + st * 32 + c4);
          u32x2 o2; o2.x = pk2(ov.x, ov.y); o2.y = pk2(ov.z, ov.w);
          *(u32x2*)(P + (size_t)row_of(ch * 64 + st) * NP + ocol + c4) = o2; }
    }
    __syncthreads();
}

__device__ __forceinline__ void mixer_mla(const Params& p, LAS unsigned char* lds, int it) {
    bf16_t* P = (bf16_t*)(p.ws + WS_P);
    const bf16_t* MQ = (const bf16_t*)(p.ws + WS_MQ);
    int b, h, row0, nm1;
    if (it < 512) { b = it >> 6; h = (it >> 4) & 3; row0 = b * SEQL + (it & 15) * 256; nm1 = 68; }
    else { const int u = it - 512; b = u >> 2; h = u & 3; row0 = TMAIN + b * CTXL; nm1 = 4; }
    attn_unit<96>(MQ + (size_t)row0 * 384 + h * 96, 384, (const bf16_t*)(p.ws + WS_KM) + (size_t)(b * 4 + h) * NKEYS * 96, (const bf16_t*)(p.ws + WS_VTM) + (size_t)(b * 4 + h) * 64 * NKEYS,
                  4, 4, nm1, false, 0, false, 0.f, 0.10206207f, P + (size_t)row0 * NP + PC_MLAQD + h * 64, NP, lds);
}
__device__ __forceinline__ void mixer_swa(const Params& p, int l, LAS unsigned char* lds, int u0) {
    bf16_t* P = (bf16_t*)(p.ws + WS_P);
    int b, h, row0, nm0, nm1, qp0; bool msk;
    if (u0 < 512) { b = u0 >> 6; h = (u0 >> 4) & 3; const int qb = u0 & 15; row0 = b * SEQL + qb * 256; nm0 = 4 + 4 * qb - 2; nm1 = 4 + 4 * qb + 6; if (nm0 < 4) nm0 = 4; if (nm1 > 68) nm1 = 68; qp0 = qb * 256; msk = true; }
    else { const int u = u0 - 512; b = u >> 2; h = u & 3; row0 = TMAIN + b * CTXL; nm0 = 4; nm1 = 4; qp0 = 0; msk = false; }
    const int hk = h >> 1;
    bf16_t* qp = P + (size_t)row0 * NP + PC_SWAQ + h * 64;
    attn_unit<64>(qp, NP, (const bf16_t*)(p.ws + WS_KS) + (size_t)(b * 2 + hk) * NKEYS * 64, (const bf16_t*)(p.ws + WS_VTS) + (size_t)(b * 2 + hk) * 64 * NKEYS,
                  4, nm0, nm1, msk, qp0, true, p.in[12][l * 4 + h], 0.125f, qp, NP, lds);
}
__device__ __forceinline__ void phase_mixers(const Params& p, int l, LAS unsigned char* lds, int bid, int nb) {
    const bool ectx = (l == 0);
    const int N_MLA = 512 + (ectx ? 32 : 0), N_SWA = 512 + (ectx ? 32 : 0), N_RET = 1024 + (ectx ? 64 : 0);
    if (bid < NSCANBLK) rwkv_scan_item(p, l, lds, bid);
    else {
        prep_rest_items(p, l, lds, bid - NSCANBLK, nb - NSCANBLK);
        asm volatile("s_waitcnt vmcnt(0)" ::: "memory");
        __syncthreads();
        if (get_tid() == 0) { __builtin_amdgcn_fence(__ATOMIC_RELEASE, "agent"); asm volatile("s_waitcnt vmcnt(0)" ::: "memory");
            __hip_atomic_fetch_add((unsigned*)(p.ws + WS_CTR) + 4 + l, 1u, __ATOMIC_RELAXED, __HIP_MEMORY_SCOPE_AGENT); }
        if (bid < NSCANBLK + 64) { wait_counter(p, 4 + l, (unsigned)(nb - NSCANBLK)); ret_scan_item(p, l, bid - NSCANBLK); }
    }
    wait_counter(p, 4 + l, (unsigned)(nb - NSCANBLK));
    bool ret_ready = false;
    unsigned* ctr = (unsigned*)(p.ws + WS_CTR) + l;
    LAS unsigned* slot = (LAS unsigned*)(lds + LDS_BYTES - 16);
    const int tid0 = get_tid();
    for (;;) {
        __syncthreads();
        if (tid0 == 0) *slot = atomicAdd(ctr, 1u);
        __syncthreads();
        const int it = (int)*slot;
        if (it >= N_MLA + N_SWA + N_RET) break;
        if (it < N_MLA) mixer_mla(p, lds, it);
        else if (it < N_MLA + N_SWA) mixer_swa(p, l, lds, it - N_MLA);
        else { if (!ret_ready) { wait_counter(p, 2 + l, 64u); ret_ready = true; } ret_out_item(p, l, lds, it - N_MLA - N_SWA); }
    }
}

__device__ __forceinline__ void phase_rwkv_finish(const Params& p, int l, LAS unsigned char* lds, int bid, int nb) {
    const int tid = get_tid();
    bf16_t* P = (bf16_t*)(p.ws + WS_P);
    const int ntiles = (l == 0 ? TT : TMAIN) / 32;
    const float* mu = p.in[14] + l * 1024 + 896;
    const float* gup = p.in[19] + (size_t)l * 128 * 256;
    const bf16_t* RV = (const bf16_t*)(p.ws + WS_RWV); const float* BON = (const float*)(p.ws + WS_BON);
    for (int tile = bid; tile < ntiles; tile += nb) {
        const int t0 = tile * 32; const SeqInfo s0 = seq_of_row(t0);
        LAS unsigned char* sgb = lds;
        LAS float* gout = (LAS float*)(lds + 32 * 272);
        { const int tok = tid >> 4, j8 = (tid & 15) * 8; const int row = t0 + tok, pos = s0.pos + tok;
          const u32x4 u0 = *(const u32x4*)(P + (size_t)row * NP + PC_RWGD + j8);
          const u32x4 um = pos > 0 ? *(const u32x4*)(P + (size_t)(row - 1) * NP + PC_RWGD + j8) : (u32x4){0u, 0u, 0u, 0u};
          const u32x4 up = pos < s0.len - 1 ? *(const u32x4*)(P + (size_t)(row + 1) * NP + PC_RWGD + j8) : (u32x4){0u, 0u, 0u, 0u};
          float z0[8], zm[8], zp[8], sv[8]; unpack8(u0, z0); unpack8(um, zm); unpack8(up, zp);
#pragma unroll
          for (int x = 0; x < 8; ++x) sv[x] = sigmoidf_(z0[x] + mu[j8 + x] * (0.5f * (zm[x] + zp[x]) - z0[x]));
          *(LAS u32x4*)(sgb + tok * 272 + j8 * 2) = (u32x4){cvt_pk_bf16(sv[0], sv[1]), cvt_pk_bf16(sv[2], sv[3]), cvt_pk_bf16(sv[4], sv[5]), cvt_pk_bf16(sv[6], sv[7])}; }
        __syncthreads();
        { const int lane = tid & 63, wave = tid >> 6, fr = lane & 15, fq = lane >> 4;
          const bf16_t* GT = (const bf16_t*)(p.ws + WS_GUPT + (size_t)l * 256 * 128 * 2);
#pragma unroll
          for (int q = 0; q < 2; ++q) { const int nt = wave + q * 8;
              f32x4 a0 = (f32x4){0.f, 0.f, 0.f, 0.f}, a1 = a0;
              const bf16_t* wrow = GT + (size_t)(nt * 16 + fr) * 128 + fq * 8;
              bf16x8 bfr[4];
#pragma unroll
              for (int kc = 0; kc < 4; ++kc) bfr[kc] = *(const bf16x8*)(wrow + kc * 32);
#pragma unroll
              for (int kc = 0; kc < 4; ++kc) { const bf16x8 x0 = *(const LAS bf16x8*)(sgb + fr * 272 + kc * 64 + fq * 16), x1 = *(const LAS bf16x8*)(sgb + (16 + fr) * 272 + kc * 64 + fq * 16);
                  a0 = __builtin_amdgcn_mfma_f32_16x16x32_bf16(x0, bfr[kc], a0, 0, 0, 0); a1 = __builtin_amdgcn_mfma_f32_16x16x32_bf16(x1, bfr[kc], a1, 0, 0, 0); }
#pragma unroll
              for (int r = 0; r < 4; ++r) { gout[(fq * 4 + r) * 256 + nt * 16 + fr] = a0[r]; gout[(16 + fq * 4 + r) * 256 + nt * 16 + fr] = a1[r]; } } }
        __syncthreads();
        const int hh = tid >> 8, c = tid & 255, h = c >> 6;
        float g[16];
#pragma unroll
        for (int i = 0; i < 16; ++i) g[i] = gout[(hh * 16 + i) * 256 + c];
        const float gn = p.in[23][l * 256 + c];
        float ov[16], rv[16], bn[16];
#pragma unroll
        for (int i = 0; i < 16; ++i) { const int row = t0 + hh * 16 + i;
            ov[i] = bf2f(P[(size_t)row * NP + PC_RWO0 + c]) + bf2f(P[(size_t)row * NP + PC_RWO1 + c]); rv[i] = bf2f(RV[(size_t)row * 256 + c]); bn[i] = BON[(size_t)row * 4 + h]; }
#pragma unroll
        for (int i = 0; i < 16; ++i) { const int row = t0 + hh * 16 + i;
            const float o = ov[i];
            const float mean = wave_sum(o) * (1.f / 64.f); const float dl = o - mean; const float var = wave_sum(dl * dl) * (1.f / 64.f);
            float y = dl * (1.f / sqrtf(var + 64e-5f)) * gn + bn[i] * rv[i];
            P[(size_t)row * NP + PC_RWO1 + c] = f2bf(y * g[i]); }
        __syncthreads();
    }
}

#ifndef N_LAUNCH_MODE
#define N_LAUNCH_MODE 1
#endif
template <int Q>
__device__ __forceinline__ void layer_phase(const Params& p, int l, LAS unsigned char* lds, int bid, int nb) {
    unsigned char* wb = p.ws + WS_WB + (size_t)l * WB_LAYER;
    const int Mrows = (l == 0) ? TT : TMAIN;
    pg8::StaticOrder S;
    if constexpr (Q == 0) { pg8::Gemm g{(const bf16_t*)(p.ws + WS_HB), (const bf16_t*)(wb + WB_IN), TT, NP, DM, DM}; S.init(TT, NP, nb, bid);
              pg8::EpiBf16<0> E{(bf16_t*)(p.ws + WS_P), NP}; pg8::gemm_phase(lds, g, S, E); }
    if constexpr (Q == 1) phase_prepA(p, l, lds, bid, nb);
    if constexpr (Q == 3) phase_mixers(p, l, lds, bid, nb);
    if constexpr (Q == 4) phase_rwkv_finish(p, l, lds, bid, nb);
    if constexpr (Q == 5) { pg8::Gemm g{(const bf16_t*)(p.ws + WS_P), (const bf16_t*)(wb + WB_OUT), Mrows, DM, DM, NP}; S.init(Mrows, DM, nb, bid);
              pg8::EpiBf16<0> E{(bf16_t*)(p.ws + WS_Z), DM}; pg8::gemm_phase(lds, g, S, E); }
    if constexpr (Q == 6) phase_rowops(p, 1, l, Mrows, bid, nb);
    if constexpr (Q == 7) { pg8::Gemm g{(const bf16_t*)(p.ws + WS_HB), (const bf16_t*)(wb + WB_W1), Mrows, FF, DM, DM}; S.init(Mrows, FF, nb, bid);
              pg8::EpiBf16<1> E{(bf16_t*)(p.ws + WS_HID), FF}; pg8::gemm_phase(lds, g, S, E); }
    if constexpr (Q == 8) { pg8::Gemm g{(const bf16_t*)(p.ws + WS_HID), (const bf16_t*)(wb + WB_W2), Mrows, DM, FF, FF}; S.init(Mrows, DM, nb, bid);
              pg8::EpiBf16<0> E{(bf16_t*)(p.ws + WS_Z), DM}; pg8::gemm_phase(lds, g, S, E); }
    if constexpr (Q == 9) phase_rowops(p, 2, l, Mrows, bid, nb);
}

#ifndef PROBE_MASK
#define PROBE_MASK 0
#endif
#define PB(BIT, CALL) do { if ((PROBE_MASK) & (BIT)) { const unsigned long long t0_ = __builtin_amdgcn_s_memrealtime(); CALL; const unsigned long long t1_ = __builtin_amdgcn_s_memrealtime(); \
        while (__builtin_amdgcn_s_memrealtime() - t1_ < (t1_ - t0_)) __builtin_amdgcn_s_sleep(8); } else { CALL; } } while (0)
#define XB_TMO      128
#define XB_XCNT(j)  (256  + 64 * (j))
#define XB_XSUB(j)  (1280 + 64 * (j))
#define XB_XGEN(j)  (2304 + 64 * (j))
#define XB_TOP      3328
#define XB_TOPGEN   3392
#define XCD_BAR_WORDS 3456
#define XB_SPIN_CAP (1u << 18)

__device__ __forceinline__ unsigned xb_ld(unsigned* p)              { return __hip_atomic_load(p, __ATOMIC_RELAXED, __HIP_MEMORY_SCOPE_AGENT); }
__device__ __forceinline__ unsigned xb_add(unsigned* p, unsigned v) { return __hip_atomic_fetch_add(p, v, __ATOMIC_RELAXED, __HIP_MEMORY_SCOPE_AGENT); }
__device__ __forceinline__ unsigned xb_xcc_id() { return (unsigned)__builtin_amdgcn_s_getreg((3 << 11) | 20) & 0xFu; }
#define XB_SPIN(cond, bar) do { unsigned _sp = 0; while (cond) { __builtin_amdgcn_s_sleep(1); \
    if ((++_sp & 255u) == 0u) { if (xb_ld(&(bar)[XB_TMO])) break; if (_sp > XB_SPIN_CAP) { atomicAdd(&(bar)[XB_TMO], 1u); break; } } } } while (0)

struct XcdBarrier {
    unsigned* bar; unsigned x;
    volatile LAS unsigned* st;
};

__device__ __forceinline__ XcdBarrier xcd_barrier_post(unsigned* bar, volatile LAS unsigned* st) {
    XcdBarrier b; b.bar = bar; b.x = xb_xcc_id(); b.st = st;
    if (threadIdx.x == 0) (void)xb_add(&bar[XB_XCNT(b.x)], 1u);
    return b;
}
__device__ __forceinline__ void xcd_barrier_complete(unsigned* bar, unsigned x, unsigned& nloc, unsigned& nx) {
    const unsigned G = gridDim.x * gridDim.y * gridDim.z;
    unsigned sum, cnt, mine, sp = 0u;
    for (;;) {
        sum = 0u; cnt = 0u; mine = 0u;
#pragma unroll
        for (unsigned j = 0; j < 16; ++j) { const unsigned c = xb_ld(&bar[XB_XCNT(j)]); sum += c; cnt += (c > 0u) ? 1u : 0u; mine = (j == x) ? c : mine; }
        if (sum == G) break;
        __builtin_amdgcn_s_sleep(1);
        if ((++sp & 255u) == 0u) { if (xb_ld(&bar[XB_TMO])) break; if (sp > XB_SPIN_CAP) { atomicAdd(&bar[XB_TMO], 1u); break; } }
    }
    nloc = mine > 0u ? mine : 1u; nx = cnt > 0u ? cnt : 1u;
}

__device__ __forceinline__ void xcd_barrier(const XcdBarrier& b) {
    asm volatile("s_waitcnt vmcnt(0)" ::: "memory");
    __syncthreads();
    if (threadIdx.x == 0) {
        unsigned* bar = b.bar;
        __builtin_amdgcn_s_waitcnt(0);
        unsigned nloc = b.st[0], nx = b.st[1];
        if (nloc == 0u) { xcd_barrier_complete(bar, b.x, nloc, nx); b.st[0] = nloc; b.st[1] = nx; }
        const unsigned old = xb_add(&bar[XB_XSUB(b.x)], 1u);
        const unsigned gen = old / nloc;
        if (old + 1u == (gen + 1u) * nloc) {
            __builtin_amdgcn_fence(__ATOMIC_RELEASE, "agent");
            asm volatile("s_waitcnt vmcnt(0)" ::: "memory");
            const unsigned og = xb_add(&bar[XB_TOP], 1u);
            const unsigned tg = og / nx;
            if (og + 1u == (tg + 1u) * nx) xb_add(&bar[XB_TOPGEN], 1u);
            else XB_SPIN(xb_ld(&bar[XB_TOPGEN]) == tg, bar);
            __builtin_amdgcn_fence(__ATOMIC_ACQUIRE, "agent");
            xb_add(&bar[XB_XGEN(b.x)], 1u);
            asm volatile("s_waitcnt vmcnt(0)" ::: "memory");
        } else {
            XB_SPIN(xb_ld(&bar[XB_XGEN(b.x)]) == gen, bar);
            __builtin_amdgcn_fence(__ATOMIC_ACQUIRE, "agent");
            asm volatile("s_waitcnt vmcnt(0)" ::: "memory");
        }
    }
    __syncthreads();
}


constexpr size_t WS_XBAR = 772 * 1024;
#define GSYNC() xcd_barrier(xb)

__global__ void __launch_bounds__(512, 2) mega_fwd(Params p) {
    extern __shared__ __attribute__((aligned(16))) unsigned char lds_raw[];
    LAS unsigned char* lds = (LAS unsigned char*)lds_raw;
    cg::grid_group grid = cg::this_grid();
    const int bid = blockIdx.x, nb = gridDim.x;
    { LAS unsigned* st_ = (LAS unsigned*)(lds + LDS_BYTES - 32); if (get_tid() == 0) { st_[0] = 0u; st_[1] = 0u; } __syncthreads(); }
    XcdBarrier xb = xcd_barrier_post((unsigned*)(p.ws + WS_XBAR), (volatile LAS unsigned*)(lds + LDS_BYTES - 32));
    PB(16, phase_prologue(p, lds, bid, nb));
    { asm volatile("s_waitcnt vmcnt(0) lgkmcnt(0)" ::: "memory"); __syncthreads(); if (get_tid() < 64) { __builtin_amdgcn_fence(__ATOMIC_RELEASE, "agent"); asm volatile("s_waitcnt vmcnt(0) lgkmcnt(0)" ::: "memory"); } grid.sync();
      if (get_tid() < 64) { __builtin_amdgcn_fence(__ATOMIC_ACQUIRE, "agent"); asm volatile("s_waitcnt vmcnt(0) lgkmcnt(0)" ::: "memory"); } __syncthreads(); }
    PB(8, phase_rowops(p, 0, 0, TT, bid, nb)); GSYNC();
#define LAYER(L, LAST) \
    PB(1, layer_phase<0>(p, L, lds, bid, nb)); GSYNC(); PB(4, layer_phase<1>(p, L, lds, bid, nb)); GSYNC(); \
    PB(2, layer_phase<3>(p, L, lds, bid, nb)); GSYNC(); PB(4, layer_phase<4>(p, L, lds, bid, nb)); GSYNC(); PB(1, layer_phase<5>(p, L, lds, bid, nb)); GSYNC(); \
    PB(8, layer_phase<6>(p, L, lds, bid, nb)); GSYNC(); PB(1, layer_phase<7>(p, L, lds, bid, nb)); GSYNC(); PB(1, layer_phase<8>(p, L, lds, bid, nb)); GSYNC(); \
    PB(8, layer_phase<9>(p, L, lds, bid, nb)); if (!(LAST)) GSYNC();
    LAYER(0, false)
    LAYER(1, true)
}
#if N_LAUNCH_MODE != 1
template <int PH> __global__ void __launch_bounds__(512, 2) one_phase(Params p, int l) {
    extern __shared__ __attribute__((aligned(16))) unsigned char lds_raw[];
    LAS unsigned char* lds = (LAS unsigned char*)lds_raw;
    if constexpr (PH == 100) phase_prologue(p, lds, blockIdx.x, gridDim.x);
    else if constexpr (PH == 101) phase_rowops(p, 0, 0, TT, blockIdx.x, gridDim.x);
    else layer_phase<PH>(p, l, lds, blockIdx.x, gridDim.x);
}
#endif

extern "C" void kernel_launch(void* const* d_in, const int* in_sizes, int n_in, void* d_out, int out_size, void* d_ws, size_t ws_size, hipStream_t stream) {
    if (n_in != 30 || ws_size < WS_NEED || out_size != TMAIN * DM) { fprintf(stderr, "kernel_launch: unexpected shapes (n_in %d, ws %zu, out %d)\n", n_in, ws_size, out_size); return; }
    Params p{};
    for (int i = 0; i < 30; ++i) p.in[i] = (const float*)d_in[i];
    p.out = (float*)d_out; p.ws = (unsigned char*)d_ws;
    static int grid_blocks = 0;
    if (!grid_blocks) {
        int dev = 0, cus = 0, per_cu = 0;
        (void)hipGetDevice(&dev);
        (void)hipDeviceGetAttribute(&cus, hipDeviceAttributeMultiprocessorCount, dev);
        (void)hipFuncSetAttribute((const void*)mega_fwd, hipFuncAttributeMaxDynamicSharedMemorySize, LDS_BYTES);
        (void)hipOccupancyMaxActiveBlocksPerMultiprocessor(&per_cu, mega_fwd, 512, LDS_BYTES);
        if (per_cu < 1) { fprintf(stderr, "kernel_launch: occupancy query says %d blocks/CU\n", per_cu); per_cu = 1; }
        grid_blocks = cus * 1;
        if (grid_blocks < 128) { fprintf(stderr, "kernel_launch: only %d CUs\n", grid_blocks); }
    }
#if N_LAUNCH_MODE == 1
    (void)hipMemsetAsync((char*)d_ws + 768 * 1024, 0, 32 * 1024, stream);
    void* args[] = {&p};
    hipError_t e = hipLaunchCooperativeKernel((const void*)mega_fwd, dim3(grid_blocks), dim3(512), args, LDS_BYTES, stream);
    if (e != hipSuccess) fprintf(stderr, "cooperative launch failed: %s (grid %d)\n", hipGetErrorString(e), grid_blocks);
#else
#define LP(PH, L) do { (void)hipFuncSetAttribute((const void*)one_phase<PH>, hipFuncAttributeMaxDynamicSharedMemorySize, LDS_BYTES); one_phase<PH><<<grid_blocks, 512, LDS_BYTES, stream>>>(p, L); } while (0)
    LP(100, 0); LP(101, 0);
    for (int l = 0; l < 2; ++l) { LP(0, l); LP(1, l); LP(2, l); LP(3, l); LP(4, l); LP(5, l); LP(6, l); LP(7, l); LP(8, l); LP(9, l); }
#endif
}
```

```cpp
#include <hip/hip_runtime.h>
#include <hip/hip_cooperative_groups.h>
#include <cstdio>
#include <cstdint>
#include <cmath>
namespace cg = cooperative_groups;
__device__ __forceinline__ int get_tid() { int t = threadIdx.x; asm volatile("" : "+v"(t)); return t; }
namespace pg8 {
#define PG8_LAS __attribute__((address_space(3)))
typedef unsigned short bf16_t;
typedef short bf16x8 __attribute__((ext_vector_type(8)));
typedef float f32x4 __attribute__((ext_vector_type(4)));
typedef unsigned u32x4 __attribute__((ext_vector_type(4)));
typedef unsigned u32x2 __attribute__((ext_vector_type(2)));
constexpr int BM = 256, BK = 64, HALF = 128, HTB = HALF * BK * 2, STAGE_BYTES = 8 * HTB, NXCD = 8, WGM = 8;

__host__ __device__ __forceinline__ int lds_byte(int r, int c) { const int st = (r >> 4) * 2 + (c >> 5), rr = r & 15, cc = c & 31, ob = rr * 64 + cc * 2; return st * 1024 + (ob ^ (((ob >> 9) & 1) << 5)); }
__host__ __device__ __forceinline__ void stage_rc(int b, int& R, int& C) { const int st = b / 1024, sb = b % 1024, swz = sb ^ (((sb >> 9) & 1) << 5); R = (st >> 1) * 16 + swz / 64; C = (st & 1) * 32 + (swz % 64) / 2; }

struct Unit { int pm, pn; };
struct Gemm { const bf16_t* A; const bf16_t* Bt; int M, N, K, lda; };

struct StaticOrder {
    int nM, nN, nwg, G, c;
    __host__ __device__ void init(int M, int N, int G_, int c_) { nM = M / BM; nN = N / BM; nwg = nM * nN; G = G_; c = c_; }
    __host__ __device__ bool next(int i, Unit& u) const {
        const long L = (long)i * G + c; if (L >= nwg) return false;
        int wgid = (int)L; { const int q = nwg / NXCD, r = nwg % NXCD, xcd = wgid % NXCD, off = wgid / NXCD; wgid = (xcd < r ? xcd * (q + 1) : r * (q + 1) + (xcd - r) * q) + off; }
        const int nig = WGM * nN, gid = wgid / nig, fm = gid * WGM, gsz = (nM - fm) < WGM ? (nM - fm) : WGM;
        u.pm = fm + ((wgid % nig) % gsz); u.pn = (wgid % nig) / gsz; return true;
    }
};

template <class Epi>
__device__ __forceinline__ void gemm_phase(PG8_LAS unsigned char* lds, const Gemm g, const StaticOrder& S, const Epi& E) {
    const int tid = get_tid(), wid = __builtin_amdgcn_readfirstlane(tid >> 6), lane = tid & 63, wr = wid >> 2, wc = wid & 3, fr = lane & 15, fq = lane >> 4;
    const int K = g.K, nt = K / BK, lda = g.lda;
    unsigned voffA[2], voffB[2];
#pragma unroll
    for (int i = 0; i < 2; ++i) { int R, C; stage_rc(tid * 16 + i * 8192, R, C);
        voffA[i] = (unsigned)(R * lda + C) * 2u; voffB[i] = (unsigned)(R * K + C) * 2u; }
    const size_t kstep = (size_t)(BK * 2);
    const size_t hstepA = (size_t)HALF * lda * 2, hstepB = (size_t)HALF * K * 2;
    const size_t tstepA = 2 * hstepA, tstepB = 2 * hstepB;
    const unsigned ldsw = (unsigned)wid * 1024u;
    const int aoff = lds_byte(wr * 64 + fr, fq * 8), boff = lds_byte(wc * 32 + fr, fq * 8);
#define PG8_SA(b, h) (((b) * 2 + (h)) * HTB)
#define PG8_SB(b, h) ((4 + (b) * 2 + (h)) * HTB)
#define PG8_STAGE(bufoff, gbase, voff) do { _Pragma("unroll") for (int _i = 0; _i < 2; ++_i) \
        __builtin_amdgcn_global_load_lds((const unsigned*)((const char*)(gbase) + (voff)[_i]), (PG8_LAS unsigned*)(lds + (bufoff) + ldsw + _i * 8192), 16, 0, 0); } while (0)
#define PG8_LDA(dst, b, h) do { _Pragma("unroll") for (int m = 0; m < 4; ++m) _Pragma("unroll") for (int k = 0; k < 2; ++k) dst[m][k] = *(const PG8_LAS bf16x8*)(lds + PG8_SA(b, h) + aoff + m * 2048 + k * 1024); } while (0)
#define PG8_LDB(dst, b, h) do { _Pragma("unroll") for (int n = 0; n < 2; ++n) _Pragma("unroll") for (int k = 0; k < 2; ++k) dst[n][k] = *(const PG8_LAS bf16x8*)(lds + PG8_SB(b, h) + boff + n * 2048 + k * 1024); } while (0)
#define PG8_MMA(ai, bj, At, Bt) do { __builtin_amdgcn_s_setprio(1); _Pragma("unroll") for (int m = 0; m < 4; ++m) _Pragma("unroll") for (int n = 0; n < 2; ++n) _Pragma("unroll") for (int k = 0; k < 2; ++k) \
        acc[ai][bj][m][n] = __builtin_amdgcn_mfma_f32_16x16x32_bf16(Bt[n][k], At[m][k], acc[ai][bj][m][n], 0, 0, 0); __builtin_amdgcn_s_setprio(0); } while (0)
#define PG8_WAIT_V(n) asm volatile("s_waitcnt vmcnt(" #n ")" ::: "memory")
#define PG8_WAIT_L(n) asm volatile("s_waitcnt lgkmcnt(" #n ")" ::: "memory")
#define PG8_BAR __builtin_amdgcn_s_barrier()
#define PG8_SCHED __builtin_amdgcn_sched_barrier(0)
    Unit cur, nxt; int ui = 0;
    if (!S.next(0, cur)) return;
    f32x4 acc[2][2][4][2];
#pragma unroll
    for (int a = 0; a < 2; ++a)
#pragma unroll
        for (int b = 0; b < 2; ++b)
#pragma unroll
            for (int m = 0; m < 4; ++m)
#pragma unroll
                for (int n = 0; n < 2; ++n) acc[a][b][m][n] = (f32x4){0.f, 0.f, 0.f, 0.f};
    bf16x8 At[4][2], B0[2][2], B1[2][2];
    const char* cA = (const char*)g.A + (size_t)cur.pm * tstepA; const char* cB = (const char*)g.Bt + (size_t)cur.pn * tstepB;
    PG8_STAGE(PG8_SB(0, 0), cB, voffB); PG8_STAGE(PG8_SA(0, 0), cA, voffA); PG8_STAGE(PG8_SB(0, 1), cB + hstepB, voffB); PG8_STAGE(PG8_SA(0, 1), cA + hstepA, voffA);
    if (wr == 1) PG8_BAR;
    PG8_WAIT_V(4); PG8_BAR;
    PG8_STAGE(PG8_SB(1, 0), cB + kstep, voffB); PG8_STAGE(PG8_SA(1, 0), cA + kstep, voffA); PG8_STAGE(PG8_SB(1, 1), cB + hstepB + kstep, voffB);
    PG8_WAIT_V(6); PG8_BAR;
    for (;;) {
        const bool has_next = S.next(ui + 1, nxt);
        const char* nA = has_next ? (const char*)g.A + (size_t)nxt.pm * tstepA : cA; const char* nB = has_next ? (const char*)g.Bt + (size_t)nxt.pn * tstepB : cB;
        for (int t = 0; t < nt; t += 2) {
            const bool last = (t == nt - 2);
            const char* a1 = cA + (size_t)(t + 1) * kstep;
            const char* a2 = last ? nA : cA + (size_t)(t + 2) * kstep; const char* b2 = last ? nB : cB + (size_t)(t + 2) * kstep;
            const char* a3 = a2 + kstep; const char* b3 = b2 + kstep;
            PG8_LDB(B0, 0, 0); PG8_SCHED; PG8_LDA(At, 0, 0); PG8_STAGE(PG8_SA(1, 1), a1 + hstepA, voffA);
            PG8_WAIT_L(8); PG8_BAR; PG8_WAIT_L(0); PG8_MMA(0, 0, At, B0); PG8_BAR; PG8_SCHED;
            PG8_LDB(B1, 0, 1); PG8_STAGE(PG8_SB(0, 0), b2, voffB);
            PG8_BAR; PG8_WAIT_L(0); PG8_MMA(0, 1, At, B1); PG8_BAR;
            PG8_LDA(At, 0, 1); PG8_STAGE(PG8_SA(0, 0), a2, voffA);
            PG8_BAR; PG8_WAIT_L(0); PG8_MMA(1, 0, At, B0); PG8_BAR; PG8_SCHED;
            PG8_STAGE(PG8_SB(0, 1), b2 + hstepB, voffB);
            PG8_WAIT_V(6); PG8_BAR; PG8_MMA(1, 1, At, B1); PG8_BAR;
            PG8_LDB(B0, 1, 0); PG8_SCHED; PG8_LDA(At, 1, 0); PG8_STAGE(PG8_SA(0, 1), a2 + hstepA, voffA);
            PG8_WAIT_L(8); PG8_BAR; PG8_WAIT_L(0); PG8_MMA(0, 0, At, B0); PG8_BAR; PG8_SCHED;
            PG8_LDB(B1, 1, 1); PG8_STAGE(PG8_SB(1, 0), b3, voffB);
            PG8_BAR; PG8_WAIT_L(0); PG8_MMA(0, 1, At, B1); PG8_BAR;
            PG8_LDA(At, 1, 1); PG8_STAGE(PG8_SA(1, 0), a3, voffA);
            PG8_BAR; PG8_WAIT_L(0); PG8_MMA(1, 0, At, B0); PG8_BAR; PG8_SCHED;
            PG8_STAGE(PG8_SB(1, 1), b3 + hstepB, voffB);
            PG8_WAIT_V(6); PG8_BAR; PG8_MMA(1, 1, At, B1); PG8_BAR;
        }
        E(acc, cur, wr, wc, fr, fq);
        if (!has_next) break;
#pragma unroll
        for (int a = 0; a < 2; ++a)
#pragma unroll
            for (int b = 0; b < 2; ++b)
#pragma unroll
                for (int m = 0; m < 4; ++m)
#pragma unroll
                    for (int n = 0; n < 2; ++n) acc[a][b][m][n] = (f32x4){0.f, 0.f, 0.f, 0.f};
        cur = nxt; cA = nA; cB = nB; ++ui;
    }
    PG8_WAIT_V(0);
    if (wr == 0) PG8_BAR;
    PG8_BAR;
#undef PG8_SA
#undef PG8_SB
#undef PG8_STAGE
#undef PG8_LDA
#undef PG8_LDB
#undef PG8_MMA
#undef PG8_WAIT_V
#undef PG8_WAIT_L
#undef PG8_BAR
#undef PG8_SCHED
}

__device__ __forceinline__ unsigned f2bf_u(float f) { unsigned u = __builtin_bit_cast(unsigned, f); return (u + 0x7fffu + ((u >> 16) & 1u)) >> 16; }
template <int ACT> struct EpiBf16 {
    bf16_t* O; int ldc;
    __device__ __forceinline__ void operator()(const f32x4 (&acc)[2][2][4][2], const Unit& u, int wr, int wc, int fr, int fq) const {
        const int row0 = u.pm * BM + wr * 64 + fr, col0 = u.pn * BM + wc * 32 + 4 * fq;
#pragma unroll
        for (int ai = 0; ai < 2; ++ai)
#pragma unroll
            for (int m = 0; m < 4; ++m) { bf16_t* rowp = O + (size_t)(row0 + ai * HALF + m * 16) * ldc + col0;
#pragma unroll
                for (int bj = 0; bj < 2; ++bj)
#pragma unroll
                    for (int n = 0; n < 2; ++n) { f32x4 v = acc[ai][bj][m][n];
                        if (ACT == 1) { v.x = v.x > 0.f ? v.x * v.x : 0.f; v.y = v.y > 0.f ? v.y * v.y : 0.f; v.z = v.z > 0.f ? v.z * v.z : 0.f; v.w = v.w > 0.f ? v.w * v.w : 0.f; }
                        u32x2 o; o.x = f2bf_u(v.x) | (f2bf_u(v.y) << 16); o.y = f2bf_u(v.z) | (f2bf_u(v.w) << 16);
                        *(u32x2*)(rowp + bj * HALF + n * 16) = o; } }
    }
};
}
typedef unsigned short bf16_t;
typedef short bf16x8 __attribute__((ext_vector_type(8)));
typedef float f32x4 __attribute__((ext_vector_type(4)));
typedef unsigned u32x4 __attribute__((ext_vector_type(4)));
typedef unsigned u32x2 __attribute__((ext_vector_type(2)));
#define LAS __attribute__((address_space(3)))

constexpr int NBATCH = 8, SEQL = 4096, DM = 1024, CTXL = 256, TMAIN = 32768, TCTX = 2048, TT = 34816, NP = 3072, FF = 4096;
constexpr int PC_SWAQ = 0, PC_RETQ = 256, PC_RWR = 512, PC_MLAQD = 768, PC_SWAK = 1024, PC_SWAV = 1152, PC_RETK = 1280, PC_RETV = 1536, PC_RETG = 1792,
              PC_RWK = 2048, PC_RWV = 2304, PC_RWWD = 2560, PC_RWAD = 2624, PC_RWGD = 2688, PC_MLAKVD = 2816, PC_MLAKPE = 2944;
constexpr int PC_RWO0 = PC_RWV, PC_RWO1 = PC_RWR;
constexpr int NKEYS = CTXL + SEQL;

constexpr size_t MiB = 1u << 20;
constexpr size_t WS_MOD = 0;
constexpr size_t WS_TAB = 512 * 1024;
constexpr size_t WS_CTR = 768 * 1024;
constexpr size_t WS_BON = 1 * MiB;
constexpr size_t WS_WB = 2 * MiB;
constexpr size_t WB_LAYER = 24 * MiB, WB_IN = 0, WB_OUT = 6 * MiB, WB_W1 = 8 * MiB, WB_W2 = 16 * MiB;
constexpr size_t WS_XC = 50 * MiB;
constexpr size_t WS_P = 58 * MiB;
constexpr size_t WS_HID = 58 * MiB;
constexpr size_t WS_A = 262 * MiB;
constexpr size_t ARR17 = 17 * MiB;
constexpr size_t WS_RWK = WS_A, WS_RWV = WS_A + ARR17, WS_RWRR = WS_A + 2 * ARR17, WS_RWA0 = WS_A + 3 * ARR17, WS_RWA1 = WS_A + 4 * ARR17,
                 WS_RWM0 = WS_A + 5 * ARR17, WS_RWM1 = WS_A + 6 * ARR17;
constexpr size_t WS_RET = WS_A + 119 * MiB;
constexpr size_t WS_MQ = WS_RET + 34 * MiB;
constexpr size_t WS_KM = WS_MQ + 26738688;
constexpr size_t WS_VTM = WS_KM + 26738688;
constexpr size_t WS_KS = WS_VTM + ARR17;
constexpr size_t WS_VTS = WS_KS + 8912896;
constexpr size_t WS_A_END = WS_VTS + 8912896;
constexpr size_t WS_Z = 330 * MiB;
constexpr size_t WS_HB = 398 * MiB;
constexpr size_t WS_MLAW = 500 * MiB;
constexpr size_t MLAW_LAYER = 384 * 256 * 2 + 512 * 128 * 2, MLAW_KV = 384 * 256 * 2;
constexpr size_t WS_GUPT = 501 * MiB;
constexpr size_t WS_LORAT = 502 * MiB;
constexpr size_t WS_NEED = 503 * MiB;
static_assert(WS_A_END <= WS_NEED && WS_HB + 68 * MiB <= WS_NEED && WS_HID + 272 * MiB <= WS_Z, "ws map");

constexpr int LDS_BYTES = 150 * 1024;

struct Params { const float* in[30]; float* out; unsigned char* ws; };

__device__ __forceinline__ float bf2f(bf16_t v) { return __builtin_bit_cast(float, (unsigned)v << 16); }
__device__ __forceinline__ bf16_t f2bf(float f) { unsigned u = __builtin_bit_cast(unsigned, f); return (bf16_t)((u + 0x7fffu + ((u >> 16) & 1u)) >> 16); }
__device__ __forceinline__ unsigned pk2(float lo, float hi) { return (unsigned)f2bf(lo) | ((unsigned)f2bf(hi) << 16); }
typedef float f32x2 __attribute__((ext_vector_type(2)));
typedef __bf16 bf16x2_t __attribute__((ext_vector_type(2)));
__device__ __forceinline__ unsigned cvt_pk_bf16(float lo, float hi) { const f32x2 v = {lo, hi}; return __builtin_bit_cast(unsigned, __builtin_convertvector(v, bf16x2_t)); }
template <int CTRL> __device__ __forceinline__ float dppf(float v) { return __builtin_bit_cast(float, __builtin_amdgcn_update_dpp(0, __builtin_bit_cast(int, v), CTRL, 0xF, 0xF, true)); }
__device__ __forceinline__ float red4(float v) { v += dppf<0xB1>(v); v += dppf<0x4E>(v); return v; }
__device__ __forceinline__ float red8(float v) { v = red4(v); v += dppf<0x141>(v); return v; }
__device__ __forceinline__ float red16(float v) { v = red8(v); v += dppf<0x140>(v); return v; }
__device__ __forceinline__ float max16(float v) { v = fmaxf(v, dppf<0xB1>(v)); v = fmaxf(v, dppf<0x4E>(v)); v = fmaxf(v, dppf<0x141>(v)); v = fmaxf(v, dppf<0x140>(v)); return v; }
__device__ __forceinline__ float wave_sum(float v) {
    v = red16(v);
    const int u = __builtin_bit_cast(int, v);
    return __builtin_bit_cast(float, __builtin_amdgcn_readlane(u, 0)) + __builtin_bit_cast(float, __builtin_amdgcn_readlane(u, 16)) +
           __builtin_bit_cast(float, __builtin_amdgcn_readlane(u, 32)) + __builtin_bit_cast(float, __builtin_amdgcn_readlane(u, 48));
}
__device__ __forceinline__ void unpack8(const u32x4 u, float* f) {
    f[0] = bf2f((bf16_t)(u.x & 0xffff)); f[1] = bf2f((bf16_t)(u.x >> 16)); f[2] = bf2f((bf16_t)(u.y & 0xffff)); f[3] = bf2f((bf16_t)(u.y >> 16));
    f[4] = bf2f((bf16_t)(u.z & 0xffff)); f[5] = bf2f((bf16_t)(u.z >> 16)); f[6] = bf2f((bf16_t)(u.w & 0xffff)); f[7] = bf2f((bf16_t)(u.w >> 16));
}
__device__ __forceinline__ float sigmoidf_(float x) { return __builtin_amdgcn_rcpf(1.f + __expf(-x)); }

struct SeqInfo { int b, pos, len, start, isctx; };
__device__ __forceinline__ SeqInfo seq_of_row(int row) {
    SeqInfo s;
    if (row < TMAIN) { s.b = row >> 12; s.pos = row & 4095; s.len = SEQL; s.start = s.b << 12; s.isctx = 0; }
    else { const int r = row - TMAIN; s.b = r >> 8; s.pos = r & 255; s.len = CTXL; s.start = TMAIN + (s.b << 8); s.isctx = 1; }
    return s;
}

__device__ __forceinline__ void transpose_item(const float* W, int N, int nsrc0, bf16_t* WT, int K, int ndst0, int k0, LAS float* scr, int lane) {
    if (nsrc0 >= 0) {
#pragma unroll 32
        for (int i = 0; i < 32; ++i) { const int kk = 2 * i + (lane >> 5); scr[kk * 33 + (lane & 31)] = W[(size_t)(k0 + kk) * N + nsrc0 + (lane & 31)]; }
    } else {
#pragma unroll 8
        for (int i = 0; i < 32; ++i) { const int kk = 2 * i + (lane >> 5); scr[kk * 33 + (lane & 31)] = 0.f; }
    }
    __builtin_amdgcn_wave_barrier(); asm volatile("s_waitcnt lgkmcnt(0)" ::: "memory");
    const int c = lane & 7;
#pragma unroll
    for (int j = 0; j < 4; ++j) { const int n = (lane >> 3) + 8 * j; const LAS float* s = scr + (8 * c) * 33 + n;
        u32x4 o; o.x = pk2(s[0 * 33], s[1 * 33]); o.y = pk2(s[2 * 33], s[3 * 33]); o.z = pk2(s[4 * 33], s[5 * 33]); o.w = pk2(s[6 * 33], s[7 * 33]);
        *(u32x4*)(WT + (size_t)(ndst0 + n) * K + k0 + 8 * c) = o; }
    __builtin_amdgcn_wave_barrier(); asm volatile("s_waitcnt lgkmcnt(0)" ::: "memory");
}
__device__ __forceinline__ int win_src_col(int n) {
    if (n < 256) return n;
    if (n < 512) return 512 + (n - 256);
    if (n < 768) return 1536 + (n - 512);
    if (n < 1024) return 2560 + (n - 768);
    if (n < 1280) return 256 + (n - 1024);
    if (n < 2048) return 768 + (n - 1280);
    if (n < 2816) return 1792 + (n - 2048);
    if (n < 2976) return n;
    return -1;
}
__device__ __forceinline__ void phase_prologue(const Params& p, LAS unsigned char* lds, int bid, int nb) {
    const int tid = get_tid(), lane = tid & 63, wave = tid >> 6;
    LAS float* scr = (LAS float*)(lds + wave * 16384);
    const int gw = bid * 8 + wave, NGW = nb * 8;
    constexpr int I_IN = 16 * 96, I_OUT = 16 * 32, I_1 = 16 * 128, I_2 = 64 * 32, I_Q = 4 * 12, I_KV = 2 * 16, I_G = 2 * 8, I_LO = 4 * 8, I_L = I_IN + I_OUT + I_1 + I_2 + I_Q + I_KV + I_G + I_LO;
    for (int it = gw; it < 2 * I_L; it += NGW) {
        const int l = it / I_L; int r = it % I_L;
        unsigned char* wb = p.ws + WS_WB + (size_t)l * WB_LAYER;
        if (r < I_IN) { const int kb = r / 96, nbk = r % 96; transpose_item(p.in[10] + (size_t)l * DM * 2976, 2976, win_src_col(nbk * 32), (bf16_t*)(wb + WB_IN), DM, nbk * 32, kb * 64, scr, lane); continue; } r -= I_IN;
        if (r < I_OUT) { const int kb = r / 32, nbk = r % 32; transpose_item(p.in[11] + (size_t)l * DM * DM, DM, nbk * 32, (bf16_t*)(wb + WB_OUT), DM, nbk * 32, kb * 64, scr, lane); continue; } r -= I_OUT;
        if (r < I_1) { const int kb = r / 128, nbk = r % 128; transpose_item(p.in[28] + (size_t)l * DM * FF, FF, nbk * 32, (bf16_t*)(wb + WB_W1), DM, nbk * 32, kb * 64, scr, lane); continue; } r -= I_1;
        if (r < I_2) { const int kb = r / 32, nbk = r % 32; transpose_item(p.in[29] + (size_t)l * FF * DM, DM, nbk * 32, (bf16_t*)(wb + WB_W2), FF, nbk * 32, kb * 64, scr, lane); continue; } r -= I_2;
        unsigned char* mw = p.ws + WS_MLAW + (size_t)l * MLAW_LAYER;
        if (r < I_Q) { const int kb = r / 12, nbk = r % 12; transpose_item(p.in[25] + (size_t)l * 256 * 384, 384, nbk * 32, (bf16_t*)mw, 256, nbk * 32, kb * 64, scr, lane); continue; } r -= I_Q;
        if (r < I_KV) { const int kb = r / 16, nbk = r % 16; transpose_item(p.in[27] + (size_t)l * 128 * 512, 512, nbk * 32, (bf16_t*)(mw + MLAW_KV), 128, nbk * 32, kb * 64, scr, lane); continue; } r -= I_KV;
        if (r < I_G) { const int kb = r / 8, nbk = r % 8; transpose_item(p.in[19] + (size_t)l * 128 * 256, 256, nbk * 32, (bf16_t*)(p.ws + WS_GUPT + (size_t)l * 256 * 128 * 2), 128, nbk * 32, kb * 64, scr, lane); continue; } r -= I_G;
        { const int m = r / 8, nbk = r % 8; const float* src = (m < 2 ? p.in[16] : p.in[18]) + ((size_t)l * 2 + (m & 1)) * 64 * 256;
          transpose_item(src, 256, nbk * 32, (bf16_t*)(p.ws + WS_LORAT + ((size_t)l * 4 + m) * 256 * 64 * 2), 64, nbk * 32, 0, scr, lane); }
    }
    __syncthreads();
    for (int it = bid; it < 192; it += nb) {
        const int l = it / 96, cb = it % 96;
        LAS float* sc = (LAS float*)lds;
        LAS float* red = sc + 9 * 1024;
        for (int e = tid; e < 9 * 1024; e += 512) { const int r = e >> 10, k = e & 1023; const float v = (r < 8) ? p.in[1][r * 1024 + k] : p.in[3][k]; sc[e] = v / (1.f + __expf(-v)); }
        __syncthreads();
        const int ks = tid >> 6, cl = tid & 63, n = cb * 64 + cl;
        float acc[9];
#pragma unroll
        for (int r = 0; r < 9; ++r) acc[r] = 0.f;
        const float* aw = p.in[4] + (size_t)l * DM * 6144;
#pragma unroll 16
        for (int k = ks * 128; k < ks * 128 + 128; ++k) { const float w = aw[(size_t)k * 6144 + n];
#pragma unroll
            for (int r = 0; r < 9; ++r) acc[r] += sc[r * 1024 + k] * w; }
#pragma unroll
        for (int r = 0; r < 9; ++r) red[(ks * 9 + r) * 64 + cl] = acc[r];
        __syncthreads();
        for (int e = tid; e < 9 * 64; e += 512) { const int r = e >> 6, c2 = e & 63; float s = 0.f;
            for (int q = 0; q < 8; ++q) s += red[(q * 9 + r) * 64 + c2];
            ((float*)(p.ws + WS_MOD))[((size_t)l * 9 + r) * 6144 + cb * 64 + c2] = s + p.in[5][(size_t)l * 6144 + cb * 64 + c2]; }
        __syncthreads();
    }
    if (bid == 0 && tid < 4) ((unsigned*)(p.ws + WS_CTR))[tid] = 0u;
    if (bid == nb - 1) {
        float* tab = (float*)(p.ws + WS_TAB);
        for (int e = tid; e < 64 * 16; e += 512) { const int pos = e >> 4, f = e & 15; const float inv = powf(10000.f, -(float)(2 * f) / 32.f); const float a = (float)pos * inv; tab[e] = cosf(a); tab[1024 + e] = sinf(a); }
        for (int e = tid; e < 64 * 8; e += 512) { const int pos = e >> 3, f = e & 7; const float inv = powf(10000.f, -(float)(2 * f) / 16.f); const float a = (float)pos * inv; tab[2048 + e] = cosf(a); tab[2560 + e] = sinf(a); }
    }
}

struct RowJob { const float* xsrc; const bf16_t* z; const float* gpost; const float* gate; float* xdst; const float* gpre; const float* shift; const float* scale; bf16_t* hdst; };
__device__ __forceinline__ RowJob make_rowjob(const Params& p, int mode, int l, int row) {
    const float* mod = (const float*)(p.ws + WS_MOD);
    bf16_t* HB = (bf16_t*)(p.ws + WS_HB); const bf16_t* Z = (const bf16_t*)(p.ws + WS_Z);
    float* XC = (float*)(p.ws + WS_XC);
    const SeqInfo s = seq_of_row(row);
    const int mr = s.isctx ? 8 : s.b;
    const float* m_l = mod + ((size_t)l * 9 + mr) * 6144;
    float* xs = s.isctx ? XC + (size_t)(row - TMAIN) * DM : p.out + (size_t)row * DM;
    const float* xin = s.isctx ? p.in[2] + (size_t)(row - TMAIN) * DM : p.in[0] + (size_t)row * DM;
    RowJob j;
    if (mode == 0) { j = RowJob{xin, nullptr, nullptr, nullptr, nullptr, p.in[6] + l * DM, m_l + 0, m_l + 1024, HB + (size_t)row * DM}; }
    else if (mode == 1) { j = RowJob{l == 0 ? xin : xs, Z + (size_t)row * DM, p.in[7] + l * DM, m_l + 2048, xs, p.in[8] + l * DM, m_l + 3072, m_l + 4096, HB + (size_t)row * DM}; }
    else { const bool has_next = (l + 1 < 2); const float* m_n = mod + ((size_t)(has_next ? l + 1 : l) * 9 + mr) * 6144;
        j = RowJob{xs, Z + (size_t)row * DM, p.in[9] + l * DM, m_l + 5120, xs, p.in[6] + (has_next ? l + 1 : l) * DM, m_n + 0, m_n + 1024, has_next ? HB + (size_t)row * DM : nullptr}; }
    return j;
}
template <int RB>
__device__ __forceinline__ void rowop_batch(const RowJob (&jb)[RB], const bool (&valid)[RB], int lane) {
    f32x4 v[RB][4]; u32x2 zu[RB][4];
#pragma unroll
    for (int r = 0; r < RB; ++r) if (valid[r]) {
#pragma unroll
        for (int j = 0; j < 4; ++j) { v[r][j] = *(const f32x4*)(jb[r].xsrc + (j * 64 + lane) * 4); if (jb[r].z) zu[r][j] = *(const u32x2*)(jb[r].z + (j * 64 + lane) * 4); }
    }
#pragma unroll
    for (int r = 0; r < RB; ++r) if (valid[r]) {
        const RowJob& J = jb[r];
        if (J.z) {
            f32x4 zz[4], gp[4], gt[4]; float ss = 0.f;
#pragma unroll
            for (int j = 0; j < 4; ++j) { const int c = (j * 64 + lane) * 4; gp[j] = *(const f32x4*)(J.gpost + c); gt[j] = *(const f32x4*)(J.gate + c); }
#pragma unroll
            for (int j = 0; j < 4; ++j) { const u32x2 u = zu[r][j];
                zz[j].x = bf2f((bf16_t)(u.x & 0xffff)); zz[j].y = bf2f((bf16_t)(u.x >> 16)); zz[j].z = bf2f((bf16_t)(u.y & 0xffff)); zz[j].w = bf2f((bf16_t)(u.y >> 16));
                ss += zz[j].x * zz[j].x + zz[j].y * zz[j].y + zz[j].z * zz[j].z + zz[j].w * zz[j].w; }
            const float rinv = 1.f / sqrtf(wave_sum(ss) * (1.f / 1024.f) + 1e-6f);
#pragma unroll
            for (int j = 0; j < 4; ++j) { const int c = (j * 64 + lane) * 4;
                v[r][j].x += gt[j].x * (zz[j].x * rinv * gp[j].x); v[r][j].y += gt[j].y * (zz[j].y * rinv * gp[j].y); v[r][j].z += gt[j].z * (zz[j].z * rinv * gp[j].z); v[r][j].w += gt[j].w * (zz[j].w * rinv * gp[j].w);
                *(f32x4*)(J.xdst + c) = v[r][j]; }
        }
        if (J.hdst) {
            f32x4 g[4], sh[4], sc[4]; float ss = 0.f;
#pragma unroll
            for (int j = 0; j < 4; ++j) { const int c = (j * 64 + lane) * 4; g[j] = *(const f32x4*)(J.gpre + c); sh[j] = *(const f32x4*)(J.shift + c); sc[j] = *(const f32x4*)(J.scale + c); }
#pragma unroll
            for (int j = 0; j < 4; ++j) ss += v[r][j].x * v[r][j].x + v[r][j].y * v[r][j].y + v[r][j].z * v[r][j].z + v[r][j].w * v[r][j].w;
            const float rinv = 1.f / sqrtf(wave_sum(ss) * (1.f / 1024.f) + 1e-6f);
#pragma unroll
            for (int j = 0; j < 4; ++j) { const int c = (j * 64 + lane) * 4;
                u32x2 o; o.x = pk2(v[r][j].x * rinv * g[j].x * (1.f + sc[j].x) + sh[j].x, v[r][j].y * rinv * g[j].y * (1.f + sc[j].y) + sh[j].y);
                o.y = pk2(v[r][j].z * rinv * g[j].z * (1.f + sc[j].z) + sh[j].z, v[r][j].w * rinv * g[j].w * (1.f + sc[j].w) + sh[j].w);
                *(u32x2*)(J.hdst + c) = o; }
        }
    }
}
__device__ __forceinline__ void phase_rowops(const Params& p, int mode, int l, int nrows, int bid, int nb) {
    const int tid = get_tid(), lane = tid & 63, wave = tid >> 6;
    constexpr int RB = 4;
    const int nwaves = nb * 8, gw = bid * 8 + wave;
    for (int base = gw; base < nrows; base += nwaves * RB) {
        RowJob jb[RB]; bool valid[RB];
#pragma unroll
        for (int r = 0; r < RB; ++r) { const int row = base + r * nwaves; valid[r] = row < nrows; jb[r] = make_rowjob(p, mode, l, valid[r] ? row : 0); }
        rowop_batch<RB>(jb, valid, lane);
    }
}

__device__ __forceinline__ void rwkv_prep_item(const Params& p, int l, LAS unsigned char* lds, int tile) {
    const int tid = get_tid(), lane = tid & 63, wave = tid >> 6, fr = lane & 15, fq = lane >> 4;
    const bf16_t* P = (const bf16_t*)(p.ws + WS_P);
    const int t0 = tile * 32; const SeqInfo s0 = seq_of_row(t0);
    const float* mu = p.in[14] + l * 1024;
    LAS bf16_t* r_s = (LAS bf16_t*)lds;
    LAS bf16_t* k_s = r_s + 32 * 256;
    LAS bf16_t* v_s = k_s + 32 * 256;
    LAS unsigned char* twd = lds + 3 * 16384;
    LAS unsigned char* ads = twd + 32 * 144;
    LAS float* O1 = (LAS float*)(ads + 32 * 144);
#pragma unroll
    for (int it = 0; it < 7; ++it) {
        const int pc = tid + it * 512; const int tok = pc / 112, c8 = pc % 112, cc = c8 * 8;
        const int pcol = cc < 256 ? PC_RWR + cc : PC_RWK + (cc - 256);
        const int row = t0 + tok, pos = s0.pos + tok;
        const u32x4 u0 = *(const u32x4*)(P + (size_t)row * NP + pcol);
        const u32x4 um = pos > 0 ? *(const u32x4*)(P + (size_t)(row - 1) * NP + pcol) : (u32x4){0u, 0u, 0u, 0u};
        const u32x4 up = pos < s0.len - 1 ? *(const u32x4*)(P + (size_t)(row + 1) * NP + pcol) : (u32x4){0u, 0u, 0u, 0u};
        const f32x4 mu0 = *(const f32x4*)(mu + cc), mu1 = *(const f32x4*)(mu + cc + 4);
        float z0[8], zm[8], zp[8], zs[8]; unpack8(u0, z0); unpack8(um, zm); unpack8(up, zp);
        const float mm[8] = {mu0.x, mu0.y, mu0.z, mu0.w, mu1.x, mu1.y, mu1.z, mu1.w};
#pragma unroll
        for (int x = 0; x < 8; ++x) zs[x] = z0[x] + mm[x] * (0.5f * (zm[x] + zp[x]) - z0[x]);
        LAS unsigned char* dst;
        if (cc < 256) dst = (LAS unsigned char*)(r_s + tok * 256 + cc);
        else if (cc < 512) dst = (LAS unsigned char*)(k_s + tok * 256 + cc - 256);
        else if (cc < 768) dst = (LAS unsigned char*)(v_s + tok * 256 + cc - 512);
        else if (cc < 832) { dst = twd + tok * 144 + (cc - 768) * 2;
#pragma unroll
            for (int x = 0; x < 8; ++x) zs[x] = 1.f - 2.f * __builtin_amdgcn_rcpf(1.f + __expf(2.f * zs[x])); }
        else dst = ads + tok * 144 + (cc - 832) * 2;
        *(LAS u32x4*)dst = (u32x4){cvt_pk_bf16(zs[0], zs[1]), cvt_pk_bf16(zs[2], zs[3]), cvt_pk_bf16(zs[4], zs[5]), cvt_pk_bf16(zs[6], zs[7])};
    }
    __syncthreads();
    const int hh = tid >> 8, c = tid & 255, h = c >> 6;
    bf16_t* RK = (bf16_t*)(p.ws + WS_RWK); bf16_t* RV = (bf16_t*)(p.ws + WS_RWV); bf16_t* RR = (bf16_t*)(p.ws + WS_RWRR);
    bf16_t* RA0 = (bf16_t*)(p.ws + WS_RWA0); bf16_t* RA1 = (bf16_t*)(p.ws + WS_RWA1); bf16_t* RM0 = (bf16_t*)(p.ws + WS_RWM0); bf16_t* RM1 = (bf16_t*)(p.ws + WS_RWM1);
    float* BON = (float*)(p.ws + WS_BON);
#pragma unroll
    for (int pass = 0; pass < 2; ++pass) {
        { const bf16_t* WT = (const bf16_t*)(p.ws + WS_LORAT + ((size_t)l * 4 + pass * 2) * 256 * 64 * 2);
          LAS unsigned char* A = pass ? ads : twd;
          const bf16x8 x00 = *(const LAS bf16x8*)(A + fr * 144 + fq * 16), x01 = *(const LAS bf16x8*)(A + fr * 144 + 64 + fq * 16);
          const bf16x8 x10 = *(const LAS bf16x8*)(A + (16 + fr) * 144 + fq * 16), x11 = *(const LAS bf16x8*)(A + (16 + fr) * 144 + 64 + fq * 16);
          bf16x8 b0[4], b1[4];
#pragma unroll
          for (int q = 0; q < 4; ++q) { const int t = wave * 4 + q, m = t >> 4, nt = t & 15; const bf16_t* wrow = WT + (size_t)m * 256 * 64 + (size_t)(nt * 16 + fr) * 64 + fq * 8;
              b0[q] = *(const bf16x8*)wrow; b1[q] = *(const bf16x8*)(wrow + 32); }
#pragma unroll
          for (int q = 0; q < 4; ++q) { const int t = wave * 4 + q, m = t >> 4, nt = t & 15;
              f32x4 a0 = (f32x4){0.f, 0.f, 0.f, 0.f}, a1 = a0;
              a0 = __builtin_amdgcn_mfma_f32_16x16x32_bf16(x00, b0[q], a0, 0, 0, 0); a0 = __builtin_amdgcn_mfma_f32_16x16x32_bf16(x01, b1[q], a0, 0, 0, 0);
              a1 = __builtin_amdgcn_mfma_f32_16x16x32_bf16(x10, b0[q], a1, 0, 0, 0); a1 = __builtin_amdgcn_mfma_f32_16x16x32_bf16(x11, b1[q], a1, 0, 0, 0);
#pragma unroll
              for (int r = 0; r < 4; ++r) { O1[(m * 32 + fq * 4 + r) * 256 + nt * 16 + fr] = a0[r]; O1[(m * 32 + 16 + fq * 4 + r) * 256 + nt * 16 + fr] = a1[r]; } } }
        __syncthreads();
        if (pass == 0) {
            const float w0b0 = p.in[15][(l * 2 + 0) * 256 + c], w0b1 = p.in[15][(l * 2 + 1) * 256 + c];
#pragma unroll
            for (int i = 0; i < 16; ++i) { const int tok = hh * 16 + i; const size_t o = (size_t)(t0 + tok) * 256 + c;
                const float sg0 = sigmoidf_(w0b0 + O1[tok * 256 + c]), sg1 = sigmoidf_(w0b1 + O1[(32 + tok) * 256 + c]);
                RM0[o] = f2bf(1.f - __expf(-0.60653066f * sg0)); RM1[o] = f2bf(1.f - __expf(-0.60653066f * sg1)); }
        } else {
            const float a0b0 = p.in[17][(l * 2 + 0) * 256 + c], a0b1 = p.in[17][(l * 2 + 1) * 256 + c];
            const float ka = p.in[21][l * 256 + c], rk = p.in[22][l * 256 + c];
#pragma unroll
            for (int i = 0; i < 16; ++i) { const int tok = hh * 16 + i, row = t0 + tok; const size_t o = (size_t)row * 256 + c;
                const bf16_t kb = k_s[tok * 256 + c], vb = v_s[tok * 256 + c], rb = r_s[tok * 256 + c];
                const float k = bf2f(kb), r = bf2f(rb);
                const float a0 = sigmoidf_(a0b0 + O1[tok * 256 + c]), a1 = sigmoidf_(a0b1 + O1[(32 + tok) * 256 + c]);
                const float kt0 = k * (1.f + (a0 - 1.f) * ka), kt1 = k * (1.f + (a1 - 1.f) * ka);
                const float bs = wave_sum(r * (kt0 + kt1) * rk);
                RK[o] = kb; RV[o] = vb; RR[o] = rb; RA0[o] = f2bf(a0); RA1[o] = f2bf(a1);
                if ((tid & 63) == 0) BON[(size_t)row * 4 + h] = bs; }
        }
        __syncthreads();
    }
}
__device__ __forceinline__ int ret_chunk_index(int cr, int& b) { if (cr < 256) { b = cr >> 5; return 2 + (cr & 31); } b = (cr - 256) >> 1; return (cr - 256) & 1; }
__device__ __forceinline__ void ret_kv_item(const Params& p, LAS unsigned char* lds, int item) {
    const int tid = get_tid(), lane = tid & 63, wave = tid >> 6, fr = lane & 15, fq = lane >> 4;
    const bf16_t* P = (const bf16_t*)(p.ws + WS_P);
    const int cr = item >> 2, h = item & 3; int b; const int ci = ret_chunk_index(cr, b);
    const int r0 = cr * 128;
    LAS unsigned char* Ktf = lds;
    LAS unsigned char* Ktb = lds + 64 * 272;
    LAS unsigned char* Vt = lds + 2 * 64 * 272;
    const float lg2 = log1pf(-exp2f(-5.f - (float)h)) * 1.44269504f;
#pragma unroll
    for (int it = 0; it < 2; ++it) { const int pc = tid + it * 512, j = pc >> 3, c8 = pc & 7;
        const u32x4 kk = *(const u32x4*)(P + (size_t)(r0 + j) * NP + PC_RETK + h * 64 + c8 * 8);
        const u32x4 vv = *(const u32x4*)(P + (size_t)(r0 + j) * NP + PC_RETV + h * 64 + c8 * 8);
        float kf[8]; unpack8(kk, kf);
        const float df = 0.125f * __builtin_amdgcn_exp2f((float)(127 - j) * lg2), db = 0.125f * __builtin_amdgcn_exp2f((float)j * lg2);
        const unsigned vw[4] = {vv.x, vv.y, vv.z, vv.w};
#pragma unroll
        for (int x = 0; x < 8; ++x) { const int d = c8 * 8 + x;
            *(LAS bf16_t*)(Ktf + d * 272 + j * 2) = f2bf(kf[x] * df); *(LAS bf16_t*)(Ktb + d * 272 + j * 2) = f2bf(kf[x] * db);
            *(LAS bf16_t*)(Vt + d * 272 + j * 2) = (bf16_t)((x & 1) ? (vw[x >> 1] >> 16) : (vw[x >> 1] & 0xffff)); } }
    __syncthreads();
    const int dir = wave >> 2, mt = wave & 3;
    LAS unsigned char* A = dir ? Ktb : Ktf;
    bf16x8 af[4];
#pragma unroll
    for (int kc = 0; kc < 4; ++kc) af[kc] = *(const LAS bf16x8*)(A + (mt * 16 + fr) * 272 + kc * 64 + fq * 16);
    float* RS = (float*)(p.ws + WS_RET) + ((size_t)((b * 4 + h) * 34 + ci) * 2 + dir) * 4096;
#pragma unroll
    for (int nt = 0; nt < 4; ++nt) { f32x4 acc = (f32x4){0.f, 0.f, 0.f, 0.f};
#pragma unroll
        for (int kc = 0; kc < 4; ++kc) { const bf16x8 bf = *(const LAS bf16x8*)(Vt + (nt * 16 + fr) * 272 + kc * 64 + fq * 16);
            acc = __builtin_amdgcn_mfma_f32_16x16x32_bf16(af[kc], bf, acc, 0, 0, 0); }
#pragma unroll
        for (int r = 0; r < 4; ++r) RS[(mt * 16 + fq * 4 + r) * 64 + nt * 16 + fr] = acc[r]; }
    __syncthreads();
}
__device__ __forceinline__ void swa_prep_item(const Params& p, LAS unsigned char* lds, int tile) {
    const int tid = get_tid();
    bf16_t* P = (bf16_t*)(p.ws + WS_P);
    const float* tabc = (const float*)(p.ws + WS_TAB); const float* tabs = tabc + 1024;
    bf16_t* KS = (bf16_t*)(p.ws + WS_KS); bf16_t* VT = (bf16_t*)(p.ws + WS_VTS);
    const int t0 = tile * 64; const SeqInfo s0 = seq_of_row(t0);
    const int key0 = s0.isctx ? s0.pos : CTXL + s0.pos;
    LAS bf16_t* Vs = (LAS bf16_t*)lds;
    u32x4 vreg[2];
#pragma unroll
    for (int it = 0; it < 2; ++it) { const int pc = tid + it * 512, tok = pc >> 4, c8 = pc & 15; vreg[it] = *(const u32x4*)(P + (size_t)(t0 + tok) * NP + PC_SWAV + c8 * 8); }
    u32x4 x1[3], x2[3];
#pragma unroll
    for (int it = 0; it < 3; ++it) { const int e = tid + it * 512; const int tok = e / 24, rem = e % 24, hd = rem >> 2, axis = (rem >> 1) & 1, fg = rem & 1;
        const int colbase = (hd < 4 ? PC_SWAQ + hd * 64 : PC_SWAK + (hd - 4) * 64) + axis * 32 + fg * 8;
        x1[it] = *(const u32x4*)(P + (size_t)(t0 + tok) * NP + colbase); x2[it] = *(const u32x4*)(P + (size_t)(t0 + tok) * NP + colbase + 16); }
#pragma unroll
    for (int it = 0; it < 2; ++it) { const int pc = tid + it * 512, tok = pc >> 4, c8 = pc & 15; *(LAS u32x4*)(Vs + tok * 136 + c8 * 8) = vreg[it]; }
#pragma unroll
    for (int it = 0; it < 3; ++it) { const int e = tid + it * 512; const int tok = e / 24, rem = e % 24, hd = rem >> 2, axis = (rem >> 1) & 1, fg = rem & 1;
        const int row = t0 + tok, pos = s0.pos + tok;
        const int colbase = (hd < 4 ? PC_SWAQ + hd * 64 : PC_SWAK + (hd - 4) * 64) + axis * 32 + fg * 8;
        float a[8], bb[8]; unpack8(x1[it], a); unpack8(x2[it], bb);
        if (!s0.isctx) { const int pp = axis == 0 ? (pos >> 6) : (pos & 63);
            const f32x4 c0 = *(const f32x4*)(tabc + pp * 16 + fg * 8), c1 = *(const f32x4*)(tabc + pp * 16 + fg * 8 + 4), s0v = *(const f32x4*)(tabs + pp * 16 + fg * 8), s1v = *(const f32x4*)(tabs + pp * 16 + fg * 8 + 4);
            const float cs[8] = {c0.x, c0.y, c0.z, c0.w, c1.x, c1.y, c1.z, c1.w}, sn[8] = {s0v.x, s0v.y, s0v.z, s0v.w, s1v.x, s1v.y, s1v.z, s1v.w};
#pragma unroll
            for (int x = 0; x < 8; ++x) { const float y1 = a[x] * cs[x] - bb[x] * sn[x], y2 = bb[x] * cs[x] + a[x] * sn[x]; a[x] = y1; bb[x] = y2; } }
        u32x4 o1, o2; o1.x = pk2(a[0], a[1]); o1.y = pk2(a[2], a[3]); o1.z = pk2(a[4], a[5]); o1.w = pk2(a[6], a[7]);
        o2.x = pk2(bb[0], bb[1]); o2.y = pk2(bb[2], bb[3]); o2.z = pk2(bb[4], bb[5]); o2.w = pk2(bb[6], bb[7]);
        if (hd < 4) { if (!s0.isctx) { *(u32x4*)(P + (size_t)row * NP + colbase) = o1; *(u32x4*)(P + (size_t)row * NP + colbase + 16) = o2; } }
        else { bf16_t* kd = KS + ((size_t)(s0.b * 2 + (hd - 4)) * NKEYS + key0 + tok) * 64 + axis * 32 + fg * 8; *(u32x4*)kd = o1; *(u32x4*)(kd + 16) = o2; }
    }
    __syncthreads();
#pragma unroll
    for (int it = 0; it < 2; ++it) { const int pc = tid + it * 512, hd = pc >> 3, k8 = pc & 7, hk = hd >> 6, d = hd & 63;
        unsigned w[4];
#pragma unroll
        for (int x = 0; x < 4; ++x) w[x] = (unsigned)Vs[(k8 * 8 + 2 * x) * 136 + hd] | ((unsigned)Vs[(k8 * 8 + 2 * x + 1) * 136 + hd] << 16);
        *(u32x4*)(VT + ((size_t)(s0.b * 2 + hk) * 64 + d) * NKEYS + key0 + k8 * 8) = (u32x4){w[0], w[1], w[2], w[3]}; }
    __syncthreads();
}
__device__ __forceinline__ void mla_proj_item(const Params& p, int l, LAS unsigned char* lds, int tile);
__device__ __forceinline__ void phase_prepA(const Params& p, int l, LAS unsigned char* lds, int bid, int nb) {
    for (int it = bid; it < TT / 32; it += nb) rwkv_prep_item(p, l, lds, it);
}
__device__ __forceinline__ void prep_rest_items(const Params& p, int l, LAS unsigned char* lds, int first, int stride) {
    constexpr int N2 = 272 * 4, N3 = TT / 64, N4 = TT / 32;
    for (int it = first; it < N2 + N3 + N4; it += stride) {
        if (it < N4) mla_proj_item(p, l, lds, it);
        else if (it < N4 + N2) ret_kv_item(p, lds, it - N4);
        else swa_prep_item(p, lds, it - N4 - N2);
    }
}

__device__ __forceinline__ void mla_proj_item(const Params& p, int l, LAS unsigned char* lds, int tile) {
    const int tid = get_tid(), lane = tid & 63, wave = tid >> 6, fr = lane & 15, fq = lane >> 4;
    const bf16_t* P = (const bf16_t*)(p.ws + WS_P);
    const float* tabc = (const float*)(p.ws + WS_TAB) + 2048; const float* tabs = tabc + 512;
    const int t0 = tile * 32; const SeqInfo s0 = seq_of_row(t0);
    const int key0 = s0.isctx ? s0.pos : CTXL + s0.pos;
    LAS unsigned char* qn = lds;
    LAS unsigned char* kvn = lds + 32 * 528;
    LAS float* qo = (LAS float*)(lds + 32 * 528 + 32 * 272);
    LAS float* kvo = qo + 32 * 384;
    const float* qg = p.in[24] + l * 256; const float* kvg = p.in[26] + l * 128;
    for (int i = 0; i < 4; ++i) { const int tok = wave * 4 + i, row = t0 + tok;
        float x[4]; float ss = 0.f;
#pragma unroll
        for (int j = 0; j < 4; ++j) { x[j] = bf2f(P[(size_t)row * NP + PC_MLAQD + j * 64 + lane]); ss += x[j] * x[j]; }
        const float rq = 1.f / sqrtf(wave_sum(ss) * (1.f / 256.f) + 1e-6f);
#pragma unroll
        for (int j = 0; j < 4; ++j) *(LAS bf16_t*)(qn + tok * 528 + (j * 64 + lane) * 2) = f2bf(x[j] * rq * qg[j * 64 + lane]);
        float y[2]; float s2 = 0.f;
#pragma unroll
        for (int j = 0; j < 2; ++j) { y[j] = bf2f(P[(size_t)row * NP + PC_MLAKVD + j * 64 + lane]); s2 += y[j] * y[j]; }
        const float rk = 1.f / sqrtf(wave_sum(s2) * (1.f / 128.f) + 1e-6f);
#pragma unroll
        for (int j = 0; j < 2; ++j) *(LAS bf16_t*)(kvn + tok * 272 + (j * 64 + lane) * 2) = f2bf(y[j] * rk * kvg[j * 64 + lane]);
    }
    __syncthreads();
    {
        const bf16_t* WqT = (const bf16_t*)(p.ws + WS_MLAW + (size_t)l * MLAW_LAYER);
        const bf16_t* WkvT = (const bf16_t*)(p.ws + WS_MLAW + (size_t)l * MLAW_LAYER + MLAW_KV);
        {
            bf16x8 bq[3][8];
#pragma unroll
            for (int q = 0; q < 3; ++q) { const bf16_t* wrow = WqT + (size_t)((wave + 8 * q) * 16 + fr) * 256 + fq * 8;
#pragma unroll
                for (int kc = 0; kc < 8; ++kc) bq[q][kc] = *(const bf16x8*)(wrow + kc * 32); }
#pragma unroll
            for (int q = 0; q < 3; ++q) { const int nt = wave + 8 * q;
                f32x4 a0 = (f32x4){0.f, 0.f, 0.f, 0.f}, a1 = a0;
#pragma unroll
                for (int kc = 0; kc < 8; ++kc) { const bf16x8 x0 = *(const LAS bf16x8*)(qn + fr * 528 + kc * 64 + fq * 16), x1 = *(const LAS bf16x8*)(qn + (16 + fr) * 528 + kc * 64 + fq * 16);
                    a0 = __builtin_amdgcn_mfma_f32_16x16x32_bf16(x0, bq[q][kc], a0, 0, 0, 0); a1 = __builtin_amdgcn_mfma_f32_16x16x32_bf16(x1, bq[q][kc], a1, 0, 0, 0); }
#pragma unroll
                for (int r = 0; r < 4; ++r) { qo[(fq * 4 + r) * 384 + nt * 16 + fr] = a0[r]; qo[(16 + fq * 4 + r) * 384 + nt * 16 + fr] = a1[r]; } }
        }
        {
            bf16x8 bk[4][4];
#pragma unroll
            for (int q = 0; q < 4; ++q) { const bf16_t* wrow = WkvT + (size_t)((wave + 8 * q) * 16 + fr) * 128 + fq * 8;
#pragma unroll
                for (int kc = 0; kc < 4; ++kc) bk[q][kc] = *(const bf16x8*)(wrow + kc * 32); }
#pragma unroll
            for (int q = 0; q < 4; ++q) { const int n0 = (wave + 8 * q) * 16;
                f32x4 a0 = (f32x4){0.f, 0.f, 0.f, 0.f}, a1 = a0;
#pragma unroll
                for (int kc = 0; kc < 4; ++kc) { const bf16x8 x0 = *(const LAS bf16x8*)(kvn + fr * 272 + kc * 64 + fq * 16), x1 = *(const LAS bf16x8*)(kvn + (16 + fr) * 272 + kc * 64 + fq * 16);
                    a0 = __builtin_amdgcn_mfma_f32_16x16x32_bf16(x0, bk[q][kc], a0, 0, 0, 0); a1 = __builtin_amdgcn_mfma_f32_16x16x32_bf16(x1, bk[q][kc], a1, 0, 0, 0); }
#pragma unroll
                for (int r = 0; r < 4; ++r) { kvo[(fq * 4 + r) * 512 + n0 + fr] = a0[r]; kvo[(16 + fq * 4 + r) * 512 + n0 + fr] = a1[r]; } }
        }
    }
    __syncthreads();
    {
        const int h = tid >> 7, dd = tid & 127;
        if (dd < 64) { bf16_t* KM = (bf16_t*)(p.ws + WS_KM) + ((size_t)(s0.b * 4 + h) * NKEYS + key0) * 96 + dd;
#pragma unroll
            for (int i = 0; i < 32; ++i) KM[(size_t)i * 96] = f2bf(kvo[i * 512 + tid]); }
        else { bf16_t* VT = (bf16_t*)(p.ws + WS_VTM) + ((size_t)(s0.b * 4 + h) * 64 + (dd - 64)) * NKEYS + key0;
            unsigned w[16];
#pragma unroll
            for (int i = 0; i < 16; ++i) w[i] = pk2(kvo[(2 * i) * 512 + tid], kvo[(2 * i + 1) * 512 + tid]);
#pragma unroll
            for (int i = 0; i < 4; ++i) *(u32x4*)(VT + i * 8) = (u32x4){w[4 * i], w[4 * i + 1], w[4 * i + 2], w[4 * i + 3]}; }
    }
    bf16_t* MQ = (bf16_t*)(p.ws + WS_MQ);
    for (int e = tid; e < 32 * 384; e += 512) { const int tok = e / 384, c = e % 384, dd = c % 96; const int pos = s0.pos + tok;
        float v = qo[e];
        if (dd >= 64 && !s0.isctx) { const int pe = dd - 64, axis = pe >> 4, half = (pe >> 3) & 1, f = pe & 7; const int pp = axis == 0 ? (pos >> 6) : (pos & 63);
            const float cs = tabc[pp * 8 + f], sn = tabs[pp * 8 + f];
            const float x1 = half ? qo[e - 8] : v, x2 = half ? v : qo[e + 8];
            v = half ? (x2 * cs + x1 * sn) : (x1 * cs - x2 * sn); }
        MQ[(size_t)(t0 + tok) * 384 + c] = f2bf(v); }
    for (int e = tid; e < 32 * 32; e += 512) { const int tok = e >> 5, pe = e & 31, axis = pe >> 4, half = (pe >> 3) & 1, f = pe & 7; const int row = t0 + tok, pos = s0.pos + tok;
        float v = bf2f(P[(size_t)row * NP + PC_MLAKPE + pe]);
        if (!s0.isctx) { const int pp = axis == 0 ? (pos >> 6) : (pos & 63); const float cs = tabc[pp * 8 + f], sn = tabs[pp * 8 + f];
            const float other = bf2f(P[(size_t)row * NP + PC_MLAKPE + (half ? pe - 8 : pe + 8)]);
            const float x1 = half ? other : v, x2 = half ? v : other;
            v = half ? (x2 * cs + x1 * sn) : (x1 * cs - x2 * sn); }
        const bf16_t o = f2bf(v);
#pragma unroll
        for (int h = 0; h < 4; ++h) ((bf16_t*)(p.ws + WS_KM))[((size_t)(s0.b * 4 + h) * NKEYS + key0 + tok) * 96 + 64 + pe] = o; }
    __syncthreads();
}
__device__ __forceinline__ void ret_scan_item(const Params& p, int l, int item) {
    const int tid = get_tid(); const int seq = item >> 1, dir = item & 1, h = seq & 3;
    const float lg = log1pf(-exp2f(-5.f - (float)h)); const float cdec = expf(128.f * lg);
    float* base = (float*)(p.ws + WS_RET) + (size_t)seq * 34 * 2 * 4096 + dir * 4096;
    auto ci_of = [&](int st) -> int { return dir == 0 ? st : (st == 0 ? 1 : (st == 1 ? 0 : 35 - st)); };
    float S[8];
#pragma unroll
    for (int i = 0; i < 8; ++i) S[i] = 0.f;
    f32x4 pa[4], pb[4];
#pragma unroll
    for (int k = 0; k < 4; ++k) { const float* q = base + (size_t)ci_of(k) * 2 * 4096 + tid * 8; pa[k] = *(const f32x4*)q; pb[k] = *(const f32x4*)(q + 4); }
#pragma unroll 1
    for (int st0 = 0; st0 < 36; st0 += 4) {
#pragma unroll
        for (int k = 0; k < 4; ++k) { const int st = st0 + k;
            if (st < 34) {
                float* q = base + (size_t)ci_of(st) * 2 * 4096 + tid * 8;
                const f32x4 t0 = pa[k], t1 = pb[k];
                if (st + 4 < 34) { const float* qn = base + (size_t)ci_of(st + 4) * 2 * 4096 + tid * 8; pa[k] = *(const f32x4*)qn; pb[k] = *(const f32x4*)(qn + 4); }
                *(f32x4*)q = (f32x4){S[0], S[1], S[2], S[3]}; *(f32x4*)(q + 4) = (f32x4){S[4], S[5], S[6], S[7]};
                S[0] = S[0] * cdec + t0.x; S[1] = S[1] * cdec + t0.y; S[2] = S[2] * cdec + t0.z; S[3] = S[3] * cdec + t0.w;
                S[4] = S[4] * cdec + t1.x; S[5] = S[5] * cdec + t1.y; S[6] = S[6] * cdec + t1.z; S[7] = S[7] * cdec + t1.w;
            } }
    }
    asm volatile("s_waitcnt vmcnt(0)" ::: "memory");
    __syncthreads();
    if (tid == 0) { __builtin_amdgcn_fence(__ATOMIC_RELEASE, "agent"); asm volatile("s_waitcnt vmcnt(0)" ::: "memory");
        __hip_atomic_fetch_add((unsigned*)(p.ws + WS_CTR) + 2 + l, 1u, __ATOMIC_RELAXED, __HIP_MEMORY_SCOPE_AGENT); }
}
__device__ __forceinline__ void wait_counter(const Params& p, int idx, unsigned need) {
    if (get_tid() == 0) { unsigned* f = (unsigned*)(p.ws + WS_CTR) + idx; unsigned sp = 0;
        while (__hip_atomic_load(f, __ATOMIC_RELAXED, __HIP_MEMORY_SCOPE_AGENT) < need) { __builtin_amdgcn_s_sleep(4); if (++sp > (1u << 22)) break; }
        __builtin_amdgcn_fence(__ATOMIC_ACQUIRE, "agent"); asm volatile("s_waitcnt vmcnt(0)" ::: "memory"); }
    __syncthreads();
}
template <int DK>
__device__ __forceinline__ void attn_unit(const bf16_t* Q, int qstride, const bf16_t* K, const bf16_t* Vt, int nctx, int mt0, int mt1, bool masked, int qpos0,
                                          bool has_sink, float sink, float scale, bf16_t* O, int ostride, LAS unsigned char* lds) {
    constexpr int KC = DK / 32, KP = DK + 8, KROW = KP * 2;
    constexpr int PIECES_K = 64 * DK / 8;
    constexpr int BUFB = 64 * KROW + 64 * 144;
    const int tid = get_tid(), lane = tid & 63, wave = tid >> 6, fr = lane & 15, fq = lane >> 4;
    const float sl2 = scale * 1.44269504f;
    bf16x8 qf[2][KC];
#pragma unroll
    for (int g = 0; g < 2; ++g)
#pragma unroll
        for (int kc = 0; kc < KC; ++kc) { const u32x4 u = *(const u32x4*)(Q + (size_t)(wave * 32 + g * 16 + fr) * qstride + kc * 32 + fq * 8); float f[8]; unpack8(u, f);
            u32x4 o; o.x = cvt_pk_bf16(f[0] * sl2, f[1] * sl2); o.y = cvt_pk_bf16(f[2] * sl2, f[3] * sl2); o.z = cvt_pk_bf16(f[4] * sl2, f[5] * sl2); o.w = cvt_pk_bf16(f[6] * sl2, f[7] * sl2);
            qf[g][kc] = __builtin_bit_cast(bf16x8, o); }
    float mq[2] = {0.f, 0.f}, lsum[2] = {0.f, 0.f}; f32x4 o[2][4];
#pragma unroll
    for (int g = 0; g < 2; ++g)
#pragma unroll
        for (int n = 0; n < 4; ++n) o[g][n] = (f32x4){0.f, 0.f, 0.f, 0.f};
    const int ntiles = nctx + (mt1 - mt0);
    u32x4 kr[2], vr;
    auto issue = [&](int ti) {
        const int tile = ti < nctx ? ti : mt0 + (ti - nctx);
        const bf16_t* kb = K + (size_t)tile * 64 * DK;
#pragma unroll
        for (int i = 0; i < 2; ++i) { const int pc = tid + i * 512; if (pc < PIECES_K) kr[i] = *(const u32x4*)(kb + (size_t)pc * 8); }
        { const int d = tid >> 3, c8 = tid & 7; vr = *(const u32x4*)(Vt + (size_t)d * NKEYS + tile * 64 + c8 * 8); }
    };
    auto stash = [&](int bufi) {
        LAS unsigned char* Kt = lds + bufi * BUFB; LAS unsigned char* Vl = Kt + 64 * KROW;
#pragma unroll
        for (int i = 0; i < 2; ++i) { const int pc = tid + i * 512; if (pc < PIECES_K) { const int row = pc / (DK / 8), c8 = pc % (DK / 8); *(LAS u32x4*)(Kt + row * KROW + c8 * 16) = kr[i]; } }
        { const int d = tid >> 3, c8 = tid & 7; *(LAS u32x4*)(Vl + d * 144 + c8 * 16) = vr; }
    };
    issue(0); stash(0);
    if (ntiles > 1) issue(1);
    __syncthreads();
    for (int ti = 0; ti < ntiles; ++ti) {
        const int tile = ti < nctx ? ti : mt0 + (ti - nctx);
        LAS unsigned char* Kt = lds + (ti & 1) * BUFB; LAS unsigned char* Vl = Kt + 64 * KROW;
        if (ti + 1 < ntiles) { stash((ti + 1) & 1); if (ti + 2 < ntiles) issue(ti + 2); }
        f32x4 s[2][4];
#pragma unroll
        for (int n = 0; n < 4; ++n) {
            s[0][n] = (f32x4){-mq[0], -mq[0], -mq[0], -mq[0]}; s[1][n] = (f32x4){-mq[1], -mq[1], -mq[1], -mq[1]};
#pragma unroll
            for (int kc = 0; kc < KC; ++kc) { const bf16x8 kf = *(const LAS bf16x8*)(Kt + (n * 16 + fr) * KROW + kc * 64 + fq * 16);
                s[0][n] = __builtin_amdgcn_mfma_f32_16x16x32_bf16(kf, qf[0][kc], s[0][n], 0, 0, 0);
                s[1][n] = __builtin_amdgcn_mfma_f32_16x16x32_bf16(kf, qf[1][kc], s[1][n], 0, 0, 0); } }
        if (ti == 0) {
#pragma unroll
            for (int g = 0; g < 2; ++g) {
                float t = -INFINITY;
#pragma unroll
                for (int n = 0; n < 4; ++n)
#pragma unroll
                    for (int r = 0; r < 4; ++r) t = fmaxf(t, s[g][n][r]);
                t = fmaxf(t, __shfl_xor(t, 16)); t = fmaxf(t, __shfl_xor(t, 32));
                if (has_sink) t = fmaxf(t, sink * 1.44269504f);
                mq[g] = t;
#pragma unroll
                for (int n = 0; n < 4; ++n)
#pragma unroll
                    for (int r = 0; r < 4; ++r) s[g][n][r] -= t;
            }
        }
        if (masked && ti >= nctx) {
#pragma unroll
            for (int g = 0; g < 2; ++g)
#pragma unroll
                for (int n = 0; n < 4; ++n)
#pragma unroll
                    for (int r = 0; r < 4; ++r) { const int kp = tile * 64 + n * 16 + fq * 4 + r - CTXL, qp = qpos0 + wave * 32 + g * 16 + fr; const int df = qp - kp; if (df > 128 || df < -128) s[g][n][r] = -INFINITY; }
        }
#pragma unroll
        for (int g = 0; g < 2; ++g)
#pragma unroll
            for (int n = 0; n < 4; ++n)
#pragma unroll
                for (int r = 0; r < 4; ++r) { s[g][n][r] = __builtin_amdgcn_exp2f(s[g][n][r]); lsum[g] += s[g][n][r]; }
#pragma unroll
        for (int c = 0; c < 2; ++c) {
            bf16x8 pf[2];
#pragma unroll
            for (int g = 0; g < 2; ++g) { u32x4 pu; pu.x = cvt_pk_bf16(s[g][2 * c][0], s[g][2 * c][1]); pu.y = cvt_pk_bf16(s[g][2 * c][2], s[g][2 * c][3]);
                pu.z = cvt_pk_bf16(s[g][2 * c + 1][0], s[g][2 * c + 1][1]); pu.w = cvt_pk_bf16(s[g][2 * c + 1][2], s[g][2 * c + 1][3]); pf[g] = __builtin_bit_cast(bf16x8, pu); }
#pragma unroll
            for (int n = 0; n < 4; ++n) {
                const u32x2 lo = *(const LAS u32x2*)(Vl + (n * 16 + fr) * 144 + ((2 * c) * 16 + fq * 4) * 2), hi = *(const LAS u32x2*)(Vl + (n * 16 + fr) * 144 + ((2 * c + 1) * 16 + fq * 4) * 2);
                const bf16x8 vf = __builtin_bit_cast(bf16x8, (u32x4){lo.x, lo.y, hi.x, hi.y});
                o[0][n] = __builtin_amdgcn_mfma_f32_16x16x32_bf16(vf, pf[0], o[0][n], 0, 0, 0);
                o[1][n] = __builtin_amdgcn_mfma_f32_16x16x32_bf16(vf, pf[1], o[1][n], 0, 0, 0); }
        }
        __syncthreads();
    }
#pragma unroll
    for (int g = 0; g < 2; ++g) {
        float t = lsum[g];
        t += __shfl_xor(t, 16); t += __shfl_xor(t, 32);
        if (has_sink) t += __builtin_amdgcn_exp2f(sink * 1.44269504f - mq[g]);
        const float inv = 1.f / t;
#pragma unroll
        for (int n = 0; n < 4; ++n) { u32x2 ov; ov.x = cvt_pk_bf16(o[g][n][0] * inv, o[g][n][1] * inv); ov.y = cvt_pk_bf16(o[g][n][2] * inv, o[g][n][3] * inv);
            *(u32x2*)(O + (size_t)(wave * 32 + g * 16 + fr) * ostride + n * 16 + fq * 4) = ov; }
    }
}

__device__ __forceinline__ void ret_out_item(const Params& p, int l, LAS unsigned char* lds, int item) {
    const int tid = get_tid(), lane = tid & 63, wave = tid >> 6, fr = lane & 15, fq = lane >> 4;
    bf16_t* P = (bf16_t*)(p.ws + WS_P);
    const int cr = item >> 2, h = item & 3; int b; const int ci = ret_chunk_index(cr, b);
    const int r0 = cr * 128;
    const float lg2 = log1pf(-exp2f(-5.f - (float)h)) * 1.44269504f;
    LAS unsigned char* Kb = lds;
    LAS unsigned char* Vt = lds + 18432;
    LAS unsigned char* SfT = lds + 35840;
    LAS unsigned char* SbT = lds + 45056;
    for (int pc = tid; pc < 1024; pc += 512) { const int j = pc >> 3, c8 = pc & 7;
        const u32x4 kk = *(const u32x4*)(P + (size_t)(r0 + j) * NP + PC_RETK + h * 64 + c8 * 8);
        const u32x4 vv = *(const u32x4*)(P + (size_t)(r0 + j) * NP + PC_RETV + h * 64 + c8 * 8);
        float kf[8]; unpack8(kk, kf);
        u32x4 ko; ko.x = pk2(kf[0] * 0.125f, kf[1] * 0.125f); ko.y = pk2(kf[2] * 0.125f, kf[3] * 0.125f); ko.z = pk2(kf[4] * 0.125f, kf[5] * 0.125f); ko.w = pk2(kf[6] * 0.125f, kf[7] * 0.125f);
        *(LAS u32x4*)(Kb + j * 144 + c8 * 16) = ko;
        const unsigned vw[4] = {vv.x, vv.y, vv.z, vv.w};
#pragma unroll
        for (int x = 0; x < 8; ++x) *(LAS bf16_t*)(Vt + (c8 * 8 + x) * 272 + j * 2) = (bf16_t)((x & 1) ? (vw[x >> 1] >> 16) : (vw[x >> 1] & 0xffff)); }
    { const float* RS = (const float*)(p.ws + WS_RET) + ((size_t)((b * 4 + h) * 34 + ci) * 2) * 4096;
      for (int pc = tid; pc < 1024; pc += 512) { const int d = pc >> 4, e4 = (pc & 15) * 4;
          const f32x4 a = *(const f32x4*)(RS + d * 64 + e4), bb = *(const f32x4*)(RS + 4096 + d * 64 + e4);
#pragma unroll
          for (int x = 0; x < 4; ++x) { *(LAS bf16_t*)(SfT + (e4 + x) * 144 + d * 2) = f2bf(a[x]); *(LAS bf16_t*)(SbT + (e4 + x) * 144 + d * 2) = f2bf(bb[x]); } } }
    const int i = wave * 16 + fr;
    u32x4 qraw[2];
#pragma unroll
    for (int kc = 0; kc < 2; ++kc) qraw[kc] = *(const u32x4*)(P + (size_t)(r0 + i) * NP + PC_RETQ + h * 64 + kc * 32 + fq * 8);
    __syncthreads();
    f32x4 s[8];
#pragma unroll
    for (int nb = 0; nb < 8; ++nb) { s[nb] = (f32x4){0.f, 0.f, 0.f, 0.f};
#pragma unroll
        for (int kc = 0; kc < 2; ++kc) { const bf16x8 kf = *(const LAS bf16x8*)(Kb + (nb * 16 + fr) * 144 + kc * 64 + fq * 16);
            s[nb] = __builtin_amdgcn_mfma_f32_16x16x32_bf16(kf, __builtin_bit_cast(bf16x8, qraw[kc]), s[nb], 0, 0, 0); } }
#pragma unroll
    for (int nb = 0; nb < 8; ++nb)
#pragma unroll
        for (int r = 0; r < 4; ++r) { const int j = nb * 16 + fq * 4 + r; const int df = i - j; const int adf = df < 0 ? -df : df;
            float dcy = __builtin_amdgcn_exp2f((float)adf * lg2); if (df == 0) dcy = 2.f; s[nb][r] *= dcy; }
    f32x4 o[4];
#pragma unroll
    for (int n = 0; n < 4; ++n) o[n] = (f32x4){0.f, 0.f, 0.f, 0.f};
#pragma unroll
    for (int c = 0; c < 4; ++c) {
        u32x4 pu; pu.x = cvt_pk_bf16(s[2 * c][0], s[2 * c][1]); pu.y = cvt_pk_bf16(s[2 * c][2], s[2 * c][3]); pu.z = cvt_pk_bf16(s[2 * c + 1][0], s[2 * c + 1][1]); pu.w = cvt_pk_bf16(s[2 * c + 1][2], s[2 * c + 1][3]);
        const bf16x8 pf = __builtin_bit_cast(bf16x8, pu);
#pragma unroll
        for (int n = 0; n < 4; ++n) {
            const u32x2 lo = *(const LAS u32x2*)(Vt + (n * 16 + fr) * 272 + ((2 * c) * 16 + fq * 4) * 2), hi = *(const LAS u32x2*)(Vt + (n * 16 + fr) * 272 + ((2 * c + 1) * 16 + fq * 4) * 2);
            const bf16x8 vf = __builtin_bit_cast(bf16x8, (u32x4){lo.x, lo.y, hi.x, hi.y});
            o[n] = __builtin_amdgcn_mfma_f32_16x16x32_bf16(vf, pf, o[n], 0, 0, 0); }
    }
    const float gf = __builtin_amdgcn_exp2f((float)(i + 1) * lg2), gb = __builtin_amdgcn_exp2f((float)(128 - i) * lg2);
#pragma unroll
    for (int kc = 0; kc < 2; ++kc) {
        float f[8]; unpack8(qraw[kc], f);
        u32x4 uf, ub;
        uf.x = cvt_pk_bf16(f[0] * gf, f[1] * gf); uf.y = cvt_pk_bf16(f[2] * gf, f[3] * gf); uf.z = cvt_pk_bf16(f[4] * gf, f[5] * gf); uf.w = cvt_pk_bf16(f[6] * gf, f[7] * gf);
        ub.x = cvt_pk_bf16(f[0] * gb, f[1] * gb); ub.y = cvt_pk_bf16(f[2] * gb, f[3] * gb); ub.z = cvt_pk_bf16(f[4] * gb, f[5] * gb); ub.w = cvt_pk_bf16(f[6] * gb, f[7] * gb);
        const bf16x8 qF = __builtin_bit_cast(bf16x8, uf), qB = __builtin_bit_cast(bf16x8, ub);
#pragma unroll
        for (int n = 0; n < 4; ++n) {
            const bf16x8 af = *(const LAS bf16x8*)(SfT + (n * 16 + fr) * 144 + kc * 64 + fq * 16), ab = *(const LAS bf16x8*)(SbT + (n * 16 + fr) * 144 + kc * 64 + fq * 16);
            o[n] = __builtin_amdgcn_mfma_f32_16x16x32_bf16(af, qF, o[n], 0, 0, 0);
            o[n] = __builtin_amdgcn_mfma_f32_16x16x32_bf16(ab, qB, o[n], 0, 0, 0); }
    }
    float sm = 0.f;
#pragma unroll
    for (int n = 0; n < 4; ++n) sm += (o[n][0] + o[n][1]) + (o[n][2] + o[n][3]);
    sm += __shfl_xor(sm, 16); sm += __shfl_xor(sm, 32);
    const float mu = sm * (1.f / 64.f);
    float vs = 0.f;
#pragma unroll
    for (int n = 0; n < 4; ++n)
#pragma unroll
        for (int r = 0; r < 4; ++r) { const float dl = o[n][r] - mu; vs += dl * dl; }
    vs += __shfl_xor(vs, 16); vs += __shfl_xor(vs, 32);
    const float rstd = 1.f / sqrtf(vs * (1.f / 64.f) + 1e-5f);
#pragma unroll
    for (int n = 0; n < 4; ++n) { const int e0 = n * 16 + fq * 4;
        const u32x2 gu = *(const u32x2*)(P + (size_t)(r0 + i) * NP + PC_RETG + h * 64 + e0);
        const f32x4 gn = *(const f32x4*)(p.in[13] + l * 256 + h * 64 + e0);
        const float g0 = bf2f((bf16_t)(gu.x & 0xffff)), g1 = bf2f((bf16_t)(gu.x >> 16)), g2 = bf2f((bf16_t)(gu.y & 0xffff)), g3 = bf2f((bf16_t)(gu.y >> 16));
        u32x2 yo;
        yo.x = cvt_pk_bf16((o[n][0] - mu) * rstd * gn.x * (g0 / (1.f + __expf(-g0))), (o[n][1] - mu) * rstd * gn.y * (g1 / (1.f + __expf(-g1))));
        yo.y = cvt_pk_bf16((o[n][2] - mu) * rstd * gn.z * (g2 / (1.f + __expf(-g2))), (o[n][3] - mu) * rstd * gn.w * (g3 / (1.f + __expf(-g3))));
        *(u32x2*)(P + (size_t)(r0 + i) * NP + PC_RETQ + h * 64 + e0) = yo; }
    __syncthreads();
}

constexpr int NSCANBLK = 128;
__device__ __forceinline__ void rwkv_scan_item(const Params& p, int l, LAS unsigned char* lds, int item) {
    const int tid = get_tid();
    const int sc = item >> 1, half = item & 1;
    const int b = sc >> 3, h = (sc >> 1) & 3, dir = sc & 1;
    const bf16_t* RK = (const bf16_t*)(p.ws + WS_RWK); const bf16_t* RV = (const bf16_t*)(p.ws + WS_RWV); const bf16_t* RR = (const bf16_t*)(p.ws + WS_RWRR);
    const bf16_t* RA = (const bf16_t*)(p.ws + (dir ? WS_RWA1 : WS_RWA0)); const bf16_t* RM = (const bf16_t*)(p.ws + (dir ? WS_RWM1 : WS_RWM0));
    bf16_t* P = (bf16_t*)(p.ws + WS_P);
    const int ocol = (dir ? PC_RWO1 : PC_RWO0) + h * 64 + half * 32;
    LAS float* KH = (LAS float*)lds;
    LAS float* WW = KH + 4096; LAS float* BB = WW + 4096; LAS float* KT = BB + 4096; LAS float* RRl = KT + 4096; LAS float* VV = RRl + 4096; LAS float* OUT = VV + 4096;
    const int st = tid >> 3, c0 = (tid & 7) * 8;
    float kkp[8], kap[8];
#pragma unroll
    for (int i = 0; i < 8; ++i) { kkp[i] = p.in[20][l * 256 + h * 64 + c0 + i]; kap[i] = p.in[21][l * 256 + h * 64 + c0 + i]; }
    const int row_l = tid >> 4, kq = tid & 15;
    f32x2 S[2];
#pragma unroll
    for (int i = 0; i < 2; ++i) S[i] = (f32x2){0.f, 0.f};
    auto row_of = [&](int s) -> int {
        if (s < CTXL) return TMAIN + b * CTXL + (dir ? CTXL - 1 - s : s);
        const int t = s - CTXL; return b * SEQL + (dir ? SEQL - 1 - t : t);
    };
    u32x4 gk, gv, gr, ga, gm;
    auto issue = [&](int ch) { const size_t o = (size_t)row_of(ch * 64 + st) * 256 + h * 64 + c0;
        gk = *(const u32x4*)(RK + o); gv = *(const u32x4*)(RV + o); gr = *(const u32x4*)(RR + o); ga = *(const u32x4*)(RA + o); gm = *(const u32x4*)(RM + o); };
    issue(0);
    for (int ch = 0; ch < 68; ++ch) {
        {
            float k[8], a[8], om[8], rr[8], vv8[8]; unpack8(gk, k); unpack8(ga, a); unpack8(gm, om); unpack8(gr, rr); unpack8(gv, vv8);
            float kk[8]; float n2 = 0.f;
#pragma unroll
            for (int i = 0; i < 8; ++i) { kk[i] = k[i] * kkp[i]; n2 += kk[i] * kk[i]; }
            n2 = red8(n2);
            const float rn = 1.f / sqrtf(fmaxf(n2, 1e-12f));
            f32x4 o0, o1;
#define ST8(DST, EXPR) { float t8[8]; _Pragma("unroll") for (int i = 0; i < 8; ++i) t8[i] = (EXPR); \
            *(LAS f32x4*)(DST + st * 64 + c0) = (f32x4){t8[0], t8[1], t8[2], t8[3]}; *(LAS f32x4*)(DST + st * 64 + c0 + 4) = (f32x4){t8[4], t8[5], t8[6], t8[7]}; }
            ST8(KH, kk[i] * rn)
            ST8(WW, 1.f - om[i])
            ST8(BB, kk[i] * rn * a[i])
            ST8(KT, k[i] * (1.f + (a[i] - 1.f) * kap[i]))
            ST8(RRl, rr[i])
            ST8(VV, vv8[i])
#undef ST8
        }
        __syncthreads();
        if (ch + 1 < 68) issue(ch + 1);
        {
            struct Ops { f32x4 kh, w, b, t, r; float vv; };
            auto ldops = [&](int s) -> Ops { Ops q;
                q.kh = *(const LAS f32x4*)(KH + s * 64 + kq * 4); q.w = *(const LAS f32x4*)(WW + s * 64 + kq * 4); q.b = *(const LAS f32x4*)(BB + s * 64 + kq * 4);
                q.t = *(const LAS f32x4*)(KT + s * 64 + kq * 4); q.r = *(const LAS f32x4*)(RRl + s * 64 + kq * 4);
                q.vv = VV[s * 64 + half * 32 + row_l]; return q; };
            Ops nx = ldops(0);
#pragma unroll 2
            for (int s = 0; s < 64; ++s) {
                const Ops c = nx;
                nx = ldops(s + 1 < 64 ? s + 1 : 63);
                f32x2 a2 = S[0] * (f32x2){c.kh.x, c.kh.y}; a2 = S[1] * (f32x2){c.kh.z, c.kh.w} + a2;
                const float sk = red16(a2.x + a2.y);
                const f32x2 nsk = (f32x2){-sk, -sk}, vv2 = (f32x2){c.vv, c.vv};
                S[0] = S[0] * (f32x2){c.w.x, c.w.y} + (nsk * (f32x2){c.b.x, c.b.y} + vv2 * (f32x2){c.t.x, c.t.y});
                S[1] = S[1] * (f32x2){c.w.z, c.w.w} + (nsk * (f32x2){c.b.z, c.b.w} + vv2 * (f32x2){c.t.z, c.t.w});
                f32x2 o2 = S[0] * (f32x2){c.r.x, c.r.y}; o2 = S[1] * (f32x2){c.r.z, c.r.w} + o2;
                const float ov = red16(o2.x + o2.y);
                if (kq == 0) OUT[s * 32 + row_l] = ov;
            }
        }
        __syncthreads();
        { const int c4 = (tid & 7) * 4; const f32x4 ov = *(const LAS f32x4*)(OUT + st * 32 + c4);
          u32x2 o2; o2.x = pk2(ov.x, ov.y); o2.y = pk2(ov.z, ov.w);
          *(u32x2*)(P + (size_t)row_of(ch * 64 + st) * NP + ocol + c4) = o2; }
    }
    __syncthreads();
}

__device__ __forceinline__ void mixer_mla(const Params& p, LAS unsigned char* lds, int it) {
    bf16_t* P = (bf16_t*)(p.ws + WS_P);
    const bf16_t* MQ = (const bf16_t*)(p.ws + WS_MQ);
    int b, h, row0, nm1;
    if (it < 512) { b = it >> 6; h = (it >> 4) & 3; row0 = b * SEQL + (it & 15) * 256; nm1 = 68; }
    else { const int u = it - 512; b = u >> 2; h = u & 3; row0 = TMAIN + b * CTXL; nm1 = 4; }
    attn_unit<96>(MQ + (size_t)row0 * 384 + h * 96, 384, (const bf16_t*)(p.ws + WS_KM) + (size_t)(b * 4 + h) * NKEYS * 96, (const bf16_t*)(p.ws + WS_VTM) + (size_t)(b * 4 + h) * 64 * NKEYS,
                  4, 4, nm1, false, 0, false, 0.f, 0.10206207f, P + (size_t)row0 * NP + PC_MLAQD + h * 64, NP, lds);
}
__device__ __forceinline__ void mixer_swa(const Params& p, int l, LAS unsigned char* lds, int u0) {
    bf16_t* P = (bf16_t*)(p.ws + WS_P);
    int b, h, row0, nm0, nm1, qp0; bool msk;
    if (u0 < 512) { b = u0 >> 6; h = (u0 >> 4) & 3; const int qb = u0 & 15; row0 = b * SEQL + qb * 256; nm0 = 4 + 4 * qb - 2; nm1 = 4 + 4 * qb + 6; if (nm0 < 4) nm0 = 4; if (nm1 > 68) nm1 = 68; qp0 = qb * 256; msk = true; }
    else { const int u = u0 - 512; b = u >> 2; h = u & 3; row0 = TMAIN + b * CTXL; nm0 = 4; nm1 = 4; qp0 = 0; msk = false; }
    const int hk = h >> 1;
    bf16_t* qp = P + (size_t)row0 * NP + PC_SWAQ + h * 64;
    attn_unit<64>(qp, NP, (const bf16_t*)(p.ws + WS_KS) + (size_t)(b * 2 + hk) * NKEYS * 64, (const bf16_t*)(p.ws + WS_VTS) + (size_t)(b * 2 + hk) * 64 * NKEYS,
                  4, nm0, nm1, msk, qp0, true, p.in[12][l * 4 + h], 0.125f, qp, NP, lds);
}
__device__ __forceinline__ void phase_mixers(const Params& p, int l, LAS unsigned char* lds, int bid, int nb) {
    const bool ectx = (l == 0);
    const int N_MLA = 512 + (ectx ? 32 : 0), N_SWA = 512 + (ectx ? 32 : 0), N_RET = 1024 + (ectx ? 64 : 0);
    if (bid < NSCANBLK) rwkv_scan_item(p, l, lds, bid);
    else {
        prep_rest_items(p, l, lds, bid - NSCANBLK, nb - NSCANBLK);
        asm volatile("s_waitcnt vmcnt(0)" ::: "memory");
        __syncthreads();
        if (get_tid() == 0) { __builtin_amdgcn_fence(__ATOMIC_RELEASE, "agent"); asm volatile("s_waitcnt vmcnt(0)" ::: "memory");
            __hip_atomic_fetch_add((unsigned*)(p.ws + WS_CTR) + 4 + l, 1u, __ATOMIC_RELAXED, __HIP_MEMORY_SCOPE_AGENT); }
        if (bid < NSCANBLK + 64) { wait_counter(p, 4 + l, (unsigned)(nb - NSCANBLK)); ret_scan_item(p, l, bid - NSCANBLK); }
    }
    wait_counter(p, 4 + l, (unsigned)(nb - NSCANBLK));
    bool ret_ready = false;
    unsigned* ctr = (unsigned*)(p.ws + WS_CTR) + l;
    LAS unsigned* slot = (LAS unsigned*)(lds + LDS_BYTES - 16);
    const int tid0 = get_tid();
    for (;;) {
        __syncthreads();
        if (tid0 == 0) *slot = atomicAdd(ctr, 1u);
        __syncthreads();
        const int it = (int)*slot;
        if (it >= N_MLA + N_SWA + N_RET) break;
        if (it < N_MLA) mixer_mla(p, lds, it);
        else if (it < N_MLA + N_SWA) mixer_swa(p, l, lds, it - N_MLA);
        else { if (!ret_ready) { wait_counter(p, 2 + l, 64u); ret_ready = true; } ret_out_item(p, l, lds, it - N_MLA - N_SWA); }
    }
}

__device__ __forceinline__ void phase_rwkv_finish(const Params& p, int l, LAS unsigned char* lds, int bid, int nb) {
    const int tid = get_tid();
    bf16_t* P = (bf16_t*)(p.ws + WS_P);
    const int ntiles = (l == 0 ? TT : TMAIN) / 32;
    const float* mu = p.in[14] + l * 1024 + 896;
    const float* gup = p.in[19] + (size_t)l * 128 * 256;
    const bf16_t* RV = (const bf16_t*)(p.ws + WS_RWV); const float* BON = (const float*)(p.ws + WS_BON);
    for (int tile = bid; tile < ntiles; tile += nb) {
        const int t0 = tile * 32; const SeqInfo s0 = seq_of_row(t0);
        LAS unsigned char* sgb = lds;
        LAS float* gout = (LAS float*)(lds + 32 * 272);
        { const int tok = tid >> 4, j8 = (tid & 15) * 8; const int row = t0 + tok, pos = s0.pos + tok;
          const u32x4 u0 = *(const u32x4*)(P + (size_t)row * NP + PC_RWGD + j8);
          const u32x4 um = pos > 0 ? *(const u32x4*)(P + (size_t)(row - 1) * NP + PC_RWGD + j8) : (u32x4){0u, 0u, 0u, 0u};
          const u32x4 up = pos < s0.len - 1 ? *(const u32x4*)(P + (size_t)(row + 1) * NP + PC_RWGD + j8) : (u32x4){0u, 0u, 0u, 0u};
          float z0[8], zm[8], zp[8], sv[8]; unpack8(u0, z0); unpack8(um, zm); unpack8(up, zp);
#pragma unroll
          for (int x = 0; x < 8; ++x) sv[x] = sigmoidf_(z0[x] + mu[j8 + x] * (0.5f * (zm[x] + zp[x]) - z0[x]));
          *(LAS u32x4*)(sgb + tok * 272 + j8 * 2) = (u32x4){cvt_pk_bf16(sv[0], sv[1]), cvt_pk_bf16(sv[2], sv[3]), cvt_pk_bf16(sv[4], sv[5]), cvt_pk_bf16(sv[6], sv[7])}; }
        __syncthreads();
        { const int lane = tid & 63, wave = tid >> 6, fr = lane & 15, fq = lane >> 4;
          const bf16_t* GT = (const bf16_t*)(p.ws + WS_GUPT + (size_t)l * 256 * 128 * 2);
#pragma unroll
          for (int q = 0; q < 2; ++q) { const int nt = wave + q * 8;
              f32x4 a0 = (f32x4){0.f, 0.f, 0.f, 0.f}, a1 = a0;
              const bf16_t* wrow = GT + (size_t)(nt * 16 + fr) * 128 + fq * 8;
              bf16x8 bfr[4];
#pragma unroll
              for (int kc = 0; kc < 4; ++kc) bfr[kc] = *(const bf16x8*)(wrow + kc * 32);
#pragma unroll
              for (int kc = 0; kc < 4; ++kc) { const bf16x8 x0 = *(const LAS bf16x8*)(sgb + fr * 272 + kc * 64 + fq * 16), x1 = *(const LAS bf16x8*)(sgb + (16 + fr) * 272 + kc * 64 + fq * 16);
                  a0 = __builtin_amdgcn_mfma_f32_16x16x32_bf16(x0, bfr[kc], a0, 0, 0, 0); a1 = __builtin_amdgcn_mfma_f32_16x16x32_bf16(x1, bfr[kc], a1, 0, 0, 0); }
#pragma unroll
              for (int r = 0; r < 4; ++r) { gout[(fq * 4 + r) * 256 + nt * 16 + fr] = a0[r]; gout[(16 + fq * 4 + r) * 256 + nt * 16 + fr] = a1[r]; } } }
        __syncthreads();
        const int hh = tid >> 8, c = tid & 255, h = c >> 6;
        float g[16];
#pragma unroll
        for (int i = 0; i < 16; ++i) g[i] = gout[(hh * 16 + i) * 256 + c];
        const float gn = p.in[23][l * 256 + c];
        float ov[16], rv[16], bn[16];
#pragma unroll
        for (int i = 0; i < 16; ++i) { const int row = t0 + hh * 16 + i;
            ov[i] = bf2f(P[(size_t)row * NP + PC_RWO0 + c]) + bf2f(P[(size_t)row * NP + PC_RWO1 + c]); rv[i] = bf2f(RV[(size_t)row * 256 + c]); bn[i] = BON[(size_t)row * 4 + h]; }
#pragma unroll
        for (int i = 0; i < 16; ++i) { const int row = t0 + hh * 16 + i;
            const float o = ov[i];
            const float mean = wave_sum(o) * (1.f / 64.f); const float dl = o - mean; const float var = wave_sum(dl * dl) * (1.f / 64.f);
            float y = dl * (1.f / sqrtf(var + 64e-5f)) * gn + bn[i] * rv[i];
            P[(size_t)row * NP + PC_RWO1 + c] = f2bf(y * g[i]); }
        __syncthreads();
    }
}

#ifndef N_LAUNCH_MODE
#define N_LAUNCH_MODE 1
#endif
template <int Q>
__device__ __forceinline__ void layer_phase(const Params& p, int l, LAS unsigned char* lds, int bid, int nb) {
    unsigned char* wb = p.ws + WS_WB + (size_t)l * WB_LAYER;
    const int Mrows = (l == 0) ? TT : TMAIN;
    pg8::StaticOrder S;
    if constexpr (Q == 0) { pg8::Gemm g{(const bf16_t*)(p.ws + WS_HB), (const bf16_t*)(wb + WB_IN), TT, NP, DM, DM}; S.init(TT, NP, nb, bid);
              pg8::EpiBf16<0> E{(bf16_t*)(p.ws + WS_P), NP}; pg8::gemm_phase(lds, g, S, E); }
    if constexpr (Q == 1) phase_prepA(p, l, lds, bid, nb);
    if constexpr (Q == 3) phase_mixers(p, l, lds, bid, nb);
    if constexpr (Q == 4) phase_rwkv_finish(p, l, lds, bid, nb);
    if constexpr (Q == 5) { pg8::Gemm g{(const bf16_t*)(p.ws + WS_P), (const bf16_t*)(wb + WB_OUT), Mrows, DM, DM, NP}; S.init(Mrows, DM, nb, bid);
              pg8::EpiBf16<0> E{(bf16_t*)(p.ws + WS_Z), DM}; pg8::gemm_phase(lds, g, S, E); }
    if constexpr (Q == 6) phase_rowops(p, 1, l, Mrows, bid, nb);
    if constexpr (Q == 7) { pg8::Gemm g{(const bf16_t*)(p.ws + WS_HB), (const bf16_t*)(wb + WB_W1), Mrows, FF, DM, DM}; S.init(Mrows, FF, nb, bid);
              pg8::EpiBf16<1> E{(bf16_t*)(p.ws + WS_HID), FF}; pg8::gemm_phase(lds, g, S, E); }
    if constexpr (Q == 8) { pg8::Gemm g{(const bf16_t*)(p.ws + WS_HID), (const bf16_t*)(wb + WB_W2), Mrows, DM, FF, FF}; S.init(Mrows, DM, nb, bid);
              pg8::EpiBf16<0> E{(bf16_t*)(p.ws + WS_Z), DM}; pg8::gemm_phase(lds, g, S, E); }
    if constexpr (Q == 9) phase_rowops(p, 2, l, Mrows, bid, nb);
}

#ifndef PROBE_MASK
#define PROBE_MASK 0
#endif
#define PB(BIT, CALL) do { if ((PROBE_MASK) & (BIT)) { const unsigned long long t0_ = __builtin_amdgcn_s_memrealtime(); CALL; const unsigned long long t1_ = __builtin_amdgcn_s_memrealtime(); \
        while (__builtin_amdgcn_s_memrealtime() - t1_ < (t1_ - t0_)) __builtin_amdgcn_s_sleep(8); } else { CALL; } } while (0)
#define XB_TMO      128
#define XB_XCNT(j)  (256  + 64 * (j))
#define XB_XSUB(j)  (1280 + 64 * (j))
#define XB_XGEN(j)  (2304 + 64 * (j))
#define XB_TOP      3328
#define XB_TOPGEN   3392
#define XCD_BAR_WORDS 3456
#define XB_SPIN_CAP (1u << 18)

__device__ __forceinline__ unsigned xb_ld(unsigned* p)              { return __hip_atomic_load(p, __ATOMIC_RELAXED, __HIP_MEMORY_SCOPE_AGENT); }
__device__ __forceinline__ unsigned xb_add(unsigned* p, unsigned v) { return __hip_atomic_fetch_add(p, v, __ATOMIC_RELAXED, __HIP_MEMORY_SCOPE_AGENT); }
__device__ __forceinline__ unsigned xb_xcc_id() { return (unsigned)__builtin_amdgcn_s_getreg((3 << 11) | 20) & 0xFu; }
#define XB_SPIN(cond, bar) do { unsigned _sp = 0; while (cond) { __builtin_amdgcn_s_sleep(1); \
    if ((++_sp & 255u) == 0u) { if (xb_ld(&(bar)[XB_TMO])) break; if (_sp > XB_SPIN_CAP) { atomicAdd(&(bar)[XB_TMO], 1u); break; } } } } while (0)

struct XcdBarrier {
    unsigned* bar; unsigned x;
    volatile LAS unsigned* st;
};

__device__ __forceinline__ XcdBarrier xcd_barrier_post(unsigned* bar, volatile LAS unsigned* st) {
    XcdBarrier b; b.bar = bar; b.x = xb_xcc_id(); b.st = st;
    if (threadIdx.x == 0) (void)xb_add(&bar[XB_XCNT(b.x)], 1u);
    return b;
}
__device__ __forceinline__ void xcd_barrier_complete(unsigned* bar, unsigned x, unsigned& nloc, unsigned& nx) {
    const unsigned G = gridDim.x * gridDim.y * gridDim.z;
    unsigned sum, cnt, mine, sp = 0u;
    for (;;) {
        sum = 0u; cnt = 0u; mine = 0u;
#pragma unroll
        for (unsigned j = 0; j < 16; ++j) { const unsigned c = xb_ld(&bar[XB_XCNT(j)]); sum += c; cnt += (c > 0u) ? 1u : 0u; mine = (j == x) ? c : mine; }
        if (sum == G) break;
        __builtin_amdgcn_s_sleep(1);
        if ((++sp & 255u) == 0u) { if (xb_ld(&bar[XB_TMO])) break; if (sp > XB_SPIN_CAP) { atomicAdd(&bar[XB_TMO], 1u); break; } }
    }
    nloc = mine > 0u ? mine : 1u; nx = cnt > 0u ? cnt : 1u;
}

__device__ __forceinline__ void xcd_barrier(const XcdBarrier& b) {
    asm volatile("s_waitcnt vmcnt(0)" ::: "memory");
    __syncthreads();
    if (threadIdx.x == 0) {
        unsigned* bar = b.bar;
        __builtin_amdgcn_s_waitcnt(0);
        unsigned nloc = b.st[0], nx = b.st[1];
        if (nloc == 0u) { xcd_barrier_complete(bar, b.x, nloc, nx); b.st[0] = nloc; b.st[1] = nx; }
        const unsigned old = xb_add(&bar[XB_XSUB(b.x)], 1u);
        const unsigned gen = old / nloc;
        if (old + 1u == (gen + 1u) * nloc) {
            __builtin_amdgcn_fence(__ATOMIC_RELEASE, "agent");
            asm volatile("s_waitcnt vmcnt(0)" ::: "memory");
            const unsigned og = xb_add(&bar[XB_TOP], 1u);
            const unsigned tg = og / nx;
            if (og + 1u == (tg + 1u) * nx) xb_add(&bar[XB_TOPGEN], 1u);
            else XB_SPIN(xb_ld(&bar[XB_TOPGEN]) == tg, bar);
            __builtin_amdgcn_fence(__ATOMIC_ACQUIRE, "agent");
            xb_add(&bar[XB_XGEN(b.x)], 1u);
            asm volatile("s_waitcnt vmcnt(0)" ::: "memory");
        } else {
            XB_SPIN(xb_ld(&bar[XB_XGEN(b.x)]) == gen, bar);
            __builtin_amdgcn_fence(__ATOMIC_ACQUIRE, "agent");
            asm volatile("s_waitcnt vmcnt(0)" ::: "memory");
        }
    }
    __syncthreads();
}


constexpr size_t WS_XBAR = 772 * 1024;
#define GSYNC() xcd_barrier(xb)

__global__ void __launch_bounds__(512, 2) mega_fwd(Params p) {
    extern __shared__ __attribute__((aligned(16))) unsigned char lds_raw[];
    LAS unsigned char* lds = (LAS unsigned char*)lds_raw;
    cg::grid_group grid = cg::this_grid();
    const int bid = blockIdx.x, nb = gridDim.x;
    { LAS unsigned* st_ = (LAS unsigned*)(lds + LDS_BYTES - 32); if (get_tid() == 0) { st_[0] = 0u; st_[1] = 0u; } __syncthreads(); }
    XcdBarrier xb = xcd_barrier_post((unsigned*)(p.ws + WS_XBAR), (volatile LAS unsigned*)(lds + LDS_BYTES - 32));
    grid.sync();
    PB(16, phase_prologue(p, lds, bid, nb)); GSYNC();
    PB(8, phase_rowops(p, 0, 0, TT, bid, nb)); GSYNC();
#define LAYER(L, LAST) \
    PB(1, layer_phase<0>(p, L, lds, bid, nb)); GSYNC(); PB(4, layer_phase<1>(p, L, lds, bid, nb)); GSYNC(); \
    PB(2, layer_phase<3>(p, L, lds, bid, nb)); GSYNC(); PB(4, layer_phase<4>(p, L, lds, bid, nb)); GSYNC(); PB(1, layer_phase<5>(p, L, lds, bid, nb)); GSYNC(); \
    PB(8, layer_phase<6>(p, L, lds, bid, nb)); GSYNC(); PB(1, layer_phase<7>(p, L, lds, bid, nb)); GSYNC(); PB(1, layer_phase<8>(p, L, lds, bid, nb)); GSYNC(); \
    PB(8, layer_phase<9>(p, L, lds, bid, nb)); if (!(LAST)) GSYNC();
    LAYER(0, false)
    LAYER(1, true)
}
#if N_LAUNCH_MODE != 1
template <int PH> __global__ void __launch_bounds__(512, 2) one_phase(Params p, int l) {
    extern __shared__ __attribute__((aligned(16))) unsigned char lds_raw[];
    LAS unsigned char* lds = (LAS unsigned char*)lds_raw;
    if constexpr (PH == 100) phase_prologue(p, lds, blockIdx.x, gridDim.x);
    else if constexpr (PH == 101) phase_rowops(p, 0, 0, TT, blockIdx.x, gridDim.x);
    else layer_phase<PH>(p, l, lds, blockIdx.x, gridDim.x);
}
#endif

extern "C" void kernel_launch(void* const* d_in, const int* in_sizes, int n_in, void* d_out, int out_size, void* d_ws, size_t ws_size, hipStream_t stream) {
    if (n_in != 30 || ws_size < WS_NEED || out_size != TMAIN * DM) { fprintf(stderr, "kernel_launch: unexpected shapes (n_in %d, ws %zu, out %d)\n", n_in, ws_size, out_size); return; }
    Params p{};
    for (int i = 0; i < 30; ++i) p.in[i] = (const float*)d_in[i];
    p.out = (float*)d_out; p.ws = (unsigned char*)d_ws;
    static int grid_blocks = 0;
    if (!grid_blocks) {
        int dev = 0, cus = 0, per_cu = 0;
        (void)hipGetDevice(&dev);
        (void)hipDeviceGetAttribute(&cus, hipDeviceAttributeMultiprocessorCount, dev);
        (void)hipFuncSetAttribute((const void*)mega_fwd, hipFuncAttributeMaxDynamicSharedMemorySize, LDS_BYTES);
        (void)hipOccupancyMaxActiveBlocksPerMultiprocessor(&per_cu, mega_fwd, 512, LDS_BYTES);
        if (per_cu < 1) { fprintf(stderr, "kernel_launch: occupancy query says %d blocks/CU\n", per_cu); per_cu = 1; }
        grid_blocks = cus * 1;
        if (grid_blocks < 128) { fprintf(stderr, "kernel_launch: only %d CUs\n", grid_blocks); }
    }
#if N_LAUNCH_MODE == 1
    (void)hipMemsetAsync((char*)d_ws + 768 * 1024, 0, 32 * 1024, stream);
    void* args[] = {&p};
    hipError_t e = hipLaunchCooperativeKernel((const void*)mega_fwd, dim3(grid_blocks), dim3(512), args, LDS_BYTES, stream);
    if (e != hipSuccess) fprintf(stderr, "cooperative launch failed: %s (grid %d)\n", hipGetErrorString(e), grid_blocks);
#else
#define LP(PH, L) do { (void)hipFuncSetAttribute((const void*)one_phase<PH>, hipFuncAttributeMaxDynamicSharedMemorySize, LDS_BYTES); one_phase<PH><<<grid_blocks, 512, LDS_BYTES, stream>>>(p, L); } while (0)
    LP(100, 0); LP(101, 0);
    for (int l = 0; l < 2; ++l) { LP(0, l); LP(1, l); LP(2, l); LP(3, l); LP(4, l); LP(5, l); LP(6, l); LP(7, l); LP(8, l); LP(9, l); }
#endif
}
```

```cpp
#include <hip/hip_runtime.h>
#include <hip/hip_cooperative_groups.h>
#include <cstdio>
#include <cstdint>
#include <cmath>
namespace cg = cooperative_groups;
__device__ __forceinline__ int get_tid() { int t = threadIdx.x; asm volatile("" : "+v"(t)); return t; }
namespace pg8 {
#define PG8_LAS __attribute__((address_space(3)))
typedef unsigned short bf16_t;
typedef short bf16x8 __attribute__((ext_vector_type(8)));
typedef float f32x4 __attribute__((ext_vector_type(4)));
typedef unsigned u32x4 __attribute__((ext_vector_type(4)));
typedef unsigned u32x2 __attribute__((ext_vector_type(2)));
constexpr int BM = 256, BK = 64, HALF = 128, HTB = HALF * BK * 2, STAGE_BYTES = 8 * HTB, NXCD = 8, WGM = 8;

__host__ __device__ __forceinline__ int lds_byte(int r, int c) { const int st = (r >> 4) * 2 + (c >> 5), rr = r & 15, cc = c & 31, ob = rr * 64 + cc * 2; return st * 1024 + (ob ^ (((ob >> 9) & 1) << 5)); }
__host__ __device__ __forceinline__ void stage_rc(int b, int& R, int& C) { const int st = b / 1024, sb = b % 1024, swz = sb ^ (((sb >> 9) & 1) << 5); R = (st >> 1) * 16 + swz / 64; C = (st & 1) * 32 + (swz % 64) / 2; }

struct Unit { int pm, pn; };
struct Gemm { const bf16_t* A; const bf16_t* Bt; int M, N, K, lda; };

struct StaticOrder {
    int nM, nN, nwg, G, c;
    __host__ __device__ void init(int M, int N, int G_, int c_) { nM = M / BM; nN = N / BM; nwg = nM * nN; G = G_; c = c_; }
    __host__ __device__ bool next(int i, Unit& u) const {
        const long L = (long)i * G + c; if (L >= nwg) return false;
        int wgid = (int)L; { const int q = nwg / NXCD, r = nwg % NXCD, xcd = wgid % NXCD, off = wgid / NXCD; wgid = (xcd < r ? xcd * (q + 1) : r * (q + 1) + (xcd - r) * q) + off; }
        const int nig = WGM * nN, gid = wgid / nig, fm = gid * WGM, gsz = (nM - fm) < WGM ? (nM - fm) : WGM;
        u.pm = fm + ((wgid % nig) % gsz); u.pn = (wgid % nig) / gsz; return true;
    }
};

template <class Epi>
__device__ __forceinline__ void gemm_phase(PG8_LAS unsigned char* lds, const Gemm g, const StaticOrder& S, const Epi& E) {
    const int tid = get_tid(), wid = __builtin_amdgcn_readfirstlane(tid >> 6), lane = tid & 63, wr = wid >> 2, wc = wid & 3, fr = lane & 15, fq = lane >> 4;
    const int K = g.K, nt = K / BK, lda = g.lda;
    unsigned voffA[2], voffB[2];
#pragma unroll
    for (int i = 0; i < 2; ++i) { int R, C; stage_rc(tid * 16 + i * 8192, R, C);
        voffA[i] = (unsigned)(R * lda + C) * 2u; voffB[i] = (unsigned)(R * K + C) * 2u; }
    const size_t kstep = (size_t)(BK * 2);
    const size_t hstepA = (size_t)HALF * lda * 2, hstepB = (size_t)HALF * K * 2;
    const size_t tstepA = 2 * hstepA, tstepB = 2 * hstepB;
    const unsigned ldsw = (unsigned)wid * 1024u;
    const int aoff = lds_byte(wr * 64 + fr, fq * 8), boff = lds_byte(wc * 32 + fr, fq * 8);
#define PG8_SA(b, h) (((b) * 2 + (h)) * HTB)
#define PG8_SB(b, h) ((4 + (b) * 2 + (h)) * HTB)
#define PG8_STAGE(bufoff, gbase, voff) do { _Pragma("unroll") for (int _i = 0; _i < 2; ++_i) \
        __builtin_amdgcn_global_load_lds((const unsigned*)((const char*)(gbase) + (voff)[_i]), (PG8_LAS unsigned*)(lds + (bufoff) + ldsw + _i * 8192), 16, 0, 0); } while (0)
#define PG8_LDA(dst, b, h) do { _Pragma("unroll") for (int m = 0; m < 4; ++m) _Pragma("unroll") for (int k = 0; k < 2; ++k) dst[m][k] = *(const PG8_LAS bf16x8*)(lds + PG8_SA(b, h) + aoff + m * 2048 + k * 1024); } while (0)
#define PG8_LDB(dst, b, h) do { _Pragma("unroll") for (int n = 0; n < 2; ++n) _Pragma("unroll") for (int k = 0; k < 2; ++k) dst[n][k] = *(const PG8_LAS bf16x8*)(lds + PG8_SB(b, h) + boff + n * 2048 + k * 1024); } while (0)
#define PG8_MMA(ai, bj, At, Bt) do { __builtin_amdgcn_s_setprio(1); _Pragma("unroll") for (int m = 0; m < 4; ++m) _Pragma("unroll") for (int n = 0; n < 2; ++n) _Pragma("unroll") for (int k = 0; k < 2; ++k) \
        acc[ai][bj][m][n] = __builtin_amdgcn_mfma_f32_16x16x32_bf16(Bt[n][k], At[m][k], acc[ai][bj][m][n], 0, 0, 0); __builtin_amdgcn_s_setprio(0); } while (0)
#define PG8_WAIT_V(n) asm volatile("s_waitcnt vmcnt(" #n ")" ::: "memory")
#define PG8_WAIT_L(n) asm volatile("s_waitcnt lgkmcnt(" #n ")" ::: "memory")
#define PG8_BAR __builtin_amdgcn_s_barrier()
#define PG8_SCHED __builtin_amdgcn_sched_barrier(0)
    Unit cur, nxt; int ui = 0;
    if (!S.next(0, cur)) return;
    f32x4 acc[2][2][4][2];
#pragma unroll
    for (int a = 0; a < 2; ++a)
#pragma unroll
        for (int b = 0; b < 2; ++b)
#pragma unroll
            for (int m = 0; m < 4; ++m)
#pragma unroll
                for (int n = 0; n < 2; ++n) acc[a][b][m][n] = (f32x4){0.f, 0.f, 0.f, 0.f};
    bf16x8 At[4][2], B0[2][2], B1[2][2];
    const char* cA = (const char*)g.A + (size_t)cur.pm * tstepA; const char* cB = (const char*)g.Bt + (size_t)cur.pn * tstepB;
    PG8_STAGE(PG8_SB(0, 0), cB, voffB); PG8_STAGE(PG8_SA(0, 0), cA, voffA); PG8_STAGE(PG8_SB(0, 1), cB + hstepB, voffB); PG8_STAGE(PG8_SA(0, 1), cA + hstepA, voffA);
    if (wr == 1) PG8_BAR;
    PG8_WAIT_V(4); PG8_BAR;
    PG8_STAGE(PG8_SB(1, 0), cB + kstep, voffB); PG8_STAGE(PG8_SA(1, 0), cA + kstep, voffA); PG8_STAGE(PG8_SB(1, 1), cB + hstepB + kstep, voffB);
    PG8_WAIT_V(6); PG8_BAR;
    for (;;) {
        const bool has_next = S.next(ui + 1, nxt);
        const char* nA = has_next ? (const char*)g.A + (size_t)nxt.pm * tstepA : cA; const char* nB = has_next ? (const char*)g.Bt + (size_t)nxt.pn * tstepB : cB;
        for (int t = 0; t < nt; t += 2) {
            const bool last = (t == nt - 2);
            const char* a1 = cA + (size_t)(t + 1) * kstep;
            const char* a2 = last ? nA : cA + (size_t)(t + 2) * kstep; const char* b2 = last ? nB : cB + (size_t)(t + 2) * kstep;
            const char* a3 = a2 + kstep; const char* b3 = b2 + kstep;
            PG8_LDB(B0, 0, 0); PG8_SCHED; PG8_LDA(At, 0, 0); PG8_STAGE(PG8_SA(1, 1), a1 + hstepA, voffA);
            PG8_WAIT_L(8); PG8_BAR; PG8_WAIT_L(0); PG8_MMA(0, 0, At, B0); PG8_BAR; PG8_SCHED;
            PG8_LDB(B1, 0, 1); PG8_STAGE(PG8_SB(0, 0), b2, voffB);
            PG8_BAR; PG8_WAIT_L(0); PG8_MMA(0, 1, At, B1); PG8_BAR;
            PG8_LDA(At, 0, 1); PG8_STAGE(PG8_SA(0, 0), a2, voffA);
            PG8_BAR; PG8_WAIT_L(0); PG8_MMA(1, 0, At, B0); PG8_BAR; PG8_SCHED;
            PG8_STAGE(PG8_SB(0, 1), b2 + hstepB, voffB);
            PG8_WAIT_V(6); PG8_BAR; PG8_MMA(1, 1, At, B1); PG8_BAR;
            PG8_LDB(B0, 1, 0); PG8_SCHED; PG8_LDA(At, 1, 0); PG8_STAGE(PG8_SA(0, 1), a2 + hstepA, voffA);
            PG8_WAIT_L(8); PG8_BAR; PG8_WAIT_L(0); PG8_MMA(0, 0, At, B0); PG8_BAR; PG8_SCHED;
            PG8_LDB(B1, 1, 1); PG8_STAGE(PG8_SB(1, 0), b3, voffB);
            PG8_BAR; PG8_WAIT_L(0); PG8_MMA(0, 1, At, B1); PG8_BAR;
            PG8_LDA(At, 1, 1); PG8_STAGE(PG8_SA(1, 0), a3, voffA);
            PG8_BAR; PG8_WAIT_L(0); PG8_MMA(1, 0, At, B0); PG8_BAR; PG8_SCHED;
            PG8_STAGE(PG8_SB(1, 1), b3 + hstepB, voffB);
            PG8_WAIT_V(6); PG8_BAR; PG8_MMA(1, 1, At, B1); PG8_BAR;
        }
        E(acc, cur, wr, wc, fr, fq);
        if (!has_next) break;
#pragma unroll
        for (int a = 0; a < 2; ++a)
#pragma unroll
            for (int b = 0; b < 2; ++b)
#pragma unroll
                for (int m = 0; m < 4; ++m)
#pragma unroll
                    for (int n = 0; n < 2; ++n) acc[a][b][m][n] = (f32x4){0.f, 0.f, 0.f, 0.f};
        cur = nxt; cA = nA; cB = nB; ++ui;
    }
    PG8_WAIT_V(0);
    if (wr == 0) PG8_BAR;
    PG8_BAR;
#undef PG8_SA
#undef PG8_SB
#undef PG8_STAGE
#undef PG8_LDA
#undef PG8_LDB
#undef PG8_MMA
#undef PG8_WAIT_V
#undef PG8_WAIT_L
#undef PG8_BAR
#undef PG8_SCHED
}

__device__ __forceinline__ unsigned f2bf_u(float f) { unsigned u = __builtin_bit_cast(unsigned, f); return (u + 0x7fffu + ((u >> 16) & 1u)) >> 16; }
template <int ACT> struct EpiBf16 {
    bf16_t* O; int ldc;
    __device__ __forceinline__ void operator()(const f32x4 (&acc)[2][2][4][2], const Unit& u, int wr, int wc, int fr, int fq) const {
        const int row0 = u.pm * BM + wr * 64 + fr, col0 = u.pn * BM + wc * 32 + 4 * fq;
#pragma unroll
        for (int ai = 0; ai < 2; ++ai)
#pragma unroll
            for (int m = 0; m < 4; ++m) { bf16_t* rowp = O + (size_t)(row0 + ai * HALF + m * 16) * ldc + col0;
#pragma unroll
                for (int bj = 0; bj < 2; ++bj)
#pragma unroll
                    for (int n = 0; n < 2; ++n) { f32x4 v = acc[ai][bj][m][n];
                        if (ACT == 1) { v.x = v.x > 0.f ? v.x * v.x : 0.f; v.y = v.y > 0.f ? v.y * v.y : 0.f; v.z = v.z > 0.f ? v.z * v.z : 0.f; v.w = v.w > 0.f ? v.w * v.w : 0.f; }
                        u32x2 o; o.x = f2bf_u(v.x) | (f2bf_u(v.y) << 16); o.y = f2bf_u(v.z) | (f2bf_u(v.w) << 16);
                        *(u32x2*)(rowp + bj * HALF + n * 16) = o; } }
    }
};
}
typedef unsigned short bf16_t;
typedef short bf16x8 __attribute__((ext_vector_type(8)));
typedef float f32x4 __attribute__((ext_vector_type(4)));
typedef unsigned u32x4 __attribute__((ext_vector_type(4)));
typedef unsigned u32x2 __attribute__((ext_vector_type(2)));
#define LAS __attribute__((address_space(3)))

constexpr int NBATCH = 8, SEQL = 4096, DM = 1024, CTXL = 256, TMAIN = 32768, TCTX = 2048, TT = 34816, NP = 3072, FF = 4096;
constexpr int PC_SWAQ = 0, PC_RETQ = 256, PC_RWR = 512, PC_MLAQD = 768, PC_SWAK = 1024, PC_SWAV = 1152, PC_RETK = 1280, PC_RETV = 1536, PC_RETG = 1792,
              PC_RWK = 2048, PC_RWV = 2304, PC_RWWD = 2560, PC_RWAD = 2624, PC_RWGD = 2688, PC_MLAKVD = 2816, PC_MLAKPE = 2944;
constexpr int PC_RWO0 = PC_RWV, PC_RWO1 = PC_RWR;
constexpr int NKEYS = CTXL + SEQL;

constexpr size_t MiB = 1u << 20;
constexpr size_t WS_MOD = 0;
constexpr size_t WS_TAB = 512 * 1024;
constexpr size_t WS_CTR = 768 * 1024;
constexpr size_t WS_BON = 1 * MiB;
constexpr size_t WS_WB = 2 * MiB;
constexpr size_t WB_LAYER = 24 * MiB, WB_IN = 0, WB_OUT = 6 * MiB, WB_W1 = 8 * MiB, WB_W2 = 16 * MiB;
constexpr size_t WS_XC = 50 * MiB;
constexpr size_t WS_P = 58 * MiB;
constexpr size_t WS_HID = 58 * MiB;
constexpr size_t WS_A = 262 * MiB;
constexpr size_t ARR17 = 17 * MiB;
constexpr size_t WS_RWK = WS_A, WS_RWV = WS_A + ARR17, WS_RWRR = WS_A + 2 * ARR17, WS_RWA0 = WS_A + 3 * ARR17, WS_RWA1 = WS_A + 4 * ARR17,
                 WS_RWM0 = WS_A + 5 * ARR17, WS_RWM1 = WS_A + 6 * ARR17;
constexpr size_t WS_RET = WS_A + 119 * MiB;
constexpr size_t WS_MQ = WS_RET + 34 * MiB;
constexpr size_t WS_KM = WS_MQ + 26738688;
constexpr size_t WS_VTM = WS_KM + 26738688;
constexpr size_t WS_KS = WS_VTM + ARR17;
constexpr size_t WS_VTS = WS_KS + 8912896;
constexpr size_t WS_A_END = WS_VTS + 8912896;
constexpr size_t WS_Z = 330 * MiB;
constexpr size_t WS_HB = 398 * MiB;
constexpr size_t WS_MLAW = 500 * MiB;
constexpr size_t MLAW_LAYER = 384 * 256 * 2 + 512 * 128 * 2, MLAW_KV = 384 * 256 * 2;
constexpr size_t WS_GUPT = 501 * MiB;
constexpr size_t WS_LORAT = 502 * MiB;
constexpr size_t WS_NEED = 503 * MiB;
static_assert(WS_A_END <= WS_NEED && WS_HB + 68 * MiB <= WS_NEED && WS_HID + 272 * MiB <= WS_Z, "ws map");

constexpr int LDS_BYTES = 150 * 1024;

struct Params { const float* in[30]; float* out; unsigned char* ws; };

__device__ __forceinline__ float bf2f(bf16_t v) { return __builtin_bit_cast(float, (unsigned)v << 16); }
__device__ __forceinline__ bf16_t f2bf(float f) { unsigned u = __builtin_bit_cast(unsigned, f); return (bf16_t)((u + 0x7fffu + ((u >> 16) & 1u)) >> 16); }
__device__ __forceinline__ unsigned pk2(float lo, float hi) { return (unsigned)f2bf(lo) | ((unsigned)f2bf(hi) << 16); }
typedef float f32x2 __attribute__((ext_vector_type(2)));
typedef __bf16 bf16x2_t __attribute__((ext_vector_type(2)));
__device__ __forceinline__ unsigned cvt_pk_bf16(float lo, float hi) { const f32x2 v = {lo, hi}; return __builtin_bit_cast(unsigned, __builtin_convertvector(v, bf16x2_t)); }
template <int CTRL> __device__ __forceinline__ float dppf(float v) { return __builtin_bit_cast(float, __builtin_amdgcn_update_dpp(0, __builtin_bit_cast(int, v), CTRL, 0xF, 0xF, true)); }
__device__ __forceinline__ float red4(float v) { v += dppf<0xB1>(v); v += dppf<0x4E>(v); return v; }
__device__ __forceinline__ float red8(float v) { v = red4(v); v += dppf<0x141>(v); return v; }
__device__ __forceinline__ float red16(float v) { v = red8(v); v += dppf<0x140>(v); return v; }
__device__ __forceinline__ float max16(float v) { v = fmaxf(v, dppf<0xB1>(v)); v = fmaxf(v, dppf<0x4E>(v)); v = fmaxf(v, dppf<0x141>(v)); v = fmaxf(v, dppf<0x140>(v)); return v; }
__device__ __forceinline__ float wave_sum(float v) {
    v = red16(v);
    const int u = __builtin_bit_cast(int, v);
    return __builtin_bit_cast(float, __builtin_amdgcn_readlane(u, 0)) + __builtin_bit_cast(float, __builtin_amdgcn_readlane(u, 16)) +
           __builtin_bit_cast(float, __builtin_amdgcn_readlane(u, 32)) + __builtin_bit_cast(float, __builtin_amdgcn_readlane(u, 48));
}
__device__ __forceinline__ void unpack8(const u32x4 u, float* f) {
    f[0] = bf2f((bf16_t)(u.x & 0xffff)); f[1] = bf2f((bf16_t)(u.x >> 16)); f[2] = bf2f((bf16_t)(u.y & 0xffff)); f[3] = bf2f((bf16_t)(u.y >> 16));
    f[4] = bf2f((bf16_t)(u.z & 0xffff)); f[5] = bf2f((bf16_t)(u.z >> 16)); f[6] = bf2f((bf16_t)(u.w & 0xffff)); f[7] = bf2f((bf16_t)(u.w >> 16));
}
__device__ __forceinline__ float sigmoidf_(float x) { return __builtin_amdgcn_rcpf(1.f + __expf(-x)); }

struct SeqInfo { int b, pos, len, start, isctx; };
__device__ __forceinline__ SeqInfo seq_of_row(int row) {
    SeqInfo s;
    if (row < TMAIN) { s.b = row >> 12; s.pos = row & 4095; s.len = SEQL; s.start = s.b << 12; s.isctx = 0; }
    else { const int r = row - TMAIN; s.b = r >> 8; s.pos = r & 255; s.len = CTXL; s.start = TMAIN + (s.b << 8); s.isctx = 1; }
    return s;
}

__device__ __forceinline__ void transpose_item(const float* W, int N, int nsrc0, bf16_t* WT, int K, int ndst0, int k0, LAS float* scr, int lane) {
    if (nsrc0 >= 0) {
#pragma unroll 32
        for (int i = 0; i < 32; ++i) { const int kk = 2 * i + (lane >> 5); scr[kk * 33 + (lane & 31)] = W[(size_t)(k0 + kk) * N + nsrc0 + (lane & 31)]; }
    } else {
#pragma unroll 8
        for (int i = 0; i < 32; ++i) { const int kk = 2 * i + (lane >> 5); scr[kk * 33 + (lane & 31)] = 0.f; }
    }
    __builtin_amdgcn_wave_barrier(); asm volatile("s_waitcnt lgkmcnt(0)" ::: "memory");
    const int c = lane & 7;
#pragma unroll
    for (int j = 0; j < 4; ++j) { const int n = (lane >> 3) + 8 * j; const LAS float* s = scr + (8 * c) * 33 + n;
        u32x4 o; o.x = pk2(s[0 * 33], s[1 * 33]); o.y = pk2(s[2 * 33], s[3 * 33]); o.z = pk2(s[4 * 33], s[5 * 33]); o.w = pk2(s[6 * 33], s[7 * 33]);
        *(u32x4*)(WT + (size_t)(ndst0 + n) * K + k0 + 8 * c) = o; }
    __builtin_amdgcn_wave_barrier(); asm volatile("s_waitcnt lgkmcnt(0)" ::: "memory");
}
__device__ __forceinline__ int win_src_col(int n) {
    if (n < 256) return n;
    if (n < 512) return 512 + (n - 256);
    if (n < 768) return 1536 + (n - 512);
    if (n < 1024) return 2560 + (n - 768);
    if (n < 1280) return 256 + (n - 1024);
    if (n < 2048) return 768 + (n - 1280);
    if (n < 2816) return 1792 + (n - 2048);
    if (n < 2976) return n;
    return -1;
}
__device__ __forceinline__ void phase_prologue(const Params& p, LAS unsigned char* lds, int bid, int nb) {
    const int tid = get_tid(), lane = tid & 63, wave = tid >> 6;
    LAS float* scr = (LAS float*)(lds + wave * 16384);
    const int gw = bid * 8 + wave, NGW = nb * 8;
    constexpr int I_IN = 16 * 96, I_OUT = 16 * 32, I_1 = 16 * 128, I_2 = 64 * 32, I_Q = 4 * 12, I_KV = 2 * 16, I_G = 2 * 8, I_LO = 4 * 8, I_L = I_IN + I_OUT + I_1 + I_2 + I_Q + I_KV + I_G + I_LO;
    for (int it = gw; it < 2 * I_L; it += NGW) {
        const int l = it / I_L; int r = it % I_L;
        unsigned char* wb = p.ws + WS_WB + (size_t)l * WB_LAYER;
        if (r < I_IN) { const int kb = r / 96, nbk = r % 96; transpose_item(p.in[10] + (size_t)l * DM * 2976, 2976, win_src_col(nbk * 32), (bf16_t*)(wb + WB_IN), DM, nbk * 32, kb * 64, scr, lane); continue; } r -= I_IN;
        if (r < I_OUT) { const int kb = r / 32, nbk = r % 32; transpose_item(p.in[11] + (size_t)l * DM * DM, DM, nbk * 32, (bf16_t*)(wb + WB_OUT), DM, nbk * 32, kb * 64, scr, lane); continue; } r -= I_OUT;
        if (r < I_1) { const int kb = r / 128, nbk = r % 128; transpose_item(p.in[28] + (size_t)l * DM * FF, FF, nbk * 32, (bf16_t*)(wb + WB_W1), DM, nbk * 32, kb * 64, scr, lane); continue; } r -= I_1;
        if (r < I_2) { const int kb = r / 32, nbk = r % 32; transpose_item(p.in[29] + (size_t)l * FF * DM, DM, nbk * 32, (bf16_t*)(wb + WB_W2), FF, nbk * 32, kb * 64, scr, lane); continue; } r -= I_2;
        unsigned char* mw = p.ws + WS_MLAW + (size_t)l * MLAW_LAYER;
        if (r < I_Q) { const int kb = r / 12, nbk = r % 12; transpose_item(p.in[25] + (size_t)l * 256 * 384, 384, nbk * 32, (bf16_t*)mw, 256, nbk * 32, kb * 64, scr, lane); continue; } r -= I_Q;
        if (r < I_KV) { const int kb = r / 16, nbk = r % 16; transpose_item(p.in[27] + (size_t)l * 128 * 512, 512, nbk * 32, (bf16_t*)(mw + MLAW_KV), 128, nbk * 32, kb * 64, scr, lane); continue; } r -= I_KV;
        if (r < I_G) { const int kb = r / 8, nbk = r % 8; transpose_item(p.in[19] + (size_t)l * 128 * 256, 256, nbk * 32, (bf16_t*)(p.ws + WS_GUPT + (size_t)l * 256 * 128 * 2), 128, nbk * 32, kb * 64, scr, lane); continue; } r -= I_G;
        { const int m = r / 8, nbk = r % 8; const float* src = (m < 2 ? p.in[16] : p.in[18]) + ((size_t)l * 2 + (m & 1)) * 64 * 256;
          transpose_item(src, 256, nbk * 32, (bf16_t*)(p.ws + WS_LORAT + ((size_t)l * 4 + m) * 256 * 64 * 2), 64, nbk * 32, 0, scr, lane); }
    }
    __syncthreads();
    for (int it = bid; it < 192; it += nb) {
        const int l = it / 96, cb = it % 96;
        LAS float* sc = (LAS float*)lds;
        LAS float* red = sc + 9 * 1024;
        for (int e = tid; e < 9 * 1024; e += 512) { const int r = e >> 10, k = e & 1023; const float v = (r < 8) ? p.in[1][r * 1024 + k] : p.in[3][k]; sc[e] = v / (1.f + __expf(-v)); }
        __syncthreads();
        const int ks = tid >> 6, cl = tid & 63, n = cb * 64 + cl;
        float acc[9];
#pragma unroll
        for (int r = 0; r < 9; ++r) acc[r] = 0.f;
        const float* aw = p.in[4] + (size_t)l * DM * 6144;
#pragma unroll 16
        for (int k = ks * 128; k < ks * 128 + 128; ++k) { const float w = aw[(size_t)k * 6144 + n];
#pragma unroll
            for (int r = 0; r < 9; ++r) acc[r] += sc[r * 1024 + k] * w; }
#pragma unroll
        for (int r = 0; r < 9; ++r) red[(ks * 9 + r) * 64 + cl] = acc[r];
        __syncthreads();
        for (int e = tid; e < 9 * 64; e += 512) { const int r = e >> 6, c2 = e & 63; float s = 0.f;
            for (int q = 0; q < 8; ++q) s += red[(q * 9 + r) * 64 + c2];
            ((float*)(p.ws + WS_MOD))[((size_t)l * 9 + r) * 6144 + cb * 64 + c2] = s + p.in[5][(size_t)l * 6144 + cb * 64 + c2]; }
        __syncthreads();
    }
    if (bid == 0 && tid < 4) ((unsigned*)(p.ws + WS_CTR))[tid] = 0u;
    if (bid == nb - 1) {
        float* tab = (float*)(p.ws + WS_TAB);
        for (int e = tid; e < 64 * 16; e += 512) { const int pos = e >> 4, f = e & 15; const float inv = powf(10000.f, -(float)(2 * f) / 32.f); const float a = (float)pos * inv; tab[e] = cosf(a); tab[1024 + e] = sinf(a); }
        for (int e = tid; e < 64 * 8; e += 512) { const int pos = e >> 3, f = e & 7; const float inv = powf(10000.f, -(float)(2 * f) / 16.f); const float a = (float)pos * inv; tab[2048 + e] = cosf(a); tab[2560 + e] = sinf(a); }
    }
}

struct RowJob { const float* xsrc; const bf16_t* z; const float* gpost; const float* gate; float* xdst; const float* gpre; const float* shift; const float* scale; bf16_t* hdst; };
__device__ __forceinline__ RowJob make_rowjob(const Params& p, int mode, int l, int row) {
    const float* mod = (const float*)(p.ws + WS_MOD);
    bf16_t* HB = (bf16_t*)(p.ws + WS_HB); const bf16_t* Z = (const bf16_t*)(p.ws + WS_Z);
    float* XC = (float*)(p.ws + WS_XC);
    const SeqInfo s = seq_of_row(row);
    const int mr = s.isctx ? 8 : s.b;
    const float* m_l = mod + ((size_t)l * 9 + mr) * 6144;
    float* xs = s.isctx ? XC + (size_t)(row - TMAIN) * DM : p.out + (size_t)row * DM;
    const float* xin = s.isctx ? p.in[2] + (size_t)(row - TMAIN) * DM : p.in[0] + (size_t)row * DM;
    RowJob j;
    if (mode == 0) { j = RowJob{xin, nullptr, nullptr, nullptr, nullptr, p.in[6] + l * DM, m_l + 0, m_l + 1024, HB + (size_t)row * DM}; }
    else if (mode == 1) { j = RowJob{l == 0 ? xin : xs, Z + (size_t)row * DM, p.in[7] + l * DM, m_l + 2048, xs, p.in[8] + l * DM, m_l + 3072, m_l + 4096, HB + (size_t)row * DM}; }
    else { const bool has_next = (l + 1 < 2); const float* m_n = mod + ((size_t)(has_next ? l + 1 : l) * 9 + mr) * 6144;
        j = RowJob{xs, Z + (size_t)row * DM, p.in[9] + l * DM, m_l + 5120, xs, p.in[6] + (has_next ? l + 1 : l) * DM, m_n + 0, m_n + 1024, has_next ? HB + (size_t)row * DM : nullptr}; }
    return j;
}
template <int RB>
__device__ __forceinline__ void rowop_batch(const RowJob (&jb)[RB], const bool (&valid)[RB], int lane) {
    f32x4 v[RB][4]; u32x2 zu[RB][4];
#pragma unroll
    for (int r = 0; r < RB; ++r) if (valid[r]) {
#pragma unroll
        for (int j = 0; j < 4; ++j) { v[r][j] = *(const f32x4*)(jb[r].xsrc + (j * 64 + lane) * 4); if (jb[r].z) zu[r][j] = *(const u32x2*)(jb[r].z + (j * 64 + lane) * 4); }
    }
#pragma unroll
    for (int r = 0; r < RB; ++r) if (valid[r]) {
        const RowJob& J = jb[r];
        if (J.z) {
            f32x4 zz[4], gp[4], gt[4]; float ss = 0.f;
#pragma unroll
            for (int j = 0; j < 4; ++j) { const int c = (j * 64 + lane) * 4; gp[j] = *(const f32x4*)(J.gpost + c); gt[j] = *(const f32x4*)(J.gate + c); }
#pragma unroll
            for (int j = 0; j < 4; ++j) { const u32x2 u = zu[r][j];
                zz[j].x = bf2f((bf16_t)(u.x & 0xffff)); zz[j].y = bf2f((bf16_t)(u.x >> 16)); zz[j].z = bf2f((bf16_t)(u.y & 0xffff)); zz[j].w = bf2f((bf16_t)(u.y >> 16));
                ss += zz[j].x * zz[j].x + zz[j].y * zz[j].y + zz[j].z * zz[j].z + zz[j].w * zz[j].w; }
            const float rinv = 1.f / sqrtf(wave_sum(ss) * (1.f / 1024.f) + 1e-6f);
#pragma unroll
            for (int j = 0; j < 4; ++j) { const int c = (j * 64 + lane) * 4;
                v[r][j].x += gt[j].x * (zz[j].x * rinv * gp[j].x); v[r][j].y += gt[j].y * (zz[j].y * rinv * gp[j].y); v[r][j].z += gt[j].z * (zz[j].z * rinv * gp[j].z); v[r][j].w += gt[j].w * (zz[j].w * rinv * gp[j].w);
                *(f32x4*)(J.xdst + c) = v[r][j]; }
        }
        if (J.hdst) {
            f32x4 g[4], sh[4], sc[4]; float ss = 0.f;
#pragma unroll
            for (int j = 0; j < 4; ++j) { const int c = (j * 64 + lane) * 4; g[j] = *(const f32x4*)(J.gpre + c); sh[j] = *(const f32x4*)(J.shift + c); sc[j] = *(const f32x4*)(J.scale + c); }
#pragma unroll
            for (int j = 0; j < 4; ++j) ss += v[r][j].x * v[r][j].x + v[r][j].y * v[r][j].y + v[r][j].z * v[r][j].z + v[r][j].w * v[r][j].w;
            const float rinv = 1.f / sqrtf(wave_sum(ss) * (1.f / 1024.f) + 1e-6f);
#pragma unroll
            for (int j = 0; j < 4; ++j) { const int c = (j * 64 + lane) * 4;
                u32x2 o; o.x = pk2(v[r][j].x * rinv * g[j].x * (1.f + sc[j].x) + sh[j].x, v[r][j].y * rinv * g[j].y * (1.f + sc[j].y) + sh[j].y);
                o.y = pk2(v[r][j].z * rinv * g[j].z * (1.f + sc[j].z) + sh[j].z, v[r][j].w * rinv * g[j].w * (1.f + sc[j].w) + sh[j].w);
                *(u32x2*)(J.hdst + c) = o; }
        }
    }
}
__device__ __forceinline__ void phase_rowops(const Params& p, int mode, int l, int nrows, int bid, int nb) {
    const int tid = get_tid(), lane = tid & 63, wave = tid >> 6;
    constexpr int RB = 4;
    const int nwaves = nb * 8, gw = bid * 8 + wave;
    for (int base = gw; base < nrows; base += nwaves * RB) {
        RowJob jb[RB]; bool valid[RB];
#pragma unroll
        for (int r = 0; r < RB; ++r) { const int row = base + r * nwaves; valid[r] = row < nrows; jb[r] = make_rowjob(p, mode, l, valid[r] ? row : 0); }
        rowop_batch<RB>(jb, valid, lane);
    }
}

__device__ __forceinline__ void rwkv_prep_item(const Params& p, int l, LAS unsigned char* lds, int tile) {
    const int tid = get_tid(), lane = tid & 63, wave = tid >> 6, fr = lane & 15, fq = lane >> 4;
    const bf16_t* P = (const bf16_t*)(p.ws + WS_P);
    const int t0 = tile * 32; const SeqInfo s0 = seq_of_row(t0);
    const float* mu = p.in[14] + l * 1024;
    LAS bf16_t* r_s = (LAS bf16_t*)lds;
    LAS bf16_t* k_s = r_s + 32 * 256;
    LAS bf16_t* v_s = k_s + 32 * 256;
    LAS unsigned char* twd = lds + 3 * 16384;
    LAS unsigned char* ads = twd + 32 * 144;
    LAS float* O1 = (LAS float*)(ads + 32 * 144);
#pragma unroll
    for (int it = 0; it < 7; ++it) {
        const int pc = tid + it * 512; const int tok = pc / 112, c8 = pc % 112, cc = c8 * 8;
        const int pcol = cc < 256 ? PC_RWR + cc : PC_RWK + (cc - 256);
        const int row = t0 + tok, pos = s0.pos + tok;
        const u32x4 u0 = *(const u32x4*)(P + (size_t)row * NP + pcol);
        const u32x4 um = pos > 0 ? *(const u32x4*)(P + (size_t)(row - 1) * NP + pcol) : (u32x4){0u, 0u, 0u, 0u};
        const u32x4 up = pos < s0.len - 1 ? *(const u32x4*)(P + (size_t)(row + 1) * NP + pcol) : (u32x4){0u, 0u, 0u, 0u};
        const f32x4 mu0 = *(const f32x4*)(mu + cc), mu1 = *(const f32x4*)(mu + cc + 4);
        float z0[8], zm[8], zp[8], zs[8]; unpack8(u0, z0); unpack8(um, zm); unpack8(up, zp);
        const float mm[8] = {mu0.x, mu0.y, mu0.z, mu0.w, mu1.x, mu1.y, mu1.z, mu1.w};
#pragma unroll
        for (int x = 0; x < 8; ++x) zs[x] = z0[x] + mm[x] * (0.5f * (zm[x] + zp[x]) - z0[x]);
        LAS unsigned char* dst;
        if (cc < 256) dst = (LAS unsigned char*)(r_s + tok * 256 + cc);
        else if (cc < 512) dst = (LAS unsigned char*)(k_s + tok * 256 + cc - 256);
        else if (cc < 768) dst = (LAS unsigned char*)(v_s + tok * 256 + cc - 512);
        else if (cc < 832) { dst = twd + tok * 144 + (cc - 768) * 2;
#pragma unroll
            for (int x = 0; x < 8; ++x) zs[x] = 1.f - 2.f * __builtin_amdgcn_rcpf(1.f + __expf(2.f * zs[x])); }
        else dst = ads + tok * 144 + (cc - 832) * 2;
        *(LAS u32x4*)dst = (u32x4){cvt_pk_bf16(zs[0], zs[1]), cvt_pk_bf16(zs[2], zs[3]), cvt_pk_bf16(zs[4], zs[5]), cvt_pk_bf16(zs[6], zs[7])};
    }
    __syncthreads();
    const int hh = tid >> 8, c = tid & 255, h = c >> 6;
    bf16_t* RK = (bf16_t*)(p.ws + WS_RWK); bf16_t* RV = (bf16_t*)(p.ws + WS_RWV); bf16_t* RR = (bf16_t*)(p.ws + WS_RWRR);
    bf16_t* RA0 = (bf16_t*)(p.ws + WS_RWA0); bf16_t* RA1 = (bf16_t*)(p.ws + WS_RWA1); bf16_t* RM0 = (bf16_t*)(p.ws + WS_RWM0); bf16_t* RM1 = (bf16_t*)(p.ws + WS_RWM1);
    float* BON = (float*)(p.ws + WS_BON);
#pragma unroll
    for (int pass = 0; pass < 2; ++pass) {
        { const bf16_t* WT = (const bf16_t*)(p.ws + WS_LORAT + ((size_t)l * 4 + pass * 2) * 256 * 64 * 2);
          LAS unsigned char* A = pass ? ads : twd;
          const bf16x8 x00 = *(const LAS bf16x8*)(A + fr * 144 + fq * 16), x01 = *(const LAS bf16x8*)(A + fr * 144 + 64 + fq * 16);
          const bf16x8 x10 = *(const LAS bf16x8*)(A + (16 + fr) * 144 + fq * 16), x11 = *(const LAS bf16x8*)(A + (16 + fr) * 144 + 64 + fq * 16);
          bf16x8 b0[4], b1[4];
#pragma unroll
          for (int q = 0; q < 4; ++q) { const int t = wave * 4 + q, m = t >> 4, nt = t & 15; const bf16_t* wrow = WT + (size_t)m * 256 * 64 + (size_t)(nt * 16 + fr) * 64 + fq * 8;
              b0[q] = *(const bf16x8*)wrow; b1[q] = *(const bf16x8*)(wrow + 32); }
#pragma unroll
          for (int q = 0; q < 4; ++q) { const int t = wave * 4 + q, m = t >> 4, nt = t & 15;
              f32x4 a0 = (f32x4){0.f, 0.f, 0.f, 0.f}, a1 = a0;
              a0 = __builtin_amdgcn_mfma_f32_16x16x32_bf16(x00, b0[q], a0, 0, 0, 0); a0 = __builtin_amdgcn_mfma_f32_16x16x32_bf16(x01, b1[q], a0, 0, 0, 0);
              a1 = __builtin_amdgcn_mfma_f32_16x16x32_bf16(x10, b0[q], a1, 0, 0, 0); a1 = __builtin_amdgcn_mfma_f32_16x16x32_bf16(x11, b1[q], a1, 0, 0, 0);
#pragma unroll
              for (int r = 0; r < 4; ++r) { O1[(m * 32 + fq * 4 + r) * 256 + nt * 16 + fr] = a0[r]; O1[(m * 32 + 16 + fq * 4 + r) * 256 + nt * 16 + fr] = a1[r]; } } }
        __syncthreads();
        if (pass == 0) {
            const float w0b0 = p.in[15][(l * 2 + 0) * 256 + c], w0b1 = p.in[15][(l * 2 + 1) * 256 + c];
#pragma unroll
            for (int i = 0; i < 16; ++i) { const int tok = hh * 16 + i; const size_t o = (size_t)(t0 + tok) * 256 + c;
                const float sg0 = sigmoidf_(w0b0 + O1[tok * 256 + c]), sg1 = sigmoidf_(w0b1 + O1[(32 + tok) * 256 + c]);
                RM0[o] = f2bf(1.f - __expf(-0.60653066f * sg0)); RM1[o] = f2bf(1.f - __expf(-0.60653066f * sg1)); }
        } else {
            const float a0b0 = p.in[17][(l * 2 + 0) * 256 + c], a0b1 = p.in[17][(l * 2 + 1) * 256 + c];
            const float ka = p.in[21][l * 256 + c], rk = p.in[22][l * 256 + c];
#pragma unroll
            for (int i = 0; i < 16; ++i) { const int tok = hh * 16 + i, row = t0 + tok; const size_t o = (size_t)row * 256 + c;
                const bf16_t kb = k_s[tok * 256 + c], vb = v_s[tok * 256 + c], rb = r_s[tok * 256 + c];
                const float k = bf2f(kb), r = bf2f(rb);
                const float a0 = sigmoidf_(a0b0 + O1[tok * 256 + c]), a1 = sigmoidf_(a0b1 + O1[(32 + tok) * 256 + c]);
                const float kt0 = k * (1.f + (a0 - 1.f) * ka), kt1 = k * (1.f + (a1 - 1.f) * ka);
                const float bs = wave_sum(r * (kt0 + kt1) * rk);
                RK[o] = kb; RV[o] = vb; RR[o] = rb; RA0[o] = f2bf(a0); RA1[o] = f2bf(a1);
                if ((tid & 63) == 0) BON[(size_t)row * 4 + h] = bs; }
        }
        __syncthreads();
    }
}
__device__ __forceinline__ int ret_chunk_index(int cr, int& b) { if (cr < 256) { b = cr >> 5; return 2 + (cr & 31); } b = (cr - 256) >> 1; return (cr - 256) & 1; }
__device__ __forceinline__ void ret_kv_item(const Params& p, LAS unsigned char* lds, int item) {
    const int tid = get_tid(), lane = tid & 63, wave = tid >> 6, fr = lane & 15, fq = lane >> 4;
    const bf16_t* P = (const bf16_t*)(p.ws + WS_P);
    const int cr = item >> 2, h = item & 3; int b; const int ci = ret_chunk_index(cr, b);
    const int r0 = cr * 128;
    LAS unsigned char* Ktf = lds;
    LAS unsigned char* Ktb = lds + 64 * 272;
    LAS unsigned char* Vt = lds + 2 * 64 * 272;
    const float lg2 = log1pf(-exp2f(-5.f - (float)h)) * 1.44269504f;
#pragma unroll
    for (int it = 0; it < 2; ++it) { const int pc = tid + it * 512, j = pc >> 3, c8 = pc & 7;
        const u32x4 kk = *(const u32x4*)(P + (size_t)(r0 + j) * NP + PC_RETK + h * 64 + c8 * 8);
        const u32x4 vv = *(const u32x4*)(P + (size_t)(r0 + j) * NP + PC_RETV + h * 64 + c8 * 8);
        float kf[8]; unpack8(kk, kf);
        const float df = 0.125f * __builtin_amdgcn_exp2f((float)(127 - j) * lg2), db = 0.125f * __builtin_amdgcn_exp2f((float)j * lg2);
        const unsigned vw[4] = {vv.x, vv.y, vv.z, vv.w};
#pragma unroll
        for (int x = 0; x < 8; ++x) { const int d = c8 * 8 + x;
            *(LAS bf16_t*)(Ktf + d * 272 + j * 2) = f2bf(kf[x] * df); *(LAS bf16_t*)(Ktb + d * 272 + j * 2) = f2bf(kf[x] * db);
            *(LAS bf16_t*)(Vt + d * 272 + j * 2) = (bf16_t)((x & 1) ? (vw[x >> 1] >> 16) : (vw[x >> 1] & 0xffff)); } }
    __syncthreads();
    const int dir = wave >> 2, mt = wave & 3;
    LAS unsigned char* A = dir ? Ktb : Ktf;
    bf16x8 af[4];
#pragma unroll
    for (int kc = 0; kc < 4; ++kc) af[kc] = *(const LAS bf16x8*)(A + (mt * 16 + fr) * 272 + kc * 64 + fq * 16);
    float* RS = (float*)(p.ws + WS_RET) + ((size_t)((b * 4 + h) * 34 + ci) * 2 + dir) * 4096;
#pragma unroll
    for (int nt = 0; nt < 4; ++nt) { f32x4 acc = (f32x4){0.f, 0.f, 0.f, 0.f};
#pragma unroll
        for (int kc = 0; kc < 4; ++kc) { const bf16x8 bf = *(const LAS bf16x8*)(Vt + (nt * 16 + fr) * 272 + kc * 64 + fq * 16);
            acc = __builtin_amdgcn_mfma_f32_16x16x32_bf16(af[kc], bf, acc, 0, 0, 0); }
#pragma unroll
        for (int r = 0; r < 4; ++r) RS[(mt * 16 + fq * 4 + r) * 64 + nt * 16 + fr] = acc[r]; }
    __syncthreads();
}
__device__ __forceinline__ void swa_prep_item(const Params& p, LAS unsigned char* lds, int tile) {
    const int tid = get_tid();
    bf16_t* P = (bf16_t*)(p.ws + WS_P);
    const float* tabc = (const float*)(p.ws + WS_TAB); const float* tabs = tabc + 1024;
    bf16_t* KS = (bf16_t*)(p.ws + WS_KS); bf16_t* VT = (bf16_t*)(p.ws + WS_VTS);
    const int t0 = tile * 64; const SeqInfo s0 = seq_of_row(t0);
    const int key0 = s0.isctx ? s0.pos : CTXL + s0.pos;
    LAS bf16_t* Vs = (LAS bf16_t*)lds;
    u32x4 vreg[2];
#pragma unroll
    for (int it = 0; it < 2; ++it) { const int pc = tid + it * 512, tok = pc >> 4, c8 = pc & 15; vreg[it] = *(const u32x4*)(P + (size_t)(t0 + tok) * NP + PC_SWAV + c8 * 8); }
    u32x4 x1[3], x2[3];
#pragma unroll
    for (int it = 0; it < 3; ++it) { const int e = tid + it * 512; const int tok = e / 24, rem = e % 24, hd = rem >> 2, axis = (rem >> 1) & 1, fg = rem & 1;
        const int colbase = (hd < 4 ? PC_SWAQ + hd * 64 : PC_SWAK + (hd - 4) * 64) + axis * 32 + fg * 8;
        x1[it] = *(const u32x4*)(P + (size_t)(t0 + tok) * NP + colbase); x2[it] = *(const u32x4*)(P + (size_t)(t0 + tok) * NP + colbase + 16); }
#pragma unroll
    for (int it = 0; it < 2; ++it) { const int pc = tid + it * 512, tok = pc >> 4, c8 = pc & 15; *(LAS u32x4*)(Vs + tok * 136 + c8 * 8) = vreg[it]; }
#pragma unroll
    for (int it = 0; it < 3; ++it) { const int e = tid + it * 512; const int tok = e / 24, rem = e % 24, hd = rem >> 2, axis = (rem >> 1) & 1, fg = rem & 1;
        const int row = t0 + tok, pos = s0.pos + tok;
        const int colbase = (hd < 4 ? PC_SWAQ + hd * 64 : PC_SWAK + (hd - 4) * 64) + axis * 32 + fg * 8;
        float a[8], bb[8]; unpack8(x1[it], a); unpack8(x2[it], bb);
        if (!s0.isctx) { const int pp = axis == 0 ? (pos >> 6) : (pos & 63);
            const f32x4 c0 = *(const f32x4*)(tabc + pp * 16 + fg * 8), c1 = *(const f32x4*)(tabc + pp * 16 + fg * 8 + 4), s0v = *(const f32x4*)(tabs + pp * 16 + fg * 8), s1v = *(const f32x4*)(tabs + pp * 16 + fg * 8 + 4);
            const float cs[8] = {c0.x, c0.y, c0.z, c0.w, c1.x, c1.y, c1.z, c1.w}, sn[8] = {s0v.x, s0v.y, s0v.z, s0v.w, s1v.x, s1v.y, s1v.z, s1v.w};
#pragma unroll
            for (int x = 0; x < 8; ++x) { const float y1 = a[x] * cs[x] - bb[x] * sn[x], y2 = bb[x] * cs[x] + a[x] * sn[x]; a[x] = y1; bb[x] = y2; } }
        u32x4 o1, o2; o1.x = pk2(a[0], a[1]); o1.y = pk2(a[2], a[3]); o1.z = pk2(a[4], a[5]); o1.w = pk2(a[6], a[7]);
        o2.x = pk2(bb[0], bb[1]); o2.y = pk2(bb[2], bb[3]); o2.z = pk2(bb[4], bb[5]); o2.w = pk2(bb[6], bb[7]);
        if (hd < 4) { if (!s0.isctx) { *(u32x4*)(P + (size_t)row * NP + colbase) = o1; *(u32x4*)(P + (size_t)row * NP + colbase + 16) = o2; } }
        else { bf16_t* kd = KS + ((size_t)(s0.b * 2 + (hd - 4)) * NKEYS + key0 + tok) * 64 + axis * 32 + fg * 8; *(u32x4*)kd = o1; *(u32x4*)(kd + 16) = o2; }
    }
    __syncthreads();
#pragma unroll
    for (int it = 0; it < 2; ++it) { const int pc = tid + it * 512, hd = pc >> 3, k8 = pc & 7, hk = hd >> 6, d = hd & 63;
        unsigned w[4];
#pragma unroll
        for (int x = 0; x < 4; ++x) w[x] = (unsigned)Vs[(k8 * 8 + 2 * x) * 136 + hd] | ((unsigned)Vs[(k8 * 8 + 2 * x + 1) * 136 + hd] << 16);
        *(u32x4*)(VT + ((size_t)(s0.b * 2 + hk) * 64 + d) * NKEYS + key0 + k8 * 8) = (u32x4){w[0], w[1], w[2], w[3]}; }
    __syncthreads();
}
__device__ __forceinline__ void mla_proj_item(const Params& p, int l, LAS unsigned char* lds, int tile);
__device__ __forceinline__ void phase_prepA(const Params& p, int l, LAS unsigned char* lds, int bid, int nb) {
    for (int it = bid; it < TT / 32; it += nb) rwkv_prep_item(p, l, lds, it);
}
__device__ __forceinline__ void prep_rest_items(const Params& p, int l, LAS unsigned char* lds, int first, int stride) {
    constexpr int N2 = 272 * 4, N3 = TT / 64, N4 = TT / 32;
    for (int it = first; it < N2 + N3 + N4; it += stride) {
        if (it < N4) mla_proj_item(p, l, lds, it);
        else if (it < N4 + N2) ret_kv_item(p, lds, it - N4);
        else swa_prep_item(p, lds, it - N4 - N2);
    }
}

__device__ __forceinline__ void mla_proj_item(const Params& p, int l, LAS unsigned char* lds, int tile) {
    const int tid = get_tid(), lane = tid & 63, wave = tid >> 6, fr = lane & 15, fq = lane >> 4;
    const bf16_t* P = (const bf16_t*)(p.ws + WS_P);
    const float* tabc = (const float*)(p.ws + WS_TAB) + 2048; const float* tabs = tabc + 512;
    const int t0 = tile * 32; const SeqInfo s0 = seq_of_row(t0);
    const int key0 = s0.isctx ? s0.pos : CTXL + s0.pos;
    LAS unsigned char* qn = lds;
    LAS unsigned char* kvn = lds + 32 * 528;
    LAS float* qo = (LAS float*)(lds + 32 * 528 + 32 * 272);
    LAS float* kvo = qo + 32 * 384;
    const float* qg = p.in[24] + l * 256; const float* kvg = p.in[26] + l * 128;
    for (int i = 0; i < 4; ++i) { const int tok = wave * 4 + i, row = t0 + tok;
        float x[4]; float ss = 0.f;
#pragma unroll
        for (int j = 0; j < 4; ++j) { x[j] = bf2f(P[(size_t)row * NP + PC_MLAQD + j * 64 + lane]); ss += x[j] * x[j]; }
        const float rq = 1.f / sqrtf(wave_sum(ss) * (1.f / 256.f) + 1e-6f);
#pragma unroll
        for (int j = 0; j < 4; ++j) *(LAS bf16_t*)(qn + tok * 528 + (j * 64 + lane) * 2) = f2bf(x[j] * rq * qg[j * 64 + lane]);
        float y[2]; float s2 = 0.f;
#pragma unroll
        for (int j = 0; j < 2; ++j) { y[j] = bf2f(P[(size_t)row * NP + PC_MLAKVD + j * 64 + lane]); s2 += y[j] * y[j]; }
        const float rk = 1.f / sqrtf(wave_sum(s2) * (1.f / 128.f) + 1e-6f);
#pragma unroll
        for (int j = 0; j < 2; ++j) *(LAS bf16_t*)(kvn + tok * 272 + (j * 64 + lane) * 2) = f2bf(y[j] * rk * kvg[j * 64 + lane]);
    }
    __syncthreads();
    {
        const bf16_t* WqT = (const bf16_t*)(p.ws + WS_MLAW + (size_t)l * MLAW_LAYER);
        const bf16_t* WkvT = (const bf16_t*)(p.ws + WS_MLAW + (size_t)l * MLAW_LAYER + MLAW_KV);
        {
            bf16x8 bq[3][8];
#pragma unroll
            for (int q = 0; q < 3; ++q) { const bf16_t* wrow = WqT + (size_t)((wave + 8 * q) * 16 + fr) * 256 + fq * 8;
#pragma unroll
                for (int kc = 0; kc < 8; ++kc) bq[q][kc] = *(const bf16x8*)(wrow + kc * 32); }
#pragma unroll
            for (int q = 0; q < 3; ++q) { const int nt = wave + 8 * q;
                f32x4 a0 = (f32x4){0.f, 0.f, 0.f, 0.f}, a1 = a0;
#pragma unroll
                for (int kc = 0; kc < 8; ++kc) { const bf16x8 x0 = *(const LAS bf16x8*)(qn + fr * 528 + kc * 64 + fq * 16), x1 = *(const LAS bf16x8*)(qn + (16 + fr) * 528 + kc * 64 + fq * 16);
                    a0 = __builtin_amdgcn_mfma_f32_16x16x32_bf16(x0, bq[q][kc], a0, 0, 0, 0); a1 = __builtin_amdgcn_mfma_f32_16x16x32_bf16(x1, bq[q][kc], a1, 0, 0, 0); }
#pragma unroll
                for (int r = 0; r < 4; ++r) { qo[(fq * 4 + r) * 384 + nt * 16 + fr] = a0[r]; qo[(16 + fq * 4 + r) * 384 + nt * 16 + fr] = a1[r]; } }
        }
        {
            bf16x8 bk[4][4];
#pragma unroll
            for (int q = 0; q < 4; ++q) { const bf16_t* wrow = WkvT + (size_t)((wave + 8 * q) * 16 + fr) * 128 + fq * 8;
#pragma unroll
                for (int kc = 0; kc < 4; ++kc) bk[q][kc] = *(const bf16x8*)(wrow + kc * 32); }
#pragma unroll
            for (int q = 0; q < 4; ++q) { const int n0 = (wave + 8 * q) * 16;
                f32x4 a0 = (f32x4){0.f, 0.f, 0.f, 0.f}, a1 = a0;
#pragma unroll
                for (int kc = 0; kc < 4; ++kc) { const bf16x8 x0 = *(const LAS bf16x8*)(kvn + fr * 272 + kc * 64 + fq * 16), x1 = *(const LAS bf16x8*)(kvn + (16 + fr) * 272 + kc * 64 + fq * 16);
                    a0 = __builtin_amdgcn_mfma_f32_16x16x32_bf16(x0, bk[q][kc], a0, 0, 0, 0); a1 = __builtin_amdgcn_mfma_f32_16x16x32_bf16(x1, bk[q][kc], a1, 0, 0, 0); }
#pragma unroll
                for (int r = 0; r < 4; ++r) { kvo[(fq * 4 + r) * 512 + n0 + fr] = a0[r]; kvo[(16 + fq * 4 + r) * 512 + n0 + fr] = a1[r]; } }
        }
    }
    __syncthreads();
    {
        const int h = tid >> 7, dd = tid & 127;
        if (dd < 64) { bf16_t* KM = (bf16_t*)(p.ws + WS_KM) + ((size_t)(s0.b * 4 + h) * NKEYS + key0) * 96 + dd;
#pragma unroll
            for (int i = 0; i < 32; ++i) KM[(size_t)i * 96] = f2bf(kvo[i * 512 + tid]); }
        else { bf16_t* VT = (bf16_t*)(p.ws + WS_VTM) + ((size_t)(s0.b * 4 + h) * 64 + (dd - 64)) * NKEYS + key0;
            unsigned w[16];
#pragma unroll
            for (int i = 0; i < 16; ++i) w[i] = pk2(kvo[(2 * i) * 512 + tid], kvo[(2 * i + 1) * 512 + tid]);
#pragma unroll
            for (int i = 0; i < 4; ++i) *(u32x4*)(VT + i * 8) = (u32x4){w[4 * i], w[4 * i + 1], w[4 * i + 2], w[4 * i + 3]}; }
    }
    bf16_t* MQ = (bf16_t*)(p.ws + WS_MQ);
    for (int e = tid; e < 32 * 384; e += 512) { const int tok = e / 384, c = e % 384, dd = c % 96; const int pos = s0.pos + tok;
        float v = qo[e];
        if (dd >= 64 && !s0.isctx) { const int pe = dd - 64, axis = pe >> 4, half = (pe >> 3) & 1, f = pe & 7; const int pp = axis == 0 ? (pos >> 6) : (pos & 63);
            const float cs = tabc[pp * 8 + f], sn = tabs[pp * 8 + f];
            const float x1 = half ? qo[e - 8] : v, x2 = half ? v : qo[e + 8];
            v = half ? (x2 * cs + x1 * sn) : (x1 * cs - x2 * sn); }
        MQ[(size_t)(t0 + tok) * 384 + c] = f2bf(v); }
    for (int e = tid; e < 32 * 32; e += 512) { const int tok = e >> 5, pe = e & 31, axis = pe >> 4, half = (pe >> 3) & 1, f = pe & 7; const int row = t0 + tok, pos = s0.pos + tok;
        float v = bf2f(P[(size_t)row * NP + PC_MLAKPE + pe]);
        if (!s0.isctx) { const int pp = axis == 0 ? (pos >> 6) : (pos & 63); const float cs = tabc[pp * 8 + f], sn = tabs[pp * 8 + f];
            const float other = bf2f(P[(size_t)row * NP + PC_MLAKPE + (half ? pe - 8 : pe + 8)]);
            const float x1 = half ? other : v, x2 = half ? v : other;
            v = half ? (x2 * cs + x1 * sn) : (x1 * cs - x2 * sn); }
        const bf16_t o = f2bf(v);
#pragma unroll
        for (int h = 0; h < 4; ++h) ((bf16_t*)(p.ws + WS_KM))[((size_t)(s0.b * 4 + h) * NKEYS + key0 + tok) * 96 + 64 + pe] = o; }
    __syncthreads();
}
__device__ __forceinline__ void ret_scan_item(const Params& p, int l, int item) {
    const int tid = get_tid(); const int seq = item >> 1, dir = item & 1, h = seq & 3;
    const float lg = log1pf(-exp2f(-5.f - (float)h)); const float cdec = expf(128.f * lg);
    float* base = (float*)(p.ws + WS_RET) + (size_t)seq * 34 * 2 * 4096 + dir * 4096;
    auto ci_of = [&](int st) -> int { return dir == 0 ? st : (st == 0 ? 1 : (st == 1 ? 0 : 35 - st)); };
    float S[8];
#pragma unroll
    for (int i = 0; i < 8; ++i) S[i] = 0.f;
    f32x4 pa[4], pb[4];
#pragma unroll
    for (int k = 0; k < 4; ++k) { const float* q = base + (size_t)ci_of(k) * 2 * 4096 + tid * 8; pa[k] = *(const f32x4*)q; pb[k] = *(const f32x4*)(q + 4); }
#pragma unroll 1
    for (int st0 = 0; st0 < 36; st0 += 4) {
#pragma unroll
        for (int k = 0; k < 4; ++k) { const int st = st0 + k;
            if (st < 34) {
                float* q = base + (size_t)ci_of(st) * 2 * 4096 + tid * 8;
                const f32x4 t0 = pa[k], t1 = pb[k];
                if (st + 4 < 34) { const float* qn = base + (size_t)ci_of(st + 4) * 2 * 4096 + tid * 8; pa[k] = *(const f32x4*)qn; pb[k] = *(const f32x4*)(qn + 4); }
                *(f32x4*)q = (f32x4){S[0], S[1], S[2], S[3]}; *(f32x4*)(q + 4) = (f32x4){S[4], S[5], S[6], S[7]};
                S[0] = S[0] * cdec + t0.x; S[1] = S[1] * cdec + t0.y; S[2] = S[2] * cdec + t0.z; S[3] = S[3] * cdec + t0.w;
                S[4] = S[4] * cdec + t1.x; S[5] = S[5] * cdec + t1.y; S[6] = S[6] * cdec + t1.z; S[7] = S[7] * cdec + t1.w;
            } }
    }
    asm volatile("s_waitcnt vmcnt(0)" ::: "memory");
    __syncthreads();
    if (tid == 0) { __builtin_amdgcn_fence(__ATOMIC_RELEASE, "agent"); asm volatile("s_waitcnt vmcnt(0)" ::: "memory");
        __hip_atomic_fetch_add((unsigned*)(p.ws + WS_CTR) + 2 + l, 1u, __ATOMIC_RELAXED, __HIP_MEMORY_SCOPE_AGENT); }
}
__device__ __forceinline__ void wait_counter(const Params& p, int idx, unsigned need) {
    if (get_tid() == 0) { unsigned* f = (unsigned*)(p.ws + WS_CTR) + idx; unsigned sp = 0;
        while (__hip_atomic_load(f, __ATOMIC_RELAXED, __HIP_MEMORY_SCOPE_AGENT) < need) { __builtin_amdgcn_s_sleep(4); if (++sp > (1u << 22)) break; }
        __builtin_amdgcn_fence(__ATOMIC_ACQUIRE, "agent"); asm volatile("s_waitcnt vmcnt(0)" ::: "memory"); }
    __syncthreads();
}
template <int DK>
__device__ __forceinline__ void attn_unit(const bf16_t* Q, int qstride, const bf16_t* K, const bf16_t* Vt, int nctx, int mt0, int mt1, bool masked, int qpos0,
                                          bool has_sink, float sink, float scale, bf16_t* O, int ostride, LAS unsigned char* lds) {
    constexpr int KC = DK / 32, KP = DK + 8, KROW = KP * 2;
    constexpr int PIECES_K = 64 * DK / 8;
    constexpr int BUFB = 64 * KROW + 64 * 144;
    const int tid = get_tid(), lane = tid & 63, wave = tid >> 6, fr = lane & 15, fq = lane >> 4;
    const float sl2 = scale * 1.44269504f;
    bf16x8 qf[2][KC];
#pragma unroll
    for (int g = 0; g < 2; ++g)
#pragma unroll
        for (int kc = 0; kc < KC; ++kc) { const u32x4 u = *(const u32x4*)(Q + (size_t)(wave * 32 + g * 16 + fr) * qstride + kc * 32 + fq * 8); float f[8]; unpack8(u, f);
            u32x4 o; o.x = cvt_pk_bf16(f[0] * sl2, f[1] * sl2); o.y = cvt_pk_bf16(f[2] * sl2, f[3] * sl2); o.z = cvt_pk_bf16(f[4] * sl2, f[5] * sl2); o.w = cvt_pk_bf16(f[6] * sl2, f[7] * sl2);
            qf[g][kc] = __builtin_bit_cast(bf16x8, o); }
    float mq[2] = {0.f, 0.f}, lsum[2] = {0.f, 0.f}; f32x4 o[2][4];
#pragma unroll
    for (int g = 0; g < 2; ++g)
#pragma unroll
        for (int n = 0; n < 4; ++n) o[g][n] = (f32x4){0.f, 0.f, 0.f, 0.f};
    const int ntiles = nctx + (mt1 - mt0);
    u32x4 kr[2], vr;
    auto issue = [&](int ti) {
        const int tile = ti < nctx ? ti : mt0 + (ti - nctx);
        const bf16_t* kb = K + (size_t)tile * 64 * DK;
#pragma unroll
        for (int i = 0; i < 2; ++i) { const int pc = tid + i * 512; if (pc < PIECES_K) kr[i] = *(const u32x4*)(kb + (size_t)pc * 8); }
        { const int d = tid >> 3, c8 = tid & 7; vr = *(const u32x4*)(Vt + (size_t)d * NKEYS + tile * 64 + c8 * 8); }
    };
    auto stash = [&](int bufi) {
        LAS unsigned char* Kt = lds + bufi * BUFB; LAS unsigned char* Vl = Kt + 64 * KROW;
#pragma unroll
        for (int i = 0; i < 2; ++i) { const int pc = tid + i * 512; if (pc < PIECES_K) { const int row = pc / (DK / 8), c8 = pc % (DK / 8); *(LAS u32x4*)(Kt + row * KROW + c8 * 16) = kr[i]; } }
        { const int d = tid >> 3, c8 = tid & 7; *(LAS u32x4*)(Vl + d * 144 + c8 * 16) = vr; }
    };
    issue(0); stash(0);
    if (ntiles > 1) issue(1);
    __syncthreads();
    for (int ti = 0; ti < ntiles; ++ti) {
        const int tile = ti < nctx ? ti : mt0 + (ti - nctx);
        LAS unsigned char* Kt = lds + (ti & 1) * BUFB; LAS unsigned char* Vl = Kt + 64 * KROW;
        if (ti + 1 < ntiles) { stash((ti + 1) & 1); if (ti + 2 < ntiles) issue(ti + 2); }
        f32x4 s[2][4];
#pragma unroll
        for (int n = 0; n < 4; ++n) {
            s[0][n] = (f32x4){-mq[0], -mq[0], -mq[0], -mq[0]}; s[1][n] = (f32x4){-mq[1], -mq[1], -mq[1], -mq[1]};
#pragma unroll
            for (int kc = 0; kc < KC; ++kc) { const bf16x8 kf = *(const LAS bf16x8*)(Kt + (n * 16 + fr) * KROW + kc * 64 + fq * 16);
                s[0][n] = __builtin_amdgcn_mfma_f32_16x16x32_bf16(kf, qf[0][kc], s[0][n], 0, 0, 0);
                s[1][n] = __builtin_amdgcn_mfma_f32_16x16x32_bf16(kf, qf[1][kc], s[1][n], 0, 0, 0); } }
        if (ti == 0) {
#pragma unroll
            for (int g = 0; g < 2; ++g) {
                float t = -INFINITY;
#pragma unroll
                for (int n = 0; n < 4; ++n)
#pragma unroll
                    for (int r = 0; r < 4; ++r) t = fmaxf(t, s[g][n][r]);
                t = fmaxf(t, __shfl_xor(t, 16)); t = fmaxf(t, __shfl_xor(t, 32));
                if (has_sink) t = fmaxf(t, sink * 1.44269504f);
                mq[g] = t;
#pragma unroll
                for (int n = 0; n < 4; ++n)
#pragma unroll
                    for (int r = 0; r < 4; ++r) s[g][n][r] -= t;
            }
        }
        if (masked && ti >= nctx) {
#pragma unroll
            for (int g = 0; g < 2; ++g)
#pragma unroll
                for (int n = 0; n < 4; ++n)
#pragma unroll
                    for (int r = 0; r < 4; ++r) { const int kp = tile * 64 + n * 16 + fq * 4 + r - CTXL, qp = qpos0 + wave * 32 + g * 16 + fr; const int df = qp - kp; if (df > 128 || df < -128) s[g][n][r] = -INFINITY; }
        }
#pragma unroll
        for (int g = 0; g < 2; ++g)
#pragma unroll
            for (int n = 0; n < 4; ++n)
#pragma unroll
                for (int r = 0; r < 4; ++r) { s[g][n][r] = __builtin_amdgcn_exp2f(s[g][n][r]); lsum[g] += s[g][n][r]; }
#pragma unroll
        for (int c = 0; c < 2; ++c) {
            bf16x8 pf[2];
#pragma unroll
            for (int g = 0; g < 2; ++g) { u32x4 pu; pu.x = cvt_pk_bf16(s[g][2 * c][0], s[g][2 * c][1]); pu.y = cvt_pk_bf16(s[g][2 * c][2], s[g][2 * c][3]);
                pu.z = cvt_pk_bf16(s[g][2 * c + 1][0], s[g][2 * c + 1][1]); pu.w = cvt_pk_bf16(s[g][2 * c + 1][2], s[g][2 * c + 1][3]); pf[g] = __builtin_bit_cast(bf16x8, pu); }
#pragma unroll
            for (int n = 0; n < 4; ++n) {
                const u32x2 lo = *(const LAS u32x2*)(Vl + (n * 16 + fr) * 144 + ((2 * c) * 16 + fq * 4) * 2), hi = *(const LAS u32x2*)(Vl + (n * 16 + fr) * 144 + ((2 * c + 1) * 16 + fq * 4) * 2);
                const bf16x8 vf = __builtin_bit_cast(bf16x8, (u32x4){lo.x, lo.y, hi.x, hi.y});
                o[0][n] = __builtin_amdgcn_mfma_f32_16x16x32_bf16(vf, pf[0], o[0][n], 0, 0, 0);
                o[1][n] = __builtin_amdgcn_mfma_f32_16x16x32_bf16(vf, pf[1], o[1][n], 0, 0, 0); }
        }
        __syncthreads();
    }
#pragma unroll
    for (int g = 0; g < 2; ++g) {
        float t = lsum[g];
        t += __shfl_xor(t, 16); t += __shfl_xor(t, 32);
        if (has_sink) t += __builtin_amdgcn_exp2f(sink * 1.44269504f - mq[g]);
        const float inv = 1.f / t;
#pragma unroll
        for (int n = 0; n < 4; ++n) { u32x2 ov; ov.x = cvt_pk_bf16(o[g][n][0] * inv, o[g][n][1] * inv); ov.y = cvt_pk_bf16(o[g][n][2] * inv, o[g][n][3] * inv);
            *(u32x2*)(O + (size_t)(wave * 32 + g * 16 + fr) * ostride + n * 16 + fq * 4) = ov; }
    }
}

__device__ __forceinline__ void ret_out_item(const Params& p, int l, LAS unsigned char* lds, int item) {
    const int tid = get_tid(), lane = tid & 63, wave = tid >> 6, fr = lane & 15, fq = lane >> 4;
    bf16_t* P = (bf16_t*)(p.ws + WS_P);
    const int cr = item >> 2, h = item & 3; int b; const int ci = ret_chunk_index(cr, b);
    const int r0 = cr * 128;
    const float lg2 = log1pf(-exp2f(-5.f - (float)h)) * 1.44269504f;
    LAS unsigned char* Kb = lds;
    LAS unsigned char* Vt = lds + 18432;
    LAS unsigned char* SfT = lds + 35840;
    LAS unsigned char* SbT = lds + 45056;
    for (int pc = tid; pc < 1024; pc += 512) { const int j = pc >> 3, c8 = pc & 7;
        const u32x4 kk = *(const u32x4*)(P + (size_t)(r0 + j) * NP + PC_RETK + h * 64 + c8 * 8);
        const u32x4 vv = *(const u32x4*)(P + (size_t)(r0 + j) * NP + PC_RETV + h * 64 + c8 * 8);
        float kf[8]; unpack8(kk, kf);
        u32x4 ko; ko.x = pk2(kf[0] * 0.125f, kf[1] * 0.125f); ko.y = pk2(kf[2] * 0.125f, kf[3] * 0.125f); ko.z = pk2(kf[4] * 0.125f, kf[5] * 0.125f); ko.w = pk2(kf[6] * 0.125f, kf[7] * 0.125f);
        *(LAS u32x4*)(Kb + j * 144 + c8 * 16) = ko;
        const unsigned vw[4] = {vv.x, vv.y, vv.z, vv.w};
#pragma unroll
        for (int x = 0; x < 8; ++x) *(LAS bf16_t*)(Vt + (c8 * 8 + x) * 272 + j * 2) = (bf16_t)((x & 1) ? (vw[x >> 1] >> 16) : (vw[x >> 1] & 0xffff)); }
    { const float* RS = (const float*)(p.ws + WS_RET) + ((size_t)((b * 4 + h) * 34 + ci) * 2) * 4096;
      for (int pc = tid; pc < 1024; pc += 512) { const int d = pc >> 4, e4 = (pc & 15) * 4;
          const f32x4 a = *(const f32x4*)(RS + d * 64 + e4), bb = *(const f32x4*)(RS + 4096 + d * 64 + e4);
#pragma unroll
          for (int x = 0; x < 4; ++x) { *(LAS bf16_t*)(SfT + (e4 + x) * 144 + d * 2) = f2bf(a[x]); *(LAS bf16_t*)(SbT + (e4 + x) * 144 + d * 2) = f2bf(bb[x]); } } }
    const int i = wave * 16 + fr;
    u32x4 qraw[2];
#pragma unroll
    for (int kc = 0; kc < 2; ++kc) qraw[kc] = *(const u32x4*)(P + (size_t)(r0 + i) * NP + PC_RETQ + h * 64 + kc * 32 + fq * 8);
    __syncthreads();
    f32x4 s[8];
#pragma unroll
    for (int nb = 0; nb < 8; ++nb) { s[nb] = (f32x4){0.f, 0.f, 0.f, 0.f};
#pragma unroll
        for (int kc = 0; kc < 2; ++kc) { const bf16x8 kf = *(const LAS bf16x8*)(Kb + (nb * 16 + fr) * 144 + kc * 64 + fq * 16);
            s[nb] = __builtin_amdgcn_mfma_f32_16x16x32_bf16(kf, __builtin_bit_cast(bf16x8, qraw[kc]), s[nb], 0, 0, 0); } }
#pragma unroll
    for (int nb = 0; nb < 8; ++nb)
#pragma unroll
        for (int r = 0; r < 4; ++r) { const int j = nb * 16 + fq * 4 + r; const int df = i - j; const int adf = df < 0 ? -df : df;
            float dcy = __builtin_amdgcn_exp2f((float)adf * lg2); if (df == 0) dcy = 2.f; s[nb][r] *= dcy; }
    f32x4 o[4];
#pragma unroll
    for (int n = 0; n < 4; ++n) o[n] = (f32x4){0.f, 0.f, 0.f, 0.f};
#pragma unroll
    for (int c = 0; c < 4; ++c) {
        u32x4 pu; pu.x = cvt_pk_bf16(s[2 * c][0], s[2 * c][1]); pu.y = cvt_pk_bf16(s[2 * c][2], s[2 * c][3]); pu.z = cvt_pk_bf16(s[2 * c + 1][0], s[2 * c + 1][1]); pu.w = cvt_pk_bf16(s[2 * c + 1][2], s[2 * c + 1][3]);
        const bf16x8 pf = __builtin_bit_cast(bf16x8, pu);
#pragma unroll
        for (int n = 0; n < 4; ++n) {
            const u32x2 lo = *(const LAS u32x2*)(Vt + (n * 16 + fr) * 272 + ((2 * c) * 16 + fq * 4) * 2), hi = *(const LAS u32x2*)(Vt + (n * 16 + fr) * 272 + ((2 * c + 1) * 16 + fq * 4) * 2);
            const bf16x8 vf = __builtin_bit_cast(bf16x8, (u32x4){lo.x, lo.y, hi.x, hi.y});
            o[n] = __builtin_amdgcn_mfma_f32_16x16x32_bf16(vf, pf, o[n], 0, 0, 0); }
    }
    const float gf = __builtin_amdgcn_exp2f((float)(i + 1) * lg2), gb = __builtin_amdgcn_exp2f((float)(128 - i) * lg2);
#pragma unroll
    for (int kc = 0; kc < 2; ++kc) {
        float f[8]; unpack8(qraw[kc], f);
        u32x4 uf, ub;
        uf.x = cvt_pk_bf16(f[0] * gf, f[1] * gf); uf.y = cvt_pk_bf16(f[2] * gf, f[3] * gf); uf.z = cvt_pk_bf16(f[4] * gf, f[5] * gf); uf.w = cvt_pk_bf16(f[6] * gf, f[7] * gf);
        ub.x = cvt_pk_bf16(f[0] * gb, f[1] * gb); ub.y = cvt_pk_bf16(f[2] * gb, f[3] * gb); ub.z = cvt_pk_bf16(f[4] * gb, f[5] * gb); ub.w = cvt_pk_bf16(f[6] * gb, f[7] * gb);
        const bf16x8 qF = __builtin_bit_cast(bf16x8, uf), qB = __builtin_bit_cast(bf16x8, ub);
#pragma unroll
        for (int n = 0; n < 4; ++n) {
            const bf16x8 af = *(const LAS bf16x8*)(SfT + (n * 16 + fr) * 144 + kc * 64 + fq * 16), ab = *(const LAS bf16x8*)(SbT + (n * 16 + fr) * 144 + kc * 64 + fq * 16);
            o[n] = __builtin_amdgcn_mfma_f32_16x16x32_bf16(af, qF, o[n], 0, 0, 0);
            o[n] = __builtin_amdgcn_mfma_f32_16x16x32_bf16(ab, qB, o[n], 0, 0, 0); }
    }
    float sm = 0.f;
#pragma unroll
    for (int n = 0; n < 4; ++n) sm += (o[n][0] + o[n][1]) + (o[n][2] + o[n][3]);
    sm += __shfl_xor(sm, 16); sm += __shfl_xor(sm, 32);
    const float mu = sm * (1.f / 64.f);
    float vs = 0.f;
#pragma unroll
    for (int n = 0; n < 4; ++n)
#pragma unroll
        for (int r = 0; r < 4; ++r) { const float dl = o[n][r] - mu; vs += dl * dl; }
    vs += __shfl_xor(vs, 16); vs += __shfl_xor(vs, 32);
    const float rstd = 1.f / sqrtf(vs * (1.f / 64.f) + 1e-5f);
#pragma unroll
    for (int n = 0; n < 4; ++n) { const int e0 = n * 16 + fq * 4;
        const u32x2 gu = *(const u32x2*)(P + (size_t)(r0 + i) * NP + PC_RETG + h * 64 + e0);
        const f32x4 gn = *(const f32x4*)(p.in[13] + l * 256 + h * 64 + e0);
        const float g0 = bf2f((bf16_t)(gu.x & 0xffff)), g1 = bf2f((bf16_t)(gu.x >> 16)), g2 = bf2f((bf16_t)(gu.y & 0xffff)), g3 = bf2f((bf16_t)(gu.y >> 16));
        u32x2 yo;
        yo.x = cvt_pk_bf16((o[n][0] - mu) * rstd * gn.x * (g0 / (1.f + __expf(-g0))), (o[n][1] - mu) * rstd * gn.y * (g1 / (1.f + __expf(-g1))));
        yo.y = cvt_pk_bf16((o[n][2] - mu) * rstd * gn.z * (g2 / (1.f + __expf(-g2))), (o[n][3] - mu) * rstd * gn.w * (g3 / (1.f + __expf(-g3))));
        *(u32x2*)(P + (size_t)(r0 + i) * NP + PC_RETQ + h * 64 + e0) = yo; }
    __syncthreads();
}

constexpr int NSCANBLK = 128;
__device__ __forceinline__ void rwkv_scan_item(const Params& p, int l, LAS unsigned char* lds, int item) {
    const int tid = get_tid();
    const int sc = item >> 1, half = item & 1;
    const int b = sc >> 3, h = (sc >> 1) & 3, dir = sc & 1;
    const bf16_t* RK = (const bf16_t*)(p.ws + WS_RWK); const bf16_t* RV = (const bf16_t*)(p.ws + WS_RWV); const bf16_t* RR = (const bf16_t*)(p.ws + WS_RWRR);
    const bf16_t* RA = (const bf16_t*)(p.ws + (dir ? WS_RWA1 : WS_RWA0)); const bf16_t* RM = (const bf16_t*)(p.ws + (dir ? WS_RWM1 : WS_RWM0));
    bf16_t* P = (bf16_t*)(p.ws + WS_P);
    const int ocol = (dir ? PC_RWO1 : PC_RWO0) + h * 64 + half * 32;
    LAS float* SA = (LAS float*)lds;
    LAS float* OUT = SA + 64 * 384;
    const int st = tid >> 3, c0 = (tid & 7) * 8;
    float kkp[8], kap[8];
#pragma unroll
    for (int i = 0; i < 8; ++i) { kkp[i] = p.in[20][l * 256 + h * 64 + c0 + i]; kap[i] = p.in[21][l * 256 + h * 64 + c0 + i]; }
    const int row_l = tid >> 4, kq = tid & 15;
    f32x2 S[2];
#pragma unroll
    for (int i = 0; i < 2; ++i) S[i] = (f32x2){0.f, 0.f};
    auto row_of = [&](int s) -> int {
        if (s < CTXL) return TMAIN + b * CTXL + (dir ? CTXL - 1 - s : s);
        const int t = s - CTXL; return b * SEQL + (dir ? SEQL - 1 - t : t);
    };
    u32x4 gk, gv, gr, ga, gm;
    auto issue = [&](int ch) { const size_t o = (size_t)row_of(ch * 64 + st) * 256 + h * 64 + c0;
        gk = *(const u32x4*)(RK + o); gv = *(const u32x4*)(RV + o); gr = *(const u32x4*)(RR + o); ga = *(const u32x4*)(RA + o); gm = *(const u32x4*)(RM + o); };
    issue(0);
    for (int ch = 0; ch < 68; ++ch) {
        {
            float k[8], a[8], om[8], rr[8], vv8[8]; unpack8(gk, k); unpack8(ga, a); unpack8(gm, om); unpack8(gr, rr); unpack8(gv, vv8);
            float kk[8]; float n2 = 0.f;
#pragma unroll
            for (int i = 0; i < 8; ++i) { kk[i] = k[i] * kkp[i]; n2 += kk[i] * kk[i]; }
            n2 = red8(n2);
            const float rn = 1.f / sqrtf(fmaxf(n2, 1e-12f));
            f32x4 o0, o1;
#define ST8(DST, EXPR) { float t8[8]; _Pragma("unroll") for (int i = 0; i < 8; ++i) t8[i] = (EXPR); \
            *(LAS f32x4*)(SA + st * 384 + (DST) * 64 + c0) = (f32x4){t8[0], t8[1], t8[2], t8[3]}; *(LAS f32x4*)(SA + st * 384 + (DST) * 64 + c0 + 4) = (f32x4){t8[4], t8[5], t8[6], t8[7]}; }
            ST8(0, kk[i] * rn)
            ST8(1, 1.f - om[i])
            ST8(2, kk[i] * rn * a[i])
            ST8(3, k[i] * (1.f + (a[i] - 1.f) * kap[i]))
            ST8(4, rr[i])
            ST8(5, vv8[i])
#undef ST8
        }
        __syncthreads();
        if (ch + 1 < 68) issue(ch + 1);
        {
            struct Ops { f32x4 kh, w, b, t, r; float vv; };
            const LAS float* sbase = SA + kq * 4; const LAS float* vbase = SA + 5 * 64 + half * 32 + row_l;
            auto ldops = [&](int s) -> Ops { Ops q;
                q.kh = *(const LAS f32x4*)(sbase + s * 384); q.w = *(const LAS f32x4*)(sbase + s * 384 + 64); q.b = *(const LAS f32x4*)(sbase + s * 384 + 128);
                q.t = *(const LAS f32x4*)(sbase + s * 384 + 192); q.r = *(const LAS f32x4*)(sbase + s * 384 + 256);
                q.vv = vbase[s * 384]; return q; };
            Ops nx = ldops(0);
#pragma unroll 2
            for (int s = 0; s < 64; ++s) {
                const Ops c = nx;
                nx = ldops(s + 1 < 64 ? s + 1 : 63);
                f32x2 a2 = S[0] * (f32x2){c.kh.x, c.kh.y}; a2 = S[1] * (f32x2){c.kh.z, c.kh.w} + a2;
                const float sk = red16(a2.x + a2.y);
                const f32x2 nsk = (f32x2){-sk, -sk}, vv2 = (f32x2){c.vv, c.vv};
                S[0] = S[0] * (f32x2){c.w.x, c.w.y} + (nsk * (f32x2){c.b.x, c.b.y} + vv2 * (f32x2){c.t.x, c.t.y});
                S[1] = S[1] * (f32x2){c.w.z, c.w.w} + (nsk * (f32x2){c.b.z, c.b.w} + vv2 * (f32x2){c.t.z, c.t.w});
                f32x2 o2 = S[0] * (f32x2){c.r.x, c.r.y}; o2 = S[1] * (f32x2){c.r.z, c.r.w} + o2;
                const float ov = red16(o2.x + o2.y);
                OUT[s * 32 + row_l] = ov;
            }
        }
        __syncthreads();
        { const int c4 = (tid & 7) * 4; const f32x4 ov = *(const LAS f32x4*)(OUT + st * 32 + c4);
          u32x2 o2; o2.x = pk2(ov.x, ov.y); o2.y = pk2(ov.z, ov.w);
          *(u32x2*)(P + (size_t)row_of(ch * 64 + st) * NP + ocol + c4) = o2; }
    }
    __syncthreads();
}

__device__ __forceinline__ void mixer_mla(const Params& p, LAS unsigned char* lds, int it) {
    bf16_t* P = (bf16_t*)(p.ws + WS_P);
    const bf16_t* MQ = (const bf16_t*)(p.ws + WS_MQ);
    int b, h, row0, nm1;
    if (it < 512) { b = it >> 6; h = (it >> 4) & 3; row0 = b * SEQL + (it & 15) * 256; nm1 = 68; }
    else { const int u = it - 512; b = u >> 2; h = u & 3; row0 = TMAIN + b * CTXL; nm1 = 4; }
    attn_unit<96>(MQ + (size_t)row0 * 384 + h * 96, 384, (const bf16_t*)(p.ws + WS_KM) + (size_t)(b * 4 + h) * NKEYS * 96, (const bf16_t*)(p.ws + WS_VTM) + (size_t)(b * 4 + h) * 64 * NKEYS,
                  4, 4, nm1, false, 0, false, 0.f, 0.10206207f, P + (size_t)row0 * NP + PC_MLAQD + h * 64, NP, lds);
}
__device__ __forceinline__ void mixer_swa(const Params& p, int l, LAS unsigned char* lds, int u0) {
    bf16_t* P = (bf16_t*)(p.ws + WS_P);
    int b, h, row0, nm0, nm1, qp0; bool msk;
    if (u0 < 512) { b = u0 >> 6; h = (u0 >> 4) & 3; const int qb = u0 & 15; row0 = b * SEQL + qb * 256; nm0 = 4 + 4 * qb - 2; nm1 = 4 + 4 * qb + 6; if (nm0 < 4) nm0 = 4; if (nm1 > 68) nm1 = 68; qp0 = qb * 256; msk = true; }
    else { const int u = u0 - 512; b = u >> 2; h = u & 3; row0 = TMAIN + b * CTXL; nm0 = 4; nm1 = 4; qp0 = 0; msk = false; }
    const int hk = h >> 1;
    bf16_t* qp = P + (size_t)row0 * NP + PC_SWAQ + h * 64;
    attn_unit<64>(qp, NP, (const bf16_t*)(p.ws + WS_KS) + (size_t)(b * 2 + hk) * NKEYS * 64, (const bf16_t*)(p.ws + WS_VTS) + (size_t)(b * 2 + hk) * 64 * NKEYS,
                  4, nm0, nm1, msk, qp0, true, p.in[12][l * 4 + h], 0.125f, qp, NP, lds);
}
__device__ __forceinline__ void phase_mixers(const Params& p, int l, LAS unsigned char* lds, int bid, int nb) {
    const bool ectx = (l == 0);
    const int N_MLA = 512 + (ectx ? 32 : 0), N_SWA = 512 + (ectx ? 32 : 0), N_RET = 1024 + (ectx ? 64 : 0);
    if (bid < NSCANBLK) rwkv_scan_item(p, l, lds, bid);
    else {
        prep_rest_items(p, l, lds, bid - NSCANBLK, nb - NSCANBLK);
        asm volatile("s_waitcnt vmcnt(0)" ::: "memory");
        __syncthreads();
        if (get_tid() == 0) { __builtin_amdgcn_fence(__ATOMIC_RELEASE, "agent"); asm volatile("s_waitcnt vmcnt(0)" ::: "memory");
            __hip_atomic_fetch_add((unsigned*)(p.ws + WS_CTR) + 4 + l, 1u, __ATOMIC_RELAXED, __HIP_MEMORY_SCOPE_AGENT); }
        if (bid < NSCANBLK + 64) { wait_counter(p, 4 + l, (unsigned)(nb - NSCANBLK)); ret_scan_item(p, l, bid - NSCANBLK); }
    }
    wait_counter(p, 4 + l, (unsigned)(nb - NSCANBLK));
    bool ret_ready = false;
    unsigned* ctr = (unsigned*)(p.ws + WS_CTR) + l;
    LAS unsigned* slot = (LAS unsigned*)(lds + LDS_BYTES - 16);
    const int tid0 = get_tid();
    for (;;) {
        __syncthreads();
        if (tid0 == 0) *slot = atomicAdd(ctr, 1u);
        __syncthreads();
        const int it = (int)*slot;
        if (it >= N_MLA + N_SWA + N_RET) break;
        if (it < N_MLA) mixer_mla(p, lds, it);
        else if (it < N_MLA + N_SWA) mixer_swa(p, l, lds, it - N_MLA);
        else { if (!ret_ready) { wait_counter(p, 2 + l, 64u); ret_ready = true; } ret_out_item(p, l, lds, it - N_MLA - N_SWA); }
    }
}

__device__ __forceinline__ void phase_rwkv_finish(const Params& p, int l, LAS unsigned char* lds, int bid, int nb) {
    const int tid = get_tid();
    bf16_t* P = (bf16_t*)(p.ws + WS_P);
    const int ntiles = (l == 0 ? TT : TMAIN) / 32;
    const float* mu = p.in[14] + l * 1024 + 896;
    const float* gup = p.in[19] + (size_t)l * 128 * 256;
    const bf16_t* RV = (const bf16_t*)(p.ws + WS_RWV); const float* BON = (const float*)(p.ws + WS_BON);
    for (int tile = bid; tile < ntiles; tile += nb) {
        const int t0 = tile * 32; const SeqInfo s0 = seq_of_row(t0);
        LAS unsigned char* sgb = lds;
        LAS float* gout = (LAS float*)(lds + 32 * 272);
        { const int tok = tid >> 4, j8 = (tid & 15) * 8; const int row = t0 + tok, pos = s0.pos + tok;
          const u32x4 u0 = *(const u32x4*)(P + (size_t)row * NP + PC_RWGD + j8);
          const u32x4 um = pos > 0 ? *(const u32x4*)(P + (size_t)(row - 1) * NP + PC_RWGD + j8) : (u32x4){0u, 0u, 0u, 0u};
          const u32x4 up = pos < s0.len - 1 ? *(const u32x4*)(P + (size_t)(row + 1) * NP + PC_RWGD + j8) : (u32x4){0u, 0u, 0u, 0u};
          float z0[8], zm[8], zp[8], sv[8]; unpack8(u0, z0); unpack8(um, zm); unpack8(up, zp);
#pragma unroll
          for (int x = 0; x < 8; ++x) sv[x] = sigmoidf_(z0[x] + mu[j8 + x] * (0.5f * (zm[x] + zp[x]) - z0[x]));
          *(LAS u32x4*)(sgb + tok * 272 + j8 * 2) = (u32x4){cvt_pk_bf16(sv[0], sv[1]), cvt_pk_bf16(sv[2], sv[3]), cvt_pk_bf16(sv[4], sv[5]), cvt_pk_bf16(sv[6], sv[7])}; }
        __syncthreads();
        { const int lane = tid & 63, wave = tid >> 6, fr = lane & 15, fq = lane >> 4;
          const bf16_t* GT = (const bf16_t*)(p.ws + WS_GUPT + (size_t)l * 256 * 128 * 2);
#pragma unroll
          for (int q = 0; q < 2; ++q) { const int nt = wave + q * 8;
              f32x4 a0 = (f32x4){0.f, 0.f, 0.f, 0.f}, a1 = a0;
              const bf16_t* wrow = GT + (size_t)(nt * 16 + fr) * 128 + fq * 8;
              bf16x8 bfr[4];
#pragma unroll
              for (int kc = 0; kc < 4; ++kc) bfr[kc] = *(const bf16x8*)(wrow + kc * 32);
#pragma unroll
              for (int kc = 0; kc < 4; ++kc) { const bf16x8 x0 = *(const LAS bf16x8*)(sgb + fr * 272 + kc * 64 + fq * 16), x1 = *(const LAS bf16x8*)(sgb + (16 + fr) * 272 + kc * 64 + fq * 16);
                  a0 = __builtin_amdgcn_mfma_f32_16x16x32_bf16(x0, bfr[kc], a0, 0, 0, 0); a1 = __builtin_amdgcn_mfma_f32_16x16x32_bf16(x1, bfr[kc], a1, 0, 0, 0); }
#pragma unroll
              for (int r = 0; r < 4; ++r) { gout[(fq * 4 + r) * 256 + nt * 16 + fr] = a0[r]; gout[(16 + fq * 4 + r) * 256 + nt * 16 + fr] = a1[r]; } } }
        __syncthreads();
        const int hh = tid >> 8, c = tid & 255, h = c >> 6;
        float g[16];
#pragma unroll
        for (int i = 0; i < 16; ++i) g[i] = gout[(hh * 16 + i) * 256 + c];
        const float gn = p.in[23][l * 256 + c];
        float ov[16], rv[16], bn[16];
#pragma unroll
        for (int i = 0; i < 16; ++i) { const int row = t0 + hh * 16 + i;
            ov[i] = bf2f(P[(size_t)row * NP + PC_RWO0 + c]) + bf2f(P[(size_t)row * NP + PC_RWO1 + c]); rv[i] = bf2f(RV[(size_t)row * 256 + c]); bn[i] = BON[(size_t)row * 4 + h]; }
#pragma unroll
        for (int i = 0; i < 16; ++i) { const int row = t0 + hh * 16 + i;
            const float o = ov[i];
            const float mean = wave_sum(o) * (1.f / 64.f); const float dl = o - mean; const float var = wave_sum(dl * dl) * (1.f / 64.f);
            float y = dl * (1.f / sqrtf(var + 64e-5f)) * gn + bn[i] * rv[i];
            P[(size_t)row * NP + PC_RWO1 + c] = f2bf(y * g[i]); }
        __syncthreads();
    }
}

#ifndef N_LAUNCH_MODE
#define N_LAUNCH_MODE 1
#endif
template <int Q>
__device__ __forceinline__ void layer_phase(const Params& p, int l, LAS unsigned char* lds, int bid, int nb) {
    unsigned char* wb = p.ws + WS_WB + (size_t)l * WB_LAYER;
    const int Mrows = (l == 0) ? TT : TMAIN;
    pg8::StaticOrder S;
    if constexpr (Q == 0) { pg8::Gemm g{(const bf16_t*)(p.ws + WS_HB), (const bf16_t*)(wb + WB_IN), TT, NP, DM, DM}; S.init(TT, NP, nb, bid);
              pg8::EpiBf16<0> E{(bf16_t*)(p.ws + WS_P), NP}; pg8::gemm_phase(lds, g, S, E); }
    if constexpr (Q == 1) phase_prepA(p, l, lds, bid, nb);
    if constexpr (Q == 3) phase_mixers(p, l, lds, bid, nb);
    if constexpr (Q == 4) phase_rwkv_finish(p, l, lds, bid, nb);
    if constexpr (Q == 5) { pg8::Gemm g{(const bf16_t*)(p.ws + WS_P), (const bf16_t*)(wb + WB_OUT), Mrows, DM, DM, NP}; S.init(Mrows, DM, nb, bid);
              pg8::EpiBf16<0> E{(bf16_t*)(p.ws + WS_Z), DM}; pg8::gemm_phase(lds, g, S, E); }
    if constexpr (Q == 6) phase_rowops(p, 1, l, Mrows, bid, nb);
    if constexpr (Q == 7) { pg8::Gemm g{(const bf16_t*)(p.ws + WS_HB), (const bf16_t*)(wb + WB_W1), Mrows, FF, DM, DM}; S.init(Mrows, FF, nb, bid);
              pg8::EpiBf16<1> E{(bf16_t*)(p.ws + WS_HID), FF}; pg8::gemm_phase(lds, g, S, E); }
    if constexpr (Q == 8) { pg8::Gemm g{(const bf16_t*)(p.ws + WS_HID), (const bf16_t*)(wb + WB_W2), Mrows, DM, FF, FF}; S.init(Mrows, DM, nb, bid);
              pg8::EpiBf16<0> E{(bf16_t*)(p.ws + WS_Z), DM}; pg8::gemm_phase(lds, g, S, E); }
    if constexpr (Q == 9) phase_rowops(p, 2, l, Mrows, bid, nb);
}

#ifndef PROBE_MASK
#define PROBE_MASK 0
#endif
#define PB(BIT, CALL) do { if ((PROBE_MASK) & (BIT)) { const unsigned long long t0_ = __builtin_amdgcn_s_memrealtime(); CALL; const unsigned long long t1_ = __builtin_amdgcn_s_memrealtime(); \
        while (__builtin_amdgcn_s_memrealtime() - t1_ < (t1_ - t0_)) __builtin_amdgcn_s_sleep(8); } else { CALL; } } while (0)
#define XB_TMO      128
#define XB_XCNT(j)  (256  + 64 * (j))
#define XB_XSUB(j)  (1280 + 64 * (j))
#define XB_XGEN(j)  (2304 + 64 * (j))
#define XB_TOP      3328
#define XB_TOPGEN   3392
#define XCD_BAR_WORDS 3456
#define XB_SPIN_CAP (1u << 18)

__device__ __forceinline__ unsigned xb_ld(unsigned* p)              { return __hip_atomic_load(p, __ATOMIC_RELAXED, __HIP_MEMORY_SCOPE_AGENT); }
__device__ __forceinline__ unsigned xb_add(unsigned* p, unsigned v) { return __hip_atomic_fetch_add(p, v, __ATOMIC_RELAXED, __HIP_MEMORY_SCOPE_AGENT); }
__device__ __forceinline__ unsigned xb_xcc_id() { return (unsigned)__builtin_amdgcn_s_getreg((3 << 11) | 20) & 0xFu; }
#define XB_SPIN(cond, bar) do { unsigned _sp = 0; while (cond) { __builtin_amdgcn_s_sleep(1); \
    if ((++_sp & 255u) == 0u) { if (xb_ld(&(bar)[XB_TMO])) break; if (_sp > XB_SPIN_CAP) { atomicAdd(&(bar)[XB_TMO], 1u); break; } } } } while (0)

struct XcdBarrier {
    unsigned* bar; unsigned x;
    volatile LAS unsigned* st;
};

__device__ __forceinline__ XcdBarrier xcd_barrier_post(unsigned* bar, volatile LAS unsigned* st) {
    XcdBarrier b; b.bar = bar; b.x = xb_xcc_id(); b.st = st;
    if (threadIdx.x == 0) (void)xb_add(&bar[XB_XCNT(b.x)], 1u);
    return b;
}
__device__ __forceinline__ void xcd_barrier_complete(unsigned* bar, unsigned x, unsigned& nloc, unsigned& nx) {
    const unsigned G = gridDim.x * gridDim.y * gridDim.z;
    unsigned sum, cnt, mine, sp = 0u;
    for (;;) {
        sum = 0u; cnt = 0u; mine = 0u;
#pragma unroll
        for (unsigned j = 0; j < 16; ++j) { const unsigned c = xb_ld(&bar[XB_XCNT(j)]); sum += c; cnt += (c > 0u) ? 1u : 0u; mine = (j == x) ? c : mine; }
        if (sum == G) break;
        __builtin_amdgcn_s_sleep(1);
        if ((++sp & 255u) == 0u) { if (xb_ld(&bar[XB_TMO])) break; if (sp > XB_SPIN_CAP) { atomicAdd(&bar[XB_TMO], 1u); break; } }
    }
    nloc = mine > 0u ? mine : 1u; nx = cnt > 0u ? cnt : 1u;
}

__device__ __forceinline__ void xcd_barrier(const XcdBarrier& b) {
    asm volatile("s_waitcnt vmcnt(0)" ::: "memory");
    __syncthreads();
    if (threadIdx.x == 0) {
        unsigned* bar = b.bar;
        __builtin_amdgcn_s_waitcnt(0);
        unsigned nloc = b.st[0], nx = b.st[1];
        if (nloc == 0u) { xcd_barrier_complete(bar, b.x, nloc, nx); b.st[0] = nloc; b.st[1] = nx; }
        const unsigned old = xb_add(&bar[XB_XSUB(b.x)], 1u);
        const unsigned gen = old / nloc;
        if (old + 1u == (gen + 1u) * nloc) {
            __builtin_amdgcn_fence(__ATOMIC_RELEASE, "agent");
            asm volatile("s_waitcnt vmcnt(0)" ::: "memory");
            const unsigned og = xb_add(&bar[XB_TOP], 1u);
            const unsigned tg = og / nx;
            if (og + 1u == (tg + 1u) * nx) xb_add(&bar[XB_TOPGEN], 1u);
            else XB_SPIN(xb_ld(&bar[XB_TOPGEN]) == tg, bar);
            __builtin_amdgcn_fence(__ATOMIC_ACQUIRE, "agent");
            xb_add(&bar[XB_XGEN(b.x)], 1u);
            asm volatile("s_waitcnt vmcnt(0)" ::: "memory");
        } else {
            XB_SPIN(xb_ld(&bar[XB_XGEN(b.x)]) == gen, bar);
            __builtin_amdgcn_fence(__ATOMIC_ACQUIRE, "agent");
            asm volatile("s_waitcnt vmcnt(0)" ::: "memory");
        }
    }
    __syncthreads();
}


constexpr size_t WS_XBAR = 772 * 1024;
#define GSYNC() xcd_barrier(xb)

__global__ void __launch_bounds__(512, 2) mega_fwd(Params p) {
    extern __shared__ __attribute__((aligned(16))) unsigned char lds_raw[];
    LAS unsigned char* lds = (LAS unsigned char*)lds_raw;
    cg::grid_group grid = cg::this_grid();
    const int bid = blockIdx.x, nb = gridDim.x;
    { LAS unsigned* st_ = (LAS unsigned*)(lds + LDS_BYTES - 32); if (get_tid() == 0) { st_[0] = 0u; st_[1] = 0u; } __syncthreads(); }
    XcdBarrier xb = xcd_barrier_post((unsigned*)(p.ws + WS_XBAR), (volatile LAS unsigned*)(lds + LDS_BYTES - 32));
    grid.sync();
    PB(16, phase_prologue(p, lds, bid, nb)); GSYNC();
    PB(8, phase_rowops(p, 0, 0, TT, bid, nb)); GSYNC();
#define LAYER(L, LAST) \
    PB(1, layer_phase<0>(p, L, lds, bid, nb)); GSYNC(); PB(4, layer_phase<1>(p, L, lds, bid, nb)); GSYNC(); \
    PB(2, layer_phase<3>(p, L, lds, bid, nb)); GSYNC(); PB(4, layer_phase<4>(p, L, lds, bid, nb)); GSYNC(); PB(1, layer_phase<5>(p, L, lds, bid, nb)); GSYNC(); \
    PB(8, layer_phase<6>(p, L, lds, bid, nb)); GSYNC(); PB(1, layer_phase<7>(p, L, lds, bid, nb)); GSYNC(); PB(1, layer_phase<8>(p, L, lds, bid, nb)); GSYNC(); \
    PB(8, layer_phase<9>(p, L, lds, bid, nb)); if (!(LAST)) GSYNC();
    LAYER(0, false)
    LAYER(1, true)
}
#if N_LAUNCH_MODE != 1
template <int PH> __global__ void __launch_bounds__(512, 2) one_phase(Params p, int l) {
    extern __shared__ __attribute__((aligned(16))) unsigned char lds_raw[];
    LAS unsigned char* lds = (LAS unsigned char*)lds_raw;
    if constexpr (PH == 100) phase_prologue(p, lds, blockIdx.x, gridDim.x);
    else if constexpr (PH == 101) phase_rowops(p, 0, 0, TT, blockIdx.x, gridDim.x);
    else layer_phase<PH>(p, l, lds, blockIdx.x, gridDim.x);
}
#endif

extern "C" void kernel_launch(void* const* d_in, const int* in_sizes, int n_in, void* d_out, int out_size, void* d_ws, size_t ws_size, hipStream_t stream) {
    if (n_in != 30 || ws_size < WS_NEED || out_size != TMAIN * DM) { fprintf(stderr, "kernel_launch: unexpected shapes (n_in %d, ws %zu, out %d)\n", n_in, ws_size, out_size); return; }
    Params p{};
    for (int i = 0; i < 30; ++i) p.in[i] = (const float*)d_in[i];
    p.out = (float*)d_out; p.ws = (unsigned char*)d_ws;
    static int grid_blocks = 0;
    if (!grid_blocks) {
        int dev = 0, cus = 0, per_cu = 0;
        (void)hipGetDevice(&dev);
        (void)hipDeviceGetAttribute(&cus, hipDeviceAttributeMultiprocessorCount, dev);
        (void)hipFuncSetAttribute((const void*)mega_fwd, hipFuncAttributeMaxDynamicSharedMemorySize, LDS_BYTES);
        (void)hipOccupancyMaxActiveBlocksPerMultiprocessor(&per_cu, mega_fwd, 512, LDS_BYTES);
        if (per_cu < 1) { fprintf(stderr, "kernel_launch: occupancy query says %d blocks/CU\n", per_cu); per_cu = 1; }
        grid_blocks = cus * 1;
        if (grid_blocks < 128) { fprintf(stderr, "kernel_launch: only %d CUs\n", grid_blocks); }
    }
#if N_LAUNCH_MODE == 1
    (void)hipMemsetAsync((char*)d_ws + 768 * 1024, 0, 32 * 1024, stream);
    void* args[] = {&p};
    hipError_t e = hipLaunchCooperativeKernel((const void*)mega_fwd, dim3(grid_blocks), dim3(512), args, LDS_BYTES, stream);
    if (e != hipSuccess) fprintf(stderr, "cooperative launch failed: %s (grid %d)\n", hipGetErrorString(e), grid_blocks);
#else
#define LP(PH, L) do { (void)hipFuncSetAttribute((const void*)one_phase<PH>, hipFuncAttributeMaxDynamicSharedMemorySize, LDS_BYTES); one_phase<PH><<<grid_blocks, 512, LDS_BYTES, stream>>>(p, L); } while (0)
    LP(100, 0); LP(101, 0);
    for (int l = 0; l < 2; ++l) { LP(0, l); LP(1, l); LP(2, l); LP(3, l); LP(4, l); LP(5, l); LP(6, l); LP(7, l); LP(8, l); LP(9, l); }
#endif
}
```

```cpp
#include <hip/hip_runtime.h>
#include <hip/hip_cooperative_groups.h>
#include <cstdio>
#include <cstdint>
#include <cmath>
namespace cg = cooperative_groups;
__device__ __forceinline__ int get_tid() { int t = threadIdx.x; asm volatile("" : "+v"(t)); return t; }
namespace pg8 {
#define PG8_LAS __attribute__((address_space(3)))
typedef unsigned short bf16_t;
typedef short bf16x8 __attribute__((ext_vector_type(8)));
typedef float f32x4 __attribute__((ext_vector_type(4)));
typedef unsigned u32x4 __attribute__((ext_vector_type(4)));
typedef unsigned u32x2 __attribute__((ext_vector_type(2)));
constexpr int BM = 256, BK = 64, HALF = 128, HTB = HALF * BK * 2, STAGE_BYTES = 8 * HTB, NXCD = 8, WGM = 8;

__host__ __device__ __forceinline__ int lds_byte(int r, int c) { const int st = (r >> 4) * 2 + (c >> 5), rr = r & 15, cc = c & 31, ob = rr * 64 + cc * 2; return st * 1024 + (ob ^ (((ob >> 9) & 1) << 5)); }
__host__ __device__ __forceinline__ void stage_rc(int b, int& R, int& C) { const int st = b / 1024, sb = b % 1024, swz = sb ^ (((sb >> 9) & 1) << 5); R = (st >> 1) * 16 + swz / 64; C = (st & 1) * 32 + (swz % 64) / 2; }

struct Unit { int pm, pn; };
struct Gemm { const bf16_t* A; const bf16_t* Bt; int M, N, K, lda; };

struct StaticOrder {
    int nM, nN, nwg, G, c;
    __host__ __device__ void init(int M, int N, int G_, int c_) { nM = M / BM; nN = N / BM; nwg = nM * nN; G = G_; c = c_; }
    __host__ __device__ bool next(int i, Unit& u) const {
        const long L = (long)i * G + c; if (L >= nwg) return false;
        int wgid = (int)L; { const int q = nwg / NXCD, r = nwg % NXCD, xcd = wgid % NXCD, off = wgid / NXCD; wgid = (xcd < r ? xcd * (q + 1) : r * (q + 1) + (xcd - r) * q) + off; }
        const int nig = WGM * nN, gid = wgid / nig, fm = gid * WGM, gsz = (nM - fm) < WGM ? (nM - fm) : WGM;
        u.pm = fm + ((wgid % nig) % gsz); u.pn = (wgid % nig) / gsz; return true;
    }
};

template <class Epi>
__device__ __forceinline__ void gemm_phase(PG8_LAS unsigned char* lds, const Gemm g, const StaticOrder& S, const Epi& E) {
    const int tid = get_tid(), wid = __builtin_amdgcn_readfirstlane(tid >> 6), lane = tid & 63, wr = wid >> 2, wc = wid & 3, fr = lane & 15, fq = lane >> 4;
    const int K = g.K, nt = K / BK, lda = g.lda;
    unsigned voffA[2], voffB[2];
#pragma unroll
    for (int i = 0; i < 2; ++i) { int R, C; stage_rc(tid * 16 + i * 8192, R, C);
        voffA[i] = (unsigned)(R * lda + C) * 2u; voffB[i] = (unsigned)(R * K + C) * 2u; }
    const size_t kstep = (size_t)(BK * 2);
    const size_t hstepA = (size_t)HALF * lda * 2, hstepB = (size_t)HALF * K * 2;
    const size_t tstepA = 2 * hstepA, tstepB = 2 * hstepB;
    const unsigned ldsw = (unsigned)wid * 1024u;
    const int aoff = lds_byte(wr * 64 + fr, fq * 8), boff = lds_byte(wc * 32 + fr, fq * 8);
#define PG8_SA(b, h) (((b) * 2 + (h)) * HTB)
#define PG8_SB(b, h) ((4 + (b) * 2 + (h)) * HTB)
#define PG8_STAGE(bufoff, gbase, voff) do { _Pragma("unroll") for (int _i = 0; _i < 2; ++_i) \
        __builtin_amdgcn_global_load_lds((const unsigned*)((const char*)(gbase) + (voff)[_i]), (PG8_LAS unsigned*)(lds + (bufoff) + ldsw + _i * 8192), 16, 0, 0); } while (0)
#define PG8_LDA(dst, b, h) do { _Pragma("unroll") for (int m = 0; m < 4; ++m) _Pragma("unroll") for (int k = 0; k < 2; ++k) dst[m][k] = *(const PG8_LAS bf16x8*)(lds + PG8_SA(b, h) + aoff + m * 2048 + k * 1024); } while (0)
#define PG8_LDB(dst, b, h) do { _Pragma("unroll") for (int n = 0; n < 2; ++n) _Pragma("unroll") for (int k = 0; k < 2; ++k) dst[n][k] = *(const PG8_LAS bf16x8*)(lds + PG8_SB(b, h) + boff + n * 2048 + k * 1024); } while (0)
#define PG8_MMA(ai, bj, At, Bt) do { __builtin_amdgcn_s_setprio(1); _Pragma("unroll") for (int m = 0; m < 4; ++m) _Pragma("unroll") for (int n = 0; n < 2; ++n) _Pragma("unroll") for (int k = 0; k < 2; ++k) \
        acc[ai][bj][m][n] = __builtin_amdgcn_mfma_f32_16x16x32_bf16(Bt[n][k], At[m][k], acc[ai][bj][m][n], 0, 0, 0); __builtin_amdgcn_s_setprio(0); } while (0)
#define PG8_WAIT_V(n) asm volatile("s_waitcnt vmcnt(" #n ")" ::: "memory")
#define PG8_WAIT_L(n) asm volatile("s_waitcnt lgkmcnt(" #n ")" ::: "memory")
#define PG8_BAR __builtin_amdgcn_s_barrier()
#define PG8_SCHED __builtin_amdgcn_sched_barrier(0)
    Unit cur, nxt; int ui = 0;
    if (!S.next(0, cur)) return;
    f32x4 acc[2][2][4][2];
#pragma unroll
    for (int a = 0; a < 2; ++a)
#pragma unroll
        for (int b = 0; b < 2; ++b)
#pragma unroll
            for (int m = 0; m < 4; ++m)
#pragma unroll
                for (int n = 0; n < 2; ++n) acc[a][b][m][n] = (f32x4){0.f, 0.f, 0.f, 0.f};
    bf16x8 At[4][2], B0[2][2], B1[2][2];
    const char* cA = (const char*)g.A + (size_t)cur.pm * tstepA; const char* cB = (const char*)g.Bt + (size_t)cur.pn * tstepB;
    PG8_STAGE(PG8_SB(0, 0), cB, voffB); PG8_STAGE(PG8_SA(0, 0), cA, voffA); PG8_STAGE(PG8_SB(0, 1), cB + hstepB, voffB); PG8_STAGE(PG8_SA(0, 1), cA + hstepA, voffA);
    if (wr == 1) PG8_BAR;
    PG8_WAIT_V(4); PG8_BAR;
    PG8_STAGE(PG8_SB(1, 0), cB + kstep, voffB); PG8_STAGE(PG8_SA(1, 0), cA + kstep, voffA); PG8_STAGE(PG8_SB(1, 1), cB + hstepB + kstep, voffB);
    PG8_WAIT_V(6); PG8_BAR;
    for (;;) {
        const bool has_next = S.next(ui + 1, nxt);
        const char* nA = has_next ? (const char*)g.A + (size_t)nxt.pm * tstepA : cA; const char* nB = has_next ? (const char*)g.Bt + (size_t)nxt.pn * tstepB : cB;
        for (int t = 0; t < nt; t += 2) {
            const bool last = (t == nt - 2);
            const char* a1 = cA + (size_t)(t + 1) * kstep;
            const char* a2 = last ? nA : cA + (size_t)(t + 2) * kstep; const char* b2 = last ? nB : cB + (size_t)(t + 2) * kstep;
            const char* a3 = a2 + kstep; const char* b3 = b2 + kstep;
            PG8_LDB(B0, 0, 0); PG8_SCHED; PG8_LDA(At, 0, 0); PG8_STAGE(PG8_SA(1, 1), a1 + hstepA, voffA);
            PG8_WAIT_L(8); PG8_BAR; PG8_WAIT_L(0); PG8_MMA(0, 0, At, B0); PG8_BAR; PG8_SCHED;
            PG8_LDB(B1, 0, 1); PG8_STAGE(PG8_SB(0, 0), b2, voffB);
            PG8_BAR; PG8_WAIT_L(0); PG8_MMA(0, 1, At, B1); PG8_BAR;
            PG8_LDA(At, 0, 1); PG8_STAGE(PG8_SA(0, 0), a2, voffA);
            PG8_BAR; PG8_WAIT_L(0); PG8_MMA(1, 0, At, B0); PG8_BAR; PG8_SCHED;
            PG8_STAGE(PG8_SB(0, 1), b2 + hstepB, voffB);
            PG8_WAIT_V(6); PG8_BAR; PG8_MMA(1, 1, At, B1); PG8_BAR;
            PG8_LDB(B0, 1, 0); PG8_SCHED; PG8_LDA(At, 1, 0); PG8_STAGE(PG8_SA(0, 1), a2 + hstepA, voffA);
            PG8_WAIT_L(8); PG8_BAR; PG8_WAIT_L(0); PG8_MMA(0, 0, At, B0); PG8_BAR; PG8_SCHED;
            PG8_LDB(B1, 1, 1); PG8_STAGE(PG8_SB(1, 0), b3, voffB);
            PG8_BAR; PG8_WAIT_L(0); PG8_MMA(0, 1, At, B1); PG8_BAR;
            PG8_LDA(At, 1, 1); PG8_STAGE(PG8_SA(1, 0), a3, voffA);
            PG8_BAR; PG8_WAIT_L(0); PG8_MMA(1, 0, At, B0); PG8_BAR; PG8_SCHED;
            PG8_STAGE(PG8_SB(1, 1), b3 + hstepB, voffB);
            PG8_WAIT_V(6); PG8_BAR; PG8_MMA(1, 1, At, B1); PG8_BAR;
        }
        E(acc, cur, wr, wc, fr, fq);
        if (!has_next) break;
#pragma unroll
        for (int a = 0; a < 2; ++a)
#pragma unroll
            for (int b = 0; b < 2; ++b)
#pragma unroll
                for (int m = 0; m < 4; ++m)
#pragma unroll
                    for (int n = 0; n < 2; ++n) acc[a][b][m][n] = (f32x4){0.f, 0.f, 0.f, 0.f};
        cur = nxt; cA = nA; cB = nB; ++ui;
    }
    PG8_WAIT_V(0);
    if (wr == 0) PG8_BAR;
    PG8_BAR;
#undef PG8_SA
#undef PG8_SB
#undef PG8_STAGE
#undef PG8_LDA
#undef PG8_LDB
#undef PG8_MMA
#undef PG8_WAIT_V
#undef PG8_WAIT_L
#undef PG8_BAR
#undef PG8_SCHED
}

typedef float f32x2_g __attribute__((ext_vector_type(2)));
typedef __bf16 bf16x2_g __attribute__((ext_vector_type(2)));
__device__ __forceinline__ unsigned pk2_g(float lo, float hi) { const f32x2_g v = {lo, hi}; return __builtin_bit_cast(unsigned, __builtin_convertvector(v, bf16x2_g)); }
template <int ACT> struct EpiBf16 {
    bf16_t* O; int ldc;
    __device__ __forceinline__ void operator()(const f32x4 (&acc)[2][2][4][2], const Unit& u, int wr, int wc, int fr, int fq) const {
        const int row0 = u.pm * BM + wr * 64 + fr, col0 = u.pn * BM + wc * 32 + 4 * fq;
#pragma unroll
        for (int ai = 0; ai < 2; ++ai)
#pragma unroll
            for (int m = 0; m < 4; ++m) { bf16_t* rowp = O + (size_t)(row0 + ai * HALF + m * 16) * ldc + col0;
#pragma unroll
                for (int bj = 0; bj < 2; ++bj)
#pragma unroll
                    for (int n = 0; n < 2; ++n) { f32x4 v = acc[ai][bj][m][n];
                        if (ACT == 1) { v.x = v.x > 0.f ? v.x * v.x : 0.f; v.y = v.y > 0.f ? v.y * v.y : 0.f; v.z = v.z > 0.f ? v.z * v.z : 0.f; v.w = v.w > 0.f ? v.w * v.w : 0.f; }
                        u32x2 o; o.x = pk2_g(v.x, v.y); o.y = pk2_g(v.z, v.w);
                        *(u32x2*)(rowp + bj * HALF + n * 16) = o; } }
    }
};
}
typedef unsigned short bf16_t;
typedef short bf16x8 __attribute__((ext_vector_type(8)));
typedef float f32x4 __attribute__((ext_vector_type(4)));
typedef unsigned u32x4 __attribute__((ext_vector_type(4)));
typedef unsigned u32x2 __attribute__((ext_vector_type(2)));
#define LAS __attribute__((address_space(3)))

constexpr int NBATCH = 8, SEQL = 4096, DM = 1024, CTXL = 256, TMAIN = 32768, TCTX = 2048, TT = 34816, NP = 3072, FF = 4096;
constexpr int PC_SWAQ = 0, PC_RETQ = 256, PC_RWR = 512, PC_MLAQD = 768, PC_SWAK = 1024, PC_SWAV = 1152, PC_RETK = 1280, PC_RETV = 1536, PC_RETG = 1792,
              PC_RWK = 2048, PC_RWV = 2304, PC_RWWD = 2560, PC_RWAD = 2624, PC_RWGD = 2688, PC_MLAKVD = 2816, PC_MLAKPE = 2944;
constexpr int PC_RWO0 = PC_RWV, PC_RWO1 = PC_RWR;
constexpr int NKEYS = CTXL + SEQL;

constexpr size_t MiB = 1u << 20;
constexpr size_t WS_MOD = 0;
constexpr size_t WS_TAB = 512 * 1024;
constexpr size_t WS_CTR = 768 * 1024;
constexpr size_t WS_BON = 1 * MiB;
constexpr size_t WS_WB = 2 * MiB;
constexpr size_t WB_LAYER = 24 * MiB, WB_IN = 0, WB_OUT = 6 * MiB, WB_W1 = 8 * MiB, WB_W2 = 16 * MiB;
constexpr size_t WS_XC = 50 * MiB;
constexpr size_t WS_P = 58 * MiB;
constexpr size_t WS_HID = 58 * MiB;
constexpr size_t WS_A = 262 * MiB;
constexpr size_t ARR17 = 17 * MiB;
constexpr size_t WS_RWK = WS_A, WS_RWV = WS_A + ARR17, WS_RWRR = WS_A + 2 * ARR17, WS_RWA0 = WS_A + 3 * ARR17, WS_RWA1 = WS_A + 4 * ARR17,
                 WS_RWM0 = WS_A + 5 * ARR17, WS_RWM1 = WS_A + 6 * ARR17;
constexpr size_t WS_RET = WS_A + 119 * MiB;
constexpr size_t WS_MQ = WS_RET + 34 * MiB;
constexpr size_t WS_KM = WS_MQ + 26738688;
constexpr size_t WS_VTM = WS_KM + 26738688;
constexpr size_t WS_KS = WS_VTM + ARR17;
constexpr size_t WS_VTS = WS_KS + 8912896;
constexpr size_t WS_A_END = WS_VTS + 8912896;
constexpr size_t WS_Z = 330 * MiB;
constexpr size_t WS_HB = 398 * MiB;
constexpr size_t WS_MLAW = 500 * MiB;
constexpr size_t MLAW_LAYER = 384 * 256 * 2 + 512 * 128 * 2, MLAW_KV = 384 * 256 * 2;
constexpr size_t WS_GUPT = 501 * MiB;
constexpr size_t WS_LORAT = 502 * MiB;
constexpr size_t WS_NEED = 503 * MiB;
static_assert(WS_A_END <= WS_NEED && WS_HB + 68 * MiB <= WS_NEED && WS_HID + 272 * MiB <= WS_Z, "ws map");

constexpr int LDS_BYTES = 150 * 1024;

struct Params { const float* in[30]; float* out; unsigned char* ws; };

__device__ __forceinline__ float bf2f(bf16_t v) { return __builtin_bit_cast(float, (unsigned)v << 16); }
typedef float f32x2_c __attribute__((ext_vector_type(2)));
typedef __bf16 bf16x2_c __attribute__((ext_vector_type(2)));
__device__ __forceinline__ unsigned pk2(float lo, float hi) { const f32x2_c v = {lo, hi}; return __builtin_bit_cast(unsigned, __builtin_convertvector(v, bf16x2_c)); }
__device__ __forceinline__ bf16_t f2bf(float f) { return (bf16_t)(pk2(f, 0.f) & 0xffffu); }
typedef float f32x2 __attribute__((ext_vector_type(2)));
typedef __bf16 bf16x2_t __attribute__((ext_vector_type(2)));
__device__ __forceinline__ unsigned cvt_pk_bf16(float lo, float hi) { const f32x2 v = {lo, hi}; return __builtin_bit_cast(unsigned, __builtin_convertvector(v, bf16x2_t)); }
template <int CTRL> __device__ __forceinline__ float dppf(float v) { return __builtin_bit_cast(float, __builtin_amdgcn_update_dpp(0, __builtin_bit_cast(int, v), CTRL, 0xF, 0xF, true)); }
__device__ __forceinline__ float red4(float v) { v += dppf<0xB1>(v); v += dppf<0x4E>(v); return v; }
__device__ __forceinline__ float red8(float v) { v = red4(v); v += dppf<0x141>(v); return v; }
__device__ __forceinline__ float red16(float v) { v = red8(v); v += dppf<0x140>(v); return v; }
__device__ __forceinline__ float max16(float v) { v = fmaxf(v, dppf<0xB1>(v)); v = fmaxf(v, dppf<0x4E>(v)); v = fmaxf(v, dppf<0x141>(v)); v = fmaxf(v, dppf<0x140>(v)); return v; }
__device__ __forceinline__ float wave_sum(float v) {
    v = red16(v);
    const int u = __builtin_bit_cast(int, v);
    return __builtin_bit_cast(float, __builtin_amdgcn_readlane(u, 0)) + __builtin_bit_cast(float, __builtin_amdgcn_readlane(u, 16)) +
           __builtin_bit_cast(float, __builtin_amdgcn_readlane(u, 32)) + __builtin_bit_cast(float, __builtin_amdgcn_readlane(u, 48));
}
__device__ __forceinline__ void unpack8(const u32x4 u, float* f) {
    f[0] = bf2f((bf16_t)(u.x & 0xffff)); f[1] = bf2f((bf16_t)(u.x >> 16)); f[2] = bf2f((bf16_t)(u.y & 0xffff)); f[3] = bf2f((bf16_t)(u.y >> 16));
    f[4] = bf2f((bf16_t)(u.z & 0xffff)); f[5] = bf2f((bf16_t)(u.z >> 16)); f[6] = bf2f((bf16_t)(u.w & 0xffff)); f[7] = bf2f((bf16_t)(u.w >> 16));
}
__device__ __forceinline__ float sigmoidf_(float x) { return __builtin_amdgcn_rcpf(1.f + __expf(-x)); }

struct SeqInfo { int b, pos, len, start, isctx; };
__device__ __forceinline__ SeqInfo seq_of_row(int row) {
    SeqInfo s;
    if (row < TMAIN) { s.b = row >> 12; s.pos = row & 4095; s.len = SEQL; s.start = s.b << 12; s.isctx = 0; }
    else { const int r = row - TMAIN; s.b = r >> 8; s.pos = r & 255; s.len = CTXL; s.start = TMAIN + (s.b << 8); s.isctx = 1; }
    return s;
}

__device__ __forceinline__ void transpose_item(const float* W, int N, int nsrc0, bf16_t* WT, int K, int ndst0, int k0, LAS float* scr, int lane) {
    if (nsrc0 >= 0) {
#pragma unroll 32
        for (int i = 0; i < 32; ++i) { const int kk = 2 * i + (lane >> 5); scr[kk * 33 + (lane & 31)] = W[(size_t)(k0 + kk) * N + nsrc0 + (lane & 31)]; }
    } else {
#pragma unroll 8
        for (int i = 0; i < 32; ++i) { const int kk = 2 * i + (lane >> 5); scr[kk * 33 + (lane & 31)] = 0.f; }
    }
    __builtin_amdgcn_wave_barrier(); asm volatile("s_waitcnt lgkmcnt(0)" ::: "memory");
    const int c = lane & 7;
#pragma unroll
    for (int j = 0; j < 4; ++j) { const int n = (lane >> 3) + 8 * j; const LAS float* s = scr + (8 * c) * 33 + n;
        u32x4 o; o.x = pk2(s[0 * 33], s[1 * 33]); o.y = pk2(s[2 * 33], s[3 * 33]); o.z = pk2(s[4 * 33], s[5 * 33]); o.w = pk2(s[6 * 33], s[7 * 33]);
        *(u32x4*)(WT + (size_t)(ndst0 + n) * K + k0 + 8 * c) = o; }
    __builtin_amdgcn_wave_barrier(); asm volatile("s_waitcnt lgkmcnt(0)" ::: "memory");
}
__device__ __forceinline__ int win_src_col(int n) {
    if (n < 256) return n;
    if (n < 512) return 512 + (n - 256);
    if (n < 768) return 1536 + (n - 512);
    if (n < 1024) return 2560 + (n - 768);
    if (n < 1280) return 256 + (n - 1024);
    if (n < 2048) return 768 + (n - 1280);
    if (n < 2816) return 1792 + (n - 2048);
    if (n < 2976) return n;
    return -1;
}
__device__ __forceinline__ void phase_prologue(const Params& p, LAS unsigned char* lds, int bid, int nb) {
    const int tid = get_tid(), lane = tid & 63, wave = tid >> 6;
    LAS float* scr = (LAS float*)(lds + wave * 16384);
    const int gw = bid * 8 + wave, NGW = nb * 8;
    constexpr int I_IN = 16 * 96, I_OUT = 16 * 32, I_1 = 16 * 128, I_2 = 64 * 32, I_Q = 4 * 12, I_KV = 2 * 16, I_G = 2 * 8, I_LO = 4 * 8, I_L = I_IN + I_OUT + I_1 + I_2 + I_Q + I_KV + I_G + I_LO;
    for (int it = gw; it < 2 * I_L; it += NGW) {
        const int l = it / I_L; int r = it % I_L;
        unsigned char* wb = p.ws + WS_WB + (size_t)l * WB_LAYER;
        if (r < I_IN) { const int kb = r / 96, nbk = r % 96; transpose_item(p.in[10] + (size_t)l * DM * 2976, 2976, win_src_col(nbk * 32), (bf16_t*)(wb + WB_IN), DM, nbk * 32, kb * 64, scr, lane); continue; } r -= I_IN;
        if (r < I_OUT) { const int kb = r / 32, nbk = r % 32; transpose_item(p.in[11] + (size_t)l * DM * DM, DM, nbk * 32, (bf16_t*)(wb + WB_OUT), DM, nbk * 32, kb * 64, scr, lane); continue; } r -= I_OUT;
        if (r < I_1) { const int kb = r / 128, nbk = r % 128; transpose_item(p.in[28] + (size_t)l * DM * FF, FF, nbk * 32, (bf16_t*)(wb + WB_W1), DM, nbk * 32, kb * 64, scr, lane); continue; } r -= I_1;
        if (r < I_2) { const int kb = r / 32, nbk = r % 32; transpose_item(p.in[29] + (size_t)l * FF * DM, DM, nbk * 32, (bf16_t*)(wb + WB_W2), FF, nbk * 32, kb * 64, scr, lane); continue; } r -= I_2;
        unsigned char* mw = p.ws + WS_MLAW + (size_t)l * MLAW_LAYER;
        if (r < I_Q) { const int kb = r / 12, nbk = r % 12; transpose_item(p.in[25] + (size_t)l * 256 * 384, 384, nbk * 32, (bf16_t*)mw, 256, nbk * 32, kb * 64, scr, lane); continue; } r -= I_Q;
        if (r < I_KV) { const int kb = r / 16, nbk = r % 16; transpose_item(p.in[27] + (size_t)l * 128 * 512, 512, nbk * 32, (bf16_t*)(mw + MLAW_KV), 128, nbk * 32, kb * 64, scr, lane); continue; } r -= I_KV;
        if (r < I_G) { const int kb = r / 8, nbk = r % 8; transpose_item(p.in[19] + (size_t)l * 128 * 256, 256, nbk * 32, (bf16_t*)(p.ws + WS_GUPT + (size_t)l * 256 * 128 * 2), 128, nbk * 32, kb * 64, scr, lane); continue; } r -= I_G;
        { const int m = r / 8, nbk = r % 8; const float* src = (m < 2 ? p.in[16] : p.in[18]) + ((size_t)l * 2 + (m & 1)) * 64 * 256;
          transpose_item(src, 256, nbk * 32, (bf16_t*)(p.ws + WS_LORAT + ((size_t)l * 4 + m) * 256 * 64 * 2), 64, nbk * 32, 0, scr, lane); }
    }
    __syncthreads();
    for (int it = bid; it < 192; it += nb) {
        const int l = it / 96, cb = it % 96;
        LAS float* sc = (LAS float*)lds;
        LAS float* red = sc + 9 * 1024;
        for (int e = tid; e < 9 * 1024; e += 512) { const int r = e >> 10, k = e & 1023; const float v = (r < 8) ? p.in[1][r * 1024 + k] : p.in[3][k]; sc[e] = v / (1.f + __expf(-v)); }
        __syncthreads();
        const int ks = tid >> 6, cl = tid & 63, n = cb * 64 + cl;
        float acc[9];
#pragma unroll
        for (int r = 0; r < 9; ++r) acc[r] = 0.f;
        const float* aw = p.in[4] + (size_t)l * DM * 6144;
#pragma unroll 16
        for (int k = ks * 128; k < ks * 128 + 128; ++k) { const float w = aw[(size_t)k * 6144 + n];
#pragma unroll
            for (int r = 0; r < 9; ++r) acc[r] += sc[r * 1024 + k] * w; }
#pragma unroll
        for (int r = 0; r < 9; ++r) red[(ks * 9 + r) * 64 + cl] = acc[r];
        __syncthreads();
        for (int e = tid; e < 9 * 64; e += 512) { const int r = e >> 6, c2 = e & 63; float s = 0.f;
            for (int q = 0; q < 8; ++q) s += red[(q * 9 + r) * 64 + c2];
            ((float*)(p.ws + WS_MOD))[((size_t)l * 9 + r) * 6144 + cb * 64 + c2] = s + p.in[5][(size_t)l * 6144 + cb * 64 + c2]; }
        __syncthreads();
    }
    if (bid == 0 && tid < 4) ((unsigned*)(p.ws + WS_CTR))[tid] = 0u;
    if (bid == nb - 1) {
        float* tab = (float*)(p.ws + WS_TAB);
        for (int e = tid; e < 64 * 16; e += 512) { const int pos = e >> 4, f = e & 15; const float inv = powf(10000.f, -(float)(2 * f) / 32.f); const float a = (float)pos * inv; tab[e] = cosf(a); tab[1024 + e] = sinf(a); }
        for (int e = tid; e < 64 * 8; e += 512) { const int pos = e >> 3, f = e & 7; const float inv = powf(10000.f, -(float)(2 * f) / 16.f); const float a = (float)pos * inv; tab[2048 + e] = cosf(a); tab[2560 + e] = sinf(a); }
    }
}

struct RowJob { const float* xsrc; const bf16_t* z; const float* gpost; const float* gate; float* xdst; const float* gpre; const float* shift; const float* scale; bf16_t* hdst; };
__device__ __forceinline__ RowJob make_rowjob(const Params& p, int mode, int l, int row) {
    const float* mod = (const float*)(p.ws + WS_MOD);
    bf16_t* HB = (bf16_t*)(p.ws + WS_HB); const bf16_t* Z = (const bf16_t*)(p.ws + WS_Z);
    float* XC = (float*)(p.ws + WS_XC);
    const SeqInfo s = seq_of_row(row);
    const int mr = s.isctx ? 8 : s.b;
    const float* m_l = mod + ((size_t)l * 9 + mr) * 6144;
    float* xs = s.isctx ? XC + (size_t)(row - TMAIN) * DM : p.out + (size_t)row * DM;
    const float* xin = s.isctx ? p.in[2] + (size_t)(row - TMAIN) * DM : p.in[0] + (size_t)row * DM;
    RowJob j;
    if (mode == 0) { j = RowJob{xin, nullptr, nullptr, nullptr, nullptr, p.in[6] + l * DM, m_l + 0, m_l + 1024, HB + (size_t)row * DM}; }
    else if (mode == 1) { j = RowJob{l == 0 ? xin : xs, Z + (size_t)row * DM, p.in[7] + l * DM, m_l + 2048, xs, p.in[8] + l * DM, m_l + 3072, m_l + 4096, HB + (size_t)row * DM}; }
    else { const bool has_next = (l + 1 < 2); const float* m_n = mod + ((size_t)(has_next ? l + 1 : l) * 9 + mr) * 6144;
        j = RowJob{xs, Z + (size_t)row * DM, p.in[9] + l * DM, m_l + 5120, xs, p.in[6] + (has_next ? l + 1 : l) * DM, m_n + 0, m_n + 1024, has_next ? HB + (size_t)row * DM : nullptr}; }
    return j;
}
template <int RB>
__device__ __forceinline__ void rowop_batch(const RowJob (&jb)[RB], const bool (&valid)[RB], int lane) {
    f32x4 v[RB][4]; u32x2 zu[RB][4];
#pragma unroll
    for (int r = 0; r < RB; ++r) if (valid[r]) {
#pragma unroll
        for (int j = 0; j < 4; ++j) { v[r][j] = *(const f32x4*)(jb[r].xsrc + (j * 64 + lane) * 4); if (jb[r].z) zu[r][j] = *(const u32x2*)(jb[r].z + (j * 64 + lane) * 4); }
    }
#pragma unroll
    for (int r = 0; r < RB; ++r) if (valid[r]) {
        const RowJob& J = jb[r];
        if (J.z) {
            f32x4 zz[4], gp[4], gt[4]; float ss = 0.f;
#pragma unroll
            for (int j = 0; j < 4; ++j) { const int c = (j * 64 + lane) * 4; gp[j] = *(const f32x4*)(J.gpost + c); gt[j] = *(const f32x4*)(J.gate + c); }
#pragma unroll
            for (int j = 0; j < 4; ++j) { const u32x2 u = zu[r][j];
                zz[j].x = bf2f((bf16_t)(u.x & 0xffff)); zz[j].y = bf2f((bf16_t)(u.x >> 16)); zz[j].z = bf2f((bf16_t)(u.y & 0xffff)); zz[j].w = bf2f((bf16_t)(u.y >> 16));
                ss += zz[j].x * zz[j].x + zz[j].y * zz[j].y + zz[j].z * zz[j].z + zz[j].w * zz[j].w; }
            const float rinv = 1.f / sqrtf(wave_sum(ss) * (1.f / 1024.f) + 1e-6f);
#pragma unroll
            for (int j = 0; j < 4; ++j) { const int c = (j * 64 + lane) * 4;
                v[r][j].x += gt[j].x * (zz[j].x * rinv * gp[j].x); v[r][j].y += gt[j].y * (zz[j].y * rinv * gp[j].y); v[r][j].z += gt[j].z * (zz[j].z * rinv * gp[j].z); v[r][j].w += gt[j].w * (zz[j].w * rinv * gp[j].w);
                *(f32x4*)(J.xdst + c) = v[r][j]; }
        }
        if (J.hdst) {
            f32x4 g[4], sh[4], sc[4]; float ss = 0.f;
#pragma unroll
            for (int j = 0; j < 4; ++j) { const int c = (j * 64 + lane) * 4; g[j] = *(const f32x4*)(J.gpre + c); sh[j] = *(const f32x4*)(J.shift + c); sc[j] = *(const f32x4*)(J.scale + c); }
#pragma unroll
            for (int j = 0; j < 4; ++j) ss += v[r][j].x * v[r][j].x + v[r][j].y * v[r][j].y + v[r][j].z * v[r][j].z + v[r][j].w * v[r][j].w;
            const float rinv = 1.f / sqrtf(wave_sum(ss) * (1.f / 1024.f) + 1e-6f);
#pragma unroll
            for (int j = 0; j < 4; ++j) { const int c = (j * 64 + lane) * 4;
                u32x2 o; o.x = pk2(v[r][j].x * rinv * g[j].x * (1.f + sc[j].x) + sh[j].x, v[r][j].y * rinv * g[j].y * (1.f + sc[j].y) + sh[j].y);
                o.y = pk2(v[r][j].z * rinv * g[j].z * (1.f + sc[j].z) + sh[j].z, v[r][j].w * rinv * g[j].w * (1.f + sc[j].w) + sh[j].w);
                *(u32x2*)(J.hdst + c) = o; }
        }
    }
}
__device__ __forceinline__ void phase_rowops(const Params& p, int mode, int l, int nrows, int bid, int nb) {
    const int tid = get_tid(), lane = tid & 63, wave = tid >> 6;
    constexpr int RB = 4;
    const int nwaves = nb * 8, gw = bid * 8 + wave;
    for (int base = gw; base < nrows; base += nwaves * RB) {
        RowJob jb[RB]; bool valid[RB];
#pragma unroll
        for (int r = 0; r < RB; ++r) { const int row = base + r * nwaves; valid[r] = row < nrows; jb[r] = make_rowjob(p, mode, l, valid[r] ? row : 0); }
        rowop_batch<RB>(jb, valid, lane);
    }
}

__device__ __forceinline__ void rwkv_prep_item(const Params& p, int l, LAS unsigned char* lds, int tile) {
    const int tid = get_tid(), lane = tid & 63, wave = tid >> 6, fr = lane & 15, fq = lane >> 4;
    const bf16_t* P = (const bf16_t*)(p.ws + WS_P);
    const int t0 = tile * 32; const SeqInfo s0 = seq_of_row(t0);
    const float* mu = p.in[14] + l * 1024;
    LAS bf16_t* r_s = (LAS bf16_t*)lds;
    LAS bf16_t* k_s = r_s + 32 * 256;
    LAS bf16_t* v_s = k_s + 32 * 256;
    LAS unsigned char* twd = lds + 3 * 16384;
    LAS unsigned char* ads = twd + 32 * 144;
    LAS float* O1 = (LAS float*)(ads + 32 * 144);
#pragma unroll
    for (int it = 0; it < 7; ++it) {
        const int pc = tid + it * 512; const int tok = pc / 112, c8 = pc % 112, cc = c8 * 8;
        const int pcol = cc < 256 ? PC_RWR + cc : PC_RWK + (cc - 256);
        const int row = t0 + tok, pos = s0.pos + tok;
        const u32x4 u0 = *(const u32x4*)(P + (size_t)row * NP + pcol);
        const u32x4 um = pos > 0 ? *(const u32x4*)(P + (size_t)(row - 1) * NP + pcol) : (u32x4){0u, 0u, 0u, 0u};
        const u32x4 up = pos < s0.len - 1 ? *(const u32x4*)(P + (size_t)(row + 1) * NP + pcol) : (u32x4){0u, 0u, 0u, 0u};
        const f32x4 mu0 = *(const f32x4*)(mu + cc), mu1 = *(const f32x4*)(mu + cc + 4);
        float z0[8], zm[8], zp[8], zs[8]; unpack8(u0, z0); unpack8(um, zm); unpack8(up, zp);
        const float mm[8] = {mu0.x, mu0.y, mu0.z, mu0.w, mu1.x, mu1.y, mu1.z, mu1.w};
#pragma unroll
        for (int x = 0; x < 8; ++x) zs[x] = z0[x] + mm[x] * (0.5f * (zm[x] + zp[x]) - z0[x]);
        LAS unsigned char* dst;
        if (cc < 256) dst = (LAS unsigned char*)(r_s + tok * 256 + cc);
        else if (cc < 512) dst = (LAS unsigned char*)(k_s + tok * 256 + cc - 256);
        else if (cc < 768) dst = (LAS unsigned char*)(v_s + tok * 256 + cc - 512);
        else if (cc < 832) { dst = twd + tok * 144 + (cc - 768) * 2;
#pragma unroll
            for (int x = 0; x < 8; ++x) zs[x] = 1.f - 2.f * __builtin_amdgcn_rcpf(1.f + __expf(2.f * zs[x])); }
        else dst = ads + tok * 144 + (cc - 832) * 2;
        *(LAS u32x4*)dst = (u32x4){cvt_pk_bf16(zs[0], zs[1]), cvt_pk_bf16(zs[2], zs[3]), cvt_pk_bf16(zs[4], zs[5]), cvt_pk_bf16(zs[6], zs[7])};
    }
    __syncthreads();
    const int hh = tid >> 8, c = tid & 255, h = c >> 6;
    bf16_t* RK = (bf16_t*)(p.ws + WS_RWK); bf16_t* RV = (bf16_t*)(p.ws + WS_RWV); bf16_t* RR = (bf16_t*)(p.ws + WS_RWRR);
    bf16_t* RA0 = (bf16_t*)(p.ws + WS_RWA0); bf16_t* RA1 = (bf16_t*)(p.ws + WS_RWA1); bf16_t* RM0 = (bf16_t*)(p.ws + WS_RWM0); bf16_t* RM1 = (bf16_t*)(p.ws + WS_RWM1);
    float* BON = (float*)(p.ws + WS_BON);
#pragma unroll
    for (int pass = 0; pass < 2; ++pass) {
        { const bf16_t* WT = (const bf16_t*)(p.ws + WS_LORAT + ((size_t)l * 4 + pass * 2) * 256 * 64 * 2);
          LAS unsigned char* A = pass ? ads : twd;
          const bf16x8 x00 = *(const LAS bf16x8*)(A + fr * 144 + fq * 16), x01 = *(const LAS bf16x8*)(A + fr * 144 + 64 + fq * 16);
          const bf16x8 x10 = *(const LAS bf16x8*)(A + (16 + fr) * 144 + fq * 16), x11 = *(const LAS bf16x8*)(A + (16 + fr) * 144 + 64 + fq * 16);
          bf16x8 b0[4], b1[4];
#pragma unroll
          for (int q = 0; q < 4; ++q) { const int t = wave * 4 + q, m = t >> 4, nt = t & 15; const bf16_t* wrow = WT + (size_t)m * 256 * 64 + (size_t)(nt * 16 + fr) * 64 + fq * 8;
              b0[q] = *(const bf16x8*)wrow; b1[q] = *(const bf16x8*)(wrow + 32); }
#pragma unroll
          for (int q = 0; q < 4; ++q) { const int t = wave * 4 + q, m = t >> 4, nt = t & 15;
              f32x4 a0 = (f32x4){0.f, 0.f, 0.f, 0.f}, a1 = a0;
              a0 = __builtin_amdgcn_mfma_f32_16x16x32_bf16(x00, b0[q], a0, 0, 0, 0); a0 = __builtin_amdgcn_mfma_f32_16x16x32_bf16(x01, b1[q], a0, 0, 0, 0);
              a1 = __builtin_amdgcn_mfma_f32_16x16x32_bf16(x10, b0[q], a1, 0, 0, 0); a1 = __builtin_amdgcn_mfma_f32_16x16x32_bf16(x11, b1[q], a1, 0, 0, 0);
#pragma unroll
              for (int r = 0; r < 4; ++r) { O1[(m * 32 + fq * 4 + r) * 256 + nt * 16 + fr] = a0[r]; O1[(m * 32 + 16 + fq * 4 + r) * 256 + nt * 16 + fr] = a1[r]; } } }
        __syncthreads();
        if (pass == 0) {
            const float w0b0 = p.in[15][(l * 2 + 0) * 256 + c], w0b1 = p.in[15][(l * 2 + 1) * 256 + c];
#pragma unroll
            for (int i = 0; i < 16; ++i) { const int tok = hh * 16 + i; const size_t o = (size_t)(t0 + tok) * 256 + c;
                const float sg0 = sigmoidf_(w0b0 + O1[tok * 256 + c]), sg1 = sigmoidf_(w0b1 + O1[(32 + tok) * 256 + c]);
                RM0[o] = f2bf(1.f - __expf(-0.60653066f * sg0)); RM1[o] = f2bf(1.f - __expf(-0.60653066f * sg1)); }
        } else {
            const float a0b0 = p.in[17][(l * 2 + 0) * 256 + c], a0b1 = p.in[17][(l * 2 + 1) * 256 + c];
            const float ka = p.in[21][l * 256 + c], rk = p.in[22][l * 256 + c];
#pragma unroll
            for (int i = 0; i < 16; ++i) { const int tok = hh * 16 + i, row = t0 + tok; const size_t o = (size_t)row * 256 + c;
                const bf16_t kb = k_s[tok * 256 + c], vb = v_s[tok * 256 + c], rb = r_s[tok * 256 + c];
                const float k = bf2f(kb), r = bf2f(rb);
                const float a0 = sigmoidf_(a0b0 + O1[tok * 256 + c]), a1 = sigmoidf_(a0b1 + O1[(32 + tok) * 256 + c]);
                const float kt0 = k * (1.f + (a0 - 1.f) * ka), kt1 = k * (1.f + (a1 - 1.f) * ka);
                const float bs = wave_sum(r * (kt0 + kt1) * rk);
                RK[o] = kb; RV[o] = vb; RR[o] = rb; RA0[o] = f2bf(a0); RA1[o] = f2bf(a1);
                if ((tid & 63) == 0) BON[(size_t)row * 4 + h] = bs; }
        }
        __syncthreads();
    }
}
__device__ __forceinline__ int ret_chunk_index(int cr, int& b) { if (cr < 256) { b = cr >> 5; return 2 + (cr & 31); } b = (cr - 256) >> 1; return (cr - 256) & 1; }
__device__ __forceinline__ void ret_kv_item(const Params& p, LAS unsigned char* lds, int item) {
    const int tid = get_tid(), lane = tid & 63, wave = tid >> 6, fr = lane & 15, fq = lane >> 4;
    const bf16_t* P = (const bf16_t*)(p.ws + WS_P);
    const int cr = item >> 2, h = item & 3; int b; const int ci = ret_chunk_index(cr, b);
    const int r0 = cr * 128;
    LAS unsigned char* Ktf = lds;
    LAS unsigned char* Ktb = lds + 64 * 272;
    LAS unsigned char* Vt = lds + 2 * 64 * 272;
    const float lg2 = log1pf(-exp2f(-5.f - (float)h)) * 1.44269504f;
#pragma unroll
    for (int it = 0; it < 2; ++it) { const int pc = tid + it * 512, j = pc >> 3, c8 = pc & 7;
        const u32x4 kk = *(const u32x4*)(P + (size_t)(r0 + j) * NP + PC_RETK + h * 64 + c8 * 8);
        const u32x4 vv = *(const u32x4*)(P + (size_t)(r0 + j) * NP + PC_RETV + h * 64 + c8 * 8);
        float kf[8]; unpack8(kk, kf);
        const float df = 0.125f * __builtin_amdgcn_exp2f((float)(127 - j) * lg2), db = 0.125f * __builtin_amdgcn_exp2f((float)j * lg2);
        const unsigned vw[4] = {vv.x, vv.y, vv.z, vv.w};
#pragma unroll
        for (int x = 0; x < 8; ++x) { const int d = c8 * 8 + x;
            *(LAS bf16_t*)(Ktf + d * 272 + j * 2) = f2bf(kf[x] * df); *(LAS bf16_t*)(Ktb + d * 272 + j * 2) = f2bf(kf[x] * db);
            *(LAS bf16_t*)(Vt + d * 272 + j * 2) = (bf16_t)((x & 1) ? (vw[x >> 1] >> 16) : (vw[x >> 1] & 0xffff)); } }
    __syncthreads();
    const int dir = wave >> 2, mt = wave & 3;
    LAS unsigned char* A = dir ? Ktb : Ktf;
    bf16x8 af[4];
#pragma unroll
    for (int kc = 0; kc < 4; ++kc) af[kc] = *(const LAS bf16x8*)(A + (mt * 16 + fr) * 272 + kc * 64 + fq * 16);
    float* RS = (float*)(p.ws + WS_RET) + ((size_t)((b * 4 + h) * 34 + ci) * 2 + dir) * 4096;
#pragma unroll
    for (int nt = 0; nt < 4; ++nt) { f32x4 acc = (f32x4){0.f, 0.f, 0.f, 0.f};
#pragma unroll
        for (int kc = 0; kc < 4; ++kc) { const bf16x8 bf = *(const LAS bf16x8*)(Vt + (nt * 16 + fr) * 272 + kc * 64 + fq * 16);
            acc = __builtin_amdgcn_mfma_f32_16x16x32_bf16(af[kc], bf, acc, 0, 0, 0); }
#pragma unroll
        for (int r = 0; r < 4; ++r) RS[(mt * 16 + fq * 4 + r) * 64 + nt * 16 + fr] = acc[r]; }
    __syncthreads();
}
__device__ __forceinline__ void swa_prep_item(const Params& p, LAS unsigned char* lds, int tile) {
    const int tid = get_tid();
    bf16_t* P = (bf16_t*)(p.ws + WS_P);
    const float* tabc = (const float*)(p.ws + WS_TAB); const float* tabs = tabc + 1024;
    bf16_t* KS = (bf16_t*)(p.ws + WS_KS); bf16_t* VT = (bf16_t*)(p.ws + WS_VTS);
    const int t0 = tile * 64; const SeqInfo s0 = seq_of_row(t0);
    const int key0 = s0.isctx ? s0.pos : CTXL + s0.pos;
    LAS bf16_t* Vs = (LAS bf16_t*)lds;
    u32x4 vreg[2];
#pragma unroll
    for (int it = 0; it < 2; ++it) { const int pc = tid + it * 512, tok = pc >> 4, c8 = pc & 15; vreg[it] = *(const u32x4*)(P + (size_t)(t0 + tok) * NP + PC_SWAV + c8 * 8); }
    u32x4 x1[3], x2[3];
#pragma unroll
    for (int it = 0; it < 3; ++it) { const int e = tid + it * 512; const int tok = e / 24, rem = e % 24, hd = rem >> 2, axis = (rem >> 1) & 1, fg = rem & 1;
        const int colbase = (hd < 4 ? PC_SWAQ + hd * 64 : PC_SWAK + (hd - 4) * 64) + axis * 32 + fg * 8;
        x1[it] = *(const u32x4*)(P + (size_t)(t0 + tok) * NP + colbase); x2[it] = *(const u32x4*)(P + (size_t)(t0 + tok) * NP + colbase + 16); }
#pragma unroll
    for (int it = 0; it < 2; ++it) { const int pc = tid + it * 512, tok = pc >> 4, c8 = pc & 15; *(LAS u32x4*)(Vs + tok * 136 + c8 * 8) = vreg[it]; }
#pragma unroll
    for (int it = 0; it < 3; ++it) { const int e = tid + it * 512; const int tok = e / 24, rem = e % 24, hd = rem >> 2, axis = (rem >> 1) & 1, fg = rem & 1;
        const int row = t0 + tok, pos = s0.pos + tok;
        const int colbase = (hd < 4 ? PC_SWAQ + hd * 64 : PC_SWAK + (hd - 4) * 64) + axis * 32 + fg * 8;
        float a[8], bb[8]; unpack8(x1[it], a); unpack8(x2[it], bb);
        if (!s0.isctx) { const int pp = axis == 0 ? (pos >> 6) : (pos & 63);
            const f32x4 c0 = *(const f32x4*)(tabc + pp * 16 + fg * 8), c1 = *(const f32x4*)(tabc + pp * 16 + fg * 8 + 4), s0v = *(const f32x4*)(tabs + pp * 16 + fg * 8), s1v = *(const f32x4*)(tabs + pp * 16 + fg * 8 + 4);
            const float cs[8] = {c0.x, c0.y, c0.z, c0.w, c1.x, c1.y, c1.z, c1.w}, sn[8] = {s0v.x, s0v.y, s0v.z, s0v.w, s1v.x, s1v.y, s1v.z, s1v.w};
#pragma unroll
            for (int x = 0; x < 8; ++x) { const float y1 = a[x] * cs[x] - bb[x] * sn[x], y2 = bb[x] * cs[x] + a[x] * sn[x]; a[x] = y1; bb[x] = y2; } }
        u32x4 o1, o2; o1.x = pk2(a[0], a[1]); o1.y = pk2(a[2], a[3]); o1.z = pk2(a[4], a[5]); o1.w = pk2(a[6], a[7]);
        o2.x = pk2(bb[0], bb[1]); o2.y = pk2(bb[2], bb[3]); o2.z = pk2(bb[4], bb[5]); o2.w = pk2(bb[6], bb[7]);
        if (hd < 4) { if (!s0.isctx) { *(u32x4*)(P + (size_t)row * NP + colbase) = o1; *(u32x4*)(P + (size_t)row * NP + colbase + 16) = o2; } }
        else { bf16_t* kd = KS + ((size_t)(s0.b * 2 + (hd - 4)) * NKEYS + key0 + tok) * 64 + axis * 32 + fg * 8; *(u32x4*)kd = o1; *(u32x4*)(kd + 16) = o2; }
    }
    __syncthreads();
#pragma unroll
    for (int it = 0; it < 2; ++it) { const int pc = tid + it * 512, hd = pc >> 3, k8 = pc & 7, hk = hd >> 6, d = hd & 63;
        unsigned w[4];
#pragma unroll
        for (int x = 0; x < 4; ++x) w[x] = (unsigned)Vs[(k8 * 8 + 2 * x) * 136 + hd] | ((unsigned)Vs[(k8 * 8 + 2 * x + 1) * 136 + hd] << 16);
        *(u32x4*)(VT + ((size_t)(s0.b * 2 + hk) * 64 + d) * NKEYS + key0 + k8 * 8) = (u32x4){w[0], w[1], w[2], w[3]}; }
    __syncthreads();
}
__device__ __forceinline__ void mla_proj_item(const Params& p, int l, LAS unsigned char* lds, int tile);
__device__ __forceinline__ void phase_prepA(const Params& p, int l, LAS unsigned char* lds, int bid, int nb) {
    for (int it = bid; it < TT / 32; it += nb) rwkv_prep_item(p, l, lds, it);
}
__device__ __forceinline__ void prep_rest_items(const Params& p, int l, LAS unsigned char* lds, int first, int stride) {
    constexpr int N2 = 272 * 4, N3 = TT / 64, N4 = TT / 32;
    for (int it = first; it < N2 + N3 + N4; it += stride) {
        if (it < N4) mla_proj_item(p, l, lds, it);
        else if (it < N4 + N2) ret_kv_item(p, lds, it - N4);
        else swa_prep_item(p, lds, it - N4 - N2);
    }
}

__device__ __forceinline__ void mla_proj_item(const Params& p, int l, LAS unsigned char* lds, int tile) {
    const int tid = get_tid(), lane = tid & 63, wave = tid >> 6, fr = lane & 15, fq = lane >> 4;
    const bf16_t* P = (const bf16_t*)(p.ws + WS_P);
    const float* tabc = (const float*)(p.ws + WS_TAB) + 2048; const float* tabs = tabc + 512;
    const int t0 = tile * 32; const SeqInfo s0 = seq_of_row(t0);
    const int key0 = s0.isctx ? s0.pos : CTXL + s0.pos;
    LAS unsigned char* qn = lds;
    LAS unsigned char* kvn = lds + 32 * 528;
    LAS float* qo = (LAS float*)(lds + 32 * 528 + 32 * 272);
    LAS float* kvo = qo + 32 * 384;
    const float* qg = p.in[24] + l * 256; const float* kvg = p.in[26] + l * 128;
    for (int i = 0; i < 4; ++i) { const int tok = wave * 4 + i, row = t0 + tok;
        float x[4]; float ss = 0.f;
#pragma unroll
        for (int j = 0; j < 4; ++j) { x[j] = bf2f(P[(size_t)row * NP + PC_MLAQD + j * 64 + lane]); ss += x[j] * x[j]; }
        const float rq = 1.f / sqrtf(wave_sum(ss) * (1.f / 256.f) + 1e-6f);
#pragma unroll
        for (int j = 0; j < 4; ++j) *(LAS bf16_t*)(qn + tok * 528 + (j * 64 + lane) * 2) = f2bf(x[j] * rq * qg[j * 64 + lane]);
        float y[2]; float s2 = 0.f;
#pragma unroll
        for (int j = 0; j < 2; ++j) { y[j] = bf2f(P[(size_t)row * NP + PC_MLAKVD + j * 64 + lane]); s2 += y[j] * y[j]; }
        const float rk = 1.f / sqrtf(wave_sum(s2) * (1.f / 128.f) + 1e-6f);
#pragma unroll
        for (int j = 0; j < 2; ++j) *(LAS bf16_t*)(kvn + tok * 272 + (j * 64 + lane) * 2) = f2bf(y[j] * rk * kvg[j * 64 + lane]);
    }
    __syncthreads();
    {
        const bf16_t* WqT = (const bf16_t*)(p.ws + WS_MLAW + (size_t)l * MLAW_LAYER);
        const bf16_t* WkvT = (const bf16_t*)(p.ws + WS_MLAW + (size_t)l * MLAW_LAYER + MLAW_KV);
        {
            bf16x8 bq[3][8];
#pragma unroll
            for (int q = 0; q < 3; ++q) { const bf16_t* wrow = WqT + (size_t)((wave + 8 * q) * 16 + fr) * 256 + fq * 8;
#pragma unroll
                for (int kc = 0; kc < 8; ++kc) bq[q][kc] = *(const bf16x8*)(wrow + kc * 32); }
#pragma unroll
            for (int q = 0; q < 3; ++q) { const int nt = wave + 8 * q;
                f32x4 a0 = (f32x4){0.f, 0.f, 0.f, 0.f}, a1 = a0;
#pragma unroll
                for (int kc = 0; kc < 8; ++kc) { const bf16x8 x0 = *(const LAS bf16x8*)(qn + fr * 528 + kc * 64 + fq * 16), x1 = *(const LAS bf16x8*)(qn + (16 + fr) * 528 + kc * 64 + fq * 16);
                    a0 = __builtin_amdgcn_mfma_f32_16x16x32_bf16(x0, bq[q][kc], a0, 0, 0, 0); a1 = __builtin_amdgcn_mfma_f32_16x16x32_bf16(x1, bq[q][kc], a1, 0, 0, 0); }
#pragma unroll
                for (int r = 0; r < 4; ++r) { qo[(fq * 4 + r) * 384 + nt * 16 + fr] = a0[r]; qo[(16 + fq * 4 + r) * 384 + nt * 16 + fr] = a1[r]; } }
        }
        {
            bf16x8 bk[4][4];
#pragma unroll
            for (int q = 0; q < 4; ++q) { const bf16_t* wrow = WkvT + (size_t)((wave + 8 * q) * 16 + fr) * 128 + fq * 8;
#pragma unroll
                for (int kc = 0; kc < 4; ++kc) bk[q][kc] = *(const bf16x8*)(wrow + kc * 32); }
#pragma unroll
            for (int q = 0; q < 4; ++q) { const int n0 = (wave + 8 * q) * 16;
                f32x4 a0 = (f32x4){0.f, 0.f, 0.f, 0.f}, a1 = a0;
#pragma unroll
                for (int kc = 0; kc < 4; ++kc) { const bf16x8 x0 = *(const LAS bf16x8*)(kvn + fr * 272 + kc * 64 + fq * 16), x1 = *(const LAS bf16x8*)(kvn + (16 + fr) * 272 + kc * 64 + fq * 16);
                    a0 = __builtin_amdgcn_mfma_f32_16x16x32_bf16(x0, bk[q][kc], a0, 0, 0, 0); a1 = __builtin_amdgcn_mfma_f32_16x16x32_bf16(x1, bk[q][kc], a1, 0, 0, 0); }
#pragma unroll
                for (int r = 0; r < 4; ++r) { kvo[(fq * 4 + r) * 512 + n0 + fr] = a0[r]; kvo[(16 + fq * 4 + r) * 512 + n0 + fr] = a1[r]; } }
        }
    }
    __syncthreads();
    {
        const int h = tid >> 7, dd = tid & 127;
        if (dd < 64) { bf16_t* KM = (bf16_t*)(p.ws + WS_KM) + ((size_t)(s0.b * 4 + h) * NKEYS + key0) * 96 + dd;
#pragma unroll
            for (int i = 0; i < 32; ++i) KM[(size_t)i * 96] = f2bf(kvo[i * 512 + tid]); }
        else { bf16_t* VT = (bf16_t*)(p.ws + WS_VTM) + ((size_t)(s0.b * 4 + h) * 64 + (dd - 64)) * NKEYS + key0;
            unsigned w[16];
#pragma unroll
            for (int i = 0; i < 16; ++i) w[i] = pk2(kvo[(2 * i) * 512 + tid], kvo[(2 * i + 1) * 512 + tid]);
#pragma unroll
            for (int i = 0; i < 4; ++i) *(u32x4*)(VT + i * 8) = (u32x4){w[4 * i], w[4 * i + 1], w[4 * i + 2], w[4 * i + 3]}; }
    }
    bf16_t* MQ = (bf16_t*)(p.ws + WS_MQ);
    for (int e = tid; e < 32 * 384; e += 512) { const int tok = e / 384, c = e % 384, dd = c % 96; const int pos = s0.pos + tok;
        float v = qo[e];
        if (dd >= 64 && !s0.isctx) { const int pe = dd - 64, axis = pe >> 4, half = (pe >> 3) & 1, f = pe & 7; const int pp = axis == 0 ? (pos >> 6) : (pos & 63);
            const float cs = tabc[pp * 8 + f], sn = tabs[pp * 8 + f];
            const float x1 = half ? qo[e - 8] : v, x2 = half ? v : qo[e + 8];
            v = half ? (x2 * cs + x1 * sn) : (x1 * cs - x2 * sn); }
        MQ[(size_t)(t0 + tok) * 384 + c] = f2bf(v); }
    for (int e = tid; e < 32 * 32; e += 512) { const int tok = e >> 5, pe = e & 31, axis = pe >> 4, half = (pe >> 3) & 1, f = pe & 7; const int row = t0 + tok, pos = s0.pos + tok;
        float v = bf2f(P[(size_t)row * NP + PC_MLAKPE + pe]);
        if (!s0.isctx) { const int pp = axis == 0 ? (pos >> 6) : (pos & 63); const float cs = tabc[pp * 8 + f], sn = tabs[pp * 8 + f];
            const float other = bf2f(P[(size_t)row * NP + PC_MLAKPE + (half ? pe - 8 : pe + 8)]);
            const float x1 = half ? other : v, x2 = half ? v : other;
            v = half ? (x2 * cs + x1 * sn) : (x1 * cs - x2 * sn); }
        const bf16_t o = f2bf(v);
#pragma unroll
        for (int h = 0; h < 4; ++h) ((bf16_t*)(p.ws + WS_KM))[((size_t)(s0.b * 4 + h) * NKEYS + key0 + tok) * 96 + 64 + pe] = o; }
    __syncthreads();
}
__device__ __forceinline__ void ret_scan_item(const Params& p, int l, int item) {
    const int tid = get_tid(); const int seq = item >> 1, dir = item & 1, h = seq & 3;
    const float lg = log1pf(-exp2f(-5.f - (float)h)); const float cdec = expf(128.f * lg);
    float* base = (float*)(p.ws + WS_RET) + (size_t)seq * 34 * 2 * 4096 + dir * 4096;
    auto ci_of = [&](int st) -> int { return dir == 0 ? st : (st == 0 ? 1 : (st == 1 ? 0 : 35 - st)); };
    float S[8];
#pragma unroll
    for (int i = 0; i < 8; ++i) S[i] = 0.f;
    f32x4 pa[4], pb[4];
#pragma unroll
    for (int k = 0; k < 4; ++k) { const float* q = base + (size_t)ci_of(k) * 2 * 4096 + tid * 8; pa[k] = *(const f32x4*)q; pb[k] = *(const f32x4*)(q + 4); }
#pragma unroll 1
    for (int st0 = 0; st0 < 36; st0 += 4) {
#pragma unroll
        for (int k = 0; k < 4; ++k) { const int st = st0 + k;
            if (st < 34) {
                float* q = base + (size_t)ci_of(st) * 2 * 4096 + tid * 8;
                const f32x4 t0 = pa[k], t1 = pb[k];
                if (st + 4 < 34) { const float* qn = base + (size_t)ci_of(st + 4) * 2 * 4096 + tid * 8; pa[k] = *(const f32x4*)qn; pb[k] = *(const f32x4*)(qn + 4); }
                *(f32x4*)q = (f32x4){S[0], S[1], S[2], S[3]}; *(f32x4*)(q + 4) = (f32x4){S[4], S[5], S[6], S[7]};
                S[0] = S[0] * cdec + t0.x; S[1] = S[1] * cdec + t0.y; S[2] = S[2] * cdec + t0.z; S[3] = S[3] * cdec + t0.w;
                S[4] = S[4] * cdec + t1.x; S[5] = S[5] * cdec + t1.y; S[6] = S[6] * cdec + t1.z; S[7] = S[7] * cdec + t1.w;
            } }
    }
    asm volatile("s_waitcnt vmcnt(0)" ::: "memory");
    __syncthreads();
    if (tid == 0) { __builtin_amdgcn_fence(__ATOMIC_RELEASE, "agent"); asm volatile("s_waitcnt vmcnt(0)" ::: "memory");
        __hip_atomic_fetch_add((unsigned*)(p.ws + WS_CTR) + 2 + l, 1u, __ATOMIC_RELAXED, __HIP_MEMORY_SCOPE_AGENT); }
}
__device__ __forceinline__ void wait_counter(const Params& p, int idx, unsigned need) {
    if (get_tid() == 0) { unsigned* f = (unsigned*)(p.ws + WS_CTR) + idx; unsigned sp = 0;
        while (__hip_atomic_load(f, __ATOMIC_RELAXED, __HIP_MEMORY_SCOPE_AGENT) < need) { __builtin_amdgcn_s_sleep(4); if (++sp > (1u << 22)) break; }
        __builtin_amdgcn_fence(__ATOMIC_ACQUIRE, "agent"); asm volatile("s_waitcnt vmcnt(0)" ::: "memory"); }
    __syncthreads();
}
template <int DK>
__device__ __forceinline__ void attn_unit(const bf16_t* Q, int qstride, const bf16_t* K, const bf16_t* Vt, int nctx, int mt0, int mt1, bool masked, int qpos0,
                                          bool has_sink, float sink, float scale, bf16_t* O, int ostride, LAS unsigned char* lds) {
    constexpr int KC = DK / 32, KP = DK + 8, KROW = KP * 2;
    constexpr int PIECES_K = 64 * DK / 8;
    constexpr int BUFB = 64 * KROW + 64 * 144;
    const int tid = get_tid(), lane = tid & 63, wave = tid >> 6, fr = lane & 15, fq = lane >> 4;
    const float sl2 = scale * 1.44269504f;
    bf16x8 qf[2][KC];
#pragma unroll
    for (int g = 0; g < 2; ++g)
#pragma unroll
        for (int kc = 0; kc < KC; ++kc) { const u32x4 u = *(const u32x4*)(Q + (size_t)(wave * 32 + g * 16 + fr) * qstride + kc * 32 + fq * 8); float f[8]; unpack8(u, f);
            u32x4 o; o.x = cvt_pk_bf16(f[0] * sl2, f[1] * sl2); o.y = cvt_pk_bf16(f[2] * sl2, f[3] * sl2); o.z = cvt_pk_bf16(f[4] * sl2, f[5] * sl2); o.w = cvt_pk_bf16(f[6] * sl2, f[7] * sl2);
            qf[g][kc] = __builtin_bit_cast(bf16x8, o); }
    float mq[2] = {0.f, 0.f}, lsum[2] = {0.f, 0.f}; f32x4 o[2][4];
#pragma unroll
    for (int g = 0; g < 2; ++g)
#pragma unroll
        for (int n = 0; n < 4; ++n) o[g][n] = (f32x4){0.f, 0.f, 0.f, 0.f};
    const int ntiles = nctx + (mt1 - mt0);
    u32x4 kr[2], vr;
    auto issue = [&](int ti) {
        const int tile = ti < nctx ? ti : mt0 + (ti - nctx);
        const bf16_t* kb = K + (size_t)tile * 64 * DK;
#pragma unroll
        for (int i = 0; i < 2; ++i) { const int pc = tid + i * 512; if (pc < PIECES_K) kr[i] = *(const u32x4*)(kb + (size_t)pc * 8); }
        { const int d = tid >> 3, c8 = tid & 7; vr = *(const u32x4*)(Vt + (size_t)d * NKEYS + tile * 64 + c8 * 8); }
    };
    auto stash = [&](int bufi) {
        LAS unsigned char* Kt = lds + bufi * BUFB; LAS unsigned char* Vl = Kt + 64 * KROW;
#pragma unroll
        for (int i = 0; i < 2; ++i) { const int pc = tid + i * 512; if (pc < PIECES_K) { const int row = pc / (DK / 8), c8 = pc % (DK / 8); *(LAS u32x4*)(Kt + row * KROW + c8 * 16) = kr[i]; } }
        { const int d = tid >> 3, c8 = tid & 7; *(LAS u32x4*)(Vl + d * 144 + c8 * 16) = vr; }
    };
    issue(0); stash(0);
    if (ntiles > 1) issue(1);
    __syncthreads();
    for (int ti = 0; ti < ntiles; ++ti) {
        const int tile = ti < nctx ? ti : mt0 + (ti - nctx);
        LAS unsigned char* Kt = lds + (ti & 1) * BUFB; LAS unsigned char* Vl = Kt + 64 * KROW;
        if (ti + 1 < ntiles) { stash((ti + 1) & 1); if (ti + 2 < ntiles) issue(ti + 2); }
        f32x4 s[2][4];
#pragma unroll
        for (int n = 0; n < 4; ++n) {
            s[0][n] = (f32x4){-mq[0], -mq[0], -mq[0], -mq[0]}; s[1][n] = (f32x4){-mq[1], -mq[1], -mq[1], -mq[1]};
#pragma unroll
            for (int kc = 0; kc < KC; ++kc) { const bf16x8 kf = *(const LAS bf16x8*)(Kt + (n * 16 + fr) * KROW + kc * 64 + fq * 16);
                s[0][n] = __builtin_amdgcn_mfma_f32_16x16x32_bf16(kf, qf[0][kc], s[0][n], 0, 0, 0);
                s[1][n] = __builtin_amdgcn_mfma_f32_16x16x32_bf16(kf, qf[1][kc], s[1][n], 0, 0, 0); } }
        if (ti == 0) {
#pragma unroll
            for (int g = 0; g < 2; ++g) {
                float t = -INFINITY;
#pragma unroll
                for (int n = 0; n < 4; ++n)
#pragma unroll
                    for (int r = 0; r < 4; ++r) t = fmaxf(t, s[g][n][r]);
                t = fmaxf(t, __shfl_xor(t, 16)); t = fmaxf(t, __shfl_xor(t, 32));
                if (has_sink) t = fmaxf(t, sink * 1.44269504f);
                mq[g] = t;
#pragma unroll
                for (int n = 0; n < 4; ++n)
#pragma unroll
                    for (int r = 0; r < 4; ++r) s[g][n][r] -= t;
            }
        }
        if (masked && ti >= nctx) {
#pragma unroll
            for (int g = 0; g < 2; ++g)
#pragma unroll
                for (int n = 0; n < 4; ++n)
#pragma unroll
                    for (int r = 0; r < 4; ++r) { const int kp = tile * 64 + n * 16 + fq * 4 + r - CTXL, qp = qpos0 + wave * 32 + g * 16 + fr; const int df = qp - kp; if (df > 128 || df < -128) s[g][n][r] = -INFINITY; }
        }
#pragma unroll
        for (int g = 0; g < 2; ++g)
#pragma unroll
            for (int n = 0; n < 4; ++n)
#pragma unroll
                for (int r = 0; r < 4; ++r) { s[g][n][r] = __builtin_amdgcn_exp2f(s[g][n][r]); lsum[g] += s[g][n][r]; }
#pragma unroll
        for (int c = 0; c < 2; ++c) {
            bf16x8 pf[2];
#pragma unroll
            for (int g = 0; g < 2; ++g) { u32x4 pu; pu.x = cvt_pk_bf16(s[g][2 * c][0], s[g][2 * c][1]); pu.y = cvt_pk_bf16(s[g][2 * c][2], s[g][2 * c][3]);
                pu.z = cvt_pk_bf16(s[g][2 * c + 1][0], s[g][2 * c + 1][1]); pu.w = cvt_pk_bf16(s[g][2 * c + 1][2], s[g][2 * c + 1][3]); pf[g] = __builtin_bit_cast(bf16x8, pu); }
#pragma unroll
            for (int n = 0; n < 4; ++n) {
                const u32x2 lo = *(const LAS u32x2*)(Vl + (n * 16 + fr) * 144 + ((2 * c) * 16 + fq * 4) * 2), hi = *(const LAS u32x2*)(Vl + (n * 16 + fr) * 144 + ((2 * c + 1) * 16 + fq * 4) * 2);
                const bf16x8 vf = __builtin_bit_cast(bf16x8, (u32x4){lo.x, lo.y, hi.x, hi.y});
                o[0][n] = __builtin_amdgcn_mfma_f32_16x16x32_bf16(vf, pf[0], o[0][n], 0, 0, 0);
                o[1][n] = __builtin_amdgcn_mfma_f32_16x16x32_bf16(vf, pf[1], o[1][n], 0, 0, 0); }
        }
        __syncthreads();
    }
#pragma unroll
    for (int g = 0; g < 2; ++g) {
        float t = lsum[g];
        t += __shfl_xor(t, 16); t += __shfl_xor(t, 32);
        if (has_sink) t += __builtin_amdgcn_exp2f(sink * 1.44269504f - mq[g]);
        const float inv = 1.f / t;
#pragma unroll
        for (int n = 0; n < 4; ++n) { u32x2 ov; ov.x = cvt_pk_bf16(o[g][n][0] * inv, o[g][n][1] * inv); ov.y = cvt_pk_bf16(o[g][n][2] * inv, o[g][n][3] * inv);
            *(u32x2*)(O + (size_t)(wave * 32 + g * 16 + fr) * ostride + n * 16 + fq * 4) = ov; }
    }
}

__device__ __forceinline__ void ret_out_item(const Params& p, int l, LAS unsigned char* lds, int item) {
    const int tid = get_tid(), lane = tid & 63, wave = tid >> 6, fr = lane & 15, fq = lane >> 4;
    bf16_t* P = (bf16_t*)(p.ws + WS_P);
    const int cr = item >> 2, h = item & 3; int b; const int ci = ret_chunk_index(cr, b);
    const int r0 = cr * 128;
    const float lg2 = log1pf(-exp2f(-5.f - (float)h)) * 1.44269504f;
    LAS unsigned char* Kb = lds;
    LAS unsigned char* Vt = lds + 18432;
    LAS unsigned char* SfT = lds + 35840;
    LAS unsigned char* SbT = lds + 45056;
    for (int pc = tid; pc < 1024; pc += 512) { const int j = pc >> 3, c8 = pc & 7;
        const u32x4 kk = *(const u32x4*)(P + (size_t)(r0 + j) * NP + PC_RETK + h * 64 + c8 * 8);
        const u32x4 vv = *(const u32x4*)(P + (size_t)(r0 + j) * NP + PC_RETV + h * 64 + c8 * 8);
        float kf[8]; unpack8(kk, kf);
        u32x4 ko; ko.x = pk2(kf[0] * 0.125f, kf[1] * 0.125f); ko.y = pk2(kf[2] * 0.125f, kf[3] * 0.125f); ko.z = pk2(kf[4] * 0.125f, kf[5] * 0.125f); ko.w = pk2(kf[6] * 0.125f, kf[7] * 0.125f);
        *(LAS u32x4*)(Kb + j * 144 + c8 * 16) = ko;
        const unsigned vw[4] = {vv.x, vv.y, vv.z, vv.w};
#pragma unroll
        for (int x = 0; x < 8; ++x) *(LAS bf16_t*)(Vt + (c8 * 8 + x) * 272 + j * 2) = (bf16_t)((x & 1) ? (vw[x >> 1] >> 16) : (vw[x >> 1] & 0xffff)); }
    { const float* RS = (const float*)(p.ws + WS_RET) + ((size_t)((b * 4 + h) * 34 + ci) * 2) * 4096;
      for (int pc = tid; pc < 1024; pc += 512) { const int d = pc >> 4, e4 = (pc & 15) * 4;
          const f32x4 a = *(const f32x4*)(RS + d * 64 + e4), bb = *(const f32x4*)(RS + 4096 + d * 64 + e4);
#pragma unroll
          for (int x = 0; x < 4; ++x) { *(LAS bf16_t*)(SfT + (e4 + x) * 144 + d * 2) = f2bf(a[x]); *(LAS bf16_t*)(SbT + (e4 + x) * 144 + d * 2) = f2bf(bb[x]); } } }
    const int i = wave * 16 + fr;
    u32x4 qraw[2];
#pragma unroll
    for (int kc = 0; kc < 2; ++kc) qraw[kc] = *(const u32x4*)(P + (size_t)(r0 + i) * NP + PC_RETQ + h * 64 + kc * 32 + fq * 8);
    __syncthreads();
    f32x4 s[8];
#pragma unroll
    for (int nb = 0; nb < 8; ++nb) { s[nb] = (f32x4){0.f, 0.f, 0.f, 0.f};
#pragma unroll
        for (int kc = 0; kc < 2; ++kc) { const bf16x8 kf = *(const LAS bf16x8*)(Kb + (nb * 16 + fr) * 144 + kc * 64 + fq * 16);
            s[nb] = __builtin_amdgcn_mfma_f32_16x16x32_bf16(kf, __builtin_bit_cast(bf16x8, qraw[kc]), s[nb], 0, 0, 0); } }
#pragma unroll
    for (int nb = 0; nb < 8; ++nb)
#pragma unroll
        for (int r = 0; r < 4; ++r) { const int j = nb * 16 + fq * 4 + r; const int df = i - j; const int adf = df < 0 ? -df : df;
            float dcy = __builtin_amdgcn_exp2f((float)adf * lg2); if (df == 0) dcy = 2.f; s[nb][r] *= dcy; }
    f32x4 o[4];
#pragma unroll
    for (int n = 0; n < 4; ++n) o[n] = (f32x4){0.f, 0.f, 0.f, 0.f};
#pragma unroll
    for (int c = 0; c < 4; ++c) {
        u32x4 pu; pu.x = cvt_pk_bf16(s[2 * c][0], s[2 * c][1]); pu.y = cvt_pk_bf16(s[2 * c][2], s[2 * c][3]); pu.z = cvt_pk_bf16(s[2 * c + 1][0], s[2 * c + 1][1]); pu.w = cvt_pk_bf16(s[2 * c + 1][2], s[2 * c + 1][3]);
        const bf16x8 pf = __builtin_bit_cast(bf16x8, pu);
#pragma unroll
        for (int n = 0; n < 4; ++n) {
            const u32x2 lo = *(const LAS u32x2*)(Vt + (n * 16 + fr) * 272 + ((2 * c) * 16 + fq * 4) * 2), hi = *(const LAS u32x2*)(Vt + (n * 16 + fr) * 272 + ((2 * c + 1) * 16 + fq * 4) * 2);
            const bf16x8 vf = __builtin_bit_cast(bf16x8, (u32x4){lo.x, lo.y, hi.x, hi.y});
            o[n] = __builtin_amdgcn_mfma_f32_16x16x32_bf16(vf, pf, o[n], 0, 0, 0); }
    }
    const float gf = __builtin_amdgcn_exp2f((float)(i + 1) * lg2), gb = __builtin_amdgcn_exp2f((float)(128 - i) * lg2);
#pragma unroll
    for (int kc = 0; kc < 2; ++kc) {
        float f[8]; unpack8(qraw[kc], f);
        u32x4 uf, ub;
        uf.x = cvt_pk_bf16(f[0] * gf, f[1] * gf); uf.y = cvt_pk_bf16(f[2] * gf, f[3] * gf); uf.z = cvt_pk_bf16(f[4] * gf, f[5] * gf); uf.w = cvt_pk_bf16(f[6] * gf, f[7] * gf);
        ub.x = cvt_pk_bf16(f[0] * gb, f[1] * gb); ub.y = cvt_pk_bf16(f[2] * gb, f[3] * gb); ub.z = cvt_pk_bf16(f[4] * gb, f[5] * gb); ub.w = cvt_pk_bf16(f[6] * gb, f[7] * gb);
        const bf16x8 qF = __builtin_bit_cast(bf16x8, uf), qB = __builtin_bit_cast(bf16x8, ub);
#pragma unroll
        for (int n = 0; n < 4; ++n) {
            const bf16x8 af = *(const LAS bf16x8*)(SfT + (n * 16 + fr) * 144 + kc * 64 + fq * 16), ab = *(const LAS bf16x8*)(SbT + (n * 16 + fr) * 144 + kc * 64 + fq * 16);
            o[n] = __builtin_amdgcn_mfma_f32_16x16x32_bf16(af, qF, o[n], 0, 0, 0);
            o[n] = __builtin_amdgcn_mfma_f32_16x16x32_bf16(ab, qB, o[n], 0, 0, 0); }
    }
    float sm = 0.f;
#pragma unroll
    for (int n = 0; n < 4; ++n) sm += (o[n][0] + o[n][1]) + (o[n][2] + o[n][3]);
    sm += __shfl_xor(sm, 16); sm += __shfl_xor(sm, 32);
    const float mu = sm * (1.f / 64.f);
    float vs = 0.f;
#pragma unroll
    for (int n = 0; n < 4; ++n)
#pragma unroll
        for (int r = 0; r < 4; ++r) { const float dl = o[n][r] - mu; vs += dl * dl; }
    vs += __shfl_xor(vs, 16); vs += __shfl_xor(vs, 32);
    const float rstd = 1.f / sqrtf(vs * (1.f / 64.f) + 1e-5f);
#pragma unroll
    for (int n = 0; n < 4; ++n) { const int e0 = n * 16 + fq * 4;
        const u32x2 gu = *(const u32x2*)(P + (size_t)(r0 + i) * NP + PC_RETG + h * 64 + e0);
        const f32x4 gn = *(const f32x4*)(p.in[13] + l * 256 + h * 64 + e0);
        const float g0 = bf2f((bf16_t)(gu.x & 0xffff)), g1 = bf2f((bf16_t)(gu.x >> 16)), g2 = bf2f((bf16_t)(gu.y & 0xffff)), g3 = bf2f((bf16_t)(gu.y >> 16));
        u32x2 yo;
        yo.x = cvt_pk_bf16((o[n][0] - mu) * rstd * gn.x * (g0 / (1.f + __expf(-g0))), (o[n][1] - mu) * rstd * gn.y * (g1 / (1.f + __expf(-g1))));
        yo.y = cvt_pk_bf16((o[n][2] - mu) * rstd * gn.z * (g2 / (1.f + __expf(-g2))), (o[n][3] - mu) * rstd * gn.w * (g3 / (1.f + __expf(-g3))));
        *(u32x2*)(P + (size_t)(r0 + i) * NP + PC_RETQ + h * 64 + e0) = yo; }
    __syncthreads();
}

constexpr int NSCANBLK = 128;
__device__ __forceinline__ void rwkv_scan_item(const Params& p, int l, LAS unsigned char* lds, int item) {
    const int tid = get_tid();
    const int sc = item >> 1, half = item & 1;
    const int b = sc >> 3, h = (sc >> 1) & 3, dir = sc & 1;
    const bf16_t* RK = (const bf16_t*)(p.ws + WS_RWK); const bf16_t* RV = (const bf16_t*)(p.ws + WS_RWV); const bf16_t* RR = (const bf16_t*)(p.ws + WS_RWRR);
    const bf16_t* RA = (const bf16_t*)(p.ws + (dir ? WS_RWA1 : WS_RWA0)); const bf16_t* RM = (const bf16_t*)(p.ws + (dir ? WS_RWM1 : WS_RWM0));
    bf16_t* P = (bf16_t*)(p.ws + WS_P);
    const int ocol = (dir ? PC_RWO1 : PC_RWO0) + h * 64 + half * 32;
    LAS float* SA = (LAS float*)lds;
    LAS float* OUT = SA + 64 * 384;
    const int st = tid >> 3, c0 = (tid & 7) * 8;
    float kkp[8], kap[8];
#pragma unroll
    for (int i = 0; i < 8; ++i) { kkp[i] = p.in[20][l * 256 + h * 64 + c0 + i]; kap[i] = p.in[21][l * 256 + h * 64 + c0 + i]; }
    const int row_l = tid >> 4, kq = tid & 15;
    f32x2 S[2];
#pragma unroll
    for (int i = 0; i < 2; ++i) S[i] = (f32x2){0.f, 0.f};
    auto row_of = [&](int s) -> int {
        if (s < CTXL) return TMAIN + b * CTXL + (dir ? CTXL - 1 - s : s);
        const int t = s - CTXL; return b * SEQL + (dir ? SEQL - 1 - t : t);
    };
    u32x4 gk, gv, gr, ga, gm;
    auto issue = [&](int ch) { const size_t o = (size_t)row_of(ch * 64 + st) * 256 + h * 64 + c0;
        gk = *(const u32x4*)(RK + o); gv = *(const u32x4*)(RV + o); gr = *(const u32x4*)(RR + o); ga = *(const u32x4*)(RA + o); gm = *(const u32x4*)(RM + o); };
    issue(0);
    for (int ch = 0; ch < 68; ++ch) {
        {
            float k[8], a[8], om[8], rr[8], vv8[8]; unpack8(gk, k); unpack8(ga, a); unpack8(gm, om); unpack8(gr, rr); unpack8(gv, vv8);
            float kk[8]; float n2 = 0.f;
#pragma unroll
            for (int i = 0; i < 8; ++i) { kk[i] = k[i] * kkp[i]; n2 += kk[i] * kk[i]; }
            n2 = red8(n2);
            const float rn = 1.f / sqrtf(fmaxf(n2, 1e-12f));
            f32x4 o0, o1;
#define ST8(DST, EXPR) { float t8[8]; _Pragma("unroll") for (int i = 0; i < 8; ++i) t8[i] = (EXPR); \
            *(LAS f32x4*)(SA + st * 384 + (DST) * 64 + c0) = (f32x4){t8[0], t8[1], t8[2], t8[3]}; *(LAS f32x4*)(SA + st * 384 + (DST) * 64 + c0 + 4) = (f32x4){t8[4], t8[5], t8[6], t8[7]}; }
            ST8(0, kk[i] * rn)
            ST8(1, 1.f - om[i])
            ST8(2, kk[i] * rn * a[i])
            ST8(3, k[i] * (1.f + (a[i] - 1.f) * kap[i]))
            ST8(4, rr[i])
            ST8(5, vv8[i])
#undef ST8
        }
        __syncthreads();
        if (ch + 1 < 68) issue(ch + 1);
        {
            struct Ops { f32x4 kh, w, b, t, r; float vv; };
            const LAS float* sbase = SA + kq * 4; const LAS float* vbase = SA + 5 * 64 + half * 32 + row_l;
            auto ldops = [&](int s) -> Ops { Ops q;
                q.kh = *(const LAS f32x4*)(sbase + s * 384); q.w = *(const LAS f32x4*)(sbase + s * 384 + 64); q.b = *(const LAS f32x4*)(sbase + s * 384 + 128);
                q.t = *(const LAS f32x4*)(sbase + s * 384 + 192); q.r = *(const LAS f32x4*)(sbase + s * 384 + 256);
                q.vv = vbase[s * 384]; return q; };
            Ops nx = ldops(0);
#pragma unroll 2
            for (int s = 0; s < 64; ++s) {
                const Ops c = nx;
                nx = ldops(s + 1 < 64 ? s + 1 : 63);
                f32x2 a2 = S[0] * (f32x2){c.kh.x, c.kh.y}; a2 = S[1] * (f32x2){c.kh.z, c.kh.w} + a2;
                const float sk = red16(a2.x + a2.y);
                const f32x2 nsk = (f32x2){-sk, -sk}, vv2 = (f32x2){c.vv, c.vv};
                S[0] = S[0] * (f32x2){c.w.x, c.w.y} + (nsk * (f32x2){c.b.x, c.b.y} + vv2 * (f32x2){c.t.x, c.t.y});
                S[1] = S[1] * (f32x2){c.w.z, c.w.w} + (nsk * (f32x2){c.b.z, c.b.w} + vv2 * (f32x2){c.t.z, c.t.w});
                f32x2 o2 = S[0] * (f32x2){c.r.x, c.r.y}; o2 = S[1] * (f32x2){c.r.z, c.r.w} + o2;
                const float ov = red16(o2.x + o2.y);
                OUT[s * 32 + row_l] = ov;
            }
        }
        __syncthreads();
        { const int c4 = (tid & 7) * 4; const f32x4 ov = *(const LAS f32x4*)(OUT + st * 32 + c4);
          u32x2 o2; o2.x = pk2(ov.x, ov.y); o2.y = pk2(ov.z, ov.w);
          *(u32x2*)(P + (size_t)row_of(ch * 64 + st) * NP + ocol + c4) = o2; }
    }
    __syncthreads();
}

__device__ __forceinline__ void mixer_mla(const Params& p, LAS unsigned char* lds, int it) {
    bf16_t* P = (bf16_t*)(p.ws + WS_P);
    const bf16_t* MQ = (const bf16_t*)(p.ws + WS_MQ);
    int b, h, row0, nm1;
    if (it < 512) { b = it >> 6; h = (it >> 4) & 3; row0 = b * SEQL + (it & 15) * 256; nm1 = 68; }
    else { const int u = it - 512; b = u >> 2; h = u & 3; row0 = TMAIN + b * CTXL; nm1 = 4; }
    attn_unit<96>(MQ + (size_t)row0 * 384 + h * 96, 384, (const bf16_t*)(p.ws + WS_KM) + (size_t)(b * 4 + h) * NKEYS * 96, (const bf16_t*)(p.ws + WS_VTM) + (size_t)(b * 4 + h) * 64 * NKEYS,
                  4, 4, nm1, false, 0, false, 0.f, 0.10206207f, P + (size_t)row0 * NP + PC_MLAQD + h * 64, NP, lds);
}
__device__ __forceinline__ void mixer_swa(const Params& p, int l, LAS unsigned char* lds, int u0) {
    bf16_t* P = (bf16_t*)(p.ws + WS_P);
    int b, h, row0, nm0, nm1, qp0; bool msk;
    if (u0 < 512) { b = u0 >> 6; h = (u0 >> 4) & 3; const int qb = u0 & 15; row0 = b * SEQL + qb * 256; nm0 = 4 + 4 * qb - 2; nm1 = 4 + 4 * qb + 6; if (nm0 < 4) nm0 = 4; if (nm1 > 68) nm1 = 68; qp0 = qb * 256; msk = true; }
    else { const int u = u0 - 512; b = u >> 2; h = u & 3; row0 = TMAIN + b * CTXL; nm0 = 4; nm1 = 4; qp0 = 0; msk = false; }
    const int hk = h >> 1;
    bf16_t* qp = P + (size_t)row0 * NP + PC_SWAQ + h * 64;
    attn_unit<64>(qp, NP, (const bf16_t*)(p.ws + WS_KS) + (size_t)(b * 2 + hk) * NKEYS * 64, (const bf16_t*)(p.ws + WS_VTS) + (size_t)(b * 2 + hk) * 64 * NKEYS,
                  4, nm0, nm1, msk, qp0, true, p.in[12][l * 4 + h], 0.125f, qp, NP, lds);
}
__device__ __forceinline__ void phase_mixers(const Params& p, int l, LAS unsigned char* lds, int bid, int nb) {
    const bool ectx = (l == 0);
    const int N_MLA = 512 + (ectx ? 32 : 0), N_SWA = 512 + (ectx ? 32 : 0), N_RET = 1024 + (ectx ? 64 : 0);
    if (bid < NSCANBLK) rwkv_scan_item(p, l, lds, bid);
    else {
        prep_rest_items(p, l, lds, bid - NSCANBLK, nb - NSCANBLK);
        asm volatile("s_waitcnt vmcnt(0)" ::: "memory");
        __syncthreads();
        if (get_tid() == 0) { __builtin_amdgcn_fence(__ATOMIC_RELEASE, "agent"); asm volatile("s_waitcnt vmcnt(0)" ::: "memory");
            __hip_atomic_fetch_add((unsigned*)(p.ws + WS_CTR) + 4 + l, 1u, __ATOMIC_RELAXED, __HIP_MEMORY_SCOPE_AGENT); }
        if (bid < NSCANBLK + 64) { wait_counter(p, 4 + l, (unsigned)(nb - NSCANBLK)); ret_scan_item(p, l, bid - NSCANBLK); }
    }
    wait_counter(p, 4 + l, (unsigned)(nb - NSCANBLK));
    bool ret_ready = false;
    unsigned* ctr = (unsigned*)(p.ws + WS_CTR) + l;
    LAS unsigned* slot = (LAS unsigned*)(lds + LDS_BYTES - 16);
    const int tid0 = get_tid();
    for (;;) {
        __syncthreads();
        if (tid0 == 0) *slot = atomicAdd(ctr, 1u);
        __syncthreads();
        const int it = (int)*slot;
        if (it >= N_MLA + N_SWA + N_RET) break;
        if (it < N_MLA) mixer_mla(p, lds, it);
        else if (it < N_MLA + N_SWA) mixer_swa(p, l, lds, it - N_MLA);
        else { if (!ret_ready) { wait_counter(p, 2 + l, 64u); ret_ready = true; } ret_out_item(p, l, lds, it - N_MLA - N_SWA); }
    }
}

__device__ __forceinline__ void phase_rwkv_finish(const Params& p, int l, LAS unsigned char* lds, int bid, int nb) {
    const int tid = get_tid();
    bf16_t* P = (bf16_t*)(p.ws + WS_P);
    const int ntiles = (l == 0 ? TT : TMAIN) / 32;
    const float* mu = p.in[14] + l * 1024 + 896;
    const float* gup = p.in[19] + (size_t)l * 128 * 256;
    const bf16_t* RV = (const bf16_t*)(p.ws + WS_RWV); const float* BON = (const float*)(p.ws + WS_BON);
    for (int tile = bid; tile < ntiles; tile += nb) {
        const int t0 = tile * 32; const SeqInfo s0 = seq_of_row(t0);
        LAS unsigned char* sgb = lds;
        LAS float* gout = (LAS float*)(lds + 32 * 272);
        { const int tok = tid >> 4, j8 = (tid & 15) * 8; const int row = t0 + tok, pos = s0.pos + tok;
          const u32x4 u0 = *(const u32x4*)(P + (size_t)row * NP + PC_RWGD + j8);
          const u32x4 um = pos > 0 ? *(const u32x4*)(P + (size_t)(row - 1) * NP + PC_RWGD + j8) : (u32x4){0u, 0u, 0u, 0u};
          const u32x4 up = pos < s0.len - 1 ? *(const u32x4*)(P + (size_t)(row + 1) * NP + PC_RWGD + j8) : (u32x4){0u, 0u, 0u, 0u};
          float z0[8], zm[8], zp[8], sv[8]; unpack8(u0, z0); unpack8(um, zm); unpack8(up, zp);
#pragma unroll
          for (int x = 0; x < 8; ++x) sv[x] = sigmoidf_(z0[x] + mu[j8 + x] * (0.5f * (zm[x] + zp[x]) - z0[x]));
          *(LAS u32x4*)(sgb + tok * 272 + j8 * 2) = (u32x4){cvt_pk_bf16(sv[0], sv[1]), cvt_pk_bf16(sv[2], sv[3]), cvt_pk_bf16(sv[4], sv[5]), cvt_pk_bf16(sv[6], sv[7])}; }
        __syncthreads();
        { const int lane = tid & 63, wave = tid >> 6, fr = lane & 15, fq = lane >> 4;
          const bf16_t* GT = (const bf16_t*)(p.ws + WS_GUPT + (size_t)l * 256 * 128 * 2);
#pragma unroll
          for (int q = 0; q < 2; ++q) { const int nt = wave + q * 8;
              f32x4 a0 = (f32x4){0.f, 0.f, 0.f, 0.f}, a1 = a0;
              const bf16_t* wrow = GT + (size_t)(nt * 16 + fr) * 128 + fq * 8;
              bf16x8 bfr[4];
#pragma unroll
              for (int kc = 0; kc < 4; ++kc) bfr[kc] = *(const bf16x8*)(wrow + kc * 32);
#pragma unroll
              for (int kc = 0; kc < 4; ++kc) { const bf16x8 x0 = *(const LAS bf16x8*)(sgb + fr * 272 + kc * 64 + fq * 16), x1 = *(const LAS bf16x8*)(sgb + (16 + fr) * 272 + kc * 64 + fq * 16);
                  a0 = __builtin_amdgcn_mfma_f32_16x16x32_bf16(x0, bfr[kc], a0, 0, 0, 0); a1 = __builtin_amdgcn_mfma_f32_16x16x32_bf16(x1, bfr[kc], a1, 0, 0, 0); }
#pragma unroll
              for (int r = 0; r < 4; ++r) { gout[(fq * 4 + r) * 256 + nt * 16 + fr] = a0[r]; gout[(16 + fq * 4 + r) * 256 + nt * 16 + fr] = a1[r]; } } }
        __syncthreads();
        const int hh = tid >> 8, c = tid & 255, h = c >> 6;
        float g[16];
#pragma unroll
        for (int i = 0; i < 16; ++i) g[i] = gout[(hh * 16 + i) * 256 + c];
        const float gn = p.in[23][l * 256 + c];
        float ov[16], rv[16], bn[16];
#pragma unroll
        for (int i = 0; i < 16; ++i) { const int row = t0 + hh * 16 + i;
            ov[i] = bf2f(P[(size_t)row * NP + PC_RWO0 + c]) + bf2f(P[(size_t)row * NP + PC_RWO1 + c]); rv[i] = bf2f(RV[(size_t)row * 256 + c]); bn[i] = BON[(size_t)row * 4 + h]; }
#pragma unroll
        for (int i = 0; i < 16; ++i) { const int row = t0 + hh * 16 + i;
            const float o = ov[i];
            const float mean = wave_sum(o) * (1.f / 64.f); const float dl = o - mean; const float var = wave_sum(dl * dl) * (1.f / 64.f);
            float y = dl * (1.f / sqrtf(var + 64e-5f)) * gn + bn[i] * rv[i];
            P[(size_t)row * NP + PC_RWO1 + c] = f2bf(y * g[i]); }
        __syncthreads();
    }
}

#ifndef N_LAUNCH_MODE
#define N_LAUNCH_MODE 1
#endif
template <int Q>
__device__ __forceinline__ void layer_phase(const Params& p, int l, LAS unsigned char* lds, int bid, int nb) {
    unsigned char* wb = p.ws + WS_WB + (size_t)l * WB_LAYER;
    const int Mrows = (l == 0) ? TT : TMAIN;
    pg8::StaticOrder S;
    if constexpr (Q == 0) { pg8::Gemm g{(const bf16_t*)(p.ws + WS_HB), (const bf16_t*)(wb + WB_IN), TT, NP, DM, DM}; S.init(TT, NP, nb, bid);
              pg8::EpiBf16<0> E{(bf16_t*)(p.ws + WS_P), NP}; pg8::gemm_phase(lds, g, S, E); }
    if constexpr (Q == 1) phase_prepA(p, l, lds, bid, nb);
    if constexpr (Q == 3) phase_mixers(p, l, lds, bid, nb);
    if constexpr (Q == 4) phase_rwkv_finish(p, l, lds, bid, nb);
    if constexpr (Q == 5) { pg8::Gemm g{(const bf16_t*)(p.ws + WS_P), (const bf16_t*)(wb + WB_OUT), Mrows, DM, DM, NP}; S.init(Mrows, DM, nb, bid);
              pg8::EpiBf16<0> E{(bf16_t*)(p.ws + WS_Z), DM}; pg8::gemm_phase(lds, g, S, E); }
    if constexpr (Q == 6) phase_rowops(p, 1, l, Mrows, bid, nb);
    if constexpr (Q == 7) { pg8::Gemm g{(const bf16_t*)(p.ws + WS_HB), (const bf16_t*)(wb + WB_W1), Mrows, FF, DM, DM}; S.init(Mrows, FF, nb, bid);
              pg8::EpiBf16<1> E{(bf16_t*)(p.ws + WS_HID), FF}; pg8::gemm_phase(lds, g, S, E); }
    if constexpr (Q == 8) { pg8::Gemm g{(const bf16_t*)(p.ws + WS_HID), (const bf16_t*)(wb + WB_W2), Mrows, DM, FF, FF}; S.init(Mrows, DM, nb, bid);
              pg8::EpiBf16<0> E{(bf16_t*)(p.ws + WS_Z), DM}; pg8::gemm_phase(lds, g, S, E); }
    if constexpr (Q == 9) phase_rowops(p, 2, l, Mrows, bid, nb);
}

#ifndef PROBE_MASK
#define PROBE_MASK 0
#endif
#define PB(BIT, CALL) do { if ((PROBE_MASK) & (BIT)) { const unsigned long long t0_ = __builtin_amdgcn_s_memrealtime(); CALL; const unsigned long long t1_ = __builtin_amdgcn_s_memrealtime(); \
        while (__builtin_amdgcn_s_memrealtime() - t1_ < (t1_ - t0_)) __builtin_amdgcn_s_sleep(8); } else { CALL; } } while (0)
#define XB_TMO      128
#define XB_XCNT(j)  (256  + 64 * (j))
#define XB_XSUB(j)  (1280 + 64 * (j))
#define XB_XGEN(j)  (2304 + 64 * (j))
#define XB_TOP      3328
#define XB_TOPGEN   3392
#define XCD_BAR_WORDS 3456
#define XB_SPIN_CAP (1u << 18)

__device__ __forceinline__ unsigned xb_ld(unsigned* p)              { return __hip_atomic_load(p, __ATOMIC_RELAXED, __HIP_MEMORY_SCOPE_AGENT); }
__device__ __forceinline__ unsigned xb_add(unsigned* p, unsigned v) { return __hip_atomic_fetch_add(p, v, __ATOMIC_RELAXED, __HIP_MEMORY_SCOPE_AGENT); }
__device__ __forceinline__ unsigned xb_xcc_id() { return (unsigned)__builtin_amdgcn_s_getreg((3 << 11) | 20) & 0xFu; }
#define XB_SPIN(cond, bar) do { unsigned _sp = 0; while (cond) { __builtin_amdgcn_s_sleep(1); \
    if ((++_sp & 255u) == 0u) { if (xb_ld(&(bar)[XB_TMO])) break; if (_sp > XB_SPIN_CAP) { atomicAdd(&(bar)[XB_TMO], 1u); break; } } } } while (0)

struct XcdBarrier {
    unsigned* bar; unsigned x;
    volatile LAS unsigned* st;
};

__device__ __forceinline__ XcdBarrier xcd_barrier_post(unsigned* bar, volatile LAS unsigned* st) {
    XcdBarrier b; b.bar = bar; b.x = xb_xcc_id(); b.st = st;
    if (threadIdx.x == 0) (void)xb_add(&bar[XB_XCNT(b.x)], 1u);
    return b;
}
__device__ __forceinline__ void xcd_barrier_complete(unsigned* bar, unsigned x, unsigned& nloc, unsigned& nx) {
    const unsigned G = gridDim.x * gridDim.y * gridDim.z;
    unsigned sum, cnt, mine, sp = 0u;
    for (;;) {
        sum = 0u; cnt = 0u; mine = 0u;
#pragma unroll
        for (unsigned j = 0; j < 16; ++j) { const unsigned c = xb_ld(&bar[XB_XCNT(j)]); sum += c; cnt += (c > 0u) ? 1u : 0u; mine = (j == x) ? c : mine; }
        if (sum == G) break;
        __builtin_amdgcn_s_sleep(1);
        if ((++sp & 255u) == 0u) { if (xb_ld(&bar[XB_TMO])) break; if (sp > XB_SPIN_CAP) { atomicAdd(&bar[XB_TMO], 1u); break; } }
    }
    nloc = mine > 0u ? mine : 1u; nx = cnt > 0u ? cnt : 1u;
}

__device__ __forceinline__ void xcd_barrier(const XcdBarrier& b) {
    asm volatile("s_waitcnt vmcnt(0)" ::: "memory");
    __syncthreads();
    if (threadIdx.x == 0) {
        unsigned* bar = b.bar;
        __builtin_amdgcn_s_waitcnt(0);
        unsigned nloc = b.st[0], nx = b.st[1];
        if (nloc == 0u) { xcd_barrier_complete(bar, b.x, nloc, nx); b.st[0] = nloc; b.st[1] = nx; }
        const unsigned old = xb_add(&bar[XB_XSUB(b.x)], 1u);
        const unsigned gen = old / nloc;
        if (old + 1u == (gen + 1u) * nloc) {
            __builtin_amdgcn_fence(__ATOMIC_RELEASE, "agent");
            asm volatile("s_waitcnt vmcnt(0)" ::: "memory");
            const unsigned og = xb_add(&bar[XB_TOP], 1u);
            const unsigned tg = og / nx;
            if (og + 1u == (tg + 1u) * nx) xb_add(&bar[XB_TOPGEN], 1u);
            else XB_SPIN(xb_ld(&bar[XB_TOPGEN]) == tg, bar);
            __builtin_amdgcn_fence(__ATOMIC_ACQUIRE, "agent");
            xb_add(&bar[XB_XGEN(b.x)], 1u);
            asm volatile("s_waitcnt vmcnt(0)" ::: "memory");
        } else {
            XB_SPIN(xb_ld(&bar[XB_XGEN(b.x)]) == gen, bar);
            __builtin_amdgcn_fence(__ATOMIC_ACQUIRE, "agent");
            asm volatile("s_waitcnt vmcnt(0)" ::: "memory");
        }
    }
    __syncthreads();
}


constexpr size_t WS_XBAR = 772 * 1024;
#define GSYNC() xcd_barrier(xb)

__global__ void __launch_bounds__(512, 2) mega_fwd(Params p) {
    extern __shared__ __attribute__((aligned(16))) unsigned char lds_raw[];
    LAS unsigned char* lds = (LAS unsigned char*)lds_raw;
    cg::grid_group grid = cg::this_grid();
    const int bid = blockIdx.x, nb = gridDim.x;
    { LAS unsigned* st_ = (LAS unsigned*)(lds + LDS_BYTES - 32); if (get_tid() == 0) { st_[0] = 0u; st_[1] = 0u; } __syncthreads(); }
    XcdBarrier xb = xcd_barrier_post((unsigned*)(p.ws + WS_XBAR), (volatile LAS unsigned*)(lds + LDS_BYTES - 32));
    grid.sync();
    PB(16, phase_prologue(p, lds, bid, nb)); GSYNC();
    PB(8, phase_rowops(p, 0, 0, TT, bid, nb)); GSYNC();
#define LAYER(L, LAST) \
    PB(1, layer_phase<0>(p, L, lds, bid, nb)); GSYNC(); PB(4, layer_phase<1>(p, L, lds, bid, nb)); GSYNC(); \
    PB(2, layer_phase<3>(p, L, lds, bid, nb)); GSYNC(); PB(4, layer_phase<4>(p, L, lds, bid, nb)); GSYNC(); PB(1, layer_phase<5>(p, L, lds, bid, nb)); GSYNC(); \
    PB(8, layer_phase<6>(p, L, lds, bid, nb)); GSYNC(); PB(1, layer_phase<7>(p, L, lds, bid, nb)); GSYNC(); PB(1, layer_phase<8>(p, L, lds, bid, nb)); GSYNC(); \
    PB(8, layer_phase<9>(p, L, lds, bid, nb)); if (!(LAST)) GSYNC();
    LAYER(0, false)
    LAYER(1, true)
}
#if N_LAUNCH_MODE != 1
template <int PH> __global__ void __launch_bounds__(512, 2) one_phase(Params p, int l) {
    extern __shared__ __attribute__((aligned(16))) unsigned char lds_raw[];
    LAS unsigned char* lds = (LAS unsigned char*)lds_raw;
    if constexpr (PH == 100) phase_prologue(p, lds, blockIdx.x, gridDim.x);
    else if constexpr (PH == 101) phase_rowops(p, 0, 0, TT, blockIdx.x, gridDim.x);
    else layer_phase<PH>(p, l, lds, blockIdx.x, gridDim.x);
}
#endif

extern "C" void kernel_launch(void* const* d_in, const int* in_sizes, int n_in, void* d_out, int out_size, void* d_ws, size_t ws_size, hipStream_t stream) {
    if (n_in != 30 || ws_size < WS_NEED || out_size != TMAIN * DM) { fprintf(stderr, "kernel_launch: unexpected shapes (n_in %d, ws %zu, out %d)\n", n_in, ws_size, out_size); return; }
    Params p{};
    for (int i = 0; i < 30; ++i) p.in[i] = (const float*)d_in[i];
    p.out = (float*)d_out; p.ws = (unsigned char*)d_ws;
    static int grid_blocks = 0;
    if (!grid_blocks) {
        int dev = 0, cus = 0, per_cu = 0;
        (void)hipGetDevice(&dev);
        (void)hipDeviceGetAttribute(&cus, hipDeviceAttributeMultiprocessorCount, dev);
        (void)hipFuncSetAttribute((const void*)mega_fwd, hipFuncAttributeMaxDynamicSharedMemorySize, LDS_BYTES);
        (void)hipOccupancyMaxActiveBlocksPerMultiprocessor(&per_cu, mega_fwd, 512, LDS_BYTES);
        if (per_cu < 1) { fprintf(stderr, "kernel_launch: occupancy query says %d blocks/CU\n", per_cu); per_cu = 1; }
        grid_blocks = cus * 1;
        if (grid_blocks < 128) { fprintf(stderr, "kernel_launch: only %d CUs\n", grid_blocks); }
    }
#if N_LAUNCH_MODE == 1
    (void)hipMemsetAsync((char*)d_ws + 768 * 1024, 0, 32 * 1024, stream);
    void* args[] = {&p};
    hipError_t e = hipLaunchCooperativeKernel((const void*)mega_fwd, dim3(grid_blocks), dim3(512), args, LDS_BYTES, stream);
    if (e != hipSuccess) fprintf(stderr, "cooperative launch failed: %s (grid %d)\n", hipGetErrorString(e), grid_blocks);
#else
#define LP(PH, L) do { (void)hipFuncSetAttribute((const void*)one_phase<PH>, hipFuncAttributeMaxDynamicSharedMemorySize, LDS_BYTES); one_phase<PH><<<grid_blocks, 512, LDS_BYTES, stream>>>(p, L); } while (0)
    LP(100, 0); LP(101, 0);
    for (int l = 0; l < 2; ++l) { LP(0, l); LP(1, l); LP(2, l); LP(3, l); LP(4, l); LP(5, l); LP(6, l); LP(7, l); LP(8, l); LP(9, l); }
#endif
}
```

```cpp
#include <hip/hip_runtime.h>
#include <hip/hip_cooperative_groups.h>
#include <cstdio>
#include <cstdint>
#include <cmath>
namespace cg = cooperative_groups;
__device__ __forceinline__ int get_tid() { int t = threadIdx.x; asm volatile("" : "+v"(t)); return t; }
namespace pg8 {
#define PG8_LAS __attribute__((address_space(3)))
typedef unsigned short bf16_t;
typedef short bf16x8 __attribute__((ext_vector_type(8)));
typedef float f32x4 __attribute__((ext_vector_type(4)));
typedef unsigned u32x4 __attribute__((ext_vector_type(4)));
typedef unsigned u32x2 __attribute__((ext_vector_type(2)));
constexpr int BM = 256, BK = 64, HALF = 128, HTB = HALF * BK * 2, STAGE_BYTES = 8 * HTB, NXCD = 8, WGM = 8;

__host__ __device__ __forceinline__ int lds_byte(int r, int c) { const int st = (r >> 4) * 2 + (c >> 5), rr = r & 15, cc = c & 31, ob = rr * 64 + cc * 2; return st * 1024 + (ob ^ (((ob >> 9) & 1) << 5)); }
__host__ __device__ __forceinline__ void stage_rc(int b, int& R, int& C) { const int st = b / 1024, sb = b % 1024, swz = sb ^ (((sb >> 9) & 1) << 5); R = (st >> 1) * 16 + swz / 64; C = (st & 1) * 32 + (swz % 64) / 2; }

__host__ __device__ __forceinline__ int perm32(int rho) { const int n = rho >> 4, i = rho & 15; return 8 * (i >> 2) + 4 * n + (i & 3); }
struct Unit { int pm, pn; };
struct Gemm { const bf16_t* A; const bf16_t* Bt; int M, N, K, lda; };

struct StaticOrder {
    int nM, nN, nwg, G, c;
    __host__ __device__ void init(int M, int N, int G_, int c_) { nM = M / BM; nN = N / BM; nwg = nM * nN; G = G_; c = c_; }
    __host__ __device__ bool next(int i, Unit& u) const {
        const long L = (long)i * G + c; if (L >= nwg) return false;
        int wgid = (int)L; { const int q = nwg / NXCD, r = nwg % NXCD, xcd = wgid % NXCD, off = wgid / NXCD; wgid = (xcd < r ? xcd * (q + 1) : r * (q + 1) + (xcd - r) * q) + off; }
        const int nig = WGM * nN, gid = wgid / nig, fm = gid * WGM, gsz = (nM - fm) < WGM ? (nM - fm) : WGM;
        u.pm = fm + ((wgid % nig) % gsz); u.pn = (wgid % nig) / gsz; return true;
    }
};

template <class Epi>
__device__ __forceinline__ void gemm_phase(PG8_LAS unsigned char* lds, const Gemm g, const StaticOrder& S, const Epi& E) {
    const int tid = get_tid(), wid = __builtin_amdgcn_readfirstlane(tid >> 6), lane = tid & 63, wr = wid >> 2, wc = wid & 3, fr = lane & 15, fq = lane >> 4;
    const int K = g.K, nt = K / BK, lda = g.lda;
    unsigned voffA[2], voffB[2];
#pragma unroll
    for (int i = 0; i < 2; ++i) { int R, C; stage_rc(tid * 16 + i * 8192, R, C);
        const int Rb = (R & ~31) + perm32(R & 31);
        voffA[i] = (unsigned)(R * lda + C) * 2u; voffB[i] = (unsigned)(Rb * K + C) * 2u; }
    const size_t kstep = (size_t)(BK * 2);
    const size_t hstepA = (size_t)HALF * lda * 2, hstepB = (size_t)HALF * K * 2;
    const size_t tstepA = 2 * hstepA, tstepB = 2 * hstepB;
    const unsigned ldsw = (unsigned)wid * 1024u;
    const int aoff = lds_byte(wr * 64 + fr, fq * 8), boff = lds_byte(wc * 32 + fr, fq * 8);
#define PG8_SA(b, h) (((b) * 2 + (h)) * HTB)
#define PG8_SB(b, h) ((4 + (b) * 2 + (h)) * HTB)
#define PG8_STAGE(bufoff, gbase, voff) do { _Pragma("unroll") for (int _i = 0; _i < 2; ++_i) \
        __builtin_amdgcn_global_load_lds((const unsigned*)((const char*)(gbase) + (voff)[_i]), (PG8_LAS unsigned*)(lds + (bufoff) + ldsw + _i * 8192), 16, 0, 0); } while (0)
#define PG8_LDA(dst, b, h) do { _Pragma("unroll") for (int m = 0; m < 4; ++m) _Pragma("unroll") for (int k = 0; k < 2; ++k) dst[m][k] = *(const PG8_LAS bf16x8*)(lds + PG8_SA(b, h) + aoff + m * 2048 + k * 1024); } while (0)
#define PG8_LDB(dst, b, h) do { _Pragma("unroll") for (int n = 0; n < 2; ++n) _Pragma("unroll") for (int k = 0; k < 2; ++k) dst[n][k] = *(const PG8_LAS bf16x8*)(lds + PG8_SB(b, h) + boff + n * 2048 + k * 1024); } while (0)
#define PG8_MMA(ai, bj, At, Bt) do { __builtin_amdgcn_s_setprio(1); _Pragma("unroll") for (int m = 0; m < 4; ++m) _Pragma("unroll") for (int n = 0; n < 2; ++n) _Pragma("unroll") for (int k = 0; k < 2; ++k) \
        acc[ai][bj][m][n] = __builtin_amdgcn_mfma_f32_16x16x32_bf16(Bt[n][k], At[m][k], acc[ai][bj][m][n], 0, 0, 0); __builtin_amdgcn_s_setprio(0); } while (0)
#define PG8_WAIT_V(n) asm volatile("s_waitcnt vmcnt(" #n ")" ::: "memory")
#define PG8_WAIT_L(n) asm volatile("s_waitcnt lgkmcnt(" #n ")" ::: "memory")
#define PG8_BAR __builtin_amdgcn_s_barrier()
#define PG8_SCHED __builtin_amdgcn_sched_barrier(0)
    Unit cur, nxt; int ui = 0;
    if (!S.next(0, cur)) return;
    f32x4 acc[2][2][4][2];
#pragma unroll
    for (int a = 0; a < 2; ++a)
#pragma unroll
        for (int b = 0; b < 2; ++b)
#pragma unroll
            for (int m = 0; m < 4; ++m)
#pragma unroll
                for (int n = 0; n < 2; ++n) acc[a][b][m][n] = (f32x4){0.f, 0.f, 0.f, 0.f};
    bf16x8 At[4][2], B0[2][2], B1[2][2];
    const char* cA = (const char*)g.A + (size_t)cur.pm * tstepA; const char* cB = (const char*)g.Bt + (size_t)cur.pn * tstepB;
    PG8_STAGE(PG8_SB(0, 0), cB, voffB); PG8_STAGE(PG8_SA(0, 0), cA, voffA); PG8_STAGE(PG8_SB(0, 1), cB + hstepB, voffB); PG8_STAGE(PG8_SA(0, 1), cA + hstepA, voffA);
    if (wr == 1) PG8_BAR;
    PG8_WAIT_V(4); PG8_BAR;
    PG8_STAGE(PG8_SB(1, 0), cB + kstep, voffB); PG8_STAGE(PG8_SA(1, 0), cA + kstep, voffA); PG8_STAGE(PG8_SB(1, 1), cB + hstepB + kstep, voffB);
    PG8_WAIT_V(6); PG8_BAR;
    for (;;) {
        const bool has_next = S.next(ui + 1, nxt);
        const char* nA = has_next ? (const char*)g.A + (size_t)nxt.pm * tstepA : cA; const char* nB = has_next ? (const char*)g.Bt + (size_t)nxt.pn * tstepB : cB;
        for (int t = 0; t < nt; t += 2) {
            const bool last = (t == nt - 2);
            const char* a1 = cA + (size_t)(t + 1) * kstep;
            const char* a2 = last ? nA : cA + (size_t)(t + 2) * kstep; const char* b2 = last ? nB : cB + (size_t)(t + 2) * kstep;
            const char* a3 = a2 + kstep; const char* b3 = b2 + kstep;
            PG8_LDB(B0, 0, 0); PG8_SCHED; PG8_LDA(At, 0, 0); PG8_STAGE(PG8_SA(1, 1), a1 + hstepA, voffA);
            PG8_WAIT_L(8); PG8_BAR; PG8_WAIT_L(0); PG8_MMA(0, 0, At, B0); PG8_BAR; PG8_SCHED;
            PG8_LDB(B1, 0, 1); PG8_STAGE(PG8_SB(0, 0), b2, voffB);
            PG8_BAR; PG8_WAIT_L(0); PG8_MMA(0, 1, At, B1); PG8_BAR;
            PG8_LDA(At, 0, 1); PG8_STAGE(PG8_SA(0, 0), a2, voffA);
            PG8_BAR; PG8_WAIT_L(0); PG8_MMA(1, 0, At, B0); PG8_BAR; PG8_SCHED;
            PG8_STAGE(PG8_SB(0, 1), b2 + hstepB, voffB);
            PG8_WAIT_V(6); PG8_BAR; PG8_MMA(1, 1, At, B1); PG8_BAR;
            PG8_LDB(B0, 1, 0); PG8_SCHED; PG8_LDA(At, 1, 0); PG8_STAGE(PG8_SA(0, 1), a2 + hstepA, voffA);
            PG8_WAIT_L(8); PG8_BAR; PG8_WAIT_L(0); PG8_MMA(0, 0, At, B0); PG8_BAR; PG8_SCHED;
            PG8_LDB(B1, 1, 1); PG8_STAGE(PG8_SB(1, 0), b3, voffB);
            PG8_BAR; PG8_WAIT_L(0); PG8_MMA(0, 1, At, B1); PG8_BAR;
            PG8_LDA(At, 1, 1); PG8_STAGE(PG8_SA(1, 0), a3, voffA);
            PG8_BAR; PG8_WAIT_L(0); PG8_MMA(1, 0, At, B0); PG8_BAR; PG8_SCHED;
            PG8_STAGE(PG8_SB(1, 1), b3 + hstepB, voffB);
            PG8_WAIT_V(6); PG8_BAR; PG8_MMA(1, 1, At, B1); PG8_BAR;
        }
        E(acc, cur, wr, wc, fr, fq);
        if (!has_next) break;
#pragma unroll
        for (int a = 0; a < 2; ++a)
#pragma unroll
            for (int b = 0; b < 2; ++b)
#pragma unroll
                for (int m = 0; m < 4; ++m)
#pragma unroll
                    for (int n = 0; n < 2; ++n) acc[a][b][m][n] = (f32x4){0.f, 0.f, 0.f, 0.f};
        cur = nxt; cA = nA; cB = nB; ++ui;
    }
    PG8_WAIT_V(0);
    if (wr == 0) PG8_BAR;
    PG8_BAR;
#undef PG8_SA
#undef PG8_SB
#undef PG8_STAGE
#undef PG8_LDA
#undef PG8_LDB
#undef PG8_MMA
#undef PG8_WAIT_V
#undef PG8_WAIT_L
#undef PG8_BAR
#undef PG8_SCHED
}

typedef float f32x2_g __attribute__((ext_vector_type(2)));
typedef __bf16 bf16x2_g __attribute__((ext_vector_type(2)));
__device__ __forceinline__ unsigned pk2_g(float lo, float hi) { const f32x2_g v = {lo, hi}; return __builtin_bit_cast(unsigned, __builtin_convertvector(v, bf16x2_g)); }
template <int ACT> struct EpiBf16 {
    bf16_t* O; int ldc;
    __device__ __forceinline__ void operator()(const f32x4 (&acc)[2][2][4][2], const Unit& u, int wr, int wc, int fr, int fq) const {
        const int row0 = u.pm * BM + wr * 64 + fr, col0 = u.pn * BM + wc * 32 + 8 * fq;
#pragma unroll
        for (int ai = 0; ai < 2; ++ai)
#pragma unroll
            for (int m = 0; m < 4; ++m) { bf16_t* rowp = O + (size_t)(row0 + ai * HALF + m * 16) * ldc + col0;
#pragma unroll
                for (int bj = 0; bj < 2; ++bj) { f32x4 v0 = acc[ai][bj][m][0], v1 = acc[ai][bj][m][1];
                    if (ACT == 1) { v0.x = v0.x > 0.f ? v0.x * v0.x : 0.f; v0.y = v0.y > 0.f ? v0.y * v0.y : 0.f; v0.z = v0.z > 0.f ? v0.z * v0.z : 0.f; v0.w = v0.w > 0.f ? v0.w * v0.w : 0.f;
                                    v1.x = v1.x > 0.f ? v1.x * v1.x : 0.f; v1.y = v1.y > 0.f ? v1.y * v1.y : 0.f; v1.z = v1.z > 0.f ? v1.z * v1.z : 0.f; v1.w = v1.w > 0.f ? v1.w * v1.w : 0.f; }
                    u32x4 o; o.x = pk2_g(v0.x, v0.y); o.y = pk2_g(v0.z, v0.w); o.z = pk2_g(v1.x, v1.y); o.w = pk2_g(v1.z, v1.w);
                    *(u32x4*)(rowp + bj * HALF) = o; } }
    }
};
}
typedef unsigned short bf16_t;
typedef short bf16x8 __attribute__((ext_vector_type(8)));
typedef float f32x4 __attribute__((ext_vector_type(4)));
typedef unsigned u32x4 __attribute__((ext_vector_type(4)));
typedef unsigned u32x2 __attribute__((ext_vector_type(2)));
#define LAS __attribute__((address_space(3)))

constexpr int NBATCH = 8, SEQL = 4096, DM = 1024, CTXL = 256, TMAIN = 32768, TCTX = 2048, TT = 34816, NP = 3072, FF = 4096;
constexpr int PC_SWAQ = 0, PC_RETQ = 256, PC_RWR = 512, PC_MLAQD = 768, PC_SWAK = 1024, PC_SWAV = 1152, PC_RETK = 1280, PC_RETV = 1536, PC_RETG = 1792,
              PC_RWK = 2048, PC_RWV = 2304, PC_RWWD = 2560, PC_RWAD = 2624, PC_RWGD = 2688, PC_MLAKVD = 2816, PC_MLAKPE = 2944;
constexpr int PC_RWO0 = PC_RWV, PC_RWO1 = PC_RWR;
constexpr int NKEYS = CTXL + SEQL;

constexpr size_t MiB = 1u << 20;
constexpr size_t WS_MOD = 0;
constexpr size_t WS_TAB = 512 * 1024;
constexpr size_t WS_CTR = 768 * 1024;
constexpr size_t WS_BON = 1 * MiB;
constexpr size_t WS_WB = 2 * MiB;
constexpr size_t WB_LAYER = 24 * MiB, WB_IN = 0, WB_OUT = 6 * MiB, WB_W1 = 8 * MiB, WB_W2 = 16 * MiB;
constexpr size_t WS_XC = 50 * MiB;
constexpr size_t WS_P = 58 * MiB;
constexpr size_t WS_HID = 58 * MiB;
constexpr size_t WS_A = 262 * MiB;
constexpr size_t ARR17 = 17 * MiB;
constexpr size_t WS_RWK = WS_A, WS_RWV = WS_A + ARR17, WS_RWRR = WS_A + 2 * ARR17, WS_RWA0 = WS_A + 3 * ARR17, WS_RWA1 = WS_A + 4 * ARR17,
                 WS_RWM0 = WS_A + 5 * ARR17, WS_RWM1 = WS_A + 6 * ARR17;
constexpr size_t WS_RET = WS_A + 119 * MiB;
constexpr size_t WS_MQ = WS_RET + 34 * MiB;
constexpr size_t WS_KM = WS_MQ + 26738688;
constexpr size_t WS_VTM = WS_KM + 26738688;
constexpr size_t WS_KS = WS_VTM + ARR17;
constexpr size_t WS_VTS = WS_KS + 8912896;
constexpr size_t WS_A_END = WS_VTS + 8912896;
constexpr size_t WS_Z = 330 * MiB;
constexpr size_t WS_HB = 398 * MiB;
constexpr size_t WS_MLAW = 500 * MiB;
constexpr size_t MLAW_LAYER = 384 * 256 * 2 + 512 * 128 * 2, MLAW_KV = 384 * 256 * 2;
constexpr size_t WS_GUPT = 501 * MiB;
constexpr size_t WS_LORAT = 502 * MiB;
constexpr size_t WS_NEED = 503 * MiB;
static_assert(WS_A_END <= WS_NEED && WS_HB + 68 * MiB <= WS_NEED && WS_HID + 272 * MiB <= WS_Z, "ws map");

constexpr int LDS_BYTES = 150 * 1024;

struct Params { const float* in[30]; float* out; unsigned char* ws; };

__device__ __forceinline__ float bf2f(bf16_t v) { return __builtin_bit_cast(float, (unsigned)v << 16); }
typedef float f32x2_c __attribute__((ext_vector_type(2)));
typedef __bf16 bf16x2_c __attribute__((ext_vector_type(2)));
__device__ __forceinline__ unsigned pk2(float lo, float hi) { const f32x2_c v = {lo, hi}; return __builtin_bit_cast(unsigned, __builtin_convertvector(v, bf16x2_c)); }
__device__ __forceinline__ bf16_t f2bf(float f) { return (bf16_t)(pk2(f, 0.f) & 0xffffu); }
typedef float f32x2 __attribute__((ext_vector_type(2)));
typedef __bf16 bf16x2_t __attribute__((ext_vector_type(2)));
__device__ __forceinline__ unsigned cvt_pk_bf16(float lo, float hi) { const f32x2 v = {lo, hi}; return __builtin_bit_cast(unsigned, __builtin_convertvector(v, bf16x2_t)); }
template <int CTRL> __device__ __forceinline__ float dppf(float v) { return __builtin_bit_cast(float, __builtin_amdgcn_update_dpp(0, __builtin_bit_cast(int, v), CTRL, 0xF, 0xF, true)); }
__device__ __forceinline__ float red4(float v) { v += dppf<0xB1>(v); v += dppf<0x4E>(v); return v; }
__device__ __forceinline__ float red8(float v) { v = red4(v); v += dppf<0x141>(v); return v; }
__device__ __forceinline__ float red16(float v) { v = red8(v); v += dppf<0x140>(v); return v; }
__device__ __forceinline__ float max16(float v) { v = fmaxf(v, dppf<0xB1>(v)); v = fmaxf(v, dppf<0x4E>(v)); v = fmaxf(v, dppf<0x141>(v)); v = fmaxf(v, dppf<0x140>(v)); return v; }
__device__ __forceinline__ float wave_sum(float v) {
    v = red16(v);
    const int u = __builtin_bit_cast(int, v);
    return __builtin_bit_cast(float, __builtin_amdgcn_readlane(u, 0)) + __builtin_bit_cast(float, __builtin_amdgcn_readlane(u, 16)) +
           __builtin_bit_cast(float, __builtin_amdgcn_readlane(u, 32)) + __builtin_bit_cast(float, __builtin_amdgcn_readlane(u, 48));
}
__device__ __forceinline__ void unpack8(const u32x4 u, float* f) {
    f[0] = bf2f((bf16_t)(u.x & 0xffff)); f[1] = bf2f((bf16_t)(u.x >> 16)); f[2] = bf2f((bf16_t)(u.y & 0xffff)); f[3] = bf2f((bf16_t)(u.y >> 16));
    f[4] = bf2f((bf16_t)(u.z & 0xffff)); f[5] = bf2f((bf16_t)(u.z >> 16)); f[6] = bf2f((bf16_t)(u.w & 0xffff)); f[7] = bf2f((bf16_t)(u.w >> 16));
}
__device__ __forceinline__ float sigmoidf_(float x) { return __builtin_amdgcn_rcpf(1.f + __expf(-x)); }

struct SeqInfo { int b, pos, len, start, isctx; };
__device__ __forceinline__ SeqInfo seq_of_row(int row) {
    SeqInfo s;
    if (row < TMAIN) { s.b = row >> 12; s.pos = row & 4095; s.len = SEQL; s.start = s.b << 12; s.isctx = 0; }
    else { const int r = row - TMAIN; s.b = r >> 8; s.pos = r & 255; s.len = CTXL; s.start = TMAIN + (s.b << 8); s.isctx = 1; }
    return s;
}

__device__ __forceinline__ void transpose_item(const float* W, int N, int nsrc0, bf16_t* WT, int K, int ndst0, int k0, LAS float* scr, int lane) {
    if (nsrc0 >= 0) {
#pragma unroll 32
        for (int i = 0; i < 32; ++i) { const int kk = 2 * i + (lane >> 5); scr[kk * 33 + (lane & 31)] = W[(size_t)(k0 + kk) * N + nsrc0 + (lane & 31)]; }
    } else {
#pragma unroll 8
        for (int i = 0; i < 32; ++i) { const int kk = 2 * i + (lane >> 5); scr[kk * 33 + (lane & 31)] = 0.f; }
    }
    __builtin_amdgcn_wave_barrier(); asm volatile("s_waitcnt lgkmcnt(0)" ::: "memory");
    const int c = lane & 7;
#pragma unroll
    for (int j = 0; j < 4; ++j) { const int n = (lane >> 3) + 8 * j; const LAS float* s = scr + (8 * c) * 33 + n;
        u32x4 o; o.x = pk2(s[0 * 33], s[1 * 33]); o.y = pk2(s[2 * 33], s[3 * 33]); o.z = pk2(s[4 * 33], s[5 * 33]); o.w = pk2(s[6 * 33], s[7 * 33]);
        *(u32x4*)(WT + (size_t)(ndst0 + n) * K + k0 + 8 * c) = o; }
    __builtin_amdgcn_wave_barrier(); asm volatile("s_waitcnt lgkmcnt(0)" ::: "memory");
}
__device__ __forceinline__ int win_src_col(int n) {
    if (n < 256) return n;
    if (n < 512) return 512 + (n - 256);
    if (n < 768) return 1536 + (n - 512);
    if (n < 1024) return 2560 + (n - 768);
    if (n < 1280) return 256 + (n - 1024);
    if (n < 2048) return 768 + (n - 1280);
    if (n < 2816) return 1792 + (n - 2048);
    if (n < 2976) return n;
    return -1;
}
__device__ __forceinline__ void phase_prologue(const Params& p, LAS unsigned char* lds, int bid, int nb) {
    const int tid = get_tid(), lane = tid & 63, wave = tid >> 6;
    LAS float* scr = (LAS float*)(lds + wave * 16384);
    const int gw = bid * 8 + wave, NGW = nb * 8;
    constexpr int I_IN = 16 * 96, I_OUT = 16 * 32, I_1 = 16 * 128, I_2 = 64 * 32, I_Q = 4 * 12, I_KV = 2 * 16, I_G = 2 * 8, I_LO = 4 * 8, I_L = I_IN + I_OUT + I_1 + I_2 + I_Q + I_KV + I_G + I_LO;
    for (int it = gw; it < 2 * I_L; it += NGW) {
        const int l = it / I_L; int r = it % I_L;
        unsigned char* wb = p.ws + WS_WB + (size_t)l * WB_LAYER;
        if (r < I_IN) { const int kb = r / 96, nbk = r % 96; transpose_item(p.in[10] + (size_t)l * DM * 2976, 2976, win_src_col(nbk * 32), (bf16_t*)(wb + WB_IN), DM, nbk * 32, kb * 64, scr, lane); continue; } r -= I_IN;
        if (r < I_OUT) { const int kb = r / 32, nbk = r % 32; transpose_item(p.in[11] + (size_t)l * DM * DM, DM, nbk * 32, (bf16_t*)(wb + WB_OUT), DM, nbk * 32, kb * 64, scr, lane); continue; } r -= I_OUT;
        if (r < I_1) { const int kb = r / 128, nbk = r % 128; transpose_item(p.in[28] + (size_t)l * DM * FF, FF, nbk * 32, (bf16_t*)(wb + WB_W1), DM, nbk * 32, kb * 64, scr, lane); continue; } r -= I_1;
        if (r < I_2) { const int kb = r / 32, nbk = r % 32; transpose_item(p.in[29] + (size_t)l * FF * DM, DM, nbk * 32, (bf16_t*)(wb + WB_W2), FF, nbk * 32, kb * 64, scr, lane); continue; } r -= I_2;
        unsigned char* mw = p.ws + WS_MLAW + (size_t)l * MLAW_LAYER;
        if (r < I_Q) { const int kb = r / 12, nbk = r % 12; transpose_item(p.in[25] + (size_t)l * 256 * 384, 384, nbk * 32, (bf16_t*)mw, 256, nbk * 32, kb * 64, scr, lane); continue; } r -= I_Q;
        if (r < I_KV) { const int kb = r / 16, nbk = r % 16; transpose_item(p.in[27] + (size_t)l * 128 * 512, 512, nbk * 32, (bf16_t*)(mw + MLAW_KV), 128, nbk * 32, kb * 64, scr, lane); continue; } r -= I_KV;
        if (r < I_G) { const int kb = r / 8, nbk = r % 8; transpose_item(p.in[19] + (size_t)l * 128 * 256, 256, nbk * 32, (bf16_t*)(p.ws + WS_GUPT + (size_t)l * 256 * 128 * 2), 128, nbk * 32, kb * 64, scr, lane); continue; } r -= I_G;
        { const int m = r / 8, nbk = r % 8; const float* src = (m < 2 ? p.in[16] : p.in[18]) + ((size_t)l * 2 + (m & 1)) * 64 * 256;
          transpose_item(src, 256, nbk * 32, (bf16_t*)(p.ws + WS_LORAT + ((size_t)l * 4 + m) * 256 * 64 * 2), 64, nbk * 32, 0, scr, lane); }
    }
    __syncthreads();
    for (int it = bid; it < 192; it += nb) {
        const int l = it / 96, cb = it % 96;
        LAS float* sc = (LAS float*)lds;
        LAS float* red = sc + 9 * 1024;
        for (int e = tid; e < 9 * 1024; e += 512) { const int r = e >> 10, k = e & 1023; const float v = (r < 8) ? p.in[1][r * 1024 + k] : p.in[3][k]; sc[e] = v / (1.f + __expf(-v)); }
        __syncthreads();
        const int ks = tid >> 6, cl = tid & 63, n = cb * 64 + cl;
        float acc[9];
#pragma unroll
        for (int r = 0; r < 9; ++r) acc[r] = 0.f;
        const float* aw = p.in[4] + (size_t)l * DM * 6144;
#pragma unroll 16
        for (int k = ks * 128; k < ks * 128 + 128; ++k) { const float w = aw[(size_t)k * 6144 + n];
#pragma unroll
            for (int r = 0; r < 9; ++r) acc[r] += sc[r * 1024 + k] * w; }
#pragma unroll
        for (int r = 0; r < 9; ++r) red[(ks * 9 + r) * 64 + cl] = acc[r];
        __syncthreads();
        for (int e = tid; e < 9 * 64; e += 512) { const int r = e >> 6, c2 = e & 63; float s = 0.f;
            for (int q = 0; q < 8; ++q) s += red[(q * 9 + r) * 64 + c2];
            ((float*)(p.ws + WS_MOD))[((size_t)l * 9 + r) * 6144 + cb * 64 + c2] = s + p.in[5][(size_t)l * 6144 + cb * 64 + c2]; }
        __syncthreads();
    }
    if (bid == 0 && tid < 4) ((unsigned*)(p.ws + WS_CTR))[tid] = 0u;
    if (bid == nb - 1) {
        float* tab = (float*)(p.ws + WS_TAB);
        for (int e = tid; e < 64 * 16; e += 512) { const int pos = e >> 4, f = e & 15; const float inv = powf(10000.f, -(float)(2 * f) / 32.f); const float a = (float)pos * inv; tab[e] = cosf(a); tab[1024 + e] = sinf(a); }
        for (int e = tid; e < 64 * 8; e += 512) { const int pos = e >> 3, f = e & 7; const float inv = powf(10000.f, -(float)(2 * f) / 16.f); const float a = (float)pos * inv; tab[2048 + e] = cosf(a); tab[2560 + e] = sinf(a); }
    }
}

struct RowJob { const float* xsrc; const bf16_t* z; const float* gpost; const float* gate; float* xdst; const float* gpre; const float* shift; const float* scale; bf16_t* hdst; };
__device__ __forceinline__ RowJob make_rowjob(const Params& p, int mode, int l, int row) {
    const float* mod = (const float*)(p.ws + WS_MOD);
    bf16_t* HB = (bf16_t*)(p.ws + WS_HB); const bf16_t* Z = (const bf16_t*)(p.ws + WS_Z);
    float* XC = (float*)(p.ws + WS_XC);
    const SeqInfo s = seq_of_row(row);
    const int mr = s.isctx ? 8 : s.b;
    const float* m_l = mod + ((size_t)l * 9 + mr) * 6144;
    float* xs = s.isctx ? XC + (size_t)(row - TMAIN) * DM : p.out + (size_t)row * DM;
    const float* xin = s.isctx ? p.in[2] + (size_t)(row - TMAIN) * DM : p.in[0] + (size_t)row * DM;
    RowJob j;
    if (mode == 0) { j = RowJob{xin, nullptr, nullptr, nullptr, nullptr, p.in[6] + l * DM, m_l + 0, m_l + 1024, HB + (size_t)row * DM}; }
    else if (mode == 1) { j = RowJob{l == 0 ? xin : xs, Z + (size_t)row * DM, p.in[7] + l * DM, m_l + 2048, xs, p.in[8] + l * DM, m_l + 3072, m_l + 4096, HB + (size_t)row * DM}; }
    else { const bool has_next = (l + 1 < 2); const float* m_n = mod + ((size_t)(has_next ? l + 1 : l) * 9 + mr) * 6144;
        j = RowJob{xs, Z + (size_t)row * DM, p.in[9] + l * DM, m_l + 5120, xs, p.in[6] + (has_next ? l + 1 : l) * DM, m_n + 0, m_n + 1024, has_next ? HB + (size_t)row * DM : nullptr}; }
    return j;
}
template <int RB>
__device__ __forceinline__ void rowop_batch(const RowJob (&jb)[RB], const bool (&valid)[RB], int lane) {
    f32x4 v[RB][4]; u32x2 zu[RB][4];
#pragma unroll
    for (int r = 0; r < RB; ++r) if (valid[r]) {
#pragma unroll
        for (int j = 0; j < 4; ++j) { v[r][j] = *(const f32x4*)(jb[r].xsrc + (j * 64 + lane) * 4); if (jb[r].z) zu[r][j] = *(const u32x2*)(jb[r].z + (j * 64 + lane) * 4); }
    }
#pragma unroll
    for (int r = 0; r < RB; ++r) if (valid[r]) {
        const RowJob& J = jb[r];
        if (J.z) {
            f32x4 zz[4], gp[4], gt[4]; float ss = 0.f;
#pragma unroll
            for (int j = 0; j < 4; ++j) { const int c = (j * 64 + lane) * 4; gp[j] = *(const f32x4*)(J.gpost + c); gt[j] = *(const f32x4*)(J.gate + c); }
#pragma unroll
            for (int j = 0; j < 4; ++j) { const u32x2 u = zu[r][j];
                zz[j].x = bf2f((bf16_t)(u.x & 0xffff)); zz[j].y = bf2f((bf16_t)(u.x >> 16)); zz[j].z = bf2f((bf16_t)(u.y & 0xffff)); zz[j].w = bf2f((bf16_t)(u.y >> 16));
                ss += zz[j].x * zz[j].x + zz[j].y * zz[j].y + zz[j].z * zz[j].z + zz[j].w * zz[j].w; }
            const float rinv = 1.f / sqrtf(wave_sum(ss) * (1.f / 1024.f) + 1e-6f);
#pragma unroll
            for (int j = 0; j < 4; ++j) { const int c = (j * 64 + lane) * 4;
                v[r][j].x += gt[j].x * (zz[j].x * rinv * gp[j].x); v[r][j].y += gt[j].y * (zz[j].y * rinv * gp[j].y); v[r][j].z += gt[j].z * (zz[j].z * rinv * gp[j].z); v[r][j].w += gt[j].w * (zz[j].w * rinv * gp[j].w);
                *(f32x4*)(J.xdst + c) = v[r][j]; }
        }
        if (J.hdst) {
            f32x4 g[4], sh[4], sc[4]; float ss = 0.f;
#pragma unroll
            for (int j = 0; j < 4; ++j) { const int c = (j * 64 + lane) * 4; g[j] = *(const f32x4*)(J.gpre + c); sh[j] = *(const f32x4*)(J.shift + c); sc[j] = *(const f32x4*)(J.scale + c); }
#pragma unroll
            for (int j = 0; j < 4; ++j) ss += v[r][j].x * v[r][j].x + v[r][j].y * v[r][j].y + v[r][j].z * v[r][j].z + v[r][j].w * v[r][j].w;
            const float rinv = 1.f / sqrtf(wave_sum(ss) * (1.f / 1024.f) + 1e-6f);
#pragma unroll
            for (int j = 0; j < 4; ++j) { const int c = (j * 64 + lane) * 4;
                u32x2 o; o.x = pk2(v[r][j].x * rinv * g[j].x * (1.f + sc[j].x) + sh[j].x, v[r][j].y * rinv * g[j].y * (1.f + sc[j].y) + sh[j].y);
                o.y = pk2(v[r][j].z * rinv * g[j].z * (1.f + sc[j].z) + sh[j].z, v[r][j].w * rinv * g[j].w * (1.f + sc[j].w) + sh[j].w);
                *(u32x2*)(J.hdst + c) = o; }
        }
    }
}
__device__ __forceinline__ void phase_rowops(const Params& p, int mode, int l, int nrows, int bid, int nb) {
    const int tid = get_tid(), lane = tid & 63, wave = tid >> 6;
    constexpr int RB = 4;
    const int nwaves = nb * 8, gw = bid * 8 + wave;
    for (int base = gw; base < nrows; base += nwaves * RB) {
        RowJob jb[RB]; bool valid[RB];
#pragma unroll
        for (int r = 0; r < RB; ++r) { const int row = base + r * nwaves; valid[r] = row < nrows; jb[r] = make_rowjob(p, mode, l, valid[r] ? row : 0); }
        rowop_batch<RB>(jb, valid, lane);
    }
}

__device__ __forceinline__ void rwkv_prep_item(const Params& p, int l, LAS unsigned char* lds, int tile) {
    const int tid = get_tid(), lane = tid & 63, wave = tid >> 6, fr = lane & 15, fq = lane >> 4;
    const bf16_t* P = (const bf16_t*)(p.ws + WS_P);
    const int t0 = tile * 32; const SeqInfo s0 = seq_of_row(t0);
    const float* mu = p.in[14] + l * 1024;
    LAS bf16_t* r_s = (LAS bf16_t*)lds;
    LAS bf16_t* k_s = r_s + 32 * 256;
    LAS bf16_t* v_s = k_s + 32 * 256;
    LAS unsigned char* twd = lds + 3 * 16384;
    LAS unsigned char* ads = twd + 32 * 144;
    LAS float* O1 = (LAS float*)(ads + 32 * 144);
#pragma unroll
    for (int it = 0; it < 7; ++it) {
        const int pc = tid + it * 512; const int tok = pc / 112, c8 = pc % 112, cc = c8 * 8;
        const int pcol = cc < 256 ? PC_RWR + cc : PC_RWK + (cc - 256);
        const int row = t0 + tok, pos = s0.pos + tok;
        const u32x4 u0 = *(const u32x4*)(P + (size_t)row * NP + pcol);
        const u32x4 um = pos > 0 ? *(const u32x4*)(P + (size_t)(row - 1) * NP + pcol) : (u32x4){0u, 0u, 0u, 0u};
        const u32x4 up = pos < s0.len - 1 ? *(const u32x4*)(P + (size_t)(row + 1) * NP + pcol) : (u32x4){0u, 0u, 0u, 0u};
        const f32x4 mu0 = *(const f32x4*)(mu + cc), mu1 = *(const f32x4*)(mu + cc + 4);
        float z0[8], zm[8], zp[8], zs[8]; unpack8(u0, z0); unpack8(um, zm); unpack8(up, zp);
        const float mm[8] = {mu0.x, mu0.y, mu0.z, mu0.w, mu1.x, mu1.y, mu1.z, mu1.w};
#pragma unroll
        for (int x = 0; x < 8; ++x) zs[x] = z0[x] + mm[x] * (0.5f * (zm[x] + zp[x]) - z0[x]);
        LAS unsigned char* dst;
        if (cc < 256) dst = (LAS unsigned char*)(r_s + tok * 256 + cc);
        else if (cc < 512) dst = (LAS unsigned char*)(k_s + tok * 256 + cc - 256);
        else if (cc < 768) dst = (LAS unsigned char*)(v_s + tok * 256 + cc - 512);
        else if (cc < 832) { dst = twd + tok * 144 + (cc - 768) * 2;
#pragma unroll
            for (int x = 0; x < 8; ++x) zs[x] = 1.f - 2.f * __builtin_amdgcn_rcpf(1.f + __expf(2.f * zs[x])); }
        else dst = ads + tok * 144 + (cc - 832) * 2;
        *(LAS u32x4*)dst = (u32x4){cvt_pk_bf16(zs[0], zs[1]), cvt_pk_bf16(zs[2], zs[3]), cvt_pk_bf16(zs[4], zs[5]), cvt_pk_bf16(zs[6], zs[7])};
    }
    __syncthreads();
    const int hh = tid >> 8, c = tid & 255, h = c >> 6;
    bf16_t* RK = (bf16_t*)(p.ws + WS_RWK); bf16_t* RV = (bf16_t*)(p.ws + WS_RWV); bf16_t* RR = (bf16_t*)(p.ws + WS_RWRR);
    bf16_t* RA0 = (bf16_t*)(p.ws + WS_RWA0); bf16_t* RA1 = (bf16_t*)(p.ws + WS_RWA1); bf16_t* RM0 = (bf16_t*)(p.ws + WS_RWM0); bf16_t* RM1 = (bf16_t*)(p.ws + WS_RWM1);
    float* BON = (float*)(p.ws + WS_BON);
#pragma unroll
    for (int pass = 0; pass < 2; ++pass) {
        { const bf16_t* WT = (const bf16_t*)(p.ws + WS_LORAT + ((size_t)l * 4 + pass * 2) * 256 * 64 * 2);
          LAS unsigned char* A = pass ? ads : twd;
          const bf16x8 x00 = *(const LAS bf16x8*)(A + fr * 144 + fq * 16), x01 = *(const LAS bf16x8*)(A + fr * 144 + 64 + fq * 16);
          const bf16x8 x10 = *(const LAS bf16x8*)(A + (16 + fr) * 144 + fq * 16), x11 = *(const LAS bf16x8*)(A + (16 + fr) * 144 + 64 + fq * 16);
          bf16x8 b0[4], b1[4];
#pragma unroll
          for (int q = 0; q < 4; ++q) { const int t = wave * 4 + q, m = t >> 4, nt = t & 15; const bf16_t* wrow = WT + (size_t)m * 256 * 64 + (size_t)(nt * 16 + fr) * 64 + fq * 8;
              b0[q] = *(const bf16x8*)wrow; b1[q] = *(const bf16x8*)(wrow + 32); }
#pragma unroll
          for (int q = 0; q < 4; ++q) { const int t = wave * 4 + q, m = t >> 4, nt = t & 15;
              f32x4 a0 = (f32x4){0.f, 0.f, 0.f, 0.f}, a1 = a0;
              a0 = __builtin_amdgcn_mfma_f32_16x16x32_bf16(x00, b0[q], a0, 0, 0, 0); a0 = __builtin_amdgcn_mfma_f32_16x16x32_bf16(x01, b1[q], a0, 0, 0, 0);
              a1 = __builtin_amdgcn_mfma_f32_16x16x32_bf16(x10, b0[q], a1, 0, 0, 0); a1 = __builtin_amdgcn_mfma_f32_16x16x32_bf16(x11, b1[q], a1, 0, 0, 0);
#pragma unroll
              for (int r = 0; r < 4; ++r) { O1[(m * 32 + fq * 4 + r) * 256 + nt * 16 + fr] = a0[r]; O1[(m * 32 + 16 + fq * 4 + r) * 256 + nt * 16 + fr] = a1[r]; } } }
        __syncthreads();
        if (pass == 0) {
            const float w0b0 = p.in[15][(l * 2 + 0) * 256 + c], w0b1 = p.in[15][(l * 2 + 1) * 256 + c];
#pragma unroll
            for (int i = 0; i < 16; ++i) { const int tok = hh * 16 + i; const size_t o = (size_t)(t0 + tok) * 256 + c;
                const float sg0 = sigmoidf_(w0b0 + O1[tok * 256 + c]), sg1 = sigmoidf_(w0b1 + O1[(32 + tok) * 256 + c]);
                RM0[o] = f2bf(1.f - __expf(-0.60653066f * sg0)); RM1[o] = f2bf(1.f - __expf(-0.60653066f * sg1)); }
        } else {
            const float a0b0 = p.in[17][(l * 2 + 0) * 256 + c], a0b1 = p.in[17][(l * 2 + 1) * 256 + c];
            const float ka = p.in[21][l * 256 + c], rk = p.in[22][l * 256 + c];
#pragma unroll
            for (int i = 0; i < 16; ++i) { const int tok = hh * 16 + i, row = t0 + tok; const size_t o = (size_t)row * 256 + c;
                const bf16_t kb = k_s[tok * 256 + c], vb = v_s[tok * 256 + c], rb = r_s[tok * 256 + c];
                const float k = bf2f(kb), r = bf2f(rb);
                const float a0 = sigmoidf_(a0b0 + O1[tok * 256 + c]), a1 = sigmoidf_(a0b1 + O1[(32 + tok) * 256 + c]);
                const float kt0 = k * (1.f + (a0 - 1.f) * ka), kt1 = k * (1.f + (a1 - 1.f) * ka);
                const float bs = wave_sum(r * (kt0 + kt1) * rk);
                RK[o] = kb; RV[o] = vb; RR[o] = rb; RA0[o] = f2bf(a0); RA1[o] = f2bf(a1);
                if ((tid & 63) == 0) BON[(size_t)row * 4 + h] = bs; }
        }
        __syncthreads();
    }
}
__device__ __forceinline__ int ret_chunk_index(int cr, int& b) { if (cr < 256) { b = cr >> 5; return 2 + (cr & 31); } b = (cr - 256) >> 1; return (cr - 256) & 1; }
__device__ __forceinline__ void ret_kv_item(const Params& p, LAS unsigned char* lds, int item) {
    const int tid = get_tid(), lane = tid & 63, wave = tid >> 6, fr = lane & 15, fq = lane >> 4;
    const bf16_t* P = (const bf16_t*)(p.ws + WS_P);
    const int cr = item >> 2, h = item & 3; int b; const int ci = ret_chunk_index(cr, b);
    const int r0 = cr * 128;
    LAS unsigned char* Ktf = lds;
    LAS unsigned char* Ktb = lds + 64 * 272;
    LAS unsigned char* Vt = lds + 2 * 64 * 272;
    const float lg2 = log1pf(-exp2f(-5.f - (float)h)) * 1.44269504f;
#pragma unroll
    for (int it = 0; it < 2; ++it) { const int pc = tid + it * 512, j = pc >> 3, c8 = pc & 7;
        const u32x4 kk = *(const u32x4*)(P + (size_t)(r0 + j) * NP + PC_RETK + h * 64 + c8 * 8);
        const u32x4 vv = *(const u32x4*)(P + (size_t)(r0 + j) * NP + PC_RETV + h * 64 + c8 * 8);
        float kf[8]; unpack8(kk, kf);
        const float df = 0.125f * __builtin_amdgcn_exp2f((float)(127 - j) * lg2), db = 0.125f * __builtin_amdgcn_exp2f((float)j * lg2);
        const unsigned vw[4] = {vv.x, vv.y, vv.z, vv.w};
#pragma unroll
        for (int x = 0; x < 8; ++x) { const int d = c8 * 8 + x;
            *(LAS bf16_t*)(Ktf + d * 272 + j * 2) = f2bf(kf[x] * df); *(LAS bf16_t*)(Ktb + d * 272 + j * 2) = f2bf(kf[x] * db);
            *(LAS bf16_t*)(Vt + d * 272 + j * 2) = (bf16_t)((x & 1) ? (vw[x >> 1] >> 16) : (vw[x >> 1] & 0xffff)); } }
    __syncthreads();
    const int dir = wave >> 2, mt = wave & 3;
    LAS unsigned char* A = dir ? Ktb : Ktf;
    bf16x8 af[4];
#pragma unroll
    for (int kc = 0; kc < 4; ++kc) af[kc] = *(const LAS bf16x8*)(A + (mt * 16 + fr) * 272 + kc * 64 + fq * 16);
    float* RS = (float*)(p.ws + WS_RET) + ((size_t)((b * 4 + h) * 34 + ci) * 2 + dir) * 4096;
#pragma unroll
    for (int nt = 0; nt < 4; ++nt) { f32x4 acc = (f32x4){0.f, 0.f, 0.f, 0.f};
#pragma unroll
        for (int kc = 0; kc < 4; ++kc) { const bf16x8 bf = *(const LAS bf16x8*)(Vt + (nt * 16 + fr) * 272 + kc * 64 + fq * 16);
            acc = __builtin_amdgcn_mfma_f32_16x16x32_bf16(af[kc], bf, acc, 0, 0, 0); }
#pragma unroll
        for (int r = 0; r < 4; ++r) RS[(mt * 16 + fq * 4 + r) * 64 + nt * 16 + fr] = acc[r]; }
    __syncthreads();
}
__device__ __forceinline__ void swa_prep_item(const Params& p, LAS unsigned char* lds, int tile) {
    const int tid = get_tid();
    bf16_t* P = (bf16_t*)(p.ws + WS_P);
    const float* tabc = (const float*)(p.ws + WS_TAB); const float* tabs = tabc + 1024;
    bf16_t* KS = (bf16_t*)(p.ws + WS_KS); bf16_t* VT = (bf16_t*)(p.ws + WS_VTS);
    const int t0 = tile * 64; const SeqInfo s0 = seq_of_row(t0);
    const int key0 = s0.isctx ? s0.pos : CTXL + s0.pos;
    LAS bf16_t* Vs = (LAS bf16_t*)lds;
    u32x4 vreg[2];
#pragma unroll
    for (int it = 0; it < 2; ++it) { const int pc = tid + it * 512, tok = pc >> 4, c8 = pc & 15; vreg[it] = *(const u32x4*)(P + (size_t)(t0 + tok) * NP + PC_SWAV + c8 * 8); }
    u32x4 x1[3], x2[3];
#pragma unroll
    for (int it = 0; it < 3; ++it) { const int e = tid + it * 512; const int tok = e / 24, rem = e % 24, hd = rem >> 2, axis = (rem >> 1) & 1, fg = rem & 1;
        const int colbase = (hd < 4 ? PC_SWAQ + hd * 64 : PC_SWAK + (hd - 4) * 64) + axis * 32 + fg * 8;
        x1[it] = *(const u32x4*)(P + (size_t)(t0 + tok) * NP + colbase); x2[it] = *(const u32x4*)(P + (size_t)(t0 + tok) * NP + colbase + 16); }
#pragma unroll
    for (int it = 0; it < 2; ++it) { const int pc = tid + it * 512, tok = pc >> 4, c8 = pc & 15; *(LAS u32x4*)(Vs + tok * 136 + c8 * 8) = vreg[it]; }
#pragma unroll
    for (int it = 0; it < 3; ++it) { const int e = tid + it * 512; const int tok = e / 24, rem = e % 24, hd = rem >> 2, axis = (rem >> 1) & 1, fg = rem & 1;
        const int row = t0 + tok, pos = s0.pos + tok;
        const int colbase = (hd < 4 ? PC_SWAQ + hd * 64 : PC_SWAK + (hd - 4) * 64) + axis * 32 + fg * 8;
        float a[8], bb[8]; unpack8(x1[it], a); unpack8(x2[it], bb);
        if (!s0.isctx) { const int pp = axis == 0 ? (pos >> 6) : (pos & 63);
            const f32x4 c0 = *(const f32x4*)(tabc + pp * 16 + fg * 8), c1 = *(const f32x4*)(tabc + pp * 16 + fg * 8 + 4), s0v = *(const f32x4*)(tabs + pp * 16 + fg * 8), s1v = *(const f32x4*)(tabs + pp * 16 + fg * 8 + 4);
            const float cs[8] = {c0.x, c0.y, c0.z, c0.w, c1.x, c1.y, c1.z, c1.w}, sn[8] = {s0v.x, s0v.y, s0v.z, s0v.w, s1v.x, s1v.y, s1v.z, s1v.w};
#pragma unroll
            for (int x = 0; x < 8; ++x) { const float y1 = a[x] * cs[x] - bb[x] * sn[x], y2 = bb[x] * cs[x] + a[x] * sn[x]; a[x] = y1; bb[x] = y2; } }
        u32x4 o1, o2; o1.x = pk2(a[0], a[1]); o1.y = pk2(a[2], a[3]); o1.z = pk2(a[4], a[5]); o1.w = pk2(a[6], a[7]);
        o2.x = pk2(bb[0], bb[1]); o2.y = pk2(bb[2], bb[3]); o2.z = pk2(bb[4], bb[5]); o2.w = pk2(bb[6], bb[7]);
        if (hd < 4) { if (!s0.isctx) { *(u32x4*)(P + (size_t)row * NP + colbase) = o1; *(u32x4*)(P + (size_t)row * NP + colbase + 16) = o2; } }
        else { bf16_t* kd = KS + ((size_t)(s0.b * 2 + (hd - 4)) * NKEYS + key0 + tok) * 64 + axis * 32 + fg * 8; *(u32x4*)kd = o1; *(u32x4*)(kd + 16) = o2; }
    }
    __syncthreads();
#pragma unroll
    for (int it = 0; it < 2; ++it) { const int pc = tid + it * 512, hd = pc >> 3, k8 = pc & 7, hk = hd >> 6, d = hd & 63;
        unsigned w[4];
#pragma unroll
        for (int x = 0; x < 4; ++x) w[x] = (unsigned)Vs[(k8 * 8 + 2 * x) * 136 + hd] | ((unsigned)Vs[(k8 * 8 + 2 * x + 1) * 136 + hd] << 16);
        *(u32x4*)(VT + ((size_t)(s0.b * 2 + hk) * 64 + d) * NKEYS + key0 + k8 * 8) = (u32x4){w[0], w[1], w[2], w[3]}; }
    __syncthreads();
}
__device__ __forceinline__ void mla_proj_item(const Params& p, int l, LAS unsigned char* lds, int tile);
__device__ __forceinline__ void phase_prepA(const Params& p, int l, LAS unsigned char* lds, int bid, int nb) {
    for (int it = bid; it < TT / 32; it += nb) rwkv_prep_item(p, l, lds, it);
}
__device__ __forceinline__ void prep_rest_items(const Params& p, int l, LAS unsigned char* lds, int first, int stride) {
    constexpr int N2 = 272 * 4, N3 = TT / 64, N4 = TT / 32;
    for (int it = first; it < N2 + N3 + N4; it += stride) {
        if (it < N4) mla_proj_item(p, l, lds, it);
        else if (it < N4 + N2) ret_kv_item(p, lds, it - N4);
        else swa_prep_item(p, lds, it - N4 - N2);
    }
}

__device__ __forceinline__ void mla_proj_item(const Params& p, int l, LAS unsigned char* lds, int tile) {
    const int tid = get_tid(), lane = tid & 63, wave = tid >> 6, fr = lane & 15, fq = lane >> 4;
    const bf16_t* P = (const bf16_t*)(p.ws + WS_P);
    const float* tabc = (const float*)(p.ws + WS_TAB) + 2048; const float* tabs = tabc + 512;
    const int t0 = tile * 32; const SeqInfo s0 = seq_of_row(t0);
    const int key0 = s0.isctx ? s0.pos : CTXL + s0.pos;
    LAS unsigned char* qn = lds;
    LAS unsigned char* kvn = lds + 32 * 528;
    LAS float* qo = (LAS float*)(lds + 32 * 528 + 32 * 272);
    LAS float* kvo = qo + 32 * 384;
    const float* qg = p.in[24] + l * 256; const float* kvg = p.in[26] + l * 128;
    for (int i = 0; i < 4; ++i) { const int tok = wave * 4 + i, row = t0 + tok;
        float x[4]; float ss = 0.f;
#pragma unroll
        for (int j = 0; j < 4; ++j) { x[j] = bf2f(P[(size_t)row * NP + PC_MLAQD + j * 64 + lane]); ss += x[j] * x[j]; }
        const float rq = 1.f / sqrtf(wave_sum(ss) * (1.f / 256.f) + 1e-6f);
#pragma unroll
        for (int j = 0; j < 4; ++j) *(LAS bf16_t*)(qn + tok * 528 + (j * 64 + lane) * 2) = f2bf(x[j] * rq * qg[j * 64 + lane]);
        float y[2]; float s2 = 0.f;
#pragma unroll
        for (int j = 0; j < 2; ++j) { y[j] = bf2f(P[(size_t)row * NP + PC_MLAKVD + j * 64 + lane]); s2 += y[j] * y[j]; }
        const float rk = 1.f / sqrtf(wave_sum(s2) * (1.f / 128.f) + 1e-6f);
#pragma unroll
        for (int j = 0; j < 2; ++j) *(LAS bf16_t*)(kvn + tok * 272 + (j * 64 + lane) * 2) = f2bf(y[j] * rk * kvg[j * 64 + lane]);
    }
    __syncthreads();
    {
        const bf16_t* WqT = (const bf16_t*)(p.ws + WS_MLAW + (size_t)l * MLAW_LAYER);
        const bf16_t* WkvT = (const bf16_t*)(p.ws + WS_MLAW + (size_t)l * MLAW_LAYER + MLAW_KV);
        {
            bf16x8 bq[3][8];
#pragma unroll
            for (int q = 0; q < 3; ++q) { const bf16_t* wrow = WqT + (size_t)((wave + 8 * q) * 16 + fr) * 256 + fq * 8;
#pragma unroll
                for (int kc = 0; kc < 8; ++kc) bq[q][kc] = *(const bf16x8*)(wrow + kc * 32); }
#pragma unroll
            for (int q = 0; q < 3; ++q) { const int nt = wave + 8 * q;
                f32x4 a0 = (f32x4){0.f, 0.f, 0.f, 0.f}, a1 = a0;
#pragma unroll
                for (int kc = 0; kc < 8; ++kc) { const bf16x8 x0 = *(const LAS bf16x8*)(qn + fr * 528 + kc * 64 + fq * 16), x1 = *(const LAS bf16x8*)(qn + (16 + fr) * 528 + kc * 64 + fq * 16);
                    a0 = __builtin_amdgcn_mfma_f32_16x16x32_bf16(x0, bq[q][kc], a0, 0, 0, 0); a1 = __builtin_amdgcn_mfma_f32_16x16x32_bf16(x1, bq[q][kc], a1, 0, 0, 0); }
#pragma unroll
                for (int r = 0; r < 4; ++r) { qo[(fq * 4 + r) * 384 + nt * 16 + fr] = a0[r]; qo[(16 + fq * 4 + r) * 384 + nt * 16 + fr] = a1[r]; } }
        }
        {
            bf16x8 bk[4][4];
#pragma unroll
            for (int q = 0; q < 4; ++q) { const bf16_t* wrow = WkvT + (size_t)((wave + 8 * q) * 16 + fr) * 128 + fq * 8;
#pragma unroll
                for (int kc = 0; kc < 4; ++kc) bk[q][kc] = *(const bf16x8*)(wrow + kc * 32); }
#pragma unroll
            for (int q = 0; q < 4; ++q) { const int n0 = (wave + 8 * q) * 16;
                f32x4 a0 = (f32x4){0.f, 0.f, 0.f, 0.f}, a1 = a0;
#pragma unroll
                for (int kc = 0; kc < 4; ++kc) { const bf16x8 x0 = *(const LAS bf16x8*)(kvn + fr * 272 + kc * 64 + fq * 16), x1 = *(const LAS bf16x8*)(kvn + (16 + fr) * 272 + kc * 64 + fq * 16);
                    a0 = __builtin_amdgcn_mfma_f32_16x16x32_bf16(x0, bk[q][kc], a0, 0, 0, 0); a1 = __builtin_amdgcn_mfma_f32_16x16x32_bf16(x1, bk[q][kc], a1, 0, 0, 0); }
#pragma unroll
                for (int r = 0; r < 4; ++r) { kvo[(fq * 4 + r) * 512 + n0 + fr] = a0[r]; kvo[(16 + fq * 4 + r) * 512 + n0 + fr] = a1[r]; } }
        }
    }
    __syncthreads();
    {
        const int h = tid >> 7, dd = tid & 127;
        if (dd < 64) { bf16_t* KM = (bf16_t*)(p.ws + WS_KM) + ((size_t)(s0.b * 4 + h) * NKEYS + key0) * 96 + dd;
#pragma unroll
            for (int i = 0; i < 32; ++i) KM[(size_t)i * 96] = f2bf(kvo[i * 512 + tid]); }
        else { bf16_t* VT = (bf16_t*)(p.ws + WS_VTM) + ((size_t)(s0.b * 4 + h) * 64 + (dd - 64)) * NKEYS + key0;
            unsigned w[16];
#pragma unroll
            for (int i = 0; i < 16; ++i) w[i] = pk2(kvo[(2 * i) * 512 + tid], kvo[(2 * i + 1) * 512 + tid]);
#pragma unroll
            for (int i = 0; i < 4; ++i) *(u32x4*)(VT + i * 8) = (u32x4){w[4 * i], w[4 * i + 1], w[4 * i + 2], w[4 * i + 3]}; }
    }
    bf16_t* MQ = (bf16_t*)(p.ws + WS_MQ);
    for (int e = tid; e < 32 * 384; e += 512) { const int tok = e / 384, c = e % 384, dd = c % 96; const int pos = s0.pos + tok;
        float v = qo[e];
        if (dd >= 64 && !s0.isctx) { const int pe = dd - 64, axis = pe >> 4, half = (pe >> 3) & 1, f = pe & 7; const int pp = axis == 0 ? (pos >> 6) : (pos & 63);
            const float cs = tabc[pp * 8 + f], sn = tabs[pp * 8 + f];
            const float x1 = half ? qo[e - 8] : v, x2 = half ? v : qo[e + 8];
            v = half ? (x2 * cs + x1 * sn) : (x1 * cs - x2 * sn); }
        MQ[(size_t)(t0 + tok) * 384 + c] = f2bf(v); }
    for (int e = tid; e < 32 * 32; e += 512) { const int tok = e >> 5, pe = e & 31, axis = pe >> 4, half = (pe >> 3) & 1, f = pe & 7; const int row = t0 + tok, pos = s0.pos + tok;
        float v = bf2f(P[(size_t)row * NP + PC_MLAKPE + pe]);
        if (!s0.isctx) { const int pp = axis == 0 ? (pos >> 6) : (pos & 63); const float cs = tabc[pp * 8 + f], sn = tabs[pp * 8 + f];
            const float other = bf2f(P[(size_t)row * NP + PC_MLAKPE + (half ? pe - 8 : pe + 8)]);
            const float x1 = half ? other : v, x2 = half ? v : other;
            v = half ? (x2 * cs + x1 * sn) : (x1 * cs - x2 * sn); }
        const bf16_t o = f2bf(v);
#pragma unroll
        for (int h = 0; h < 4; ++h) ((bf16_t*)(p.ws + WS_KM))[((size_t)(s0.b * 4 + h) * NKEYS + key0 + tok) * 96 + 64 + pe] = o; }
    __syncthreads();
}
__device__ __forceinline__ void ret_scan_item(const Params& p, int l, int item) {
    const int tid = get_tid(); const int seq = item >> 1, dir = item & 1, h = seq & 3;
    const float lg = log1pf(-exp2f(-5.f - (float)h)); const float cdec = expf(128.f * lg);
    float* base = (float*)(p.ws + WS_RET) + (size_t)seq * 34 * 2 * 4096 + dir * 4096;
    auto ci_of = [&](int st) -> int { return dir == 0 ? st : (st == 0 ? 1 : (st == 1 ? 0 : 35 - st)); };
    float S[8];
#pragma unroll
    for (int i = 0; i < 8; ++i) S[i] = 0.f;
    f32x4 pa[4], pb[4];
#pragma unroll
    for (int k = 0; k < 4; ++k) { const float* q = base + (size_t)ci_of(k) * 2 * 4096 + tid * 8; pa[k] = *(const f32x4*)q; pb[k] = *(const f32x4*)(q + 4); }
#pragma unroll 1
    for (int st0 = 0; st0 < 36; st0 += 4) {
#pragma unroll
        for (int k = 0; k < 4; ++k) { const int st = st0 + k;
            if (st < 34) {
                float* q = base + (size_t)ci_of(st) * 2 * 4096 + tid * 8;
                const f32x4 t0 = pa[k], t1 = pb[k];
                if (st + 4 < 34) { const float* qn = base + (size_t)ci_of(st + 4) * 2 * 4096 + tid * 8; pa[k] = *(const f32x4*)qn; pb[k] = *(const f32x4*)(qn + 4); }
                *(f32x4*)q = (f32x4){S[0], S[1], S[2], S[3]}; *(f32x4*)(q + 4) = (f32x4){S[4], S[5], S[6], S[7]};
                S[0] = S[0] * cdec + t0.x; S[1] = S[1] * cdec + t0.y; S[2] = S[2] * cdec + t0.z; S[3] = S[3] * cdec + t0.w;
                S[4] = S[4] * cdec + t1.x; S[5] = S[5] * cdec + t1.y; S[6] = S[6] * cdec + t1.z; S[7] = S[7] * cdec + t1.w;
            } }
    }
    asm volatile("s_waitcnt vmcnt(0)" ::: "memory");
    __syncthreads();
    if (tid == 0) { __builtin_amdgcn_fence(__ATOMIC_RELEASE, "agent"); asm volatile("s_waitcnt vmcnt(0)" ::: "memory");
        __hip_atomic_fetch_add((unsigned*)(p.ws + WS_CTR) + 2 + l, 1u, __ATOMIC_RELAXED, __HIP_MEMORY_SCOPE_AGENT); }
}
__device__ __forceinline__ void wait_counter(const Params& p, int idx, unsigned need) {
    if (get_tid() == 0) { unsigned* f = (unsigned*)(p.ws + WS_CTR) + idx; unsigned sp = 0;
        while (__hip_atomic_load(f, __ATOMIC_RELAXED, __HIP_MEMORY_SCOPE_AGENT) < need) { __builtin_amdgcn_s_sleep(4); if (++sp > (1u << 22)) break; }
        __builtin_amdgcn_fence(__ATOMIC_ACQUIRE, "agent"); asm volatile("s_waitcnt vmcnt(0)" ::: "memory"); }
    __syncthreads();
}
template <int DK>
__device__ __forceinline__ void attn_unit(const bf16_t* Q, int qstride, const bf16_t* K, const bf16_t* Vt, int nctx, int mt0, int mt1, bool masked, int qpos0,
                                          bool has_sink, float sink, float scale, bf16_t* O, int ostride, LAS unsigned char* lds) {
    constexpr int KC = DK / 32, KP = DK + 8, KROW = KP * 2;
    constexpr int PIECES_K = 64 * DK / 8;
    constexpr int BUFB = 64 * KROW + 64 * 144;
    const int tid = get_tid(), lane = tid & 63, wave = tid >> 6, fr = lane & 15, fq = lane >> 4;
    const float sl2 = scale * 1.44269504f;
    bf16x8 qf[2][KC];
#pragma unroll
    for (int g = 0; g < 2; ++g)
#pragma unroll
        for (int kc = 0; kc < KC; ++kc) { const u32x4 u = *(const u32x4*)(Q + (size_t)(wave * 32 + g * 16 + fr) * qstride + kc * 32 + fq * 8); float f[8]; unpack8(u, f);
            u32x4 o; o.x = cvt_pk_bf16(f[0] * sl2, f[1] * sl2); o.y = cvt_pk_bf16(f[2] * sl2, f[3] * sl2); o.z = cvt_pk_bf16(f[4] * sl2, f[5] * sl2); o.w = cvt_pk_bf16(f[6] * sl2, f[7] * sl2);
            qf[g][kc] = __builtin_bit_cast(bf16x8, o); }
    float mq[2] = {0.f, 0.f}, lsum[2] = {0.f, 0.f}; f32x4 o[2][4];
#pragma unroll
    for (int g = 0; g < 2; ++g)
#pragma unroll
        for (int n = 0; n < 4; ++n) o[g][n] = (f32x4){0.f, 0.f, 0.f, 0.f};
    const int ntiles = nctx + (mt1 - mt0);
    u32x4 kr[2], vr;
    auto issue = [&](int ti) {
        const int tile = ti < nctx ? ti : mt0 + (ti - nctx);
        const bf16_t* kb = K + (size_t)tile * 64 * DK;
#pragma unroll
        for (int i = 0; i < 2; ++i) { const int pc = tid + i * 512; if (pc < PIECES_K) kr[i] = *(const u32x4*)(kb + (size_t)pc * 8); }
        { const int d = tid >> 3, c8 = tid & 7; vr = *(const u32x4*)(Vt + (size_t)d * NKEYS + tile * 64 + c8 * 8); }
    };
    auto stash = [&](int bufi) {
        LAS unsigned char* Kt = lds + bufi * BUFB; LAS unsigned char* Vl = Kt + 64 * KROW;
#pragma unroll
        for (int i = 0; i < 2; ++i) { const int pc = tid + i * 512; if (pc < PIECES_K) { const int row = pc / (DK / 8), c8 = pc % (DK / 8); *(LAS u32x4*)(Kt + row * KROW + c8 * 16) = kr[i]; } }
        { const int d = tid >> 3, c8 = tid & 7; *(LAS u32x4*)(Vl + d * 144 + c8 * 16) = vr; }
    };
    issue(0); stash(0);
    if (ntiles > 1) issue(1);
    __syncthreads();
    for (int ti = 0; ti < ntiles; ++ti) {
        const int tile = ti < nctx ? ti : mt0 + (ti - nctx);
        LAS unsigned char* Kt = lds + (ti & 1) * BUFB; LAS unsigned char* Vl = Kt + 64 * KROW;
        if (ti + 1 < ntiles) { stash((ti + 1) & 1); if (ti + 2 < ntiles) issue(ti + 2); }
        f32x4 s[2][4];
#pragma unroll
        for (int n = 0; n < 4; ++n) {
            s[0][n] = (f32x4){-mq[0], -mq[0], -mq[0], -mq[0]}; s[1][n] = (f32x4){-mq[1], -mq[1], -mq[1], -mq[1]};
#pragma unroll
            for (int kc = 0; kc < KC; ++kc) { const bf16x8 kf = *(const LAS bf16x8*)(Kt + (n * 16 + fr) * KROW + kc * 64 + fq * 16);
                s[0][n] = __builtin_amdgcn_mfma_f32_16x16x32_bf16(kf, qf[0][kc], s[0][n], 0, 0, 0);
                s[1][n] = __builtin_amdgcn_mfma_f32_16x16x32_bf16(kf, qf[1][kc], s[1][n], 0, 0, 0); } }
        if (ti == 0) {
#pragma unroll
            for (int g = 0; g < 2; ++g) {
                float t = -INFINITY;
#pragma unroll
                for (int n = 0; n < 4; ++n)
#pragma unroll
                    for (int r = 0; r < 4; ++r) t = fmaxf(t, s[g][n][r]);
                t = fmaxf(t, __shfl_xor(t, 16)); t = fmaxf(t, __shfl_xor(t, 32));
                if (has_sink) t = fmaxf(t, sink * 1.44269504f);
                mq[g] = t;
#pragma unroll
                for (int n = 0; n < 4; ++n)
#pragma unroll
                    for (int r = 0; r < 4; ++r) s[g][n][r] -= t;
            }
        }
        if (masked && ti >= nctx) {
#pragma unroll
            for (int g = 0; g < 2; ++g)
#pragma unroll
                for (int n = 0; n < 4; ++n)
#pragma unroll
                    for (int r = 0; r < 4; ++r) { const int kp = tile * 64 + n * 16 + fq * 4 + r - CTXL, qp = qpos0 + wave * 32 + g * 16 + fr; const int df = qp - kp; if (df > 128 || df < -128) s[g][n][r] = -INFINITY; }
        }
#pragma unroll
        for (int g = 0; g < 2; ++g)
#pragma unroll
            for (int n = 0; n < 4; ++n)
#pragma unroll
                for (int r = 0; r < 4; ++r) { s[g][n][r] = __builtin_amdgcn_exp2f(s[g][n][r]); lsum[g] += s[g][n][r]; }
#pragma unroll
        for (int c = 0; c < 2; ++c) {
            bf16x8 pf[2];
#pragma unroll
            for (int g = 0; g < 2; ++g) { u32x4 pu; pu.x = cvt_pk_bf16(s[g][2 * c][0], s[g][2 * c][1]); pu.y = cvt_pk_bf16(s[g][2 * c][2], s[g][2 * c][3]);
                pu.z = cvt_pk_bf16(s[g][2 * c + 1][0], s[g][2 * c + 1][1]); pu.w = cvt_pk_bf16(s[g][2 * c + 1][2], s[g][2 * c + 1][3]); pf[g] = __builtin_bit_cast(bf16x8, pu); }
#pragma unroll
            for (int n = 0; n < 4; ++n) {
                const u32x2 lo = *(const LAS u32x2*)(Vl + (n * 16 + fr) * 144 + ((2 * c) * 16 + fq * 4) * 2), hi = *(const LAS u32x2*)(Vl + (n * 16 + fr) * 144 + ((2 * c + 1) * 16 + fq * 4) * 2);
                const bf16x8 vf = __builtin_bit_cast(bf16x8, (u32x4){lo.x, lo.y, hi.x, hi.y});
                o[0][n] = __builtin_amdgcn_mfma_f32_16x16x32_bf16(vf, pf[0], o[0][n], 0, 0, 0);
                o[1][n] = __builtin_amdgcn_mfma_f32_16x16x32_bf16(vf, pf[1], o[1][n], 0, 0, 0); }
        }
        __syncthreads();
    }
#pragma unroll
    for (int g = 0; g < 2; ++g) {
        float t = lsum[g];
        t += __shfl_xor(t, 16); t += __shfl_xor(t, 32);
        if (has_sink) t += __builtin_amdgcn_exp2f(sink * 1.44269504f - mq[g]);
        const float inv = 1.f / t;
#pragma unroll
        for (int n = 0; n < 4; ++n) { u32x2 ov; ov.x = cvt_pk_bf16(o[g][n][0] * inv, o[g][n][1] * inv); ov.y = cvt_pk_bf16(o[g][n][2] * inv, o[g][n][3] * inv);
            *(u32x2*)(O + (size_t)(wave * 32 + g * 16 + fr) * ostride + n * 16 + fq * 4) = ov; }
    }
}

__device__ __forceinline__ void ret_out_item(const Params& p, int l, LAS unsigned char* lds, int item) {
    const int tid = get_tid(), lane = tid & 63, wave = tid >> 6, fr = lane & 15, fq = lane >> 4;
    bf16_t* P = (bf16_t*)(p.ws + WS_P);
    const int cr = item >> 2, h = item & 3; int b; const int ci = ret_chunk_index(cr, b);
    const int r0 = cr * 128;
    const float lg2 = log1pf(-exp2f(-5.f - (float)h)) * 1.44269504f;
    LAS unsigned char* Kb = lds;
    LAS unsigned char* Vt = lds + 18432;
    LAS unsigned char* SfT = lds + 35840;
    LAS unsigned char* SbT = lds + 45056;
    for (int pc = tid; pc < 1024; pc += 512) { const int j = pc >> 3, c8 = pc & 7;
        const u32x4 kk = *(const u32x4*)(P + (size_t)(r0 + j) * NP + PC_RETK + h * 64 + c8 * 8);
        const u32x4 vv = *(const u32x4*)(P + (size_t)(r0 + j) * NP + PC_RETV + h * 64 + c8 * 8);
        float kf[8]; unpack8(kk, kf);
        u32x4 ko; ko.x = pk2(kf[0] * 0.125f, kf[1] * 0.125f); ko.y = pk2(kf[2] * 0.125f, kf[3] * 0.125f); ko.z = pk2(kf[4] * 0.125f, kf[5] * 0.125f); ko.w = pk2(kf[6] * 0.125f, kf[7] * 0.125f);
        *(LAS u32x4*)(Kb + j * 144 + c8 * 16) = ko;
        const unsigned vw[4] = {vv.x, vv.y, vv.z, vv.w};
#pragma unroll
        for (int x = 0; x < 8; ++x) *(LAS bf16_t*)(Vt + (c8 * 8 + x) * 272 + j * 2) = (bf16_t)((x & 1) ? (vw[x >> 1] >> 16) : (vw[x >> 1] & 0xffff)); }
    { const float* RS = (const float*)(p.ws + WS_RET) + ((size_t)((b * 4 + h) * 34 + ci) * 2) * 4096;
      for (int pc = tid; pc < 1024; pc += 512) { const int d = pc >> 4, e4 = (pc & 15) * 4;
          const f32x4 a = *(const f32x4*)(RS + d * 64 + e4), bb = *(const f32x4*)(RS + 4096 + d * 64 + e4);
#pragma unroll
          for (int x = 0; x < 4; ++x) { *(LAS bf16_t*)(SfT + (e4 + x) * 144 + d * 2) = f2bf(a[x]); *(LAS bf16_t*)(SbT + (e4 + x) * 144 + d * 2) = f2bf(bb[x]); } } }
    const int i = wave * 16 + fr;
    u32x4 qraw[2];
#pragma unroll
    for (int kc = 0; kc < 2; ++kc) qraw[kc] = *(const u32x4*)(P + (size_t)(r0 + i) * NP + PC_RETQ + h * 64 + kc * 32 + fq * 8);
    __syncthreads();
    f32x4 s[8];
#pragma unroll
    for (int nb = 0; nb < 8; ++nb) { s[nb] = (f32x4){0.f, 0.f, 0.f, 0.f};
#pragma unroll
        for (int kc = 0; kc < 2; ++kc) { const bf16x8 kf = *(const LAS bf16x8*)(Kb + (nb * 16 + fr) * 144 + kc * 64 + fq * 16);
            s[nb] = __builtin_amdgcn_mfma_f32_16x16x32_bf16(kf, __builtin_bit_cast(bf16x8, qraw[kc]), s[nb], 0, 0, 0); } }
#pragma unroll
    for (int nb = 0; nb < 8; ++nb)
#pragma unroll
        for (int r = 0; r < 4; ++r) { const int j = nb * 16 + fq * 4 + r; const int df = i - j; const int adf = df < 0 ? -df : df;
            float dcy = __builtin_amdgcn_exp2f((float)adf * lg2); if (df == 0) dcy = 2.f; s[nb][r] *= dcy; }
    f32x4 o[4];
#pragma unroll
    for (int n = 0; n < 4; ++n) o[n] = (f32x4){0.f, 0.f, 0.f, 0.f};
#pragma unroll
    for (int c = 0; c < 4; ++c) {
        u32x4 pu; pu.x = cvt_pk_bf16(s[2 * c][0], s[2 * c][1]); pu.y = cvt_pk_bf16(s[2 * c][2], s[2 * c][3]); pu.z = cvt_pk_bf16(s[2 * c + 1][0], s[2 * c + 1][1]); pu.w = cvt_pk_bf16(s[2 * c + 1][2], s[2 * c + 1][3]);
        const bf16x8 pf = __builtin_bit_cast(bf16x8, pu);
#pragma unroll
        for (int n = 0; n < 4; ++n) {
            const u32x2 lo = *(const LAS u32x2*)(Vt + (n * 16 + fr) * 272 + ((2 * c) * 16 + fq * 4) * 2), hi = *(const LAS u32x2*)(Vt + (n * 16 + fr) * 272 + ((2 * c + 1) * 16 + fq * 4) * 2);
            const bf16x8 vf = __builtin_bit_cast(bf16x8, (u32x4){lo.x, lo.y, hi.x, hi.y});
            o[n] = __builtin_amdgcn_mfma_f32_16x16x32_bf16(vf, pf, o[n], 0, 0, 0); }
    }
    const float gf = __builtin_amdgcn_exp2f((float)(i + 1) * lg2), gb = __builtin_amdgcn_exp2f((float)(128 - i) * lg2);
#pragma unroll
    for (int kc = 0; kc < 2; ++kc) {
        float f[8]; unpack8(qraw[kc], f);
        u32x4 uf, ub;
        uf.x = cvt_pk_bf16(f[0] * gf, f[1] * gf); uf.y = cvt_pk_bf16(f[2] * gf, f[3] * gf); uf.z = cvt_pk_bf16(f[4] * gf, f[5] * gf); uf.w = cvt_pk_bf16(f[6] * gf, f[7] * gf);
        ub.x = cvt_pk_bf16(f[0] * gb, f[1] * gb); ub.y = cvt_pk_bf16(f[2] * gb, f[3] * gb); ub.z = cvt_pk_bf16(f[4] * gb, f[5] * gb); ub.w = cvt_pk_bf16(f[6] * gb, f[7] * gb);
        const bf16x8 qF = __builtin_bit_cast(bf16x8, uf), qB = __builtin_bit_cast(bf16x8, ub);
#pragma unroll
        for (int n = 0; n < 4; ++n) {
            const bf16x8 af = *(const LAS bf16x8*)(SfT + (n * 16 + fr) * 144 + kc * 64 + fq * 16), ab = *(const LAS bf16x8*)(SbT + (n * 16 + fr) * 144 + kc * 64 + fq * 16);
            o[n] = __builtin_amdgcn_mfma_f32_16x16x32_bf16(af, qF, o[n], 0, 0, 0);
            o[n] = __builtin_amdgcn_mfma_f32_16x16x32_bf16(ab, qB, o[n], 0, 0, 0); }
    }
    float sm = 0.f;
#pragma unroll
    for (int n = 0; n < 4; ++n) sm += (o[n][0] + o[n][1]) + (o[n][2] + o[n][3]);
    sm += __shfl_xor(sm, 16); sm += __shfl_xor(sm, 32);
    const float mu = sm * (1.f / 64.f);
    float vs = 0.f;
#pragma unroll
    for (int n = 0; n < 4; ++n)
#pragma unroll
        for (int r = 0; r < 4; ++r) { const float dl = o[n][r] - mu; vs += dl * dl; }
    vs += __shfl_xor(vs, 16); vs += __shfl_xor(vs, 32);
    const float rstd = 1.f / sqrtf(vs * (1.f / 64.f) + 1e-5f);
#pragma unroll
    for (int n = 0; n < 4; ++n) { const int e0 = n * 16 + fq * 4;
        const u32x2 gu = *(const u32x2*)(P + (size_t)(r0 + i) * NP + PC_RETG + h * 64 + e0);
        const f32x4 gn = *(const f32x4*)(p.in[13] + l * 256 + h * 64 + e0);
        const float g0 = bf2f((bf16_t)(gu.x & 0xffff)), g1 = bf2f((bf16_t)(gu.x >> 16)), g2 = bf2f((bf16_t)(gu.y & 0xffff)), g3 = bf2f((bf16_t)(gu.y >> 16));
        u32x2 yo;
        yo.x = cvt_pk_bf16((o[n][0] - mu) * rstd * gn.x * (g0 / (1.f + __expf(-g0))), (o[n][1] - mu) * rstd * gn.y * (g1 / (1.f + __expf(-g1))));
        yo.y = cvt_pk_bf16((o[n][2] - mu) * rstd * gn.z * (g2 / (1.f + __expf(-g2))), (o[n][3] - mu) * rstd * gn.w * (g3 / (1.f + __expf(-g3))));
        *(u32x2*)(P + (size_t)(r0 + i) * NP + PC_RETQ + h * 64 + e0) = yo; }
    __syncthreads();
}

constexpr int NSCANBLK = 128;
__device__ __forceinline__ void rwkv_scan_item(const Params& p, int l, LAS unsigned char* lds, int item) {
    const int tid = get_tid();
    const int sc = item >> 1, half = item & 1;
    const int b = sc >> 3, h = (sc >> 1) & 3, dir = sc & 1;
    const bf16_t* RK = (const bf16_t*)(p.ws + WS_RWK); const bf16_t* RV = (const bf16_t*)(p.ws + WS_RWV); const bf16_t* RR = (const bf16_t*)(p.ws + WS_RWRR);
    const bf16_t* RA = (const bf16_t*)(p.ws + (dir ? WS_RWA1 : WS_RWA0)); const bf16_t* RM = (const bf16_t*)(p.ws + (dir ? WS_RWM1 : WS_RWM0));
    bf16_t* P = (bf16_t*)(p.ws + WS_P);
    const int ocol = (dir ? PC_RWO1 : PC_RWO0) + h * 64 + half * 32;
    LAS float* SA = (LAS float*)lds;
    LAS float* OUT = SA + 64 * 384;
    const int st = tid >> 3, c0 = (tid & 7) * 8;
    float kkp[8], kap[8];
#pragma unroll
    for (int i = 0; i < 8; ++i) { kkp[i] = p.in[20][l * 256 + h * 64 + c0 + i]; kap[i] = p.in[21][l * 256 + h * 64 + c0 + i]; }
    const int row_l = tid >> 4, kq = tid & 15;
    f32x2 S[2];
#pragma unroll
    for (int i = 0; i < 2; ++i) S[i] = (f32x2){0.f, 0.f};
    auto row_of = [&](int s) -> int {
        if (s < CTXL) return TMAIN + b * CTXL + (dir ? CTXL - 1 - s : s);
        const int t = s - CTXL; return b * SEQL + (dir ? SEQL - 1 - t : t);
    };
    u32x4 gk, gv, gr, ga, gm;
    auto issue = [&](int ch) { const size_t o = (size_t)row_of(ch * 64 + st) * 256 + h * 64 + c0;
        gk = *(const u32x4*)(RK + o); gv = *(const u32x4*)(RV + o); gr = *(const u32x4*)(RR + o); ga = *(const u32x4*)(RA + o); gm = *(const u32x4*)(RM + o); };
    issue(0);
    for (int ch = 0; ch < 68; ++ch) {
        {
            float k[8], a[8], om[8], rr[8], vv8[8]; unpack8(gk, k); unpack8(ga, a); unpack8(gm, om); unpack8(gr, rr); unpack8(gv, vv8);
            float kk[8]; float n2 = 0.f;
#pragma unroll
            for (int i = 0; i < 8; ++i) { kk[i] = k[i] * kkp[i]; n2 += kk[i] * kk[i]; }
            n2 = red8(n2);
            const float rn = 1.f / sqrtf(fmaxf(n2, 1e-12f));
            f32x4 o0, o1;
#define ST8(DST, EXPR) { float t8[8]; _Pragma("unroll") for (int i = 0; i < 8; ++i) t8[i] = (EXPR); \
            *(LAS f32x4*)(SA + st * 384 + (DST) * 64 + c0) = (f32x4){t8[0], t8[1], t8[2], t8[3]}; *(LAS f32x4*)(SA + st * 384 + (DST) * 64 + c0 + 4) = (f32x4){t8[4], t8[5], t8[6], t8[7]}; }
            ST8(0, kk[i] * rn)
            ST8(1, 1.f - om[i])
            ST8(2, kk[i] * rn * a[i])
            ST8(3, k[i] * (1.f + (a[i] - 1.f) * kap[i]))
            ST8(4, rr[i])
            ST8(5, vv8[i])
#undef ST8
        }
        __syncthreads();
        if (ch + 1 < 68) issue(ch + 1);
        {
            struct Ops { f32x4 kh, w, b, t, r; float vv; };
            const LAS float* sbase = SA + kq * 4; const LAS float* vbase = SA + 5 * 64 + half * 32 + row_l;
            auto ldops = [&](int s) -> Ops { Ops q;
                q.kh = *(const LAS f32x4*)(sbase + s * 384); q.w = *(const LAS f32x4*)(sbase + s * 384 + 64); q.b = *(const LAS f32x4*)(sbase + s * 384 + 128);
                q.t = *(const LAS f32x4*)(sbase + s * 384 + 192); q.r = *(const LAS f32x4*)(sbase + s * 384 + 256);
                q.vv = vbase[s * 384]; return q; };
            Ops nx = ldops(0);
#pragma unroll 2
            for (int s = 0; s < 64; ++s) {
                const Ops c = nx;
                nx = ldops(s + 1 < 64 ? s + 1 : 63);
                f32x2 a2 = S[0] * (f32x2){c.kh.x, c.kh.y}; a2 = S[1] * (f32x2){c.kh.z, c.kh.w} + a2;
                const float sk = red16(a2.x + a2.y);
                const f32x2 nsk = (f32x2){-sk, -sk}, vv2 = (f32x2){c.vv, c.vv};
                S[0] = S[0] * (f32x2){c.w.x, c.w.y} + (nsk * (f32x2){c.b.x, c.b.y} + vv2 * (f32x2){c.t.x, c.t.y});
                S[1] = S[1] * (f32x2){c.w.z, c.w.w} + (nsk * (f32x2){c.b.z, c.b.w} + vv2 * (f32x2){c.t.z, c.t.w});
                f32x2 o2 = S[0] * (f32x2){c.r.x, c.r.y}; o2 = S[1] * (f32x2){c.r.z, c.r.w} + o2;
                const float ov = red16(o2.x + o2.y);
                OUT[s * 32 + row_l] = ov;
            }
        }
        __syncthreads();
        { const int c4 = (tid & 7) * 4; const f32x4 ov = *(const LAS f32x4*)(OUT + st * 32 + c4);
          u32x2 o2; o2.x = pk2(ov.x, ov.y); o2.y = pk2(ov.z, ov.w);
          *(u32x2*)(P + (size_t)row_of(ch * 64 + st) * NP + ocol + c4) = o2; }
    }
    __syncthreads();
}

__device__ __forceinline__ void mixer_mla(const Params& p, LAS unsigned char* lds, int it) {
    bf16_t* P = (bf16_t*)(p.ws + WS_P);
    const bf16_t* MQ = (const bf16_t*)(p.ws + WS_MQ);
    int b, h, row0, nm1;
    if (it < 512) { b = it >> 6; h = (it >> 4) & 3; row0 = b * SEQL + (it & 15) * 256; nm1 = 68; }
    else { const int u = it - 512; b = u >> 2; h = u & 3; row0 = TMAIN + b * CTXL; nm1 = 4; }
    attn_unit<96>(MQ + (size_t)row0 * 384 + h * 96, 384, (const bf16_t*)(p.ws + WS_KM) + (size_t)(b * 4 + h) * NKEYS * 96, (const bf16_t*)(p.ws + WS_VTM) + (size_t)(b * 4 + h) * 64 * NKEYS,
                  4, 4, nm1, false, 0, false, 0.f, 0.10206207f, P + (size_t)row0 * NP + PC_MLAQD + h * 64, NP, lds);
}
__device__ __forceinline__ void mixer_swa(const Params& p, int l, LAS unsigned char* lds, int u0) {
    bf16_t* P = (bf16_t*)(p.ws + WS_P);
    int b, h, row0, nm0, nm1, qp0; bool msk;
    if (u0 < 512) { b = u0 >> 6; h = (u0 >> 4) & 3; const int qb = u0 & 15; row0 = b * SEQL + qb * 256; nm0 = 4 + 4 * qb - 2; nm1 = 4 + 4 * qb + 6; if (nm0 < 4) nm0 = 4; if (nm1 > 68) nm1 = 68; qp0 = qb * 256; msk = true; }
    else { const int u = u0 - 512; b = u >> 2; h = u & 3; row0 = TMAIN + b * CTXL; nm0 = 4; nm1 = 4; qp0 = 0; msk = false; }
    const int hk = h >> 1;
    bf16_t* qp = P + (size_t)row0 * NP + PC_SWAQ + h * 64;
    attn_unit<64>(qp, NP, (const bf16_t*)(p.ws + WS_KS) + (size_t)(b * 2 + hk) * NKEYS * 64, (const bf16_t*)(p.ws + WS_VTS) + (size_t)(b * 2 + hk) * 64 * NKEYS,
                  4, nm0, nm1, msk, qp0, true, p.in[12][l * 4 + h], 0.125f, qp, NP, lds);
}
__device__ __forceinline__ void phase_mixers(const Params& p, int l, LAS unsigned char* lds, int bid, int nb) {
    const bool ectx = (l == 0);
    const int N_MLA = 512 + (ectx ? 32 : 0), N_SWA = 512 + (ectx ? 32 : 0), N_RET = 1024 + (ectx ? 64 : 0);
    if (bid < NSCANBLK) rwkv_scan_item(p, l, lds, bid);
    else {
        prep_rest_items(p, l, lds, bid - NSCANBLK, nb - NSCANBLK);
        asm volatile("s_waitcnt vmcnt(0)" ::: "memory");
        __syncthreads();
        if (get_tid() == 0) { __builtin_amdgcn_fence(__ATOMIC_RELEASE, "agent"); asm volatile("s_waitcnt vmcnt(0)" ::: "memory");
            __hip_atomic_fetch_add((unsigned*)(p.ws + WS_CTR) + 4 + l, 1u, __ATOMIC_RELAXED, __HIP_MEMORY_SCOPE_AGENT); }
        if (bid < NSCANBLK + 64) { wait_counter(p, 4 + l, (unsigned)(nb - NSCANBLK)); ret_scan_item(p, l, bid - NSCANBLK); }
    }
    wait_counter(p, 4 + l, (unsigned)(nb - NSCANBLK));
    bool ret_ready = false;
    unsigned* ctr = (unsigned*)(p.ws + WS_CTR) + l;
    LAS unsigned* slot = (LAS unsigned*)(lds + LDS_BYTES - 16);
    const int tid0 = get_tid();
    for (;;) {
        __syncthreads();
        if (tid0 == 0) *slot = atomicAdd(ctr, 1u);
        __syncthreads();
        const int it = (int)*slot;
        if (it >= N_MLA + N_SWA + N_RET) break;
        if (it < N_MLA) mixer_mla(p, lds, it);
        else if (it < N_MLA + N_SWA) mixer_swa(p, l, lds, it - N_MLA);
        else { if (!ret_ready) { wait_counter(p, 2 + l, 64u); ret_ready = true; } ret_out_item(p, l, lds, it - N_MLA - N_SWA); }
    }
}

__device__ __forceinline__ void phase_rwkv_finish(const Params& p, int l, LAS unsigned char* lds, int bid, int nb) {
    const int tid = get_tid();
    bf16_t* P = (bf16_t*)(p.ws + WS_P);
    const int ntiles = (l == 0 ? TT : TMAIN) / 32;
    const float* mu = p.in[14] + l * 1024 + 896;
    const float* gup = p.in[19] + (size_t)l * 128 * 256;
    const bf16_t* RV = (const bf16_t*)(p.ws + WS_RWV); const float* BON = (const float*)(p.ws + WS_BON);
    for (int tile = bid; tile < ntiles; tile += nb) {
        const int t0 = tile * 32; const SeqInfo s0 = seq_of_row(t0);
        LAS unsigned char* sgb = lds;
        LAS float* gout = (LAS float*)(lds + 32 * 272);
        { const int tok = tid >> 4, j8 = (tid & 15) * 8; const int row = t0 + tok, pos = s0.pos + tok;
          const u32x4 u0 = *(const u32x4*)(P + (size_t)row * NP + PC_RWGD + j8);
          const u32x4 um = pos > 0 ? *(const u32x4*)(P + (size_t)(row - 1) * NP + PC_RWGD + j8) : (u32x4){0u, 0u, 0u, 0u};
          const u32x4 up = pos < s0.len - 1 ? *(const u32x4*)(P + (size_t)(row + 1) * NP + PC_RWGD + j8) : (u32x4){0u, 0u, 0u, 0u};
          float z0[8], zm[8], zp[8], sv[8]; unpack8(u0, z0); unpack8(um, zm); unpack8(up, zp);
#pragma unroll
          for (int x = 0; x < 8; ++x) sv[x] = sigmoidf_(z0[x] + mu[j8 + x] * (0.5f * (zm[x] + zp[x]) - z0[x]));
          *(LAS u32x4*)(sgb + tok * 272 + j8 * 2) = (u32x4){cvt_pk_bf16(sv[0], sv[1]), cvt_pk_bf16(sv[2], sv[3]), cvt_pk_bf16(sv[4], sv[5]), cvt_pk_bf16(sv[6], sv[7])}; }
        __syncthreads();
        { const int lane = tid & 63, wave = tid >> 6, fr = lane & 15, fq = lane >> 4;
          const bf16_t* GT = (const bf16_t*)(p.ws + WS_GUPT + (size_t)l * 256 * 128 * 2);
#pragma unroll
          for (int q = 0; q < 2; ++q) { const int nt = wave + q * 8;
              f32x4 a0 = (f32x4){0.f, 0.f, 0.f, 0.f}, a1 = a0;
              const bf16_t* wrow = GT + (size_t)(nt * 16 + fr) * 128 + fq * 8;
              bf16x8 bfr[4];
#pragma unroll
              for (int kc = 0; kc < 4; ++kc) bfr[kc] = *(const bf16x8*)(wrow + kc * 32);
#pragma unroll
              for (int kc = 0; kc < 4; ++kc) { const bf16x8 x0 = *(const LAS bf16x8*)(sgb + fr * 272 + kc * 64 + fq * 16), x1 = *(const LAS bf16x8*)(sgb + (16 + fr) * 272 + kc * 64 + fq * 16);
                  a0 = __builtin_amdgcn_mfma_f32_16x16x32_bf16(x0, bfr[kc], a0, 0, 0, 0); a1 = __builtin_amdgcn_mfma_f32_16x16x32_bf16(x1, bfr[kc], a1, 0, 0, 0); }
#pragma unroll
              for (int r = 0; r < 4; ++r) { gout[(fq * 4 + r) * 256 + nt * 16 + fr] = a0[r]; gout[(16 + fq * 4 + r) * 256 + nt * 16 + fr] = a1[r]; } } }
        __syncthreads();
        const int hh = tid >> 8, c = tid & 255, h = c >> 6;
        float g[16];
#pragma unroll
        for (int i = 0; i < 16; ++i) g[i] = gout[(hh * 16 + i) * 256 + c];
        const float gn = p.in[23][l * 256 + c];
        float ov[16], rv[16], bn[16];
#pragma unroll
        for (int i = 0; i < 16; ++i) { const int row = t0 + hh * 16 + i;
            ov[i] = bf2f(P[(size_t)row * NP + PC_RWO0 + c]) + bf2f(P[(size_t)row * NP + PC_RWO1 + c]); rv[i] = bf2f(RV[(size_t)row * 256 + c]); bn[i] = BON[(size_t)row * 4 + h]; }
#pragma unroll
        for (int i = 0; i < 16; ++i) { const int row = t0 + hh * 16 + i;
            const float o = ov[i];
            const float mean = wave_sum(o) * (1.f / 64.f); const float dl = o - mean; const float var = wave_sum(dl * dl) * (1.f / 64.f);
            float y = dl * (1.f / sqrtf(var + 64e-5f)) * gn + bn[i] * rv[i];
            P[(size_t)row * NP + PC_RWO1 + c] = f2bf(y * g[i]); }
        __syncthreads();
    }
}

#ifndef N_LAUNCH_MODE
#define N_LAUNCH_MODE 1
#endif
template <int Q>
__device__ __forceinline__ void layer_phase(const Params& p, int l, LAS unsigned char* lds, int bid, int nb) {
    unsigned char* wb = p.ws + WS_WB + (size_t)l * WB_LAYER;
    const int Mrows = (l == 0) ? TT : TMAIN;
    pg8::StaticOrder S;
    if constexpr (Q == 0) { pg8::Gemm g{(const bf16_t*)(p.ws + WS_HB), (const bf16_t*)(wb + WB_IN), TT, NP, DM, DM}; S.init(TT, NP, nb, bid);
              pg8::EpiBf16<0> E{(bf16_t*)(p.ws + WS_P), NP}; pg8::gemm_phase(lds, g, S, E); }
    if constexpr (Q == 1) phase_prepA(p, l, lds, bid, nb);
    if constexpr (Q == 3) phase_mixers(p, l, lds, bid, nb);
    if constexpr (Q == 4) phase_rwkv_finish(p, l, lds, bid, nb);
    if constexpr (Q == 5) { pg8::Gemm g{(const bf16_t*)(p.ws + WS_P), (const bf16_t*)(wb + WB_OUT), Mrows, DM, DM, NP}; S.init(Mrows, DM, nb, bid);
              pg8::EpiBf16<0> E{(bf16_t*)(p.ws + WS_Z), DM}; pg8::gemm_phase(lds, g, S, E); }
    if constexpr (Q == 6) phase_rowops(p, 1, l, Mrows, bid, nb);
    if constexpr (Q == 7) { pg8::Gemm g{(const bf16_t*)(p.ws + WS_HB), (const bf16_t*)(wb + WB_W1), Mrows, FF, DM, DM}; S.init(Mrows, FF, nb, bid);
              pg8::EpiBf16<1> E{(bf16_t*)(p.ws + WS_HID), FF}; pg8::gemm_phase(lds, g, S, E); }
    if constexpr (Q == 8) { pg8::Gemm g{(const bf16_t*)(p.ws + WS_HID), (const bf16_t*)(wb + WB_W2), Mrows, DM, FF, FF}; S.init(Mrows, DM, nb, bid);
              pg8::EpiBf16<0> E{(bf16_t*)(p.ws + WS_Z), DM}; pg8::gemm_phase(lds, g, S, E); }
    if constexpr (Q == 9) phase_rowops(p, 2, l, Mrows, bid, nb);
}

#ifndef PROBE_MASK
#define PROBE_MASK 0
#endif
#define PB(BIT, CALL) do { if ((PROBE_MASK) & (BIT)) { const unsigned long long t0_ = __builtin_amdgcn_s_memrealtime(); CALL; const unsigned long long t1_ = __builtin_amdgcn_s_memrealtime(); \
        while (__builtin_amdgcn_s_memrealtime() - t1_ < (t1_ - t0_)) __builtin_amdgcn_s_sleep(8); } else { CALL; } } while (0)
#define XB_TMO      128
#define XB_XCNT(j)  (256  + 64 * (j))
#define XB_XSUB(j)  (1280 + 64 * (j))
#define XB_XGEN(j)  (2304 + 64 * (j))
#define XB_TOP      3328
#define XB_TOPGEN   3392
#define XCD_BAR_WORDS 3456
#define XB_SPIN_CAP (1u << 18)

__device__ __forceinline__ unsigned xb_ld(unsigned* p)              { return __hip_atomic_load(p, __ATOMIC_RELAXED, __HIP_MEMORY_SCOPE_AGENT); }
__device__ __forceinline__ unsigned xb_add(unsigned* p, unsigned v) { return __hip_atomic_fetch_add(p, v, __ATOMIC_RELAXED, __HIP_MEMORY_SCOPE_AGENT); }
__device__ __forceinline__ unsigned xb_xcc_id() { return (unsigned)__builtin_amdgcn_s_getreg((3 << 11) | 20) & 0xFu; }
#define XB_SPIN(cond, bar) do { unsigned _sp = 0; while (cond) { __builtin_amdgcn_s_sleep(1); \
    if ((++_sp & 255u) == 0u) { if (xb_ld(&(bar)[XB_TMO])) break; if (_sp > XB_SPIN_CAP) { atomicAdd(&(bar)[XB_TMO], 1u); break; } } } } while (0)

struct XcdBarrier {
    unsigned* bar; unsigned x;
    volatile LAS unsigned* st;
};

__device__ __forceinline__ XcdBarrier xcd_barrier_post(unsigned* bar, volatile LAS unsigned* st) {
    XcdBarrier b; b.bar = bar; b.x = xb_xcc_id(); b.st = st;
    if (threadIdx.x == 0) (void)xb_add(&bar[XB_XCNT(b.x)], 1u);
    return b;
}
__device__ __forceinline__ void xcd_barrier_complete(unsigned* bar, unsigned x, unsigned& nloc, unsigned& nx) {
    const unsigned G = gridDim.x * gridDim.y * gridDim.z;
    unsigned sum, cnt, mine, sp = 0u;
    for (;;) {
        sum = 0u; cnt = 0u; mine = 0u;
#pragma unroll
        for (unsigned j = 0; j < 16; ++j) { const unsigned c = xb_ld(&bar[XB_XCNT(j)]); sum += c; cnt += (c > 0u) ? 1u : 0u; mine = (j == x) ? c : mine; }
        if (sum == G) break;
        __builtin_amdgcn_s_sleep(1);
        if ((++sp & 255u) == 0u) { if (xb_ld(&bar[XB_TMO])) break; if (sp > XB_SPIN_CAP) { atomicAdd(&bar[XB_TMO], 1u); break; } }
    }
    nloc = mine > 0u ? mine : 1u; nx = cnt > 0u ? cnt : 1u;
}

__device__ __forceinline__ void xcd_barrier(const XcdBarrier& b) {
    asm volatile("s_waitcnt vmcnt(0)" ::: "memory");
    __syncthreads();
    if (threadIdx.x == 0) {
        unsigned* bar = b.bar;
        __builtin_amdgcn_s_waitcnt(0);
        unsigned nloc = b.st[0], nx = b.st[1];
        if (nloc == 0u) { xcd_barrier_complete(bar, b.x, nloc, nx); b.st[0] = nloc; b.st[1] = nx; }
        const unsigned old = xb_add(&bar[XB_XSUB(b.x)], 1u);
        const unsigned gen = old / nloc;
        if (old + 1u == (gen + 1u) * nloc) {
            __builtin_amdgcn_fence(__ATOMIC_RELEASE, "agent");
            asm volatile("s_waitcnt vmcnt(0)" ::: "memory");
            const unsigned og = xb_add(&bar[XB_TOP], 1u);
            const unsigned tg = og / nx;
            if (og + 1u == (tg + 1u) * nx) xb_add(&bar[XB_TOPGEN], 1u);
            else XB_SPIN(xb_ld(&bar[XB_TOPGEN]) == tg, bar);
            __builtin_amdgcn_fence(__ATOMIC_ACQUIRE, "agent");
            xb_add(&bar[XB_XGEN(b.x)], 1u);
            asm volatile("s_waitcnt vmcnt(0)" ::: "memory");
        } else {
            XB_SPIN(xb_ld(&bar[XB_XGEN(b.x)]) == gen, bar);
            __builtin_amdgcn_fence(__ATOMIC_ACQUIRE, "agent");
            asm volatile("s_waitcnt vmcnt(0)" ::: "memory");
        }
    }
    __syncthreads();
}


constexpr size_t WS_XBAR = 772 * 1024;
#define GSYNC() xcd_barrier(xb)

__global__ void __launch_bounds__(512, 2) mega_fwd(Params p) {
    extern __shared__ __attribute__((aligned(16))) unsigned char lds_raw[];
    LAS unsigned char* lds = (LAS unsigned char*)lds_raw;
    cg::grid_group grid = cg::this_grid();
    const int bid = blockIdx.x, nb = gridDim.x;
    { LAS unsigned* st_ = (LAS unsigned*)(lds + LDS_BYTES - 32); if (get_tid() == 0) { st_[0] = 0u; st_[1] = 0u; } __syncthreads(); }
    XcdBarrier xb = xcd_barrier_post((unsigned*)(p.ws + WS_XBAR), (volatile LAS unsigned*)(lds + LDS_BYTES - 32));
    grid.sync();
    PB(16, phase_prologue(p, lds, bid, nb)); GSYNC();
    PB(8, phase_rowops(p, 0, 0, TT, bid, nb)); GSYNC();
#define LAYER(L, LAST) \
    PB(1, layer_phase<0>(p, L, lds, bid, nb)); GSYNC(); PB(4, layer_phase<1>(p, L, lds, bid, nb)); GSYNC(); \
    PB(2, layer_phase<3>(p, L, lds, bid, nb)); GSYNC(); PB(4, layer_phase<4>(p, L, lds, bid, nb)); GSYNC(); PB(1, layer_phase<5>(p, L, lds, bid, nb)); GSYNC(); \
    PB(8, layer_phase<6>(p, L, lds, bid, nb)); GSYNC(); PB(1, layer_phase<7>(p, L, lds, bid, nb)); GSYNC(); PB(1, layer_phase<8>(p, L, lds, bid, nb)); GSYNC(); \
    PB(8, layer_phase<9>(p, L, lds, bid, nb)); if (!(LAST)) GSYNC();
    LAYER(0, false)
    LAYER(1, true)
}
#if N_LAUNCH_MODE != 1
template <int PH> __global__ void __launch_bounds__(512, 2) one_phase(Params p, int l) {
    extern __shared__ __attribute__((aligned(16))) unsigned char lds_raw[];
    LAS unsigned char* lds = (LAS unsigned char*)lds_raw;
    if constexpr (PH == 100) phase_prologue(p, lds, blockIdx.x, gridDim.x);
    else if constexpr (PH == 101) phase_rowops(p, 0, 0, TT, blockIdx.x, gridDim.x);
    else layer_phase<PH>(p, l, lds, blockIdx.x, gridDim.x);
}
#endif

extern "C" void kernel_launch(void* const* d_in, const int* in_sizes, int n_in, void* d_out, int out_size, void* d_ws, size_t ws_size, hipStream_t stream) {
    if (n_in != 30 || ws_size < WS_NEED || out_size != TMAIN * DM) { fprintf(stderr, "kernel_launch: unexpected shapes (n_in %d, ws %zu, out %d)\n", n_in, ws_size, out_size); return; }
    Params p{};
    for (int i = 0; i < 30; ++i) p.in[i] = (const float*)d_in[i];
    p.out = (float*)d_out; p.ws = (unsigned char*)d_ws;
    static int grid_blocks = 0;
    if (!grid_blocks) {
        int dev = 0, cus = 0, per_cu = 0;
        (void)hipGetDevice(&dev);
        (void)hipDeviceGetAttribute(&cus, hipDeviceAttributeMultiprocessorCount, dev);
        (void)hipFuncSetAttribute((const void*)mega_fwd, hipFuncAttributeMaxDynamicSharedMemorySize, LDS_BYTES);
        (void)hipOccupancyMaxActiveBlocksPerMultiprocessor(&per_cu, mega_fwd, 512, LDS_BYTES);
        if (per_cu < 1) { fprintf(stderr, "kernel_launch: occupancy query says %d blocks/CU\n", per_cu); per_cu = 1; }
        grid_blocks = cus * 1;
        if (grid_blocks < 128) { fprintf(stderr, "kernel_launch: only %d CUs\n", grid_blocks); }
    }
#if N_LAUNCH_MODE == 1
    (void)hipMemsetAsync((char*)d_ws + 768 * 1024, 0, 32 * 1024, stream);
    void* args[] = {&p};
    hipError_t e = hipLaunchCooperativeKernel((const void*)mega_fwd, dim3(grid_blocks), dim3(512), args, LDS_BYTES, stream);
    if (e != hipSuccess) fprintf(stderr, "cooperative launch failed: %s (grid %d)\n", hipGetErrorString(e), grid_blocks);
#else
#define LP(PH, L) do { (void)hipFuncSetAttribute((const void*)one_phase<PH>, hipFuncAttributeMaxDynamicSharedMemorySize, LDS_BYTES); one_phase<PH><<<grid_blocks, 512, LDS_BYTES, stream>>>(p, L); } while (0)
    LP(100, 0); LP(101, 0);
    for (int l = 0; l < 2; ++l) { LP(0, l); LP(1, l); LP(2, l); LP(3, l); LP(4, l); LP(5, l); LP(6, l); LP(7, l); LP(8, l); LP(9, l); }
#endif
}
```

```cpp
#include <hip/hip_runtime.h>
#include <hip/hip_cooperative_groups.h>
#include <cstdio>
#include <cstdint>
#include <cmath>
namespace cg = cooperative_groups;
__device__ __forceinline__ int get_tid() { int t = threadIdx.x; asm volatile("" : "+v"(t)); return t; }
namespace pg8 {
#define PG8_LAS __attribute__((address_space(3)))
typedef unsigned short bf16_t;
typedef short bf16x8 __attribute__((ext_vector_type(8)));
typedef float f32x4 __attribute__((ext_vector_type(4)));
typedef unsigned u32x4 __attribute__((ext_vector_type(4)));
typedef unsigned u32x2 __attribute__((ext_vector_type(2)));
constexpr int BM = 256, BK = 64, HALF = 128, HTB = HALF * BK * 2, STAGE_BYTES = 8 * HTB, NXCD = 8, WGM = 8;

__host__ __device__ __forceinline__ int lds_byte(int r, int c) { const int st = (r >> 4) * 2 + (c >> 5), rr = r & 15, cc = c & 31, ob = rr * 64 + cc * 2; return st * 1024 + (ob ^ (((ob >> 9) & 1) << 5)); }
__host__ __device__ __forceinline__ void stage_rc(int b, int& R, int& C) { const int st = b / 1024, sb = b % 1024, swz = sb ^ (((sb >> 9) & 1) << 5); R = (st >> 1) * 16 + swz / 64; C = (st & 1) * 32 + (swz % 64) / 2; }

__host__ __device__ __forceinline__ int perm32(int rho) { const int n = rho >> 4, i = rho & 15; return 8 * (i >> 2) + 4 * n + (i & 3); }
struct Unit { int pm, pn; };
struct Gemm { const bf16_t* A; const bf16_t* Bt; int M, N, K, lda; };

struct StaticOrder {
    int nM, nN, nwg, G, c;
    __host__ __device__ void init(int M, int N, int G_, int c_) { nM = M / BM; nN = N / BM; nwg = nM * nN; G = G_; c = c_; }
    __host__ __device__ bool next(int i, Unit& u) const {
        const long L = (long)i * G + c; if (L >= nwg) return false;
        int wgid = (int)L; { const int q = nwg / NXCD, r = nwg % NXCD, xcd = wgid % NXCD, off = wgid / NXCD; wgid = (xcd < r ? xcd * (q + 1) : r * (q + 1) + (xcd - r) * q) + off; }
        const int nig = WGM * nN, gid = wgid / nig, fm = gid * WGM, gsz = (nM - fm) < WGM ? (nM - fm) : WGM;
        u.pm = fm + ((wgid % nig) % gsz); u.pn = (wgid % nig) / gsz; return true;
    }
};

template <class Epi>
__device__ __forceinline__ void gemm_phase(PG8_LAS unsigned char* lds, const Gemm g, const StaticOrder& S, const Epi& E) {
    const int tid = get_tid(), wid = __builtin_amdgcn_readfirstlane(tid >> 6), lane = tid & 63, wr = wid >> 2, wc = wid & 3, fr = lane & 15, fq = lane >> 4;
    const int K = g.K, nt = K / BK, lda = g.lda;
    unsigned voffA[2], voffB[2];
#pragma unroll
    for (int i = 0; i < 2; ++i) { int R, C; stage_rc(tid * 16 + i * 8192, R, C);
        const int Rb = (R & ~31) + perm32(R & 31);
        voffA[i] = (unsigned)(R * lda + C) * 2u; voffB[i] = (unsigned)(Rb * K + C) * 2u; }
    const size_t kstep = (size_t)(BK * 2);
    const size_t hstepA = (size_t)HALF * lda * 2, hstepB = (size_t)HALF * K * 2;
    const size_t tstepA = 2 * hstepA, tstepB = 2 * hstepB;
    const unsigned ldsw = (unsigned)wid * 1024u;
    const int aoff = lds_byte(wr * 64 + fr, fq * 8), boff = lds_byte(wc * 32 + fr, fq * 8);
#define PG8_SA(b, h) (((b) * 2 + (h)) * HTB)
#define PG8_SB(b, h) ((4 + (b) * 2 + (h)) * HTB)
#define PG8_STAGE(bufoff, gbase, voff) do { _Pragma("unroll") for (int _i = 0; _i < 2; ++_i) \
        __builtin_amdgcn_global_load_lds((const unsigned*)((const char*)(gbase) + (voff)[_i]), (PG8_LAS unsigned*)(lds + (bufoff) + ldsw + _i * 8192), 16, 0, 0); } while (0)
#define PG8_LDA(dst, b, h) do { _Pragma("unroll") for (int m = 0; m < 4; ++m) _Pragma("unroll") for (int k = 0; k < 2; ++k) dst[m][k] = *(const PG8_LAS bf16x8*)(lds + PG8_SA(b, h) + aoff + m * 2048 + k * 1024); } while (0)
#define PG8_LDB(dst, b, h) do { _Pragma("unroll") for (int n = 0; n < 2; ++n) _Pragma("unroll") for (int k = 0; k < 2; ++k) dst[n][k] = *(const PG8_LAS bf16x8*)(lds + PG8_SB(b, h) + boff + n * 2048 + k * 1024); } while (0)
#define PG8_MMA(ai, bj, At, Bt) do { __builtin_amdgcn_s_setprio(1); _Pragma("unroll") for (int m = 0; m < 4; ++m) _Pragma("unroll") for (int n = 0; n < 2; ++n) _Pragma("unroll") for (int k = 0; k < 2; ++k) \
        acc[ai][bj][m][n] = __builtin_amdgcn_mfma_f32_16x16x32_bf16(Bt[n][k], At[m][k], acc[ai][bj][m][n], 0, 0, 0); __builtin_amdgcn_s_setprio(0); } while (0)
#define PG8_WAIT_V(n) asm volatile("s_waitcnt vmcnt(" #n ")" ::: "memory")
#define PG8_WAIT_L(n) asm volatile("s_waitcnt lgkmcnt(" #n ")" ::: "memory")
#define PG8_BAR __builtin_amdgcn_s_barrier()
#define PG8_SCHED __builtin_amdgcn_sched_barrier(0)
    Unit cur, nxt; int ui = 0;
    if (!S.next(0, cur)) return;
    f32x4 acc[2][2][4][2];
#pragma unroll
    for (int a = 0; a < 2; ++a)
#pragma unroll
        for (int b = 0; b < 2; ++b)
#pragma unroll
            for (int m = 0; m < 4; ++m)
#pragma unroll
                for (int n = 0; n < 2; ++n) acc[a][b][m][n] = (f32x4){0.f, 0.f, 0.f, 0.f};
    bf16x8 At[4][2], B0[2][2], B1[2][2];
    const char* cA = (const char*)g.A + (size_t)cur.pm * tstepA; const char* cB = (const char*)g.Bt + (size_t)cur.pn * tstepB;
    PG8_STAGE(PG8_SB(0, 0), cB, voffB); PG8_STAGE(PG8_SA(0, 0), cA, voffA); PG8_STAGE(PG8_SB(0, 1), cB + hstepB, voffB); PG8_STAGE(PG8_SA(0, 1), cA + hstepA, voffA);
    if (wr == 1) PG8_BAR;
    PG8_WAIT_V(4); PG8_BAR;
    PG8_STAGE(PG8_SB(1, 0), cB + kstep, voffB); PG8_STAGE(PG8_SA(1, 0), cA + kstep, voffA); PG8_STAGE(PG8_SB(1, 1), cB + hstepB + kstep, voffB);
    PG8_WAIT_V(6); PG8_BAR;
    for (;;) {
        const bool has_next = S.next(ui + 1, nxt);
        const char* nA = has_next ? (const char*)g.A + (size_t)nxt.pm * tstepA : cA; const char* nB = has_next ? (const char*)g.Bt + (size_t)nxt.pn * tstepB : cB;
        for (int t = 0; t < nt; t += 2) {
            const bool last = (t == nt - 2);
            const char* a1 = cA + (size_t)(t + 1) * kstep;
            const char* a2 = last ? nA : cA + (size_t)(t + 2) * kstep; const char* b2 = last ? nB : cB + (size_t)(t + 2) * kstep;
            const char* a3 = a2 + kstep; const char* b3 = b2 + kstep;
            PG8_LDB(B0, 0, 0); PG8_SCHED; PG8_LDA(At, 0, 0); PG8_STAGE(PG8_SA(1, 1), a1 + hstepA, voffA);
            PG8_WAIT_L(8); PG8_BAR; PG8_WAIT_L(0); PG8_MMA(0, 0, At, B0); PG8_BAR; PG8_SCHED;
            PG8_LDB(B1, 0, 1); PG8_STAGE(PG8_SB(0, 0), b2, voffB);
            PG8_BAR; PG8_WAIT_L(0); PG8_MMA(0, 1, At, B1); PG8_BAR;
            PG8_LDA(At, 0, 1); PG8_STAGE(PG8_SA(0, 0), a2, voffA);
            PG8_BAR; PG8_WAIT_L(0); PG8_MMA(1, 0, At, B0); PG8_BAR; PG8_SCHED;
            PG8_STAGE(PG8_SB(0, 1), b2 + hstepB, voffB);
            PG8_WAIT_V(6); PG8_BAR; PG8_MMA(1, 1, At, B1); PG8_BAR;
            PG8_LDB(B0, 1, 0); PG8_SCHED; PG8_LDA(At, 1, 0); PG8_STAGE(PG8_SA(0, 1), a2 + hstepA, voffA);
            PG8_WAIT_L(8); PG8_BAR; PG8_WAIT_L(0); PG8_MMA(0, 0, At, B0); PG8_BAR; PG8_SCHED;
            PG8_LDB(B1, 1, 1); PG8_STAGE(PG8_SB(1, 0), b3, voffB);
            PG8_BAR; PG8_WAIT_L(0); PG8_MMA(0, 1, At, B1); PG8_BAR;
            PG8_LDA(At, 1, 1); PG8_STAGE(PG8_SA(1, 0), a3, voffA);
            PG8_BAR; PG8_WAIT_L(0); PG8_MMA(1, 0, At, B0); PG8_BAR; PG8_SCHED;
            PG8_STAGE(PG8_SB(1, 1), b3 + hstepB, voffB);
            PG8_WAIT_V(6); PG8_BAR; PG8_MMA(1, 1, At, B1); PG8_BAR;
        }
        E(acc, cur, wr, wc, fr, fq);
        if (!has_next) break;
#pragma unroll
        for (int a = 0; a < 2; ++a)
#pragma unroll
            for (int b = 0; b < 2; ++b)
#pragma unroll
                for (int m = 0; m < 4; ++m)
#pragma unroll
                    for (int n = 0; n < 2; ++n) acc[a][b][m][n] = (f32x4){0.f, 0.f, 0.f, 0.f};
        cur = nxt; cA = nA; cB = nB; ++ui;
    }
    PG8_WAIT_V(0);
    if (wr == 0) PG8_BAR;
    PG8_BAR;
#undef PG8_SA
#undef PG8_SB
#undef PG8_STAGE
#undef PG8_LDA
#undef PG8_LDB
#undef PG8_MMA
#undef PG8_WAIT_V
#undef PG8_WAIT_L
#undef PG8_BAR
#undef PG8_SCHED
}

typedef float f32x2_g __attribute__((ext_vector_type(2)));
typedef __bf16 bf16x2_g __attribute__((ext_vector_type(2)));
__device__ __forceinline__ unsigned pk2_g(float lo, float hi) { const f32x2_g v = {lo, hi}; return __builtin_bit_cast(unsigned, __builtin_convertvector(v, bf16x2_g)); }
template <int ACT> struct EpiBf16 {
    bf16_t* O; int ldc;
    __device__ __forceinline__ void operator()(const f32x4 (&acc)[2][2][4][2], const Unit& u, int wr, int wc, int fr, int fq) const {
        const int row0 = u.pm * BM + wr * 64 + fr, col0 = u.pn * BM + wc * 32 + 8 * fq;
#pragma unroll
        for (int ai = 0; ai < 2; ++ai)
#pragma unroll
            for (int m = 0; m < 4; ++m) { bf16_t* rowp = O + (size_t)(row0 + ai * HALF + m * 16) * ldc + col0;
#pragma unroll
                for (int bj = 0; bj < 2; ++bj) { f32x4 v0 = acc[ai][bj][m][0], v1 = acc[ai][bj][m][1];
                    if (ACT == 1) { v0.x = v0.x > 0.f ? v0.x * v0.x : 0.f; v0.y = v0.y > 0.f ? v0.y * v0.y : 0.f; v0.z = v0.z > 0.f ? v0.z * v0.z : 0.f; v0.w = v0.w > 0.f ? v0.w * v0.w : 0.f;
                                    v1.x = v1.x > 0.f ? v1.x * v1.x : 0.f; v1.y = v1.y > 0.f ? v1.y * v1.y : 0.f; v1.z = v1.z > 0.f ? v1.z * v1.z : 0.f; v1.w = v1.w > 0.f ? v1.w * v1.w : 0.f; }
                    u32x4 o; o.x = pk2_g(v0.x, v0.y); o.y = pk2_g(v0.z, v0.w); o.z = pk2_g(v1.x, v1.y); o.w = pk2_g(v1.z, v1.w);
                    *(u32x4*)(rowp + bj * HALF) = o; } }
    }
};
}
typedef unsigned short bf16_t;
typedef short bf16x8 __attribute__((ext_vector_type(8)));
typedef float f32x4 __attribute__((ext_vector_type(4)));
typedef unsigned u32x4 __attribute__((ext_vector_type(4)));
typedef unsigned u32x2 __attribute__((ext_vector_type(2)));
#define LAS __attribute__((address_space(3)))

constexpr int NBATCH = 8, SEQL = 4096, DM = 1024, CTXL = 256, TMAIN = 32768, TCTX = 2048, TT = 34816, NP = 3072, FF = 4096;
constexpr int PC_SWAQ = 0, PC_RETQ = 256, PC_RWR = 512, PC_MLAQD = 768, PC_SWAK = 1024, PC_SWAV = 1152, PC_RETK = 1280, PC_RETV = 1536, PC_RETG = 1792,
              PC_RWK = 2048, PC_RWV = 2304, PC_RWWD = 2560, PC_RWAD = 2624, PC_RWGD = 2688, PC_MLAKVD = 2816, PC_MLAKPE = 2944;
constexpr int PC_RWO0 = PC_RWV, PC_RWO1 = PC_RWR;
constexpr int NKEYS = CTXL + SEQL;

constexpr size_t MiB = 1u << 20;
constexpr size_t WS_MOD = 0;
constexpr size_t WS_TAB = 512 * 1024;
constexpr size_t WS_CTR = 768 * 1024;
constexpr size_t WS_BON = 1 * MiB;
constexpr size_t WS_WB = 2 * MiB;
constexpr size_t WB_LAYER = 24 * MiB, WB_IN = 0, WB_OUT = 6 * MiB, WB_W1 = 8 * MiB, WB_W2 = 16 * MiB;
constexpr size_t WS_XC = 50 * MiB;
constexpr size_t WS_P = 58 * MiB;
constexpr size_t WS_HID = 58 * MiB;
constexpr size_t WS_A = 262 * MiB;
constexpr size_t ARR17 = 17 * MiB;
constexpr size_t WS_RWK = WS_A, WS_RWV = WS_A + ARR17, WS_RWRR = WS_A + 2 * ARR17, WS_RWA0 = WS_A + 3 * ARR17, WS_RWA1 = WS_A + 4 * ARR17,
                 WS_RWM0 = WS_A + 5 * ARR17, WS_RWM1 = WS_A + 6 * ARR17;
constexpr size_t WS_RET = WS_A + 119 * MiB;
constexpr size_t WS_MQ = WS_RET + 34 * MiB;
constexpr size_t WS_KM = WS_MQ + 26738688;
constexpr size_t WS_VTM = WS_KM + 26738688;
constexpr size_t WS_KS = WS_VTM + ARR17;
constexpr size_t WS_VTS = WS_KS + 8912896;
constexpr size_t WS_A_END = WS_VTS + 8912896;
constexpr size_t WS_Z = 330 * MiB;
constexpr size_t WS_HB = 398 * MiB;
constexpr size_t WS_MLAW = 500 * MiB;
constexpr size_t MLAW_LAYER = 384 * 256 * 2 + 512 * 128 * 2, MLAW_KV = 384 * 256 * 2;
constexpr size_t WS_GUPT = 501 * MiB;
constexpr size_t WS_LORAT = 502 * MiB;
constexpr size_t WS_NEED = 503 * MiB;
static_assert(WS_A_END <= WS_NEED && WS_HB + 68 * MiB <= WS_NEED && WS_HID + 272 * MiB <= WS_Z, "ws map");

constexpr int LDS_BYTES = 150 * 1024;

struct Params { const float* in[30]; float* out; unsigned char* ws; };

__device__ __forceinline__ float bf2f(bf16_t v) { return __builtin_bit_cast(float, (unsigned)v << 16); }
typedef float f32x2_c __attribute__((ext_vector_type(2)));
typedef __bf16 bf16x2_c __attribute__((ext_vector_type(2)));
__device__ __forceinline__ unsigned pk2(float lo, float hi) { const f32x2_c v = {lo, hi}; return __builtin_bit_cast(unsigned, __builtin_convertvector(v, bf16x2_c)); }
__device__ __forceinline__ bf16_t f2bf(float f) { return (bf16_t)(pk2(f, 0.f) & 0xffffu); }
typedef float f32x2 __attribute__((ext_vector_type(2)));
typedef __bf16 bf16x2_t __attribute__((ext_vector_type(2)));
__device__ __forceinline__ unsigned cvt_pk_bf16(float lo, float hi) { const f32x2 v = {lo, hi}; return __builtin_bit_cast(unsigned, __builtin_convertvector(v, bf16x2_t)); }
template <int CTRL> __device__ __forceinline__ float dppf(float v) { return __builtin_bit_cast(float, __builtin_amdgcn_update_dpp(0, __builtin_bit_cast(int, v), CTRL, 0xF, 0xF, true)); }
__device__ __forceinline__ float red4(float v) { v += dppf<0xB1>(v); v += dppf<0x4E>(v); return v; }
__device__ __forceinline__ float red8(float v) { v = red4(v); v += dppf<0x141>(v); return v; }
__device__ __forceinline__ float red16(float v) { v = red8(v); v += dppf<0x140>(v); return v; }
__device__ __forceinline__ float max16(float v) { v = fmaxf(v, dppf<0xB1>(v)); v = fmaxf(v, dppf<0x4E>(v)); v = fmaxf(v, dppf<0x141>(v)); v = fmaxf(v, dppf<0x140>(v)); return v; }
__device__ __forceinline__ float wave_sum(float v) {
    v = red16(v);
    const int u = __builtin_bit_cast(int, v);
    return __builtin_bit_cast(float, __builtin_amdgcn_readlane(u, 0)) + __builtin_bit_cast(float, __builtin_amdgcn_readlane(u, 16)) +
           __builtin_bit_cast(float, __builtin_amdgcn_readlane(u, 32)) + __builtin_bit_cast(float, __builtin_amdgcn_readlane(u, 48));
}
__device__ __forceinline__ void unpack8(const u32x4 u, float* f) {
    f[0] = bf2f((bf16_t)(u.x & 0xffff)); f[1] = bf2f((bf16_t)(u.x >> 16)); f[2] = bf2f((bf16_t)(u.y & 0xffff)); f[3] = bf2f((bf16_t)(u.y >> 16));
    f[4] = bf2f((bf16_t)(u.z & 0xffff)); f[5] = bf2f((bf16_t)(u.z >> 16)); f[6] = bf2f((bf16_t)(u.w & 0xffff)); f[7] = bf2f((bf16_t)(u.w >> 16));
}
__device__ __forceinline__ float sigmoidf_(float x) { return __builtin_amdgcn_rcpf(1.f + __expf(-x)); }

struct SeqInfo { int b, pos, len, start, isctx; };
__device__ __forceinline__ SeqInfo seq_of_row(int row) {
    SeqInfo s;
    if (row < TMAIN) { s.b = row >> 12; s.pos = row & 4095; s.len = SEQL; s.start = s.b << 12; s.isctx = 0; }
    else { const int r = row - TMAIN; s.b = r >> 8; s.pos = r & 255; s.len = CTXL; s.start = TMAIN + (s.b << 8); s.isctx = 1; }
    return s;
}

__device__ __forceinline__ void transpose_item(const float* W, int N, int nsrc0, bf16_t* WT, int K, int ndst0, int k0, LAS float* scr, int lane) {
    if (nsrc0 >= 0) {
#pragma unroll 32
        for (int i = 0; i < 32; ++i) { const int kk = 2 * i + (lane >> 5); scr[kk * 33 + (lane & 31)] = W[(size_t)(k0 + kk) * N + nsrc0 + (lane & 31)]; }
    } else {
#pragma unroll 8
        for (int i = 0; i < 32; ++i) { const int kk = 2 * i + (lane >> 5); scr[kk * 33 + (lane & 31)] = 0.f; }
    }
    __builtin_amdgcn_wave_barrier(); asm volatile("s_waitcnt lgkmcnt(0)" ::: "memory");
    const int c = lane & 7;
#pragma unroll
    for (int j = 0; j < 4; ++j) { const int n = (lane >> 3) + 8 * j; const LAS float* s = scr + (8 * c) * 33 + n;
        u32x4 o; o.x = pk2(s[0 * 33], s[1 * 33]); o.y = pk2(s[2 * 33], s[3 * 33]); o.z = pk2(s[4 * 33], s[5 * 33]); o.w = pk2(s[6 * 33], s[7 * 33]);
        *(u32x4*)(WT + (size_t)(ndst0 + n) * K + k0 + 8 * c) = o; }
    __builtin_amdgcn_wave_barrier(); asm volatile("s_waitcnt lgkmcnt(0)" ::: "memory");
}
__device__ __forceinline__ int win_src_col(int n) {
    if (n < 256) return n;
    if (n < 512) return 512 + (n - 256);
    if (n < 768) return 1536 + (n - 512);
    if (n < 1024) return 2560 + (n - 768);
    if (n < 1280) return 256 + (n - 1024);
    if (n < 2048) return 768 + (n - 1280);
    if (n < 2816) return 1792 + (n - 2048);
    if (n < 2976) return n;
    return -1;
}
__device__ __forceinline__ void phase_prologue(const Params& p, LAS unsigned char* lds, int bid, int nb) {
    const int tid = get_tid(), lane = tid & 63, wave = tid >> 6;
    LAS float* scr = (LAS float*)(lds + wave * 16384);
    const int gw = bid * 8 + wave, NGW = nb * 8;
    constexpr int I_IN = 16 * 96, I_OUT = 16 * 32, I_1 = 16 * 128, I_2 = 64 * 32, I_Q = 4 * 12, I_KV = 2 * 16, I_G = 2 * 8, I_LO = 4 * 8, I_L = I_IN + I_OUT + I_1 + I_2 + I_Q + I_KV + I_G + I_LO;
    for (int it = gw; it < 2 * I_L; it += NGW) {
        const int l = it / I_L; int r = it % I_L;
        unsigned char* wb = p.ws + WS_WB + (size_t)l * WB_LAYER;
        if (r < I_IN) { const int kb = r / 96, nbk = r % 96; transpose_item(p.in[10] + (size_t)l * DM * 2976, 2976, win_src_col(nbk * 32), (bf16_t*)(wb + WB_IN), DM, nbk * 32, kb * 64, scr, lane); continue; } r -= I_IN;
        if (r < I_OUT) { const int kb = r / 32, nbk = r % 32; transpose_item(p.in[11] + (size_t)l * DM * DM, DM, nbk * 32, (bf16_t*)(wb + WB_OUT), DM, nbk * 32, kb * 64, scr, lane); continue; } r -= I_OUT;
        if (r < I_1) { const int kb = r / 128, nbk = r % 128; transpose_item(p.in[28] + (size_t)l * DM * FF, FF, nbk * 32, (bf16_t*)(wb + WB_W1), DM, nbk * 32, kb * 64, scr, lane); continue; } r -= I_1;
        if (r < I_2) { const int kb = r / 32, nbk = r % 32; transpose_item(p.in[29] + (size_t)l * FF * DM, DM, nbk * 32, (bf16_t*)(wb + WB_W2), FF, nbk * 32, kb * 64, scr, lane); continue; } r -= I_2;
        unsigned char* mw = p.ws + WS_MLAW + (size_t)l * MLAW_LAYER;
        if (r < I_Q) { const int kb = r / 12, nbk = r % 12; transpose_item(p.in[25] + (size_t)l * 256 * 384, 384, nbk * 32, (bf16_t*)mw, 256, nbk * 32, kb * 64, scr, lane); continue; } r -= I_Q;
        if (r < I_KV) { const int kb = r / 16, nbk = r % 16; transpose_item(p.in[27] + (size_t)l * 128 * 512, 512, nbk * 32, (bf16_t*)(mw + MLAW_KV), 128, nbk * 32, kb * 64, scr, lane); continue; } r -= I_KV;
        if (r < I_G) { const int kb = r / 8, nbk = r % 8; transpose_item(p.in[19] + (size_t)l * 128 * 256, 256, nbk * 32, (bf16_t*)(p.ws + WS_GUPT + (size_t)l * 256 * 128 * 2), 128, nbk * 32, kb * 64, scr, lane); continue; } r -= I_G;
        { const int m = r / 8, nbk = r % 8; const float* src = (m < 2 ? p.in[16] : p.in[18]) + ((size_t)l * 2 + (m & 1)) * 64 * 256;
          transpose_item(src, 256, nbk * 32, (bf16_t*)(p.ws + WS_LORAT + ((size_t)l * 4 + m) * 256 * 64 * 2), 64, nbk * 32, 0, scr, lane); }
    }
    __syncthreads();
    for (int it = bid; it < 192; it += nb) {
        const int l = it / 96, cb = it % 96;
        LAS float* sc = (LAS float*)lds;
        LAS float* red = sc + 9 * 1024;
        for (int e = tid; e < 9 * 1024; e += 512) { const int r = e >> 10, k = e & 1023; const float v = (r < 8) ? p.in[1][r * 1024 + k] : p.in[3][k]; sc[e] = v / (1.f + __expf(-v)); }
        __syncthreads();
        const int ks = tid >> 6, cl = tid & 63, n = cb * 64 + cl;
        float acc[9];
#pragma unroll
        for (int r = 0; r < 9; ++r) acc[r] = 0.f;
        const float* aw = p.in[4] + (size_t)l * DM * 6144;
#pragma unroll 16
        for (int k = ks * 128; k < ks * 128 + 128; ++k) { const float w = aw[(size_t)k * 6144 + n];
#pragma unroll
            for (int r = 0; r < 9; ++r) acc[r] += sc[r * 1024 + k] * w; }
#pragma unroll
        for (int r = 0; r < 9; ++r) red[(ks * 9 + r) * 64 + cl] = acc[r];
        __syncthreads();
        for (int e = tid; e < 9 * 64; e += 512) { const int r = e >> 6, c2 = e & 63; float s = 0.f;
            for (int q = 0; q < 8; ++q) s += red[(q * 9 + r) * 64 + c2];
            ((float*)(p.ws + WS_MOD))[((size_t)l * 9 + r) * 6144 + cb * 64 + c2] = s + p.in[5][(size_t)l * 6144 + cb * 64 + c2]; }
        __syncthreads();
    }
    if (bid == 0 && tid < 4) ((unsigned*)(p.ws + WS_CTR))[tid] = 0u;
    if (bid == nb - 1) {
        float* tab = (float*)(p.ws + WS_TAB);
        for (int e = tid; e < 64 * 16; e += 512) { const int pos = e >> 4, f = e & 15; const float inv = powf(10000.f, -(float)(2 * f) / 32.f); const float a = (float)pos * inv; tab[e] = cosf(a); tab[1024 + e] = sinf(a); }
        for (int e = tid; e < 64 * 8; e += 512) { const int pos = e >> 3, f = e & 7; const float inv = powf(10000.f, -(float)(2 * f) / 16.f); const float a = (float)pos * inv; tab[2048 + e] = cosf(a); tab[2560 + e] = sinf(a); }
    }
}

struct RowJob { const float* xsrc; const bf16_t* z; const float* gpost; const float* gate; float* xdst; const float* gpre; const float* shift; const float* scale; bf16_t* hdst; };
__device__ __forceinline__ RowJob make_rowjob(const Params& p, int mode, int l, int row) {
    const float* mod = (const float*)(p.ws + WS_MOD);
    bf16_t* HB = (bf16_t*)(p.ws + WS_HB); const bf16_t* Z = (const bf16_t*)(p.ws + WS_Z);
    float* XC = (float*)(p.ws + WS_XC);
    const SeqInfo s = seq_of_row(row);
    const int mr = s.isctx ? 8 : s.b;
    const float* m_l = mod + ((size_t)l * 9 + mr) * 6144;
    float* xs = s.isctx ? XC + (size_t)(row - TMAIN) * DM : p.out + (size_t)row * DM;
    const float* xin = s.isctx ? p.in[2] + (size_t)(row - TMAIN) * DM : p.in[0] + (size_t)row * DM;
    RowJob j;
    if (mode == 0) { j = RowJob{xin, nullptr, nullptr, nullptr, nullptr, p.in[6] + l * DM, m_l + 0, m_l + 1024, HB + (size_t)row * DM}; }
    else if (mode == 1) { j = RowJob{l == 0 ? xin : xs, Z + (size_t)row * DM, p.in[7] + l * DM, m_l + 2048, xs, p.in[8] + l * DM, m_l + 3072, m_l + 4096, HB + (size_t)row * DM}; }
    else { const bool has_next = (l + 1 < 2); const float* m_n = mod + ((size_t)(has_next ? l + 1 : l) * 9 + mr) * 6144;
        j = RowJob{xs, Z + (size_t)row * DM, p.in[9] + l * DM, m_l + 5120, xs, p.in[6] + (has_next ? l + 1 : l) * DM, m_n + 0, m_n + 1024, has_next ? HB + (size_t)row * DM : nullptr}; }
    return j;
}
template <int RB>
__device__ __forceinline__ void rowop_batch(const RowJob (&jb)[RB], const bool (&valid)[RB], int lane) {
    f32x4 v[RB][4]; u32x2 zu[RB][4];
#pragma unroll
    for (int r = 0; r < RB; ++r) if (valid[r]) {
#pragma unroll
        for (int j = 0; j < 4; ++j) { v[r][j] = *(const f32x4*)(jb[r].xsrc + (j * 64 + lane) * 4); if (jb[r].z) zu[r][j] = *(const u32x2*)(jb[r].z + (j * 64 + lane) * 4); }
    }
#pragma unroll
    for (int r = 0; r < RB; ++r) if (valid[r]) {
        const RowJob& J = jb[r];
        if (J.z) {
            f32x4 zz[4], gp[4], gt[4]; float ss = 0.f;
#pragma unroll
            for (int j = 0; j < 4; ++j) { const int c = (j * 64 + lane) * 4; gp[j] = *(const f32x4*)(J.gpost + c); gt[j] = *(const f32x4*)(J.gate + c); }
#pragma unroll
            for (int j = 0; j < 4; ++j) { const u32x2 u = zu[r][j];
                zz[j].x = bf2f((bf16_t)(u.x & 0xffff)); zz[j].y = bf2f((bf16_t)(u.x >> 16)); zz[j].z = bf2f((bf16_t)(u.y & 0xffff)); zz[j].w = bf2f((bf16_t)(u.y >> 16));
                ss += zz[j].x * zz[j].x + zz[j].y * zz[j].y + zz[j].z * zz[j].z + zz[j].w * zz[j].w; }
            const float rinv = 1.f / sqrtf(wave_sum(ss) * (1.f / 1024.f) + 1e-6f);
#pragma unroll
            for (int j = 0; j < 4; ++j) { const int c = (j * 64 + lane) * 4;
                v[r][j].x += gt[j].x * (zz[j].x * rinv * gp[j].x); v[r][j].y += gt[j].y * (zz[j].y * rinv * gp[j].y); v[r][j].z += gt[j].z * (zz[j].z * rinv * gp[j].z); v[r][j].w += gt[j].w * (zz[j].w * rinv * gp[j].w);
                *(f32x4*)(J.xdst + c) = v[r][j]; }
        }
        if (J.hdst) {
            f32x4 g[4], sh[4], sc[4]; float ss = 0.f;
#pragma unroll
            for (int j = 0; j < 4; ++j) { const int c = (j * 64 + lane) * 4; g[j] = *(const f32x4*)(J.gpre + c); sh[j] = *(const f32x4*)(J.shift + c); sc[j] = *(const f32x4*)(J.scale + c); }
#pragma unroll
            for (int j = 0; j < 4; ++j) ss += v[r][j].x * v[r][j].x + v[r][j].y * v[r][j].y + v[r][j].z * v[r][j].z + v[r][j].w * v[r][j].w;
            const float rinv = 1.f / sqrtf(wave_sum(ss) * (1.f / 1024.f) + 1e-6f);
#pragma unroll
            for (int j = 0; j < 4; ++j) { const int c = (j * 64 + lane) * 4;
                u32x2 o; o.x = pk2(v[r][j].x * rinv * g[j].x * (1.f + sc[j].x) + sh[j].x, v[r][j].y * rinv * g[j].y * (1.f + sc[j].y) + sh[j].y);
                o.y = pk2(v[r][j].z * rinv * g[j].z * (1.f + sc[j].z) + sh[j].z, v[r][j].w * rinv * g[j].w * (1.f + sc[j].w) + sh[j].w);
                *(u32x2*)(J.hdst + c) = o; }
        }
    }
}
__device__ __forceinline__ void phase_rowops(const Params& p, int mode, int l, int nrows, int bid, int nb) {
    const int tid = get_tid(), lane = tid & 63, wave = tid >> 6;
    constexpr int RB = 4;
    const int nwaves = nb * 8, gw = bid * 8 + wave;
    for (int base = gw; base < nrows; base += nwaves * RB) {
        RowJob jb[RB]; bool valid[RB];
#pragma unroll
        for (int r = 0; r < RB; ++r) { const int row = base + r * nwaves; valid[r] = row < nrows; jb[r] = make_rowjob(p, mode, l, valid[r] ? row : 0); }
        rowop_batch<RB>(jb, valid, lane);
    }
}

__device__ __forceinline__ void rwkv_prep_item(const Params& p, int l, LAS unsigned char* lds, int tile) {
    const int tid = get_tid(), lane = tid & 63, wave = tid >> 6, fr = lane & 15, fq = lane >> 4;
    const bf16_t* P = (const bf16_t*)(p.ws + WS_P);
    const int t0 = tile * 32; const SeqInfo s0 = seq_of_row(t0);
    const float* mu = p.in[14] + l * 1024;
    LAS bf16_t* r_s = (LAS bf16_t*)lds;
    LAS bf16_t* k_s = r_s + 32 * 256;
    LAS bf16_t* v_s = k_s + 32 * 256;
    LAS unsigned char* twd = lds + 3 * 16384;
    LAS unsigned char* ads = twd + 32 * 144;
    LAS float* O1 = (LAS float*)(ads + 32 * 144);
#pragma unroll
    for (int it = 0; it < 7; ++it) {
        const int pc = tid + it * 512; const int tok = pc / 112, c8 = pc % 112, cc = c8 * 8;
        const int pcol = cc < 256 ? PC_RWR + cc : PC_RWK + (cc - 256);
        const int row = t0 + tok, pos = s0.pos + tok;
        const u32x4 u0 = *(const u32x4*)(P + (size_t)row * NP + pcol);
        const u32x4 um = pos > 0 ? *(const u32x4*)(P + (size_t)(row - 1) * NP + pcol) : (u32x4){0u, 0u, 0u, 0u};
        const u32x4 up = pos < s0.len - 1 ? *(const u32x4*)(P + (size_t)(row + 1) * NP + pcol) : (u32x4){0u, 0u, 0u, 0u};
        const f32x4 mu0 = *(const f32x4*)(mu + cc), mu1 = *(const f32x4*)(mu + cc + 4);
        float z0[8], zm[8], zp[8], zs[8]; unpack8(u0, z0); unpack8(um, zm); unpack8(up, zp);
        const float mm[8] = {mu0.x, mu0.y, mu0.z, mu0.w, mu1.x, mu1.y, mu1.z, mu1.w};
#pragma unroll
        for (int x = 0; x < 8; ++x) zs[x] = z0[x] + mm[x] * (0.5f * (zm[x] + zp[x]) - z0[x]);
        LAS unsigned char* dst;
        if (cc < 256) dst = (LAS unsigned char*)(r_s + tok * 256 + cc);
        else if (cc < 512) dst = (LAS unsigned char*)(k_s + tok * 256 + cc - 256);
        else if (cc < 768) dst = (LAS unsigned char*)(v_s + tok * 256 + cc - 512);
        else if (cc < 832) { dst = twd + tok * 144 + (cc - 768) * 2;
#pragma unroll
            for (int x = 0; x < 8; ++x) zs[x] = 1.f - 2.f * __builtin_amdgcn_rcpf(1.f + __expf(2.f * zs[x])); }
        else dst = ads + tok * 144 + (cc - 832) * 2;
        *(LAS u32x4*)dst = (u32x4){cvt_pk_bf16(zs[0], zs[1]), cvt_pk_bf16(zs[2], zs[3]), cvt_pk_bf16(zs[4], zs[5]), cvt_pk_bf16(zs[6], zs[7])};
    }
    __syncthreads();
    const int hh = tid >> 8, c = tid & 255, h = c >> 6;
    bf16_t* RK = (bf16_t*)(p.ws + WS_RWK); bf16_t* RV = (bf16_t*)(p.ws + WS_RWV); bf16_t* RR = (bf16_t*)(p.ws + WS_RWRR);
    bf16_t* RA0 = (bf16_t*)(p.ws + WS_RWA0); bf16_t* RA1 = (bf16_t*)(p.ws + WS_RWA1); bf16_t* RM0 = (bf16_t*)(p.ws + WS_RWM0); bf16_t* RM1 = (bf16_t*)(p.ws + WS_RWM1);
    float* BON = (float*)(p.ws + WS_BON);
#pragma unroll
    for (int pass = 0; pass < 2; ++pass) {
        { const bf16_t* WT = (const bf16_t*)(p.ws + WS_LORAT + ((size_t)l * 4 + pass * 2) * 256 * 64 * 2);
          LAS unsigned char* A = pass ? ads : twd;
          const bf16x8 x00 = *(const LAS bf16x8*)(A + fr * 144 + fq * 16), x01 = *(const LAS bf16x8*)(A + fr * 144 + 64 + fq * 16);
          const bf16x8 x10 = *(const LAS bf16x8*)(A + (16 + fr) * 144 + fq * 16), x11 = *(const LAS bf16x8*)(A + (16 + fr) * 144 + 64 + fq * 16);
          bf16x8 b0[4], b1[4];
#pragma unroll
          for (int q = 0; q < 4; ++q) { const int t = wave * 4 + q, m = t >> 4, nt = t & 15; const bf16_t* wrow = WT + (size_t)m * 256 * 64 + (size_t)(nt * 16 + fr) * 64 + fq * 8;
              b0[q] = *(const bf16x8*)wrow; b1[q] = *(const bf16x8*)(wrow + 32); }
#pragma unroll
          for (int q = 0; q < 4; ++q) { const int t = wave * 4 + q, m = t >> 4, nt = t & 15;
              f32x4 a0 = (f32x4){0.f, 0.f, 0.f, 0.f}, a1 = a0;
              a0 = __builtin_amdgcn_mfma_f32_16x16x32_bf16(x00, b0[q], a0, 0, 0, 0); a0 = __builtin_amdgcn_mfma_f32_16x16x32_bf16(x01, b1[q], a0, 0, 0, 0);
              a1 = __builtin_amdgcn_mfma_f32_16x16x32_bf16(x10, b0[q], a1, 0, 0, 0); a1 = __builtin_amdgcn_mfma_f32_16x16x32_bf16(x11, b1[q], a1, 0, 0, 0);
#pragma unroll
              for (int r = 0; r < 4; ++r) { O1[(m * 32 + fq * 4 + r) * 256 + nt * 16 + fr] = a0[r]; O1[(m * 32 + 16 + fq * 4 + r) * 256 + nt * 16 + fr] = a1[r]; } } }
        __syncthreads();
        if (pass == 0) {
            const float w0b0 = p.in[15][(l * 2 + 0) * 256 + c], w0b1 = p.in[15][(l * 2 + 1) * 256 + c];
#pragma unroll
            for (int i = 0; i < 16; ++i) { const int tok = hh * 16 + i; const size_t o = (size_t)(t0 + tok) * 256 + c;
                const float sg0 = sigmoidf_(w0b0 + O1[tok * 256 + c]), sg1 = sigmoidf_(w0b1 + O1[(32 + tok) * 256 + c]);
                RM0[o] = f2bf(1.f - __expf(-0.60653066f * sg0)); RM1[o] = f2bf(1.f - __expf(-0.60653066f * sg1)); }
        } else {
            const float a0b0 = p.in[17][(l * 2 + 0) * 256 + c], a0b1 = p.in[17][(l * 2 + 1) * 256 + c];
            const float ka = p.in[21][l * 256 + c], rk = p.in[22][l * 256 + c];
#pragma unroll
            for (int i = 0; i < 16; ++i) { const int tok = hh * 16 + i, row = t0 + tok; const size_t o = (size_t)row * 256 + c;
                const bf16_t kb = k_s[tok * 256 + c], vb = v_s[tok * 256 + c], rb = r_s[tok * 256 + c];
                const float k = bf2f(kb), r = bf2f(rb);
                const float a0 = sigmoidf_(a0b0 + O1[tok * 256 + c]), a1 = sigmoidf_(a0b1 + O1[(32 + tok) * 256 + c]);
                const float kt0 = k * (1.f + (a0 - 1.f) * ka), kt1 = k * (1.f + (a1 - 1.f) * ka);
                const float bs = wave_sum(r * (kt0 + kt1) * rk);
                RK[o] = kb; RV[o] = vb; RR[o] = rb; RA0[o] = f2bf(a0); RA1[o] = f2bf(a1);
                if ((tid & 63) == 0) BON[(size_t)row * 4 + h] = bs; }
        }
        __syncthreads();
    }
}
__device__ __forceinline__ int ret_chunk_index(int cr, int& b) { if (cr < 256) { b = cr >> 5; return 2 + (cr & 31); } b = (cr - 256) >> 1; return (cr - 256) & 1; }
__device__ __forceinline__ void ret_kv_item(const Params& p, LAS unsigned char* lds, int item) {
    const int tid = get_tid(), lane = tid & 63, wave = tid >> 6, fr = lane & 15, fq = lane >> 4;
    const bf16_t* P = (const bf16_t*)(p.ws + WS_P);
    const int cr = item >> 2, h = item & 3; int b; const int ci = ret_chunk_index(cr, b);
    const int r0 = cr * 128;
    LAS unsigned char* Ktf = lds;
    LAS unsigned char* Ktb = lds + 64 * 272;
    LAS unsigned char* Vt = lds + 2 * 64 * 272;
    const float lg2 = log1pf(-exp2f(-5.f - (float)h)) * 1.44269504f;
#pragma unroll
    for (int it = 0; it < 2; ++it) { const int pc = tid + it * 512, j = pc >> 3, c8 = pc & 7;
        const u32x4 kk = *(const u32x4*)(P + (size_t)(r0 + j) * NP + PC_RETK + h * 64 + c8 * 8);
        const u32x4 vv = *(const u32x4*)(P + (size_t)(r0 + j) * NP + PC_RETV + h * 64 + c8 * 8);
        float kf[8]; unpack8(kk, kf);
        const float df = 0.125f * __builtin_amdgcn_exp2f((float)(127 - j) * lg2), db = 0.125f * __builtin_amdgcn_exp2f((float)j * lg2);
        const unsigned vw[4] = {vv.x, vv.y, vv.z, vv.w};
#pragma unroll
        for (int x = 0; x < 8; ++x) { const int d = c8 * 8 + x;
            *(LAS bf16_t*)(Ktf + d * 272 + j * 2) = f2bf(kf[x] * df); *(LAS bf16_t*)(Ktb + d * 272 + j * 2) = f2bf(kf[x] * db);
            *(LAS bf16_t*)(Vt + d * 272 + j * 2) = (bf16_t)((x & 1) ? (vw[x >> 1] >> 16) : (vw[x >> 1] & 0xffff)); } }
    __syncthreads();
    const int dir = wave >> 2, mt = wave & 3;
    LAS unsigned char* A = dir ? Ktb : Ktf;
    bf16x8 af[4];
#pragma unroll
    for (int kc = 0; kc < 4; ++kc) af[kc] = *(const LAS bf16x8*)(A + (mt * 16 + fr) * 272 + kc * 64 + fq * 16);
    float* RS = (float*)(p.ws + WS_RET) + ((size_t)((b * 4 + h) * 34 + ci) * 2 + dir) * 4096;
#pragma unroll
    for (int nt = 0; nt < 4; ++nt) { f32x4 acc = (f32x4){0.f, 0.f, 0.f, 0.f};
#pragma unroll
        for (int kc = 0; kc < 4; ++kc) { const bf16x8 bf = *(const LAS bf16x8*)(Vt + (nt * 16 + fr) * 272 + kc * 64 + fq * 16);
            acc = __builtin_amdgcn_mfma_f32_16x16x32_bf16(af[kc], bf, acc, 0, 0, 0); }
#pragma unroll
        for (int r = 0; r < 4; ++r) RS[(mt * 16 + fq * 4 + r) * 64 + nt * 16 + fr] = acc[r]; }
    __syncthreads();
}
__device__ __forceinline__ void swa_prep_item(const Params& p, LAS unsigned char* lds, int tile) {
    const int tid = get_tid();
    bf16_t* P = (bf16_t*)(p.ws + WS_P);
    const float* tabc = (const float*)(p.ws + WS_TAB); const float* tabs = tabc + 1024;
    bf16_t* KS = (bf16_t*)(p.ws + WS_KS); bf16_t* VT = (bf16_t*)(p.ws + WS_VTS);
    const int t0 = tile * 64; const SeqInfo s0 = seq_of_row(t0);
    const int key0 = s0.isctx ? s0.pos : CTXL + s0.pos;
    LAS bf16_t* Vs = (LAS bf16_t*)lds;
    u32x4 vreg[2];
#pragma unroll
    for (int it = 0; it < 2; ++it) { const int pc = tid + it * 512, tok = pc >> 4, c8 = pc & 15; vreg[it] = *(const u32x4*)(P + (size_t)(t0 + tok) * NP + PC_SWAV + c8 * 8); }
    u32x4 x1[3], x2[3];
#pragma unroll
    for (int it = 0; it < 3; ++it) { const int e = tid + it * 512; const int tok = e / 24, rem = e % 24, hd = rem >> 2, axis = (rem >> 1) & 1, fg = rem & 1;
        const int colbase = (hd < 4 ? PC_SWAQ + hd * 64 : PC_SWAK + (hd - 4) * 64) + axis * 32 + fg * 8;
        x1[it] = *(const u32x4*)(P + (size_t)(t0 + tok) * NP + colbase); x2[it] = *(const u32x4*)(P + (size_t)(t0 + tok) * NP + colbase + 16); }
#pragma unroll
    for (int it = 0; it < 2; ++it) { const int pc = tid + it * 512, tok = pc >> 4, c8 = pc & 15; *(LAS u32x4*)(Vs + tok * 136 + c8 * 8) = vreg[it]; }
#pragma unroll
    for (int it = 0; it < 3; ++it) { const int e = tid + it * 512; const int tok = e / 24, rem = e % 24, hd = rem >> 2, axis = (rem >> 1) & 1, fg = rem & 1;
        const int row = t0 + tok, pos = s0.pos + tok;
        const int colbase = (hd < 4 ? PC_SWAQ + hd * 64 : PC_SWAK + (hd - 4) * 64) + axis * 32 + fg * 8;
        float a[8], bb[8]; unpack8(x1[it], a); unpack8(x2[it], bb);
        if (!s0.isctx) { const int pp = axis == 0 ? (pos >> 6) : (pos & 63);
            const f32x4 c0 = *(const f32x4*)(tabc + pp * 16 + fg * 8), c1 = *(const f32x4*)(tabc + pp * 16 + fg * 8 + 4), s0v = *(const f32x4*)(tabs + pp * 16 + fg * 8), s1v = *(const f32x4*)(tabs + pp * 16 + fg * 8 + 4);
            const float cs[8] = {c0.x, c0.y, c0.z, c0.w, c1.x, c1.y, c1.z, c1.w}, sn[8] = {s0v.x, s0v.y, s0v.z, s0v.w, s1v.x, s1v.y, s1v.z, s1v.w};
#pragma unroll
            for (int x = 0; x < 8; ++x) { const float y1 = a[x] * cs[x] - bb[x] * sn[x], y2 = bb[x] * cs[x] + a[x] * sn[x]; a[x] = y1; bb[x] = y2; } }
        u32x4 o1, o2; o1.x = pk2(a[0], a[1]); o1.y = pk2(a[2], a[3]); o1.z = pk2(a[4], a[5]); o1.w = pk2(a[6], a[7]);
        o2.x = pk2(bb[0], bb[1]); o2.y = pk2(bb[2], bb[3]); o2.z = pk2(bb[4], bb[5]); o2.w = pk2(bb[6], bb[7]);
        if (hd < 4) { if (!s0.isctx) { *(u32x4*)(P + (size_t)row * NP + colbase) = o1; *(u32x4*)(P + (size_t)row * NP + colbase + 16) = o2; } }
        else { bf16_t* kd = KS + ((size_t)(s0.b * 2 + (hd - 4)) * NKEYS + key0 + tok) * 64 + axis * 32 + fg * 8; *(u32x4*)kd = o1; *(u32x4*)(kd + 16) = o2; }
    }
    __syncthreads();
#pragma unroll
    for (int it = 0; it < 2; ++it) { const int pc = tid + it * 512, hd = pc >> 3, k8 = pc & 7, hk = hd >> 6, d = hd & 63;
        unsigned w[4];
#pragma unroll
        for (int x = 0; x < 4; ++x) w[x] = (unsigned)Vs[(k8 * 8 + 2 * x) * 136 + hd] | ((unsigned)Vs[(k8 * 8 + 2 * x + 1) * 136 + hd] << 16);
        *(u32x4*)(VT + ((size_t)(s0.b * 2 + hk) * 64 + d) * NKEYS + key0 + k8 * 8) = (u32x4){w[0], w[1], w[2], w[3]}; }
    __syncthreads();
}
__device__ __forceinline__ void mla_proj_item(const Params& p, int l, LAS unsigned char* lds, int tile);
__device__ __forceinline__ void phase_prepA(const Params& p, int l, LAS unsigned char* lds, int bid, int nb) {
    for (int it = bid; it < TT / 32; it += nb) rwkv_prep_item(p, l, lds, it);
}
__device__ __forceinline__ void prep_rest_items(const Params& p, int l, LAS unsigned char* lds, int first, int stride) {
    constexpr int N2 = 272 * 4, N3 = TT / 64, N4 = TT / 32;
    for (int it = first; it < N2 + N3 + N4; it += stride) {
        if (it < N4) mla_proj_item(p, l, lds, it);
        else if (it < N4 + N2) ret_kv_item(p, lds, it - N4);
        else swa_prep_item(p, lds, it - N4 - N2);
    }
}

__device__ __forceinline__ void mla_proj_item(const Params& p, int l, LAS unsigned char* lds, int tile) {
    const int tid = get_tid(), lane = tid & 63, wave = tid >> 6, fr = lane & 15, fq = lane >> 4;
    const bf16_t* P = (const bf16_t*)(p.ws + WS_P);
    const float* tabc = (const float*)(p.ws + WS_TAB) + 2048; const float* tabs = tabc + 512;
    const int t0 = tile * 32; const SeqInfo s0 = seq_of_row(t0);
    const int key0 = s0.isctx ? s0.pos : CTXL + s0.pos;
    LAS unsigned char* qn = lds;
    LAS unsigned char* kvn = lds + 32 * 528;
    LAS float* qo = (LAS float*)(lds + 32 * 528 + 32 * 272);
    LAS float* kvo = qo + 32 * 384;
    const float* qg = p.in[24] + l * 256; const float* kvg = p.in[26] + l * 128;
    for (int i = 0; i < 4; ++i) { const int tok = wave * 4 + i, row = t0 + tok;
        float x[4]; float ss = 0.f;
#pragma unroll
        for (int j = 0; j < 4; ++j) { x[j] = bf2f(P[(size_t)row * NP + PC_MLAQD + j * 64 + lane]); ss += x[j] * x[j]; }
        const float rq = 1.f / sqrtf(wave_sum(ss) * (1.f / 256.f) + 1e-6f);
#pragma unroll
        for (int j = 0; j < 4; ++j) *(LAS bf16_t*)(qn + tok * 528 + (j * 64 + lane) * 2) = f2bf(x[j] * rq * qg[j * 64 + lane]);
        float y[2]; float s2 = 0.f;
#pragma unroll
        for (int j = 0; j < 2; ++j) { y[j] = bf2f(P[(size_t)row * NP + PC_MLAKVD + j * 64 + lane]); s2 += y[j] * y[j]; }
        const float rk = 1.f / sqrtf(wave_sum(s2) * (1.f / 128.f) + 1e-6f);
#pragma unroll
        for (int j = 0; j < 2; ++j) *(LAS bf16_t*)(kvn + tok * 272 + (j * 64 + lane) * 2) = f2bf(y[j] * rk * kvg[j * 64 + lane]);
    }
    __syncthreads();
    {
        const bf16_t* WqT = (const bf16_t*)(p.ws + WS_MLAW + (size_t)l * MLAW_LAYER);
        const bf16_t* WkvT = (const bf16_t*)(p.ws + WS_MLAW + (size_t)l * MLAW_LAYER + MLAW_KV);
        {
            bf16x8 bq[3][8];
#pragma unroll
            for (int q = 0; q < 3; ++q) { const bf16_t* wrow = WqT + (size_t)((wave + 8 * q) * 16 + fr) * 256 + fq * 8;
#pragma unroll
                for (int kc = 0; kc < 8; ++kc) bq[q][kc] = *(const bf16x8*)(wrow + kc * 32); }
#pragma unroll
            for (int q = 0; q < 3; ++q) { const int nt = wave + 8 * q;
                f32x4 a0 = (f32x4){0.f, 0.f, 0.f, 0.f}, a1 = a0;
#pragma unroll
                for (int kc = 0; kc < 8; ++kc) { const bf16x8 x0 = *(const LAS bf16x8*)(qn + fr * 528 + kc * 64 + fq * 16), x1 = *(const LAS bf16x8*)(qn + (16 + fr) * 528 + kc * 64 + fq * 16);
                    a0 = __builtin_amdgcn_mfma_f32_16x16x32_bf16(x0, bq[q][kc], a0, 0, 0, 0); a1 = __builtin_amdgcn_mfma_f32_16x16x32_bf16(x1, bq[q][kc], a1, 0, 0, 0); }
#pragma unroll
                for (int r = 0; r < 4; ++r) { qo[(fq * 4 + r) * 384 + nt * 16 + fr] = a0[r]; qo[(16 + fq * 4 + r) * 384 + nt * 16 + fr] = a1[r]; } }
        }
        {
            bf16x8 bk[4][4];
#pragma unroll
            for (int q = 0; q < 4; ++q) { const bf16_t* wrow = WkvT + (size_t)((wave + 8 * q) * 16 + fr) * 128 + fq * 8;
#pragma unroll
                for (int kc = 0; kc < 4; ++kc) bk[q][kc] = *(const bf16x8*)(wrow + kc * 32); }
#pragma unroll
            for (int q = 0; q < 4; ++q) { const int n0 = (wave + 8 * q) * 16;
                f32x4 a0 = (f32x4){0.f, 0.f, 0.f, 0.f}, a1 = a0;
#pragma unroll
                for (int kc = 0; kc < 4; ++kc) { const bf16x8 x0 = *(const LAS bf16x8*)(kvn + fr * 272 + kc * 64 + fq * 16), x1 = *(const LAS bf16x8*)(kvn + (16 + fr) * 272 + kc * 64 + fq * 16);
                    a0 = __builtin_amdgcn_mfma_f32_16x16x32_bf16(x0, bk[q][kc], a0, 0, 0, 0); a1 = __builtin_amdgcn_mfma_f32_16x16x32_bf16(x1, bk[q][kc], a1, 0, 0, 0); }
#pragma unroll
                for (int r = 0; r < 4; ++r) { kvo[(fq * 4 + r) * 512 + n0 + fr] = a0[r]; kvo[(16 + fq * 4 + r) * 512 + n0 + fr] = a1[r]; } }
        }
    }
    __syncthreads();
    {
        const int h = tid >> 7, dd = tid & 127;
        if (dd < 64) { bf16_t* KM = (bf16_t*)(p.ws + WS_KM) + ((size_t)(s0.b * 4 + h) * NKEYS + key0) * 96 + dd;
#pragma unroll
            for (int i = 0; i < 32; ++i) KM[(size_t)i * 96] = f2bf(kvo[i * 512 + tid]); }
        else { bf16_t* VT = (bf16_t*)(p.ws + WS_VTM) + ((size_t)(s0.b * 4 + h) * 64 + (dd - 64)) * NKEYS + key0;
            unsigned w[16];
#pragma unroll
            for (int i = 0; i < 16; ++i) w[i] = pk2(kvo[(2 * i) * 512 + tid], kvo[(2 * i + 1) * 512 + tid]);
#pragma unroll
            for (int i = 0; i < 4; ++i) *(u32x4*)(VT + i * 8) = (u32x4){w[4 * i], w[4 * i + 1], w[4 * i + 2], w[4 * i + 3]}; }
    }
    bf16_t* MQ = (bf16_t*)(p.ws + WS_MQ);
    for (int e = tid; e < 32 * 384; e += 512) { const int tok = e / 384, c = e % 384, dd = c % 96; const int pos = s0.pos + tok;
        float v = qo[e];
        if (dd >= 64 && !s0.isctx) { const int pe = dd - 64, axis = pe >> 4, half = (pe >> 3) & 1, f = pe & 7; const int pp = axis == 0 ? (pos >> 6) : (pos & 63);
            const float cs = tabc[pp * 8 + f], sn = tabs[pp * 8 + f];
            const float x1 = half ? qo[e - 8] : v, x2 = half ? v : qo[e + 8];
            v = half ? (x2 * cs + x1 * sn) : (x1 * cs - x2 * sn); }
        MQ[(size_t)(t0 + tok) * 384 + c] = f2bf(v); }
    for (int e = tid; e < 32 * 32; e += 512) { const int tok = e >> 5, pe = e & 31, axis = pe >> 4, half = (pe >> 3) & 1, f = pe & 7; const int row = t0 + tok, pos = s0.pos + tok;
        float v = bf2f(P[(size_t)row * NP + PC_MLAKPE + pe]);
        if (!s0.isctx) { const int pp = axis == 0 ? (pos >> 6) : (pos & 63); const float cs = tabc[pp * 8 + f], sn = tabs[pp * 8 + f];
            const float other = bf2f(P[(size_t)row * NP + PC_MLAKPE + (half ? pe - 8 : pe + 8)]);
            const float x1 = half ? other : v, x2 = half ? v : other;
            v = half ? (x2 * cs + x1 * sn) : (x1 * cs - x2 * sn); }
        const bf16_t o = f2bf(v);
#pragma unroll
        for (int h = 0; h < 4; ++h) ((bf16_t*)(p.ws + WS_KM))[((size_t)(s0.b * 4 + h) * NKEYS + key0 + tok) * 96 + 64 + pe] = o; }
    __syncthreads();
}
__device__ __forceinline__ void ret_scan_item(const Params& p, int l, int item) {
    const int tid = get_tid(); const int seq = item >> 1, dir = item & 1, h = seq & 3;
    const float lg = log1pf(-exp2f(-5.f - (float)h)); const float cdec = expf(128.f * lg);
    float* base = (float*)(p.ws + WS_RET) + (size_t)seq * 34 * 2 * 4096 + dir * 4096;
    auto ci_of = [&](int st) -> int { return dir == 0 ? st : (st == 0 ? 1 : (st == 1 ? 0 : 35 - st)); };
    float S[8];
#pragma unroll
    for (int i = 0; i < 8; ++i) S[i] = 0.f;
    f32x4 pa[4], pb[4];
#pragma unroll
    for (int k = 0; k < 4; ++k) { const float* q = base + (size_t)ci_of(k) * 2 * 4096 + tid * 8; pa[k] = *(const f32x4*)q; pb[k] = *(const f32x4*)(q + 4); }
#pragma unroll 1
    for (int st0 = 0; st0 < 36; st0 += 4) {
#pragma unroll
        for (int k = 0; k < 4; ++k) { const int st = st0 + k;
            if (st < 34) {
                float* q = base + (size_t)ci_of(st) * 2 * 4096 + tid * 8;
                const f32x4 t0 = pa[k], t1 = pb[k];
                if (st + 4 < 34) { const float* qn = base + (size_t)ci_of(st + 4) * 2 * 4096 + tid * 8; pa[k] = *(const f32x4*)qn; pb[k] = *(const f32x4*)(qn + 4); }
                *(f32x4*)q = (f32x4){S[0], S[1], S[2], S[3]}; *(f32x4*)(q + 4) = (f32x4){S[4], S[5], S[6], S[7]};
                S[0] = S[0] * cdec + t0.x; S[1] = S[1] * cdec + t0.y; S[2] = S[2] * cdec + t0.z; S[3] = S[3] * cdec + t0.w;
                S[4] = S[4] * cdec + t1.x; S[5] = S[5] * cdec + t1.y; S[6] = S[6] * cdec + t1.z; S[7] = S[7] * cdec + t1.w;
            } }
    }
    asm volatile("s_waitcnt vmcnt(0)" ::: "memory");
    __syncthreads();
    if (tid == 0) { __builtin_amdgcn_fence(__ATOMIC_RELEASE, "agent"); asm volatile("s_waitcnt vmcnt(0)" ::: "memory");
        __hip_atomic_fetch_add((unsigned*)(p.ws + WS_CTR) + 2 + l, 1u, __ATOMIC_RELAXED, __HIP_MEMORY_SCOPE_AGENT); }
}
__device__ __forceinline__ void wait_counter(const Params& p, int idx, unsigned need) {
    if (get_tid() == 0) { unsigned* f = (unsigned*)(p.ws + WS_CTR) + idx; unsigned sp = 0;
        while (__hip_atomic_load(f, __ATOMIC_RELAXED, __HIP_MEMORY_SCOPE_AGENT) < need) { __builtin_amdgcn_s_sleep(4); if (++sp > (1u << 22)) break; }
        __builtin_amdgcn_fence(__ATOMIC_ACQUIRE, "agent"); asm volatile("s_waitcnt vmcnt(0)" ::: "memory"); }
    __syncthreads();
}
template <int DK>
__device__ __forceinline__ void attn_unit(const bf16_t* Q, int qstride, const bf16_t* K, const bf16_t* Vt, int nctx, int mt0, int mt1, bool masked, int qpos0,
                                          bool has_sink, float sink, float scale, bf16_t* O, int ostride, LAS unsigned char* lds) {
    constexpr int KC = DK / 32, KP = DK + 8, KROW = KP * 2;
    constexpr int PIECES_K = 64 * DK / 8;
    constexpr int BUFB = 64 * KROW + 64 * 144;
    const int tid = get_tid(), lane = tid & 63, wave = tid >> 6, fr = lane & 15, fq = lane >> 4;
    const float sl2 = scale * 1.44269504f;
    bf16x8 qf[2][KC];
#pragma unroll
    for (int g = 0; g < 2; ++g)
#pragma unroll
        for (int kc = 0; kc < KC; ++kc) { const u32x4 u = *(const u32x4*)(Q + (size_t)(wave * 32 + g * 16 + fr) * qstride + kc * 32 + fq * 8); float f[8]; unpack8(u, f);
            u32x4 o; o.x = cvt_pk_bf16(f[0] * sl2, f[1] * sl2); o.y = cvt_pk_bf16(f[2] * sl2, f[3] * sl2); o.z = cvt_pk_bf16(f[4] * sl2, f[5] * sl2); o.w = cvt_pk_bf16(f[6] * sl2, f[7] * sl2);
            qf[g][kc] = __builtin_bit_cast(bf16x8, o); }
    float mq[2] = {0.f, 0.f}, lsum[2] = {0.f, 0.f}; f32x4 o[2][4];
#pragma unroll
    for (int g = 0; g < 2; ++g)
#pragma unroll
        for (int n = 0; n < 4; ++n) o[g][n] = (f32x4){0.f, 0.f, 0.f, 0.f};
    const int ntiles = nctx + (mt1 - mt0);
    u32x4 kr[2], vr;
    auto issue = [&](int ti) {
        const int tile = ti < nctx ? ti : mt0 + (ti - nctx);
        const bf16_t* kb = K + (size_t)tile * 64 * DK;
#pragma unroll
        for (int i = 0; i < 2; ++i) { const int pc = tid + i * 512; if (pc < PIECES_K) kr[i] = *(const u32x4*)(kb + (size_t)pc * 8); }
        { const int d = tid >> 3, c8 = tid & 7; vr = *(const u32x4*)(Vt + (size_t)d * NKEYS + tile * 64 + c8 * 8); }
    };
    auto stash = [&](int bufi) {
        LAS unsigned char* Kt = lds + bufi * BUFB; LAS unsigned char* Vl = Kt + 64 * KROW;
#pragma unroll
        for (int i = 0; i < 2; ++i) { const int pc = tid + i * 512; if (pc < PIECES_K) { const int row = pc / (DK / 8), c8 = pc % (DK / 8); *(LAS u32x4*)(Kt + row * KROW + c8 * 16) = kr[i]; } }
        { const int d = tid >> 3, c8 = tid & 7; *(LAS u32x4*)(Vl + d * 144 + c8 * 16) = vr; }
    };
    issue(0); stash(0);
    if (ntiles > 1) issue(1);
    __syncthreads();
    for (int ti = 0; ti < ntiles; ++ti) {
        const int tile = ti < nctx ? ti : mt0 + (ti - nctx);
        LAS unsigned char* Kt = lds + (ti & 1) * BUFB; LAS unsigned char* Vl = Kt + 64 * KROW;
        if (ti + 1 < ntiles) { stash((ti + 1) & 1); if (ti + 2 < ntiles) issue(ti + 2); }
        f32x4 s[2][4];
#pragma unroll
        for (int n = 0; n < 4; ++n) {
            s[0][n] = (f32x4){-mq[0], -mq[0], -mq[0], -mq[0]}; s[1][n] = (f32x4){-mq[1], -mq[1], -mq[1], -mq[1]};
#pragma unroll
            for (int kc = 0; kc < KC; ++kc) { const bf16x8 kf = *(const LAS bf16x8*)(Kt + (n * 16 + fr) * KROW + kc * 64 + fq * 16);
                s[0][n] = __builtin_amdgcn_mfma_f32_16x16x32_bf16(kf, qf[0][kc], s[0][n], 0, 0, 0);
                s[1][n] = __builtin_amdgcn_mfma_f32_16x16x32_bf16(kf, qf[1][kc], s[1][n], 0, 0, 0); } }
        if (ti == 0) {
#pragma unroll
            for (int g = 0; g < 2; ++g) {
                float t = -INFINITY;
#pragma unroll
                for (int n = 0; n < 4; ++n)
#pragma unroll
                    for (int r = 0; r < 4; ++r) t = fmaxf(t, s[g][n][r]);
                t = fmaxf(t, __shfl_xor(t, 16)); t = fmaxf(t, __shfl_xor(t, 32));
                if (has_sink) t = fmaxf(t, sink * 1.44269504f);
                mq[g] = t;
#pragma unroll
                for (int n = 0; n < 4; ++n)
#pragma unroll
                    for (int r = 0; r < 4; ++r) s[g][n][r] -= t;
            }
        }
        if (masked && ti >= nctx) {
#pragma unroll
            for (int g = 0; g < 2; ++g)
#pragma unroll
                for (int n = 0; n < 4; ++n)
#pragma unroll
                    for (int r = 0; r < 4; ++r) { const int kp = tile * 64 + n * 16 + fq * 4 + r - CTXL, qp = qpos0 + wave * 32 + g * 16 + fr; const int df = qp - kp; if (df > 128 || df < -128) s[g][n][r] = -INFINITY; }
        }
#pragma unroll
        for (int g = 0; g < 2; ++g)
#pragma unroll
            for (int n = 0; n < 4; ++n)
#pragma unroll
                for (int r = 0; r < 4; ++r) { s[g][n][r] = __builtin_amdgcn_exp2f(s[g][n][r]); lsum[g] += s[g][n][r]; }
#pragma unroll
        for (int c = 0; c < 2; ++c) {
            bf16x8 pf[2];
#pragma unroll
            for (int g = 0; g < 2; ++g) { u32x4 pu; pu.x = cvt_pk_bf16(s[g][2 * c][0], s[g][2 * c][1]); pu.y = cvt_pk_bf16(s[g][2 * c][2], s[g][2 * c][3]);
                pu.z = cvt_pk_bf16(s[g][2 * c + 1][0], s[g][2 * c + 1][1]); pu.w = cvt_pk_bf16(s[g][2 * c + 1][2], s[g][2 * c + 1][3]); pf[g] = __builtin_bit_cast(bf16x8, pu); }
#pragma unroll
            for (int n = 0; n < 4; ++n) {
                const u32x2 lo = *(const LAS u32x2*)(Vl + (n * 16 + fr) * 144 + ((2 * c) * 16 + fq * 4) * 2), hi = *(const LAS u32x2*)(Vl + (n * 16 + fr) * 144 + ((2 * c + 1) * 16 + fq * 4) * 2);
                const bf16x8 vf = __builtin_bit_cast(bf16x8, (u32x4){lo.x, lo.y, hi.x, hi.y});
                o[0][n] = __builtin_amdgcn_mfma_f32_16x16x32_bf16(vf, pf[0], o[0][n], 0, 0, 0);
                o[1][n] = __builtin_amdgcn_mfma_f32_16x16x32_bf16(vf, pf[1], o[1][n], 0, 0, 0); }
        }
        __syncthreads();
    }
#pragma unroll
    for (int g = 0; g < 2; ++g) {
        float t = lsum[g];
        t += __shfl_xor(t, 16); t += __shfl_xor(t, 32);
        if (has_sink) t += __builtin_amdgcn_exp2f(sink * 1.44269504f - mq[g]);
        const float inv = 1.f / t;
#pragma unroll
        for (int n = 0; n < 4; ++n) { u32x2 ov; ov.x = cvt_pk_bf16(o[g][n][0] * inv, o[g][n][1] * inv); ov.y = cvt_pk_bf16(o[g][n][2] * inv, o[g][n][3] * inv);
            *(u32x2*)(O + (size_t)(wave * 32 + g * 16 + fr) * ostride + n * 16 + fq * 4) = ov; }
    }
}

__device__ __forceinline__ void ret_out_item(const Params& p, int l, LAS unsigned char* lds, int item) {
    const int tid = get_tid(), lane = tid & 63, wave = tid >> 6, fr = lane & 15, fq = lane >> 4;
    bf16_t* P = (bf16_t*)(p.ws + WS_P);
    const int cr = item >> 2, h = item & 3; int b; const int ci = ret_chunk_index(cr, b);
    const int r0 = cr * 128;
    const float lg2 = log1pf(-exp2f(-5.f - (float)h)) * 1.44269504f;
    LAS unsigned char* Kb = lds;
    LAS unsigned char* Vt = lds + 18432;
    LAS unsigned char* SfT = lds + 35840;
    LAS unsigned char* SbT = lds + 45056;
    for (int pc = tid; pc < 1024; pc += 512) { const int j = pc >> 3, c8 = pc & 7;
        const u32x4 kk = *(const u32x4*)(P + (size_t)(r0 + j) * NP + PC_RETK + h * 64 + c8 * 8);
        const u32x4 vv = *(const u32x4*)(P + (size_t)(r0 + j) * NP + PC_RETV + h * 64 + c8 * 8);
        float kf[8]; unpack8(kk, kf);
        u32x4 ko; ko.x = pk2(kf[0] * 0.125f, kf[1] * 0.125f); ko.y = pk2(kf[2] * 0.125f, kf[3] * 0.125f); ko.z = pk2(kf[4] * 0.125f, kf[5] * 0.125f); ko.w = pk2(kf[6] * 0.125f, kf[7] * 0.125f);
        *(LAS u32x4*)(Kb + j * 144 + c8 * 16) = ko;
        const unsigned vw[4] = {vv.x, vv.y, vv.z, vv.w};
#pragma unroll
        for (int x = 0; x < 8; ++x) *(LAS bf16_t*)(Vt + (c8 * 8 + x) * 272 + j * 2) = (bf16_t)((x & 1) ? (vw[x >> 1] >> 16) : (vw[x >> 1] & 0xffff)); }
    { const float* RS = (const float*)(p.ws + WS_RET) + ((size_t)((b * 4 + h) * 34 + ci) * 2) * 4096;
      for (int pc = tid; pc < 1024; pc += 512) { const int d = pc >> 4, e4 = (pc & 15) * 4;
          const f32x4 a = *(const f32x4*)(RS + d * 64 + e4), bb = *(const f32x4*)(RS + 4096 + d * 64 + e4);
#pragma unroll
          for (int x = 0; x < 4; ++x) { *(LAS bf16_t*)(SfT + (e4 + x) * 144 + d * 2) = f2bf(a[x]); *(LAS bf16_t*)(SbT + (e4 + x) * 144 + d * 2) = f2bf(bb[x]); } } }
    const int i = wave * 16 + fr;
    u32x4 qraw[2];
#pragma unroll
    for (int kc = 0; kc < 2; ++kc) qraw[kc] = *(const u32x4*)(P + (size_t)(r0 + i) * NP + PC_RETQ + h * 64 + kc * 32 + fq * 8);
    __syncthreads();
    f32x4 s[8];
#pragma unroll
    for (int nb = 0; nb < 8; ++nb) { s[nb] = (f32x4){0.f, 0.f, 0.f, 0.f};
#pragma unroll
        for (int kc = 0; kc < 2; ++kc) { const bf16x8 kf = *(const LAS bf16x8*)(Kb + (nb * 16 + fr) * 144 + kc * 64 + fq * 16);
            s[nb] = __builtin_amdgcn_mfma_f32_16x16x32_bf16(kf, __builtin_bit_cast(bf16x8, qraw[kc]), s[nb], 0, 0, 0); } }
#pragma unroll
    for (int nb = 0; nb < 8; ++nb)
#pragma unroll
        for (int r = 0; r < 4; ++r) { const int j = nb * 16 + fq * 4 + r; const int df = i - j; const int adf = df < 0 ? -df : df;
            float dcy = __builtin_amdgcn_exp2f((float)adf * lg2); if (df == 0) dcy = 2.f; s[nb][r] *= dcy; }
    f32x4 o[4];
#pragma unroll
    for (int n = 0; n < 4; ++n) o[n] = (f32x4){0.f, 0.f, 0.f, 0.f};
#pragma unroll
    for (int c = 0; c < 4; ++c) {
        u32x4 pu; pu.x = cvt_pk_bf16(s[2 * c][0], s[2 * c][1]); pu.y = cvt_pk_bf16(s[2 * c][2], s[2 * c][3]); pu.z = cvt_pk_bf16(s[2 * c + 1][0], s[2 * c + 1][1]); pu.w = cvt_pk_bf16(s[2 * c + 1][2], s[2 * c + 1][3]);
        const bf16x8 pf = __builtin_bit_cast(bf16x8, pu);
#pragma unroll
        for (int n = 0; n < 4; ++n) {
            const u32x2 lo = *(const LAS u32x2*)(Vt + (n * 16 + fr) * 272 + ((2 * c) * 16 + fq * 4) * 2), hi = *(const LAS u32x2*)(Vt + (n * 16 + fr) * 272 + ((2 * c + 1) * 16 + fq * 4) * 2);
            const bf16x8 vf = __builtin_bit_cast(bf16x8, (u32x4){lo.x, lo.y, hi.x, hi.y});
            o[n] = __builtin_amdgcn_mfma_f32_16x16x32_bf16(vf, pf, o[n], 0, 0, 0); }
    }
    const float gf = __builtin_amdgcn_exp2f((float)(i + 1) * lg2), gb = __builtin_amdgcn_exp2f((float)(128 - i) * lg2);
#pragma unroll
    for (int kc = 0; kc < 2; ++kc) {
        float f[8]; unpack8(qraw[kc], f);
        u32x4 uf, ub;
        uf.x = cvt_pk_bf16(f[0] * gf, f[1] * gf); uf.y = cvt_pk_bf16(f[2] * gf, f[3] * gf); uf.z = cvt_pk_bf16(f[4] * gf, f[5] * gf); uf.w = cvt_pk_bf16(f[6] * gf, f[7] * gf);
        ub.x = cvt_pk_bf16(f[0] * gb, f[1] * gb); ub.y = cvt_pk_bf16(f[2] * gb, f[3] * gb); ub.z = cvt_pk_bf16(f[4] * gb, f[5] * gb); ub.w = cvt_pk_bf16(f[6] * gb, f[7] * gb);
        const bf16x8 qF = __builtin_bit_cast(bf16x8, uf), qB = __builtin_bit_cast(bf16x8, ub);
#pragma unroll
        for (int n = 0; n < 4; ++n) {
            const bf16x8 af = *(const LAS bf16x8*)(SfT + (n * 16 + fr) * 144 + kc * 64 + fq * 16), ab = *(const LAS bf16x8*)(SbT + (n * 16 + fr) * 144 + kc * 64 + fq * 16);
            o[n] = __builtin_amdgcn_mfma_f32_16x16x32_bf16(af, qF, o[n], 0, 0, 0);
            o[n] = __builtin_amdgcn_mfma_f32_16x16x32_bf16(ab, qB, o[n], 0, 0, 0); }
    }
    float sm = 0.f;
#pragma unroll
    for (int n = 0; n < 4; ++n) sm += (o[n][0] + o[n][1]) + (o[n][2] + o[n][3]);
    sm += __shfl_xor(sm, 16); sm += __shfl_xor(sm, 32);
    const float mu = sm * (1.f / 64.f);
    float vs = 0.f;
#pragma unroll
    for (int n = 0; n < 4; ++n)
#pragma unroll
        for (int r = 0; r < 4; ++r) { const float dl = o[n][r] - mu; vs += dl * dl; }
    vs += __shfl_xor(vs, 16); vs += __shfl_xor(vs, 32);
    const float rstd = 1.f / sqrtf(vs * (1.f / 64.f) + 1e-5f);
#pragma unroll
    for (int n = 0; n < 4; ++n) { const int e0 = n * 16 + fq * 4;
        const u32x2 gu = *(const u32x2*)(P + (size_t)(r0 + i) * NP + PC_RETG + h * 64 + e0);
        const f32x4 gn = *(const f32x4*)(p.in[13] + l * 256 + h * 64 + e0);
        const float g0 = bf2f((bf16_t)(gu.x & 0xffff)), g1 = bf2f((bf16_t)(gu.x >> 16)), g2 = bf2f((bf16_t)(gu.y & 0xffff)), g3 = bf2f((bf16_t)(gu.y >> 16));
        u32x2 yo;
        yo.x = cvt_pk_bf16((o[n][0] - mu) * rstd * gn.x * (g0 / (1.f + __expf(-g0))), (o[n][1] - mu) * rstd * gn.y * (g1 / (1.f + __expf(-g1))));
        yo.y = cvt_pk_bf16((o[n][2] - mu) * rstd * gn.z * (g2 / (1.f + __expf(-g2))), (o[n][3] - mu) * rstd * gn.w * (g3 / (1.f + __expf(-g3))));
        *(u32x2*)(P + (size_t)(r0 + i) * NP + PC_RETQ + h * 64 + e0) = yo; }
    __syncthreads();
}

constexpr int NSCANBLK = 128;
__device__ __forceinline__ void rwkv_scan_item(const Params& p, int l, LAS unsigned char* lds, int item) {
    const int tid = get_tid();
    const int sc = item >> 1, half = item & 1;
    const int b = sc >> 3, h = (sc >> 1) & 3, dir = sc & 1;
    const bf16_t* RK = (const bf16_t*)(p.ws + WS_RWK); const bf16_t* RV = (const bf16_t*)(p.ws + WS_RWV); const bf16_t* RR = (const bf16_t*)(p.ws + WS_RWRR);
    const bf16_t* RA = (const bf16_t*)(p.ws + (dir ? WS_RWA1 : WS_RWA0)); const bf16_t* RM = (const bf16_t*)(p.ws + (dir ? WS_RWM1 : WS_RWM0));
    bf16_t* P = (bf16_t*)(p.ws + WS_P);
    const int ocol = (dir ? PC_RWO1 : PC_RWO0) + h * 64 + half * 32;
    LAS float* SA = (LAS float*)lds;
    LAS float* OUT = SA + 64 * 384;
    const int st = tid >> 3, c0 = (tid & 7) * 8;
    float kkp[8], kap[8];
#pragma unroll
    for (int i = 0; i < 8; ++i) { kkp[i] = p.in[20][l * 256 + h * 64 + c0 + i]; kap[i] = p.in[21][l * 256 + h * 64 + c0 + i]; }
    const int row_l = tid >> 4, kq = tid & 15;
    f32x2 S[2];
#pragma unroll
    for (int i = 0; i < 2; ++i) S[i] = (f32x2){0.f, 0.f};
    auto row_of = [&](int s) -> int {
        if (s < CTXL) return TMAIN + b * CTXL + (dir ? CTXL - 1 - s : s);
        const int t = s - CTXL; return b * SEQL + (dir ? SEQL - 1 - t : t);
    };
    u32x4 gk, gv, gr, ga, gm;
    auto issue = [&](int ch) { const size_t o = (size_t)row_of(ch * 64 + st) * 256 + h * 64 + c0;
        gk = *(const u32x4*)(RK + o); gv = *(const u32x4*)(RV + o); gr = *(const u32x4*)(RR + o); ga = *(const u32x4*)(RA + o); gm = *(const u32x4*)(RM + o); };
    issue(0);
    for (int ch = 0; ch < 68; ++ch) {
        {
            float k[8], a[8], om[8], rr[8], vv8[8]; unpack8(gk, k); unpack8(ga, a); unpack8(gm, om); unpack8(gr, rr); unpack8(gv, vv8);
            float kk[8]; float n2 = 0.f;
#pragma unroll
            for (int i = 0; i < 8; ++i) { kk[i] = k[i] * kkp[i]; n2 += kk[i] * kk[i]; }
            n2 = red8(n2);
            const float rn = 1.f / sqrtf(fmaxf(n2, 1e-12f));
            f32x4 o0, o1;
#define ST8(DST, EXPR) { float t8[8]; _Pragma("unroll") for (int i = 0; i < 8; ++i) t8[i] = (EXPR); \
            *(LAS f32x4*)(SA + st * 384 + (DST) * 64 + c0) = (f32x4){t8[0], t8[1], t8[2], t8[3]}; *(LAS f32x4*)(SA + st * 384 + (DST) * 64 + c0 + 4) = (f32x4){t8[4], t8[5], t8[6], t8[7]}; }
            ST8(0, kk[i] * rn)
            ST8(1, 1.f - om[i])
            ST8(2, kk[i] * rn * a[i])
            ST8(3, k[i] * (1.f + (a[i] - 1.f) * kap[i]))
            ST8(4, rr[i])
            ST8(5, vv8[i])
#undef ST8
        }
        __syncthreads();
        if (ch + 1 < 68) issue(ch + 1);
        {
            struct Ops { f32x4 kh, w, b, t, r; float vv; };
            const LAS float* sbase = SA + kq * 4; const LAS float* vbase = SA + 5 * 64 + half * 32 + row_l;
            auto ldops = [&](int s) -> Ops { Ops q;
                q.kh = *(const LAS f32x4*)(sbase + s * 384); q.w = *(const LAS f32x4*)(sbase + s * 384 + 64); q.b = *(const LAS f32x4*)(sbase + s * 384 + 128);
                q.t = *(const LAS f32x4*)(sbase + s * 384 + 192); q.r = *(const LAS f32x4*)(sbase + s * 384 + 256);
                q.vv = vbase[s * 384]; return q; };
            Ops nx = ldops(0);
#pragma unroll 2
            for (int s = 0; s < 64; ++s) {
                const Ops c = nx;
                nx = ldops(s + 1 < 64 ? s + 1 : 63);
                f32x2 a2 = S[0] * (f32x2){c.kh.x, c.kh.y}; a2 = S[1] * (f32x2){c.kh.z, c.kh.w} + a2;
                const float sk = red16(a2.x + a2.y);
                const f32x2 nsk = (f32x2){-sk, -sk}, vv2 = (f32x2){c.vv, c.vv};
                S[0] = S[0] * (f32x2){c.w.x, c.w.y} + (nsk * (f32x2){c.b.x, c.b.y} + vv2 * (f32x2){c.t.x, c.t.y});
                S[1] = S[1] * (f32x2){c.w.z, c.w.w} + (nsk * (f32x2){c.b.z, c.b.w} + vv2 * (f32x2){c.t.z, c.t.w});
                f32x2 o2 = S[0] * (f32x2){c.r.x, c.r.y}; o2 = S[1] * (f32x2){c.r.z, c.r.w} + o2;
                const float ov = red4(o2.x + o2.y);
                OUT[(s * 32 + row_l) * 4 + (kq >> 2)] = ov;
            }
        }
        __syncthreads();
        { const int c4 = (tid & 7) * 4;
          const f32x4 q0 = *(const LAS f32x4*)(OUT + (st * 32 + c4) * 4), q1 = *(const LAS f32x4*)(OUT + (st * 32 + c4 + 1) * 4), q2 = *(const LAS f32x4*)(OUT + (st * 32 + c4 + 2) * 4), q3 = *(const LAS f32x4*)(OUT + (st * 32 + c4 + 3) * 4);
          const f32x4 ov = (f32x4){(q0.x + q0.y) + (q0.z + q0.w), (q1.x + q1.y) + (q1.z + q1.w), (q2.x + q2.y) + (q2.z + q2.w), (q3.x + q3.y) + (q3.z + q3.w)};
          u32x2 o2; o2.x = pk2(ov.x, ov.y); o2.y = pk2(ov.z, ov.w);
          *(u32x2*)(P + (size_t)row_of(ch * 64 + st) * NP + ocol + c4) = o2; }
    }
    __syncthreads();
}

__device__ __forceinline__ void mixer_mla(const Params& p, LAS unsigned char* lds, int it) {
    bf16_t* P = (bf16_t*)(p.ws + WS_P);
    const bf16_t* MQ = (const bf16_t*)(p.ws + WS_MQ);
    int b, h, row0, nm1;
    if (it < 512) { b = it >> 6; h = (it >> 4) & 3; row0 = b * SEQL + (it & 15) * 256; nm1 = 68; }
    else { const int u = it - 512; b = u >> 2; h = u & 3; row0 = TMAIN + b * CTXL; nm1 = 4; }
    attn_unit<96>(MQ + (size_t)row0 * 384 + h * 96, 384, (const bf16_t*)(p.ws + WS_KM) + (size_t)(b * 4 + h) * NKEYS * 96, (const bf16_t*)(p.ws + WS_VTM) + (size_t)(b * 4 + h) * 64 * NKEYS,
                  4, 4, nm1, false, 0, false, 0.f, 0.10206207f, P + (size_t)row0 * NP + PC_MLAQD + h * 64, NP, lds);
}
__device__ __forceinline__ void mixer_swa(const Params& p, int l, LAS unsigned char* lds, int u0) {
    bf16_t* P = (bf16_t*)(p.ws + WS_P);
    int b, h, row0, nm0, nm1, qp0; bool msk;
    if (u0 < 512) { b = u0 >> 6; h = (u0 >> 4) & 3; const int qb = u0 & 15; row0 = b * SEQL + qb * 256; nm0 = 4 + 4 * qb - 2; nm1 = 4 + 4 * qb + 6; if (nm0 < 4) nm0 = 4; if (nm1 > 68) nm1 = 68; qp0 = qb * 256; msk = true; }
    else { const int u = u0 - 512; b = u >> 2; h = u & 3; row0 = TMAIN + b * CTXL; nm0 = 4; nm1 = 4; qp0 = 0; msk = false; }
    const int hk = h >> 1;
    bf16_t* qp = P + (size_t)row0 * NP + PC_SWAQ + h * 64;
    attn_unit<64>(qp, NP, (const bf16_t*)(p.ws + WS_KS) + (size_t)(b * 2 + hk) * NKEYS * 64, (const bf16_t*)(p.ws + WS_VTS) + (size_t)(b * 2 + hk) * 64 * NKEYS,
                  4, nm0, nm1, msk, qp0, true, p.in[12][l * 4 + h], 0.125f, qp, NP, lds);
}
__device__ __forceinline__ void phase_mixers(const Params& p, int l, LAS unsigned char* lds, int bid, int nb) {
    const bool ectx = (l == 0);
    const int N_MLA = 512 + (ectx ? 32 : 0), N_SWA = 512 + (ectx ? 32 : 0), N_RET = 1024 + (ectx ? 64 : 0);
    if (bid < NSCANBLK) rwkv_scan_item(p, l, lds, bid);
    else {
        prep_rest_items(p, l, lds, bid - NSCANBLK, nb - NSCANBLK);
        asm volatile("s_waitcnt vmcnt(0)" ::: "memory");
        __syncthreads();
        if (get_tid() == 0) { __builtin_amdgcn_fence(__ATOMIC_RELEASE, "agent"); asm volatile("s_waitcnt vmcnt(0)" ::: "memory");
            __hip_atomic_fetch_add((unsigned*)(p.ws + WS_CTR) + 4 + l, 1u, __ATOMIC_RELAXED, __HIP_MEMORY_SCOPE_AGENT); }
        if (bid < NSCANBLK + 64) { wait_counter(p, 4 + l, (unsigned)(nb - NSCANBLK)); ret_scan_item(p, l, bid - NSCANBLK); }
    }
    wait_counter(p, 4 + l, (unsigned)(nb - NSCANBLK));
    bool ret_ready = false;
    unsigned* ctr = (unsigned*)(p.ws + WS_CTR) + l;
    LAS unsigned* slot = (LAS unsigned*)(lds + LDS_BYTES - 16);
    const int tid0 = get_tid();
    for (;;) {
        __syncthreads();
        if (tid0 == 0) *slot = atomicAdd(ctr, 1u);
        __syncthreads();
        const int it = (int)*slot;
        if (it >= N_MLA + N_SWA + N_RET) break;
        if (it < N_MLA) mixer_mla(p, lds, it);
        else if (it < N_MLA + N_SWA) mixer_swa(p, l, lds, it - N_MLA);
        else { if (!ret_ready) { wait_counter(p, 2 + l, 64u); ret_ready = true; } ret_out_item(p, l, lds, it - N_MLA - N_SWA); }
    }
}

__device__ __forceinline__ void phase_rwkv_finish(const Params& p, int l, LAS unsigned char* lds, int bid, int nb) {
    const int tid = get_tid();
    bf16_t* P = (bf16_t*)(p.ws + WS_P);
    const int ntiles = (l == 0 ? TT : TMAIN) / 32;
    const float* mu = p.in[14] + l * 1024 + 896;
    const float* gup = p.in[19] + (size_t)l * 128 * 256;
    const bf16_t* RV = (const bf16_t*)(p.ws + WS_RWV); const float* BON = (const float*)(p.ws + WS_BON);
    for (int tile = bid; tile < ntiles; tile += nb) {
        const int t0 = tile * 32; const SeqInfo s0 = seq_of_row(t0);
        LAS unsigned char* sgb = lds;
        LAS float* gout = (LAS float*)(lds + 32 * 272);
        { const int tok = tid >> 4, j8 = (tid & 15) * 8; const int row = t0 + tok, pos = s0.pos + tok;
          const u32x4 u0 = *(const u32x4*)(P + (size_t)row * NP + PC_RWGD + j8);
          const u32x4 um = pos > 0 ? *(const u32x4*)(P + (size_t)(row - 1) * NP + PC_RWGD + j8) : (u32x4){0u, 0u, 0u, 0u};
          const u32x4 up = pos < s0.len - 1 ? *(const u32x4*)(P + (size_t)(row + 1) * NP + PC_RWGD + j8) : (u32x4){0u, 0u, 0u, 0u};
          float z0[8], zm[8], zp[8], sv[8]; unpack8(u0, z0); unpack8(um, zm); unpack8(up, zp);
#pragma unroll
          for (int x = 0; x < 8; ++x) sv[x] = sigmoidf_(z0[x] + mu[j8 + x] * (0.5f * (zm[x] + zp[x]) - z0[x]));
          *(LAS u32x4*)(sgb + tok * 272 + j8 * 2) = (u32x4){cvt_pk_bf16(sv[0], sv[1]), cvt_pk_bf16(sv[2], sv[3]), cvt_pk_bf16(sv[4], sv[5]), cvt_pk_bf16(sv[6], sv[7])}; }
        __syncthreads();
        { const int lane = tid & 63, wave = tid >> 6, fr = lane & 15, fq = lane >> 4;
          const bf16_t* GT = (const bf16_t*)(p.ws + WS_GUPT + (size_t)l * 256 * 128 * 2);
#pragma unroll
          for (int q = 0; q < 2; ++q) { const int nt = wave + q * 8;
              f32x4 a0 = (f32x4){0.f, 0.f, 0.f, 0.f}, a1 = a0;
              const bf16_t* wrow = GT + (size_t)(nt * 16 + fr) * 128 + fq * 8;
              bf16x8 bfr[4];
#pragma unroll
              for (int kc = 0; kc < 4; ++kc) bfr[kc] = *(const bf16x8*)(wrow + kc * 32);
#pragma unroll
              for (int kc = 0; kc < 4; ++kc) { const bf16x8 x0 = *(const LAS bf16x8*)(sgb + fr * 272 + kc * 64 + fq * 16), x1 = *(const LAS bf16x8*)(sgb + (16 + fr) * 272 + kc * 64 + fq * 16);
                  a0 = __builtin_amdgcn_mfma_f32_16x16x32_bf16(x0, bfr[kc], a0, 0, 0, 0); a1 = __builtin_amdgcn_mfma_f32_16x16x32_bf16(x1, bfr[kc], a1, 0, 0, 0); }
#pragma unroll
              for (int r = 0; r < 4; ++r) { gout[(fq * 4 + r) * 256 + nt * 16 + fr] = a0[r]; gout[(16 + fq * 4 + r) * 256 + nt * 16 + fr] = a1[r]; } } }
        __syncthreads();
        const int hh = tid >> 8, c = tid & 255, h = c >> 6;
        float g[16];
#pragma unroll
        for (int i = 0; i < 16; ++i) g[i] = gout[(hh * 16 + i) * 256 + c];
        const float gn = p.in[23][l * 256 + c];
        float ov[16], rv[16], bn[16];
#pragma unroll
        for (int i = 0; i < 16; ++i) { const int row = t0 + hh * 16 + i;
            ov[i] = bf2f(P[(size_t)row * NP + PC_RWO0 + c]) + bf2f(P[(size_t)row * NP + PC_RWO1 + c]); rv[i] = bf2f(RV[(size_t)row * 256 + c]); bn[i] = BON[(size_t)row * 4 + h]; }
#pragma unroll
        for (int i = 0; i < 16; ++i) { const int row = t0 + hh * 16 + i;
            const float o = ov[i];
            const float mean = wave_sum(o) * (1.f / 64.f); const float dl = o - mean; const float var = wave_sum(dl * dl) * (1.f / 64.f);
            float y = dl * (1.f / sqrtf(var + 64e-5f)) * gn + bn[i] * rv[i];
            P[(size_t)row * NP + PC_RWO1 + c] = f2bf(y * g[i]); }
        __syncthreads();
    }
}

#ifndef N_LAUNCH_MODE
#define N_LAUNCH_MODE 1
#endif
template <int Q>
__device__ __forceinline__ void layer_phase(const Params& p, int l, LAS unsigned char* lds, int bid, int nb) {
    unsigned char* wb = p.ws + WS_WB + (size_t)l * WB_LAYER;
    const int Mrows = (l == 0) ? TT : TMAIN;
    pg8::StaticOrder S;
    if constexpr (Q == 0) { pg8::Gemm g{(const bf16_t*)(p.ws + WS_HB), (const bf16_t*)(wb + WB_IN), TT, NP, DM, DM}; S.init(TT, NP, nb, bid);
              pg8::EpiBf16<0> E{(bf16_t*)(p.ws + WS_P), NP}; pg8::gemm_phase(lds, g, S, E); }
    if constexpr (Q == 1) phase_prepA(p, l, lds, bid, nb);
    if constexpr (Q == 3) phase_mixers(p, l, lds, bid, nb);
    if constexpr (Q == 4) phase_rwkv_finish(p, l, lds, bid, nb);
    if constexpr (Q == 5) { pg8::Gemm g{(const bf16_t*)(p.ws + WS_P), (const bf16_t*)(wb + WB_OUT), Mrows, DM, DM, NP}; S.init(Mrows, DM, nb, bid);
              pg8::EpiBf16<0> E{(bf16_t*)(p.ws + WS_Z), DM}; pg8::gemm_phase(lds, g, S, E); }
    if constexpr (Q == 6) phase_rowops(p, 1, l, Mrows, bid, nb);
    if constexpr (Q == 7) { pg8::Gemm g{(const bf16_t*)(p.ws + WS_HB), (const bf16_t*)(wb + WB_W1), Mrows, FF, DM, DM}; S.init(Mrows, FF, nb, bid);
              pg8::EpiBf16<1> E{(bf16_t*)(p.ws + WS_HID), FF}; pg8::gemm_phase(lds, g, S, E); }
    if constexpr (Q == 8) { pg8::Gemm g{(const bf16_t*)(p.ws + WS_HID), (const bf16_t*)(wb + WB_W2), Mrows, DM, FF, FF}; S.init(Mrows, DM, nb, bid);
              pg8::EpiBf16<0> E{(bf16_t*)(p.ws + WS_Z), DM}; pg8::gemm_phase(lds, g, S, E); }
    if constexpr (Q == 9) phase_rowops(p, 2, l, Mrows, bid, nb);
}

#ifndef PROBE_MASK
#define PROBE_MASK 0
#endif
#define PB(BIT, CALL) do { if ((PROBE_MASK) & (BIT)) { const unsigned long long t0_ = __builtin_amdgcn_s_memrealtime(); CALL; const unsigned long long t1_ = __builtin_amdgcn_s_memrealtime(); \
        while (__builtin_amdgcn_s_memrealtime() - t1_ < (t1_ - t0_)) __builtin_amdgcn_s_sleep(8); } else { CALL; } } while (0)
#define XB_TMO      128
#define XB_XCNT(j)  (256  + 64 * (j))
#define XB_XSUB(j)  (1280 + 64 * (j))
#define XB_XGEN(j)  (2304 + 64 * (j))
#define XB_TOP      3328
#define XB_TOPGEN   3392
#define XCD_BAR_WORDS 3456
#define XB_SPIN_CAP (1u << 18)

__device__ __forceinline__ unsigned xb_ld(unsigned* p)              { return __hip_atomic_load(p, __ATOMIC_RELAXED, __HIP_MEMORY_SCOPE_AGENT); }
__device__ __forceinline__ unsigned xb_add(unsigned* p, unsigned v) { return __hip_atomic_fetch_add(p, v, __ATOMIC_RELAXED, __HIP_MEMORY_SCOPE_AGENT); }
__device__ __forceinline__ unsigned xb_xcc_id() { return (unsigned)__builtin_amdgcn_s_getreg((3 << 11) | 20) & 0xFu; }
#define XB_SPIN(cond, bar) do { unsigned _sp = 0; while (cond) { __builtin_amdgcn_s_sleep(1); \
    if ((++_sp & 255u) == 0u) { if (xb_ld(&(bar)[XB_TMO])) break; if (_sp > XB_SPIN_CAP) { atomicAdd(&(bar)[XB_TMO], 1u); break; } } } } while (0)

struct XcdBarrier {
    unsigned* bar; unsigned x;
    volatile LAS unsigned* st;
};

__device__ __forceinline__ XcdBarrier xcd_barrier_post(unsigned* bar, volatile LAS unsigned* st) {
    XcdBarrier b; b.bar = bar; b.x = xb_xcc_id(); b.st = st;
    if (threadIdx.x == 0) (void)xb_add(&bar[XB_XCNT(b.x)], 1u);
    return b;
}
__device__ __forceinline__ void xcd_barrier_complete(unsigned* bar, unsigned x, unsigned& nloc, unsigned& nx) {
    const unsigned G = gridDim.x * gridDim.y * gridDim.z;
    unsigned sum, cnt, mine, sp = 0u;
    for (;;) {
        sum = 0u; cnt = 0u; mine = 0u;
#pragma unroll
        for (unsigned j = 0; j < 16; ++j) { const unsigned c = xb_ld(&bar[XB_XCNT(j)]); sum += c; cnt += (c > 0u) ? 1u : 0u; mine = (j == x) ? c : mine; }
        if (sum == G) break;
        __builtin_amdgcn_s_sleep(1);
        if ((++sp & 255u) == 0u) { if (xb_ld(&bar[XB_TMO])) break; if (sp > XB_SPIN_CAP) { atomicAdd(&bar[XB_TMO], 1u); break; } }
    }
    nloc = mine > 0u ? mine : 1u; nx = cnt > 0u ? cnt : 1u;
}

__device__ __forceinline__ void xcd_barrier(const XcdBarrier& b) {
    asm volatile("s_waitcnt vmcnt(0)" ::: "memory");
    __syncthreads();
    if (threadIdx.x == 0) {
        unsigned* bar = b.bar;
        __builtin_amdgcn_s_waitcnt(0);
        unsigned nloc = b.st[0], nx = b.st[1];
        if (nloc == 0u) { xcd_barrier_complete(bar, b.x, nloc, nx); b.st[0] = nloc; b.st[1] = nx; }
        const unsigned old = xb_add(&bar[XB_XSUB(b.x)], 1u);
        const unsigned gen = old / nloc;
        if (old + 1u == (gen + 1u) * nloc) {
            __builtin_amdgcn_fence(__ATOMIC_RELEASE, "agent");
            asm volatile("s_waitcnt vmcnt(0)" ::: "memory");
            const unsigned og = xb_add(&bar[XB_TOP], 1u);
            const unsigned tg = og / nx;
            if (og + 1u == (tg + 1u) * nx) xb_add(&bar[XB_TOPGEN], 1u);
            else XB_SPIN(xb_ld(&bar[XB_TOPGEN]) == tg, bar);
            __builtin_amdgcn_fence(__ATOMIC_ACQUIRE, "agent");
            xb_add(&bar[XB_XGEN(b.x)], 1u);
            asm volatile("s_waitcnt vmcnt(0)" ::: "memory");
        } else {
            XB_SPIN(xb_ld(&bar[XB_XGEN(b.x)]) == gen, bar);
            __builtin_amdgcn_fence(__ATOMIC_ACQUIRE, "agent");
            asm volatile("s_waitcnt vmcnt(0)" ::: "memory");
        }
    }
    __syncthreads();
}


constexpr size_t WS_XBAR = 772 * 1024;
#define GSYNC() xcd_barrier(xb)

__global__ void __launch_bounds__(512, 2) mega_fwd(Params p) {
    extern __shared__ __attribute__((aligned(16))) unsigned char lds_raw[];
    LAS unsigned char* lds = (LAS unsigned char*)lds_raw;
    cg::grid_group grid = cg::this_grid();
    const int bid = blockIdx.x, nb = gridDim.x;
    { LAS unsigned* st_ = (LAS unsigned*)(lds + LDS_BYTES - 32); if (get_tid() == 0) { st_[0] = 0u; st_[1] = 0u; } __syncthreads(); }
    XcdBarrier xb = xcd_barrier_post((unsigned*)(p.ws + WS_XBAR), (volatile LAS unsigned*)(lds + LDS_BYTES - 32));
    grid.sync();
    PB(16, phase_prologue(p, lds, bid, nb)); GSYNC();
    PB(8, phase_rowops(p, 0, 0, TT, bid, nb)); GSYNC();
#define LAYER(L, LAST) \
    PB(1, layer_phase<0>(p, L, lds, bid, nb)); GSYNC(); PB(4, layer_phase<1>(p, L, lds, bid, nb)); GSYNC(); \
    PB(2, layer_phase<3>(p, L, lds, bid, nb)); GSYNC(); PB(4, layer_phase<4>(p, L, lds, bid, nb)); GSYNC(); PB(1, layer_phase<5>(p, L, lds, bid, nb)); GSYNC(); \
    PB(8, layer_phase<6>(p, L, lds, bid, nb)); GSYNC(); PB(1, layer_phase<7>(p, L, lds, bid, nb)); GSYNC(); PB(1, layer_phase<8>(p, L, lds, bid, nb)); GSYNC(); \
    PB(8, layer_phase<9>(p, L, lds, bid, nb)); if (!(LAST)) GSYNC();
    LAYER(0, false)
    LAYER(1, true)
}
#if N_LAUNCH_MODE != 1
template <int PH> __global__ void __launch_bounds__(512, 2) one_phase(Params p, int l) {
    extern __shared__ __attribute__((aligned(16))) unsigned char lds_raw[];
    LAS unsigned char* lds = (LAS unsigned char*)lds_raw;
    if constexpr (PH == 100) phase_prologue(p, lds, blockIdx.x, gridDim.x);
    else if constexpr (PH == 101) phase_rowops(p, 0, 0, TT, blockIdx.x, gridDim.x);
    else layer_phase<PH>(p, l, lds, blockIdx.x, gridDim.x);
}
#endif

extern "C" void kernel_launch(void* const* d_in, const int* in_sizes, int n_in, void* d_out, int out_size, void* d_ws, size_t ws_size, hipStream_t stream) {
    if (n_in != 30 || ws_size < WS_NEED || out_size != TMAIN * DM) { fprintf(stderr, "kernel_launch: unexpected shapes (n_in %d, ws %zu, out %d)\n", n_in, ws_size, out_size); return; }
    Params p{};
    for (int i = 0; i < 30; ++i) p.in[i] = (const float*)d_in[i];
    p.out = (float*)d_out; p.ws = (unsigned char*)d_ws;
    static int grid_blocks = 0;
    if (!grid_blocks) {
        int dev = 0, cus = 0, per_cu = 0;
        (void)hipGetDevice(&dev);
        (void)hipDeviceGetAttribute(&cus, hipDeviceAttributeMultiprocessorCount, dev);
        (void)hipFuncSetAttribute((const void*)mega_fwd, hipFuncAttributeMaxDynamicSharedMemorySize, LDS_BYTES);
        (void)hipOccupancyMaxActiveBlocksPerMultiprocessor(&per_cu, mega_fwd, 512, LDS_BYTES);
        if (per_cu < 1) { fprintf(stderr, "kernel_launch: occupancy query says %d blocks/CU\n", per_cu); per_cu = 1; }
        grid_blocks = cus * 1;
        if (grid_blocks < 128) { fprintf(stderr, "kernel_launch: only %d CUs\n", grid_blocks); }
    }
#if N_LAUNCH_MODE == 1
    (void)hipMemsetAsync((char*)d_ws + 768 * 1024, 0, 32 * 1024, stream);
    void* args[] = {&p};
    hipError_t e = hipLaunchCooperativeKernel((const void*)mega_fwd, dim3(grid_blocks), dim3(512), args, LDS_BYTES, stream);
    if (e != hipSuccess) fprintf(stderr, "cooperative launch failed: %s (grid %d)\n", hipGetErrorString(e), grid_blocks);
#else
#define LP(PH, L) do { (void)hipFuncSetAttribute((const void*)one_phase<PH>, hipFuncAttributeMaxDynamicSharedMemorySize, LDS_BYTES); one_phase<PH><<<grid_blocks, 512, LDS_BYTES, stream>>>(p, L); } while (0)
    LP(100, 0); LP(101, 0);
    for (int l = 0; l < 2; ++l) { LP(0, l); LP(1, l); LP(2, l); LP(3, l); LP(4, l); LP(5, l); LP(6, l); LP(7, l); LP(8, l); LP(9, l); }
#endif
}
```
